# Optimizing an MI355X kernel written in HIP

```python
import jax, jax.numpy as jnp
from jax import lax
import numpy as np

D_MODEL = 1024
BATCH = 4
SEQ = 4096
DEPTH = 1

GLA_HEADS = 4
GLA_DK = 64
GLA_DV = 128
GLA_GATE_RANK = 16
GLA_GATE_TAU = 16.0
GLA_CHUNK = 64
DIFF_HEADS = 4
DIFF_DH = 64
DIFF_DV = 2 * DIFF_DH
ROPE_THETA = 500000.0
ROPE_DIM = DIFF_DH // 4
Q_BLOCK = 128
NEG_INF = -1e30
GLA_QK_W = GLA_HEADS * GLA_DK
GLA_V_W = GLA_HEADS * GLA_DV
DIFF_QK_W = DIFF_HEADS * 2 * DIFF_DH
DIFF_V_W = DIFF_HEADS * DIFF_DV
IN_SIZES = (GLA_QK_W, GLA_QK_W, GLA_V_W, GLA_V_W, GLA_GATE_RANK,
            DIFF_QK_W, DIFF_QK_W, DIFF_V_W, D_MODEL, D_MODEL)
D_IN = sum(IN_SIZES)
N_GROUPS = 4
EXPERTS_PER_GROUP = 8
N_EXPERTS = N_GROUPS * EXPERTS_PER_GROUP
TOP_K = 2
D_EXPERT = 512
MOE_BLOCK = 128
NORM_EPS = 1e-6
N_MOD = 6

kernel_name = "hybrid_gla_diffattn_hmoe_block"


def rms_norm(x, gain):
    xf = x.astype(jnp.float32)
    y = xf * lax.rsqrt(jnp.mean(xf * xf, axis=-1, keepdims=True) + NORM_EPS)
    return (y * gain.astype(jnp.float32)).astype(x.dtype)


def rope_tables(positions):
    half = ROPE_DIM // 2
    inv_freq = ROPE_THETA ** (-jnp.arange(half, dtype=jnp.float32) / half)
    ang = positions.astype(jnp.float32)[:, :, None] * inv_freq
    return jnp.cos(ang)[:, :, None, None, :], jnp.sin(ang)[:, :, None, None, :]


def partial_rope(x, cos, sin):
    half = ROPE_DIM // 2
    xr = x[..., :ROPE_DIM].astype(jnp.float32)
    x1, x2 = xr[..., :half], xr[..., half:]
    rot = jnp.concatenate([x1 * cos - x2 * sin, x2 * cos + x1 * sin], axis=-1)
    return jnp.concatenate([rot.astype(x.dtype), x[..., ROPE_DIM:]], axis=-1)


def gla_chunked(q, k, v, log_a):
    B, S, H, _ = q.shape
    N = S // GLA_CHUNK
    def to_chunks(t):
        return t.astype(jnp.float32).reshape(B, N, GLA_CHUNK, H, -1).transpose(0, 3, 1, 2, 4)
    q, k, v, g = to_chunks(q), to_chunks(k), to_chunks(v), to_chunks(log_a)
    b = jnp.cumsum(g, axis=3)
    b_last = b[:, :, :, -1:, :]
    q_in = q * jnp.exp(b)
    k_in = k * jnp.exp(-b)
    causal = jnp.tril(jnp.ones((GLA_CHUNK, GLA_CHUNK), dtype=bool))
    att = jnp.where(causal, jnp.einsum('bhnck,bhnsk->bhncs', q_in, k_in), 0.0)
    o_intra = jnp.einsum('bhncs,bhnsv->bhncv', att, v)
    s_chunk = jnp.einsum('bhnsk,bhnsv->bhnkv', k * jnp.exp(b_last - b), v)
    decay = jnp.exp(b_last[:, :, :, 0, :])

    def step(state, inp):
        d, s_c = inp
        return state * d[..., None] + s_c, state

    init = jnp.zeros((B, H, GLA_DK, GLA_DV), jnp.float32)
    _, s_prev = lax.scan(step, init, (jnp.moveaxis(decay, 2, 0), jnp.moveaxis(s_chunk, 2, 0)))
    s_prev = jnp.moveaxis(s_prev, 0, 2)
    o = o_intra + jnp.einsum('bhnck,bhnkv->bhncv', q_in, s_prev)
    return o.transpose(0, 2, 3, 1, 4).reshape(B, S, H, GLA_DV)


def gla_branch(q, k, v, r, a_lr, alpha_up, alpha_b, out_g):
    B, S, _ = q.shape
    q = q.reshape(B, S, GLA_HEADS, GLA_DK) * (GLA_DK ** -0.5)
    k = k.reshape(B, S, GLA_HEADS, GLA_DK)
    v = v.reshape(B, S, GLA_HEADS, GLA_DV)
    log_a = jax.nn.log_sigmoid((a_lr @ alpha_up + alpha_b).astype(jnp.float32)) / GLA_GATE_TAU
    o = gla_chunked(q, k, v, log_a.reshape(B, S, GLA_HEADS, GLA_DK)).astype(v.dtype)
    o = rms_norm(o, out_g) * jax.nn.silu(r.reshape(B, S, GLA_HEADS, GLA_DV))
    return o.reshape(B, S, GLA_V_W)


def diff_branch(q, k, v, cos, sin, q_g, k_g, lq1, lk1, lq2, lk2, out_g, lambda_init):
    B, S, _ = q.shape
    q = partial_rope(rms_norm(q.reshape(B, S, DIFF_HEADS, 2, DIFF_DH), q_g), cos, sin)
    k = partial_rope(rms_norm(k.reshape(B, S, DIFF_HEADS, 2, DIFF_DH), k_g), cos, sin)
    q = q.transpose(0, 2, 3, 1, 4)
    k = k.transpose(0, 2, 3, 1, 4)
    v = v.reshape(B, S, DIFF_HEADS, DIFF_DV).transpose(0, 2, 1, 3)
    f32 = jnp.float32
    lam = (jnp.exp(jnp.sum(lq1.astype(f32) * lk1.astype(f32)))
           - jnp.exp(jnp.sum(lq2.astype(f32) * lk2.astype(f32))) + lambda_init)
    n_blk = S // Q_BLOCK
    qb = q.reshape(B, DIFF_HEADS, 2, n_blk, Q_BLOCK, DIFF_DH).transpose(3, 0, 1, 2, 4, 5)
    key_idx = jnp.arange(S)
    scale = DIFF_DH ** -0.5

    def one_block(args):
        q_blk, blk = args
        s = jnp.einsum('bhcqd,bhckd->bhcqk', q_blk, k, preferred_element_type=f32) * scale
        q_idx = blk * Q_BLOCK + jnp.arange(Q_BLOCK)
        s = jnp.where(key_idx[None, :] <= q_idx[:, None], s, NEG_INF)
        p = jax.nn.softmax(s, axis=-1)
        a = p[:, :, 0] - lam * p[:, :, 1]
        return jnp.einsum('bhqk,bhkv->bhqv', a.astype(v.dtype), v)

    o = lax.map(one_block, (qb, jnp.arange(n_blk)))
    o = o.transpose(1, 0, 3, 2, 4).reshape(B, S, DIFF_HEADS, DIFF_DV)
    o = rms_norm(o, out_g) * (1.0 - lambda_init)
    return o.reshape(B, S, DIFF_V_W)


def hier_moe(h, w_rg, b_rg, w_re, b_re, w1, w3, w2):
    B, S, D = h.shape
    T = B * S
    xf = h.reshape(T, D)
    p_g = jax.nn.softmax((xf @ w_rg + b_rg).astype(jnp.float32), axis=-1)
    p_top, g_idx = lax.top_k(p_g, 1)
    e_logits = (xf @ w_re + b_re).astype(jnp.float32).reshape(T, N_GROUPS, EXPERTS_PER_GROUP)
    e_in = e_logits[jnp.arange(T), g_idx[:, 0]]
    pe_top, e_loc = lax.top_k(jax.nn.softmax(e_in, axis=-1), TOP_K)
    pe_top = pe_top / jnp.sum(pe_top, axis=-1, keepdims=True)
    weights = p_top * pe_top
    expert_ids = g_idx * EXPERTS_PER_GROUP + e_loc
    A = T * TOP_K
    flat_e = expert_ids.reshape(A)
    flat_tok = jnp.repeat(jnp.arange(T, dtype=jnp.int32), TOP_K)
    flat_w = weights.reshape(A)
    order = jnp.argsort(flat_e)
    sorted_e = flat_e[order]
    counts = jnp.bincount(flat_e, length=N_EXPERTS)
    starts = jnp.cumsum(counts) - counts
    padded = ((counts + MOE_BLOCK - 1) // MOE_BLOCK) * MOE_BLOCK
    pad_ends = jnp.cumsum(padded)
    pad_starts = pad_ends - padded
    dest = pad_starts[sorted_e] + (jnp.arange(A) - starts[sorted_e])
    NB = (A + N_EXPERTS * (MOE_BLOCK - 1) + MOE_BLOCK - 1) // MOE_BLOCK
    P = NB * MOE_BLOCK
    slot_tok = jnp.full((P,), T, jnp.int32).at[dest].set(flat_tok[order])
    slot_w = jnp.zeros((P,), jnp.float32).at[dest].set(flat_w[order])
    block_e = jnp.minimum(jnp.searchsorted(pad_ends, jnp.arange(NB) * MOE_BLOCK, side='right'),
                          N_EXPERTS - 1)
    x_pad = jnp.concatenate([xf, jnp.zeros((1, D), xf.dtype)], axis=0)
    xb = x_pad[slot_tok].reshape(NB, MOE_BLOCK, D)

    def expert_block(args):
        xi, e = args
        return (jax.nn.silu(xi @ w1[e]) * (xi @ w3[e])) @ w2[e]

    yb = lax.map(expert_block, (xb, block_e)).reshape(P, D)
    yb = (yb * slot_w[:, None]).astype(h.dtype)
    out = jnp.zeros((T + 1, D), h.dtype).at[slot_tok].add(yb)[:T]
    return out.reshape(B, S, D)


def setup_inputs(seed: int = 0) -> dict:
    key = jax.random.key(seed)
    ks = jax.random.split(key, 32)
    L, D = DEPTH, D_MODEL
    def nrm(k, shape, scale):
        return jax.random.normal(k, shape, jnp.float32) * scale
    def gain(k, shape):
        return 1.0 + 0.01 * jax.random.normal(k, shape, jnp.float32)
    offsets = jax.random.randint(ks[2], (BATCH, 1), 0, 1024, dtype=jnp.int32)
    return {
        "x": nrm(ks[0], (BATCH, SEQ, D), 1.0),
        "c": nrm(ks[1], (BATCH, D), 1.0),
        "positions": offsets + jnp.arange(SEQ, dtype=jnp.int32)[None, :],
        "ada_w": nrm(ks[3], (L, D, N_MOD * D), D ** -0.5),
        "ada_b": nrm(ks[4], (L, N_MOD * D), 0.02),
        "norm1_g": gain(ks[5], (L, D)),
        "norm2_g": gain(ks[6], (L, D)),
        "w_in": nrm(ks[7], (L, D, D_IN), D ** -0.5),
        "gla_alpha_up": nrm(ks[8], (L, GLA_GATE_RANK, GLA_QK_W), GLA_GATE_RANK ** -0.5),
        "gla_alpha_b": nrm(ks[9], (L, GLA_QK_W), 0.1),
        "gla_out_g": gain(ks[10], (L, GLA_DV)),
        "diff_q_g": gain(ks[11], (L, DIFF_DH)),
        "diff_k_g": gain(ks[12], (L, DIFF_DH)),
        "diff_lq1": nrm(ks[13], (L, DIFF_DH), 0.1),
        "diff_lk1": nrm(ks[14], (L, DIFF_DH), 0.1),
        "diff_lq2": nrm(ks[15], (L, DIFF_DH), 0.1),
        "diff_lk2": nrm(ks[16], (L, DIFF_DH), 0.1),
        "diff_out_g": gain(ks[17], (L, DIFF_DV)),
        "w_branch_a": nrm(ks[18], (L, GLA_V_W, D), GLA_V_W ** -0.5),
        "w_branch_b": nrm(ks[19], (L, DIFF_V_W, D), DIFF_V_W ** -0.5),
        "w_out": nrm(ks[20], (L, D, D), D ** -0.5),
        "router_group_w": nrm(ks[21], (L, D, N_GROUPS), D ** -0.5),
        "router_group_b": nrm(ks[22], (L, N_GROUPS), 0.01),
        "router_expert_w": nrm(ks[23], (L, D, N_EXPERTS), D ** -0.5),
        "router_expert_b": nrm(ks[24], (L, N_EXPERTS), 0.01),
        "expert_w1": nrm(ks[25], (L, N_EXPERTS, D, D_EXPERT), D ** -0.5),
        "expert_w3": nrm(ks[26], (L, N_EXPERTS, D, D_EXPERT), D ** -0.5),
        "expert_w2": nrm(ks[27], (L, N_EXPERTS, D_EXPERT, D), D_EXPERT ** -0.5),
    }


def reference(x, c, positions, ada_w, ada_b, norm1_g, norm2_g, w_in, gla_alpha_up, gla_alpha_b,
              gla_out_g, diff_q_g, diff_k_g, diff_lq1, diff_lk1, diff_lq2, diff_lk2, diff_out_g,
              w_branch_a, w_branch_b, w_out, router_group_w, router_group_b, router_expert_w,
              router_expert_b, expert_w1, expert_w3, expert_w2):
    B, S, D = x.shape
    cos, sin = rope_tables(positions)
    c_act = jax.nn.silu(c)
    split_idx = np.cumsum(IN_SIZES)[:-1].tolist()
    for l in range(DEPTH):
        lambda_init = 0.8 - 0.6 * float(np.exp(-0.3 * l))
        mod = (c_act @ ada_w[l] + ada_b[l]).reshape(B, N_MOD, D)
        shift1, scale1, gate1, shift2, scale2, gate2 = [mod[:, i, None, :] for i in range(N_MOD)]
        h = rms_norm(x, norm1_g[l]) * (1.0 + scale1) + shift1
        u = h @ w_in[l]
        (g_q, g_k, g_v, g_r, g_lr, d_q, d_k, d_v, gate_a, gate_b) = jnp.split(u, split_idx, axis=-1)
        o_a = gla_branch(g_q, g_k, g_v, g_r, g_lr, gla_alpha_up[l], gla_alpha_b[l], gla_out_g[l])
        o_b = diff_branch(d_q, d_k, d_v, cos, sin, diff_q_g[l], diff_k_g[l], diff_lq1[l],
                          diff_lk1[l], diff_lq2[l], diff_lk2[l], diff_out_g[l], lambda_init)
        merged = (jax.nn.sigmoid(gate_a) * (o_a @ w_branch_a[l])
                  + jax.nn.sigmoid(gate_b) * (o_b @ w_branch_b[l]))
        x = x + gate1 * (merged @ w_out[l])
        h2 = rms_norm(x, norm2_g[l]) * (1.0 + scale2) + shift2
        y = hier_moe(h2, router_group_w[l], router_group_b[l], router_expert_w[l],
                     router_expert_b[l], expert_w1[l], expert_w3[l], expert_w2[l])
        x = x + gate2 * y
    return x
```

```cpp
#include <hip/hip_runtime.h>
#include <hip/hip_bf16.h>
#include <cstdio>
#include <cstdint>

#ifndef MK_ONE_LAUNCH
#define MK_ONE_LAUNCH 0
#endif

#define LAS __attribute__((address_space(3)))
#define GAS __attribute__((address_space(1)))
typedef unsigned short bf16_t;
typedef short bf16x8 __attribute__((ext_vector_type(8)));
typedef float f32x4 __attribute__((ext_vector_type(4)));
typedef float f32x2 __attribute__((ext_vector_type(2)));
typedef unsigned u32x4 __attribute__((ext_vector_type(4)));
typedef unsigned u32x2 __attribute__((ext_vector_type(2)));

constexpr int NB = 4, SEQ = 4096, D = 1024, M = NB * SEQ;
constexpr int DIN = 5136, NPROJ = 5120;
constexpr int NEXP = 32, DEXP = 512;
constexpr int PMAX = 40960;
constexpr int NMOD = 6 * D;

constexpr size_t MiB = 1u << 20;
constexpr size_t WS_CTL = 0, CTL_ZERO_BYTES = 1 * MiB;
constexpr size_t WS_MODP = 1 * MiB;
constexpr size_t WS_MODF = 4 * MiB;
constexpr size_t WS_ALR = 5 * MiB;
constexpr size_t WS_ROUTE = 6 * MiB;
constexpr size_t WS_WIN = 8 * MiB;
constexpr size_t WS_WA = 18 * MiB, WS_WB = 19 * MiB, WS_WOUT = 20 * MiB;
constexpr size_t RA = 22 * MiB;
constexpr size_t RB = 118 * MiB;
constexpr size_t WS_END = 278 * MiB;
constexpr size_t WS_XN = RA;
constexpr size_t WS_LOGA = RA;
constexpr size_t WS_OGLA = RA + 16 * MiB;
constexpr size_t WS_OB = RA + 48 * MiB;
constexpr size_t WS_OA = RA + 64 * MiB;
constexpr size_t WS_XS = RA;
constexpr size_t WS_Y = RA;
constexpr size_t WS_UGLA = RB;
constexpr size_t WS_UDIFF = RB + 48 * MiB;
constexpr size_t WS_UGATE = RB + 96 * MiB;
constexpr size_t WS_M1 = RB + 48 * MiB;
constexpr size_t WS_MERGED = RB;
constexpr size_t WS_H2 = RB;
constexpr size_t WS_W13 = RB + 64 * MiB;
constexpr size_t WS_W2 = RB + 128 * MiB;
constexpr size_t WS_HMID = RB;
constexpr size_t RT_TOKE = 0, RT_TOKW = 131072, RT_RANK = 262144, RT_SLOT = 393216, RT_BLKCNT = 524288, RT_TILEE = 557056, RT_NT = 561152;
constexpr int CW_BAR = 4096;

constexpr int RING_BYTES = 131072;
constexpr int LDSCTL_OFF = RING_BYTES, MISC_OFF = LDSCTL_OFF + 320;
constexpr int LDS_BYTES = 147456;
constexpr int NWAVES = 8, NTHR = 512;

__device__ __forceinline__ float bf2f(bf16_t h) { return __uint_as_float((unsigned)h << 16); }
__device__ __forceinline__ unsigned f2bf(float f) { unsigned u = __float_as_uint(f); return (u + 0x7fffu + ((u >> 16) & 1u)) >> 16; }
__device__ __forceinline__ unsigned pk2(float lo, float hi) { return f2bf(lo) | (f2bf(hi) << 16); }
__device__ __forceinline__ float lo_bf(unsigned w) { return __uint_as_float(w << 16); }
__device__ __forceinline__ float hi_bf(unsigned w) { return __uint_as_float(w & 0xffff0000u); }
__device__ __forceinline__ float wave_sum(float v) {
#pragma unroll
    for (int o = 1; o < 64; o <<= 1) v += __shfl_xor(v, o);
    return v;
}
__device__ __forceinline__ float wave_max(float v) {
#pragma unroll
    for (int o = 1; o < 64; o <<= 1) v = fmaxf(v, __shfl_xor(v, o));
    return v;
}
__device__ __forceinline__ float sigmoidf_(float x) { return 1.0f / (1.0f + __expf(-x)); }
__device__ __forceinline__ float siluf_(float x) { return x / (1.0f + __expf(-x)); }
#define LDS_WAIT() asm volatile("s_waitcnt lgkmcnt(0)" ::: "memory")
#define VM_WAIT() asm volatile("s_waitcnt vmcnt(0)" ::: "memory")

namespace pg8 {
constexpr int BM = 256, BK = 64, HALF = 128, HTB = HALF * BK * 2, STAGE_BYTES = 8 * HTB, NXCD = 8, WGM = 8;
__host__ __device__ __forceinline__ int lds_byte(int r, int c) { const int st = (r >> 4) * 2 + (c >> 5), rr = r & 15, cc = c & 31, ob = rr * 64 + cc * 2; return st * 1024 + (ob ^ (((ob >> 9) & 1) << 5)); }
__host__ __device__ __forceinline__ void stage_rc(int b, int& R, int& C) { const int st = b / 1024, sb = b % 1024, swz = sb ^ (((sb >> 9) & 1) << 5); R = (st >> 1) * 16 + swz / 64; C = (st & 1) * 32 + (swz % 64) / 2; }
__host__ __device__ __forceinline__ int perm32(int rho) { const int n = rho >> 4, i = rho & 15; return 8 * (i >> 2) + 4 * n + (i & 3); }

struct Unit { int pm, pn, aux; };

__device__ __forceinline__ int xcd_swizzle(int wgid, int nwg) { const int q = nwg / NXCD, r = nwg % NXCD, xcd = wgid % NXCD, off = wgid / NXCD; return (xcd < r ? xcd * (q + 1) : r * (q + 1) + (xcd - r) * q) + off; }

struct DenseOrder {
    const char* A; const char* Bt; size_t tstep; int nM, nN, nwg, G, c;
    __device__ __forceinline__ void init(const void* A_, const void* Bt_, int M_, int N_, int K_, int G_, int c_) { A = (const char*)A_; Bt = (const char*)Bt_; tstep = (size_t)BM * K_ * 2; nM = M_ / BM; nN = N_ / BM; nwg = nM * nN; G = G_; c = c_; }
    __device__ __forceinline__ bool next(int i, Unit& u) const {
        const long L = (long)i * G + c; if (L >= nwg) return false;
        const int wgid = xcd_swizzle((int)L, nwg);
        const int nig = WGM * nN, gid = wgid / nig, fm = gid * WGM, gsz = (nM - fm) < WGM ? (nM - fm) : WGM;
        u.pm = fm + ((wgid % nig) % gsz); u.pn = (wgid % nig) / gsz; u.aux = 0; return true;
    }
    __device__ __forceinline__ const char* a_ptr(const Unit& u) const { return A + (size_t)u.pm * tstep; }
    __device__ __forceinline__ const char* b_ptr(const Unit& u) const { return Bt + (size_t)u.pn * tstep; }
};
struct MoeOrder {
    const char* A; const char* W; const int* tile_e; size_t tstep, estride; int nwg, G, c;
    __device__ __forceinline__ void init(const void* A_, const void* W_, const int* te, int ntm, int K_, size_t estride_, int G_, int c_) { A = (const char*)A_; W = (const char*)W_; tile_e = te; tstep = (size_t)BM * K_ * 2; estride = estride_; nwg = ntm * 4; G = G_; c = c_; }
    __device__ __forceinline__ bool next(int i, Unit& u) const {
        const long L = (long)i * G + c; if (L >= nwg) return false;
        const int wgid = xcd_swizzle((int)L, nwg);
        u.pm = wgid >> 2; u.pn = wgid & 3; u.aux = __builtin_amdgcn_readfirstlane(tile_e[u.pm]); return true;
    }
    __device__ __forceinline__ const char* a_ptr(const Unit& u) const { return A + (size_t)u.pm * tstep; }
    __device__ __forceinline__ const char* b_ptr(const Unit& u) const { return W + (size_t)u.aux * estride + (size_t)u.pn * tstep; }
};

__device__ __forceinline__ u32x4 pack8(const f32x4& v0, const f32x4& v1) { u32x4 w; w.x = pk2(v0[0], v0[1]); w.y = pk2(v0[2], v0[3]); w.z = pk2(v1[0], v1[1]); w.w = pk2(v1[2], v1[3]); return w; }

struct EpiInProj {
    static constexpr bool PERM = true, AFTER_DRAIN = false;
    bf16_t *Ugla, *Udiff, *Ugate;
    __device__ __forceinline__ void operator()(const f32x4 (&acc)[2][2][4][2], const Unit& u, int wr, int wc, int fr, int fq) const {
        bf16_t* base; int ldc, colt;
        if (u.pn < 6) { base = Ugla; ldc = 1536; colt = u.pn * 256; } else if (u.pn < 12) { base = Udiff; ldc = 1536; colt = (u.pn - 6) * 256; } else { base = Ugate; ldc = 2048; colt = (u.pn - 12) * 256; }
        const int row0 = u.pm * BM + wr * 64 + fr, col0 = colt + wc * 32 + 8 * fq;
#pragma unroll
        for (int ai = 0; ai < 2; ++ai)
#pragma unroll
            for (int m = 0; m < 4; ++m) { bf16_t* rowp = base + (size_t)(row0 + ai * HALF + m * 16) * ldc + col0;
#pragma unroll
                for (int bj = 0; bj < 2; ++bj) *(u32x4*)(rowp + bj * HALF) = pack8(acc[ai][bj][m][0], acc[ai][bj][m][1]); }
    }
};
struct EpiPlain {
    static constexpr bool PERM = true, AFTER_DRAIN = false;
    bf16_t* O; int ldc;
    __device__ __forceinline__ void operator()(const f32x4 (&acc)[2][2][4][2], const Unit& u, int wr, int wc, int fr, int fq) const {
        const int row0 = u.pm * BM + wr * 64 + fr, col0 = u.pn * BM + wc * 32 + 8 * fq;
#pragma unroll
        for (int ai = 0; ai < 2; ++ai)
#pragma unroll
            for (int m = 0; m < 4; ++m) { bf16_t* rowp = O + (size_t)(row0 + ai * HALF + m * 16) * ldc + col0;
#pragma unroll
                for (int bj = 0; bj < 2; ++bj) *(u32x4*)(rowp + bj * HALF) = pack8(acc[ai][bj][m][0], acc[ai][bj][m][1]); }
    }
};
struct EpiBranch {
    static constexpr bool PERM = true, AFTER_DRAIN = false;
    const bf16_t* gate; int gcol0; const bf16_t* m1in; bf16_t* out;
    __device__ __forceinline__ void operator()(const f32x4 (&acc)[2][2][4][2], const Unit& u, int wr, int wc, int fr, int fq) const {
        const int row0 = u.pm * BM + wr * 64 + fr, col0 = u.pn * BM + wc * 32 + 8 * fq;
#pragma unroll
        for (int ai = 0; ai < 2; ++ai)
#pragma unroll
            for (int m = 0; m < 4; ++m) { const size_t r = (size_t)(row0 + ai * HALF + m * 16);
#pragma unroll
                for (int bj = 0; bj < 2; ++bj) { const int c = col0 + bj * HALF;
                    const u32x4 g = *(const u32x4*)(gate + r * 2048 + gcol0 + c);
                    f32x4 v0 = acc[ai][bj][m][0], v1 = acc[ai][bj][m][1];
                    v0[0] *= sigmoidf_(lo_bf(g.x)); v0[1] *= sigmoidf_(hi_bf(g.x)); v0[2] *= sigmoidf_(lo_bf(g.y)); v0[3] *= sigmoidf_(hi_bf(g.y));
                    v1[0] *= sigmoidf_(lo_bf(g.z)); v1[1] *= sigmoidf_(hi_bf(g.z)); v1[2] *= sigmoidf_(lo_bf(g.w)); v1[3] *= sigmoidf_(hi_bf(g.w));
                    if (m1in) { const u32x4 p = *(const u32x4*)(m1in + r * 1024 + c);
                        v0[0] += lo_bf(p.x); v0[1] += hi_bf(p.x); v0[2] += lo_bf(p.y); v0[3] += hi_bf(p.y); v1[0] += lo_bf(p.z); v1[1] += hi_bf(p.z); v1[2] += lo_bf(p.w); v1[3] += hi_bf(p.w); }
                    *(u32x4*)(out + r * 1024 + c) = pack8(v0, v1); } }
    }
};
struct EpiWout {
    static constexpr bool PERM = false, AFTER_DRAIN = false;
    const float* x; const float* modf; float* out;
    __device__ __forceinline__ void operator()(const f32x4 (&acc)[2][2][4][2], const Unit& u, int wr, int wc, int fr, int fq) const {
        const int row0 = u.pm * BM + wr * 64 + fr, col0 = u.pn * BM + wc * 32 + 4 * fq;
        const float* g1 = modf + (size_t)((u.pm * BM) >> 12) * NMOD + 2 * D;
#pragma unroll
        for (int bj = 0; bj < 2; ++bj)
#pragma unroll
            for (int n = 0; n < 2; ++n) { const int c = col0 + bj * HALF + n * 16; const f32x4 gv = *(const f32x4*)(g1 + c);
#pragma unroll
                for (int ai = 0; ai < 2; ++ai)
#pragma unroll
                    for (int m = 0; m < 4; ++m) { const size_t off = (size_t)(row0 + ai * HALF + m * 16) * D + c;
                        const f32x4 xv = *(const f32x4*)(x + off); *(f32x4*)(out + off) = xv + gv * acc[ai][bj][m][n]; } }
    }
};
struct EpiUp {
    static constexpr bool PERM = true, AFTER_DRAIN = false;
    bf16_t* H;
    __device__ __forceinline__ void operator()(const f32x4 (&acc)[2][2][4][2], const Unit& u, int wr, int wc, int fr, int fq) const {
        const int row0 = u.pm * BM + wr * 64 + fr, col0 = u.pn * HALF + wc * 32 + 8 * fq;
#pragma unroll
        for (int ai = 0; ai < 2; ++ai)
#pragma unroll
            for (int m = 0; m < 4; ++m) { f32x4 v0, v1;
#pragma unroll
                for (int e = 0; e < 4; ++e) { v0[e] = siluf_(acc[ai][0][m][0][e]) * acc[ai][1][m][0][e]; v1[e] = siluf_(acc[ai][0][m][1][e]) * acc[ai][1][m][1][e]; }
                *(u32x4*)(H + (size_t)(row0 + ai * HALF + m * 16) * DEXP + col0) = pack8(v0, v1); }
    }
};

template <class Epi, class Sched, bool ALIGN_EPI = false, bool SP2 = false>
__device__ __forceinline__ void gemm_phase(LAS unsigned char* lds, const int K, const Sched& S, const Epi& E) {
    const int tid = threadIdx.x, wid = __builtin_amdgcn_readfirstlane(tid >> 6), lane = tid & 63, wr = wid >> 2, wc = wid & 3, fr = lane & 15, fq = lane >> 4;
    const int nt = K / BK;
    unsigned voffA[2], voffB[2];
#pragma unroll
    for (int i = 0; i < 2; ++i) { int R, C; stage_rc(tid * 16 + i * 8192, R, C); const int Rb = Epi::PERM ? ((R & ~31) + perm32(R & 31)) : R;
        voffA[i] = (unsigned)(R * K + C) * 2u; voffB[i] = (unsigned)(Rb * K + C) * 2u; }
    const size_t kstep = (size_t)(BK * 2);
    const size_t hstep = (size_t)HALF * K * 2;
    const unsigned ldsw = (unsigned)wid * 1024u;
    const int aoff = lds_byte(wr * 64 + fr, fq * 8), boff = lds_byte(wc * 32 + fr, fq * 8);
#define PG8_SA(b, h) (((b) * 2 + (h)) * HTB)
#define PG8_SB(b, h) ((4 + (b) * 2 + (h)) * HTB)
#define PG8_STAGE(bufoff, gbase, voff) do { _Pragma("unroll") for (int _i = 0; _i < 2; ++_i) \
        __builtin_amdgcn_global_load_lds((const unsigned*)((const char*)(gbase) + (voff)[_i]), (LAS unsigned*)(lds + (bufoff) + ldsw + _i * 8192), 16, 0, 0); } while (0)
#define PG8_LDA(dst, b, h) do { _Pragma("unroll") for (int m = 0; m < 4; ++m) _Pragma("unroll") for (int k = 0; k < 2; ++k) dst[m][k] = *(const LAS bf16x8*)(lds + PG8_SA(b, h) + aoff + m * 2048 + k * 1024); } while (0)
#define PG8_LDB(dst, b, h) do { _Pragma("unroll") for (int n = 0; n < 2; ++n) _Pragma("unroll") for (int k = 0; k < 2; ++k) dst[n][k] = *(const LAS bf16x8*)(lds + PG8_SB(b, h) + boff + n * 2048 + k * 1024); } while (0)
#define PG8_MMA(ai, bj, At, Bt) do { __builtin_amdgcn_s_setprio(1); _Pragma("unroll") for (int m = 0; m < 4; ++m) _Pragma("unroll") for (int n = 0; n < 2; ++n) _Pragma("unroll") for (int k = 0; k < 2; ++k) \
        acc[ai][bj][m][n] = __builtin_amdgcn_mfma_f32_16x16x32_bf16(Bt[n][k], At[m][k], acc[ai][bj][m][n], 0, 0, 0); __builtin_amdgcn_s_setprio(0); } while (0)
#define PG8_WAIT_V(n) asm volatile("s_waitcnt vmcnt(" #n ")" ::: "memory")
#define PG8_WAIT_L(n) asm volatile("s_waitcnt lgkmcnt(" #n ")" ::: "memory")
#define PG8_BAR __builtin_amdgcn_s_barrier()
#define PG8_SCHED __builtin_amdgcn_sched_barrier(0)
    Unit cur, nxt; int ui = 0;
    if (!S.next(0, cur)) return;
    f32x4 acc[2][2][4][2];
#pragma unroll
    for (int a = 0; a < 2; ++a)
#pragma unroll
        for (int b = 0; b < 2; ++b)
#pragma unroll
            for (int m = 0; m < 4; ++m)
#pragma unroll
                for (int n = 0; n < 2; ++n) acc[a][b][m][n] = (f32x4){0.f, 0.f, 0.f, 0.f};
    bf16x8 At[4][2], B0[2][2], B1[2][2];
    const char* cA = S.a_ptr(cur); const char* cB = S.b_ptr(cur);
    if constexpr (SP2) {
        PG8_STAGE(PG8_SB(0, 0), cB, voffB); PG8_STAGE(PG8_SB(0, 1), cB + hstep, voffB); PG8_STAGE(PG8_SA(0, 0), cA, voffA); PG8_STAGE(PG8_SA(0, 1), cA + hstep, voffA);
        if (wr == 1) PG8_BAR;
        PG8_WAIT_V(2); PG8_BAR;
        PG8_STAGE(PG8_SB(1, 0), cB + kstep, voffB); PG8_STAGE(PG8_SA(1, 0), cA + kstep, voffA); PG8_STAGE(PG8_SB(1, 1), cB + hstep + kstep, voffB);
        PG8_WAIT_V(6); PG8_BAR;
    } else {
        PG8_STAGE(PG8_SB(0, 0), cB, voffB); PG8_STAGE(PG8_SA(0, 0), cA, voffA); PG8_STAGE(PG8_SB(0, 1), cB + hstep, voffB); PG8_STAGE(PG8_SA(0, 1), cA + hstep, voffA);
        if (wr == 1) PG8_BAR;
        PG8_WAIT_V(4); PG8_BAR;
        PG8_STAGE(PG8_SB(1, 0), cB + kstep, voffB); PG8_STAGE(PG8_SA(1, 0), cA + kstep, voffA); PG8_STAGE(PG8_SB(1, 1), cB + hstep + kstep, voffB);
        PG8_WAIT_V(6); PG8_BAR;
    }
    for (;;) {
        const bool has_next = S.next(ui + 1, nxt);
        const char* nA = has_next ? S.a_ptr(nxt) : cA; const char* nB = has_next ? S.b_ptr(nxt) : cB;
        for (int t = 0; t < nt; t += 2) {
            const bool last = (t == nt - 2);
            const char* a1 = cA + (size_t)(t + 1) * kstep;
            const char* a2 = last ? nA : cA + (size_t)(t + 2) * kstep; const char* b2 = last ? nB : cB + (size_t)(t + 2) * kstep;
            const char* a3 = a2 + kstep; const char* b3 = b2 + kstep;
            if constexpr (SP2) {
            PG8_LDB(B0, 0, 0); PG8_LDB(B1, 0, 1); PG8_SCHED; PG8_LDA(At, 0, 0); PG8_STAGE(PG8_SA(1, 1), a1 + hstep, voffA);
            PG8_WAIT_V(8); PG8_WAIT_L(0); PG8_BAR; PG8_MMA(0, 0, At, B0); PG8_MMA(0, 1, At, B1); PG8_BAR; PG8_SCHED;
            PG8_LDA(At, 0, 1); PG8_STAGE(PG8_SB(0, 0), b2, voffB); PG8_STAGE(PG8_SB(0, 1), b2 + hstep, voffB); PG8_STAGE(PG8_SA(0, 0), a2, voffA);
            PG8_WAIT_V(8); PG8_WAIT_L(0); PG8_BAR; PG8_MMA(1, 0, At, B0); PG8_MMA(1, 1, At, B1); PG8_BAR; PG8_SCHED;
            PG8_LDB(B0, 1, 0); PG8_LDB(B1, 1, 1); PG8_SCHED; PG8_LDA(At, 1, 0); PG8_STAGE(PG8_SA(0, 1), a2 + hstep, voffA);
            PG8_WAIT_V(8); PG8_WAIT_L(0); PG8_BAR; PG8_MMA(0, 0, At, B0); PG8_MMA(0, 1, At, B1); PG8_BAR; PG8_SCHED;
            PG8_LDA(At, 1, 1); PG8_STAGE(PG8_SB(1, 0), b3, voffB); PG8_STAGE(PG8_SB(1, 1), b3 + hstep, voffB); PG8_STAGE(PG8_SA(1, 0), a3, voffA);
            PG8_WAIT_V(8); PG8_WAIT_L(0); PG8_BAR; PG8_MMA(1, 0, At, B0); PG8_MMA(1, 1, At, B1); PG8_BAR; PG8_SCHED;
            } else {
            PG8_LDB(B0, 0, 0); PG8_SCHED; PG8_LDA(At, 0, 0); PG8_STAGE(PG8_SA(1, 1), a1 + hstep, voffA);
            PG8_WAIT_L(8); PG8_BAR; PG8_WAIT_L(0); PG8_MMA(0, 0, At, B0); PG8_BAR; PG8_SCHED;
            PG8_LDB(B1, 0, 1); PG8_STAGE(PG8_SB(0, 0), b2, voffB);
            PG8_BAR; PG8_WAIT_L(0); PG8_MMA(0, 1, At, B1); PG8_BAR;
            PG8_LDA(At, 0, 1); PG8_STAGE(PG8_SA(0, 0), a2, voffA);
            PG8_BAR; PG8_WAIT_L(0); PG8_MMA(1, 0, At, B0); PG8_BAR; PG8_SCHED;
            PG8_STAGE(PG8_SB(0, 1), b2 + hstep, voffB);
            PG8_WAIT_V(6); PG8_BAR; PG8_MMA(1, 1, At, B1); PG8_BAR;
            PG8_LDB(B0, 1, 0); PG8_SCHED; PG8_LDA(At, 1, 0); PG8_STAGE(PG8_SA(0, 1), a2 + hstep, voffA);
            PG8_WAIT_L(8); PG8_BAR; PG8_WAIT_L(0); PG8_MMA(0, 0, At, B0); PG8_BAR; PG8_SCHED;
            PG8_LDB(B1, 1, 1); PG8_STAGE(PG8_SB(1, 0), b3, voffB);
            PG8_BAR; PG8_WAIT_L(0); PG8_MMA(0, 1, At, B1); PG8_BAR;
            PG8_LDA(At, 1, 1); PG8_STAGE(PG8_SA(1, 0), a3, voffA);
            PG8_BAR; PG8_WAIT_L(0); PG8_MMA(1, 0, At, B0); PG8_BAR; PG8_SCHED;
            PG8_STAGE(PG8_SB(1, 1), b3 + hstep, voffB);
            PG8_WAIT_V(6); PG8_BAR; PG8_MMA(1, 1, At, B1); PG8_BAR;
            }
        }
        if constexpr (ALIGN_EPI) { if (wr == 0) PG8_BAR; }
        E(acc, cur, wr, wc, fr, fq);
        if (!has_next) break;
#pragma unroll
        for (int a = 0; a < 2; ++a)
#pragma unroll
            for (int b = 0; b < 2; ++b)
#pragma unroll
                for (int m = 0; m < 4; ++m)
#pragma unroll
                    for (int n = 0; n < 2; ++n) acc[a][b][m][n] = (f32x4){0.f, 0.f, 0.f, 0.f};
        cur = nxt; cA = nA; cB = nB; ++ui;
        if constexpr (ALIGN_EPI) { if (wr == 1) PG8_BAR; }
    }
    PG8_WAIT_V(0);
    if constexpr (!ALIGN_EPI) { if (wr == 0) PG8_BAR; }
    PG8_BAR;
#undef PG8_SA
#undef PG8_SB
#undef PG8_STAGE
#undef PG8_LDA
#undef PG8_LDB
#undef PG8_MMA
#undef PG8_WAIT_V
#undef PG8_WAIT_L
#undef PG8_BAR
#undef PG8_SCHED
}
}

#define XB_TMO      128
#define XB_XCNT(j)  (256  + 64 * (j))
#define XB_XSUB(j)  (1280 + 64 * (j))
#define XB_XGEN(j)  (2304 + 64 * (j))
#define XB_TOP      3328
#define XB_TOPGEN   3392
#define XCD_BAR_WORDS 3456
#define XB_SPIN_CAP (1u << 18)
__device__ __forceinline__ unsigned xb_ld(unsigned* p)              { return __hip_atomic_load(p, __ATOMIC_RELAXED, __HIP_MEMORY_SCOPE_AGENT); }
__device__ __forceinline__ unsigned xb_add(unsigned* p, unsigned v) { return __hip_atomic_fetch_add(p, v, __ATOMIC_RELAXED, __HIP_MEMORY_SCOPE_AGENT); }
__device__ __forceinline__ unsigned xb_xcc_id() { return (unsigned)__builtin_amdgcn_s_getreg((3 << 11) | 20) & 0xFu; }
#define XB_SPIN(cond, bar) do { unsigned _sp = 0; while (cond) { __builtin_amdgcn_s_sleep(1); \
    if ((++_sp & 255u) == 0u) { if (xb_ld(&(bar)[XB_TMO])) break; if (_sp > XB_SPIN_CAP) { atomicAdd(&(bar)[XB_TMO], 1u); break; } } } } while (0)
struct XcdBarrier { unsigned* bar; unsigned x; volatile LAS unsigned* st; };
__device__ __forceinline__ XcdBarrier xcd_barrier_post(unsigned* bar, volatile LAS unsigned* st) {
    XcdBarrier b; b.bar = bar; b.x = xb_xcc_id(); b.st = st;
    if (threadIdx.x == 0) (void)xb_add(&bar[XB_XCNT(b.x)], 1u);
    return b;
}
__device__ __forceinline__ void xcd_barrier_complete(unsigned* bar, unsigned x, unsigned& nloc, unsigned& nx) {
    const unsigned G = gridDim.x * gridDim.y * gridDim.z;
    unsigned sum, cnt, mine, sp = 0u;
    for (;;) {
        sum = 0u; cnt = 0u; mine = 0u;
#pragma unroll
        for (unsigned j = 0; j < 16; ++j) { const unsigned c = xb_ld(&bar[XB_XCNT(j)]); sum += c; cnt += (c > 0u) ? 1u : 0u; mine = (j == x) ? c : mine; }
        if (sum == G) break;
        __builtin_amdgcn_s_sleep(1);
        if ((++sp & 255u) == 0u) { if (xb_ld(&bar[XB_TMO])) break; if (sp > XB_SPIN_CAP) { atomicAdd(&bar[XB_TMO], 1u); break; } }
    }
    nloc = mine > 0u ? mine : 1u; nx = cnt > 0u ? cnt : 1u;
}
__device__ __forceinline__ void xcd_barrier(const XcdBarrier& b) {
    asm volatile("s_waitcnt vmcnt(0)" ::: "memory");
    __syncthreads();
    if (threadIdx.x == 0) {
        unsigned* bar = b.bar;
        __builtin_amdgcn_s_waitcnt(0);
        unsigned nloc = b.st[0], nx = b.st[1];
        if (nloc == 0u) { xcd_barrier_complete(bar, b.x, nloc, nx); b.st[0] = nloc; b.st[1] = nx; }
        const unsigned old = xb_add(&bar[XB_XSUB(b.x)], 1u);
        const unsigned gen = old / nloc;
        if (old + 1u == (gen + 1u) * nloc) {
            __builtin_amdgcn_fence(__ATOMIC_RELEASE, "agent");
            asm volatile("s_waitcnt vmcnt(0)" ::: "memory");
            const unsigned og = xb_add(&bar[XB_TOP], 1u);
            const unsigned tg = og / nx;
            if (og + 1u == (tg + 1u) * nx) xb_add(&bar[XB_TOPGEN], 1u);
            else XB_SPIN(xb_ld(&bar[XB_TOPGEN]) == tg, bar);
            __builtin_amdgcn_fence(__ATOMIC_ACQUIRE, "agent");
            xb_add(&bar[XB_XGEN(b.x)], 1u);
            asm volatile("s_waitcnt vmcnt(0)" ::: "memory");
        } else {
            XB_SPIN(xb_ld(&bar[XB_XGEN(b.x)]) == gen, bar);
            __builtin_amdgcn_fence(__ATOMIC_ACQUIRE, "agent");
            asm volatile("s_waitcnt vmcnt(0)" ::: "memory");
        }
    }
    __syncthreads();
}

struct Args { const void* in[28]; float* out; unsigned char* ws; int ph_lo, ph_hi; };
enum { I_X = 0, I_C, I_POS, I_ADAW, I_ADAB, I_N1G, I_N2G, I_WIN, I_AUP, I_AB, I_GOG, I_DQG, I_DKG, I_LQ1, I_LK1, I_LQ2, I_LK2, I_DOG, I_WBA, I_WBB, I_WOUT, I_RGW, I_RGB, I_REW, I_REB, I_EW1, I_EW3, I_EW2 };

__device__ __forceinline__ void tr_item(const float* W, int ldn, int k0, int nsrc0, bf16_t* WT, int Kdst, int drow0, LAS float* scr, int lane) {
#pragma unroll 8
    for (int i = 0; i < 32; ++i) { const int kk = 2 * i + (lane >> 5); scr[kk * 33 + (lane & 31)] = W[(size_t)(k0 + kk) * ldn + nsrc0 + (lane & 31)]; }
    LDS_WAIT(); asm volatile("" ::: "memory");
    const int c = lane & 7;
#pragma unroll
    for (int j = 0; j < 4; ++j) { const int n = (lane >> 3) + 8 * j; const LAS float* s = scr + (8 * c) * 33 + n;
        u32x4 o; o.x = pk2(s[0 * 33], s[1 * 33]); o.y = pk2(s[2 * 33], s[3 * 33]); o.z = pk2(s[4 * 33], s[5 * 33]); o.w = pk2(s[6 * 33], s[7 * 33]);
        *(u32x4*)(WT + (size_t)(drow0 + n) * Kdst + k0 + 8 * c) = o; }
    LDS_WAIT(); asm volatile("" ::: "memory");
}

template <int LO, int HI>
__global__ void __launch_bounds__(NTHR, 2) mk_fwd(Args args) {
    extern __shared__ __attribute__((aligned(16))) unsigned char lds_raw[];
    LAS unsigned char* lds = (LAS unsigned char*)lds_raw;
    volatile LAS unsigned* MISC = (volatile LAS unsigned*)(lds + MISC_OFF);
    const int tid = threadIdx.x, lane = tid & 63, wave = __builtin_amdgcn_readfirstlane(tid >> 6);
    const int G = gridDim.x, cb = blockIdx.x;
    const int gw = cb * NWAVES + wave, NGW = G * NWAVES;
    unsigned char* ws = args.ws;
    unsigned* ctl = (unsigned*)(ws + WS_CTL);
    for (int u = tid; u < (LDS_BYTES - LDSCTL_OFF) / 4; u += NTHR) ((LAS unsigned*)(lds + LDSCTL_OFF))[u] = 0u;
    __syncthreads();
    constexpr int lo = LO, hi = HI;
    XcdBarrier bar; bar.bar = ctl + CW_BAR; bar.x = 0; bar.st = nullptr;
    if constexpr (hi - lo > 1) bar = xcd_barrier_post(ctl + CW_BAR, MISC + 8);
#define IN(k) (lo <= (k) && (k) < hi)
#define SEAM(k) do { if constexpr (IN(k) && IN((k) + 1)) xcd_barrier(bar); } while (0)

    const float* x = (const float*)args.in[I_X];
    float* out = args.out;
    float* modp = (float*)(ws + WS_MODP); float* modf = (float*)(ws + WS_MODF); float* alr = (float*)(ws + WS_ALR);
    bf16_t* Win_t = (bf16_t*)(ws + WS_WIN); bf16_t* Wa_t = (bf16_t*)(ws + WS_WA); bf16_t* Wb_t = (bf16_t*)(ws + WS_WB); bf16_t* Wout_t = (bf16_t*)(ws + WS_WOUT);
    bf16_t* XN = (bf16_t*)(ws + WS_XN); float* LOGA = (float*)(ws + WS_LOGA); float* OGLA = (float*)(ws + WS_OGLA);
    bf16_t* OB = (bf16_t*)(ws + WS_OB); bf16_t* OA = (bf16_t*)(ws + WS_OA); bf16_t* XS = (bf16_t*)(ws + WS_XS); bf16_t* Y = (bf16_t*)(ws + WS_Y);
    bf16_t* Ugla = (bf16_t*)(ws + WS_UGLA); bf16_t* Udiff = (bf16_t*)(ws + WS_UDIFF); bf16_t* Ugate = (bf16_t*)(ws + WS_UGATE);
    bf16_t* M1 = (bf16_t*)(ws + WS_M1); bf16_t* MERGED = (bf16_t*)(ws + WS_MERGED); bf16_t* H2 = (bf16_t*)(ws + WS_H2);
    bf16_t* W13_t = (bf16_t*)(ws + WS_W13); bf16_t* W2_t = (bf16_t*)(ws + WS_W2); bf16_t* HMID = (bf16_t*)(ws + WS_HMID);
    int* tok_e = (int*)(ws + WS_ROUTE + RT_TOKE); float* tok_w = (float*)(ws + WS_ROUTE + RT_TOKW); int* tok_rank = (int*)(ws + WS_ROUTE + RT_RANK);
    int* tok_slot = (int*)(ws + WS_ROUTE + RT_SLOT); int* blkcnt = (int*)(ws + WS_ROUTE + RT_BLKCNT); int* tile_e = (int*)(ws + WS_ROUTE + RT_TILEE); int* ntiles_p = (int*)(ws + WS_ROUTE + RT_NT);

    if constexpr (IN(0)) {
        const float* cvec = (const float*)args.in[I_C]; const float* ada_w = (const float*)args.in[I_ADAW];
        const float* w_in = (const float*)args.in[I_WIN];
        LAS float* scr = (LAS float*)(lds + wave * 16384);
        constexpr int I_MOD = 768, I_WIN_ = 16 * 160, I_WAB = 8 * 32, I_WO = 16 * 32;
        constexpr int NITEMS = I_MOD + I_WIN_ + 2 * I_WAB + I_WO;
        for (int it = gw; it < NITEMS; it += NGW) {
            int r = it;
            if (r < I_MOD) {
                const int jc = r % 24, kc = r / 24, j = jc * 256 + lane * 4;
                f32x4 a0 = {0, 0, 0, 0}, a1 = a0, a2 = a0, a3 = a0;
                for (int kk = 0; kk < 32; ++kk) { const int k = kc * 32 + kk; const f32x4 w = *(const f32x4*)(ada_w + (size_t)k * NMOD + j);
                    a0 += siluf_(cvec[k]) * w; a1 += siluf_(cvec[D + k]) * w; a2 += siluf_(cvec[2 * D + k]) * w; a3 += siluf_(cvec[3 * D + k]) * w; }
                *(f32x4*)(modp + (size_t)(kc * 4 + 0) * NMOD + j) = a0; *(f32x4*)(modp + (size_t)(kc * 4 + 1) * NMOD + j) = a1;
                *(f32x4*)(modp + (size_t)(kc * 4 + 2) * NMOD + j) = a2; *(f32x4*)(modp + (size_t)(kc * 4 + 3) * NMOD + j) = a3;
                continue; }
            r -= I_MOD;
            if (r < I_WIN_) { const int kb = r / 160, nb = r % 160, n0 = 32 * nb; tr_item(w_in, DIN, 64 * kb, n0 < 1536 ? n0 : n0 + 16, Win_t, D, n0, scr, lane); continue; }
            r -= I_WIN_;
            if (r < I_WAB) { const int kb = r / 32, nb = r % 32; tr_item((const float*)args.in[I_WBA], D, 64 * kb, 32 * nb, Wa_t, 512, 32 * nb, scr, lane); continue; }
            r -= I_WAB;
            if (r < I_WAB) { const int kb = r / 32, nb = r % 32; tr_item((const float*)args.in[I_WBB], D, 64 * kb, 32 * nb, Wb_t, 512, 32 * nb, scr, lane); continue; }
            r -= I_WAB;
            { const int kb = r / 32, nb = r % 32; tr_item((const float*)args.in[I_WOUT], D, 64 * kb, 32 * nb, Wout_t, D, 32 * nb, scr, lane); }
        }
    }
    SEAM(0);

    if constexpr (IN(1)) {
        const float* ada_b = (const float*)args.in[I_ADAB]; const float* g1 = (const float*)args.in[I_N1G]; const float* w_in = (const float*)args.in[I_WIN];
        LAS float* modS = (LAS float*)lds;
        LAS float* lrT = (LAS float*)(lds + 8192);
        const int b = cb >> 6;
        { const int j = tid * 4; f32x4 s = *(const f32x4*)(ada_b + j);
            for (int kc = 0; kc < 32; ++kc) s += *(const f32x4*)(modp + (size_t)(kc * 4 + b) * NMOD + j);
            if (j >= D) s += 1.0f;
            *(LAS f32x4*)(modS + j) = s; }
        if (tid < 96) { const int idx = cb * 96 + tid, bb = idx / NMOD, j = idx % NMOD; float s = ada_b[j];
            for (int kc = 0; kc < 32; ++kc) s += modp[(size_t)(kc * 4 + bb) * NMOD + j];
            modf[idx] = s; }
        for (int idx = tid; idx < 16384; idx += NTHR) { const int k = idx >> 4, r = idx & 15; lrT[r * 1024 + k] = w_in[(size_t)k * DIN + 1536 + r]; }
        __syncthreads();
        for (int i = 0; i < 8; ++i) {
            const int m = cb * 64 + wave * 8 + i;
            const f32x4* xr = (const f32x4*)(x + (size_t)m * D) + lane;
            f32x4 v[4]; float ss = 0.f;
#pragma unroll
            for (int j = 0; j < 4; ++j) { v[j] = xr[64 * j]; ss += (v[j].x * v[j].x + v[j].y * v[j].y) + (v[j].z * v[j].z + v[j].w * v[j].w); }
            const float rstd = rsqrtf(wave_sum(ss) * (1.f / D) + 1e-6f);
            unsigned long long* o8 = (unsigned long long*)(XN + (size_t)m * D) + lane;
#pragma unroll
            for (int j = 0; j < 4; ++j) { const int k = 4 * lane + 256 * j; const f32x4 gg = *(const f32x4*)(g1 + k); const f32x4 sh = *(const LAS f32x4*)(modS + k); const f32x4 sc = *(const LAS f32x4*)(modS + D + k);
                v[j] = v[j] * rstd * gg * sc + sh;
                o8[64 * j] = (unsigned long long)pk2(v[j].x, v[j].y) | ((unsigned long long)pk2(v[j].z, v[j].w) << 32); }
            float mine = 0.f;
#pragma unroll 1
            for (int r = 0; r < 16; ++r) { float p = 0.f;
#pragma unroll
                for (int j = 0; j < 4; ++j) { const f32x4 w = *(const LAS f32x4*)(lrT + r * 1024 + 4 * lane + 256 * j); p += (v[j].x * w.x + v[j].y * w.y) + (v[j].z * w.z + v[j].w * w.w); }
                p = wave_sum(p); if (lane == r) mine = p; }
            if (lane < 16) alr[(size_t)m * 16 + lane] = mine;
        }
    }
    SEAM(1);

    if constexpr (IN(2)) {
        pg8::DenseOrder S; S.init(XN, Win_t, M, NPROJ, D, G, cb);
        pg8::EpiInProj E{Ugla, Udiff, Ugate};
        pg8::gemm_phase<pg8::EpiInProj, pg8::DenseOrder, true, true>(lds, D, S, E);
    }
    SEAM(2);

    if constexpr (IN(3)) {
        const int* pos = (const int*)args.in[I_POS]; const float* qg = (const float*)args.in[I_DQG]; const float* kg = (const float*)args.in[I_DKG];
        const float* aup = (const float*)args.in[I_AUP]; const float* ab = (const float*)args.in[I_AB];
        const float invf = powf(500000.0f, -(float)(lane & 7) * 0.125f);
        float gain[16];
#pragma unroll
        for (int e = 0; e < 16; ++e) gain[e] = (lane < 32 ? qg : kg)[(lane & 3) * 16 + e];
        for (int i = 0; i < 8; ++i) {
            const int m = cb * 64 + wave * 8 + i;
            bf16_t* rowp = Udiff + (size_t)m * 1536 + lane * 16;
            const u32x4 w0 = *(const u32x4*)rowp, w1 = *(const u32x4*)(rowp + 8);
            float y[16];
            y[0] = lo_bf(w0.x); y[1] = hi_bf(w0.x); y[2] = lo_bf(w0.y); y[3] = hi_bf(w0.y); y[4] = lo_bf(w0.z); y[5] = hi_bf(w0.z); y[6] = lo_bf(w0.w); y[7] = hi_bf(w0.w);
            y[8] = lo_bf(w1.x); y[9] = hi_bf(w1.x); y[10] = lo_bf(w1.y); y[11] = hi_bf(w1.y); y[12] = lo_bf(w1.z); y[13] = hi_bf(w1.z); y[14] = lo_bf(w1.w); y[15] = hi_bf(w1.w);
            float ss = 0.f;
#pragma unroll
            for (int e = 0; e < 16; ++e) ss += y[e] * y[e];
            ss += __shfl_xor(ss, 1); ss += __shfl_xor(ss, 2);
            const float rstd = rsqrtf(ss * (1.f / 64.f) + 1e-6f);
#pragma unroll
            for (int e = 0; e < 16; ++e) y[e] = y[e] * rstd * gain[e];
            const float ang = (float)pos[m] * invf; float sv, cv; sincosf(ang, &sv, &cv);
            float r[16];
#pragma unroll
            for (int e = 0; e < 8; ++e) { const float c_ = __shfl(cv, e), s_ = __shfl(sv, e); r[e] = y[e] * c_ - y[e + 8] * s_; r[e + 8] = y[e + 8] * c_ + y[e] * s_; }
            if ((lane & 3) == 0) {
#pragma unroll
                for (int e = 0; e < 16; ++e) y[e] = r[e]; }
            u32x4 o0, o1; o0.x = pk2(y[0], y[1]); o0.y = pk2(y[2], y[3]); o0.z = pk2(y[4], y[5]); o0.w = pk2(y[6], y[7]); o1.x = pk2(y[8], y[9]); o1.y = pk2(y[10], y[11]); o1.z = pk2(y[12], y[13]); o1.w = pk2(y[14], y[15]);
            *(u32x4*)rowp = o0; *(u32x4*)(rowp + 8) = o1;
            float a[16];
#pragma unroll
            for (int rr = 0; rr < 16; ++rr) a[rr] = alr[(size_t)m * 16 + rr];
#pragma unroll
            for (int q = 0; q < 4; ++q) { const int j = lane + 64 * q; float xv = ab[j];
#pragma unroll
                for (int rr = 0; rr < 16; ++rr) xv += a[rr] * aup[rr * 256 + j];
                const float ls = fminf(xv, 0.f) - log1pf(__expf(-fabsf(xv)));
                LOGA[(size_t)m * 256 + j] = ls * (1.f / 16.f); }
        }
    }
    SEAM(3);

    if constexpr (IN(4)) {
        if (cb < 128) {
            const int bh = cb >> 3, vs = cb & 7, b = bh >> 2, h = bh & 3;
            const int v = tid & 15, kgi = tid >> 4, k0 = 2 * kgi, col = vs * 16 + v;
            LAS float* red = (LAS float*)(lds + 65536);
            float S0 = 0.f, S1 = 0.f;
            for (int tb = 0; tb < SEQ; tb += 16) {
                const int buf = (tb >> 4) & 1;
#pragma unroll 4
                for (int s = 0; s < 16; ++s) {
                    const size_t m = (size_t)b * SEQ + tb + s;
                    const bf16_t* row = Ugla + m * 1536;
                    const unsigned qq = *(const unsigned*)(row + h * 64 + k0), kk = *(const unsigned*)(row + 256 + h * 64 + k0);
                    const float vv = bf2f(row[512 + h * 128 + col]);
                    const f32x2 la = *(const f32x2*)(LOGA + m * 256 + h * 64 + k0);
                    S0 = S0 * __expf(la.x) + lo_bf(kk) * vv; S1 = S1 * __expf(la.y) + hi_bf(kk) * vv;
                    float part = 0.125f * (lo_bf(qq) * S0 + hi_bf(qq) * S1);
                    part += __shfl_xor(part, 16); part += __shfl_xor(part, 32);
                    if (lane < 16) red[((buf * 16 + s) * 8 + wave) * 16 + lane] = part;
                }
                __syncthreads();
                if (tid < 256) { const int s = tid >> 4, v2 = tid & 15; float sum = 0.f;
#pragma unroll
                    for (int w = 0; w < 8; ++w) sum += red[((buf * 16 + s) * 8 + w) * 16 + v2];
                    OGLA[((size_t)b * SEQ + tb + s) * 512 + h * 128 + vs * 16 + v2] = sum; }
            }
            __syncthreads();
        }
        {
            const float* lq1 = (const float*)args.in[I_LQ1]; const float* lk1 = (const float*)args.in[I_LK1]; const float* lq2 = (const float*)args.in[I_LQ2]; const float* lk2 = (const float*)args.in[I_LK2];
            const float* og = (const float*)args.in[I_DOG];
            const float lam = __expf(wave_sum(lq1[lane] * lk1[lane])) - __expf(wave_sum(lq2[lane] * lk2[lane])) + 0.2f;
            const float og0 = og[lane], og1 = og[lane + 64];
            LAS float* qs = (LAS float*)lds + wave * 128;
            for (int wi = gw; wi < 16 * SEQ; wi += NGW) {
                const int bh = wi & 15, i = wi >> 4, b = bh >> 2, h = bh & 3;
                const size_t m = (size_t)b * SEQ + i;
                qs[lane] = bf2f(Udiff[m * 1536 + h * 128 + lane]); qs[64 + lane] = bf2f(Udiff[m * 1536 + h * 128 + 64 + lane]);
                float m1 = -1e30f, l1 = 0.f, m2 = -1e30f, l2 = 0.f, o1a = 0.f, o1b = 0.f, o2a = 0.f, o2b = 0.f;
                for (int j0 = 0; j0 <= i; j0 += 64) {
                    const int j = j0 + lane;
                    const bf16_t* kp = Udiff + ((size_t)b * SEQ + j) * 1536 + 512 + h * 128;
                    float s1 = 0.f, s2 = 0.f;
#pragma unroll
                    for (int d = 0; d < 64; d += 8) { const u32x4 kv = *(const u32x4*)(kp + d); const f32x4 qa = *(const LAS f32x4*)(qs + d), qb = *(const LAS f32x4*)(qs + d + 4);
                        s1 += qa.x * lo_bf(kv.x) + qa.y * hi_bf(kv.x) + qa.z * lo_bf(kv.y) + qa.w * hi_bf(kv.y) + qb.x * lo_bf(kv.z) + qb.y * hi_bf(kv.z) + qb.z * lo_bf(kv.w) + qb.w * hi_bf(kv.w); }
#pragma unroll
                    for (int d = 0; d < 64; d += 8) { const u32x4 kv = *(const u32x4*)(kp + 64 + d); const f32x4 qa = *(const LAS f32x4*)(qs + 64 + d), qb = *(const LAS f32x4*)(qs + 64 + d + 4);
                        s2 += qa.x * lo_bf(kv.x) + qa.y * hi_bf(kv.x) + qa.z * lo_bf(kv.y) + qa.w * hi_bf(kv.y) + qb.x * lo_bf(kv.z) + qb.y * hi_bf(kv.z) + qb.z * lo_bf(kv.w) + qb.w * hi_bf(kv.w); }
                    const bool ok = (j <= i);
                    s1 = ok ? s1 * 0.125f : -1e30f; s2 = ok ? s2 * 0.125f : -1e30f;
                    const float mn1 = fmaxf(m1, wave_max(s1)), al1 = __expf(m1 - mn1), p1 = ok ? __expf(s1 - mn1) : 0.f;
                    const float mn2 = fmaxf(m2, wave_max(s2)), al2 = __expf(m2 - mn2), p2 = ok ? __expf(s2 - mn2) : 0.f;
                    l1 = l1 * al1 + wave_sum(p1); l2 = l2 * al2 + wave_sum(p2); m1 = mn1; m2 = mn2;
                    o1a *= al1; o1b *= al1; o2a *= al2; o2b *= al2;
                    const bf16_t* vp = Udiff + ((size_t)b * SEQ + j0) * 1536 + 1024 + h * 128;
                    for (int jj = 0; jj < 64; ++jj) { const float pj1 = __shfl(p1, jj), pj2 = __shfl(p2, jj);
                        const float va = bf2f(vp[(size_t)jj * 1536 + lane]), vb = bf2f(vp[(size_t)jj * 1536 + 64 + lane]);
                        o1a += pj1 * va; o1b += pj1 * vb; o2a += pj2 * va; o2b += pj2 * vb; }
                }
                const float oa = o1a / l1 - lam * o2a / l2, ob = o1b / l1 - lam * o2b / l2;
                const float rstd = rsqrtf(wave_sum(oa * oa + ob * ob) * (1.f / 128.f) + 1e-6f);
                OB[m * 512 + h * 128 + lane] = (bf16_t)f2bf(oa * rstd * og0 * 0.8f); OB[m * 512 + h * 128 + 64 + lane] = (bf16_t)f2bf(ob * rstd * og1 * 0.8f);
            }
        }
    }
    SEAM(4);

    if constexpr (IN(5)) {
        const float* gog = (const float*)args.in[I_GOG];
        for (int i = 0; i < 8; ++i) {
            const size_t m = (size_t)cb * 64 + wave * 8 + i; const int col0 = lane * 8;
            const f32x4 a = *(const f32x4*)(OGLA + m * 512 + col0), b2 = *(const f32x4*)(OGLA + m * 512 + col0 + 4);
            float ss = (a.x * a.x + a.y * a.y) + (a.z * a.z + a.w * a.w) + (b2.x * b2.x + b2.y * b2.y) + (b2.z * b2.z + b2.w * b2.w);
            ss += __shfl_xor(ss, 1); ss += __shfl_xor(ss, 2); ss += __shfl_xor(ss, 4); ss += __shfl_xor(ss, 8);
            const float rstd = rsqrtf(ss * (1.f / 128.f) + 1e-6f);
            const u32x4 rw = *(const u32x4*)(Ugla + m * 1536 + 1024 + col0);
            const f32x4 g0 = *(const f32x4*)(gog + (col0 & 127)), g1v = *(const f32x4*)(gog + (col0 & 127) + 4);
            f32x4 o0, o1;
            o0.x = a.x * rstd * g0.x * siluf_(lo_bf(rw.x)); o0.y = a.y * rstd * g0.y * siluf_(hi_bf(rw.x)); o0.z = a.z * rstd * g0.z * siluf_(lo_bf(rw.y)); o0.w = a.w * rstd * g0.w * siluf_(hi_bf(rw.y));
            o1.x = b2.x * rstd * g1v.x * siluf_(lo_bf(rw.z)); o1.y = b2.y * rstd * g1v.y * siluf_(hi_bf(rw.z)); o1.z = b2.z * rstd * g1v.z * siluf_(lo_bf(rw.w)); o1.w = b2.w * rstd * g1v.w * siluf_(hi_bf(rw.w));
            *(u32x4*)(OA + m * 512 + col0) = pg8::pack8(o0, o1);
        }
    }
    SEAM(5);

    if constexpr (IN(6)) {
        { pg8::DenseOrder S; S.init(OA, Wa_t, M, D, 512, G, cb); pg8::EpiBranch E{Ugate, 0, nullptr, M1};
          pg8::gemm_phase<pg8::EpiBranch, pg8::DenseOrder, true, true>(lds, 512, S, E); }
        VM_WAIT(); __syncthreads();
        { pg8::DenseOrder S; S.init(OB, Wb_t, M, D, 512, G, cb); pg8::EpiBranch E{Ugate, 1024, M1, MERGED};
          pg8::gemm_phase<pg8::EpiBranch, pg8::DenseOrder, true, true>(lds, 512, S, E); }
    }
    SEAM(6);

    if constexpr (IN(7)) {
        pg8::DenseOrder S; S.init(MERGED, Wout_t, M, D, D, G, cb); pg8::EpiWout E{x, modf, out};
        pg8::gemm_phase<pg8::EpiWout, pg8::DenseOrder, true, true>(lds, D, S, E);
    }
    SEAM(7);

    if constexpr (IN(8)) {
        const float* g2 = (const float*)args.in[I_N2G];
        const float* Wrg = (const float*)args.in[I_RGW]; const float* brg = (const float*)args.in[I_RGB]; const float* Wre = (const float*)args.in[I_REW]; const float* bre = (const float*)args.in[I_REB];
        LAS float* modS = (LAS float*)lds;
        LAS float* h2s = (LAS float*)(lds + 8192) + wave * 1024;
        LAS int* eS = (LAS int*)(lds + 8192 + 32768);
        const int b = cb >> 6;
        for (int j = tid; j < 2048; j += NTHR) modS[j] = modf[(size_t)b * NMOD + 3 * D + j] + (j >= D ? 1.0f : 0.f);
        __syncthreads();
        for (int i = 0; i < 8; ++i) {
            const int tl = wave * 8 + i; const size_t m = (size_t)cb * 64 + tl;
            const f32x4* xr = (const f32x4*)(out + m * D) + lane;
            f32x4 v[4]; float ss = 0.f;
#pragma unroll
            for (int j = 0; j < 4; ++j) { v[j] = xr[64 * j]; ss += (v[j].x * v[j].x + v[j].y * v[j].y) + (v[j].z * v[j].z + v[j].w * v[j].w); }
            const float rstd = rsqrtf(wave_sum(ss) * (1.f / D) + 1e-6f);
            unsigned long long* o8 = (unsigned long long*)(H2 + m * D) + lane;
#pragma unroll
            for (int j = 0; j < 4; ++j) { const int k = 4 * lane + 256 * j; const f32x4 gg = *(const f32x4*)(g2 + k); const f32x4 sh = *(const LAS f32x4*)(modS + k); const f32x4 sc = *(const LAS f32x4*)(modS + D + k);
                v[j] = v[j] * rstd * gg * sc + sh;
                o8[64 * j] = (unsigned long long)pk2(v[j].x, v[j].y) | ((unsigned long long)pk2(v[j].z, v[j].w) << 32);
                *(LAS f32x4*)(h2s + k) = v[j]; }
            LDS_WAIT();
            float le; { const int e = lane & 31, half = lane >> 5; float acc = 0.f;
                for (int kk = 0; kk < 512; ++kk) { const int k = half * 512 + kk; acc += h2s[k] * Wre[k * 32 + e]; }
                acc += __shfl_xor(acc, 32); le = acc + bre[e]; }
            float lg; { const int g = lane & 3, part = lane >> 2; float acc = 0.f;
                for (int kk = 0; kk < 64; ++kk) { const int k = part * 64 + kk; acc += h2s[k] * Wrg[k * 4 + g]; }
                acc += __shfl_xor(acc, 4); acc += __shfl_xor(acc, 8); acc += __shfl_xor(acc, 16); acc += __shfl_xor(acc, 32); lg = acc + brg[g]; }
            const float lg0 = __shfl(lg, 0), lg1 = __shfl(lg, 1), lg2 = __shfl(lg, 2), lg3 = __shfl(lg, 3);
            int gi = 0; float gm = lg0; if (lg1 > gm) { gm = lg1; gi = 1; } if (lg2 > gm) { gm = lg2; gi = 2; } if (lg3 > gm) { gm = lg3; gi = 3; }
            const float ptop = 1.0f / (__expf(lg0 - gm) + __expf(lg1 - gm) + __expf(lg2 - gm) + __expf(lg3 - gm));
            float el[8];
#pragma unroll
            for (int j = 0; j < 8; ++j) el[j] = __shfl(le, gi * 8 + j);
            int j0 = 0; float e0 = el[0];
#pragma unroll
            for (int j = 1; j < 8; ++j) if (el[j] > e0) { e0 = el[j]; j0 = j; }
            int j1 = -1; float e1 = -3.0e38f;
#pragma unroll
            for (int j = 0; j < 8; ++j) if (j != j0 && el[j] > e1) { e1 = el[j]; j1 = j; }
            const float t = __expf(e1 - e0), w0 = ptop / (1.0f + t), w1 = ptop * t / (1.0f + t);
            if (lane == 0) { eS[2 * tl] = gi * 8 + j0; eS[2 * tl + 1] = gi * 8 + j1; tok_w[m * 2] = w0; tok_w[m * 2 + 1] = w1; }
        }
        __syncthreads();
        if (tid < 128) { const int e = eS[tid]; int rank = 0; for (int a = 0; a < tid; ++a) rank += (eS[a] == e) ? 1 : 0;
            tok_e[(size_t)cb * 128 + tid] = e; tok_rank[(size_t)cb * 128 + tid] = rank; }
        else if (tid < 160) { const int e = tid - 128; int cnt = 0; for (int a = 0; a < 128; ++a) cnt += (eS[a] == e) ? 1 : 0; blkcnt[cb * 32 + e] = cnt; }
        __syncthreads();
        {
            const float* w1 = (const float*)args.in[I_EW1]; const float* w3 = (const float*)args.in[I_EW3]; const float* w2 = (const float*)args.in[I_EW2];
            LAS float* scr = (LAS float*)(lds + wave * 16384);
            for (int it = gw; it < NEXP * 768; it += NGW) {
                const int e = it / 768, r = it % 768;
                if (r < 512) { const int kb = r >> 5, nb = r & 31, r0 = 32 * nb, pn = r0 >> 8, half = (r0 >> 7) & 1, jj = r0 & 127;
                    tr_item((half ? w3 : w1) + (size_t)e * D * DEXP, DEXP, 64 * kb, 128 * pn + jj, W13_t + (size_t)e * 1024 * 1024, D, r0, scr, lane); }
                else { const int r2 = r - 512, kb = r2 >> 5, nb = r2 & 31;
                    tr_item(w2 + (size_t)e * DEXP * D, D, 64 * kb, 32 * nb, W2_t + (size_t)e * 1024 * 512, DEXP, 32 * nb, scr, lane); }
            }
        }
    }
    SEAM(8);

    if constexpr (IN(9)) {
        LAS int* red = (LAS int*)lds;
        LAS int* totS = red + 1024;
        LAS int* preS = totS + 32;
        LAS int* padS = preS + 32;
        LAS int* slotS = padS + 64;
        { const int e = tid & 31, part = tid >> 5; int tot = 0, pre = 0;
            for (int blk = part; blk < 256; blk += 16) { const int cval = blkcnt[blk * 32 + e]; tot += cval; pre += (blk < cb) ? cval : 0; }
            red[part * 64 + e] = tot; red[part * 64 + 32 + e] = pre; }
        __syncthreads();
        if (tid < 32) { int tot = 0, pre = 0; for (int p = 0; p < 16; ++p) { tot += red[p * 64 + tid]; pre += red[p * 64 + 32 + tid]; } totS[tid] = tot; preS[tid] = pre; }
        __syncthreads();
        if (tid == 0) { int off = 0; for (int e = 0; e < 32; ++e) { padS[e] = off; off += ((totS[e] + 255) >> 8) << 8; } padS[32] = off; }
        __syncthreads();
        if (cb == 0) { if (tid < 32) { for (int t = padS[tid] >> 8; t < (padS[tid + 1] >> 8); ++t) tile_e[t] = tid; } if (tid == 32) ntiles_p[0] = padS[32] >> 8; }
        if (tid < 128) { const size_t a = (size_t)cb * 128 + tid; const int e = tok_e[a]; const int slot = padS[e] + preS[e] + tok_rank[a]; tok_slot[a] = slot; slotS[tid] = slot; }
        __syncthreads();
        for (int a = wave * 16; a < wave * 16 + 16; ++a) { const size_t t = (size_t)cb * 64 + (a >> 1); const int slot = slotS[a];
            const u32x4* src = (const u32x4*)(H2 + t * D) + lane; u32x4* dst = (u32x4*)(XS + (size_t)slot * D) + lane;
            dst[0] = src[0]; dst[64] = src[64]; }
        if (cb < 32) { const int r0 = padS[cb] + totS[cb], r1 = padS[cb + 1];
            for (int r = r0 + wave; r < r1; r += NWAVES) { u32x4* dst = (u32x4*)(XS + (size_t)r * D) + lane; dst[0] = (u32x4){0, 0, 0, 0}; dst[64] = (u32x4){0, 0, 0, 0}; } }
    }
    SEAM(9);

    if constexpr (IN(10)) {
        const int ntm = __builtin_amdgcn_readfirstlane(ntiles_p[0]);
        pg8::MoeOrder S; S.init(XS, W13_t, tile_e, ntm, D, (size_t)1024 * 1024 * 2, G, cb); pg8::EpiUp E{HMID};
        pg8::gemm_phase<pg8::EpiUp, pg8::MoeOrder, true, true>(lds, D, S, E);
    }
    SEAM(10);

    if constexpr (IN(11)) {
        const int ntm = __builtin_amdgcn_readfirstlane(ntiles_p[0]);
        pg8::MoeOrder S; S.init(HMID, W2_t, tile_e, ntm, DEXP, (size_t)1024 * 512 * 2, G, cb); pg8::EpiPlain E{Y, D};
        pg8::gemm_phase<pg8::EpiPlain, pg8::MoeOrder, true, true>(lds, DEXP, S, E);
    }
    SEAM(11);

    if constexpr (IN(12)) {
        for (int i = 0; i < 8; ++i) {
            const size_t m = (size_t)cb * 64 + wave * 8 + i; const int b = cb >> 6;
            const int s0 = tok_slot[m * 2], s1 = tok_slot[m * 2 + 1]; const float w0 = tok_w[m * 2], w1 = tok_w[m * 2 + 1];
            const float* g2p = modf + (size_t)b * NMOD + 5 * D;
#pragma unroll
            for (int j = 0; j < 4; ++j) { const int k = 4 * lane + 256 * j;
                const f32x4 xv = *(const f32x4*)(out + m * D + k); const f32x4 gv = *(const f32x4*)(g2p + k);
                const u32x2 y0 = *(const u32x2*)(Y + (size_t)s0 * D + k), y1 = *(const u32x2*)(Y + (size_t)s1 * D + k);
                f32x4 o; o.x = xv.x + gv.x * (w0 * lo_bf(y0.x) + w1 * lo_bf(y1.x)); o.y = xv.y + gv.y * (w0 * hi_bf(y0.x) + w1 * hi_bf(y1.x));
                o.z = xv.z + gv.z * (w0 * lo_bf(y0.y) + w1 * lo_bf(y1.y)); o.w = xv.w + gv.w * (w0 * hi_bf(y0.y) + w1 * hi_bf(y1.y));
                *(f32x4*)(out + m * D + k) = o; }
        }
    }
#undef IN
#undef SEAM
}

constexpr int NPHASE = 13;
template <int LO, int HI> static void launch_range(const Args& a, hipStream_t stream) {
    static bool attr = false;
    if (!attr) { (void)hipFuncSetAttribute((const void*)mk_fwd<LO, HI>, hipFuncAttributeMaxDynamicSharedMemorySize, LDS_BYTES); attr = true; }
    hipLaunchKernelGGL((mk_fwd<LO, HI>), dim3(256), dim3(NTHR), LDS_BYTES, stream, a);
}
extern "C" void kernel_launch(void* const* d_in, const int* in_sizes, int n_in, void* d_out, int out_size, void* d_ws, size_t ws_size, hipStream_t stream) {
    static int ok = 0;
    if (ok == 0) {
        if (n_in != 28 || out_size != M * D || ws_size < WS_END) { fprintf(stderr, "kernel_launch: unexpected shapes (n_in %d, out %d, ws %zu < %zu)\n", n_in, out_size, ws_size, (size_t)WS_END); ok = -1; return; }
        ok = 1;
    }
    if (ok < 0) return;
    (void)hipMemsetAsync((char*)d_ws + WS_CTL, 0, CTL_ZERO_BYTES, stream);
    Args a{};
    for (int i = 0; i < 28; ++i) a.in[i] = d_in[i];
    a.out = (float*)d_out; a.ws = (unsigned char*)d_ws; a.ph_lo = 0; a.ph_hi = NPHASE;
#if MK_ONE_LAUNCH
    launch_range<0, NPHASE>(a, stream);
#else
    launch_range<0, 1>(a, stream); launch_range<1, 2>(a, stream); launch_range<2, 3>(a, stream); launch_range<3, 4>(a, stream);
    launch_range<4, 5>(a, stream); launch_range<5, 6>(a, stream); launch_range<6, 7>(a, stream); launch_range<7, 8>(a, stream);
    launch_range<8, 9>(a, stream); launch_range<9, 10>(a, stream); launch_range<10, 11>(a, stream); launch_range<11, 12>(a, stream);
    launch_range<12, 13>(a, stream);
#endif
}
```

```cpp
#include <hip/hip_runtime.h>
#include <hip/hip_bf16.h>
#include <cstdio>
#include <cstdint>

#ifndef MK_ONE_LAUNCH
#define MK_ONE_LAUNCH 1
#endif

#define LAS __attribute__((address_space(3)))
#define GAS __attribute__((address_space(1)))
typedef unsigned short bf16_t;
typedef short bf16x8 __attribute__((ext_vector_type(8)));
typedef float f32x4 __attribute__((ext_vector_type(4)));
typedef float f32x2 __attribute__((ext_vector_type(2)));
typedef unsigned u32x4 __attribute__((ext_vector_type(4)));
typedef unsigned u32x2 __attribute__((ext_vector_type(2)));

constexpr int NB = 4, SEQ = 4096, D = 1024, M = NB * SEQ;
constexpr int DIN = 5136, NPROJ = 5120;
constexpr int NEXP = 32, DEXP = 512;
constexpr int PMAX = 40960;
constexpr int NMOD = 6 * D;

constexpr size_t MiB = 1u << 20;
constexpr size_t WS_CTL = 0, CTL_ZERO_BYTES = 1 * MiB;
constexpr size_t WS_MODP = 1 * MiB;
constexpr size_t WS_MODF = 4 * MiB;
constexpr size_t WS_ALR = 5 * MiB;
constexpr size_t WS_ROUTE = 6 * MiB;
constexpr size_t WS_WIN = 8 * MiB;
constexpr size_t WS_WA = 18 * MiB, WS_WB = 19 * MiB, WS_WOUT = 20 * MiB;
constexpr size_t RA = 22 * MiB;
constexpr size_t RB = 118 * MiB;
constexpr size_t WS_END = 278 * MiB;
constexpr size_t WS_XN = RA;
constexpr size_t WS_LOGA = RA;
constexpr size_t WS_OGLA = RA + 16 * MiB;
constexpr size_t WS_OB = RA + 48 * MiB;
constexpr size_t WS_OA = RA + 64 * MiB;
constexpr size_t WS_XS = RA;
constexpr size_t WS_Y = RA;
constexpr size_t WS_UGLA = RB;
constexpr size_t WS_UDIFF = RB + 48 * MiB;
constexpr size_t WS_UGATE = RB + 96 * MiB;
constexpr size_t WS_M1 = RB + 48 * MiB;
constexpr size_t WS_MERGED = RB;
constexpr size_t WS_H2 = RB;
constexpr size_t WS_W13 = RB + 64 * MiB;
constexpr size_t WS_W2 = RB + 128 * MiB;
constexpr size_t WS_HMID = RB;
constexpr size_t RT_TOKE = 0, RT_TOKW = 131072, RT_RANK = 262144, RT_SLOT = 393216, RT_BLKCNT = 524288, RT_TILEE = 557056, RT_NT = 561152;
constexpr int CW_BAR = 4096;

constexpr int RING_BYTES = 131072;
constexpr int LDSCTL_OFF = RING_BYTES, MISC_OFF = LDSCTL_OFF + 320;
constexpr int LDS_BYTES = 147456;
constexpr int NWAVES = 8, NTHR = 512;

__device__ __forceinline__ float bf2f(bf16_t h) { return __uint_as_float((unsigned)h << 16); }
__device__ __forceinline__ unsigned f2bf(float f) { unsigned u = __float_as_uint(f); return (u + 0x7fffu + ((u >> 16) & 1u)) >> 16; }
__device__ __forceinline__ unsigned pk2(float lo, float hi) { return f2bf(lo) | (f2bf(hi) << 16); }
__device__ __forceinline__ float lo_bf(unsigned w) { return __uint_as_float(w << 16); }
__device__ __forceinline__ float hi_bf(unsigned w) { return __uint_as_float(w & 0xffff0000u); }
__device__ __forceinline__ float wave_sum(float v) {
#pragma unroll
    for (int o = 1; o < 64; o <<= 1) v += __shfl_xor(v, o);
    return v;
}
__device__ __forceinline__ float wave_max(float v) {
#pragma unroll
    for (int o = 1; o < 64; o <<= 1) v = fmaxf(v, __shfl_xor(v, o));
    return v;
}
__device__ __forceinline__ float sigmoidf_(float x) { return 1.0f / (1.0f + __expf(-x)); }
__device__ __forceinline__ float siluf_(float x) { return x / (1.0f + __expf(-x)); }
#define LDS_WAIT() asm volatile("s_waitcnt lgkmcnt(0)" ::: "memory")
#define VM_WAIT() asm volatile("s_waitcnt vmcnt(0)" ::: "memory")

namespace pg8 {
constexpr int BM = 256, BK = 64, HALF = 128, HTB = HALF * BK * 2, STAGE_BYTES = 8 * HTB, NXCD = 8, WGM = 8;
__host__ __device__ __forceinline__ int lds_byte(int r, int c) { const int st = (r >> 4) * 2 + (c >> 5), rr = r & 15, cc = c & 31, ob = rr * 64 + cc * 2; return st * 1024 + (ob ^ (((ob >> 9) & 1) << 5)); }
__host__ __device__ __forceinline__ void stage_rc(int b, int& R, int& C) { const int st = b / 1024, sb = b % 1024, swz = sb ^ (((sb >> 9) & 1) << 5); R = (st >> 1) * 16 + swz / 64; C = (st & 1) * 32 + (swz % 64) / 2; }
__host__ __device__ __forceinline__ int perm32(int rho) { const int n = rho >> 4, i = rho & 15; return 8 * (i >> 2) + 4 * n + (i & 3); }

struct Unit { int pm, pn, aux; };

__device__ __forceinline__ int xcd_swizzle(int wgid, int nwg) { const int q = nwg / NXCD, r = nwg % NXCD, xcd = wgid % NXCD, off = wgid / NXCD; return (xcd < r ? xcd * (q + 1) : r * (q + 1) + (xcd - r) * q) + off; }

struct DenseOrder {
    const char* A; const char* Bt; size_t tstep; int nM, nN, nwg, G, c;
    __device__ __forceinline__ void init(const void* A_, const void* Bt_, int M_, int N_, int K_, int G_, int c_) { A = (const char*)A_; Bt = (const char*)Bt_; tstep = (size_t)BM * K_ * 2; nM = M_ / BM; nN = N_ / BM; nwg = nM * nN; G = G_; c = c_; }
    __device__ __forceinline__ bool next(int i, Unit& u) const {
        const long L = (long)i * G + c; if (L >= nwg) return false;
        const int wgid = xcd_swizzle((int)L, nwg);
        const int nig = WGM * nN, gid = wgid / nig, fm = gid * WGM, gsz = (nM - fm) < WGM ? (nM - fm) : WGM;
        u.pm = fm + ((wgid % nig) % gsz); u.pn = (wgid % nig) / gsz; u.aux = 0; return true;
    }
    __device__ __forceinline__ const char* a_ptr(const Unit& u) const { return A + (size_t)u.pm * tstep; }
    __device__ __forceinline__ const char* b_ptr(const Unit& u) const { return Bt + (size_t)u.pn * tstep; }
};
struct MoeOrder {
    const char* A; const char* W; const int* tile_e; size_t tstep, estride; int nwg, G, c;
    __device__ __forceinline__ void init(const void* A_, const void* W_, const int* te, int ntm, int K_, size_t estride_, int G_, int c_) { A = (const char*)A_; W = (const char*)W_; tile_e = te; tstep = (size_t)BM * K_ * 2; estride = estride_; nwg = ntm * 4; G = G_; c = c_; }
    __device__ __forceinline__ bool next(int i, Unit& u) const {
        const long L = (long)i * G + c; if (L >= nwg) return false;
        const int wgid = xcd_swizzle((int)L, nwg);
        u.pm = wgid >> 2; u.pn = wgid & 3; u.aux = __builtin_amdgcn_readfirstlane(tile_e[u.pm]); return true;
    }
    __device__ __forceinline__ const char* a_ptr(const Unit& u) const { return A + (size_t)u.pm * tstep; }
    __device__ __forceinline__ const char* b_ptr(const Unit& u) const { return W + (size_t)u.aux * estride + (size_t)u.pn * tstep; }
};

__device__ __forceinline__ u32x4 pack8(const f32x4& v0, const f32x4& v1) { u32x4 w; w.x = pk2(v0[0], v0[1]); w.y = pk2(v0[2], v0[3]); w.z = pk2(v1[0], v1[1]); w.w = pk2(v1[2], v1[3]); return w; }

struct EpiInProj {
    static constexpr bool PERM = true, AFTER_DRAIN = false;
    bf16_t *Ugla, *Udiff, *Ugate;
    __device__ __forceinline__ void operator()(const f32x4 (&acc)[2][2][4][2], const Unit& u, int wr, int wc, int fr, int fq) const {
        bf16_t* base; int ldc, colt;
        if (u.pn < 6) { base = Ugla; ldc = 1536; colt = u.pn * 256; } else if (u.pn < 12) { base = Udiff; ldc = 1536; colt = (u.pn - 6) * 256; } else { base = Ugate; ldc = 2048; colt = (u.pn - 12) * 256; }
        const int row0 = u.pm * BM + wr * 64 + fr, col0 = colt + wc * 32 + 8 * fq;
#pragma unroll
        for (int ai = 0; ai < 2; ++ai)
#pragma unroll
            for (int m = 0; m < 4; ++m) { bf16_t* rowp = base + (size_t)(row0 + ai * HALF + m * 16) * ldc + col0;
#pragma unroll
                for (int bj = 0; bj < 2; ++bj) *(u32x4*)(rowp + bj * HALF) = pack8(acc[ai][bj][m][0], acc[ai][bj][m][1]); }
    }
};
struct EpiPlain {
    static constexpr bool PERM = true, AFTER_DRAIN = false;
    bf16_t* O; int ldc;
    __device__ __forceinline__ void operator()(const f32x4 (&acc)[2][2][4][2], const Unit& u, int wr, int wc, int fr, int fq) const {
        const int row0 = u.pm * BM + wr * 64 + fr, col0 = u.pn * BM + wc * 32 + 8 * fq;
#pragma unroll
        for (int ai = 0; ai < 2; ++ai)
#pragma unroll
            for (int m = 0; m < 4; ++m) { bf16_t* rowp = O + (size_t)(row0 + ai * HALF + m * 16) * ldc + col0;
#pragma unroll
                for (int bj = 0; bj < 2; ++bj) *(u32x4*)(rowp + bj * HALF) = pack8(acc[ai][bj][m][0], acc[ai][bj][m][1]); }
    }
};
struct EpiBranch {
    static constexpr bool PERM = true, AFTER_DRAIN = false;
    const bf16_t* gate; int gcol0; const bf16_t* m1in; bf16_t* out;
    __device__ __forceinline__ void operator()(const f32x4 (&acc)[2][2][4][2], const Unit& u, int wr, int wc, int fr, int fq) const {
        const int row0 = u.pm * BM + wr * 64 + fr, col0 = u.pn * BM + wc * 32 + 8 * fq;
#pragma unroll
        for (int ai = 0; ai < 2; ++ai)
#pragma unroll
            for (int m = 0; m < 4; ++m) { const size_t r = (size_t)(row0 + ai * HALF + m * 16);
#pragma unroll
                for (int bj = 0; bj < 2; ++bj) { const int c = col0 + bj * HALF;
                    const u32x4 g = *(const u32x4*)(gate + r * 2048 + gcol0 + c);
                    f32x4 v0 = acc[ai][bj][m][0], v1 = acc[ai][bj][m][1];
                    v0[0] *= sigmoidf_(lo_bf(g.x)); v0[1] *= sigmoidf_(hi_bf(g.x)); v0[2] *= sigmoidf_(lo_bf(g.y)); v0[3] *= sigmoidf_(hi_bf(g.y));
                    v1[0] *= sigmoidf_(lo_bf(g.z)); v1[1] *= sigmoidf_(hi_bf(g.z)); v1[2] *= sigmoidf_(lo_bf(g.w)); v1[3] *= sigmoidf_(hi_bf(g.w));
                    if (m1in) { const u32x4 p = *(const u32x4*)(m1in + r * 1024 + c);
                        v0[0] += lo_bf(p.x); v0[1] += hi_bf(p.x); v0[2] += lo_bf(p.y); v0[3] += hi_bf(p.y); v1[0] += lo_bf(p.z); v1[1] += hi_bf(p.z); v1[2] += lo_bf(p.w); v1[3] += hi_bf(p.w); }
                    *(u32x4*)(out + r * 1024 + c) = pack8(v0, v1); } }
    }
};
struct EpiWout {
    static constexpr bool PERM = false, AFTER_DRAIN = false;
    const float* x; const float* modf; float* out;
    __device__ __forceinline__ void operator()(const f32x4 (&acc)[2][2][4][2], const Unit& u, int wr, int wc, int fr, int fq) const {
        const int row0 = u.pm * BM + wr * 64 + fr, col0 = u.pn * BM + wc * 32 + 4 * fq;
        const float* g1 = modf + (size_t)((u.pm * BM) >> 12) * NMOD + 2 * D;
#pragma unroll
        for (int bj = 0; bj < 2; ++bj)
#pragma unroll
            for (int n = 0; n < 2; ++n) { const int c = col0 + bj * HALF + n * 16; const f32x4 gv = *(const f32x4*)(g1 + c);
#pragma unroll
                for (int ai = 0; ai < 2; ++ai)
#pragma unroll
                    for (int m = 0; m < 4; ++m) { const size_t off = (size_t)(row0 + ai * HALF + m * 16) * D + c;
                        const f32x4 xv = *(const f32x4*)(x + off); *(f32x4*)(out + off) = xv + gv * acc[ai][bj][m][n]; } }
    }
};
struct EpiUp {
    static constexpr bool PERM = true, AFTER_DRAIN = false;
    bf16_t* H;
    __device__ __forceinline__ void operator()(const f32x4 (&acc)[2][2][4][2], const Unit& u, int wr, int wc, int fr, int fq) const {
        const int row0 = u.pm * BM + wr * 64 + fr, col0 = u.pn * HALF + wc * 32 + 8 * fq;
#pragma unroll
        for (int ai = 0; ai < 2; ++ai)
#pragma unroll
            for (int m = 0; m < 4; ++m) { f32x4 v0, v1;
#pragma unroll
                for (int e = 0; e < 4; ++e) { v0[e] = siluf_(acc[ai][0][m][0][e]) * acc[ai][1][m][0][e]; v1[e] = siluf_(acc[ai][0][m][1][e]) * acc[ai][1][m][1][e]; }
                *(u32x4*)(H + (size_t)(row0 + ai * HALF + m * 16) * DEXP + col0) = pack8(v0, v1); }
    }
};

template <class Epi, class Sched, bool ALIGN_EPI = false, bool SP2 = false>
__device__ __forceinline__ void gemm_phase(LAS unsigned char* lds, const int K, const Sched& S, const Epi& E) {
    int tid_ = threadIdx.x; asm volatile("" : "+v"(tid_));
    const int tid = tid_, wid = __builtin_amdgcn_readfirstlane(tid >> 6), lane = tid & 63, wr = wid >> 2, wc = wid & 3, fr = lane & 15, fq = lane >> 4;
    const int nt = K / BK;
    unsigned voffA[2], voffB[2];
#pragma unroll
    for (int i = 0; i < 2; ++i) { int R, C; stage_rc(tid * 16 + i * 8192, R, C); const int Rb = Epi::PERM ? ((R & ~31) + perm32(R & 31)) : R;
        voffA[i] = (unsigned)(R * K + C) * 2u; voffB[i] = (unsigned)(Rb * K + C) * 2u; }
    const size_t kstep = (size_t)(BK * 2);
    const size_t hstep = (size_t)HALF * K * 2;
    const unsigned ldsw = (unsigned)wid * 1024u;
    const int aoff = lds_byte(wr * 64 + fr, fq * 8), boff = lds_byte(wc * 32 + fr, fq * 8);
#define PG8_SA(b, h) (((b) * 2 + (h)) * HTB)
#define PG8_SB(b, h) ((4 + (b) * 2 + (h)) * HTB)
#define PG8_STAGE(bufoff, gbase, voff) do { _Pragma("unroll") for (int _i = 0; _i < 2; ++_i) \
        __builtin_amdgcn_global_load_lds((const unsigned*)((const char*)(gbase) + (voff)[_i]), (LAS unsigned*)(lds + (bufoff) + ldsw + _i * 8192), 16, 0, 0); } while (0)
#define PG8_LDA(dst, b, h) do { _Pragma("unroll") for (int m = 0; m < 4; ++m) _Pragma("unroll") for (int k = 0; k < 2; ++k) dst[m][k] = *(const LAS bf16x8*)(lds + PG8_SA(b, h) + aoff + m * 2048 + k * 1024); } while (0)
#define PG8_LDB(dst, b, h) do { _Pragma("unroll") for (int n = 0; n < 2; ++n) _Pragma("unroll") for (int k = 0; k < 2; ++k) dst[n][k] = *(const LAS bf16x8*)(lds + PG8_SB(b, h) + boff + n * 2048 + k * 1024); } while (0)
#define PG8_MMA(ai, bj, At, Bt) do { __builtin_amdgcn_s_setprio(1); _Pragma("unroll") for (int m = 0; m < 4; ++m) _Pragma("unroll") for (int n = 0; n < 2; ++n) _Pragma("unroll") for (int k = 0; k < 2; ++k) \
        acc[ai][bj][m][n] = __builtin_amdgcn_mfma_f32_16x16x32_bf16(Bt[n][k], At[m][k], acc[ai][bj][m][n], 0, 0, 0); __builtin_amdgcn_s_setprio(0); } while (0)
#define PG8_WAIT_V(n) asm volatile("s_waitcnt vmcnt(" #n ")" ::: "memory")
#define PG8_WAIT_L(n) asm volatile("s_waitcnt lgkmcnt(" #n ")" ::: "memory")
#define PG8_BAR __builtin_amdgcn_s_barrier()
#define PG8_SCHED __builtin_amdgcn_sched_barrier(0)
    Unit cur, nxt; int ui = 0;
    if (!S.next(0, cur)) return;
    f32x4 acc[2][2][4][2];
#pragma unroll
    for (int a = 0; a < 2; ++a)
#pragma unroll
        for (int b = 0; b < 2; ++b)
#pragma unroll
            for (int m = 0; m < 4; ++m)
#pragma unroll
                for (int n = 0; n < 2; ++n) acc[a][b][m][n] = (f32x4){0.f, 0.f, 0.f, 0.f};
    bf16x8 At[4][2], B0[2][2], B1[2][2];
    const char* cA = S.a_ptr(cur); const char* cB = S.b_ptr(cur);
    if constexpr (SP2) {
        PG8_STAGE(PG8_SB(0, 0), cB, voffB); PG8_STAGE(PG8_SB(0, 1), cB + hstep, voffB); PG8_STAGE(PG8_SA(0, 0), cA, voffA); PG8_STAGE(PG8_SA(0, 1), cA + hstep, voffA);
        if (wr == 1) PG8_BAR;
        PG8_WAIT_V(2); PG8_BAR;
        PG8_STAGE(PG8_SB(1, 0), cB + kstep, voffB); PG8_STAGE(PG8_SA(1, 0), cA + kstep, voffA); PG8_STAGE(PG8_SB(1, 1), cB + hstep + kstep, voffB);
        PG8_WAIT_V(6); PG8_BAR;
    } else {
        PG8_STAGE(PG8_SB(0, 0), cB, voffB); PG8_STAGE(PG8_SA(0, 0), cA, voffA); PG8_STAGE(PG8_SB(0, 1), cB + hstep, voffB); PG8_STAGE(PG8_SA(0, 1), cA + hstep, voffA);
        if (wr == 1) PG8_BAR;
        PG8_WAIT_V(4); PG8_BAR;
        PG8_STAGE(PG8_SB(1, 0), cB + kstep, voffB); PG8_STAGE(PG8_SA(1, 0), cA + kstep, voffA); PG8_STAGE(PG8_SB(1, 1), cB + hstep + kstep, voffB);
        PG8_WAIT_V(6); PG8_BAR;
    }
    for (;;) {
        const bool has_next = S.next(ui + 1, nxt);
        const char* nA = has_next ? S.a_ptr(nxt) : cA; const char* nB = has_next ? S.b_ptr(nxt) : cB;
        for (int t = 0; t < nt; t += 2) {
            const bool last = (t == nt - 2);
            const char* a1 = cA + (size_t)(t + 1) * kstep;
            const char* a2 = last ? nA : cA + (size_t)(t + 2) * kstep; const char* b2 = last ? nB : cB + (size_t)(t + 2) * kstep;
            const char* a3 = a2 + kstep; const char* b3 = b2 + kstep;
            if constexpr (SP2) {
            PG8_LDB(B0, 0, 0); PG8_LDB(B1, 0, 1); PG8_SCHED; PG8_LDA(At, 0, 0); PG8_STAGE(PG8_SA(1, 1), a1 + hstep, voffA);
            PG8_WAIT_V(8); PG8_WAIT_L(0); PG8_BAR; PG8_MMA(0, 0, At, B0); PG8_MMA(0, 1, At, B1); PG8_BAR; PG8_SCHED;
            PG8_LDA(At, 0, 1); PG8_STAGE(PG8_SB(0, 0), b2, voffB); PG8_STAGE(PG8_SB(0, 1), b2 + hstep, voffB); PG8_STAGE(PG8_SA(0, 0), a2, voffA);
            PG8_WAIT_V(8); PG8_WAIT_L(0); PG8_BAR; PG8_MMA(1, 0, At, B0); PG8_MMA(1, 1, At, B1); PG8_BAR; PG8_SCHED;
            PG8_LDB(B0, 1, 0); PG8_LDB(B1, 1, 1); PG8_SCHED; PG8_LDA(At, 1, 0); PG8_STAGE(PG8_SA(0, 1), a2 + hstep, voffA);
            PG8_WAIT_V(8); PG8_WAIT_L(0); PG8_BAR; PG8_MMA(0, 0, At, B0); PG8_MMA(0, 1, At, B1); PG8_BAR; PG8_SCHED;
            PG8_LDA(At, 1, 1); PG8_STAGE(PG8_SB(1, 0), b3, voffB); PG8_STAGE(PG8_SB(1, 1), b3 + hstep, voffB); PG8_STAGE(PG8_SA(1, 0), a3, voffA);
            PG8_WAIT_V(8); PG8_WAIT_L(0); PG8_BAR; PG8_MMA(1, 0, At, B0); PG8_MMA(1, 1, At, B1); PG8_BAR; PG8_SCHED;
            } else {
            PG8_LDB(B0, 0, 0); PG8_SCHED; PG8_LDA(At, 0, 0); PG8_STAGE(PG8_SA(1, 1), a1 + hstep, voffA);
            PG8_WAIT_L(8); PG8_BAR; PG8_WAIT_L(0); PG8_MMA(0, 0, At, B0); PG8_BAR; PG8_SCHED;
            PG8_LDB(B1, 0, 1); PG8_STAGE(PG8_SB(0, 0), b2, voffB);
            PG8_BAR; PG8_WAIT_L(0); PG8_MMA(0, 1, At, B1); PG8_BAR;
            PG8_LDA(At, 0, 1); PG8_STAGE(PG8_SA(0, 0), a2, voffA);
            PG8_BAR; PG8_WAIT_L(0); PG8_MMA(1, 0, At, B0); PG8_BAR; PG8_SCHED;
            PG8_STAGE(PG8_SB(0, 1), b2 + hstep, voffB);
            PG8_WAIT_V(6); PG8_BAR; PG8_MMA(1, 1, At, B1); PG8_BAR;
            PG8_LDB(B0, 1, 0); PG8_SCHED; PG8_LDA(At, 1, 0); PG8_STAGE(PG8_SA(0, 1), a2 + hstep, voffA);
            PG8_WAIT_L(8); PG8_BAR; PG8_WAIT_L(0); PG8_MMA(0, 0, At, B0); PG8_BAR; PG8_SCHED;
            PG8_LDB(B1, 1, 1); PG8_STAGE(PG8_SB(1, 0), b3, voffB);
            PG8_BAR; PG8_WAIT_L(0); PG8_MMA(0, 1, At, B1); PG8_BAR;
            PG8_LDA(At, 1, 1); PG8_STAGE(PG8_SA(1, 0), a3, voffA);
            PG8_BAR; PG8_WAIT_L(0); PG8_MMA(1, 0, At, B0); PG8_BAR; PG8_SCHED;
            PG8_STAGE(PG8_SB(1, 1), b3 + hstep, voffB);
            PG8_WAIT_V(6); PG8_BAR; PG8_MMA(1, 1, At, B1); PG8_BAR;
            }
        }
        if constexpr (ALIGN_EPI) { if (wr == 0) PG8_BAR; }
        E(acc, cur, wr, wc, fr, fq);
        if (!has_next) break;
#pragma unroll
        for (int a = 0; a < 2; ++a)
#pragma unroll
            for (int b = 0; b < 2; ++b)
#pragma unroll
                for (int m = 0; m < 4; ++m)
#pragma unroll
                    for (int n = 0; n < 2; ++n) acc[a][b][m][n] = (f32x4){0.f, 0.f, 0.f, 0.f};
        cur = nxt; cA = nA; cB = nB; ++ui;
        if constexpr (ALIGN_EPI) { if (wr == 1) PG8_BAR; }
    }
    PG8_WAIT_V(0);
    if constexpr (!ALIGN_EPI) { if (wr == 0) PG8_BAR; }
    PG8_BAR;
#undef PG8_SA
#undef PG8_SB
#undef PG8_STAGE
#undef PG8_LDA
#undef PG8_LDB
#undef PG8_MMA
#undef PG8_WAIT_V
#undef PG8_WAIT_L
#undef PG8_BAR
#undef PG8_SCHED
}
}

#define XB_TMO      128
#define XB_XCNT(j)  (256  + 64 * (j))
#define XB_XSUB(j)  (1280 + 64 * (j))
#define XB_XGEN(j)  (2304 + 64 * (j))
#define XB_TOP      3328
#define XB_TOPGEN   3392
#define XCD_BAR_WORDS 3456
#define XB_SPIN_CAP (1u << 18)
__device__ __forceinline__ unsigned xb_ld(unsigned* p)              { return __hip_atomic_load(p, __ATOMIC_RELAXED, __HIP_MEMORY_SCOPE_AGENT); }
__device__ __forceinline__ unsigned xb_add(unsigned* p, unsigned v) { return __hip_atomic_fetch_add(p, v, __ATOMIC_RELAXED, __HIP_MEMORY_SCOPE_AGENT); }
__device__ __forceinline__ unsigned xb_xcc_id() { return (unsigned)__builtin_amdgcn_s_getreg((3 << 11) | 20) & 0xFu; }
#define XB_SPIN(cond, bar) do { unsigned _sp = 0; while (cond) { __builtin_amdgcn_s_sleep(1); \
    if ((++_sp & 255u) == 0u) { if (xb_ld(&(bar)[XB_TMO])) break; if (_sp > XB_SPIN_CAP) { atomicAdd(&(bar)[XB_TMO], 1u); break; } } } } while (0)
struct XcdBarrier { unsigned* bar; unsigned x; volatile LAS unsigned* st; };
__device__ __forceinline__ XcdBarrier xcd_barrier_post(unsigned* bar, volatile LAS unsigned* st) {
    XcdBarrier b; b.bar = bar; b.x = xb_xcc_id(); b.st = st;
    if (threadIdx.x == 0) (void)xb_add(&bar[XB_XCNT(b.x)], 1u);
    return b;
}
__device__ __forceinline__ void xcd_barrier_complete(unsigned* bar, unsigned x, unsigned& nloc, unsigned& nx) {
    const unsigned G = gridDim.x * gridDim.y * gridDim.z;
    unsigned sum, cnt, mine, sp = 0u;
    for (;;) {
        sum = 0u; cnt = 0u; mine = 0u;
#pragma unroll
        for (unsigned j = 0; j < 16; ++j) { const unsigned c = xb_ld(&bar[XB_XCNT(j)]); sum += c; cnt += (c > 0u) ? 1u : 0u; mine = (j == x) ? c : mine; }
        if (sum == G) break;
        __builtin_amdgcn_s_sleep(1);
        if ((++sp & 255u) == 0u) { if (xb_ld(&bar[XB_TMO])) break; if (sp > XB_SPIN_CAP) { atomicAdd(&bar[XB_TMO], 1u); break; } }
    }
    nloc = mine > 0u ? mine : 1u; nx = cnt > 0u ? cnt : 1u;
}
__device__ __forceinline__ void xcd_barrier(const XcdBarrier& b) {
    asm volatile("s_waitcnt vmcnt(0)" ::: "memory");
    __syncthreads();
    if (threadIdx.x == 0) {
        unsigned* bar = b.bar;
        __builtin_amdgcn_s_waitcnt(0);
        unsigned nloc = b.st[0], nx = b.st[1];
        if (nloc == 0u) { xcd_barrier_complete(bar, b.x, nloc, nx); b.st[0] = nloc; b.st[1] = nx; }
        const unsigned old = xb_add(&bar[XB_XSUB(b.x)], 1u);
        const unsigned gen = old / nloc;
        if (old + 1u == (gen + 1u) * nloc) {
            __builtin_amdgcn_fence(__ATOMIC_RELEASE, "agent");
            asm volatile("s_waitcnt vmcnt(0)" ::: "memory");
            const unsigned og = xb_add(&bar[XB_TOP], 1u);
            const unsigned tg = og / nx;
            if (og + 1u == (tg + 1u) * nx) xb_add(&bar[XB_TOPGEN], 1u);
            else XB_SPIN(xb_ld(&bar[XB_TOPGEN]) == tg, bar);
            __builtin_amdgcn_fence(__ATOMIC_ACQUIRE, "agent");
            xb_add(&bar[XB_XGEN(b.x)], 1u);
            asm volatile("s_waitcnt vmcnt(0)" ::: "memory");
        } else {
            XB_SPIN(xb_ld(&bar[XB_XGEN(b.x)]) == gen, bar);
            __builtin_amdgcn_fence(__ATOMIC_ACQUIRE, "agent");
            asm volatile("s_waitcnt vmcnt(0)" ::: "memory");
        }
    }
    __syncthreads();
}

struct Args { const void* in[28]; float* out; unsigned char* ws; int ph_lo, ph_hi; };
enum { I_X = 0, I_C, I_POS, I_ADAW, I_ADAB, I_N1G, I_N2G, I_WIN, I_AUP, I_AB, I_GOG, I_DQG, I_DKG, I_LQ1, I_LK1, I_LQ2, I_LK2, I_DOG, I_WBA, I_WBB, I_WOUT, I_RGW, I_RGB, I_REW, I_REB, I_EW1, I_EW3, I_EW2 };

__device__ __forceinline__ void tr_item(const float* W, int ldn, int k0, int nsrc0, bf16_t* WT, int Kdst, int drow0, LAS float* scr, int lane) {
#pragma unroll 8
    for (int i = 0; i < 32; ++i) { const int kk = 2 * i + (lane >> 5); scr[kk * 33 + (lane & 31)] = W[(size_t)(k0 + kk) * ldn + nsrc0 + (lane & 31)]; }
    LDS_WAIT(); asm volatile("" ::: "memory");
    const int c = lane & 7;
#pragma unroll
    for (int j = 0; j < 4; ++j) { const int n = (lane >> 3) + 8 * j; const LAS float* s = scr + (8 * c) * 33 + n;
        u32x4 o; o.x = pk2(s[0 * 33], s[1 * 33]); o.y = pk2(s[2 * 33], s[3 * 33]); o.z = pk2(s[4 * 33], s[5 * 33]); o.w = pk2(s[6 * 33], s[7 * 33]);
        *(u32x4*)(WT + (size_t)(drow0 + n) * Kdst + k0 + 8 * c) = o; }
    LDS_WAIT(); asm volatile("" ::: "memory");
}

template <int IDX> __device__ __forceinline__ const void* ldarg() {
    unsigned long long p;
    asm volatile("s_load_dwordx2 %0, %1, %2\n\ts_waitcnt lgkmcnt(0)" : "=s"(p) : "s"(__builtin_amdgcn_kernarg_segment_ptr()), "n"(IDX * 8) : "memory");
    return (const void*)p;
}
#define ARG_IN(i) (ldarg<(i)>())
#define ARG_WS ((unsigned char*)ldarg<29>())
#define XIN ((const float*)ARG_IN(I_X))
#define OUTP ((float*)ldarg<28>())
#define P_MODP ((float*)(ARG_WS + WS_MODP))
#define P_MODF ((float*)(ARG_WS + WS_MODF))
#define P_ALR ((float*)(ARG_WS + WS_ALR))
#define P_WIN ((bf16_t*)(ARG_WS + WS_WIN))
#define P_WA ((bf16_t*)(ARG_WS + WS_WA))
#define P_WB ((bf16_t*)(ARG_WS + WS_WB))
#define P_WOUT ((bf16_t*)(ARG_WS + WS_WOUT))
#define P_XN ((bf16_t*)(ARG_WS + WS_XN))
#define P_LOGA ((float*)(ARG_WS + WS_LOGA))
#define P_OGLA ((float*)(ARG_WS + WS_OGLA))
#define P_OB ((bf16_t*)(ARG_WS + WS_OB))
#define P_OA ((bf16_t*)(ARG_WS + WS_OA))
#define P_XS ((bf16_t*)(ARG_WS + WS_XS))
#define P_Y ((bf16_t*)(ARG_WS + WS_Y))
#define P_UGLA ((bf16_t*)(ARG_WS + WS_UGLA))
#define P_UDIFF ((bf16_t*)(ARG_WS + WS_UDIFF))
#define P_UGATE ((bf16_t*)(ARG_WS + WS_UGATE))
#define P_M1 ((bf16_t*)(ARG_WS + WS_M1))
#define P_MERGED ((bf16_t*)(ARG_WS + WS_MERGED))
#define P_H2 ((bf16_t*)(ARG_WS + WS_H2))
#define P_W13 ((bf16_t*)(ARG_WS + WS_W13))
#define P_W2 ((bf16_t*)(ARG_WS + WS_W2))
#define P_HMID ((bf16_t*)(ARG_WS + WS_HMID))
#define P_TOKE ((int*)(ARG_WS + WS_ROUTE + RT_TOKE))
#define P_TOKW ((float*)(ARG_WS + WS_ROUTE + RT_TOKW))
#define P_RANK ((int*)(ARG_WS + WS_ROUTE + RT_RANK))
#define P_SLOT ((int*)(ARG_WS + WS_ROUTE + RT_SLOT))
#define P_BLKCNT ((int*)(ARG_WS + WS_ROUTE + RT_BLKCNT))
#define P_TILEE ((int*)(ARG_WS + WS_ROUTE + RT_TILEE))
#define P_NT ((int*)(ARG_WS + WS_ROUTE + RT_NT))
template <int LO, int HI>
__global__ void __launch_bounds__(NTHR, 2) mk_fwd(Args args) {
    extern __shared__ __attribute__((aligned(16))) unsigned char lds_raw[];
    LAS unsigned char* lds = (LAS unsigned char*)lds_raw;
    volatile LAS unsigned* MISC = (volatile LAS unsigned*)(lds + MISC_OFF);
    const int tid = threadIdx.x, lane = tid & 63, wave = __builtin_amdgcn_readfirstlane(tid >> 6);
    const int G = gridDim.x, cb = blockIdx.x;
    const int gw = cb * NWAVES + wave, NGW = G * NWAVES;
    unsigned* ctl = (unsigned*)(ARG_WS + WS_CTL);
    for (int u = tid; u < (LDS_BYTES - LDSCTL_OFF) / 4; u += NTHR) ((LAS unsigned*)(lds + LDSCTL_OFF))[u] = 0u;
    __syncthreads();
    constexpr int lo = LO, hi = HI;
    XcdBarrier bar; bar.bar = ctl + CW_BAR; bar.x = 0; bar.st = nullptr;
    if constexpr (hi - lo > 1) bar = xcd_barrier_post(ctl + CW_BAR, MISC + 8);
#define IN(k) (lo <= (k) && (k) < hi)
#define SEAM(k) do { if constexpr (IN(k) && IN((k) + 1)) xcd_barrier(bar); } while (0)

    if constexpr (IN(0)) {
        float* modp = P_MODP; bf16_t* Win_t = P_WIN; bf16_t* Wa_t = P_WA; bf16_t* Wb_t = P_WB; bf16_t* Wout_t = P_WOUT;
        const float* cvec = (const float*)ARG_IN(I_C); const float* ada_w = (const float*)ARG_IN(I_ADAW);
        const float* w_in = (const float*)ARG_IN(I_WIN);
        LAS float* scr = (LAS float*)(lds + wave * 16384);
        constexpr int I_MOD = 768, I_WIN_ = 16 * 160, I_WAB = 8 * 32, I_WO = 16 * 32;
        constexpr int NITEMS = I_MOD + I_WIN_ + 2 * I_WAB + I_WO;
        for (int it = gw; it < NITEMS; it += NGW) {
            int r = it;
            if (r < I_MOD) {
                const int jc = r % 24, kc = r / 24, j = jc * 256 + lane * 4;
                f32x4 a0 = {0, 0, 0, 0}, a1 = a0, a2 = a0, a3 = a0;
                for (int kk = 0; kk < 32; ++kk) { const int k = kc * 32 + kk; const f32x4 w = *(const f32x4*)(ada_w + (size_t)k * NMOD + j);
                    a0 += siluf_(cvec[k]) * w; a1 += siluf_(cvec[D + k]) * w; a2 += siluf_(cvec[2 * D + k]) * w; a3 += siluf_(cvec[3 * D + k]) * w; }
                *(f32x4*)(modp + (size_t)(kc * 4 + 0) * NMOD + j) = a0; *(f32x4*)(modp + (size_t)(kc * 4 + 1) * NMOD + j) = a1;
                *(f32x4*)(modp + (size_t)(kc * 4 + 2) * NMOD + j) = a2; *(f32x4*)(modp + (size_t)(kc * 4 + 3) * NMOD + j) = a3;
                continue; }
            r -= I_MOD;
            if (r < I_WIN_) { const int kb = r / 160, nb = r % 160, n0 = 32 * nb; tr_item(w_in, DIN, 64 * kb, n0 < 1536 ? n0 : n0 + 16, Win_t, D, n0, scr, lane); continue; }
            r -= I_WIN_;
            if (r < I_WAB) { const int kb = r / 32, nb = r % 32; tr_item((const float*)ARG_IN(I_WBA), D, 64 * kb, 32 * nb, Wa_t, 512, 32 * nb, scr, lane); continue; }
            r -= I_WAB;
            if (r < I_WAB) { const int kb = r / 32, nb = r % 32; tr_item((const float*)ARG_IN(I_WBB), D, 64 * kb, 32 * nb, Wb_t, 512, 32 * nb, scr, lane); continue; }
            r -= I_WAB;
            { const int kb = r / 32, nb = r % 32; tr_item((const float*)ARG_IN(I_WOUT), D, 64 * kb, 32 * nb, Wout_t, D, 32 * nb, scr, lane); }
        }
    }
    SEAM(0);

    if constexpr (IN(1)) {
        const float* x = XIN; float* modp = P_MODP; float* modf = P_MODF; float* alr = P_ALR; bf16_t* XN = P_XN;
        const float* ada_b = (const float*)ARG_IN(I_ADAB); const float* g1 = (const float*)ARG_IN(I_N1G); const float* w_in = (const float*)ARG_IN(I_WIN);
        LAS float* modS = (LAS float*)lds;
        LAS float* lrT = (LAS float*)(lds + 8192);
        const int b = cb >> 6;
        { const int j = tid * 4; f32x4 s = *(const f32x4*)(ada_b + j);
            for (int kc = 0; kc < 32; ++kc) s += *(const f32x4*)(modp + (size_t)(kc * 4 + b) * NMOD + j);
            if (j >= D) s += 1.0f;
            *(LAS f32x4*)(modS + j) = s; }
        if (tid < 96) { const int idx = cb * 96 + tid, bb = idx / NMOD, j = idx % NMOD; float s = ada_b[j];
            for (int kc = 0; kc < 32; ++kc) s += modp[(size_t)(kc * 4 + bb) * NMOD + j];
            modf[idx] = s; }
        for (int idx = tid; idx < 16384; idx += NTHR) { const int k = idx >> 4, r = idx & 15; lrT[r * 1024 + k] = w_in[(size_t)k * DIN + 1536 + r]; }
        __syncthreads();
        for (int i = 0; i < 8; ++i) {
            const int m = cb * 64 + wave * 8 + i;
            const f32x4* xr = (const f32x4*)(x + (size_t)m * D) + lane;
            f32x4 v[4]; float ss = 0.f;
#pragma unroll
            for (int j = 0; j < 4; ++j) { v[j] = xr[64 * j]; ss += (v[j].x * v[j].x + v[j].y * v[j].y) + (v[j].z * v[j].z + v[j].w * v[j].w); }
            const float rstd = rsqrtf(wave_sum(ss) * (1.f / D) + 1e-6f);
            unsigned long long* o8 = (unsigned long long*)(XN + (size_t)m * D) + lane;
#pragma unroll
            for (int j = 0; j < 4; ++j) { const int k = 4 * lane + 256 * j; const f32x4 gg = *(const f32x4*)(g1 + k); const f32x4 sh = *(const LAS f32x4*)(modS + k); const f32x4 sc = *(const LAS f32x4*)(modS + D + k);
                v[j] = v[j] * rstd * gg * sc + sh;
                o8[64 * j] = (unsigned long long)pk2(v[j].x, v[j].y) | ((unsigned long long)pk2(v[j].z, v[j].w) << 32); }
            float mine = 0.f;
#pragma unroll 1
            for (int r = 0; r < 16; ++r) { float p = 0.f;
#pragma unroll
                for (int j = 0; j < 4; ++j) { const f32x4 w = *(const LAS f32x4*)(lrT + r * 1024 + 4 * lane + 256 * j); p += (v[j].x * w.x + v[j].y * w.y) + (v[j].z * w.z + v[j].w * w.w); }
                p = wave_sum(p); if (lane == r) mine = p; }
            if (lane < 16) alr[(size_t)m * 16 + lane] = mine;
        }
    }
    SEAM(1);

    if constexpr (IN(2)) {
        bf16_t* XN = P_XN; bf16_t* Win_t = P_WIN; bf16_t* Ugla = P_UGLA; bf16_t* Udiff = P_UDIFF; bf16_t* Ugate = P_UGATE;
        pg8::DenseOrder S; S.init(XN, Win_t, M, NPROJ, D, G, cb);
        pg8::EpiInProj E{Ugla, Udiff, Ugate};
        pg8::gemm_phase<pg8::EpiInProj, pg8::DenseOrder, true, true>(lds, D, S, E);
    }
    SEAM(2);

    if constexpr (IN(3)) {
        bf16_t* Udiff = P_UDIFF; float* alr = P_ALR; float* LOGA = P_LOGA;
        const int* pos = (const int*)ARG_IN(I_POS); const float* qg = (const float*)ARG_IN(I_DQG); const float* kg = (const float*)ARG_IN(I_DKG);
        const float* aup = (const float*)ARG_IN(I_AUP); const float* ab = (const float*)ARG_IN(I_AB);
        const float invf = powf(500000.0f, -(float)(lane & 7) * 0.125f);
        float gain[16];
#pragma unroll
        for (int e = 0; e < 16; ++e) gain[e] = (lane < 32 ? qg : kg)[(lane & 3) * 16 + e];
        for (int i = 0; i < 8; ++i) {
            const int m = cb * 64 + wave * 8 + i;
            bf16_t* rowp = Udiff + (size_t)m * 1536 + lane * 16;
            const u32x4 w0 = *(const u32x4*)rowp, w1 = *(const u32x4*)(rowp + 8);
            float y[16];
            y[0] = lo_bf(w0.x); y[1] = hi_bf(w0.x); y[2] = lo_bf(w0.y); y[3] = hi_bf(w0.y); y[4] = lo_bf(w0.z); y[5] = hi_bf(w0.z); y[6] = lo_bf(w0.w); y[7] = hi_bf(w0.w);
            y[8] = lo_bf(w1.x); y[9] = hi_bf(w1.x); y[10] = lo_bf(w1.y); y[11] = hi_bf(w1.y); y[12] = lo_bf(w1.z); y[13] = hi_bf(w1.z); y[14] = lo_bf(w1.w); y[15] = hi_bf(w1.w);
            float ss = 0.f;
#pragma unroll
            for (int e = 0; e < 16; ++e) ss += y[e] * y[e];
            ss += __shfl_xor(ss, 1); ss += __shfl_xor(ss, 2);
            const float rstd = rsqrtf(ss * (1.f / 64.f) + 1e-6f);
#pragma unroll
            for (int e = 0; e < 16; ++e) y[e] = y[e] * rstd * gain[e];
            const float ang = (float)pos[m] * invf; float sv, cv; sincosf(ang, &sv, &cv);
            float r[16];
#pragma unroll
            for (int e = 0; e < 8; ++e) { const float c_ = __shfl(cv, e), s_ = __shfl(sv, e); r[e] = y[e] * c_ - y[e + 8] * s_; r[e + 8] = y[e + 8] * c_ + y[e] * s_; }
            if ((lane & 3) == 0) {
#pragma unroll
                for (int e = 0; e < 16; ++e) y[e] = r[e]; }
            u32x4 o0, o1; o0.x = pk2(y[0], y[1]); o0.y = pk2(y[2], y[3]); o0.z = pk2(y[4], y[5]); o0.w = pk2(y[6], y[7]); o1.x = pk2(y[8], y[9]); o1.y = pk2(y[10], y[11]); o1.z = pk2(y[12], y[13]); o1.w = pk2(y[14], y[15]);
            *(u32x4*)rowp = o0; *(u32x4*)(rowp + 8) = o1;
            float a[16];
#pragma unroll
            for (int rr = 0; rr < 16; ++rr) a[rr] = alr[(size_t)m * 16 + rr];
#pragma unroll
            for (int q = 0; q < 4; ++q) { const int j = lane + 64 * q; float xv = ab[j];
#pragma unroll
                for (int rr = 0; rr < 16; ++rr) xv += a[rr] * aup[rr * 256 + j];
                const float ls = fminf(xv, 0.f) - log1pf(__expf(-fabsf(xv)));
                LOGA[(size_t)m * 256 + j] = ls * (1.f / 16.f); }
        }
    }
    SEAM(3);

    if constexpr (IN(4)) {
        bf16_t* Ugla = P_UGLA; bf16_t* Udiff = P_UDIFF; float* LOGA = P_LOGA; float* OGLA = P_OGLA; bf16_t* OB = P_OB;
        if (cb < 128) {
            const int bh = cb >> 3, vs = cb & 7, b = bh >> 2, h = bh & 3;
            const int v = tid & 15, kgi = tid >> 4, k0 = 2 * kgi, col = vs * 16 + v;
            LAS float* red = (LAS float*)(lds + 65536);
            float S0 = 0.f, S1 = 0.f;
            for (int tb = 0; tb < SEQ; tb += 16) {
                const int buf = (tb >> 4) & 1;
#pragma unroll 4
                for (int s = 0; s < 16; ++s) {
                    const size_t m = (size_t)b * SEQ + tb + s;
                    const bf16_t* row = Ugla + m * 1536;
                    const unsigned qq = *(const unsigned*)(row + h * 64 + k0), kk = *(const unsigned*)(row + 256 + h * 64 + k0);
                    const float vv = bf2f(row[512 + h * 128 + col]);
                    const f32x2 la = *(const f32x2*)(LOGA + m * 256 + h * 64 + k0);
                    S0 = S0 * __expf(la.x) + lo_bf(kk) * vv; S1 = S1 * __expf(la.y) + hi_bf(kk) * vv;
                    float part = 0.125f * (lo_bf(qq) * S0 + hi_bf(qq) * S1);
                    part += __shfl_xor(part, 16); part += __shfl_xor(part, 32);
                    if (lane < 16) red[((buf * 16 + s) * 8 + wave) * 16 + lane] = part;
                }
                __syncthreads();
                if (tid < 256) { const int s = tid >> 4, v2 = tid & 15; float sum = 0.f;
#pragma unroll
                    for (int w = 0; w < 8; ++w) sum += red[((buf * 16 + s) * 8 + w) * 16 + v2];
                    OGLA[((size_t)b * SEQ + tb + s) * 512 + h * 128 + vs * 16 + v2] = sum; }
            }
            __syncthreads();
        }
        {
            const float* lq1 = (const float*)ARG_IN(I_LQ1); const float* lk1 = (const float*)ARG_IN(I_LK1); const float* lq2 = (const float*)ARG_IN(I_LQ2); const float* lk2 = (const float*)ARG_IN(I_LK2);
            const float* og = (const float*)ARG_IN(I_DOG);
            const float lam = __expf(wave_sum(lq1[lane] * lk1[lane])) - __expf(wave_sum(lq2[lane] * lk2[lane])) + 0.2f;
            const float og0 = og[lane], og1 = og[lane + 64];
            LAS float* qs = (LAS float*)lds + wave * 128;
            for (int wi = gw; wi < 16 * SEQ; wi += NGW) {
                const int bh = wi & 15, i = wi >> 4, b = bh >> 2, h = bh & 3;
                const size_t m = (size_t)b * SEQ + i;
                qs[lane] = bf2f(Udiff[m * 1536 + h * 128 + lane]); qs[64 + lane] = bf2f(Udiff[m * 1536 + h * 128 + 64 + lane]);
                float m1 = -1e30f, l1 = 0.f, m2 = -1e30f, l2 = 0.f, o1a = 0.f, o1b = 0.f, o2a = 0.f, o2b = 0.f;
                for (int j0 = 0; j0 <= i; j0 += 64) {
                    const int j = j0 + lane;
                    const bf16_t* kp = Udiff + ((size_t)b * SEQ + j) * 1536 + 512 + h * 128;
                    float s1 = 0.f, s2 = 0.f;
#pragma unroll
                    for (int d = 0; d < 64; d += 8) { const u32x4 kv = *(const u32x4*)(kp + d); const f32x4 qa = *(const LAS f32x4*)(qs + d), qb = *(const LAS f32x4*)(qs + d + 4);
                        s1 += qa.x * lo_bf(kv.x) + qa.y * hi_bf(kv.x) + qa.z * lo_bf(kv.y) + qa.w * hi_bf(kv.y) + qb.x * lo_bf(kv.z) + qb.y * hi_bf(kv.z) + qb.z * lo_bf(kv.w) + qb.w * hi_bf(kv.w); }
#pragma unroll
                    for (int d = 0; d < 64; d += 8) { const u32x4 kv = *(const u32x4*)(kp + 64 + d); const f32x4 qa = *(const LAS f32x4*)(qs + 64 + d), qb = *(const LAS f32x4*)(qs + 64 + d + 4);
                        s2 += qa.x * lo_bf(kv.x) + qa.y * hi_bf(kv.x) + qa.z * lo_bf(kv.y) + qa.w * hi_bf(kv.y) + qb.x * lo_bf(kv.z) + qb.y * hi_bf(kv.z) + qb.z * lo_bf(kv.w) + qb.w * hi_bf(kv.w); }
                    const bool ok = (j <= i);
                    s1 = ok ? s1 * 0.125f : -1e30f; s2 = ok ? s2 * 0.125f : -1e30f;
                    const float mn1 = fmaxf(m1, wave_max(s1)), al1 = __expf(m1 - mn1), p1 = ok ? __expf(s1 - mn1) : 0.f;
                    const float mn2 = fmaxf(m2, wave_max(s2)), al2 = __expf(m2 - mn2), p2 = ok ? __expf(s2 - mn2) : 0.f;
                    l1 = l1 * al1 + wave_sum(p1); l2 = l2 * al2 + wave_sum(p2); m1 = mn1; m2 = mn2;
                    o1a *= al1; o1b *= al1; o2a *= al2; o2b *= al2;
                    const bf16_t* vp = Udiff + ((size_t)b * SEQ + j0) * 1536 + 1024 + h * 128;
                    for (int jj = 0; jj < 64; ++jj) { const float pj1 = __shfl(p1, jj), pj2 = __shfl(p2, jj);
                        const float va = bf2f(vp[(size_t)jj * 1536 + lane]), vb = bf2f(vp[(size_t)jj * 1536 + 64 + lane]);
                        o1a += pj1 * va; o1b += pj1 * vb; o2a += pj2 * va; o2b += pj2 * vb; }
                }
                const float oa = o1a / l1 - lam * o2a / l2, ob = o1b / l1 - lam * o2b / l2;
                const float rstd = rsqrtf(wave_sum(oa * oa + ob * ob) * (1.f / 128.f) + 1e-6f);
                OB[m * 512 + h * 128 + lane] = (bf16_t)f2bf(oa * rstd * og0 * 0.8f); OB[m * 512 + h * 128 + 64 + lane] = (bf16_t)f2bf(ob * rstd * og1 * 0.8f);
            }
        }
    }
    SEAM(4);

    if constexpr (IN(5)) {
        bf16_t* Ugla = P_UGLA; float* OGLA = P_OGLA; bf16_t* OA = P_OA;
        const float* gog = (const float*)ARG_IN(I_GOG);
        for (int i = 0; i < 8; ++i) {
            const size_t m = (size_t)cb * 64 + wave * 8 + i; const int col0 = lane * 8;
            const f32x4 a = *(const f32x4*)(OGLA + m * 512 + col0), b2 = *(const f32x4*)(OGLA + m * 512 + col0 + 4);
            float ss = (a.x * a.x + a.y * a.y) + (a.z * a.z + a.w * a.w) + (b2.x * b2.x + b2.y * b2.y) + (b2.z * b2.z + b2.w * b2.w);
            ss += __shfl_xor(ss, 1); ss += __shfl_xor(ss, 2); ss += __shfl_xor(ss, 4); ss += __shfl_xor(ss, 8);
            const float rstd = rsqrtf(ss * (1.f / 128.f) + 1e-6f);
            const u32x4 rw = *(const u32x4*)(Ugla + m * 1536 + 1024 + col0);
            const f32x4 g0 = *(const f32x4*)(gog + (col0 & 127)), g1v = *(const f32x4*)(gog + (col0 & 127) + 4);
            f32x4 o0, o1;
            o0.x = a.x * rstd * g0.x * siluf_(lo_bf(rw.x)); o0.y = a.y * rstd * g0.y * siluf_(hi_bf(rw.x)); o0.z = a.z * rstd * g0.z * siluf_(lo_bf(rw.y)); o0.w = a.w * rstd * g0.w * siluf_(hi_bf(rw.y));
            o1.x = b2.x * rstd * g1v.x * siluf_(lo_bf(rw.z)); o1.y = b2.y * rstd * g1v.y * siluf_(hi_bf(rw.z)); o1.z = b2.z * rstd * g1v.z * siluf_(lo_bf(rw.w)); o1.w = b2.w * rstd * g1v.w * siluf_(hi_bf(rw.w));
            *(u32x4*)(OA + m * 512 + col0) = pg8::pack8(o0, o1);
        }
    }
    SEAM(5);

    if constexpr (IN(6)) {
        bf16_t* OA = P_OA; bf16_t* OB = P_OB; bf16_t* Wa_t = P_WA; bf16_t* Wb_t = P_WB; bf16_t* Ugate = P_UGATE; bf16_t* M1 = P_M1; bf16_t* MERGED = P_MERGED;
        { pg8::DenseOrder S; S.init(OA, Wa_t, M, D, 512, G, cb); pg8::EpiBranch E{Ugate, 0, nullptr, M1};
          pg8::gemm_phase<pg8::EpiBranch, pg8::DenseOrder, true, true>(lds, 512, S, E); }
        VM_WAIT(); __syncthreads();
        { pg8::DenseOrder S; S.init(OB, Wb_t, M, D, 512, G, cb); pg8::EpiBranch E{Ugate, 1024, M1, MERGED};
          pg8::gemm_phase<pg8::EpiBranch, pg8::DenseOrder, true, true>(lds, 512, S, E); }
    }
    SEAM(6);

    if constexpr (IN(7)) {
        const float* x = XIN; float* out = OUTP; float* modf = P_MODF; bf16_t* MERGED = P_MERGED; bf16_t* Wout_t = P_WOUT;
        pg8::DenseOrder S; S.init(MERGED, Wout_t, M, D, D, G, cb); pg8::EpiWout E{x, modf, out};
        pg8::gemm_phase<pg8::EpiWout, pg8::DenseOrder, true, true>(lds, D, S, E);
    }
    SEAM(7);

    if constexpr (IN(8)) {
        float* out = OUTP; float* modf = P_MODF; bf16_t* H2 = P_H2; bf16_t* W13_t = P_W13; bf16_t* W2_t = P_W2; int* tok_e = P_TOKE; float* tok_w = P_TOKW; int* tok_rank = P_RANK; int* blkcnt = P_BLKCNT;
        const float* g2 = (const float*)ARG_IN(I_N2G);
        const float* Wrg = (const float*)ARG_IN(I_RGW); const float* brg = (const float*)ARG_IN(I_RGB); const float* Wre = (const float*)ARG_IN(I_REW); const float* bre = (const float*)ARG_IN(I_REB);
        LAS float* modS = (LAS float*)lds;
        LAS float* h2s = (LAS float*)(lds + 8192) + wave * 1024;
        LAS int* eS = (LAS int*)(lds + 8192 + 32768);
        const int b = cb >> 6;
        for (int j = tid; j < 2048; j += NTHR) modS[j] = modf[(size_t)b * NMOD + 3 * D + j] + (j >= D ? 1.0f : 0.f);
        __syncthreads();
        for (int i = 0; i < 8; ++i) {
            const int tl = wave * 8 + i; const size_t m = (size_t)cb * 64 + tl;
            const f32x4* xr = (const f32x4*)(out + m * D) + lane;
            f32x4 v[4]; float ss = 0.f;
#pragma unroll
            for (int j = 0; j < 4; ++j) { v[j] = xr[64 * j]; ss += (v[j].x * v[j].x + v[j].y * v[j].y) + (v[j].z * v[j].z + v[j].w * v[j].w); }
            const float rstd = rsqrtf(wave_sum(ss) * (1.f / D) + 1e-6f);
            unsigned long long* o8 = (unsigned long long*)(H2 + m * D) + lane;
#pragma unroll
            for (int j = 0; j < 4; ++j) { const int k = 4 * lane + 256 * j; const f32x4 gg = *(const f32x4*)(g2 + k); const f32x4 sh = *(const LAS f32x4*)(modS + k); const f32x4 sc = *(const LAS f32x4*)(modS + D + k);
                v[j] = v[j] * rstd * gg * sc + sh;
                o8[64 * j] = (unsigned long long)pk2(v[j].x, v[j].y) | ((unsigned long long)pk2(v[j].z, v[j].w) << 32);
                *(LAS f32x4*)(h2s + k) = v[j]; }
            LDS_WAIT();
            float le; { const int e = lane & 31, half = lane >> 5; float acc = 0.f;
                for (int kk = 0; kk < 512; ++kk) { const int k = half * 512 + kk; acc += h2s[k] * Wre[k * 32 + e]; }
                acc += __shfl_xor(acc, 32); le = acc + bre[e]; }
            float lg; { const int g = lane & 3, part = lane >> 2; float acc = 0.f;
                for (int kk = 0; kk < 64; ++kk) { const int k = part * 64 + kk; acc += h2s[k] * Wrg[k * 4 + g]; }
                acc += __shfl_xor(acc, 4); acc += __shfl_xor(acc, 8); acc += __shfl_xor(acc, 16); acc += __shfl_xor(acc, 32); lg = acc + brg[g]; }
            const float lg0 = __shfl(lg, 0), lg1 = __shfl(lg, 1), lg2 = __shfl(lg, 2), lg3 = __shfl(lg, 3);
            int gi = 0; float gm = lg0; if (lg1 > gm) { gm = lg1; gi = 1; } if (lg2 > gm) { gm = lg2; gi = 2; } if (lg3 > gm) { gm = lg3; gi = 3; }
            const float ptop = 1.0f / (__expf(lg0 - gm) + __expf(lg1 - gm) + __expf(lg2 - gm) + __expf(lg3 - gm));
            float el[8];
#pragma unroll
            for (int j = 0; j < 8; ++j) el[j] = __shfl(le, gi * 8 + j);
            int j0 = 0; float e0 = el[0];
#pragma unroll
            for (int j = 1; j < 8; ++j) if (el[j] > e0) { e0 = el[j]; j0 = j; }
            int j1 = -1; float e1 = -3.0e38f;
#pragma unroll
            for (int j = 0; j < 8; ++j) if (j != j0 && el[j] > e1) { e1 = el[j]; j1 = j; }
            const float t = __expf(e1 - e0), w0 = ptop / (1.0f + t), w1 = ptop * t / (1.0f + t);
            if (lane == 0) { eS[2 * tl] = gi * 8 + j0; eS[2 * tl + 1] = gi * 8 + j1; tok_w[m * 2] = w0; tok_w[m * 2 + 1] = w1; }
        }
        __syncthreads();
        if (tid < 128) { const int e = eS[tid]; int rank = 0; for (int a = 0; a < tid; ++a) rank += (eS[a] == e) ? 1 : 0;
            tok_e[(size_t)cb * 128 + tid] = e; tok_rank[(size_t)cb * 128 + tid] = rank; }
        else if (tid < 160) { const int e = tid - 128; int cnt = 0; for (int a = 0; a < 128; ++a) cnt += (eS[a] == e) ? 1 : 0; blkcnt[cb * 32 + e] = cnt; }
        __syncthreads();
        {
            const float* w1 = (const float*)ARG_IN(I_EW1); const float* w3 = (const float*)ARG_IN(I_EW3); const float* w2 = (const float*)ARG_IN(I_EW2);
            LAS float* scr = (LAS float*)(lds + wave * 16384);
            for (int it = gw; it < NEXP * 768; it += NGW) {
                const int e = it / 768, r = it % 768;
                if (r < 512) { const int kb = r >> 5, nb = r & 31, r0 = 32 * nb, pn = r0 >> 8, half = (r0 >> 7) & 1, jj = r0 & 127;
                    tr_item((half ? w3 : w1) + (size_t)e * D * DEXP, DEXP, 64 * kb, 128 * pn + jj, W13_t + (size_t)e * 1024 * 1024, D, r0, scr, lane); }
                else { const int r2 = r - 512, kb = r2 >> 5, nb = r2 & 31;
                    tr_item(w2 + (size_t)e * DEXP * D, D, 64 * kb, 32 * nb, W2_t + (size_t)e * 1024 * 512, DEXP, 32 * nb, scr, lane); }
            }
        }
    }
    SEAM(8);

    if constexpr (IN(9)) {
        bf16_t* H2 = P_H2; bf16_t* XS = P_XS; int* tok_e = P_TOKE; int* tok_rank = P_RANK; int* tok_slot = P_SLOT; int* blkcnt = P_BLKCNT; int* tile_e = P_TILEE; int* ntiles_p = P_NT;
        LAS int* red = (LAS int*)lds;
        LAS int* totS = red + 1024;
        LAS int* preS = totS + 32;
        LAS int* padS = preS + 32;
        LAS int* slotS = padS + 64;
        { const int e = tid & 31, part = tid >> 5; int tot = 0, pre = 0;
            for (int blk = part; blk < 256; blk += 16) { const int cval = blkcnt[blk * 32 + e]; tot += cval; pre += (blk < cb) ? cval : 0; }
            red[part * 64 + e] = tot; red[part * 64 + 32 + e] = pre; }
        __syncthreads();
        if (tid < 32) { int tot = 0, pre = 0; for (int p = 0; p < 16; ++p) { tot += red[p * 64 + tid]; pre += red[p * 64 + 32 + tid]; } totS[tid] = tot; preS[tid] = pre; }
        __syncthreads();
        if (tid == 0) { int off = 0; for (int e = 0; e < 32; ++e) { padS[e] = off; off += ((totS[e] + 255) >> 8) << 8; } padS[32] = off; }
        __syncthreads();
        if (cb == 0) { if (tid < 32) { for (int t = padS[tid] >> 8; t < (padS[tid + 1] >> 8); ++t) tile_e[t] = tid; } if (tid == 32) ntiles_p[0] = padS[32] >> 8; }
        if (tid < 128) { const size_t a = (size_t)cb * 128 + tid; const int e = tok_e[a]; const int slot = padS[e] + preS[e] + tok_rank[a]; tok_slot[a] = slot; slotS[tid] = slot; }
        __syncthreads();
        for (int a = wave * 16; a < wave * 16 + 16; ++a) { const size_t t = (size_t)cb * 64 + (a >> 1); const int slot = slotS[a];
            const u32x4* src = (const u32x4*)(H2 + t * D) + lane; u32x4* dst = (u32x4*)(XS + (size_t)slot * D) + lane;
            dst[0] = src[0]; dst[64] = src[64]; }
        if (cb < 32) { const int r0 = padS[cb] + totS[cb], r1 = padS[cb + 1];
            for (int r = r0 + wave; r < r1; r += NWAVES) { u32x4* dst = (u32x4*)(XS + (size_t)r * D) + lane; dst[0] = (u32x4){0, 0, 0, 0}; dst[64] = (u32x4){0, 0, 0, 0}; } }
    }
    SEAM(9);

    if constexpr (IN(10)) {
        bf16_t* XS = P_XS; bf16_t* W13_t = P_W13; bf16_t* HMID = P_HMID; int* tile_e = P_TILEE; int* ntiles_p = P_NT;
        const int ntm = __builtin_amdgcn_readfirstlane(ntiles_p[0]);
        pg8::MoeOrder S; S.init(XS, W13_t, tile_e, ntm, D, (size_t)1024 * 1024 * 2, G, cb); pg8::EpiUp E{HMID};
        pg8::gemm_phase<pg8::EpiUp, pg8::MoeOrder, true, true>(lds, D, S, E);
    }
    SEAM(10);

    if constexpr (IN(11)) {
        bf16_t* HMID = P_HMID; bf16_t* W2_t = P_W2; bf16_t* Y = P_Y; int* tile_e = P_TILEE; int* ntiles_p = P_NT;
        const int ntm = __builtin_amdgcn_readfirstlane(ntiles_p[0]);
        pg8::MoeOrder S; S.init(HMID, W2_t, tile_e, ntm, DEXP, (size_t)1024 * 512 * 2, G, cb); pg8::EpiPlain E{Y, D};
        pg8::gemm_phase<pg8::EpiPlain, pg8::MoeOrder, true, true>(lds, DEXP, S, E);
    }
    SEAM(11);

    if constexpr (IN(12)) {
        float* out = OUTP; float* modf = P_MODF; bf16_t* Y = P_Y; int* tok_slot = P_SLOT; float* tok_w = P_TOKW;
        for (int i = 0; i < 8; ++i) {
            const size_t m = (size_t)cb * 64 + wave * 8 + i; const int b = cb >> 6;
            const int s0 = tok_slot[m * 2], s1 = tok_slot[m * 2 + 1]; const float w0 = tok_w[m * 2], w1 = tok_w[m * 2 + 1];
            const float* g2p = modf + (size_t)b * NMOD + 5 * D;
#pragma unroll
            for (int j = 0; j < 4; ++j) { const int k = 4 * lane + 256 * j;
                const f32x4 xv = *(const f32x4*)(out + m * D + k); const f32x4 gv = *(const f32x4*)(g2p + k);
                const u32x2 y0 = *(const u32x2*)(Y + (size_t)s0 * D + k), y1 = *(const u32x2*)(Y + (size_t)s1 * D + k);
                f32x4 o; o.x = xv.x + gv.x * (w0 * lo_bf(y0.x) + w1 * lo_bf(y1.x)); o.y = xv.y + gv.y * (w0 * hi_bf(y0.x) + w1 * hi_bf(y1.x));
                o.z = xv.z + gv.z * (w0 * lo_bf(y0.y) + w1 * lo_bf(y1.y)); o.w = xv.w + gv.w * (w0 * hi_bf(y0.y) + w1 * hi_bf(y1.y));
                *(f32x4*)(out + m * D + k) = o; }
        }
    }
#undef IN
#undef SEAM
}

constexpr int NPHASE = 13;
template <int LO, int HI> static void launch_range(const Args& a, hipStream_t stream) {
    static bool attr = false;
    if (!attr) { (void)hipFuncSetAttribute((const void*)mk_fwd<LO, HI>, hipFuncAttributeMaxDynamicSharedMemorySize, LDS_BYTES); attr = true; }
    hipLaunchKernelGGL((mk_fwd<LO, HI>), dim3(256), dim3(NTHR), LDS_BYTES, stream, a);
}
extern "C" void kernel_launch(void* const* d_in, const int* in_sizes, int n_in, void* d_out, int out_size, void* d_ws, size_t ws_size, hipStream_t stream) {
    static int ok = 0;
    if (ok == 0) {
        if (n_in != 28 || out_size != M * D || ws_size < WS_END) { fprintf(stderr, "kernel_launch: unexpected shapes (n_in %d, out %d, ws %zu < %zu)\n", n_in, out_size, ws_size, (size_t)WS_END); ok = -1; return; }
        ok = 1;
    }
    if (ok < 0) return;
    (void)hipMemsetAsync((char*)d_ws + WS_CTL, 0, CTL_ZERO_BYTES, stream);
    Args a{};
    for (int i = 0; i < 28; ++i) a.in[i] = d_in[i];
    a.out = (float*)d_out; a.ws = (unsigned char*)d_ws; a.ph_lo = 0; a.ph_hi = NPHASE;
#if MK_ONE_LAUNCH
    launch_range<0, NPHASE>(a, stream);
#else
    launch_range<0, 1>(a, stream); launch_range<1, 2>(a, stream); launch_range<2, 3>(a, stream); launch_range<3, 4>(a, stream);
    launch_range<4, 5>(a, stream); launch_range<5, 6>(a, stream); launch_range<6, 7>(a, stream); launch_range<7, 8>(a, stream);
    launch_range<8, 9>(a, stream); launch_range<9, 10>(a, stream); launch_range<10, 11>(a, stream); launch_range<11, 12>(a, stream);
    launch_range<12, 13>(a, stream);
#endif
}
```

```cpp
#include <hip/hip_runtime.h>
#include <hip/hip_bf16.h>
#include <cstdio>
#include <cstdint>

#ifndef MK_ONE_LAUNCH
#define MK_ONE_LAUNCH 1
#endif

#define LAS __attribute__((address_space(3)))
#define GAS __attribute__((address_space(1)))
typedef unsigned short bf16_t;
typedef short bf16x8 __attribute__((ext_vector_type(8)));
typedef float f32x4 __attribute__((ext_vector_type(4)));
typedef float f32x2 __attribute__((ext_vector_type(2)));
typedef unsigned u32x4 __attribute__((ext_vector_type(4)));
typedef unsigned u32x2 __attribute__((ext_vector_type(2)));

constexpr int NB = 4, SEQ = 4096, D = 1024, M = NB * SEQ;
constexpr int DIN = 5136, NPROJ = 5120;
constexpr int NEXP = 32, DEXP = 512;
constexpr int PMAX = 40960;
constexpr int NMOD = 6 * D;

constexpr size_t MiB = 1u << 20;
constexpr size_t WS_CTL = 0, CTL_ZERO_BYTES = 1 * MiB;
constexpr size_t WS_MODP = 1 * MiB;
constexpr size_t WS_MODF = 4 * MiB;
constexpr size_t WS_ALR = 5 * MiB;
constexpr size_t WS_ROUTE = 6 * MiB;
constexpr size_t WS_WIN = 8 * MiB;
constexpr size_t WS_WA = 18 * MiB, WS_WB = 19 * MiB, WS_WOUT = 20 * MiB;
constexpr size_t RA = 22 * MiB;
constexpr size_t RB = 118 * MiB;
constexpr size_t WS_END = 278 * MiB;
constexpr size_t WS_XN = RA;
constexpr size_t WS_LOGA = RA;
constexpr size_t WS_SCT = RA + 16 * MiB;
constexpr size_t WS_SPT = RA + 48 * MiB;
constexpr size_t WS_OC = RA + 64 * MiB;
constexpr size_t WS_DEC = 7 * MiB;
constexpr size_t WS_OB = RB + 64 * MiB;
constexpr size_t WS_OA = RB + 48 * MiB;
constexpr size_t WS_XS = RA;
constexpr size_t WS_Y = RA;
constexpr size_t WS_UGLA = RB;
constexpr size_t WS_UDIFF = RB + 48 * MiB;
constexpr size_t WS_UGATE = RB + 96 * MiB;
constexpr size_t WS_M1 = RA;
constexpr size_t WS_MERGED = RB;
constexpr size_t WS_H2 = RB;
constexpr size_t WS_W13 = RB + 64 * MiB;
constexpr size_t WS_W2 = RB + 128 * MiB;
constexpr size_t WS_HMID = RB;
constexpr size_t RT_TOKE = 0, RT_TOKW = 131072, RT_RANK = 262144, RT_SLOT = 393216, RT_BLKCNT = 524288, RT_TILEE = 557056, RT_NT = 561152;
constexpr int CW_BAR = 4096;

constexpr int RING_BYTES = 131072;
constexpr int LDSCTL_OFF = RING_BYTES, MISC_OFF = LDSCTL_OFF + 320;
constexpr int LDS_BYTES = 147456;
constexpr int NWAVES = 8, NTHR = 512;

__device__ __forceinline__ float bf2f(bf16_t h) { return __uint_as_float((unsigned)h << 16); }
__device__ __forceinline__ unsigned f2bf(float f) { unsigned u = __float_as_uint(f); return (u + 0x7fffu + ((u >> 16) & 1u)) >> 16; }
__device__ __forceinline__ unsigned pk2(float lo, float hi) { return f2bf(lo) | (f2bf(hi) << 16); }
__device__ __forceinline__ float lo_bf(unsigned w) { return __uint_as_float(w << 16); }
__device__ __forceinline__ float hi_bf(unsigned w) { return __uint_as_float(w & 0xffff0000u); }
__device__ __forceinline__ float wave_sum(float v) {
#pragma unroll
    for (int o = 1; o < 64; o <<= 1) v += __shfl_xor(v, o);
    return v;
}
__device__ __forceinline__ float wave_max(float v) {
#pragma unroll
    for (int o = 1; o < 64; o <<= 1) v = fmaxf(v, __shfl_xor(v, o));
    return v;
}
__device__ __forceinline__ float sigmoidf_(float x) { return 1.0f / (1.0f + __expf(-x)); }
__device__ __forceinline__ float siluf_(float x) { return x / (1.0f + __expf(-x)); }
#define LDS_WAIT() asm volatile("s_waitcnt lgkmcnt(0)" ::: "memory")
#define VM_WAIT() asm volatile("s_waitcnt vmcnt(0)" ::: "memory")

namespace pg8 {
constexpr int BM = 256, BK = 64, HALF = 128, HTB = HALF * BK * 2, STAGE_BYTES = 8 * HTB, NXCD = 8, WGM = 8;
__host__ __device__ __forceinline__ int lds_byte(int r, int c) { const int st = (r >> 4) * 2 + (c >> 5), rr = r & 15, cc = c & 31, ob = rr * 64 + cc * 2; return st * 1024 + (ob ^ (((ob >> 9) & 1) << 5)); }
__host__ __device__ __forceinline__ void stage_rc(int b, int& R, int& C) { const int st = b / 1024, sb = b % 1024, swz = sb ^ (((sb >> 9) & 1) << 5); R = (st >> 1) * 16 + swz / 64; C = (st & 1) * 32 + (swz % 64) / 2; }
__host__ __device__ __forceinline__ int perm32(int rho) { const int n = rho >> 4, i = rho & 15; return 8 * (i >> 2) + 4 * n + (i & 3); }

struct Unit { int pm, pn, aux; };

__device__ __forceinline__ int xcd_swizzle(int wgid, int nwg) { const int q = nwg / NXCD, r = nwg % NXCD, xcd = wgid % NXCD, off = wgid / NXCD; return (xcd < r ? xcd * (q + 1) : r * (q + 1) + (xcd - r) * q) + off; }

struct DenseOrder {
    const char* A; const char* Bt; size_t tstep; int nM, nN, nwg, G, c;
    __device__ __forceinline__ void init(const void* A_, const void* Bt_, int M_, int N_, int K_, int G_, int c_) { A = (const char*)A_; Bt = (const char*)Bt_; tstep = (size_t)BM * K_ * 2; nM = M_ / BM; nN = N_ / BM; nwg = nM * nN; G = G_; c = c_; }
    __device__ __forceinline__ bool next(int i, Unit& u) const {
        const long L = (long)i * G + c; if (L >= nwg) return false;
        const int wgid = xcd_swizzle((int)L, nwg);
        const int nig = WGM * nN, gid = wgid / nig, fm = gid * WGM, gsz = (nM - fm) < WGM ? (nM - fm) : WGM;
        u.pm = fm + ((wgid % nig) % gsz); u.pn = (wgid % nig) / gsz; u.aux = 0; return true;
    }
    __device__ __forceinline__ const char* a_ptr(const Unit& u) const { return A + (size_t)u.pm * tstep; }
    __device__ __forceinline__ const char* b_ptr(const Unit& u) const { return Bt + (size_t)u.pn * tstep; }
};
struct MoeOrder {
    const char* A; const char* W; const int* tile_e; size_t tstep, estride; int nwg, G, c;
    __device__ __forceinline__ void init(const void* A_, const void* W_, const int* te, int ntm, int K_, size_t estride_, int G_, int c_) { A = (const char*)A_; W = (const char*)W_; tile_e = te; tstep = (size_t)BM * K_ * 2; estride = estride_; nwg = ntm * 4; G = G_; c = c_; }
    __device__ __forceinline__ bool next(int i, Unit& u) const {
        const long L = (long)i * G + c; if (L >= nwg) return false;
        const int wgid = xcd_swizzle((int)L, nwg);
        u.pm = wgid >> 2; u.pn = wgid & 3; u.aux = __builtin_amdgcn_readfirstlane(tile_e[u.pm]); return true;
    }
    __device__ __forceinline__ const char* a_ptr(const Unit& u) const { return A + (size_t)u.pm * tstep; }
    __device__ __forceinline__ const char* b_ptr(const Unit& u) const { return W + (size_t)u.aux * estride + (size_t)u.pn * tstep; }
};

__device__ __forceinline__ u32x4 pack8(const f32x4& v0, const f32x4& v1) { u32x4 w; w.x = pk2(v0[0], v0[1]); w.y = pk2(v0[2], v0[3]); w.z = pk2(v1[0], v1[1]); w.w = pk2(v1[2], v1[3]); return w; }

struct EpiInProj {
    static constexpr bool PERM = true, AFTER_DRAIN = false;
    bf16_t *Ugla, *Udiff, *Ugate;
    __device__ __forceinline__ void operator()(const f32x4 (&acc)[2][2][4][2], const Unit& u, int wr, int wc, int fr, int fq) const {
        bf16_t* base; int ldc, colt;
        if (u.pn < 6) { base = Ugla; ldc = 1536; colt = u.pn * 256; } else if (u.pn < 12) { base = Udiff; ldc = 1536; colt = (u.pn - 6) * 256; } else { base = Ugate; ldc = 2048; colt = (u.pn - 12) * 256; }
        const int row0 = u.pm * BM + wr * 64 + fr, col0 = colt + wc * 32 + 8 * fq;
#pragma unroll
        for (int ai = 0; ai < 2; ++ai)
#pragma unroll
            for (int m = 0; m < 4; ++m) { bf16_t* rowp = base + (size_t)(row0 + ai * HALF + m * 16) * ldc + col0;
#pragma unroll
                for (int bj = 0; bj < 2; ++bj) *(u32x4*)(rowp + bj * HALF) = pack8(acc[ai][bj][m][0], acc[ai][bj][m][1]); }
    }
};
struct EpiPlain {
    static constexpr bool PERM = true, AFTER_DRAIN = false;
    bf16_t* O; int ldc;
    __device__ __forceinline__ void operator()(const f32x4 (&acc)[2][2][4][2], const Unit& u, int wr, int wc, int fr, int fq) const {
        const int row0 = u.pm * BM + wr * 64 + fr, col0 = u.pn * BM + wc * 32 + 8 * fq;
#pragma unroll
        for (int ai = 0; ai < 2; ++ai)
#pragma unroll
            for (int m = 0; m < 4; ++m) { bf16_t* rowp = O + (size_t)(row0 + ai * HALF + m * 16) * ldc + col0;
#pragma unroll
                for (int bj = 0; bj < 2; ++bj) *(u32x4*)(rowp + bj * HALF) = pack8(acc[ai][bj][m][0], acc[ai][bj][m][1]); }
    }
};
struct EpiBranch {
    static constexpr bool PERM = true, AFTER_DRAIN = false;
    const bf16_t* gate; int gcol0; const bf16_t* m1in; bf16_t* out;
    __device__ __forceinline__ void operator()(const f32x4 (&acc)[2][2][4][2], const Unit& u, int wr, int wc, int fr, int fq) const {
        const int row0 = u.pm * BM + wr * 64 + fr, col0 = u.pn * BM + wc * 32 + 8 * fq;
#pragma unroll
        for (int ai = 0; ai < 2; ++ai)
#pragma unroll
            for (int m = 0; m < 4; ++m) { const size_t r = (size_t)(row0 + ai * HALF + m * 16);
#pragma unroll
                for (int bj = 0; bj < 2; ++bj) { const int c = col0 + bj * HALF;
                    const u32x4 g = *(const u32x4*)(gate + r * 2048 + gcol0 + c);
                    f32x4 v0 = acc[ai][bj][m][0], v1 = acc[ai][bj][m][1];
                    v0[0] *= sigmoidf_(lo_bf(g.x)); v0[1] *= sigmoidf_(hi_bf(g.x)); v0[2] *= sigmoidf_(lo_bf(g.y)); v0[3] *= sigmoidf_(hi_bf(g.y));
                    v1[0] *= sigmoidf_(lo_bf(g.z)); v1[1] *= sigmoidf_(hi_bf(g.z)); v1[2] *= sigmoidf_(lo_bf(g.w)); v1[3] *= sigmoidf_(hi_bf(g.w));
                    if (m1in) { const u32x4 p = *(const u32x4*)(m1in + r * 1024 + c);
                        v0[0] += lo_bf(p.x); v0[1] += hi_bf(p.x); v0[2] += lo_bf(p.y); v0[3] += hi_bf(p.y); v1[0] += lo_bf(p.z); v1[1] += hi_bf(p.z); v1[2] += lo_bf(p.w); v1[3] += hi_bf(p.w); }
                    *(u32x4*)(out + r * 1024 + c) = pack8(v0, v1); } }
    }
};
struct EpiWout {
    static constexpr bool PERM = false, AFTER_DRAIN = false;
    const float* x; const float* modf; float* out;
    __device__ __forceinline__ void operator()(const f32x4 (&acc)[2][2][4][2], const Unit& u, int wr, int wc, int fr, int fq) const {
        const int row0 = u.pm * BM + wr * 64 + fr, col0 = u.pn * BM + wc * 32 + 4 * fq;
        const float* g1 = modf + (size_t)((u.pm * BM) >> 12) * NMOD + 2 * D;
#pragma unroll
        for (int bj = 0; bj < 2; ++bj)
#pragma unroll
            for (int n = 0; n < 2; ++n) { const int c = col0 + bj * HALF + n * 16; const f32x4 gv = *(const f32x4*)(g1 + c);
#pragma unroll
                for (int ai = 0; ai < 2; ++ai)
#pragma unroll
                    for (int m = 0; m < 4; ++m) { const size_t off = (size_t)(row0 + ai * HALF + m * 16) * D + c;
                        const f32x4 xv = *(const f32x4*)(x + off); *(f32x4*)(out + off) = xv + gv * acc[ai][bj][m][n]; } }
    }
};
struct EpiUp {
    static constexpr bool PERM = true, AFTER_DRAIN = false;
    bf16_t* H;
    __device__ __forceinline__ void operator()(const f32x4 (&acc)[2][2][4][2], const Unit& u, int wr, int wc, int fr, int fq) const {
        const int row0 = u.pm * BM + wr * 64 + fr, col0 = u.pn * HALF + wc * 32 + 8 * fq;
#pragma unroll
        for (int ai = 0; ai < 2; ++ai)
#pragma unroll
            for (int m = 0; m < 4; ++m) { f32x4 v0, v1;
#pragma unroll
                for (int e = 0; e < 4; ++e) { v0[e] = siluf_(acc[ai][0][m][0][e]) * acc[ai][1][m][0][e]; v1[e] = siluf_(acc[ai][0][m][1][e]) * acc[ai][1][m][1][e]; }
                *(u32x4*)(H + (size_t)(row0 + ai * HALF + m * 16) * DEXP + col0) = pack8(v0, v1); }
    }
};

template <class Epi, class Sched, bool ALIGN_EPI = false, bool SP2 = false>
__device__ __forceinline__ void gemm_phase(LAS unsigned char* lds, const int K, const Sched& S, const Epi& E) {
    int tid_ = threadIdx.x; asm volatile("" : "+v"(tid_));
    const int tid = tid_, wid = __builtin_amdgcn_readfirstlane(tid >> 6), lane = tid & 63, wr = wid >> 2, wc = wid & 3, fr = lane & 15, fq = lane >> 4;
    const int nt = K / BK;
    unsigned voffA[2], voffB[2];
#pragma unroll
    for (int i = 0; i < 2; ++i) { int R, C; stage_rc(tid * 16 + i * 8192, R, C); const int Rb = Epi::PERM ? ((R & ~31) + perm32(R & 31)) : R;
        voffA[i] = (unsigned)(R * K + C) * 2u; voffB[i] = (unsigned)(Rb * K + C) * 2u; }
    const size_t kstep = (size_t)(BK * 2);
    const size_t hstep = (size_t)HALF * K * 2;
    const unsigned ldsw = (unsigned)wid * 1024u;
    const int aoff = lds_byte(wr * 64 + fr, fq * 8), boff = lds_byte(wc * 32 + fr, fq * 8);
#define PG8_SA(b, h) (((b) * 2 + (h)) * HTB)
#define PG8_SB(b, h) ((4 + (b) * 2 + (h)) * HTB)
#define PG8_STAGE(bufoff, gbase, voff) do { _Pragma("unroll") for (int _i = 0; _i < 2; ++_i) \
        __builtin_amdgcn_global_load_lds((const unsigned*)((const char*)(gbase) + (voff)[_i]), (LAS unsigned*)(lds + (bufoff) + ldsw + _i * 8192), 16, 0, 0); } while (0)
#define PG8_LDA(dst, b, h) do { _Pragma("unroll") for (int m = 0; m < 4; ++m) _Pragma("unroll") for (int k = 0; k < 2; ++k) dst[m][k] = *(const LAS bf16x8*)(lds + PG8_SA(b, h) + aoff + m * 2048 + k * 1024); } while (0)
#define PG8_LDB(dst, b, h) do { _Pragma("unroll") for (int n = 0; n < 2; ++n) _Pragma("unroll") for (int k = 0; k < 2; ++k) dst[n][k] = *(const LAS bf16x8*)(lds + PG8_SB(b, h) + boff + n * 2048 + k * 1024); } while (0)
#define PG8_MMA(ai, bj, At, Bt) do { __builtin_amdgcn_s_setprio(1); _Pragma("unroll") for (int m = 0; m < 4; ++m) _Pragma("unroll") for (int n = 0; n < 2; ++n) _Pragma("unroll") for (int k = 0; k < 2; ++k) \
        acc[ai][bj][m][n] = __builtin_amdgcn_mfma_f32_16x16x32_bf16(Bt[n][k], At[m][k], acc[ai][bj][m][n], 0, 0, 0); __builtin_amdgcn_s_setprio(0); } while (0)
#define PG8_WAIT_V(n) asm volatile("s_waitcnt vmcnt(" #n ")" ::: "memory")
#define PG8_WAIT_L(n) asm volatile("s_waitcnt lgkmcnt(" #n ")" ::: "memory")
#define PG8_BAR __builtin_amdgcn_s_barrier()
#define PG8_SCHED __builtin_amdgcn_sched_barrier(0)
    Unit cur, nxt; int ui = 0;
    if (!S.next(0, cur)) return;
    f32x4 acc[2][2][4][2];
#pragma unroll
    for (int a = 0; a < 2; ++a)
#pragma unroll
        for (int b = 0; b < 2; ++b)
#pragma unroll
            for (int m = 0; m < 4; ++m)
#pragma unroll
                for (int n = 0; n < 2; ++n) acc[a][b][m][n] = (f32x4){0.f, 0.f, 0.f, 0.f};
    bf16x8 At[4][2], B0[2][2], B1[2][2];
    const char* cA = S.a_ptr(cur); const char* cB = S.b_ptr(cur);
    if constexpr (SP2) {
        PG8_STAGE(PG8_SB(0, 0), cB, voffB); PG8_STAGE(PG8_SB(0, 1), cB + hstep, voffB); PG8_STAGE(PG8_SA(0, 0), cA, voffA); PG8_STAGE(PG8_SA(0, 1), cA + hstep, voffA);
        if (wr == 1) PG8_BAR;
        PG8_WAIT_V(2); PG8_BAR;
        PG8_STAGE(PG8_SB(1, 0), cB + kstep, voffB); PG8_STAGE(PG8_SA(1, 0), cA + kstep, voffA); PG8_STAGE(PG8_SB(1, 1), cB + hstep + kstep, voffB);
        PG8_WAIT_V(6); PG8_BAR;
    } else {
        PG8_STAGE(PG8_SB(0, 0), cB, voffB); PG8_STAGE(PG8_SA(0, 0), cA, voffA); PG8_STAGE(PG8_SB(0, 1), cB + hstep, voffB); PG8_STAGE(PG8_SA(0, 1), cA + hstep, voffA);
        if (wr == 1) PG8_BAR;
        PG8_WAIT_V(4); PG8_BAR;
        PG8_STAGE(PG8_SB(1, 0), cB + kstep, voffB); PG8_STAGE(PG8_SA(1, 0), cA + kstep, voffA); PG8_STAGE(PG8_SB(1, 1), cB + hstep + kstep, voffB);
        PG8_WAIT_V(6); PG8_BAR;
    }
    for (;;) {
        const bool has_next = S.next(ui + 1, nxt);
        const char* nA = has_next ? S.a_ptr(nxt) : cA; const char* nB = has_next ? S.b_ptr(nxt) : cB;
        for (int t = 0; t < nt; t += 2) {
            const bool last = (t == nt - 2);
            const char* a1 = cA + (size_t)(t + 1) * kstep;
            const char* a2 = last ? nA : cA + (size_t)(t + 2) * kstep; const char* b2 = last ? nB : cB + (size_t)(t + 2) * kstep;
            const char* a3 = a2 + kstep; const char* b3 = b2 + kstep;
            if constexpr (SP2) {
            PG8_LDB(B0, 0, 0); PG8_LDB(B1, 0, 1); PG8_SCHED; PG8_LDA(At, 0, 0); PG8_STAGE(PG8_SA(1, 1), a1 + hstep, voffA);
            PG8_WAIT_V(8); PG8_WAIT_L(0); PG8_BAR; PG8_MMA(0, 0, At, B0); PG8_MMA(0, 1, At, B1); PG8_BAR; PG8_SCHED;
            PG8_LDA(At, 0, 1); PG8_STAGE(PG8_SB(0, 0), b2, voffB); PG8_STAGE(PG8_SB(0, 1), b2 + hstep, voffB); PG8_STAGE(PG8_SA(0, 0), a2, voffA);
            PG8_WAIT_V(8); PG8_WAIT_L(0); PG8_BAR; PG8_MMA(1, 0, At, B0); PG8_MMA(1, 1, At, B1); PG8_BAR; PG8_SCHED;
            PG8_LDB(B0, 1, 0); PG8_LDB(B1, 1, 1); PG8_SCHED; PG8_LDA(At, 1, 0); PG8_STAGE(PG8_SA(0, 1), a2 + hstep, voffA);
            PG8_WAIT_V(8); PG8_WAIT_L(0); PG8_BAR; PG8_MMA(0, 0, At, B0); PG8_MMA(0, 1, At, B1); PG8_BAR; PG8_SCHED;
            PG8_LDA(At, 1, 1); PG8_STAGE(PG8_SB(1, 0), b3, voffB); PG8_STAGE(PG8_SB(1, 1), b3 + hstep, voffB); PG8_STAGE(PG8_SA(1, 0), a3, voffA);
            PG8_WAIT_V(8); PG8_WAIT_L(0); PG8_BAR; PG8_MMA(1, 0, At, B0); PG8_MMA(1, 1, At, B1); PG8_BAR; PG8_SCHED;
            } else {
            PG8_LDB(B0, 0, 0); PG8_SCHED; PG8_LDA(At, 0, 0); PG8_STAGE(PG8_SA(1, 1), a1 + hstep, voffA);
            PG8_WAIT_L(8); PG8_BAR; PG8_WAIT_L(0); PG8_MMA(0, 0, At, B0); PG8_BAR; PG8_SCHED;
            PG8_LDB(B1, 0, 1); PG8_STAGE(PG8_SB(0, 0), b2, voffB);
            PG8_BAR; PG8_WAIT_L(0); PG8_MMA(0, 1, At, B1); PG8_BAR;
            PG8_LDA(At, 0, 1); PG8_STAGE(PG8_SA(0, 0), a2, voffA);
            PG8_BAR; PG8_WAIT_L(0); PG8_MMA(1, 0, At, B0); PG8_BAR; PG8_SCHED;
            PG8_STAGE(PG8_SB(0, 1), b2 + hstep, voffB);
            PG8_WAIT_V(6); PG8_BAR; PG8_MMA(1, 1, At, B1); PG8_BAR;
            PG8_LDB(B0, 1, 0); PG8_SCHED; PG8_LDA(At, 1, 0); PG8_STAGE(PG8_SA(0, 1), a2 + hstep, voffA);
            PG8_WAIT_L(8); PG8_BAR; PG8_WAIT_L(0); PG8_MMA(0, 0, At, B0); PG8_BAR; PG8_SCHED;
            PG8_LDB(B1, 1, 1); PG8_STAGE(PG8_SB(1, 0), b3, voffB);
            PG8_BAR; PG8_WAIT_L(0); PG8_MMA(0, 1, At, B1); PG8_BAR;
            PG8_LDA(At, 1, 1); PG8_STAGE(PG8_SA(1, 0), a3, voffA);
            PG8_BAR; PG8_WAIT_L(0); PG8_MMA(1, 0, At, B0); PG8_BAR; PG8_SCHED;
            PG8_STAGE(PG8_SB(1, 1), b3 + hstep, voffB);
            PG8_WAIT_V(6); PG8_BAR; PG8_MMA(1, 1, At, B1); PG8_BAR;
            }
        }
        if constexpr (ALIGN_EPI) { if (wr == 0) PG8_BAR; }
        E(acc, cur, wr, wc, fr, fq);
        if (!has_next) break;
#pragma unroll
        for (int a = 0; a < 2; ++a)
#pragma unroll
            for (int b = 0; b < 2; ++b)
#pragma unroll
                for (int m = 0; m < 4; ++m)
#pragma unroll
                    for (int n = 0; n < 2; ++n) acc[a][b][m][n] = (f32x4){0.f, 0.f, 0.f, 0.f};
        cur = nxt; cA = nA; cB = nB; ++ui;
        if constexpr (ALIGN_EPI) { if (wr == 1) PG8_BAR; }
    }
    PG8_WAIT_V(0);
    if constexpr (!ALIGN_EPI) { if (wr == 0) PG8_BAR; }
    PG8_BAR;
#undef PG8_SA
#undef PG8_SB
#undef PG8_STAGE
#undef PG8_LDA
#undef PG8_LDB
#undef PG8_MMA
#undef PG8_WAIT_V
#undef PG8_WAIT_L
#undef PG8_BAR
#undef PG8_SCHED
}
}

namespace attn_body {
using bf16=__hip_bfloat16;
using bf16x8=__attribute__((ext_vector_type(8)))short;
using s16x4=__attribute__((ext_vector_type(4)))short;
using f32x16=__attribute__((ext_vector_type(16)))float;
using u32x4=__attribute__((ext_vector_type(4)))unsigned;
constexpr int SEQ=4096,D=64,DM=1536,DMO=512;
constexpr int NW=8,QBLK=32,QB=QBLK*NW,KVBLK=64,NQB=SEQ/QB;
constexpr int ATTN_UNIT_ROWS=QB;
__device__ __forceinline__ int crow(int r,int hi){return (r&3)+8*(r>>2)+4*hi;}
#define SBAR() __builtin_amdgcn_sched_barrier(0)
__device__ __forceinline__ void cmask(f32x16&p0,f32x16&p1,int jb,int qrel,int hi){
  const float NEG=-INFINITY; int kb=64*jb+4*hi;
  #pragma unroll
  for(int r=0;r<16;++r){int kv=kb+(r&3)+8*(r>>2); if(kv>qrel)p0[r]=NEG; if(kv+32>qrel)p1[r]=NEG;}
}

constexpr int NSLOT=3, SLOTB=8192;
constexpr int LDS_K=0, LDS_V=NSLOT*SLOTB, LDS_WS=2*NSLOT*SLOTB, LDS_OST=LDS_WS+NW*64*4, LDS_BYTES=LDS_OST+NW*4096;
constexpr float C2=0.125f*1.4426950408889634f;
__device__ __forceinline__ void glds16(const void*gsrc,unsigned lds_dst){unsigned keep;
  asm volatile("s_mov_b32 %0, m0\n\ts_mov_b32 m0, %2\n\ts_nop 0\n\tglobal_load_lds_dwordx4 %1, off\n\ts_mov_b32 m0, %0":"=&s"(keep):"v"(gsrc),"s"(lds_dst):"memory");}
__device__ __forceinline__ float max3f(float a,float b,float c){float r;asm("v_max3_f32 %0, %1, %2, %3":"=v"(r):"v"(a),"v"(b),"v"(c));return r;}
__device__ __forceinline__ float max2f(float a,float b){float r;asm("v_max_f32_e32 %0, %1, %2":"=v"(r):"v"(a),"v"(b));return r;}
__device__ __forceinline__ float fadd_s(float a,float b){float r;asm("v_add_f32_e32 %0, %1, %2":"=v"(r):"v"(a),"v"(b));return r;}
__device__ __forceinline__ float fsub_s(float a,float b){float r;asm("v_sub_f32_e32 %0, %1, %2":"=v"(r):"v"(a),"v"(b));return r;}
typedef float f32x2_t __attribute__((ext_vector_type(2))); typedef __bf16 bf16x2_t __attribute__((ext_vector_type(2)));
__device__ __forceinline__ unsigned cvtpk_s(float lo,float hi){f32x2_t v={lo,hi};bf16x2_t b=__builtin_convertvector(v,bf16x2_t);return __builtin_bit_cast(unsigned,b);}
#define WAIT_BAR(N) asm volatile("s_waitcnt vmcnt(" #N ") lgkmcnt(0)\n\ts_barrier":::"memory")

__device__ __forceinline__ void qkt(f32x16&p0,f32x16&p1,const char*Kslot,const bf16x8*qr,const f32x16&negm,int r32,int hi){
  const char*kb=Kslot+hi*1024+r32*16;
  #pragma unroll
  for(int d0=0;d0<4;++d0){
    const bf16x8 b0=*reinterpret_cast<const bf16x8*>(kb+d0*2048);
    const bf16x8 b1=*reinterpret_cast<const bf16x8*>(kb+d0*2048+512);
    if(d0==0){p0=__builtin_amdgcn_mfma_f32_32x32x16_bf16(b0,qr[0],negm,0,0,0);p1=__builtin_amdgcn_mfma_f32_32x32x16_bf16(b1,qr[0],negm,0,0,0);}
    else{p0=__builtin_amdgcn_mfma_f32_32x32x16_bf16(b0,qr[d0],p0,0,0,0);p1=__builtin_amdgcn_mfma_f32_32x32x16_bf16(b1,qr[d0],p1,0,0,0);}}
}
typedef __attribute__((address_space(3))) const char* lds_cptr;
typedef short v4i16_t __attribute__((ext_vector_type(4)));
__device__ __forceinline__ void kload8(bf16x8*kf,lds_cptr kp){
  kf[0]=*(const __attribute__((address_space(3))) bf16x8*)(kp);      kf[1]=*(const __attribute__((address_space(3))) bf16x8*)(kp+512);
  kf[2]=*(const __attribute__((address_space(3))) bf16x8*)(kp+2048); kf[3]=*(const __attribute__((address_space(3))) bf16x8*)(kp+2560);
  kf[4]=*(const __attribute__((address_space(3))) bf16x8*)(kp+4096); kf[5]=*(const __attribute__((address_space(3))) bf16x8*)(kp+4608);
  kf[6]=*(const __attribute__((address_space(3))) bf16x8*)(kp+6144); kf[7]=*(const __attribute__((address_space(3))) bf16x8*)(kp+6656);
}
__device__ __forceinline__ void kload2(bf16x8*kf,lds_cptr kp,int j){ kf[2*j]=*(const __attribute__((address_space(3))) bf16x8*)(kp+j*2048); kf[2*j+1]=*(const __attribute__((address_space(3))) bf16x8*)(kp+j*2048+512); }
__device__ __forceinline__ s16x4 vtr(lds_cptr p){ return __builtin_bit_cast(s16x4,__builtin_amdgcn_ds_read_tr16_b64_v4i16((__attribute__((address_space(3))) v4i16_t*)p)); }
__device__ __forceinline__ float rowmax(const f32x16&p0,const f32x16&p1){
  float a=max3f(p0[0],p0[1],p1[0]),b=max3f(p0[2],p0[3],p1[1]);a=max3f(a,p1[2],p1[3]);
  #pragma unroll
  for(int r=4;r<16;r+=4){a=max3f(a,p0[r],p0[r+1]);b=max3f(b,p0[r+2],p0[r+3]);a=max3f(a,p1[r],p1[r+1]);b=max3f(b,p1[r+2],p1[r+3]);}
  const float m=max2f(a,b);
  auto rr=__builtin_amdgcn_permlane32_swap(__float_as_uint(m),__float_as_uint(m),false,false);
  return max2f(__uint_as_float(rr[0]),__uint_as_float(rr[1]));
}
__device__ __forceinline__ void pv(f32x16*o,int vb,bf16x8 pa0,bf16x8 pa1,bf16x8 pa2,bf16x8 pa3){
  #pragma unroll
  for(int d0=0;d0<2;++d0){s16x4 lo[4],hi[4];
    #pragma unroll
    for(int ks=0;ks<4;++ks){
      asm volatile("ds_read_b64_tr_b16 %0,%1 offset:%c2":"=&v"(lo[ks]):"v"(vb),"i"(d0*4096+ks*1024):"memory");
      asm volatile("ds_read_b64_tr_b16 %0,%1 offset:%c2":"=&v"(hi[ks]):"v"(vb),"i"(d0*4096+ks*1024+512):"memory");}
    asm volatile("s_waitcnt lgkmcnt(0)":::"memory");SBAR();
    #define PK(k) (bf16x8){lo[k][0],lo[k][1],lo[k][2],lo[k][3],hi[k][0],hi[k][1],hi[k][2],hi[k][3]}
    o[d0]=__builtin_amdgcn_mfma_f32_32x32x16_bf16(pa0,PK(0),o[d0],0,0,0);
    o[d0]=__builtin_amdgcn_mfma_f32_32x32x16_bf16(pa1,PK(1),o[d0],0,0,0);
    o[d0]=__builtin_amdgcn_mfma_f32_32x32x16_bf16(pa2,PK(2),o[d0],0,0,0);
    o[d0]=__builtin_amdgcn_mfma_f32_32x32x16_bf16(pa3,PK(3),o[d0],0,0,0);
    #undef PK
  }
}

#ifndef ATTN_STORE16
#define ATTN_STORE16(p,v) (*(u32x4*)(p)=(v))
#endif
template<int THRL> __device__ __forceinline__ void attn_unit(int b,int qcol,int kcol,int vcol,int ocol,int qb,const bf16*Q,const bf16*__restrict__ K,const bf16*__restrict__ V,bf16*O,char*shm){
  int tid_=threadIdx.x; asm volatile("":"+v"(tid_));
  const int tid=tid_,lane=tid&63,r32=lane&31,hi=lane>>5; const int wid=__builtin_amdgcn_readfirstlane(tid>>6);
  const long rowbase=(long)b*SEQ; const int q0=qb*QB;
  const bf16*Qw=Q+(rowbase+q0+wid*QBLK)*DM+qcol;
  const bf16*Kh=K+rowbase*DM+kcol,*Vh=V+rowbase*DM+vcol;
  const unsigned lds0=(unsigned)(uintptr_t)shm;
  float*wsf=(float*)(shm+LDS_WS)+wid*64;
  const bf16*ksrc=Kh+(long)lane*DM+wid*8;
  const bf16*vsrc=Vh+(long)(16*(wid&3)+(lane>>2))*DM+(wid>>2)*32+(lane&3)*8;
  const unsigned kdst=lds0+LDS_K+wid*1024, vdst=lds0+LDS_V+wid*1024;
  #define DMA_K(t,slot) glds16(ksrc+(long)(t)*KVBLK*DM,(unsigned)__builtin_amdgcn_readfirstlane(kdst+(slot)))
  #define DMA_V(t,slot) glds16(vsrc+(long)(t)*KVBLK*DM,(unsigned)__builtin_amdgcn_readfirstlane(vdst+(slot)))
  const int vb0=(int)(lds0+LDS_V)+((lane>>4)&1)*32+(lane&3)*8+(4*hi+((lane&15)>>2))*64;
  const char*Kbase=shm+LDS_K; bf16x8 kf[8];
  const lds_cptr shm3=(lds_cptr)shm; const lds_cptr kp0=shm3+LDS_K+hi*1024+r32*16; const lds_cptr vp0=shm3+LDS_V+((lane>>4)&1)*32+(lane&3)*8+(4*hi+((lane&15)>>2))*64;
  const int NT=(q0+QB)/KVBLK;
  DMA_K(0,0);DMA_V(0,0);DMA_K(1,SLOTB);
  bf16x8 qr[4];
  #pragma unroll
  for(int d0=0;d0<4;++d0)qr[d0]=*reinterpret_cast<const bf16x8*>(&Qw[(long)r32*DM+d0*16+hi*8]);
  float mhat=0.f,l_reg=0.f;f32x16 o[2];o[0]=f32x16{};o[1]=f32x16{};f32x16 negm=f32x16{};asm volatile("":"+v"(negm));
  const int qrel=wid*QBLK+r32;
  #define CMASK(P0,P1,t) do{int jb_=(t)-(NT-4); if(jb_>=0)cmask(P0,P1,jb_,qrel,hi);}while(0)
  bool resc=false;
  #define START(P0,P1) do{ const float rm=rowmax(P0,P1); resc=false; \
    { const float dl=rm; mhat=fadd_s(mhat,dl); \
      _Pragma("unroll") for(int r=0;r<16;++r){P0[r]=fsub_s(P0[r],dl);P1[r]=fsub_s(P1[r],dl);} \
      _Pragma("unroll") for(int r=0;r<16;++r)negm[r]=-mhat; asm volatile("":"+v"(negm)); } \
    _Pragma("unroll") for(int r=0;r<16;++r)P0[r]=__builtin_amdgcn_exp2f(P0[r]); }while(0)
  #define RESC() do{ if(resc){ asm volatile("s_waitcnt lgkmcnt(0)":::"memory"); \
      _Pragma("unroll") for(int d_=0;d_<2;++d_) _Pragma("unroll") for(int r=0;r<16;++r)o[d_][r]*=wsf[crow(r,hi)]; } }while(0)
  f32x16 pA0,pA1,pB0,pB1;
  int sl_prev=0,sl_cur=0,sl_next=SLOTB;
  #define ROT() do{sl_prev=sl_cur;sl_cur=sl_next;sl_next=(sl_next==(NSLOT-1)*SLOTB)?0:sl_next+SLOTB;}while(0)
  DMA_K(2,2*SLOTB);
  WAIT_BAR(3);
  qkt(pA0,pA1,Kbase,qr,negm,r32,hi);asm volatile("s_nop 15\n\ts_nop 7":"+v"(pA0),"+v"(pA1));CMASK(pA0,pA1,0);
  START(pA0,pA1);
  _Pragma("unroll") for(int r=0;r<16;++r)pA1[r]=__builtin_amdgcn_exp2f(pA1[r]);
  WAIT_BAR(0);
  DMA_K(3,0);DMA_V(1,SLOTB);
  ROT();
  kload8(kf,kp0+sl_cur);
  WAIT_BAR(2);
  s16x4 vlo[8],vhi[8]; u32x4 pw0,pw1,pw2,pw3;
  #define PKW(P,B) cvtpk_s(P[B],P[B+1])
  #define PAF(k) __builtin_bit_cast(bf16x8,pw##k)
  #define VFR(i) (bf16x8){vlo[i][0],vlo[i][1],vlo[i][2],vlo[i][3],vhi[i][0],vhi[i][1],vhi[i][2],vhi[i][3]}
  #define PIN(x) asm volatile("":"+v"(x))
  #define MX3(a,b,c) __builtin_fmaxf(__builtin_fmaxf((a),(b)),(c))
  #define GAPA(MF,A0,A1,A2,A3,W0,W1,PW) do{ MF; sacc+=A0; sacc+=A1; sacc+=A2; sacc+=A3; PIN(sacc); W0; W1; PIN(PW); SBAR(); }while(0)
  #define EX(v) __builtin_amdgcn_exp2f(v)
  #define GAPB(MF,X,B) do{ MF; X[B]=EX(X[B]); X[B+1]=EX(X[B+1]); X[B+2]=EX(X[B+2]); X[B+3]=EX(X[B+3]); PIN(X); SBAR(); }while(0)
  #define VRD(i) do{ vlo[i]=vtr(vp_+(((i)>>2)*4096+((i)&3)*1024)); vhi[i]=vtr(vp_+(((i)>>2)*4096+((i)&3)*1024+512)); }while(0)
  #define KRD(G,j) do{ if(G){ kload2(kf,kp0+sl_next,j); SBAR(); } }while(0)
  #define STEP(C0,C1,P0,P1,t,GK,GV,GL) do{ SBAR(); \
    const lds_cptr vp_=vp0+sl_prev; \
    VRD(0); SBAR(); float sacc=(P0[0]+P0[1]); \
    GAPA(C0=__builtin_amdgcn_mfma_f32_32x32x16_bf16(kf[0],qr[0],negm,0,0,0), P0[2],P0[3],P0[4],P0[5],     pw0[0]=PKW(P0,0), pw0[1]=PKW(P0,2), pw0); \
    VRD(4); SBAR(); GAPA(C1=__builtin_amdgcn_mfma_f32_32x32x16_bf16(kf[1],qr[0],negm,0,0,0), P0[6],P0[7],P0[8],P0[9],     pw0[2]=PKW(P0,4), pw0[3]=PKW(P0,6), pw0); \
    VRD(1); SBAR(); GAPA(C0=__builtin_amdgcn_mfma_f32_32x32x16_bf16(kf[2],qr[1],C0,0,0,0),   P0[10],P0[11],P0[12],P0[13], pw1[0]=PKW(P0,8), pw1[1]=PKW(P0,10), pw1); \
    VRD(5); SBAR(); GAPA(C1=__builtin_amdgcn_mfma_f32_32x32x16_bf16(kf[3],qr[1],C1,0,0,0),   P0[14],P0[15],P1[0],P1[1],   pw1[2]=PKW(P0,12),pw1[3]=PKW(P0,14), pw1); \
    VRD(2); SBAR(); GAPA(C0=__builtin_amdgcn_mfma_f32_32x32x16_bf16(kf[4],qr[2],C0,0,0,0),   P1[2],P1[3],P1[4],P1[5],     pw2[0]=PKW(P1,0), pw2[1]=PKW(P1,2), pw2); \
    VRD(6); SBAR(); GAPA(C1=__builtin_amdgcn_mfma_f32_32x32x16_bf16(kf[5],qr[2],C1,0,0,0),   P1[6],P1[7],P1[8],P1[9],     pw2[2]=PKW(P1,4), pw2[3]=PKW(P1,6), pw2); \
    VRD(3); SBAR(); GAPA(C0=__builtin_amdgcn_mfma_f32_32x32x16_bf16(kf[6],qr[3],C0,0,0,0),   P1[10],P1[11],P1[12],P1[13], pw3[0]=PKW(P1,8), pw3[1]=PKW(P1,10), pw3); \
    VRD(7); SBAR(); GAPA(C1=__builtin_amdgcn_mfma_f32_32x32x16_bf16(kf[7],qr[3],C1,0,0,0),   P1[14],P1[15],0.f,0.f,       pw3[2]=PKW(P1,12),pw3[3]=PKW(P1,14), pw3); \
    l_reg+=sacc; \
    if(GK){DMA_K((t)+3,sl_cur);} if(GV){DMA_V((t)+1,sl_next);} \
    CMASK(C0,C1,t); \
    { float a=MX3(C0[0],C0[1],C1[0]),b=MX3(C0[2],C0[3],C1[1]); a=MX3(a,C1[2],C1[3]); \
      _Pragma("unroll") for(int r=4;r<16;r+=4){a=MX3(a,C0[r],C0[r+1]);b=MX3(b,C0[r+2],C0[r+3]);a=MX3(a,C1[r],C1[r+1]);b=MX3(b,C1[r+2],C1[r+3]);} \
      float rm=__builtin_fmaxf(a,b); { auto rr=__builtin_amdgcn_permlane32_swap(__float_as_uint(rm),__float_as_uint(rm),false,false); rm=__builtin_fmaxf(__uint_as_float(rr[0]),__uint_as_float(rr[1])); } \
      resc=false; \
      if(__builtin_expect(__any(rm>(float)THRL),0)){ const float dl=__builtin_fmaxf(rm,0.f); mhat+=dl; \
        _Pragma("unroll") for(int r=0;r<16;++r){C0[r]-=dl;C1[r]-=dl;} \
        _Pragma("unroll") for(int r=0;r<16;++r)negm[r]=-mhat; asm volatile("":"+v"(negm)); \
        const float f=__builtin_amdgcn_exp2f(-dl); l_reg*=f; if(hi==0)wsf[r32]=f; resc=true; } } \
    SBAR(); \
    GAPB(o[0]=__builtin_amdgcn_mfma_f32_32x32x16_bf16(PAF(0),VFR(0),o[0],0,0,0), C0,0); \
    GAPB(o[1]=__builtin_amdgcn_mfma_f32_32x32x16_bf16(PAF(0),VFR(4),o[1],0,0,0), C0,4); \
    KRD(GL,0); GAPB(o[0]=__builtin_amdgcn_mfma_f32_32x32x16_bf16(PAF(1),VFR(1),o[0],0,0,0), C0,8); \
    KRD(GL,1); GAPB(o[1]=__builtin_amdgcn_mfma_f32_32x32x16_bf16(PAF(1),VFR(5),o[1],0,0,0), C0,12); \
    KRD(GL,2); GAPB(o[0]=__builtin_amdgcn_mfma_f32_32x32x16_bf16(PAF(2),VFR(2),o[0],0,0,0), C1,0); \
    KRD(GL,3); GAPB(o[1]=__builtin_amdgcn_mfma_f32_32x32x16_bf16(PAF(2),VFR(6),o[1],0,0,0), C1,4); \
    GAPB(o[0]=__builtin_amdgcn_mfma_f32_32x32x16_bf16(PAF(3),VFR(3),o[0],0,0,0), C1,8); \
    GAPB(o[1]=__builtin_amdgcn_mfma_f32_32x32x16_bf16(PAF(3),VFR(7),o[1],0,0,0), C1,12); \
    }while(0)
  int t=1;
  #undef CMASK
  #define CMASK(P0,P1,t) do{}while(0)
  for(;t+5<NT;t+=2){
    STEP(pB0,pB1,pA0,pA1,t,true,true,true);     WAIT_BAR(2); RESC(); ROT();
    STEP(pA0,pA1,pB0,pB1,t+1,true,true,true);   WAIT_BAR(2); RESC(); ROT();
  }
  #undef CMASK
  #define CMASK(P0,P1,t) do{int jb_=(t)-(NT-4); if(jb_>=0)cmask(P0,P1,jb_,qrel,hi);}while(0)
  #define ENDW(tt) do{ if((tt)+3<NT){WAIT_BAR(2);} else if((tt)+2<NT){WAIT_BAR(1);} else {WAIT_BAR(0);} }while(0)
  for(;t+1<NT;t+=2){
    STEP(pB0,pB1,pA0,pA1,t,(t+3<NT),(t+1<NT),(t+1<NT));       ENDW(t);   RESC(); ROT();
    STEP(pA0,pA1,pB0,pB1,t+1,(t+4<NT),(t+2<NT),(t+2<NT));     ENDW(t+1); RESC(); ROT();
  }
  STEP(pB0,pB1,pA0,pA1,NT-1,false,false,false); RESC();
  { float sacc=pB0[0]+pB0[1]; _Pragma("unroll") for(int r=2;r<16;++r)sacc+=pB0[r]; _Pragma("unroll") for(int r=0;r<16;++r)sacc+=pB1[r]; l_reg+=sacc;
    pw0=(u32x4){PKW(pB0,0),PKW(pB0,2),PKW(pB0,4),PKW(pB0,6)};pw1=(u32x4){PKW(pB0,8),PKW(pB0,10),PKW(pB0,12),PKW(pB0,14)};pw2=(u32x4){PKW(pB1,0),PKW(pB1,2),PKW(pB1,4),PKW(pB1,6)};pw3=(u32x4){PKW(pB1,8),PKW(pB1,10),PKW(pB1,12),PKW(pB1,14)};
    SBAR(); pv(o,vb0+sl_cur,PAF(0),PAF(1),PAF(2),PAF(3)); }
  #undef PKW
  #undef PAF
  #undef VFR
  #undef PIN
  #undef MX3
  #undef GAPA
  #undef GAPB
  #undef EX
  #undef VRD
  #undef KRD
  #undef STEP
  #undef ENDW
  {auto rr=__builtin_amdgcn_permlane32_swap(__float_as_uint(l_reg),__float_as_uint(l_reg),false,false);l_reg=__uint_as_float(rr[0])+__uint_as_float(rr[1]);}
  if(hi==0)wsf[32+r32]=l_reg;asm volatile("s_waitcnt lgkmcnt(0)":::"memory");
  float rli[16];
  #pragma unroll
  for(int r=0;r<16;++r)rli[r]=__builtin_amdgcn_rcpf(wsf[32+crow(r,hi)]);
  bf16*Ow=O+(rowbase+q0+wid*QBLK)*DMO+ocol;
  { bf16*stg=(bf16*)(shm+LDS_OST)+wid*2048;
    #pragma unroll
    for(int r=0;r<16;++r){const int orow=crow(r,hi);
      #pragma unroll
      for(int d0=0;d0<2;++d0)stg[orow*64+d0*32+r32]=__float2bfloat16(o[d0][r]*rli[r]);}
    asm volatile("s_waitcnt lgkmcnt(0)":::"memory");
    #pragma unroll
    for(int i=0;i<4;++i){const int row=i*8+(lane>>3),ch=lane&7; const u32x4 v=*(const u32x4*)(stg+row*64+ch*8); ATTN_STORE16(Ow+(long)row*DMO+ch*8,v);} }
  asm volatile("s_waitcnt lgkmcnt(0)\n\ts_barrier":::"memory");
  #undef DMA_K
  #undef DMA_V
  #undef CMASK
  #undef START
  #undef RESC
  #undef ROT
}
constexpr int ATTN_LDS_BYTES=LDS_BYTES;
template<int THRL=8> __device__ __forceinline__ void attn_phase(char*lds,const bf16*U,bf16*Oc,int vcu){
  const int bhc=vcu>>3,s=vcu&7,b=bhc>>3,h=(bhc>>1)&3,c=bhc&1;
  _Pragma("unroll 1") for(int i=0;i<4;++i){ const int half=i>>1,qb=(i&1)?15-s:s;
    attn_unit<THRL>(b,h*128+c*64,512+h*128+c*64,1024+h*128+half*64,h*128+half*64,qb,U,U,U,Oc+(long)c*16384*DMO,lds); }
}
#undef SBAR
#undef WAIT_BAR
}

namespace gla {
constexpr int GP = 72;
constexpr int L_BC = 0, L_VT = 16384, L_QI = 34816, L_KI = 44032, L_ATT = 53248, L_OF = 62464, OFP = 132;
__device__ __forceinline__ bf16x8 frag(const LAS unsigned char* base, int row, int k0) { return *(const LAS bf16x8*)(base + (row * GP + k0) * 2); }
__device__ __forceinline__ void cumsum_and_vt(LAS unsigned char* lds, const float* LOGA, const bf16_t* Ugla, size_t row0, int h, int tid, int lane, int wave) {
    LAS float* Bc = (LAS float*)(lds + L_BC);
    if (wave == 0) { float acc = 0.f; const float* g = LOGA + row0 * 256 + h * 64 + lane;
#pragma unroll 8
        for (int s = 0; s < 64; ++s) { acc += g[(size_t)s * 256]; Bc[s * 64 + lane] = acc; } }
    { const int v = tid & 127, sg = tid >> 7; const bf16_t* vp = Ugla + (row0 + sg * 16) * 1536 + 512 + h * 128 + v; unsigned w[8];
#pragma unroll
        for (int j = 0; j < 8; ++j) w[j] = (unsigned)vp[(size_t)(2 * j) * 1536] | ((unsigned)vp[(size_t)(2 * j + 1) * 1536] << 16);
        LAS u32x4* dst = (LAS u32x4*)(lds + L_VT + (v * GP + sg * 16) * 2);
        dst[0] = (u32x4){w[0], w[1], w[2], w[3]}; dst[1] = (u32x4){w[4], w[5], w[6], w[7]}; }
}
__device__ __forceinline__ void chunk_state(LAS unsigned char* lds, int q, const float* LOGA, const bf16_t* Ugla, float* SCt, float* DEC, int tid, int lane, int wave) {
    const int bh = q >> 6, n = q & 63, b = bh >> 2, h = bh & 3; const size_t row0 = (size_t)b * SEQ + n * 64;
    LAS float* Bc = (LAS float*)(lds + L_BC);
    cumsum_and_vt(lds, LOGA, Ugla, row0, h, tid, lane, wave);
    __syncthreads();
    { const int k = tid & 63, sg = tid >> 6; const float bl = Bc[63 * 64 + k]; const bf16_t* kp = Ugla + (row0 + sg * 8) * 1536 + 256 + h * 64 + k; float f[8];
#pragma unroll
        for (int j = 0; j < 8; ++j) f[j] = bf2f(kp[(size_t)j * 1536]) * __expf(bl - Bc[(sg * 8 + j) * 64 + k]);
        *(LAS u32x4*)(lds + L_QI + (k * GP + sg * 8) * 2) = (u32x4){pk2(f[0], f[1]), pk2(f[2], f[3]), pk2(f[4], f[5]), pk2(f[6], f[7])};
        if (tid < 64) DEC[(size_t)q * 64 + tid] = __expf(bl); }
    __syncthreads();
    { const int fr = lane & 15, fq = lane >> 4, mt = wave >> 1;
#pragma unroll
        for (int j = 0; j < 4; ++j) { const int nt = (wave & 1) * 4 + j; f32x4 acc = {0.f, 0.f, 0.f, 0.f};
#pragma unroll
            for (int ks = 0; ks < 2; ++ks) acc = __builtin_amdgcn_mfma_f32_16x16x32_bf16(frag(lds + L_QI, 16 * mt + fr, 32 * ks + 8 * fq), frag(lds + L_VT, 16 * nt + fr, 32 * ks + 8 * fq), acc, 0, 0, 0);
            *(f32x4*)(SCt + (size_t)q * 8192 + (16 * nt + fr) * 64 + 16 * mt + 4 * fq) = acc; } }
    __syncthreads();
}
__device__ __forceinline__ void chunk_out(LAS unsigned char* lds, int q, const float* LOGA, const bf16_t* Ugla, const bf16_t* SPt, const float* gog, bf16_t* OA, int tid, int lane, int wave) {
    const int bh = q >> 6, n = q & 63, b = bh >> 2, h = bh & 3; const size_t row0 = (size_t)b * SEQ + n * 64;
    LAS float* Bc = (LAS float*)(lds + L_BC); LAS float* Of = (LAS float*)(lds + L_OF);
    const int fr = lane & 15, fq = lane >> 4;
    cumsum_and_vt(lds, LOGA, Ugla, row0, h, tid, lane, wave);
    __syncthreads();
    { const int s = tid >> 3, k0 = (tid & 7) * 8; const bf16_t* rp = Ugla + (row0 + s) * 1536 + h * 64 + k0;
        const u32x4 qw = *(const u32x4*)rp, kw = *(const u32x4*)(rp + 256); float qf[8], kf[8];
        qf[0] = lo_bf(qw.x); qf[1] = hi_bf(qw.x); qf[2] = lo_bf(qw.y); qf[3] = hi_bf(qw.y); qf[4] = lo_bf(qw.z); qf[5] = hi_bf(qw.z); qf[6] = lo_bf(qw.w); qf[7] = hi_bf(qw.w);
        kf[0] = lo_bf(kw.x); kf[1] = hi_bf(kw.x); kf[2] = lo_bf(kw.y); kf[3] = hi_bf(kw.y); kf[4] = lo_bf(kw.z); kf[5] = hi_bf(kw.z); kf[6] = lo_bf(kw.w); kf[7] = hi_bf(kw.w);
#pragma unroll
        for (int e = 0; e < 8; ++e) { const float bv = Bc[s * 64 + k0 + e]; qf[e] *= 0.125f * __expf(bv); kf[e] *= __expf(-bv); }
        *(LAS u32x4*)(lds + L_QI + (s * GP + k0) * 2) = (u32x4){pk2(qf[0], qf[1]), pk2(qf[2], qf[3]), pk2(qf[4], qf[5]), pk2(qf[6], qf[7])};
        *(LAS u32x4*)(lds + L_KI + (s * GP + k0) * 2) = (u32x4){pk2(kf[0], kf[1]), pk2(kf[2], kf[3]), pk2(kf[4], kf[5]), pk2(kf[6], kf[7])}; }
    __syncthreads();
#pragma unroll
    for (int j = 0; j < 2; ++j) { const int t = 2 * wave + j, mt = t >> 2, nt = t & 3; f32x4 acc = {0.f, 0.f, 0.f, 0.f};
#pragma unroll
        for (int ks = 0; ks < 2; ++ks) acc = __builtin_amdgcn_mfma_f32_16x16x32_bf16(frag(lds + L_QI, 16 * mt + fr, 32 * ks + 8 * fq), frag(lds + L_KI, 16 * nt + fr, 32 * ks + 8 * fq), acc, 0, 0, 0);
        LAS bf16_t* ap = (LAS bf16_t*)(lds + L_ATT); const int sc = 16 * nt + fr;
#pragma unroll
        for (int r = 0; r < 4; ++r) { const int c = 16 * mt + 4 * fq + r; ap[c * GP + sc] = (bf16_t)f2bf(sc <= c ? acc[r] : 0.f); } }
    __syncthreads();
    { const int mt = wave >> 1;
#pragma unroll
        for (int j = 0; j < 4; ++j) { const int nt = (wave & 1) * 4 + j; f32x4 acc = {0.f, 0.f, 0.f, 0.f};
#pragma unroll
            for (int ks = 0; ks < 2; ++ks) { acc = __builtin_amdgcn_mfma_f32_16x16x32_bf16(frag(lds + L_ATT, 16 * mt + fr, 32 * ks + 8 * fq), frag(lds + L_VT, 16 * nt + fr, 32 * ks + 8 * fq), acc, 0, 0, 0);
                const bf16x8 sp = *(const bf16x8*)(SPt + (size_t)q * 8192 + (16 * nt + fr) * 64 + 32 * ks + 8 * fq);
                acc = __builtin_amdgcn_mfma_f32_16x16x32_bf16(frag(lds + L_QI, 16 * mt + fr, 32 * ks + 8 * fq), sp, acc, 0, 0, 0); }
#pragma unroll
            for (int r = 0; r < 4; ++r) Of[(16 * mt + 4 * fq + r) * OFP + 16 * nt + fr] = acc[r]; } }
    __syncthreads();
    { const int c = tid >> 3, v0 = (tid & 7) * 16; float o[16]; float ss = 0.f;
#pragma unroll
        for (int e = 0; e < 16; e += 4) { const f32x4 t4 = *(const LAS f32x4*)(Of + c * OFP + v0 + e); o[e] = t4.x; o[e + 1] = t4.y; o[e + 2] = t4.z; o[e + 3] = t4.w; ss += (t4.x * t4.x + t4.y * t4.y) + (t4.z * t4.z + t4.w * t4.w); }
        ss += __shfl_xor(ss, 1); ss += __shfl_xor(ss, 2); ss += __shfl_xor(ss, 4);
        const float rstd = rsqrtf(ss * (1.f / 128.f) + 1e-6f);
        const bf16_t* rp = Ugla + (row0 + c) * 1536 + 1024 + h * 128 + v0; const u32x4 r0 = *(const u32x4*)rp, r1 = *(const u32x4*)(rp + 8);
        const unsigned rw[8] = {r0.x, r0.y, r0.z, r0.w, r1.x, r1.y, r1.z, r1.w}; unsigned ow[8];
#pragma unroll
        for (int e = 0; e < 8; ++e) { const float a = o[2 * e] * rstd * gog[v0 + 2 * e] * siluf_(lo_bf(rw[e])), b2 = o[2 * e + 1] * rstd * gog[v0 + 2 * e + 1] * siluf_(hi_bf(rw[e])); ow[e] = pk2(a, b2); }
        bf16_t* op = OA + (row0 + c) * 512 + h * 128 + v0; *(u32x4*)op = (u32x4){ow[0], ow[1], ow[2], ow[3]}; *(u32x4*)(op + 8) = (u32x4){ow[4], ow[5], ow[6], ow[7]}; }
    __syncthreads();
}
}

#define XB_TMO      128
#define XB_XCNT(j)  (256  + 64 * (j))
#define XB_XSUB(j)  (1280 + 64 * (j))
#define XB_XGEN(j)  (2304 + 64 * (j))
#define XB_TOP      3328
#define XB_TOPGEN   3392
#define XCD_BAR_WORDS 3456
#define XB_SPIN_CAP (1u << 18)
__device__ __forceinline__ unsigned xb_ld(unsigned* p)              { return __hip_atomic_load(p, __ATOMIC_RELAXED, __HIP_MEMORY_SCOPE_AGENT); }
__device__ __forceinline__ unsigned xb_add(unsigned* p, unsigned v) { return __hip_atomic_fetch_add(p, v, __ATOMIC_RELAXED, __HIP_MEMORY_SCOPE_AGENT); }
__device__ __forceinline__ unsigned xb_xcc_id() { return (unsigned)__builtin_amdgcn_s_getreg((3 << 11) | 20) & 0xFu; }
#define XB_SPIN(cond, bar) do { unsigned _sp = 0; while (cond) { __builtin_amdgcn_s_sleep(1); \
    if ((++_sp & 255u) == 0u) { if (xb_ld(&(bar)[XB_TMO])) break; if (_sp > XB_SPIN_CAP) { atomicAdd(&(bar)[XB_TMO], 1u); break; } } } } while (0)
struct XcdBarrier { unsigned* bar; unsigned x; volatile LAS unsigned* st; };
__device__ __forceinline__ XcdBarrier xcd_barrier_post(unsigned* bar, volatile LAS unsigned* st) {
    XcdBarrier b; b.bar = bar; b.x = xb_xcc_id(); b.st = st;
    if (threadIdx.x == 0) (void)xb_add(&bar[XB_XCNT(b.x)], 1u);
    return b;
}
__device__ __forceinline__ void xcd_barrier_complete(unsigned* bar, unsigned x, unsigned& nloc, unsigned& nx) {
    const unsigned G = gridDim.x * gridDim.y * gridDim.z;
    unsigned sum, cnt, mine, sp = 0u;
    for (;;) {
        sum = 0u; cnt = 0u; mine = 0u;
#pragma unroll
        for (unsigned j = 0; j < 16; ++j) { const unsigned c = xb_ld(&bar[XB_XCNT(j)]); sum += c; cnt += (c > 0u) ? 1u : 0u; mine = (j == x) ? c : mine; }
        if (sum == G) break;
        __builtin_amdgcn_s_sleep(1);
        if ((++sp & 255u) == 0u) { if (xb_ld(&bar[XB_TMO])) break; if (sp > XB_SPIN_CAP) { atomicAdd(&bar[XB_TMO], 1u); break; } }
    }
    nloc = mine > 0u ? mine : 1u; nx = cnt > 0u ? cnt : 1u;
}
__device__ __forceinline__ void xcd_barrier(const XcdBarrier& b) {
    asm volatile("s_waitcnt vmcnt(0)" ::: "memory");
    __syncthreads();
    if (threadIdx.x == 0) {
        unsigned* bar = b.bar;
        __builtin_amdgcn_s_waitcnt(0);
        unsigned nloc = b.st[0], nx = b.st[1];
        if (nloc == 0u) { xcd_barrier_complete(bar, b.x, nloc, nx); b.st[0] = nloc; b.st[1] = nx; }
        const unsigned old = xb_add(&bar[XB_XSUB(b.x)], 1u);
        const unsigned gen = old / nloc;
        if (old + 1u == (gen + 1u) * nloc) {
            __builtin_amdgcn_fence(__ATOMIC_RELEASE, "agent");
            asm volatile("s_waitcnt vmcnt(0)" ::: "memory");
            const unsigned og = xb_add(&bar[XB_TOP], 1u);
            const unsigned tg = og / nx;
            if (og + 1u == (tg + 1u) * nx) xb_add(&bar[XB_TOPGEN], 1u);
            else XB_SPIN(xb_ld(&bar[XB_TOPGEN]) == tg, bar);
            __builtin_amdgcn_fence(__ATOMIC_ACQUIRE, "agent");
            xb_add(&bar[XB_XGEN(b.x)], 1u);
            asm volatile("s_waitcnt vmcnt(0)" ::: "memory");
        } else {
            XB_SPIN(xb_ld(&bar[XB_XGEN(b.x)]) == gen, bar);
            __builtin_amdgcn_fence(__ATOMIC_ACQUIRE, "agent");
            asm volatile("s_waitcnt vmcnt(0)" ::: "memory");
        }
    }
    __syncthreads();
}

struct Args { const void* in[28]; float* out; unsigned char* ws; int ph_lo, ph_hi; };
enum { I_X = 0, I_C, I_POS, I_ADAW, I_ADAB, I_N1G, I_N2G, I_WIN, I_AUP, I_AB, I_GOG, I_DQG, I_DKG, I_LQ1, I_LK1, I_LQ2, I_LK2, I_DOG, I_WBA, I_WBB, I_WOUT, I_RGW, I_RGB, I_REW, I_REB, I_EW1, I_EW3, I_EW2 };

__device__ __forceinline__ void tr_item(const float* W, int ldn, int k0, int nsrc0, bf16_t* WT, int Kdst, int drow0, LAS float* scr, int lane) {
#pragma unroll 8
    for (int i = 0; i < 32; ++i) { const int kk = 2 * i + (lane >> 5); scr[kk * 33 + (lane & 31)] = W[(size_t)(k0 + kk) * ldn + nsrc0 + (lane & 31)]; }
    LDS_WAIT(); asm volatile("" ::: "memory");
    const int c = lane & 7;
#pragma unroll
    for (int j = 0; j < 4; ++j) { const int n = (lane >> 3) + 8 * j; const LAS float* s = scr + (8 * c) * 33 + n;
        u32x4 o; o.x = pk2(s[0 * 33], s[1 * 33]); o.y = pk2(s[2 * 33], s[3 * 33]); o.z = pk2(s[4 * 33], s[5 * 33]); o.w = pk2(s[6 * 33], s[7 * 33]);
        *(u32x4*)(WT + (size_t)(drow0 + n) * Kdst + k0 + 8 * c) = o; }
    LDS_WAIT(); asm volatile("" ::: "memory");
}

#define PHASE_LOCALS int tid_l = threadIdx.x; asm volatile("" : "+v"(tid_l)); int cb_l = blockIdx.x; asm volatile("" : "+s"(cb_l)); \
    const int tid = tid_l, lane = tid & 63, wave = __builtin_amdgcn_readfirstlane(tid >> 6), cb = cb_l, G = 256, gw = cb * NWAVES + wave, NGW = G * NWAVES; (void)lane; (void)gw; (void)NGW; (void)G;
template <int IDX> __device__ __forceinline__ const void* ldarg() {
    unsigned long long p;
    asm volatile("s_load_dwordx2 %0, %1, %2\n\ts_waitcnt lgkmcnt(0)" : "=s"(p) : "s"(__builtin_amdgcn_kernarg_segment_ptr()), "n"(IDX * 8) : "memory");
    return (const void*)p;
}
#define ARG_IN(i) (ldarg<(i)>())
#define ARG_WS ((unsigned char*)ldarg<29>())
#define XIN ((const float*)ARG_IN(I_X))
#define OUTP ((float*)ldarg<28>())
#define P_MODP ((float*)(ARG_WS + WS_MODP))
#define P_MODF ((float*)(ARG_WS + WS_MODF))
#define P_ALR ((float*)(ARG_WS + WS_ALR))
#define P_WIN ((bf16_t*)(ARG_WS + WS_WIN))
#define P_WA ((bf16_t*)(ARG_WS + WS_WA))
#define P_WB ((bf16_t*)(ARG_WS + WS_WB))
#define P_WOUT ((bf16_t*)(ARG_WS + WS_WOUT))
#define P_XN ((bf16_t*)(ARG_WS + WS_XN))
#define P_LOGA ((float*)(ARG_WS + WS_LOGA))
#define P_SCT ((float*)(ARG_WS + WS_SCT))
#define P_SPT ((bf16_t*)(ARG_WS + WS_SPT))
#define P_OC ((bf16_t*)(ARG_WS + WS_OC))
#define P_DEC ((float*)(ARG_WS + WS_DEC))
#define P_OB ((bf16_t*)(ARG_WS + WS_OB))
#define P_OA ((bf16_t*)(ARG_WS + WS_OA))
#define P_XS ((bf16_t*)(ARG_WS + WS_XS))
#define P_Y ((bf16_t*)(ARG_WS + WS_Y))
#define P_UGLA ((bf16_t*)(ARG_WS + WS_UGLA))
#define P_UDIFF ((bf16_t*)(ARG_WS + WS_UDIFF))
#define P_UGATE ((bf16_t*)(ARG_WS + WS_UGATE))
#define P_M1 ((bf16_t*)(ARG_WS + WS_M1))
#define P_MERGED ((bf16_t*)(ARG_WS + WS_MERGED))
#define P_H2 ((bf16_t*)(ARG_WS + WS_H2))
#define P_W13 ((bf16_t*)(ARG_WS + WS_W13))
#define P_W2 ((bf16_t*)(ARG_WS + WS_W2))
#define P_HMID ((bf16_t*)(ARG_WS + WS_HMID))
#define P_TOKE ((int*)(ARG_WS + WS_ROUTE + RT_TOKE))
#define P_TOKW ((float*)(ARG_WS + WS_ROUTE + RT_TOKW))
#define P_RANK ((int*)(ARG_WS + WS_ROUTE + RT_RANK))
#define P_SLOT ((int*)(ARG_WS + WS_ROUTE + RT_SLOT))
#define P_BLKCNT ((int*)(ARG_WS + WS_ROUTE + RT_BLKCNT))
#define P_TILEE ((int*)(ARG_WS + WS_ROUTE + RT_TILEE))
#define P_NT ((int*)(ARG_WS + WS_ROUTE + RT_NT))
template <int LO, int HI>
__global__ void __launch_bounds__(NTHR, 2) mk_fwd(Args args) {
    extern __shared__ __attribute__((aligned(16))) unsigned char lds_raw[];
    LAS unsigned char* lds = (LAS unsigned char*)lds_raw;
    volatile LAS unsigned* MISC = (volatile LAS unsigned*)(lds + MISC_OFF);
    unsigned* ctl = (unsigned*)(ARG_WS + WS_CTL);
    for (int u = threadIdx.x; u < (LDS_BYTES - LDSCTL_OFF) / 4; u += NTHR) ((LAS unsigned*)(lds + LDSCTL_OFF))[u] = 0u;
    __syncthreads();
    constexpr int lo = LO, hi = HI;
    XcdBarrier bar; bar.bar = ctl + CW_BAR; bar.x = 0; bar.st = nullptr;
    if constexpr (hi - lo > 1) bar = xcd_barrier_post(ctl + CW_BAR, MISC + 8);
#define IN(k) (lo <= (k) && (k) < hi)
#define SEAM(k) do { if constexpr (IN(k) && IN((k) + 1)) xcd_barrier(bar); } while (0)

    if constexpr (IN(0)) {
        asm volatile("; PHASE_BEGIN 0" ::: "memory");
        PHASE_LOCALS
        float* modp = P_MODP; bf16_t* Win_t = P_WIN; bf16_t* Wa_t = P_WA; bf16_t* Wb_t = P_WB; bf16_t* Wout_t = P_WOUT;
        const float* cvec = (const float*)ARG_IN(I_C); const float* ada_w = (const float*)ARG_IN(I_ADAW);
        const float* w_in = (const float*)ARG_IN(I_WIN);
        LAS float* scr = (LAS float*)(lds + wave * 16384);
        constexpr int I_MOD = 768, I_WIN_ = 16 * 160, I_WAB = 8 * 32, I_WO = 16 * 32;
        constexpr int NITEMS = I_MOD + I_WIN_ + 2 * I_WAB + I_WO;
        for (int it = gw; it < NITEMS; it += NGW) {
            int r = it;
            if (r < I_MOD) {
                const int jc = r % 24, kc = r / 24, j = jc * 256 + lane * 4;
                f32x4 a0 = {0, 0, 0, 0}, a1 = a0, a2 = a0, a3 = a0;
                for (int kk = 0; kk < 32; ++kk) { const int k = kc * 32 + kk; const f32x4 w = *(const f32x4*)(ada_w + (size_t)k * NMOD + j);
                    a0 += siluf_(cvec[k]) * w; a1 += siluf_(cvec[D + k]) * w; a2 += siluf_(cvec[2 * D + k]) * w; a3 += siluf_(cvec[3 * D + k]) * w; }
                *(f32x4*)(modp + (size_t)(kc * 4 + 0) * NMOD + j) = a0; *(f32x4*)(modp + (size_t)(kc * 4 + 1) * NMOD + j) = a1;
                *(f32x4*)(modp + (size_t)(kc * 4 + 2) * NMOD + j) = a2; *(f32x4*)(modp + (size_t)(kc * 4 + 3) * NMOD + j) = a3;
                continue; }
            r -= I_MOD;
            if (r < I_WIN_) { const int kb = r / 160, nb = r % 160, n0 = 32 * nb; tr_item(w_in, DIN, 64 * kb, n0 < 1536 ? n0 : n0 + 16, Win_t, D, n0, scr, lane); continue; }
            r -= I_WIN_;
            if (r < I_WAB) { const int kb = r / 32, nb = r % 32; tr_item((const float*)ARG_IN(I_WBA), D, 64 * kb, 32 * nb, Wa_t, 512, 32 * nb, scr, lane); continue; }
            r -= I_WAB;
            if (r < I_WAB) { const int kb = r / 32, nb = r % 32; tr_item((const float*)ARG_IN(I_WBB), D, 64 * kb, 32 * nb, Wb_t, 512, 32 * nb, scr, lane); continue; }
            r -= I_WAB;
            { const int kb = r / 32, nb = r % 32; tr_item((const float*)ARG_IN(I_WOUT), D, 64 * kb, 32 * nb, Wout_t, D, 32 * nb, scr, lane); }
        }
    }
    SEAM(0);

    if constexpr (IN(1)) {
        asm volatile("; PHASE_BEGIN 1" ::: "memory");
        PHASE_LOCALS
        const float* x = XIN; float* modp = P_MODP; float* modf = P_MODF; float* alr = P_ALR; bf16_t* XN = P_XN;
        const float* ada_b = (const float*)ARG_IN(I_ADAB); const float* g1 = (const float*)ARG_IN(I_N1G); const float* w_in = (const float*)ARG_IN(I_WIN);
        LAS float* modS = (LAS float*)lds;
        LAS float* lrT = (LAS float*)(lds + 8192);
        const int b = cb >> 6;
        { const int j = tid * 4; f32x4 s = *(const f32x4*)(ada_b + j);
            for (int kc = 0; kc < 32; ++kc) s += *(const f32x4*)(modp + (size_t)(kc * 4 + b) * NMOD + j);
            if (j >= D) s += 1.0f;
            *(LAS f32x4*)(modS + j) = s; }
        if (tid < 96) { const int idx = cb * 96 + tid, bb = idx / NMOD, j = idx % NMOD; float s = ada_b[j];
            for (int kc = 0; kc < 32; ++kc) s += modp[(size_t)(kc * 4 + bb) * NMOD + j];
            modf[idx] = s; }
        for (int idx = tid; idx < 16384; idx += NTHR) { const int k = idx >> 4, r = idx & 15; lrT[r * 1024 + k] = w_in[(size_t)k * DIN + 1536 + r]; }
        __syncthreads();
        for (int i = 0; i < 8; ++i) {
            const int m = cb * 64 + wave * 8 + i;
            const f32x4* xr = (const f32x4*)(x + (size_t)m * D) + lane;
            f32x4 v[4]; float ss = 0.f;
#pragma unroll
            for (int j = 0; j < 4; ++j) { v[j] = xr[64 * j]; ss += (v[j].x * v[j].x + v[j].y * v[j].y) + (v[j].z * v[j].z + v[j].w * v[j].w); }
            const float rstd = rsqrtf(wave_sum(ss) * (1.f / D) + 1e-6f);
            unsigned long long* o8 = (unsigned long long*)(XN + (size_t)m * D) + lane;
#pragma unroll
            for (int j = 0; j < 4; ++j) { const int k = 4 * lane + 256 * j; const f32x4 gg = *(const f32x4*)(g1 + k); const f32x4 sh = *(const LAS f32x4*)(modS + k); const f32x4 sc = *(const LAS f32x4*)(modS + D + k);
                v[j] = v[j] * rstd * gg * sc + sh;
                o8[64 * j] = (unsigned long long)pk2(v[j].x, v[j].y) | ((unsigned long long)pk2(v[j].z, v[j].w) << 32); }
            float mine = 0.f;
#pragma unroll 1
            for (int r = 0; r < 16; ++r) { float p = 0.f;
#pragma unroll
                for (int j = 0; j < 4; ++j) { const f32x4 w = *(const LAS f32x4*)(lrT + r * 1024 + 4 * lane + 256 * j); p += (v[j].x * w.x + v[j].y * w.y) + (v[j].z * w.z + v[j].w * w.w); }
                p = wave_sum(p); if (lane == r) mine = p; }
            if (lane < 16) alr[(size_t)m * 16 + lane] = mine;
        }
    }
    SEAM(1);

    if constexpr (IN(2)) {
        asm volatile("; PHASE_BEGIN 2" ::: "memory");
        PHASE_LOCALS
        bf16_t* XN = P_XN; bf16_t* Win_t = P_WIN; bf16_t* Ugla = P_UGLA; bf16_t* Udiff = P_UDIFF; bf16_t* Ugate = P_UGATE;
        pg8::DenseOrder S; S.init(XN, Win_t, M, NPROJ, D, G, cb);
        pg8::EpiInProj E{Ugla, Udiff, Ugate};
        pg8::gemm_phase<pg8::EpiInProj, pg8::DenseOrder, true, true>(lds, D, S, E);
    }
    SEAM(2);

    if constexpr (IN(3)) {
        asm volatile("; PHASE_BEGIN 3" ::: "memory");
        PHASE_LOCALS
        bf16_t* Udiff = P_UDIFF; float* alr = P_ALR; float* LOGA = P_LOGA;
        const int* pos = (const int*)ARG_IN(I_POS); const float* qg = (const float*)ARG_IN(I_DQG); const float* kg = (const float*)ARG_IN(I_DKG);
        const float* aup = (const float*)ARG_IN(I_AUP); const float* ab = (const float*)ARG_IN(I_AB);
        const float invf = powf(500000.0f, -(float)(lane & 7) * 0.125f);
        float gain[16];
#pragma unroll
        for (int e = 0; e < 16; ++e) gain[e] = (lane < 32 ? qg : kg)[(lane & 3) * 16 + e];
        for (int i = 0; i < 8; ++i) {
            const int m = cb * 64 + wave * 8 + i;
            bf16_t* rowp = Udiff + (size_t)m * 1536 + lane * 16;
            const u32x4 w0 = *(const u32x4*)rowp, w1 = *(const u32x4*)(rowp + 8);
            float y[16];
            y[0] = lo_bf(w0.x); y[1] = hi_bf(w0.x); y[2] = lo_bf(w0.y); y[3] = hi_bf(w0.y); y[4] = lo_bf(w0.z); y[5] = hi_bf(w0.z); y[6] = lo_bf(w0.w); y[7] = hi_bf(w0.w);
            y[8] = lo_bf(w1.x); y[9] = hi_bf(w1.x); y[10] = lo_bf(w1.y); y[11] = hi_bf(w1.y); y[12] = lo_bf(w1.z); y[13] = hi_bf(w1.z); y[14] = lo_bf(w1.w); y[15] = hi_bf(w1.w);
            float ss = 0.f;
#pragma unroll
            for (int e = 0; e < 16; ++e) ss += y[e] * y[e];
            ss += __shfl_xor(ss, 1); ss += __shfl_xor(ss, 2);
            const float rstd = rsqrtf(ss * (1.f / 64.f) + 1e-6f);
#pragma unroll
            for (int e = 0; e < 16; ++e) y[e] = y[e] * rstd * gain[e];
            const float ang = (float)pos[m] * invf; float sv, cv; sincosf(ang, &sv, &cv);
            float r[16];
#pragma unroll
            for (int e = 0; e < 8; ++e) { const float c_ = __shfl(cv, e), s_ = __shfl(sv, e); r[e] = y[e] * c_ - y[e + 8] * s_; r[e + 8] = y[e + 8] * c_ + y[e] * s_; }
            if ((lane & 3) == 0) {
#pragma unroll
                for (int e = 0; e < 16; ++e) y[e] = r[e]; }
            if (lane < 32) {
#pragma unroll
                for (int e = 0; e < 16; ++e) y[e] *= attn_body::C2; }
            u32x4 o0, o1; o0.x = pk2(y[0], y[1]); o0.y = pk2(y[2], y[3]); o0.z = pk2(y[4], y[5]); o0.w = pk2(y[6], y[7]); o1.x = pk2(y[8], y[9]); o1.y = pk2(y[10], y[11]); o1.z = pk2(y[12], y[13]); o1.w = pk2(y[14], y[15]);
            *(u32x4*)rowp = o0; *(u32x4*)(rowp + 8) = o1;
            float a[16];
#pragma unroll
            for (int rr = 0; rr < 16; ++rr) a[rr] = alr[(size_t)m * 16 + rr];
#pragma unroll
            for (int q = 0; q < 4; ++q) { const int j = lane + 64 * q; float xv = ab[j];
#pragma unroll
                for (int rr = 0; rr < 16; ++rr) xv += a[rr] * aup[rr * 256 + j];
                const float ls = fminf(xv, 0.f) - log1pf(__expf(-fabsf(xv)));
                LOGA[(size_t)m * 256 + j] = ls * (1.f / 16.f); }
        }
        VM_WAIT(); __syncthreads();
        { const bf16_t* Ugla = P_UGLA; float* SCt = P_SCT; float* DEC = P_DEC;
          for (int h = 0; h < 4; ++h) gla::chunk_state(lds, (((cb >> 6) * 4 + h) << 6) + (cb & 63), LOGA, Ugla, SCt, DEC, tid, lane, wave); }
    }
    SEAM(3);

    if constexpr (IN(4)) {
        asm volatile("; PHASE_BEGIN 4" ::: "memory");
        PHASE_LOCALS
        { const float* SCt = P_SCT; const float* DEC = P_DEC; bf16_t* SPt = P_SPT;
          const int idx = cb * NTHR + tid, bh = idx >> 13, e = idx & 8191, k = e & 63; float st = 0.f;
#pragma unroll 8
          for (int n = 0; n < 64; ++n) { const size_t q = (size_t)bh * 64 + n; const float sc = SCt[q * 8192 + e], d = DEC[q * 64 + k]; SPt[q * 8192 + e] = (bf16_t)f2bf(st); st = st * d + sc; } }
        { const int vcu = (cb % 8) * (G / 8) + cb / 8;
          attn_body::attn_phase<8>((char*)lds_raw, (const attn_body::bf16*)P_UDIFF, (attn_body::bf16*)P_OC, vcu); }
    }
    SEAM(4);

    if constexpr (IN(5)) {
        asm volatile("; PHASE_BEGIN 5" ::: "memory");
        PHASE_LOCALS
        { const float* lq1 = (const float*)ARG_IN(I_LQ1); const float* lk1 = (const float*)ARG_IN(I_LK1); const float* lq2 = (const float*)ARG_IN(I_LQ2); const float* lk2 = (const float*)ARG_IN(I_LK2);
          const float* og = (const float*)ARG_IN(I_DOG); const bf16_t* Oc = P_OC; bf16_t* OB = P_OB;
          const float lam = __expf(wave_sum(lq1[lane] * lk1[lane])) - __expf(wave_sum(lq2[lane] * lk2[lane])) + 0.2f;
          for (int i = 0; i < 8; ++i) {
            const size_t m = (size_t)cb * 64 + wave * 8 + i; const int col0 = lane * 8;
            const u32x4 a = *(const u32x4*)(Oc + m * 512 + col0), b2 = *(const u32x4*)(Oc + (size_t)M * 512 + m * 512 + col0);
            const unsigned aw[4] = {a.x, a.y, a.z, a.w}, bw[4] = {b2.x, b2.y, b2.z, b2.w}; float o[8]; float ss = 0.f;
#pragma unroll
            for (int e = 0; e < 4; ++e) { o[2 * e] = lo_bf(aw[e]) - lam * lo_bf(bw[e]); o[2 * e + 1] = hi_bf(aw[e]) - lam * hi_bf(bw[e]); ss += o[2 * e] * o[2 * e] + o[2 * e + 1] * o[2 * e + 1]; }
            ss += __shfl_xor(ss, 1); ss += __shfl_xor(ss, 2); ss += __shfl_xor(ss, 4); ss += __shfl_xor(ss, 8);
            const float rstd = rsqrtf(ss * (1.f / 128.f) + 1e-6f) * 0.8f; unsigned ow[4];
#pragma unroll
            for (int e = 0; e < 4; ++e) ow[e] = pk2(o[2 * e] * rstd * og[(col0 & 127) + 2 * e], o[2 * e + 1] * rstd * og[(col0 & 127) + 2 * e + 1]);
            *(u32x4*)(OB + m * 512 + col0) = (u32x4){ow[0], ow[1], ow[2], ow[3]}; } }
        __syncthreads();
        { const bf16_t* Ugla = P_UGLA; const float* LOGA = P_LOGA; const bf16_t* SPt = P_SPT; const float* gog = (const float*)ARG_IN(I_GOG); bf16_t* OA = P_OA;
          for (int ci = 0; ci < 4; ++ci) gla::chunk_out(lds, cb * 4 + ci, LOGA, Ugla, SPt, gog, OA, tid, lane, wave); }
    }
    SEAM(5);

    if constexpr (IN(6)) {
        asm volatile("; PHASE_BEGIN 6" ::: "memory");
        PHASE_LOCALS
        bf16_t* OA = P_OA; bf16_t* OB = P_OB; bf16_t* Wa_t = P_WA; bf16_t* Wb_t = P_WB; bf16_t* Ugate = P_UGATE; bf16_t* M1 = P_M1; bf16_t* MERGED = P_MERGED;
        { pg8::DenseOrder S; S.init(OA, Wa_t, M, D, 512, G, cb); pg8::EpiBranch E{Ugate, 0, nullptr, M1};
          pg8::gemm_phase<pg8::EpiBranch, pg8::DenseOrder, true, true>(lds, 512, S, E); }
        VM_WAIT(); __syncthreads();
        { pg8::DenseOrder S; S.init(OB, Wb_t, M, D, 512, G, cb); pg8::EpiBranch E{Ugate, 1024, M1, MERGED};
          pg8::gemm_phase<pg8::EpiBranch, pg8::DenseOrder, true, true>(lds, 512, S, E); }
    }
    SEAM(6);

    if constexpr (IN(7)) {
        asm volatile("; PHASE_BEGIN 7" ::: "memory");
        PHASE_LOCALS
        const float* x = XIN; float* out = OUTP; float* modf = P_MODF; bf16_t* MERGED = P_MERGED; bf16_t* Wout_t = P_WOUT;
        pg8::DenseOrder S; S.init(MERGED, Wout_t, M, D, D, G, cb); pg8::EpiWout E{x, modf, out};
        pg8::gemm_phase<pg8::EpiWout, pg8::DenseOrder, true, true>(lds, D, S, E);
    }
    SEAM(7);

    if constexpr (IN(8)) {
        asm volatile("; PHASE_BEGIN 8" ::: "memory");
        PHASE_LOCALS
        float* out = OUTP; float* modf = P_MODF; bf16_t* H2 = P_H2; bf16_t* W13_t = P_W13; bf16_t* W2_t = P_W2; int* tok_e = P_TOKE; float* tok_w = P_TOKW; int* tok_rank = P_RANK; int* blkcnt = P_BLKCNT;
        const float* g2 = (const float*)ARG_IN(I_N2G);
        const float* Wrg = (const float*)ARG_IN(I_RGW); const float* brg = (const float*)ARG_IN(I_RGB); const float* Wre = (const float*)ARG_IN(I_REW); const float* bre = (const float*)ARG_IN(I_REB);
        LAS float* modS = (LAS float*)lds;
        LAS float* h2s = (LAS float*)(lds + 8192) + wave * 1024;
        LAS int* eS = (LAS int*)(lds + 8192 + 32768);
        const int b = cb >> 6;
        for (int j = tid; j < 2048; j += NTHR) modS[j] = modf[(size_t)b * NMOD + 3 * D + j] + (j >= D ? 1.0f : 0.f);
        __syncthreads();
        for (int i = 0; i < 8; ++i) {
            const int tl = wave * 8 + i; const size_t m = (size_t)cb * 64 + tl;
            const f32x4* xr = (const f32x4*)(out + m * D) + lane;
            f32x4 v[4]; float ss = 0.f;
#pragma unroll
            for (int j = 0; j < 4; ++j) { v[j] = xr[64 * j]; ss += (v[j].x * v[j].x + v[j].y * v[j].y) + (v[j].z * v[j].z + v[j].w * v[j].w); }
            const float rstd = rsqrtf(wave_sum(ss) * (1.f / D) + 1e-6f);
            unsigned long long* o8 = (unsigned long long*)(H2 + m * D) + lane;
#pragma unroll
            for (int j = 0; j < 4; ++j) { const int k = 4 * lane + 256 * j; const f32x4 gg = *(const f32x4*)(g2 + k); const f32x4 sh = *(const LAS f32x4*)(modS + k); const f32x4 sc = *(const LAS f32x4*)(modS + D + k);
                v[j] = v[j] * rstd * gg * sc + sh;
                o8[64 * j] = (unsigned long long)pk2(v[j].x, v[j].y) | ((unsigned long long)pk2(v[j].z, v[j].w) << 32);
                *(LAS f32x4*)(h2s + k) = v[j]; }
            LDS_WAIT();
            float le; { const int e = lane & 31, half = lane >> 5; float acc = 0.f;
                for (int kk = 0; kk < 512; ++kk) { const int k = half * 512 + kk; acc += h2s[k] * Wre[k * 32 + e]; }
                acc += __shfl_xor(acc, 32); le = acc + bre[e]; }
            float lg; { const int g = lane & 3, part = lane >> 2; float acc = 0.f;
                for (int kk = 0; kk < 64; ++kk) { const int k = part * 64 + kk; acc += h2s[k] * Wrg[k * 4 + g]; }
                acc += __shfl_xor(acc, 4); acc += __shfl_xor(acc, 8); acc += __shfl_xor(acc, 16); acc += __shfl_xor(acc, 32); lg = acc + brg[g]; }
            const float lg0 = __shfl(lg, 0), lg1 = __shfl(lg, 1), lg2 = __shfl(lg, 2), lg3 = __shfl(lg, 3);
            int gi = 0; float gm = lg0; if (lg1 > gm) { gm = lg1; gi = 1; } if (lg2 > gm) { gm = lg2; gi = 2; } if (lg3 > gm) { gm = lg3; gi = 3; }
            const float ptop = 1.0f / (__expf(lg0 - gm) + __expf(lg1 - gm) + __expf(lg2 - gm) + __expf(lg3 - gm));
            float el[8];
#pragma unroll
            for (int j = 0; j < 8; ++j) el[j] = __shfl(le, gi * 8 + j);
            int j0 = 0; float e0 = el[0];
#pragma unroll
            for (int j = 1; j < 8; ++j) if (el[j] > e0) { e0 = el[j]; j0 = j; }
            int j1 = -1; float e1 = -3.0e38f;
#pragma unroll
            for (int j = 0; j < 8; ++j) if (j != j0 && el[j] > e1) { e1 = el[j]; j1 = j; }
            const float t = __expf(e1 - e0), w0 = ptop / (1.0f + t), w1 = ptop * t / (1.0f + t);
            if (lane == 0) { eS[2 * tl] = gi * 8 + j0; eS[2 * tl + 1] = gi * 8 + j1; tok_w[m * 2] = w0; tok_w[m * 2 + 1] = w1; }
        }
        __syncthreads();
        if (tid < 128) { const int e = eS[tid]; int rank = 0; for (int a = 0; a < tid; ++a) rank += (eS[a] == e) ? 1 : 0;
            tok_e[(size_t)cb * 128 + tid] = e; tok_rank[(size_t)cb * 128 + tid] = rank; }
        else if (tid < 160) { const int e = tid - 128; int cnt = 0; for (int a = 0; a < 128; ++a) cnt += (eS[a] == e) ? 1 : 0; blkcnt[cb * 32 + e] = cnt; }
        __syncthreads();
        {
            const float* w1 = (const float*)ARG_IN(I_EW1); const float* w3 = (const float*)ARG_IN(I_EW3); const float* w2 = (const float*)ARG_IN(I_EW2);
            LAS float* scr = (LAS float*)(lds + wave * 16384);
            for (int it = gw; it < NEXP * 768; it += NGW) {
                const int e = it / 768, r = it % 768;
                if (r < 512) { const int kb = r >> 5, nb = r & 31, r0 = 32 * nb, pn = r0 >> 8, half = (r0 >> 7) & 1, jj = r0 & 127;
                    tr_item((half ? w3 : w1) + (size_t)e * D * DEXP, DEXP, 64 * kb, 128 * pn + jj, W13_t + (size_t)e * 1024 * 1024, D, r0, scr, lane); }
                else { const int r2 = r - 512, kb = r2 >> 5, nb = r2 & 31;
                    tr_item(w2 + (size_t)e * DEXP * D, D, 64 * kb, 32 * nb, W2_t + (size_t)e * 1024 * 512, DEXP, 32 * nb, scr, lane); }
            }
        }
    }
    SEAM(8);

    if constexpr (IN(9)) {
        asm volatile("; PHASE_BEGIN 9" ::: "memory");
        PHASE_LOCALS
        bf16_t* H2 = P_H2; bf16_t* XS = P_XS; int* tok_e = P_TOKE; int* tok_rank = P_RANK; int* tok_slot = P_SLOT; int* blkcnt = P_BLKCNT; int* tile_e = P_TILEE; int* ntiles_p = P_NT;
        LAS int* red = (LAS int*)lds;
        LAS int* totS = red + 1024;
        LAS int* preS = totS + 32;
        LAS int* padS = preS + 32;
        LAS int* slotS = padS + 64;
        { const int e = tid & 31, part = tid >> 5; int tot = 0, pre = 0;
            for (int blk = part; blk < 256; blk += 16) { const int cval = blkcnt[blk * 32 + e]; tot += cval; pre += (blk < cb) ? cval : 0; }
            red[part * 64 + e] = tot; red[part * 64 + 32 + e] = pre; }
        __syncthreads();
        if (tid < 32) { int tot = 0, pre = 0; for (int p = 0; p < 16; ++p) { tot += red[p * 64 + tid]; pre += red[p * 64 + 32 + tid]; } totS[tid] = tot; preS[tid] = pre; }
        __syncthreads();
        if (tid == 0) { int off = 0; for (int e = 0; e < 32; ++e) { padS[e] = off; off += ((totS[e] + 255) >> 8) << 8; } padS[32] = off; }
        __syncthreads();
        if (cb == 0) { if (tid < 32) { for (int t = padS[tid] >> 8; t < (padS[tid + 1] >> 8); ++t) tile_e[t] = tid; } if (tid == 32) ntiles_p[0] = padS[32] >> 8; }
        if (tid < 128) { const size_t a = (size_t)cb * 128 + tid; const int e = tok_e[a]; const int slot = padS[e] + preS[e] + tok_rank[a]; tok_slot[a] = slot; slotS[tid] = slot; }
        __syncthreads();
        for (int a = wave * 16; a < wave * 16 + 16; ++a) { const size_t t = (size_t)cb * 64 + (a >> 1); const int slot = slotS[a];
            const u32x4* src = (const u32x4*)(H2 + t * D) + lane; u32x4* dst = (u32x4*)(XS + (size_t)slot * D) + lane;
            dst[0] = src[0]; dst[64] = src[64]; }
        if (cb < 32) { const int r0 = padS[cb] + totS[cb], r1 = padS[cb + 1];
            for (int r = r0 + wave; r < r1; r += NWAVES) { u32x4* dst = (u32x4*)(XS + (size_t)r * D) + lane; dst[0] = (u32x4){0, 0, 0, 0}; dst[64] = (u32x4){0, 0, 0, 0}; } }
    }
    SEAM(9);

    if constexpr (IN(10)) {
        asm volatile("; PHASE_BEGIN 10" ::: "memory");
        PHASE_LOCALS
        bf16_t* XS = P_XS; bf16_t* W13_t = P_W13; bf16_t* HMID = P_HMID; int* tile_e = P_TILEE; int* ntiles_p = P_NT;
        const int ntm = __builtin_amdgcn_readfirstlane(ntiles_p[0]);
        pg8::MoeOrder S; S.init(XS, W13_t, tile_e, ntm, D, (size_t)1024 * 1024 * 2, G, cb); pg8::EpiUp E{HMID};
        pg8::gemm_phase<pg8::EpiUp, pg8::MoeOrder, true, true>(lds, D, S, E);
    }
    SEAM(10);

    if constexpr (IN(11)) {
        asm volatile("; PHASE_BEGIN 11" ::: "memory");
        PHASE_LOCALS
        bf16_t* HMID = P_HMID; bf16_t* W2_t = P_W2; bf16_t* Y = P_Y; int* tile_e = P_TILEE; int* ntiles_p = P_NT;
        const int ntm = __builtin_amdgcn_readfirstlane(ntiles_p[0]);
        pg8::MoeOrder S; S.init(HMID, W2_t, tile_e, ntm, DEXP, (size_t)1024 * 512 * 2, G, cb); pg8::EpiPlain E{Y, D};
        pg8::gemm_phase<pg8::EpiPlain, pg8::MoeOrder, true, true>(lds, DEXP, S, E);
    }
    SEAM(11);

    if constexpr (IN(12)) {
        asm volatile("; PHASE_BEGIN 12" ::: "memory");
        PHASE_LOCALS
        float* out = OUTP; float* modf = P_MODF; bf16_t* Y = P_Y; int* tok_slot = P_SLOT; float* tok_w = P_TOKW;
        for (int i = 0; i < 8; ++i) {
            const size_t m = (size_t)cb * 64 + wave * 8 + i; const int b = cb >> 6;
            const int s0 = tok_slot[m * 2], s1 = tok_slot[m * 2 + 1]; const float w0 = tok_w[m * 2], w1 = tok_w[m * 2 + 1];
            const float* g2p = modf + (size_t)b * NMOD + 5 * D;
#pragma unroll
            for (int j = 0; j < 4; ++j) { const int k = 4 * lane + 256 * j;
                const f32x4 xv = *(const f32x4*)(out + m * D + k); const f32x4 gv = *(const f32x4*)(g2p + k);
                const u32x2 y0 = *(const u32x2*)(Y + (size_t)s0 * D + k), y1 = *(const u32x2*)(Y + (size_t)s1 * D + k);
                f32x4 o; o.x = xv.x + gv.x * (w0 * lo_bf(y0.x) + w1 * lo_bf(y1.x)); o.y = xv.y + gv.y * (w0 * hi_bf(y0.x) + w1 * hi_bf(y1.x));
                o.z = xv.z + gv.z * (w0 * lo_bf(y0.y) + w1 * lo_bf(y1.y)); o.w = xv.w + gv.w * (w0 * hi_bf(y0.y) + w1 * hi_bf(y1.y));
                *(f32x4*)(out + m * D + k) = o; }
        }
    }
#undef IN
#undef SEAM
}

constexpr int NPHASE = 13;
template <int LO, int HI> static void launch_range(const Args& a, hipStream_t stream) {
    static bool attr = false;
    if (!attr) { (void)hipFuncSetAttribute((const void*)mk_fwd<LO, HI>, hipFuncAttributeMaxDynamicSharedMemorySize, LDS_BYTES); attr = true; }
    hipLaunchKernelGGL((mk_fwd<LO, HI>), dim3(256), dim3(NTHR), LDS_BYTES, stream, a);
}
extern "C" void kernel_launch(void* const* d_in, const int* in_sizes, int n_in, void* d_out, int out_size, void* d_ws, size_t ws_size, hipStream_t stream) {
    static int ok = 0;
    if (ok == 0) {
        if (n_in != 28 || out_size != M * D || ws_size < WS_END) { fprintf(stderr, "kernel_launch: unexpected shapes (n_in %d, out %d, ws %zu < %zu)\n", n_in, out_size, ws_size, (size_t)WS_END); ok = -1; return; }
        ok = 1;
    }
    if (ok < 0) return;
    (void)hipMemsetAsync((char*)d_ws + WS_CTL, 0, CTL_ZERO_BYTES, stream);
    Args a{};
    for (int i = 0; i < 28; ++i) a.in[i] = d_in[i];
    a.out = (float*)d_out; a.ws = (unsigned char*)d_ws; a.ph_lo = 0; a.ph_hi = NPHASE;
#if MK_ONE_LAUNCH
    launch_range<0, NPHASE>(a, stream);
#else
    launch_range<0, 1>(a, stream); launch_range<1, 2>(a, stream); launch_range<2, 3>(a, stream); launch_range<3, 4>(a, stream);
    launch_range<4, 5>(a, stream); launch_range<5, 6>(a, stream); launch_range<6, 7>(a, stream); launch_range<7, 8>(a, stream);
    launch_range<8, 9>(a, stream); launch_range<9, 10>(a, stream); launch_range<10, 11>(a, stream); launch_range<11, 12>(a, stream);
    launch_range<12, 13>(a, stream);
#endif
}
```

```cpp
#include <hip/hip_runtime.h>
#include <hip/hip_bf16.h>
#include <cstdio>
#include <cstdint>

#ifndef MK_ONE_LAUNCH
#define MK_ONE_LAUNCH 1
#endif

#define LAS __attribute__((address_space(3)))
#define GAS __attribute__((address_space(1)))
typedef unsigned short bf16_t;
typedef short bf16x8 __attribute__((ext_vector_type(8)));
typedef float f32x4 __attribute__((ext_vector_type(4)));
typedef float f32x2 __attribute__((ext_vector_type(2)));
typedef unsigned u32x4 __attribute__((ext_vector_type(4)));
typedef unsigned u32x2 __attribute__((ext_vector_type(2)));

constexpr int NB = 4, SEQ = 4096, D = 1024, M = NB * SEQ;
constexpr int DIN = 5136, NPROJ = 5120;
constexpr int NEXP = 32, DEXP = 512;
constexpr int PMAX = 40960;
constexpr int NMOD = 6 * D;

constexpr size_t MiB = 1u << 20;
constexpr size_t WS_CTL = 0, CTL_ZERO_BYTES = 1 * MiB;
constexpr size_t WS_MODP = 1 * MiB;
constexpr size_t WS_MODF = 4 * MiB;
constexpr size_t WS_ALR = 5 * MiB;
constexpr size_t WS_ROUTE = 6 * MiB;
constexpr size_t WS_WIN = 8 * MiB;
constexpr size_t WS_WA = 18 * MiB, WS_WB = 19 * MiB, WS_WOUT = 20 * MiB;
constexpr size_t RA = 22 * MiB;
constexpr size_t RB = 118 * MiB;
constexpr size_t WS_END = 278 * MiB;
constexpr size_t WS_XN = RA;
constexpr size_t WS_LOGA = RA;
constexpr size_t WS_SCT = RA + 16 * MiB;
constexpr size_t WS_SPT = RA + 48 * MiB;
constexpr size_t WS_OC = RA + 64 * MiB;
constexpr size_t WS_DEC = 7 * MiB;
constexpr size_t WS_WRT = 7 * MiB + 512 * 1024;
constexpr size_t WS_OB = RB + 64 * MiB;
constexpr size_t WS_OA = RB + 48 * MiB;
constexpr size_t WS_XS = RA;
constexpr size_t WS_Y = RA;
constexpr size_t WS_UGLA = RB;
constexpr size_t WS_UDIFF = RB + 48 * MiB;
constexpr size_t WS_UGATE = RB + 96 * MiB;
constexpr size_t WS_M1 = RA;
constexpr size_t WS_MERGED = RB;
constexpr size_t WS_H2 = RB;
constexpr size_t WS_W13 = RB + 64 * MiB;
constexpr size_t WS_W2 = RB + 128 * MiB;
constexpr size_t WS_HMID = RB;
constexpr size_t RT_TOKE = 0, RT_TOKW = 131072, RT_RANK = 262144, RT_SLOT = 393216, RT_BLKCNT = 524288, RT_TILEE = 557056, RT_NT = 561152;
constexpr int CW_BAR = 4096;

constexpr int RING_BYTES = 131072;
constexpr int LDSCTL_OFF = RING_BYTES, MISC_OFF = LDSCTL_OFF + 320;
constexpr int LDS_BYTES = 147456;
constexpr int NWAVES = 8, NTHR = 512;

__device__ __forceinline__ float bf2f(bf16_t h) { return __uint_as_float((unsigned)h << 16); }
__device__ __forceinline__ unsigned f2bf(float f) { unsigned u = __float_as_uint(f); return (u + 0x7fffu + ((u >> 16) & 1u)) >> 16; }
__device__ __forceinline__ unsigned pk2(float lo, float hi) { return f2bf(lo) | (f2bf(hi) << 16); }
__device__ __forceinline__ float lo_bf(unsigned w) { return __uint_as_float(w << 16); }
__device__ __forceinline__ float hi_bf(unsigned w) { return __uint_as_float(w & 0xffff0000u); }
__device__ __forceinline__ float wave_sum(float v) {
#pragma unroll
    for (int o = 1; o < 64; o <<= 1) v += __shfl_xor(v, o);
    return v;
}
__device__ __forceinline__ float wave_max(float v) {
#pragma unroll
    for (int o = 1; o < 64; o <<= 1) v = fmaxf(v, __shfl_xor(v, o));
    return v;
}
__device__ __forceinline__ float sigmoidf_(float x) { return 1.0f / (1.0f + __expf(-x)); }
__device__ __forceinline__ float siluf_(float x) { return x / (1.0f + __expf(-x)); }
#define LDS_WAIT() asm volatile("s_waitcnt lgkmcnt(0)" ::: "memory")
#define VM_WAIT() asm volatile("s_waitcnt vmcnt(0)" ::: "memory")

namespace pg8 {
constexpr int BM = 256, BK = 64, HALF = 128, HTB = HALF * BK * 2, STAGE_BYTES = 8 * HTB, NXCD = 8, WGM = 8;
__host__ __device__ __forceinline__ int lds_byte(int r, int c) { const int st = (r >> 4) * 2 + (c >> 5), rr = r & 15, cc = c & 31, ob = rr * 64 + cc * 2; return st * 1024 + (ob ^ (((ob >> 9) & 1) << 5)); }
__host__ __device__ __forceinline__ void stage_rc(int b, int& R, int& C) { const int st = b / 1024, sb = b % 1024, swz = sb ^ (((sb >> 9) & 1) << 5); R = (st >> 1) * 16 + swz / 64; C = (st & 1) * 32 + (swz % 64) / 2; }
__host__ __device__ __forceinline__ int perm32(int rho) { const int n = rho >> 4, i = rho & 15; return 8 * (i >> 2) + 4 * n + (i & 3); }

struct Unit { int pm, pn, aux; };

__device__ __forceinline__ int xcd_swizzle(int wgid, int nwg) { const int q = nwg / NXCD, r = nwg % NXCD, xcd = wgid % NXCD, off = wgid / NXCD; return (xcd < r ? xcd * (q + 1) : r * (q + 1) + (xcd - r) * q) + off; }

struct DenseOrder {
    const char* A; const char* Bt; size_t tstep; int nM, nN, nwg, G, c;
    __device__ __forceinline__ void init(const void* A_, const void* Bt_, int M_, int N_, int K_, int G_, int c_) { A = (const char*)A_; Bt = (const char*)Bt_; tstep = (size_t)BM * K_ * 2; nM = M_ / BM; nN = N_ / BM; nwg = nM * nN; G = G_; c = c_; }
    __device__ __forceinline__ bool next(int i, Unit& u) const {
        const long L = (long)i * G + c; if (L >= nwg) return false;
        const int wgid = xcd_swizzle((int)L, nwg);
        const int nig = WGM * nN, gid = wgid / nig, fm = gid * WGM, gsz = (nM - fm) < WGM ? (nM - fm) : WGM;
        u.pm = fm + ((wgid % nig) % gsz); u.pn = (wgid % nig) / gsz; u.aux = 0; return true;
    }
    __device__ __forceinline__ const char* a_ptr(const Unit& u) const { return A + (size_t)u.pm * tstep; }
    __device__ __forceinline__ const char* b_ptr(const Unit& u) const { return Bt + (size_t)u.pn * tstep; }
};
struct MoeOrder {
    const char* A; const char* W; const int* tile_e; size_t tstep, estride; int nwg, G, c;
    __device__ __forceinline__ void init(const void* A_, const void* W_, const int* te, int ntm, int K_, size_t estride_, int G_, int c_) { A = (const char*)A_; W = (const char*)W_; tile_e = te; tstep = (size_t)BM * K_ * 2; estride = estride_; nwg = ntm * 4; G = G_; c = c_; }
    __device__ __forceinline__ bool next(int i, Unit& u) const {
        const long L = (long)i * G + c; if (L >= nwg) return false;
        const int wgid = xcd_swizzle((int)L, nwg);
        u.pm = wgid >> 2; u.pn = wgid & 3; u.aux = __builtin_amdgcn_readfirstlane(tile_e[u.pm]); return true;
    }
    __device__ __forceinline__ const char* a_ptr(const Unit& u) const { return A + (size_t)u.pm * tstep; }
    __device__ __forceinline__ const char* b_ptr(const Unit& u) const { return W + (size_t)u.aux * estride + (size_t)u.pn * tstep; }
};

__device__ __forceinline__ u32x4 pack8(const f32x4& v0, const f32x4& v1) { u32x4 w; w.x = pk2(v0[0], v0[1]); w.y = pk2(v0[2], v0[3]); w.z = pk2(v1[0], v1[1]); w.w = pk2(v1[2], v1[3]); return w; }

struct EpiInProj {
    static constexpr bool PERM = true, AFTER_DRAIN = false;
    bf16_t *Ugla, *Udiff, *Ugate;
    __device__ __forceinline__ void operator()(const f32x4 (&acc)[2][2][4][2], const Unit& u, int wr, int wc, int fr, int fq) const {
        bf16_t* base; int ldc, colt;
        if (u.pn < 6) { base = Ugla; ldc = 1536; colt = u.pn * 256; } else if (u.pn < 12) { base = Udiff; ldc = 1536; colt = (u.pn - 6) * 256; } else { base = Ugate; ldc = 2048; colt = (u.pn - 12) * 256; }
        const int row0 = u.pm * BM + wr * 64 + fr, col0 = colt + wc * 32 + 8 * fq;
#pragma unroll
        for (int ai = 0; ai < 2; ++ai)
#pragma unroll
            for (int m = 0; m < 4; ++m) { bf16_t* rowp = base + (size_t)(row0 + ai * HALF + m * 16) * ldc + col0;
#pragma unroll
                for (int bj = 0; bj < 2; ++bj) *(u32x4*)(rowp + bj * HALF) = pack8(acc[ai][bj][m][0], acc[ai][bj][m][1]); }
    }
};
struct EpiPlain {
    static constexpr bool PERM = true, AFTER_DRAIN = false;
    bf16_t* O; int ldc;
    __device__ __forceinline__ void operator()(const f32x4 (&acc)[2][2][4][2], const Unit& u, int wr, int wc, int fr, int fq) const {
        const int row0 = u.pm * BM + wr * 64 + fr, col0 = u.pn * BM + wc * 32 + 8 * fq;
#pragma unroll
        for (int ai = 0; ai < 2; ++ai)
#pragma unroll
            for (int m = 0; m < 4; ++m) { bf16_t* rowp = O + (size_t)(row0 + ai * HALF + m * 16) * ldc + col0;
#pragma unroll
                for (int bj = 0; bj < 2; ++bj) *(u32x4*)(rowp + bj * HALF) = pack8(acc[ai][bj][m][0], acc[ai][bj][m][1]); }
    }
};
struct EpiBranch {
    static constexpr bool PERM = true, AFTER_DRAIN = false;
    const bf16_t* gate; int gcol0; const bf16_t* m1in; bf16_t* out;
    __device__ __forceinline__ void operator()(const f32x4 (&acc)[2][2][4][2], const Unit& u, int wr, int wc, int fr, int fq) const {
        const int row0 = u.pm * BM + wr * 64 + fr, col0 = u.pn * BM + wc * 32 + 8 * fq;
#pragma unroll
        for (int ai = 0; ai < 2; ++ai)
#pragma unroll
            for (int m = 0; m < 4; ++m) { const size_t r = (size_t)(row0 + ai * HALF + m * 16);
#pragma unroll
                for (int bj = 0; bj < 2; ++bj) { const int c = col0 + bj * HALF;
                    const u32x4 g = *(const u32x4*)(gate + r * 2048 + gcol0 + c);
                    f32x4 v0 = acc[ai][bj][m][0], v1 = acc[ai][bj][m][1];
                    v0[0] *= sigmoidf_(lo_bf(g.x)); v0[1] *= sigmoidf_(hi_bf(g.x)); v0[2] *= sigmoidf_(lo_bf(g.y)); v0[3] *= sigmoidf_(hi_bf(g.y));
                    v1[0] *= sigmoidf_(lo_bf(g.z)); v1[1] *= sigmoidf_(hi_bf(g.z)); v1[2] *= sigmoidf_(lo_bf(g.w)); v1[3] *= sigmoidf_(hi_bf(g.w));
                    if (m1in) { const u32x4 p = *(const u32x4*)(m1in + r * 1024 + c);
                        v0[0] += lo_bf(p.x); v0[1] += hi_bf(p.x); v0[2] += lo_bf(p.y); v0[3] += hi_bf(p.y); v1[0] += lo_bf(p.z); v1[1] += hi_bf(p.z); v1[2] += lo_bf(p.w); v1[3] += hi_bf(p.w); }
                    *(u32x4*)(out + r * 1024 + c) = pack8(v0, v1); } }
    }
};
struct EpiWout {
    static constexpr bool PERM = false, AFTER_DRAIN = false;
    const float* x; const float* modf; float* out;
    __device__ __forceinline__ void operator()(const f32x4 (&acc)[2][2][4][2], const Unit& u, int wr, int wc, int fr, int fq) const {
        const int row0 = u.pm * BM + wr * 64 + fr, col0 = u.pn * BM + wc * 32 + 4 * fq;
        const float* g1 = modf + (size_t)((u.pm * BM) >> 12) * NMOD + 2 * D;
#pragma unroll
        for (int bj = 0; bj < 2; ++bj)
#pragma unroll
            for (int n = 0; n < 2; ++n) { const int c = col0 + bj * HALF + n * 16; const f32x4 gv = *(const f32x4*)(g1 + c);
#pragma unroll
                for (int ai = 0; ai < 2; ++ai)
#pragma unroll
                    for (int m = 0; m < 4; ++m) { const size_t off = (size_t)(row0 + ai * HALF + m * 16) * D + c;
                        const f32x4 xv = *(const f32x4*)(x + off); *(f32x4*)(out + off) = xv + gv * acc[ai][bj][m][n]; } }
    }
};
struct EpiUp {
    static constexpr bool PERM = true, AFTER_DRAIN = false;
    bf16_t* H;
    __device__ __forceinline__ void operator()(const f32x4 (&acc)[2][2][4][2], const Unit& u, int wr, int wc, int fr, int fq) const {
        const int row0 = u.pm * BM + wr * 64 + fr, col0 = u.pn * HALF + wc * 32 + 8 * fq;
#pragma unroll
        for (int ai = 0; ai < 2; ++ai)
#pragma unroll
            for (int m = 0; m < 4; ++m) { f32x4 v0, v1;
#pragma unroll
                for (int e = 0; e < 4; ++e) { v0[e] = siluf_(acc[ai][0][m][0][e]) * acc[ai][1][m][0][e]; v1[e] = siluf_(acc[ai][0][m][1][e]) * acc[ai][1][m][1][e]; }
                *(u32x4*)(H + (size_t)(row0 + ai * HALF + m * 16) * DEXP + col0) = pack8(v0, v1); }
    }
};

template <class Epi, class Sched, bool ALIGN_EPI = false, bool SP2 = false>
__device__ __forceinline__ void gemm_phase(LAS unsigned char* lds, const int K, const Sched& S, const Epi& E) {
    int tid_ = threadIdx.x; asm volatile("" : "+v"(tid_));
    const int tid = tid_, wid = __builtin_amdgcn_readfirstlane(tid >> 6), lane = tid & 63, wr = wid >> 2, wc = wid & 3, fr = lane & 15, fq = lane >> 4;
    const int nt = K / BK;
    unsigned voffA[2], voffB[2];
#pragma unroll
    for (int i = 0; i < 2; ++i) { int R, C; stage_rc(tid * 16 + i * 8192, R, C); const int Rb = Epi::PERM ? ((R & ~31) + perm32(R & 31)) : R;
        voffA[i] = (unsigned)(R * K + C) * 2u; voffB[i] = (unsigned)(Rb * K + C) * 2u; }
    const size_t kstep = (size_t)(BK * 2);
    const size_t hstep = (size_t)HALF * K * 2;
    const unsigned ldsw = (unsigned)wid * 1024u;
    const int aoff = lds_byte(wr * 64 + fr, fq * 8), boff = lds_byte(wc * 32 + fr, fq * 8);
#define PG8_SA(b, h) (((b) * 2 + (h)) * HTB)
#define PG8_SB(b, h) ((4 + (b) * 2 + (h)) * HTB)
#define PG8_STAGE(bufoff, gbase, voff) do { _Pragma("unroll") for (int _i = 0; _i < 2; ++_i) \
        __builtin_amdgcn_global_load_lds((const unsigned*)((const char*)(gbase) + (voff)[_i]), (LAS unsigned*)(lds + (bufoff) + ldsw + _i * 8192), 16, 0, 0); } while (0)
#define PG8_LDA(dst, b, h) do { _Pragma("unroll") for (int m = 0; m < 4; ++m) _Pragma("unroll") for (int k = 0; k < 2; ++k) dst[m][k] = *(const LAS bf16x8*)(lds + PG8_SA(b, h) + aoff + m * 2048 + k * 1024); } while (0)
#define PG8_LDB(dst, b, h) do { _Pragma("unroll") for (int n = 0; n < 2; ++n) _Pragma("unroll") for (int k = 0; k < 2; ++k) dst[n][k] = *(const LAS bf16x8*)(lds + PG8_SB(b, h) + boff + n * 2048 + k * 1024); } while (0)
#define PG8_MMA(ai, bj, At, Bt) do { __builtin_amdgcn_s_setprio(1); _Pragma("unroll") for (int m = 0; m < 4; ++m) _Pragma("unroll") for (int n = 0; n < 2; ++n) _Pragma("unroll") for (int k = 0; k < 2; ++k) \
        acc[ai][bj][m][n] = __builtin_amdgcn_mfma_f32_16x16x32_bf16(Bt[n][k], At[m][k], acc[ai][bj][m][n], 0, 0, 0); __builtin_amdgcn_s_setprio(0); } while (0)
#define PG8_WAIT_V(n) asm volatile("s_waitcnt vmcnt(" #n ")" ::: "memory")
#define PG8_WAIT_L(n) asm volatile("s_waitcnt lgkmcnt(" #n ")" ::: "memory")
#define PG8_BAR __builtin_amdgcn_s_barrier()
#define PG8_SCHED __builtin_amdgcn_sched_barrier(0)
    Unit cur, nxt; int ui = 0;
    if (!S.next(0, cur)) return;
    f32x4 acc[2][2][4][2];
#pragma unroll
    for (int a = 0; a < 2; ++a)
#pragma unroll
        for (int b = 0; b < 2; ++b)
#pragma unroll
            for (int m = 0; m < 4; ++m)
#pragma unroll
                for (int n = 0; n < 2; ++n) acc[a][b][m][n] = (f32x4){0.f, 0.f, 0.f, 0.f};
    bf16x8 At[4][2], B0[2][2], B1[2][2];
    const char* cA = S.a_ptr(cur); const char* cB = S.b_ptr(cur);
    if constexpr (SP2) {
        PG8_STAGE(PG8_SB(0, 0), cB, voffB); PG8_STAGE(PG8_SB(0, 1), cB + hstep, voffB); PG8_STAGE(PG8_SA(0, 0), cA, voffA); PG8_STAGE(PG8_SA(0, 1), cA + hstep, voffA);
        if (wr == 1) PG8_BAR;
        PG8_WAIT_V(2); PG8_BAR;
        PG8_STAGE(PG8_SB(1, 0), cB + kstep, voffB); PG8_STAGE(PG8_SA(1, 0), cA + kstep, voffA); PG8_STAGE(PG8_SB(1, 1), cB + hstep + kstep, voffB);
        PG8_WAIT_V(6); PG8_BAR;
    } else {
        PG8_STAGE(PG8_SB(0, 0), cB, voffB); PG8_STAGE(PG8_SA(0, 0), cA, voffA); PG8_STAGE(PG8_SB(0, 1), cB + hstep, voffB); PG8_STAGE(PG8_SA(0, 1), cA + hstep, voffA);
        if (wr == 1) PG8_BAR;
        PG8_WAIT_V(4); PG8_BAR;
        PG8_STAGE(PG8_SB(1, 0), cB + kstep, voffB); PG8_STAGE(PG8_SA(1, 0), cA + kstep, voffA); PG8_STAGE(PG8_SB(1, 1), cB + hstep + kstep, voffB);
        PG8_WAIT_V(6); PG8_BAR;
    }
    for (;;) {
        const bool has_next = S.next(ui + 1, nxt);
        const char* nA = has_next ? S.a_ptr(nxt) : cA; const char* nB = has_next ? S.b_ptr(nxt) : cB;
        for (int t = 0; t < nt; t += 2) {
            const bool last = (t == nt - 2);
            const char* a1 = cA + (size_t)(t + 1) * kstep;
            const char* a2 = last ? nA : cA + (size_t)(t + 2) * kstep; const char* b2 = last ? nB : cB + (size_t)(t + 2) * kstep;
            const char* a3 = a2 + kstep; const char* b3 = b2 + kstep;
            if constexpr (SP2) {
            PG8_LDB(B0, 0, 0); PG8_LDB(B1, 0, 1); PG8_SCHED; PG8_LDA(At, 0, 0); PG8_STAGE(PG8_SA(1, 1), a1 + hstep, voffA);
            PG8_WAIT_V(8); PG8_WAIT_L(0); PG8_BAR; PG8_MMA(0, 0, At, B0); PG8_MMA(0, 1, At, B1); PG8_BAR; PG8_SCHED;
            PG8_LDA(At, 0, 1); PG8_STAGE(PG8_SB(0, 0), b2, voffB); PG8_STAGE(PG8_SB(0, 1), b2 + hstep, voffB); PG8_STAGE(PG8_SA(0, 0), a2, voffA);
            PG8_WAIT_V(8); PG8_WAIT_L(0); PG8_BAR; PG8_MMA(1, 0, At, B0); PG8_MMA(1, 1, At, B1); PG8_BAR; PG8_SCHED;
            PG8_LDB(B0, 1, 0); PG8_LDB(B1, 1, 1); PG8_SCHED; PG8_LDA(At, 1, 0); PG8_STAGE(PG8_SA(0, 1), a2 + hstep, voffA);
            PG8_WAIT_V(8); PG8_WAIT_L(0); PG8_BAR; PG8_MMA(0, 0, At, B0); PG8_MMA(0, 1, At, B1); PG8_BAR; PG8_SCHED;
            PG8_LDA(At, 1, 1); PG8_STAGE(PG8_SB(1, 0), b3, voffB); PG8_STAGE(PG8_SB(1, 1), b3 + hstep, voffB); PG8_STAGE(PG8_SA(1, 0), a3, voffA);
            PG8_WAIT_V(8); PG8_WAIT_L(0); PG8_BAR; PG8_MMA(1, 0, At, B0); PG8_MMA(1, 1, At, B1); PG8_BAR; PG8_SCHED;
            } else {
            PG8_LDB(B0, 0, 0); PG8_SCHED; PG8_LDA(At, 0, 0); PG8_STAGE(PG8_SA(1, 1), a1 + hstep, voffA);
            PG8_WAIT_L(8); PG8_BAR; PG8_WAIT_L(0); PG8_MMA(0, 0, At, B0); PG8_BAR; PG8_SCHED;
            PG8_LDB(B1, 0, 1); PG8_STAGE(PG8_SB(0, 0), b2, voffB);
            PG8_BAR; PG8_WAIT_L(0); PG8_MMA(0, 1, At, B1); PG8_BAR;
            PG8_LDA(At, 0, 1); PG8_STAGE(PG8_SA(0, 0), a2, voffA);
            PG8_BAR; PG8_WAIT_L(0); PG8_MMA(1, 0, At, B0); PG8_BAR; PG8_SCHED;
            PG8_STAGE(PG8_SB(0, 1), b2 + hstep, voffB);
            PG8_WAIT_V(6); PG8_BAR; PG8_MMA(1, 1, At, B1); PG8_BAR;
            PG8_LDB(B0, 1, 0); PG8_SCHED; PG8_LDA(At, 1, 0); PG8_STAGE(PG8_SA(0, 1), a2 + hstep, voffA);
            PG8_WAIT_L(8); PG8_BAR; PG8_WAIT_L(0); PG8_MMA(0, 0, At, B0); PG8_BAR; PG8_SCHED;
            PG8_LDB(B1, 1, 1); PG8_STAGE(PG8_SB(1, 0), b3, voffB);
            PG8_BAR; PG8_WAIT_L(0); PG8_MMA(0, 1, At, B1); PG8_BAR;
            PG8_LDA(At, 1, 1); PG8_STAGE(PG8_SA(1, 0), a3, voffA);
            PG8_BAR; PG8_WAIT_L(0); PG8_MMA(1, 0, At, B0); PG8_BAR; PG8_SCHED;
            PG8_STAGE(PG8_SB(1, 1), b3 + hstep, voffB);
            PG8_WAIT_V(6); PG8_BAR; PG8_MMA(1, 1, At, B1); PG8_BAR;
            }
        }
        if constexpr (ALIGN_EPI) { if (wr == 0) PG8_BAR; }
        E(acc, cur, wr, wc, fr, fq);
        if (!has_next) break;
#pragma unroll
        for (int a = 0; a < 2; ++a)
#pragma unroll
            for (int b = 0; b < 2; ++b)
#pragma unroll
                for (int m = 0; m < 4; ++m)
#pragma unroll
                    for (int n = 0; n < 2; ++n) acc[a][b][m][n] = (f32x4){0.f, 0.f, 0.f, 0.f};
        cur = nxt; cA = nA; cB = nB; ++ui;
        if constexpr (ALIGN_EPI) { if (wr == 1) PG8_BAR; }
    }
    PG8_WAIT_V(0);
    if constexpr (!ALIGN_EPI) { if (wr == 0) PG8_BAR; }
    PG8_BAR;
#undef PG8_SA
#undef PG8_SB
#undef PG8_STAGE
#undef PG8_LDA
#undef PG8_LDB
#undef PG8_MMA
#undef PG8_WAIT_V
#undef PG8_WAIT_L
#undef PG8_BAR
#undef PG8_SCHED
}
}

namespace attn_body {
using bf16=__hip_bfloat16;
using bf16x8=__attribute__((ext_vector_type(8)))short;
using s16x4=__attribute__((ext_vector_type(4)))short;
using f32x16=__attribute__((ext_vector_type(16)))float;
using u32x4=__attribute__((ext_vector_type(4)))unsigned;
constexpr int SEQ=4096,D=64,DM=1536,DMO=512;
constexpr int NW=8,QBLK=32,QB=QBLK*NW,KVBLK=64,NQB=SEQ/QB;
constexpr int ATTN_UNIT_ROWS=QB;
__device__ __forceinline__ int crow(int r,int hi){return (r&3)+8*(r>>2)+4*hi;}
#define SBAR() __builtin_amdgcn_sched_barrier(0)
__device__ __forceinline__ void cmask(f32x16&p0,f32x16&p1,int jb,int qrel,int hi){
  const float NEG=-INFINITY; int kb=64*jb+4*hi;
  #pragma unroll
  for(int r=0;r<16;++r){int kv=kb+(r&3)+8*(r>>2); if(kv>qrel)p0[r]=NEG; if(kv+32>qrel)p1[r]=NEG;}
}

constexpr int NSLOT=3, SLOTB=8192;
constexpr int LDS_K=0, LDS_V=NSLOT*SLOTB, LDS_WS=2*NSLOT*SLOTB, LDS_OST=LDS_WS+NW*64*4, LDS_BYTES=LDS_OST+NW*4096;
constexpr float C2=0.125f*1.4426950408889634f;
__device__ __forceinline__ void glds16(const void*gsrc,unsigned lds_dst){unsigned keep;
  asm volatile("s_mov_b32 %0, m0\n\ts_mov_b32 m0, %2\n\ts_nop 0\n\tglobal_load_lds_dwordx4 %1, off\n\ts_mov_b32 m0, %0":"=&s"(keep):"v"(gsrc),"s"(lds_dst):"memory");}
__device__ __forceinline__ float max3f(float a,float b,float c){float r;asm("v_max3_f32 %0, %1, %2, %3":"=v"(r):"v"(a),"v"(b),"v"(c));return r;}
__device__ __forceinline__ float max2f(float a,float b){float r;asm("v_max_f32_e32 %0, %1, %2":"=v"(r):"v"(a),"v"(b));return r;}
__device__ __forceinline__ float fadd_s(float a,float b){float r;asm("v_add_f32_e32 %0, %1, %2":"=v"(r):"v"(a),"v"(b));return r;}
__device__ __forceinline__ float fsub_s(float a,float b){float r;asm("v_sub_f32_e32 %0, %1, %2":"=v"(r):"v"(a),"v"(b));return r;}
typedef float f32x2_t __attribute__((ext_vector_type(2))); typedef __bf16 bf16x2_t __attribute__((ext_vector_type(2)));
__device__ __forceinline__ unsigned cvtpk_s(float lo,float hi){f32x2_t v={lo,hi};bf16x2_t b=__builtin_convertvector(v,bf16x2_t);return __builtin_bit_cast(unsigned,b);}
#define WAIT_BAR(N) asm volatile("s_waitcnt vmcnt(" #N ") lgkmcnt(0)\n\ts_barrier":::"memory")

__device__ __forceinline__ void qkt(f32x16&p0,f32x16&p1,const char*Kslot,const bf16x8*qr,const f32x16&negm,int r32,int hi){
  const char*kb=Kslot+hi*1024+r32*16;
  #pragma unroll
  for(int d0=0;d0<4;++d0){
    const bf16x8 b0=*reinterpret_cast<const bf16x8*>(kb+d0*2048);
    const bf16x8 b1=*reinterpret_cast<const bf16x8*>(kb+d0*2048+512);
    if(d0==0){p0=__builtin_amdgcn_mfma_f32_32x32x16_bf16(b0,qr[0],negm,0,0,0);p1=__builtin_amdgcn_mfma_f32_32x32x16_bf16(b1,qr[0],negm,0,0,0);}
    else{p0=__builtin_amdgcn_mfma_f32_32x32x16_bf16(b0,qr[d0],p0,0,0,0);p1=__builtin_amdgcn_mfma_f32_32x32x16_bf16(b1,qr[d0],p1,0,0,0);}}
}
typedef __attribute__((address_space(3))) const char* lds_cptr;
typedef short v4i16_t __attribute__((ext_vector_type(4)));
__device__ __forceinline__ void kload8(bf16x8*kf,lds_cptr kp){
  kf[0]=*(const __attribute__((address_space(3))) bf16x8*)(kp);      kf[1]=*(const __attribute__((address_space(3))) bf16x8*)(kp+512);
  kf[2]=*(const __attribute__((address_space(3))) bf16x8*)(kp+2048); kf[3]=*(const __attribute__((address_space(3))) bf16x8*)(kp+2560);
  kf[4]=*(const __attribute__((address_space(3))) bf16x8*)(kp+4096); kf[5]=*(const __attribute__((address_space(3))) bf16x8*)(kp+4608);
  kf[6]=*(const __attribute__((address_space(3))) bf16x8*)(kp+6144); kf[7]=*(const __attribute__((address_space(3))) bf16x8*)(kp+6656);
}
__device__ __forceinline__ void kload2(bf16x8*kf,lds_cptr kp,int j){ kf[2*j]=*(const __attribute__((address_space(3))) bf16x8*)(kp+j*2048); kf[2*j+1]=*(const __attribute__((address_space(3))) bf16x8*)(kp+j*2048+512); }
__device__ __forceinline__ s16x4 vtr(lds_cptr p){ return __builtin_bit_cast(s16x4,__builtin_amdgcn_ds_read_tr16_b64_v4i16((__attribute__((address_space(3))) v4i16_t*)p)); }
__device__ __forceinline__ float rowmax(const f32x16&p0,const f32x16&p1){
  float a=max3f(p0[0],p0[1],p1[0]),b=max3f(p0[2],p0[3],p1[1]);a=max3f(a,p1[2],p1[3]);
  #pragma unroll
  for(int r=4;r<16;r+=4){a=max3f(a,p0[r],p0[r+1]);b=max3f(b,p0[r+2],p0[r+3]);a=max3f(a,p1[r],p1[r+1]);b=max3f(b,p1[r+2],p1[r+3]);}
  const float m=max2f(a,b);
  auto rr=__builtin_amdgcn_permlane32_swap(__float_as_uint(m),__float_as_uint(m),false,false);
  return max2f(__uint_as_float(rr[0]),__uint_as_float(rr[1]));
}
__device__ __forceinline__ void pv(f32x16*o,int vb,bf16x8 pa0,bf16x8 pa1,bf16x8 pa2,bf16x8 pa3){
  #pragma unroll
  for(int d0=0;d0<2;++d0){s16x4 lo[4],hi[4];
    #pragma unroll
    for(int ks=0;ks<4;++ks){
      asm volatile("ds_read_b64_tr_b16 %0,%1 offset:%c2":"=&v"(lo[ks]):"v"(vb),"i"(d0*4096+ks*1024):"memory");
      asm volatile("ds_read_b64_tr_b16 %0,%1 offset:%c2":"=&v"(hi[ks]):"v"(vb),"i"(d0*4096+ks*1024+512):"memory");}
    asm volatile("s_waitcnt lgkmcnt(0)":::"memory");SBAR();
    #define PK(k) (bf16x8){lo[k][0],lo[k][1],lo[k][2],lo[k][3],hi[k][0],hi[k][1],hi[k][2],hi[k][3]}
    o[d0]=__builtin_amdgcn_mfma_f32_32x32x16_bf16(pa0,PK(0),o[d0],0,0,0);
    o[d0]=__builtin_amdgcn_mfma_f32_32x32x16_bf16(pa1,PK(1),o[d0],0,0,0);
    o[d0]=__builtin_amdgcn_mfma_f32_32x32x16_bf16(pa2,PK(2),o[d0],0,0,0);
    o[d0]=__builtin_amdgcn_mfma_f32_32x32x16_bf16(pa3,PK(3),o[d0],0,0,0);
    #undef PK
  }
}

#ifndef ATTN_STORE16
#define ATTN_STORE16(p,v) (*(u32x4*)(p)=(v))
#endif
template<int THRL> __device__ __forceinline__ void attn_unit(int b,int qcol,int kcol,int vcol,int ocol,int qb,const bf16*Q,const bf16*__restrict__ K,const bf16*__restrict__ V,bf16*O,char*shm){
  int tid_=threadIdx.x; asm volatile("":"+v"(tid_));
  const int tid=tid_,lane=tid&63,r32=lane&31,hi=lane>>5; const int wid=__builtin_amdgcn_readfirstlane(tid>>6);
  const long rowbase=(long)b*SEQ; const int q0=qb*QB;
  const bf16*Qw=Q+(rowbase+q0+wid*QBLK)*DM+qcol;
  const bf16*Kh=K+rowbase*DM+kcol,*Vh=V+rowbase*DM+vcol;
  const unsigned lds0=(unsigned)(uintptr_t)shm;
  float*wsf=(float*)(shm+LDS_WS)+wid*64;
  const bf16*ksrc=Kh+(long)lane*DM+wid*8;
  const bf16*vsrc=Vh+(long)(16*(wid&3)+(lane>>2))*DM+(wid>>2)*32+(lane&3)*8;
  const unsigned kdst=lds0+LDS_K+wid*1024, vdst=lds0+LDS_V+wid*1024;
  #define DMA_K(t,slot) glds16(ksrc+(long)(t)*KVBLK*DM,(unsigned)__builtin_amdgcn_readfirstlane(kdst+(slot)))
  #define DMA_V(t,slot) glds16(vsrc+(long)(t)*KVBLK*DM,(unsigned)__builtin_amdgcn_readfirstlane(vdst+(slot)))
  const int vb0=(int)(lds0+LDS_V)+((lane>>4)&1)*32+(lane&3)*8+(4*hi+((lane&15)>>2))*64;
  const char*Kbase=shm+LDS_K; bf16x8 kf[8];
  const lds_cptr shm3=(lds_cptr)shm; const lds_cptr kp0=shm3+LDS_K+hi*1024+r32*16; const lds_cptr vp0=shm3+LDS_V+((lane>>4)&1)*32+(lane&3)*8+(4*hi+((lane&15)>>2))*64;
  const int NT=(q0+QB)/KVBLK;
  DMA_K(0,0);DMA_V(0,0);DMA_K(1,SLOTB);
  bf16x8 qr[4];
  #pragma unroll
  for(int d0=0;d0<4;++d0)qr[d0]=*reinterpret_cast<const bf16x8*>(&Qw[(long)r32*DM+d0*16+hi*8]);
  float mhat=0.f,l_reg=0.f;f32x16 o[2];o[0]=f32x16{};o[1]=f32x16{};f32x16 negm=f32x16{};asm volatile("":"+v"(negm));
  const int qrel=wid*QBLK+r32;
  #define CMASK(P0,P1,t) do{int jb_=(t)-(NT-4); if(jb_>=0)cmask(P0,P1,jb_,qrel,hi);}while(0)
  bool resc=false;
  #define START(P0,P1) do{ const float rm=rowmax(P0,P1); resc=false; \
    { const float dl=rm; mhat=fadd_s(mhat,dl); \
      _Pragma("unroll") for(int r=0;r<16;++r){P0[r]=fsub_s(P0[r],dl);P1[r]=fsub_s(P1[r],dl);} \
      _Pragma("unroll") for(int r=0;r<16;++r)negm[r]=-mhat; asm volatile("":"+v"(negm)); } \
    _Pragma("unroll") for(int r=0;r<16;++r)P0[r]=__builtin_amdgcn_exp2f(P0[r]); }while(0)
  #define RESC() do{ if(resc){ asm volatile("s_waitcnt lgkmcnt(0)":::"memory"); \
      _Pragma("unroll") for(int d_=0;d_<2;++d_) _Pragma("unroll") for(int r=0;r<16;++r)o[d_][r]*=wsf[crow(r,hi)]; } }while(0)
  f32x16 pA0,pA1,pB0,pB1;
  int sl_prev=0,sl_cur=0,sl_next=SLOTB;
  #define ROT() do{sl_prev=sl_cur;sl_cur=sl_next;sl_next=(sl_next==(NSLOT-1)*SLOTB)?0:sl_next+SLOTB;}while(0)
  DMA_K(2,2*SLOTB);
  WAIT_BAR(3);
  qkt(pA0,pA1,Kbase,qr,negm,r32,hi);asm volatile("s_nop 15\n\ts_nop 7":"+v"(pA0),"+v"(pA1));CMASK(pA0,pA1,0);
  START(pA0,pA1);
  _Pragma("unroll") for(int r=0;r<16;++r)pA1[r]=__builtin_amdgcn_exp2f(pA1[r]);
  WAIT_BAR(0);
  DMA_K(3,0);DMA_V(1,SLOTB);
  ROT();
  kload8(kf,kp0+sl_cur);
  WAIT_BAR(2);
  s16x4 vlo[8],vhi[8]; u32x4 pw0,pw1,pw2,pw3;
  #define PKW(P,B) cvtpk_s(P[B],P[B+1])
  #define PAF(k) __builtin_bit_cast(bf16x8,pw##k)
  #define VFR(i) (bf16x8){vlo[i][0],vlo[i][1],vlo[i][2],vlo[i][3],vhi[i][0],vhi[i][1],vhi[i][2],vhi[i][3]}
  #define PIN(x) asm volatile("":"+v"(x))
  #define MX3(a,b,c) __builtin_fmaxf(__builtin_fmaxf((a),(b)),(c))
  #define GAPA(MF,A0,A1,A2,A3,W0,W1,PW) do{ MF; sacc+=A0; sacc+=A1; sacc+=A2; sacc+=A3; PIN(sacc); W0; W1; PIN(PW); SBAR(); }while(0)
  #define EX(v) __builtin_amdgcn_exp2f(v)
  #define GAPB(MF,X,B) do{ MF; X[B]=EX(X[B]); X[B+1]=EX(X[B+1]); X[B+2]=EX(X[B+2]); X[B+3]=EX(X[B+3]); PIN(X); SBAR(); }while(0)
  #define VRD(i) do{ vlo[i]=vtr(vp_+(((i)>>2)*4096+((i)&3)*1024)); vhi[i]=vtr(vp_+(((i)>>2)*4096+((i)&3)*1024+512)); }while(0)
  #define KRD(G,j) do{ if(G){ kload2(kf,kp0+sl_next,j); SBAR(); } }while(0)
  #define STEP(C0,C1,P0,P1,t,GK,GV,GL) do{ SBAR(); \
    const lds_cptr vp_=vp0+sl_prev; \
    VRD(0); SBAR(); float sacc=(P0[0]+P0[1]); \
    GAPA(C0=__builtin_amdgcn_mfma_f32_32x32x16_bf16(kf[0],qr[0],negm,0,0,0), P0[2],P0[3],P0[4],P0[5],     pw0[0]=PKW(P0,0), pw0[1]=PKW(P0,2), pw0); \
    VRD(4); SBAR(); GAPA(C1=__builtin_amdgcn_mfma_f32_32x32x16_bf16(kf[1],qr[0],negm,0,0,0), P0[6],P0[7],P0[8],P0[9],     pw0[2]=PKW(P0,4), pw0[3]=PKW(P0,6), pw0); \
    VRD(1); SBAR(); GAPA(C0=__builtin_amdgcn_mfma_f32_32x32x16_bf16(kf[2],qr[1],C0,0,0,0),   P0[10],P0[11],P0[12],P0[13], pw1[0]=PKW(P0,8), pw1[1]=PKW(P0,10), pw1); \
    VRD(5); SBAR(); GAPA(C1=__builtin_amdgcn_mfma_f32_32x32x16_bf16(kf[3],qr[1],C1,0,0,0),   P0[14],P0[15],P1[0],P1[1],   pw1[2]=PKW(P0,12),pw1[3]=PKW(P0,14), pw1); \
    VRD(2); SBAR(); GAPA(C0=__builtin_amdgcn_mfma_f32_32x32x16_bf16(kf[4],qr[2],C0,0,0,0),   P1[2],P1[3],P1[4],P1[5],     pw2[0]=PKW(P1,0), pw2[1]=PKW(P1,2), pw2); \
    VRD(6); SBAR(); GAPA(C1=__builtin_amdgcn_mfma_f32_32x32x16_bf16(kf[5],qr[2],C1,0,0,0),   P1[6],P1[7],P1[8],P1[9],     pw2[2]=PKW(P1,4), pw2[3]=PKW(P1,6), pw2); \
    VRD(3); SBAR(); GAPA(C0=__builtin_amdgcn_mfma_f32_32x32x16_bf16(kf[6],qr[3],C0,0,0,0),   P1[10],P1[11],P1[12],P1[13], pw3[0]=PKW(P1,8), pw3[1]=PKW(P1,10), pw3); \
    VRD(7); SBAR(); GAPA(C1=__builtin_amdgcn_mfma_f32_32x32x16_bf16(kf[7],qr[3],C1,0,0,0),   P1[14],P1[15],0.f,0.f,       pw3[2]=PKW(P1,12),pw3[3]=PKW(P1,14), pw3); \
    l_reg+=sacc; \
    if(GK){DMA_K((t)+3,sl_cur);} if(GV){DMA_V((t)+1,sl_next);} \
    CMASK(C0,C1,t); \
    { float a=MX3(C0[0],C0[1],C1[0]),b=MX3(C0[2],C0[3],C1[1]); a=MX3(a,C1[2],C1[3]); \
      _Pragma("unroll") for(int r=4;r<16;r+=4){a=MX3(a,C0[r],C0[r+1]);b=MX3(b,C0[r+2],C0[r+3]);a=MX3(a,C1[r],C1[r+1]);b=MX3(b,C1[r+2],C1[r+3]);} \
      float rm=__builtin_fmaxf(a,b); { auto rr=__builtin_amdgcn_permlane32_swap(__float_as_uint(rm),__float_as_uint(rm),false,false); rm=__builtin_fmaxf(__uint_as_float(rr[0]),__uint_as_float(rr[1])); } \
      resc=false; \
      if(__builtin_expect(__any(rm>(float)THRL),0)){ const float dl=__builtin_fmaxf(rm,0.f); mhat+=dl; \
        _Pragma("unroll") for(int r=0;r<16;++r){C0[r]-=dl;C1[r]-=dl;} \
        _Pragma("unroll") for(int r=0;r<16;++r)negm[r]=-mhat; asm volatile("":"+v"(negm)); \
        const float f=__builtin_amdgcn_exp2f(-dl); l_reg*=f; if(hi==0)wsf[r32]=f; resc=true; } } \
    SBAR(); \
    GAPB(o[0]=__builtin_amdgcn_mfma_f32_32x32x16_bf16(PAF(0),VFR(0),o[0],0,0,0), C0,0); \
    GAPB(o[1]=__builtin_amdgcn_mfma_f32_32x32x16_bf16(PAF(0),VFR(4),o[1],0,0,0), C0,4); \
    KRD(GL,0); GAPB(o[0]=__builtin_amdgcn_mfma_f32_32x32x16_bf16(PAF(1),VFR(1),o[0],0,0,0), C0,8); \
    KRD(GL,1); GAPB(o[1]=__builtin_amdgcn_mfma_f32_32x32x16_bf16(PAF(1),VFR(5),o[1],0,0,0), C0,12); \
    KRD(GL,2); GAPB(o[0]=__builtin_amdgcn_mfma_f32_32x32x16_bf16(PAF(2),VFR(2),o[0],0,0,0), C1,0); \
    KRD(GL,3); GAPB(o[1]=__builtin_amdgcn_mfma_f32_32x32x16_bf16(PAF(2),VFR(6),o[1],0,0,0), C1,4); \
    GAPB(o[0]=__builtin_amdgcn_mfma_f32_32x32x16_bf16(PAF(3),VFR(3),o[0],0,0,0), C1,8); \
    GAPB(o[1]=__builtin_amdgcn_mfma_f32_32x32x16_bf16(PAF(3),VFR(7),o[1],0,0,0), C1,12); \
    }while(0)
  int t=1;
  #undef CMASK
  #define CMASK(P0,P1,t) do{}while(0)
  for(;t+5<NT;t+=2){
    STEP(pB0,pB1,pA0,pA1,t,true,true,true);     WAIT_BAR(2); RESC(); ROT();
    STEP(pA0,pA1,pB0,pB1,t+1,true,true,true);   WAIT_BAR(2); RESC(); ROT();
  }
  #undef CMASK
  #define CMASK(P0,P1,t) do{int jb_=(t)-(NT-4); if(jb_>=0)cmask(P0,P1,jb_,qrel,hi);}while(0)
  #define ENDW(tt) do{ if((tt)+3<NT){WAIT_BAR(2);} else if((tt)+2<NT){WAIT_BAR(1);} else {WAIT_BAR(0);} }while(0)
  for(;t+1<NT;t+=2){
    STEP(pB0,pB1,pA0,pA1,t,(t+3<NT),(t+1<NT),(t+1<NT));       ENDW(t);   RESC(); ROT();
    STEP(pA0,pA1,pB0,pB1,t+1,(t+4<NT),(t+2<NT),(t+2<NT));     ENDW(t+1); RESC(); ROT();
  }
  STEP(pB0,pB1,pA0,pA1,NT-1,false,false,false); RESC();
  { float sacc=pB0[0]+pB0[1]; _Pragma("unroll") for(int r=2;r<16;++r)sacc+=pB0[r]; _Pragma("unroll") for(int r=0;r<16;++r)sacc+=pB1[r]; l_reg+=sacc;
    pw0=(u32x4){PKW(pB0,0),PKW(pB0,2),PKW(pB0,4),PKW(pB0,6)};pw1=(u32x4){PKW(pB0,8),PKW(pB0,10),PKW(pB0,12),PKW(pB0,14)};pw2=(u32x4){PKW(pB1,0),PKW(pB1,2),PKW(pB1,4),PKW(pB1,6)};pw3=(u32x4){PKW(pB1,8),PKW(pB1,10),PKW(pB1,12),PKW(pB1,14)};
    SBAR(); pv(o,vb0+sl_cur,PAF(0),PAF(1),PAF(2),PAF(3)); }
  #undef PKW
  #undef PAF
  #undef VFR
  #undef PIN
  #undef MX3
  #undef GAPA
  #undef GAPB
  #undef EX
  #undef VRD
  #undef KRD
  #undef STEP
  #undef ENDW
  {auto rr=__builtin_amdgcn_permlane32_swap(__float_as_uint(l_reg),__float_as_uint(l_reg),false,false);l_reg=__uint_as_float(rr[0])+__uint_as_float(rr[1]);}
  if(hi==0)wsf[32+r32]=l_reg;asm volatile("s_waitcnt lgkmcnt(0)":::"memory");
  float rli[16];
  #pragma unroll
  for(int r=0;r<16;++r)rli[r]=__builtin_amdgcn_rcpf(wsf[32+crow(r,hi)]);
  bf16*Ow=O+(rowbase+q0+wid*QBLK)*DMO+ocol;
  { bf16*stg=(bf16*)(shm+LDS_OST)+wid*2048;
    #pragma unroll
    for(int r=0;r<16;++r){const int orow=crow(r,hi);
      #pragma unroll
      for(int d0=0;d0<2;++d0)stg[orow*64+d0*32+r32]=__float2bfloat16(o[d0][r]*rli[r]);}
    asm volatile("s_waitcnt lgkmcnt(0)":::"memory");
    #pragma unroll
    for(int i=0;i<4;++i){const int row=i*8+(lane>>3),ch=lane&7; const u32x4 v=*(const u32x4*)(stg+row*64+ch*8); ATTN_STORE16(Ow+(long)row*DMO+ch*8,v);} }
  asm volatile("s_waitcnt lgkmcnt(0)\n\ts_barrier":::"memory");
  #undef DMA_K
  #undef DMA_V
  #undef CMASK
  #undef START
  #undef RESC
  #undef ROT
}
constexpr int ATTN_LDS_BYTES=LDS_BYTES;
template<int THRL=8> __device__ __forceinline__ void attn_phase(char*lds,const bf16*U,bf16*Oc,int vcu){
  const int bhc=vcu>>3,s=vcu&7,b=bhc>>3,h=(bhc>>1)&3,c=bhc&1;
  _Pragma("unroll 1") for(int i=0;i<4;++i){ const int half=i>>1,qb=(i&1)?15-s:s;
    attn_unit<THRL>(b,h*128+c*64,512+h*128+c*64,1024+h*128+half*64,h*128+half*64,qb,U,U,U,Oc+(long)c*16384*DMO,lds); }
}
#undef SBAR
#undef WAIT_BAR
}

namespace gla {
constexpr int GP = 72;
constexpr int L_BC = 0, L_VT = 16384, L_QI = 34816, L_KI = 44032, L_ATT = 53248, L_OF = 62464, OFP = 132;
__device__ __forceinline__ bf16x8 frag(const LAS unsigned char* base, int row, int k0) { return *(const LAS bf16x8*)(base + (row * GP + k0) * 2); }
__device__ __forceinline__ void cumsum_and_vt(LAS unsigned char* lds, const float* LOGA, const bf16_t* Ugla, size_t row0, int h, int tid, int lane, int wave) {
    LAS float* Bc = (LAS float*)(lds + L_BC);
    if (wave == 0) { float acc = 0.f; const float* g = LOGA + row0 * 256 + h * 64 + lane;
#pragma unroll 8
        for (int s = 0; s < 64; ++s) { acc += g[(size_t)s * 256]; Bc[s * 64 + lane] = acc; } }
    { const int v = tid & 127, sg = tid >> 7; const bf16_t* vp = Ugla + (row0 + sg * 16) * 1536 + 512 + h * 128 + v; unsigned w[8];
#pragma unroll
        for (int j = 0; j < 8; ++j) w[j] = (unsigned)vp[(size_t)(2 * j) * 1536] | ((unsigned)vp[(size_t)(2 * j + 1) * 1536] << 16);
        LAS u32x4* dst = (LAS u32x4*)(lds + L_VT + (v * GP + sg * 16) * 2);
        dst[0] = (u32x4){w[0], w[1], w[2], w[3]}; dst[1] = (u32x4){w[4], w[5], w[6], w[7]}; }
}
__device__ __forceinline__ void chunk_state(LAS unsigned char* lds, int q, const float* LOGA, const bf16_t* Ugla, float* SCt, float* DEC, int tid, int lane, int wave) {
    const int bh = q >> 6, n = q & 63, b = bh >> 2, h = bh & 3; const size_t row0 = (size_t)b * SEQ + n * 64;
    LAS float* Bc = (LAS float*)(lds + L_BC);
    cumsum_and_vt(lds, LOGA, Ugla, row0, h, tid, lane, wave);
    __syncthreads();
    { const int k = tid & 63, sg = tid >> 6; const float bl = Bc[63 * 64 + k]; const bf16_t* kp = Ugla + (row0 + sg * 8) * 1536 + 256 + h * 64 + k; float f[8];
#pragma unroll
        for (int j = 0; j < 8; ++j) f[j] = bf2f(kp[(size_t)j * 1536]) * __expf(bl - Bc[(sg * 8 + j) * 64 + k]);
        *(LAS u32x4*)(lds + L_QI + (k * GP + sg * 8) * 2) = (u32x4){pk2(f[0], f[1]), pk2(f[2], f[3]), pk2(f[4], f[5]), pk2(f[6], f[7])};
        if (tid < 64) DEC[(size_t)q * 64 + tid] = __expf(bl); }
    __syncthreads();
    { const int fr = lane & 15, fq = lane >> 4, mt = wave >> 1;
#pragma unroll
        for (int j = 0; j < 4; ++j) { const int nt = (wave & 1) * 4 + j; f32x4 acc = {0.f, 0.f, 0.f, 0.f};
#pragma unroll
            for (int ks = 0; ks < 2; ++ks) acc = __builtin_amdgcn_mfma_f32_16x16x32_bf16(frag(lds + L_QI, 16 * mt + fr, 32 * ks + 8 * fq), frag(lds + L_VT, 16 * nt + fr, 32 * ks + 8 * fq), acc, 0, 0, 0);
            *(f32x4*)(SCt + (size_t)q * 8192 + (16 * nt + fr) * 64 + 16 * mt + 4 * fq) = acc; } }
    __syncthreads();
}
__device__ __forceinline__ void chunk_out(LAS unsigned char* lds, int q, const float* LOGA, const bf16_t* Ugla, const bf16_t* SPt, const float* gog, bf16_t* OA, int tid, int lane, int wave) {
    const int bh = q >> 6, n = q & 63, b = bh >> 2, h = bh & 3; const size_t row0 = (size_t)b * SEQ + n * 64;
    LAS float* Bc = (LAS float*)(lds + L_BC); LAS float* Of = (LAS float*)(lds + L_OF);
    const int fr = lane & 15, fq = lane >> 4;
    cumsum_and_vt(lds, LOGA, Ugla, row0, h, tid, lane, wave);
    __syncthreads();
    { const int s = tid >> 3, k0 = (tid & 7) * 8; const bf16_t* rp = Ugla + (row0 + s) * 1536 + h * 64 + k0;
        const u32x4 qw = *(const u32x4*)rp, kw = *(const u32x4*)(rp + 256); float qf[8], kf[8];
        qf[0] = lo_bf(qw.x); qf[1] = hi_bf(qw.x); qf[2] = lo_bf(qw.y); qf[3] = hi_bf(qw.y); qf[4] = lo_bf(qw.z); qf[5] = hi_bf(qw.z); qf[6] = lo_bf(qw.w); qf[7] = hi_bf(qw.w);
        kf[0] = lo_bf(kw.x); kf[1] = hi_bf(kw.x); kf[2] = lo_bf(kw.y); kf[3] = hi_bf(kw.y); kf[4] = lo_bf(kw.z); kf[5] = hi_bf(kw.z); kf[6] = lo_bf(kw.w); kf[7] = hi_bf(kw.w);
#pragma unroll
        for (int e = 0; e < 8; ++e) { const float bv = Bc[s * 64 + k0 + e]; qf[e] *= 0.125f * __expf(bv); kf[e] *= __expf(-bv); }
        *(LAS u32x4*)(lds + L_QI + (s * GP + k0) * 2) = (u32x4){pk2(qf[0], qf[1]), pk2(qf[2], qf[3]), pk2(qf[4], qf[5]), pk2(qf[6], qf[7])};
        *(LAS u32x4*)(lds + L_KI + (s * GP + k0) * 2) = (u32x4){pk2(kf[0], kf[1]), pk2(kf[2], kf[3]), pk2(kf[4], kf[5]), pk2(kf[6], kf[7])}; }
    __syncthreads();
#pragma unroll
    for (int j = 0; j < 2; ++j) { const int t = 2 * wave + j, mt = t >> 2, nt = t & 3; f32x4 acc = {0.f, 0.f, 0.f, 0.f};
#pragma unroll
        for (int ks = 0; ks < 2; ++ks) acc = __builtin_amdgcn_mfma_f32_16x16x32_bf16(frag(lds + L_QI, 16 * mt + fr, 32 * ks + 8 * fq), frag(lds + L_KI, 16 * nt + fr, 32 * ks + 8 * fq), acc, 0, 0, 0);
        LAS bf16_t* ap = (LAS bf16_t*)(lds + L_ATT); const int sc = 16 * nt + fr;
#pragma unroll
        for (int r = 0; r < 4; ++r) { const int c = 16 * mt + 4 * fq + r; ap[c * GP + sc] = (bf16_t)f2bf(sc <= c ? acc[r] : 0.f); } }
    __syncthreads();
    { const int mt = wave >> 1;
#pragma unroll
        for (int j = 0; j < 4; ++j) { const int nt = (wave & 1) * 4 + j; f32x4 acc = {0.f, 0.f, 0.f, 0.f};
#pragma unroll
            for (int ks = 0; ks < 2; ++ks) { acc = __builtin_amdgcn_mfma_f32_16x16x32_bf16(frag(lds + L_ATT, 16 * mt + fr, 32 * ks + 8 * fq), frag(lds + L_VT, 16 * nt + fr, 32 * ks + 8 * fq), acc, 0, 0, 0);
                const bf16x8 sp = *(const bf16x8*)(SPt + (size_t)q * 8192 + (16 * nt + fr) * 64 + 32 * ks + 8 * fq);
                acc = __builtin_amdgcn_mfma_f32_16x16x32_bf16(frag(lds + L_QI, 16 * mt + fr, 32 * ks + 8 * fq), sp, acc, 0, 0, 0); }
#pragma unroll
            for (int r = 0; r < 4; ++r) Of[(16 * mt + 4 * fq + r) * OFP + 16 * nt + fr] = acc[r]; } }
    __syncthreads();
    { const int c = tid >> 3, v0 = (tid & 7) * 16; float o[16]; float ss = 0.f;
#pragma unroll
        for (int e = 0; e < 16; e += 4) { const f32x4 t4 = *(const LAS f32x4*)(Of + c * OFP + v0 + e); o[e] = t4.x; o[e + 1] = t4.y; o[e + 2] = t4.z; o[e + 3] = t4.w; ss += (t4.x * t4.x + t4.y * t4.y) + (t4.z * t4.z + t4.w * t4.w); }
        ss += __shfl_xor(ss, 1); ss += __shfl_xor(ss, 2); ss += __shfl_xor(ss, 4);
        const float rstd = rsqrtf(ss * (1.f / 128.f) + 1e-6f);
        const bf16_t* rp = Ugla + (row0 + c) * 1536 + 1024 + h * 128 + v0; const u32x4 r0 = *(const u32x4*)rp, r1 = *(const u32x4*)(rp + 8);
        const unsigned rw[8] = {r0.x, r0.y, r0.z, r0.w, r1.x, r1.y, r1.z, r1.w}; unsigned ow[8];
#pragma unroll
        for (int e = 0; e < 8; ++e) { const float a = o[2 * e] * rstd * gog[v0 + 2 * e] * siluf_(lo_bf(rw[e])), b2 = o[2 * e + 1] * rstd * gog[v0 + 2 * e + 1] * siluf_(hi_bf(rw[e])); ow[e] = pk2(a, b2); }
        bf16_t* op = OA + (row0 + c) * 512 + h * 128 + v0; *(u32x4*)op = (u32x4){ow[0], ow[1], ow[2], ow[3]}; *(u32x4*)(op + 8) = (u32x4){ow[4], ow[5], ow[6], ow[7]}; }
    __syncthreads();
}
}

#define XB_TMO      128
#define XB_XCNT(j)  (256  + 64 * (j))
#define XB_XSUB(j)  (1280 + 64 * (j))
#define XB_XGEN(j)  (2304 + 64 * (j))
#define XB_TOP      3328
#define XB_TOPGEN   3392
#define XCD_BAR_WORDS 3456
#define XB_SPIN_CAP (1u << 18)
__device__ __forceinline__ unsigned xb_ld(unsigned* p)              { return __hip_atomic_load(p, __ATOMIC_RELAXED, __HIP_MEMORY_SCOPE_AGENT); }
__device__ __forceinline__ unsigned xb_add(unsigned* p, unsigned v) { return __hip_atomic_fetch_add(p, v, __ATOMIC_RELAXED, __HIP_MEMORY_SCOPE_AGENT); }
__device__ __forceinline__ unsigned xb_xcc_id() { return (unsigned)__builtin_amdgcn_s_getreg((3 << 11) | 20) & 0xFu; }
#define XB_SPIN(cond, bar) do { unsigned _sp = 0; while (cond) { __builtin_amdgcn_s_sleep(1); \
    if ((++_sp & 255u) == 0u) { if (xb_ld(&(bar)[XB_TMO])) break; if (_sp > XB_SPIN_CAP) { atomicAdd(&(bar)[XB_TMO], 1u); break; } } } } while (0)
struct XcdBarrier { unsigned* bar; unsigned x; volatile LAS unsigned* st; };
__device__ __forceinline__ XcdBarrier xcd_barrier_post(unsigned* bar, volatile LAS unsigned* st) {
    XcdBarrier b; b.bar = bar; b.x = xb_xcc_id(); b.st = st;
    if (threadIdx.x == 0) (void)xb_add(&bar[XB_XCNT(b.x)], 1u);
    return b;
}
__device__ __forceinline__ void xcd_barrier_complete(unsigned* bar, unsigned x, unsigned& nloc, unsigned& nx) {
    const unsigned G = gridDim.x * gridDim.y * gridDim.z;
    unsigned sum, cnt, mine, sp = 0u;
    for (;;) {
        sum = 0u; cnt = 0u; mine = 0u;
#pragma unroll
        for (unsigned j = 0; j < 16; ++j) { const unsigned c = xb_ld(&bar[XB_XCNT(j)]); sum += c; cnt += (c > 0u) ? 1u : 0u; mine = (j == x) ? c : mine; }
        if (sum == G) break;
        __builtin_amdgcn_s_sleep(1);
        if ((++sp & 255u) == 0u) { if (xb_ld(&bar[XB_TMO])) break; if (sp > XB_SPIN_CAP) { atomicAdd(&bar[XB_TMO], 1u); break; } }
    }
    nloc = mine > 0u ? mine : 1u; nx = cnt > 0u ? cnt : 1u;
}
__device__ __forceinline__ void xcd_barrier(const XcdBarrier& b) {
    asm volatile("s_waitcnt vmcnt(0)" ::: "memory");
    __syncthreads();
    if (threadIdx.x == 0) {
        unsigned* bar = b.bar;
        __builtin_amdgcn_s_waitcnt(0);
        unsigned nloc = b.st[0], nx = b.st[1];
        if (nloc == 0u) { xcd_barrier_complete(bar, b.x, nloc, nx); b.st[0] = nloc; b.st[1] = nx; }
        const unsigned old = xb_add(&bar[XB_XSUB(b.x)], 1u);
        const unsigned gen = old / nloc;
        if (old + 1u == (gen + 1u) * nloc) {
            __builtin_amdgcn_fence(__ATOMIC_RELEASE, "agent");
            asm volatile("s_waitcnt vmcnt(0)" ::: "memory");
            const unsigned og = xb_add(&bar[XB_TOP], 1u);
            const unsigned tg = og / nx;
            if (og + 1u == (tg + 1u) * nx) xb_add(&bar[XB_TOPGEN], 1u);
            else XB_SPIN(xb_ld(&bar[XB_TOPGEN]) == tg, bar);
            __builtin_amdgcn_fence(__ATOMIC_ACQUIRE, "agent");
            xb_add(&bar[XB_XGEN(b.x)], 1u);
            asm volatile("s_waitcnt vmcnt(0)" ::: "memory");
        } else {
            XB_SPIN(xb_ld(&bar[XB_XGEN(b.x)]) == gen, bar);
            __builtin_amdgcn_fence(__ATOMIC_ACQUIRE, "agent");
            asm volatile("s_waitcnt vmcnt(0)" ::: "memory");
        }
    }
    __syncthreads();
}

struct Args { const void* in[28]; float* out; unsigned char* ws; int ph_lo, ph_hi; };
enum { I_X = 0, I_C, I_POS, I_ADAW, I_ADAB, I_N1G, I_N2G, I_WIN, I_AUP, I_AB, I_GOG, I_DQG, I_DKG, I_LQ1, I_LK1, I_LQ2, I_LK2, I_DOG, I_WBA, I_WBB, I_WOUT, I_RGW, I_RGB, I_REW, I_REB, I_EW1, I_EW3, I_EW2 };

struct TrJob { const float* src; bf16_t* dst; int ldn, kdst; };
__device__ __forceinline__ void tr_load(f32x4 (&v)[8], const TrJob& J, int lane) {
#pragma unroll
    for (int i = 0; i < 8; ++i) v[i] = *(const f32x4*)(J.src + (size_t)(8 * i + (lane >> 3)) * J.ldn + (lane & 7) * 4);
}
__device__ __forceinline__ void tr_store(const f32x4 (&v)[8], const TrJob& J, LAS float* scr, int lane) {
#pragma unroll
    for (int i = 0; i < 8; ++i) { LAS float* p = scr + (8 * i + (lane >> 3)) * 33 + (lane & 7) * 4; p[0] = v[i].x; p[1] = v[i].y; p[2] = v[i].z; p[3] = v[i].w; }
    LDS_WAIT(); asm volatile("" ::: "memory");
    const int c = lane & 7;
#pragma unroll
    for (int j = 0; j < 4; ++j) { const int n = (lane >> 3) + 8 * j; const LAS float* sp = scr + (8 * c) * 33 + n;
        u32x4 o; o.x = pk2(sp[0 * 33], sp[1 * 33]); o.y = pk2(sp[2 * 33], sp[3 * 33]); o.z = pk2(sp[4 * 33], sp[5 * 33]); o.w = pk2(sp[6 * 33], sp[7 * 33]);
        *(u32x4*)(J.dst + (size_t)n * J.kdst + 8 * c) = o; }
    LDS_WAIT(); asm volatile("" ::: "memory");
}
template <class Dec> __device__ __forceinline__ void tr_run(int first, int total, int stride, const Dec& dec, LAS float* scr, int lane) {
    int it = first; if (it >= total) return;
    TrJob J = dec(it); f32x4 a[8]; tr_load(a, J, lane);
    for (;;) {
        const int nx = it + stride; const bool more = nx < total; TrJob Jn = J; f32x4 b[8];
        if (more) { Jn = dec(nx); tr_load(b, Jn, lane); }
        tr_store(a, J, scr, lane);
        if (!more) break;
#pragma unroll
        for (int i = 0; i < 8; ++i) a[i] = b[i];
        J = Jn; it = nx;
    }
}
struct DecDense { const float *w_in, *wa, *wb, *wo; bf16_t *Win_t, *Wa_t, *Wb_t, *Wout_t;
    __device__ __forceinline__ TrJob operator()(int r) const {
        if (r < 2560) { const int kb = r / 160, nb = r % 160, n0 = 32 * nb, ns = n0 < 1536 ? n0 : n0 + 16; return TrJob{w_in + (size_t)(64 * kb) * DIN + ns, Win_t + (size_t)n0 * D + 64 * kb, DIN, D}; }
        r -= 2560;
        if (r < 256) { const int kb = r / 32, nb = r % 32; return TrJob{wa + (size_t)(64 * kb) * D + 32 * nb, Wa_t + (size_t)(32 * nb) * 512 + 64 * kb, D, 512}; }
        r -= 256;
        if (r < 256) { const int kb = r / 32, nb = r % 32; return TrJob{wb + (size_t)(64 * kb) * D + 32 * nb, Wb_t + (size_t)(32 * nb) * 512 + 64 * kb, D, 512}; }
        r -= 256;
        { const int kb = r / 32, nb = r % 32; return TrJob{wo + (size_t)(64 * kb) * D + 32 * nb, Wout_t + (size_t)(32 * nb) * D + 64 * kb, D, D}; }
    } };
struct DecExp { const float *w1, *w3, *w2; bf16_t *W13_t, *W2_t;
    __device__ __forceinline__ TrJob operator()(int it) const {
        const int e = it / 768, r = it % 768;
        if (r < 512) { const int kb = r >> 5, nb = r & 31, r0 = 32 * nb, pn = r0 >> 8, half = (r0 >> 7) & 1, jj = r0 & 127;
            const float* p1 = w1; const float* p3 = w3; asm volatile("" : "+s"(p1), "+s"(p3));
            return TrJob{(half ? p3 : p1) + (size_t)e * D * DEXP + (size_t)(64 * kb) * DEXP + 128 * pn + jj, W13_t + (size_t)e * 1024 * 1024 + (size_t)r0 * D + 64 * kb, DEXP, D}; }
        const int r2 = r - 512, kb = r2 >> 5, nb = r2 & 31;
        return TrJob{w2 + (size_t)e * DEXP * D + (size_t)(64 * kb) * D + 32 * nb, W2_t + (size_t)e * 1024 * 512 + (size_t)(32 * nb) * DEXP + 64 * kb, D, DEXP};
    } };

#define PHASE_LOCALS int tid_l = threadIdx.x; asm volatile("" : "+v"(tid_l)); int cb_l = blockIdx.x; asm volatile("" : "+s"(cb_l)); \
    const int tid = tid_l, lane = tid & 63, wave = __builtin_amdgcn_readfirstlane(tid >> 6), cb = cb_l, G = 256, gw = cb * NWAVES + wave, NGW = G * NWAVES; (void)lane; (void)gw; (void)NGW; (void)G;
template <int IDX> __device__ __forceinline__ const void* ldarg() {
    unsigned long long p;
    asm volatile("s_load_dwordx2 %0, %1, %2\n\ts_waitcnt lgkmcnt(0)" : "=s"(p) : "s"(__builtin_amdgcn_kernarg_segment_ptr()), "n"(IDX * 8) : "memory");
    return (const void*)p;
}
#define ARG_IN(i) (ldarg<(i)>())
#define ARG_WS ((unsigned char*)ldarg<29>())
#define XIN ((const float*)ARG_IN(I_X))
#define OUTP ((float*)ldarg<28>())
#define P_MODP ((float*)(ARG_WS + WS_MODP))
#define P_MODF ((float*)(ARG_WS + WS_MODF))
#define P_ALR ((float*)(ARG_WS + WS_ALR))
#define P_WIN ((bf16_t*)(ARG_WS + WS_WIN))
#define P_WA ((bf16_t*)(ARG_WS + WS_WA))
#define P_WB ((bf16_t*)(ARG_WS + WS_WB))
#define P_WOUT ((bf16_t*)(ARG_WS + WS_WOUT))
#define P_XN ((bf16_t*)(ARG_WS + WS_XN))
#define P_LOGA ((float*)(ARG_WS + WS_LOGA))
#define P_SCT ((float*)(ARG_WS + WS_SCT))
#define P_SPT ((bf16_t*)(ARG_WS + WS_SPT))
#define P_OC ((bf16_t*)(ARG_WS + WS_OC))
#define P_DEC ((float*)(ARG_WS + WS_DEC))
#define P_WRT ((float*)(ARG_WS + WS_WRT))
#define P_OB ((bf16_t*)(ARG_WS + WS_OB))
#define P_OA ((bf16_t*)(ARG_WS + WS_OA))
#define P_XS ((bf16_t*)(ARG_WS + WS_XS))
#define P_Y ((bf16_t*)(ARG_WS + WS_Y))
#define P_UGLA ((bf16_t*)(ARG_WS + WS_UGLA))
#define P_UDIFF ((bf16_t*)(ARG_WS + WS_UDIFF))
#define P_UGATE ((bf16_t*)(ARG_WS + WS_UGATE))
#define P_M1 ((bf16_t*)(ARG_WS + WS_M1))
#define P_MERGED ((bf16_t*)(ARG_WS + WS_MERGED))
#define P_H2 ((bf16_t*)(ARG_WS + WS_H2))
#define P_W13 ((bf16_t*)(ARG_WS + WS_W13))
#define P_W2 ((bf16_t*)(ARG_WS + WS_W2))
#define P_HMID ((bf16_t*)(ARG_WS + WS_HMID))
#define P_TOKE ((int*)(ARG_WS + WS_ROUTE + RT_TOKE))
#define P_TOKW ((float*)(ARG_WS + WS_ROUTE + RT_TOKW))
#define P_RANK ((int*)(ARG_WS + WS_ROUTE + RT_RANK))
#define P_SLOT ((int*)(ARG_WS + WS_ROUTE + RT_SLOT))
#define P_BLKCNT ((int*)(ARG_WS + WS_ROUTE + RT_BLKCNT))
#define P_TILEE ((int*)(ARG_WS + WS_ROUTE + RT_TILEE))
#define P_NT ((int*)(ARG_WS + WS_ROUTE + RT_NT))
template <int LO, int HI>
__global__ void __launch_bounds__(NTHR, 2) mk_fwd(Args args) {
    extern __shared__ __attribute__((aligned(16))) unsigned char lds_raw[];
    LAS unsigned char* lds = (LAS unsigned char*)lds_raw;
    volatile LAS unsigned* MISC = (volatile LAS unsigned*)(lds + MISC_OFF);
    unsigned* ctl = (unsigned*)(ARG_WS + WS_CTL);
    for (int u = threadIdx.x; u < (LDS_BYTES - LDSCTL_OFF) / 4; u += NTHR) ((LAS unsigned*)(lds + LDSCTL_OFF))[u] = 0u;
    __syncthreads();
    constexpr int lo = LO, hi = HI;
    XcdBarrier bar; bar.bar = ctl + CW_BAR; bar.x = 0; bar.st = nullptr;
    if constexpr (hi - lo > 1) bar = xcd_barrier_post(ctl + CW_BAR, MISC + 8);
#define IN(k) (lo <= (k) && (k) < hi)
#define SEAM(k) do { if constexpr (IN(k) && IN((k) + 1)) xcd_barrier(bar); } while (0)

    if constexpr (IN(0)) {
        asm volatile("; PHASE_BEGIN 0" ::: "memory");
        PHASE_LOCALS
        float* modp = P_MODP; bf16_t* Win_t = P_WIN; bf16_t* Wa_t = P_WA; bf16_t* Wb_t = P_WB; bf16_t* Wout_t = P_WOUT;
        const float* cvec = (const float*)ARG_IN(I_C); const float* ada_w = (const float*)ARG_IN(I_ADAW);
        const float* w_in = (const float*)ARG_IN(I_WIN);
        LAS float* scr = (LAS float*)(lds + wave * 16384);
        for (int r = gw; r < 768; r += NGW) {
            const int jc = r % 24, kc = r / 24, j = jc * 256 + lane * 4;
            f32x4 a0 = {0, 0, 0, 0}, a1 = a0, a2 = a0, a3 = a0;
#pragma unroll 8
            for (int kk = 0; kk < 32; ++kk) { const int k = kc * 32 + kk; const f32x4 w = *(const f32x4*)(ada_w + (size_t)k * NMOD + j);
                a0 += siluf_(cvec[k]) * w; a1 += siluf_(cvec[D + k]) * w; a2 += siluf_(cvec[2 * D + k]) * w; a3 += siluf_(cvec[3 * D + k]) * w; }
            *(f32x4*)(modp + (size_t)(kc * 4 + 0) * NMOD + j) = a0; *(f32x4*)(modp + (size_t)(kc * 4 + 1) * NMOD + j) = a1;
            *(f32x4*)(modp + (size_t)(kc * 4 + 2) * NMOD + j) = a2; *(f32x4*)(modp + (size_t)(kc * 4 + 3) * NMOD + j) = a3; }
        { const float* Wrg = (const float*)ARG_IN(I_RGW); const float* Wre = (const float*)ARG_IN(I_REW); float* WrT = P_WRT;
          for (int idx = cb * NTHR + tid; idx < 36 * D; idx += G * NTHR) { const int j = idx >> 10, k = idx & 1023; WrT[idx] = j < 4 ? Wrg[k * 4 + j] : Wre[k * 32 + (j - 4)]; } }
        { const DecDense dec{w_in, (const float*)ARG_IN(I_WBA), (const float*)ARG_IN(I_WBB), (const float*)ARG_IN(I_WOUT), Win_t, Wa_t, Wb_t, Wout_t};
          tr_run(gw, 2560 + 256 + 256 + 512, NGW, dec, scr, lane); }
    }
    SEAM(0);

    if constexpr (IN(1)) {
        asm volatile("; PHASE_BEGIN 1" ::: "memory");
        PHASE_LOCALS
        const float* x = XIN; float* modp = P_MODP; float* modf = P_MODF; float* alr = P_ALR; bf16_t* XN = P_XN;
        const float* ada_b = (const float*)ARG_IN(I_ADAB); const float* g1 = (const float*)ARG_IN(I_N1G); const float* w_in = (const float*)ARG_IN(I_WIN);
        LAS float* modS = (LAS float*)lds;
        LAS float* lrT = (LAS float*)(lds + 8192);
        const int b = cb >> 6;
        { const int j = tid * 4; f32x4 s = *(const f32x4*)(ada_b + j);
            for (int kc = 0; kc < 32; ++kc) s += *(const f32x4*)(modp + (size_t)(kc * 4 + b) * NMOD + j);
            if (j >= D) s += 1.0f;
            *(LAS f32x4*)(modS + j) = s; }
        if (tid < 96) { const int idx = cb * 96 + tid, bb = idx / NMOD, j = idx % NMOD; float s = ada_b[j];
            for (int kc = 0; kc < 32; ++kc) s += modp[(size_t)(kc * 4 + bb) * NMOD + j];
            modf[idx] = s; }
        for (int idx = tid; idx < 16384; idx += NTHR) { const int k = idx >> 4, r = idx & 15; lrT[r * 1024 + k] = w_in[(size_t)k * DIN + 1536 + r]; }
        __syncthreads();
        for (int i = 0; i < 8; ++i) {
            const int m = cb * 64 + wave * 8 + i;
            const f32x4* xr = (const f32x4*)(x + (size_t)m * D) + lane;
            f32x4 v[4]; float ss = 0.f;
#pragma unroll
            for (int j = 0; j < 4; ++j) { v[j] = xr[64 * j]; ss += (v[j].x * v[j].x + v[j].y * v[j].y) + (v[j].z * v[j].z + v[j].w * v[j].w); }
            const float rstd = rsqrtf(wave_sum(ss) * (1.f / D) + 1e-6f);
            unsigned long long* o8 = (unsigned long long*)(XN + (size_t)m * D) + lane;
#pragma unroll
            for (int j = 0; j < 4; ++j) { const int k = 4 * lane + 256 * j; const f32x4 gg = *(const f32x4*)(g1 + k); const f32x4 sh = *(const LAS f32x4*)(modS + k); const f32x4 sc = *(const LAS f32x4*)(modS + D + k);
                v[j] = v[j] * rstd * gg * sc + sh;
                o8[64 * j] = (unsigned long long)pk2(v[j].x, v[j].y) | ((unsigned long long)pk2(v[j].z, v[j].w) << 32); }
            float mine = 0.f;
#pragma unroll 1
            for (int r = 0; r < 16; ++r) { float p = 0.f;
#pragma unroll
                for (int j = 0; j < 4; ++j) { const f32x4 w = *(const LAS f32x4*)(lrT + r * 1024 + 4 * lane + 256 * j); p += (v[j].x * w.x + v[j].y * w.y) + (v[j].z * w.z + v[j].w * w.w); }
                p = wave_sum(p); if (lane == r) mine = p; }
            if (lane < 16) alr[(size_t)m * 16 + lane] = mine;
        }
    }
    SEAM(1);

    if constexpr (IN(2)) {
        asm volatile("; PHASE_BEGIN 2" ::: "memory");
        PHASE_LOCALS
        bf16_t* XN = P_XN; bf16_t* Win_t = P_WIN; bf16_t* Ugla = P_UGLA; bf16_t* Udiff = P_UDIFF; bf16_t* Ugate = P_UGATE;
        pg8::DenseOrder S; S.init(XN, Win_t, M, NPROJ, D, G, cb);
        pg8::EpiInProj E{Ugla, Udiff, Ugate};
        pg8::gemm_phase<pg8::EpiInProj, pg8::DenseOrder, true, true>(lds, D, S, E);
    }
    SEAM(2);

    if constexpr (IN(3)) {
        asm volatile("; PHASE_BEGIN 3" ::: "memory");
        PHASE_LOCALS
        bf16_t* Udiff = P_UDIFF; float* alr = P_ALR; float* LOGA = P_LOGA;
        const int* pos = (const int*)ARG_IN(I_POS); const float* qg = (const float*)ARG_IN(I_DQG); const float* kg = (const float*)ARG_IN(I_DKG);
        const float* aup = (const float*)ARG_IN(I_AUP); const float* ab = (const float*)ARG_IN(I_AB);
        const float invf = powf(500000.0f, -(float)(lane & 7) * 0.125f);
        float gain[16];
#pragma unroll
        for (int e = 0; e < 16; ++e) gain[e] = (lane < 32 ? qg : kg)[(lane & 3) * 16 + e];
        for (int i = 0; i < 8; ++i) {
            const int m = cb * 64 + wave * 8 + i;
            bf16_t* rowp = Udiff + (size_t)m * 1536 + lane * 16;
            const u32x4 w0 = *(const u32x4*)rowp, w1 = *(const u32x4*)(rowp + 8);
            float y[16];
            y[0] = lo_bf(w0.x); y[1] = hi_bf(w0.x); y[2] = lo_bf(w0.y); y[3] = hi_bf(w0.y); y[4] = lo_bf(w0.z); y[5] = hi_bf(w0.z); y[6] = lo_bf(w0.w); y[7] = hi_bf(w0.w);
            y[8] = lo_bf(w1.x); y[9] = hi_bf(w1.x); y[10] = lo_bf(w1.y); y[11] = hi_bf(w1.y); y[12] = lo_bf(w1.z); y[13] = hi_bf(w1.z); y[14] = lo_bf(w1.w); y[15] = hi_bf(w1.w);
            float ss = 0.f;
#pragma unroll
            for (int e = 0; e < 16; ++e) ss += y[e] * y[e];
            ss += __shfl_xor(ss, 1); ss += __shfl_xor(ss, 2);
            const float rstd = rsqrtf(ss * (1.f / 64.f) + 1e-6f);
#pragma unroll
            for (int e = 0; e < 16; ++e) y[e] = y[e] * rstd * gain[e];
            const float ang = (float)pos[m] * invf; float sv, cv; sincosf(ang, &sv, &cv);
            float r[16];
#pragma unroll
            for (int e = 0; e < 8; ++e) { const float c_ = __shfl(cv, e), s_ = __shfl(sv, e); r[e] = y[e] * c_ - y[e + 8] * s_; r[e + 8] = y[e + 8] * c_ + y[e] * s_; }
            if ((lane & 3) == 0) {
#pragma unroll
                for (int e = 0; e < 16; ++e) y[e] = r[e]; }
            if (lane < 32) {
#pragma unroll
                for (int e = 0; e < 16; ++e) y[e] *= attn_body::C2; }
            u32x4 o0, o1; o0.x = pk2(y[0], y[1]); o0.y = pk2(y[2], y[3]); o0.z = pk2(y[4], y[5]); o0.w = pk2(y[6], y[7]); o1.x = pk2(y[8], y[9]); o1.y = pk2(y[10], y[11]); o1.z = pk2(y[12], y[13]); o1.w = pk2(y[14], y[15]);
            *(u32x4*)rowp = o0; *(u32x4*)(rowp + 8) = o1;
            float a[16];
#pragma unroll
            for (int rr = 0; rr < 16; ++rr) a[rr] = alr[(size_t)m * 16 + rr];
#pragma unroll
            for (int q = 0; q < 4; ++q) { const int j = lane + 64 * q; float xv = ab[j];
#pragma unroll
                for (int rr = 0; rr < 16; ++rr) xv += a[rr] * aup[rr * 256 + j];
                const float ls = fminf(xv, 0.f) - log1pf(__expf(-fabsf(xv)));
                LOGA[(size_t)m * 256 + j] = ls * (1.f / 16.f); }
        }
        VM_WAIT(); __syncthreads();
        { const bf16_t* Ugla = P_UGLA; float* SCt = P_SCT; float* DEC = P_DEC;
          for (int h = 0; h < 4; ++h) gla::chunk_state(lds, (((cb >> 6) * 4 + h) << 6) + (cb & 63), LOGA, Ugla, SCt, DEC, tid, lane, wave); }
    }
    SEAM(3);

    if constexpr (IN(4)) {
        asm volatile("; PHASE_BEGIN 4" ::: "memory");
        PHASE_LOCALS
        { const float* SCt = P_SCT; const float* DEC = P_DEC; bf16_t* SPt = P_SPT;
          const int idx = cb * NTHR + tid, bh = idx >> 13, e = idx & 8191, k = e & 63; float st = 0.f;
#pragma unroll 8
          for (int n = 0; n < 64; ++n) { const size_t q = (size_t)bh * 64 + n; const float sc = SCt[q * 8192 + e], d = DEC[q * 64 + k]; SPt[q * 8192 + e] = (bf16_t)f2bf(st); st = st * d + sc; } }
        { const int vcu = (cb % 8) * (G / 8) + cb / 8;
          attn_body::attn_phase<8>((char*)lds_raw, (const attn_body::bf16*)P_UDIFF, (attn_body::bf16*)P_OC, vcu); }
    }
    SEAM(4);

    if constexpr (IN(5)) {
        asm volatile("; PHASE_BEGIN 5" ::: "memory");
        PHASE_LOCALS
        { const float* lq1 = (const float*)ARG_IN(I_LQ1); const float* lk1 = (const float*)ARG_IN(I_LK1); const float* lq2 = (const float*)ARG_IN(I_LQ2); const float* lk2 = (const float*)ARG_IN(I_LK2);
          const float* og = (const float*)ARG_IN(I_DOG); const bf16_t* Oc = P_OC; bf16_t* OB = P_OB;
          const float lam = __expf(wave_sum(lq1[lane] * lk1[lane])) - __expf(wave_sum(lq2[lane] * lk2[lane])) + 0.2f;
          for (int i = 0; i < 8; ++i) {
            const size_t m = (size_t)cb * 64 + wave * 8 + i; const int col0 = lane * 8;
            const u32x4 a = *(const u32x4*)(Oc + m * 512 + col0), b2 = *(const u32x4*)(Oc + (size_t)M * 512 + m * 512 + col0);
            const unsigned aw[4] = {a.x, a.y, a.z, a.w}, bw[4] = {b2.x, b2.y, b2.z, b2.w}; float o[8]; float ss = 0.f;
#pragma unroll
            for (int e = 0; e < 4; ++e) { o[2 * e] = lo_bf(aw[e]) - lam * lo_bf(bw[e]); o[2 * e + 1] = hi_bf(aw[e]) - lam * hi_bf(bw[e]); ss += o[2 * e] * o[2 * e] + o[2 * e + 1] * o[2 * e + 1]; }
            ss += __shfl_xor(ss, 1); ss += __shfl_xor(ss, 2); ss += __shfl_xor(ss, 4); ss += __shfl_xor(ss, 8);
            const float rstd = rsqrtf(ss * (1.f / 128.f) + 1e-6f) * 0.8f; unsigned ow[4];
#pragma unroll
            for (int e = 0; e < 4; ++e) ow[e] = pk2(o[2 * e] * rstd * og[(col0 & 127) + 2 * e], o[2 * e + 1] * rstd * og[(col0 & 127) + 2 * e + 1]);
            *(u32x4*)(OB + m * 512 + col0) = (u32x4){ow[0], ow[1], ow[2], ow[3]}; } }
        __syncthreads();
        { const bf16_t* Ugla = P_UGLA; const float* LOGA = P_LOGA; const bf16_t* SPt = P_SPT; const float* gog = (const float*)ARG_IN(I_GOG); bf16_t* OA = P_OA;
          for (int ci = 0; ci < 4; ++ci) gla::chunk_out(lds, cb * 4 + ci, LOGA, Ugla, SPt, gog, OA, tid, lane, wave); }
    }
    SEAM(5);

    if constexpr (IN(6)) {
        asm volatile("; PHASE_BEGIN 6" ::: "memory");
        PHASE_LOCALS
        bf16_t* OA = P_OA; bf16_t* OB = P_OB; bf16_t* Wa_t = P_WA; bf16_t* Wb_t = P_WB; bf16_t* Ugate = P_UGATE; bf16_t* M1 = P_M1; bf16_t* MERGED = P_MERGED;
        { pg8::DenseOrder S; S.init(OA, Wa_t, M, D, 512, G, cb); pg8::EpiBranch E{Ugate, 0, nullptr, M1};
          pg8::gemm_phase<pg8::EpiBranch, pg8::DenseOrder, true, true>(lds, 512, S, E); }
        VM_WAIT(); __syncthreads();
        { pg8::DenseOrder S; S.init(OB, Wb_t, M, D, 512, G, cb); pg8::EpiBranch E{Ugate, 1024, M1, MERGED};
          pg8::gemm_phase<pg8::EpiBranch, pg8::DenseOrder, true, true>(lds, 512, S, E); }
    }
    SEAM(6);

    if constexpr (IN(7)) {
        asm volatile("; PHASE_BEGIN 7" ::: "memory");
        PHASE_LOCALS
        const float* x = XIN; float* out = OUTP; float* modf = P_MODF; bf16_t* MERGED = P_MERGED; bf16_t* Wout_t = P_WOUT;
        pg8::DenseOrder S; S.init(MERGED, Wout_t, M, D, D, G, cb); pg8::EpiWout E{x, modf, out};
        pg8::gemm_phase<pg8::EpiWout, pg8::DenseOrder, true, true>(lds, D, S, E);
    }
    SEAM(7);

    if constexpr (IN(8)) {
        asm volatile("; PHASE_BEGIN 8" ::: "memory");
        PHASE_LOCALS
        float* out = OUTP; float* modf = P_MODF; bf16_t* H2 = P_H2; bf16_t* W13_t = P_W13; bf16_t* W2_t = P_W2; int* tok_e = P_TOKE; float* tok_w = P_TOKW; int* tok_rank = P_RANK; int* blkcnt = P_BLKCNT;
        const float* g2 = (const float*)ARG_IN(I_N2G); const float* brg = (const float*)ARG_IN(I_RGB); const float* bre = (const float*)ARG_IN(I_REB); const float* WrT = P_WRT;
        LAS float* modS = (LAS float*)lds;
        LAS int* eS = (LAS int*)(lds + 8192);
        const int b = cb >> 6;
        for (int j = tid; j < 2048; j += NTHR) modS[j] = modf[(size_t)b * NMOD + 3 * D + j] + (j >= D ? 1.0f : 0.f);
        __syncthreads();
        {
            f32x4 hv[8][4];
            const size_t m0 = (size_t)cb * 64 + wave * 8;
#pragma unroll
            for (int i = 0; i < 8; ++i) { const f32x4* xr = (const f32x4*)(out + (m0 + i) * D) + lane;
#pragma unroll
                for (int j = 0; j < 4; ++j) hv[i][j] = xr[64 * j]; }
#pragma unroll
            for (int i = 0; i < 8; ++i) { float ss = 0.f;
#pragma unroll
                for (int j = 0; j < 4; ++j) ss += (hv[i][j].x * hv[i][j].x + hv[i][j].y * hv[i][j].y) + (hv[i][j].z * hv[i][j].z + hv[i][j].w * hv[i][j].w);
                const float rstd = rsqrtf(wave_sum(ss) * (1.f / D) + 1e-6f);
                unsigned long long* o8 = (unsigned long long*)(H2 + (m0 + i) * D) + lane;
#pragma unroll
                for (int j = 0; j < 4; ++j) { const int k = 4 * lane + 256 * j; const f32x4 gg = *(const f32x4*)(g2 + k); const f32x4 sh = *(const LAS f32x4*)(modS + k); const f32x4 sc = *(const LAS f32x4*)(modS + D + k);
                    hv[i][j] = hv[i][j] * rstd * gg * sc + sh;
                    o8[64 * j] = (unsigned long long)pk2(hv[i][j].x, hv[i][j].y) | ((unsigned long long)pk2(hv[i][j].z, hv[i][j].w) << 32); } }
            float res[8];
#pragma unroll
            for (int i = 0; i < 8; ++i) res[i] = 0.f;
            { f32x4 wn[4];
#pragma unroll
              for (int jj = 0; jj < 4; ++jj) wn[jj] = *(const f32x4*)(WrT + 4 * lane + 256 * jj);
#pragma unroll 1
              for (int jx = 0; jx < 36; ++jx) {
                f32x4 w[4];
#pragma unroll
                for (int jj = 0; jj < 4; ++jj) w[jj] = wn[jj];
                const int jn = jx < 35 ? jx + 1 : jx;
#pragma unroll
                for (int jj = 0; jj < 4; ++jj) wn[jj] = *(const f32x4*)(WrT + (size_t)jn * D + 4 * lane + 256 * jj);
#pragma unroll
                for (int i = 0; i < 8; ++i) { float a = 0.f;
#pragma unroll
                    for (int jj = 0; jj < 4; ++jj) a += (hv[i][jj].x * w[jj].x + hv[i][jj].y * w[jj].y) + (hv[i][jj].z * w[jj].z + hv[i][jj].w * w[jj].w);
                    a = wave_sum(a); if (lane == jx) res[i] = a; }
              } }
            const float bias = lane < 4 ? brg[lane] : (lane < 36 ? bre[lane - 4] : 0.f);
#pragma unroll
            for (int i = 0; i < 8; ++i) {
                const int tl = wave * 8 + i; const float lgt = res[i] + bias;
                const float lg0 = __shfl(lgt, 0), lg1 = __shfl(lgt, 1), lg2 = __shfl(lgt, 2), lg3 = __shfl(lgt, 3);
                int gi = 0; float gm = lg0; if (lg1 > gm) { gm = lg1; gi = 1; } if (lg2 > gm) { gm = lg2; gi = 2; } if (lg3 > gm) { gm = lg3; gi = 3; }
                const float ptop = 1.0f / (__expf(lg0 - gm) + __expf(lg1 - gm) + __expf(lg2 - gm) + __expf(lg3 - gm));
                float el[8];
#pragma unroll
                for (int j = 0; j < 8; ++j) el[j] = __shfl(lgt, 4 + gi * 8 + j);
                int j0 = 0; float e0 = el[0];
#pragma unroll
                for (int j = 1; j < 8; ++j) if (el[j] > e0) { e0 = el[j]; j0 = j; }
                int j1 = -1; float e1 = -3.0e38f;
#pragma unroll
                for (int j = 0; j < 8; ++j) if (j != j0 && el[j] > e1) { e1 = el[j]; j1 = j; }
                const float t = __expf(e1 - e0), w0 = ptop / (1.0f + t), w1 = ptop * t / (1.0f + t);
                if (lane == 0) { eS[2 * tl] = gi * 8 + j0; eS[2 * tl + 1] = gi * 8 + j1; tok_w[(m0 + i) * 2] = w0; tok_w[(m0 + i) * 2 + 1] = w1; }
            }
        }
        __syncthreads();
        if (tid < 128) { const int e = eS[tid]; int rank = 0; for (int a = 0; a < tid; ++a) rank += (eS[a] == e) ? 1 : 0;
            tok_e[(size_t)cb * 128 + tid] = e; tok_rank[(size_t)cb * 128 + tid] = rank; }
        else if (tid < 160) { const int e = tid - 128; int cnt = 0; for (int a = 0; a < 128; ++a) cnt += (eS[a] == e) ? 1 : 0; blkcnt[cb * 32 + e] = cnt; }
        __syncthreads();
        { const DecExp dec{(const float*)ARG_IN(I_EW1), (const float*)ARG_IN(I_EW3), (const float*)ARG_IN(I_EW2), W13_t, W2_t};
          tr_run(gw, NEXP * 768, NGW, dec, (LAS float*)(lds + wave * 16384), lane); }
    }
    SEAM(8);

    if constexpr (IN(9)) {
        asm volatile("; PHASE_BEGIN 9" ::: "memory");
        PHASE_LOCALS
        bf16_t* H2 = P_H2; bf16_t* XS = P_XS; int* tok_e = P_TOKE; int* tok_rank = P_RANK; int* tok_slot = P_SLOT; int* blkcnt = P_BLKCNT; int* tile_e = P_TILEE; int* ntiles_p = P_NT;
        LAS int* red = (LAS int*)lds;
        LAS int* totS = red + 1024;
        LAS int* preS = totS + 32;
        LAS int* padS = preS + 32;
        LAS int* slotS = padS + 64;
        { const int e = tid & 31, part = tid >> 5; int tot = 0, pre = 0;
            for (int blk = part; blk < 256; blk += 16) { const int cval = blkcnt[blk * 32 + e]; tot += cval; pre += (blk < cb) ? cval : 0; }
            red[part * 64 + e] = tot; red[part * 64 + 32 + e] = pre; }
        __syncthreads();
        if (tid < 32) { int tot = 0, pre = 0; for (int p = 0; p < 16; ++p) { tot += red[p * 64 + tid]; pre += red[p * 64 + 32 + tid]; } totS[tid] = tot; preS[tid] = pre; }
        __syncthreads();
        if (tid == 0) { int off = 0; for (int e = 0; e < 32; ++e) { padS[e] = off; off += ((totS[e] + 255) >> 8) << 8; } padS[32] = off; }
        __syncthreads();
        if (cb == 0) { if (tid < 32) { for (int t = padS[tid] >> 8; t < (padS[tid + 1] >> 8); ++t) tile_e[t] = tid; } if (tid == 32) ntiles_p[0] = padS[32] >> 8; }
        if (tid < 128) { const size_t a = (size_t)cb * 128 + tid; const int e = tok_e[a]; const int slot = padS[e] + preS[e] + tok_rank[a]; tok_slot[a] = slot; slotS[tid] = slot; }
        __syncthreads();
        for (int a = wave * 16; a < wave * 16 + 16; ++a) { const size_t t = (size_t)cb * 64 + (a >> 1); const int slot = slotS[a];
            const u32x4* src = (const u32x4*)(H2 + t * D) + lane; u32x4* dst = (u32x4*)(XS + (size_t)slot * D) + lane;
            dst[0] = src[0]; dst[64] = src[64]; }
        if (cb < 32) { const int r0 = padS[cb] + totS[cb], r1 = padS[cb + 1];
            for (int r = r0 + wave; r < r1; r += NWAVES) { u32x4* dst = (u32x4*)(XS + (size_t)r * D) + lane; dst[0] = (u32x4){0, 0, 0, 0}; dst[64] = (u32x4){0, 0, 0, 0}; } }
    }
    SEAM(9);

    if constexpr (IN(10)) {
        asm volatile("; PHASE_BEGIN 10" ::: "memory");
        PHASE_LOCALS
        bf16_t* XS = P_XS; bf16_t* W13_t = P_W13; bf16_t* HMID = P_HMID; int* tile_e = P_TILEE; int* ntiles_p = P_NT;
        const int ntm = __builtin_amdgcn_readfirstlane(ntiles_p[0]);
        pg8::MoeOrder S; S.init(XS, W13_t, tile_e, ntm, D, (size_t)1024 * 1024 * 2, G, cb); pg8::EpiUp E{HMID};
        pg8::gemm_phase<pg8::EpiUp, pg8::MoeOrder, true, true>(lds, D, S, E);
    }
    SEAM(10);

    if constexpr (IN(11)) {
        asm volatile("; PHASE_BEGIN 11" ::: "memory");
        PHASE_LOCALS
        bf16_t* HMID = P_HMID; bf16_t* W2_t = P_W2; bf16_t* Y = P_Y; int* tile_e = P_TILEE; int* ntiles_p = P_NT;
        const int ntm = __builtin_amdgcn_readfirstlane(ntiles_p[0]);
        pg8::MoeOrder S; S.init(HMID, W2_t, tile_e, ntm, DEXP, (size_t)1024 * 512 * 2, G, cb); pg8::EpiPlain E{Y, D};
        pg8::gemm_phase<pg8::EpiPlain, pg8::MoeOrder, true, true>(lds, DEXP, S, E);
    }
    SEAM(11);

    if constexpr (IN(12)) {
        asm volatile("; PHASE_BEGIN 12" ::: "memory");
        PHASE_LOCALS
        float* out = OUTP; float* modf = P_MODF; bf16_t* Y = P_Y; int* tok_slot = P_SLOT; float* tok_w = P_TOKW;
        for (int i = 0; i < 8; ++i) {
            const size_t m = (size_t)cb * 64 + wave * 8 + i; const int b = cb >> 6;
            const int s0 = tok_slot[m * 2], s1 = tok_slot[m * 2 + 1]; const float w0 = tok_w[m * 2], w1 = tok_w[m * 2 + 1];
            const float* g2p = modf + (size_t)b * NMOD + 5 * D;
#pragma unroll
            for (int j = 0; j < 4; ++j) { const int k = 4 * lane + 256 * j;
                const f32x4 xv = *(const f32x4*)(out + m * D + k); const f32x4 gv = *(const f32x4*)(g2p + k);
                const u32x2 y0 = *(const u32x2*)(Y + (size_t)s0 * D + k), y1 = *(const u32x2*)(Y + (size_t)s1 * D + k);
                f32x4 o; o.x = xv.x + gv.x * (w0 * lo_bf(y0.x) + w1 * lo_bf(y1.x)); o.y = xv.y + gv.y * (w0 * hi_bf(y0.x) + w1 * hi_bf(y1.x));
                o.z = xv.z + gv.z * (w0 * lo_bf(y0.y) + w1 * lo_bf(y1.y)); o.w = xv.w + gv.w * (w0 * hi_bf(y0.y) + w1 * hi_bf(y1.y));
                *(f32x4*)(out + m * D + k) = o; }
        }
    }
#undef IN
#undef SEAM
}

constexpr int NPHASE = 13;
template <int LO, int HI> static void launch_range(const Args& a, hipStream_t stream) {
    static bool attr = false;
    if (!attr) { (void)hipFuncSetAttribute((const void*)mk_fwd<LO, HI>, hipFuncAttributeMaxDynamicSharedMemorySize, LDS_BYTES); attr = true; }
    hipLaunchKernelGGL((mk_fwd<LO, HI>), dim3(256), dim3(NTHR), LDS_BYTES, stream, a);
}
extern "C" void kernel_launch(void* const* d_in, const int* in_sizes, int n_in, void* d_out, int out_size, void* d_ws, size_t ws_size, hipStream_t stream) {
    static int ok = 0;
    if (ok == 0) {
        if (n_in != 28 || out_size != M * D || ws_size < WS_END) { fprintf(stderr, "kernel_launch: unexpected shapes (n_in %d, out %d, ws %zu < %zu)\n", n_in, out_size, ws_size, (size_t)WS_END); ok = -1; return; }
        ok = 1;
    }
    if (ok < 0) return;
    (void)hipMemsetAsync((char*)d_ws + WS_CTL, 0, CTL_ZERO_BYTES, stream);
    Args a{};
    for (int i = 0; i < 28; ++i) a.in[i] = d_in[i];
    a.out = (float*)d_out; a.ws = (unsigned char*)d_ws; a.ph_lo = 0; a.ph_hi = NPHASE;
#if MK_ONE_LAUNCH
    launch_range<0, NPHASE>(a, stream);
#else
    launch_range<0, 1>(a, stream); launch_range<1, 2>(a, stream); launch_range<2, 3>(a, stream); launch_range<3, 4>(a, stream);
    launch_range<4, 5>(a, stream); launch_range<5, 6>(a, stream); launch_range<6, 7>(a, stream); launch_range<7, 8>(a, stream);
    launch_range<8, 9>(a, stream); launch_range<9, 10>(a, stream); launch_range<10, 11>(a, stream); launch_range<11, 12>(a, stream);
    launch_range<12, 13>(a, stream);
#endif
}
```

```cpp
#include <hip/hip_runtime.h>
#include <hip/hip_bf16.h>
#include <cstdio>
#include <cstdint>

#ifndef MK_ONE_LAUNCH
#define MK_ONE_LAUNCH 1
#endif

#define LAS __attribute__((address_space(3)))
#define GAS __attribute__((address_space(1)))
typedef unsigned short bf16_t;
typedef short bf16x8 __attribute__((ext_vector_type(8)));
typedef float f32x4 __attribute__((ext_vector_type(4)));
typedef float f32x2 __attribute__((ext_vector_type(2)));
typedef unsigned u32x4 __attribute__((ext_vector_type(4)));
typedef unsigned u32x2 __attribute__((ext_vector_type(2)));

constexpr int NB = 4, SEQ = 4096, D = 1024, M = NB * SEQ;
constexpr int DIN = 5136, NPROJ = 5120;
constexpr int NEXP = 32, DEXP = 512;
constexpr int PMAX = 40960;
constexpr int NMOD = 6 * D;

constexpr size_t MiB = 1u << 20;
constexpr size_t WS_CTL = 0, CTL_ZERO_BYTES = 1 * MiB;
constexpr size_t WS_MODP = 1 * MiB;
constexpr size_t WS_MODF = 4 * MiB;
constexpr size_t WS_ALR = 5 * MiB;
constexpr size_t WS_ROUTE = 6 * MiB;
constexpr size_t WS_WIN = 8 * MiB;
constexpr size_t WS_WA = 18 * MiB, WS_WB = 19 * MiB, WS_WOUT = 20 * MiB;
constexpr size_t RA = 22 * MiB;
constexpr size_t RB = 118 * MiB;
constexpr size_t WS_END = 278 * MiB;
constexpr size_t WS_XN = RA;
constexpr size_t WS_LOGA = RA;
constexpr size_t WS_SCT = RA + 16 * MiB;
constexpr size_t WS_SPT = RA + 48 * MiB;
constexpr size_t WS_OC = RA + 64 * MiB;
constexpr size_t WS_DEC = 7 * MiB;
constexpr size_t WS_WRT = 7 * MiB + 512 * 1024;
constexpr size_t WS_LRT = 7 * MiB + 768 * 1024;
constexpr size_t WS_OB = RB + 64 * MiB;
constexpr size_t WS_OA = RB + 48 * MiB;
constexpr size_t WS_XS = RA;
constexpr size_t WS_Y = RA;
constexpr size_t WS_UGLA = RB;
constexpr size_t WS_UDIFF = RB + 48 * MiB;
constexpr size_t WS_UGATE = RB + 96 * MiB;
constexpr size_t WS_M1 = RA;
constexpr size_t WS_MERGED = RB;
constexpr size_t WS_H2 = RB;
constexpr size_t WS_W13 = RB + 64 * MiB;
constexpr size_t WS_W2 = RB + 128 * MiB;
constexpr size_t WS_HMID = RB;
constexpr size_t RT_TOKE = 0, RT_TOKW = 131072, RT_RANK = 262144, RT_SLOT = 393216, RT_BLKCNT = 524288, RT_TILEE = 557056, RT_NT = 561152;
constexpr int CW_BAR = 4096;

constexpr int RING_BYTES = 131072;
constexpr int LDSCTL_OFF = RING_BYTES, MISC_OFF = LDSCTL_OFF + 320;
constexpr int LDS_BYTES = 147456;
constexpr int NWAVES = 8, NTHR = 512;

__device__ __forceinline__ float bf2f(bf16_t h) { return __uint_as_float((unsigned)h << 16); }
__device__ __forceinline__ unsigned f2bf(float f) { unsigned u = __float_as_uint(f); return (u + 0x7fffu + ((u >> 16) & 1u)) >> 16; }
__device__ __forceinline__ unsigned pk2(float lo, float hi) { return f2bf(lo) | (f2bf(hi) << 16); }
__device__ __forceinline__ float lo_bf(unsigned w) { return __uint_as_float(w << 16); }
__device__ __forceinline__ float hi_bf(unsigned w) { return __uint_as_float(w & 0xffff0000u); }
__device__ __forceinline__ float wave_sum(float v) {
#pragma unroll
    for (int o = 1; o < 64; o <<= 1) v += __shfl_xor(v, o);
    return v;
}
__device__ __forceinline__ float wave_max(float v) {
#pragma unroll
    for (int o = 1; o < 64; o <<= 1) v = fmaxf(v, __shfl_xor(v, o));
    return v;
}
__device__ __forceinline__ float sigmoidf_(float x) { return 1.0f / (1.0f + __expf(-x)); }
__device__ __forceinline__ float siluf_(float x) { return x / (1.0f + __expf(-x)); }
#define LDS_WAIT() asm volatile("s_waitcnt lgkmcnt(0)" ::: "memory")
#define VM_WAIT() asm volatile("s_waitcnt vmcnt(0)" ::: "memory")

namespace pg8 {
constexpr int BM = 256, BK = 64, HALF = 128, HTB = HALF * BK * 2, STAGE_BYTES = 8 * HTB, NXCD = 8, WGM = 8;
__host__ __device__ __forceinline__ int lds_byte(int r, int c) { const int st = (r >> 4) * 2 + (c >> 5), rr = r & 15, cc = c & 31, ob = rr * 64 + cc * 2; return st * 1024 + (ob ^ (((ob >> 9) & 1) << 5)); }
__host__ __device__ __forceinline__ void stage_rc(int b, int& R, int& C) { const int st = b / 1024, sb = b % 1024, swz = sb ^ (((sb >> 9) & 1) << 5); R = (st >> 1) * 16 + swz / 64; C = (st & 1) * 32 + (swz % 64) / 2; }
__host__ __device__ __forceinline__ int perm32(int rho) { const int n = rho >> 4, i = rho & 15; return 8 * (i >> 2) + 4 * n + (i & 3); }

struct Unit { int pm, pn, aux; };

__device__ __forceinline__ int xcd_swizzle(int wgid, int nwg) { const int q = nwg / NXCD, r = nwg % NXCD, xcd = wgid % NXCD, off = wgid / NXCD; return (xcd < r ? xcd * (q + 1) : r * (q + 1) + (xcd - r) * q) + off; }

struct DenseOrder {
    const char* A; const char* Bt; size_t tstep; int nM, nN, nwg, G, c;
    __device__ __forceinline__ void init(const void* A_, const void* Bt_, int M_, int N_, int K_, int G_, int c_) { A = (const char*)A_; Bt = (const char*)Bt_; tstep = (size_t)BM * K_ * 2; nM = M_ / BM; nN = N_ / BM; nwg = nM * nN; G = G_; c = c_; }
    __device__ __forceinline__ bool next(int i, Unit& u) const {
        const long L = (long)i * G + c; if (L >= nwg) return false;
        const int wgid = xcd_swizzle((int)L, nwg);
        const int nig = WGM * nN, gid = wgid / nig, fm = gid * WGM, gsz = (nM - fm) < WGM ? (nM - fm) : WGM;
        u.pm = fm + ((wgid % nig) % gsz); u.pn = (wgid % nig) / gsz; u.aux = 0; return true;
    }
    __device__ __forceinline__ const char* a_ptr(const Unit& u) const { return A + (size_t)u.pm * tstep; }
    __device__ __forceinline__ const char* b_ptr(const Unit& u) const { return Bt + (size_t)u.pn * tstep; }
};
struct MoeOrder {
    const char* A; const char* W; const int* tile_e; size_t tstep, estride; int nwg, G, c;
    __device__ __forceinline__ void init(const void* A_, const void* W_, const int* te, int ntm, int K_, size_t estride_, int G_, int c_) { A = (const char*)A_; W = (const char*)W_; tile_e = te; tstep = (size_t)BM * K_ * 2; estride = estride_; nwg = ntm * 4; G = G_; c = c_; }
    __device__ __forceinline__ bool next(int i, Unit& u) const {
        const long L = (long)i * G + c; if (L >= nwg) return false;
        const int wgid = xcd_swizzle((int)L, nwg);
        u.pm = wgid >> 2; u.pn = wgid & 3; u.aux = __builtin_amdgcn_readfirstlane(tile_e[u.pm]); return true;
    }
    __device__ __forceinline__ const char* a_ptr(const Unit& u) const { return A + (size_t)u.pm * tstep; }
    __device__ __forceinline__ const char* b_ptr(const Unit& u) const { return W + (size_t)u.aux * estride + (size_t)u.pn * tstep; }
};

__device__ __forceinline__ u32x4 pack8(const f32x4& v0, const f32x4& v1) { u32x4 w; w.x = pk2(v0[0], v0[1]); w.y = pk2(v0[2], v0[3]); w.z = pk2(v1[0], v1[1]); w.w = pk2(v1[2], v1[3]); return w; }

struct EpiInProj {
    static constexpr bool PERM = true, AFTER_DRAIN = false;
    bf16_t *Ugla, *Udiff, *Ugate;
    __device__ __forceinline__ void operator()(const f32x4 (&acc)[2][2][4][2], const Unit& u, int wr, int wc, int fr, int fq) const {
        bf16_t* base; int ldc, colt;
        if (u.pn < 6) { base = Ugla; ldc = 1536; colt = u.pn * 256; } else if (u.pn < 12) { base = Udiff; ldc = 1536; colt = (u.pn - 6) * 256; } else { base = Ugate; ldc = 2048; colt = (u.pn - 12) * 256; }
        const int row0 = u.pm * BM + wr * 64 + fr, col0 = colt + wc * 32 + 8 * fq;
#pragma unroll
        for (int ai = 0; ai < 2; ++ai)
#pragma unroll
            for (int m = 0; m < 4; ++m) { bf16_t* rowp = base + (size_t)(row0 + ai * HALF + m * 16) * ldc + col0;
#pragma unroll
                for (int bj = 0; bj < 2; ++bj) *(u32x4*)(rowp + bj * HALF) = pack8(acc[ai][bj][m][0], acc[ai][bj][m][1]); }
    }
};
struct EpiPlain {
    static constexpr bool PERM = true, AFTER_DRAIN = false;
    bf16_t* O; int ldc;
    __device__ __forceinline__ void operator()(const f32x4 (&acc)[2][2][4][2], const Unit& u, int wr, int wc, int fr, int fq) const {
        const int row0 = u.pm * BM + wr * 64 + fr, col0 = u.pn * BM + wc * 32 + 8 * fq;
#pragma unroll
        for (int ai = 0; ai < 2; ++ai)
#pragma unroll
            for (int m = 0; m < 4; ++m) { bf16_t* rowp = O + (size_t)(row0 + ai * HALF + m * 16) * ldc + col0;
#pragma unroll
                for (int bj = 0; bj < 2; ++bj) *(u32x4*)(rowp + bj * HALF) = pack8(acc[ai][bj][m][0], acc[ai][bj][m][1]); }
    }
};
struct EpiBranch {
    static constexpr bool PERM = true, AFTER_DRAIN = false;
    const bf16_t* gate; int gcol0; const bf16_t* m1in; bf16_t* out;
    __device__ __forceinline__ void operator()(const f32x4 (&acc)[2][2][4][2], const Unit& u, int wr, int wc, int fr, int fq) const {
        const int row0 = u.pm * BM + wr * 64 + fr, col0 = u.pn * BM + wc * 32 + 8 * fq;
#pragma unroll
        for (int ai = 0; ai < 2; ++ai)
#pragma unroll
            for (int m = 0; m < 4; ++m) { const size_t r = (size_t)(row0 + ai * HALF + m * 16);
#pragma unroll
                for (int bj = 0; bj < 2; ++bj) { const int c = col0 + bj * HALF;
                    const u32x4 g = *(const u32x4*)(gate + r * 2048 + gcol0 + c);
                    f32x4 v0 = acc[ai][bj][m][0], v1 = acc[ai][bj][m][1];
                    v0[0] *= sigmoidf_(lo_bf(g.x)); v0[1] *= sigmoidf_(hi_bf(g.x)); v0[2] *= sigmoidf_(lo_bf(g.y)); v0[3] *= sigmoidf_(hi_bf(g.y));
                    v1[0] *= sigmoidf_(lo_bf(g.z)); v1[1] *= sigmoidf_(hi_bf(g.z)); v1[2] *= sigmoidf_(lo_bf(g.w)); v1[3] *= sigmoidf_(hi_bf(g.w));
                    if (m1in) { const u32x4 p = *(const u32x4*)(m1in + r * 1024 + c);
                        v0[0] += lo_bf(p.x); v0[1] += hi_bf(p.x); v0[2] += lo_bf(p.y); v0[3] += hi_bf(p.y); v1[0] += lo_bf(p.z); v1[1] += hi_bf(p.z); v1[2] += lo_bf(p.w); v1[3] += hi_bf(p.w); }
                    *(u32x4*)(out + r * 1024 + c) = pack8(v0, v1); } }
    }
};
struct EpiWout {
    static constexpr bool PERM = false, AFTER_DRAIN = false;
    const float* x; const float* modf; float* out;
    __device__ __forceinline__ void operator()(const f32x4 (&acc)[2][2][4][2], const Unit& u, int wr, int wc, int fr, int fq) const {
        const int row0 = u.pm * BM + wr * 64 + fr, col0 = u.pn * BM + wc * 32 + 4 * fq;
        const float* g1 = modf + (size_t)((u.pm * BM) >> 12) * NMOD + 2 * D;
#pragma unroll
        for (int bj = 0; bj < 2; ++bj)
#pragma unroll
            for (int n = 0; n < 2; ++n) { const int c = col0 + bj * HALF + n * 16; const f32x4 gv = *(const f32x4*)(g1 + c);
#pragma unroll
                for (int ai = 0; ai < 2; ++ai)
#pragma unroll
                    for (int m = 0; m < 4; ++m) { const size_t off = (size_t)(row0 + ai * HALF + m * 16) * D + c;
                        const f32x4 xv = *(const f32x4*)(x + off); *(f32x4*)(out + off) = xv + gv * acc[ai][bj][m][n]; } }
    }
};
struct EpiUp {
    static constexpr bool PERM = true, AFTER_DRAIN = false;
    bf16_t* H;
    __device__ __forceinline__ void operator()(const f32x4 (&acc)[2][2][4][2], const Unit& u, int wr, int wc, int fr, int fq) const {
        const int row0 = u.pm * BM + wr * 64 + fr, col0 = u.pn * HALF + wc * 32 + 8 * fq;
#pragma unroll
        for (int ai = 0; ai < 2; ++ai)
#pragma unroll
            for (int m = 0; m < 4; ++m) { f32x4 v0, v1;
#pragma unroll
                for (int e = 0; e < 4; ++e) { v0[e] = siluf_(acc[ai][0][m][0][e]) * acc[ai][1][m][0][e]; v1[e] = siluf_(acc[ai][0][m][1][e]) * acc[ai][1][m][1][e]; }
                *(u32x4*)(H + (size_t)(row0 + ai * HALF + m * 16) * DEXP + col0) = pack8(v0, v1); }
    }
};

template <class Epi, class Sched, bool ALIGN_EPI = false, bool SP2 = false>
__device__ __forceinline__ void gemm_phase(LAS unsigned char* lds, const int K, const Sched& S, const Epi& E) {
    int tid_ = threadIdx.x; asm volatile("" : "+v"(tid_));
    const int tid = tid_, wid = __builtin_amdgcn_readfirstlane(tid >> 6), lane = tid & 63, wr = wid >> 2, wc = wid & 3, fr = lane & 15, fq = lane >> 4;
    const int nt = K / BK;
    unsigned voffA[2], voffB[2];
#pragma unroll
    for (int i = 0; i < 2; ++i) { int R, C; stage_rc(tid * 16 + i * 8192, R, C); const int Rb = Epi::PERM ? ((R & ~31) + perm32(R & 31)) : R;
        voffA[i] = (unsigned)(R * K + C) * 2u; voffB[i] = (unsigned)(Rb * K + C) * 2u; }
    const size_t kstep = (size_t)(BK * 2);
    const size_t hstep = (size_t)HALF * K * 2;
    const unsigned ldsw = (unsigned)wid * 1024u;
    const int aoff = lds_byte(wr * 64 + fr, fq * 8), boff = lds_byte(wc * 32 + fr, fq * 8);
#define PG8_SA(b, h) (((b) * 2 + (h)) * HTB)
#define PG8_SB(b, h) ((4 + (b) * 2 + (h)) * HTB)
#define PG8_STAGE(bufoff, gbase, voff) do { _Pragma("unroll") for (int _i = 0; _i < 2; ++_i) \
        __builtin_amdgcn_global_load_lds((const unsigned*)((const char*)(gbase) + (voff)[_i]), (LAS unsigned*)(lds + (bufoff) + ldsw + _i * 8192), 16, 0, 0); } while (0)
#define PG8_LDA(dst, b, h) do { _Pragma("unroll") for (int m = 0; m < 4; ++m) _Pragma("unroll") for (int k = 0; k < 2; ++k) dst[m][k] = *(const LAS bf16x8*)(lds + PG8_SA(b, h) + aoff + m * 2048 + k * 1024); } while (0)
#define PG8_LDB(dst, b, h) do { _Pragma("unroll") for (int n = 0; n < 2; ++n) _Pragma("unroll") for (int k = 0; k < 2; ++k) dst[n][k] = *(const LAS bf16x8*)(lds + PG8_SB(b, h) + boff + n * 2048 + k * 1024); } while (0)
#define PG8_MMA(ai, bj, At, Bt) do { __builtin_amdgcn_s_setprio(1); _Pragma("unroll") for (int m = 0; m < 4; ++m) _Pragma("unroll") for (int n = 0; n < 2; ++n) _Pragma("unroll") for (int k = 0; k < 2; ++k) \
        acc[ai][bj][m][n] = __builtin_amdgcn_mfma_f32_16x16x32_bf16(Bt[n][k], At[m][k], acc[ai][bj][m][n], 0, 0, 0); __builtin_amdgcn_s_setprio(0); } while (0)
#define PG8_WAIT_V(n) asm volatile("s_waitcnt vmcnt(" #n ")" ::: "memory")
#define PG8_WAIT_L(n) asm volatile("s_waitcnt lgkmcnt(" #n ")" ::: "memory")
#define PG8_BAR __builtin_amdgcn_s_barrier()
#define PG8_SCHED __builtin_amdgcn_sched_barrier(0)
    Unit cur, nxt; int ui = 0;
    if (!S.next(0, cur)) return;
    f32x4 acc[2][2][4][2];
#pragma unroll
    for (int a = 0; a < 2; ++a)
#pragma unroll
        for (int b = 0; b < 2; ++b)
#pragma unroll
            for (int m = 0; m < 4; ++m)
#pragma unroll
                for (int n = 0; n < 2; ++n) acc[a][b][m][n] = (f32x4){0.f, 0.f, 0.f, 0.f};
    bf16x8 At[4][2], B0[2][2], B1[2][2];
    const char* cA = S.a_ptr(cur); const char* cB = S.b_ptr(cur);
    if constexpr (SP2) {
        PG8_STAGE(PG8_SB(0, 0), cB, voffB); PG8_STAGE(PG8_SB(0, 1), cB + hstep, voffB); PG8_STAGE(PG8_SA(0, 0), cA, voffA); PG8_STAGE(PG8_SA(0, 1), cA + hstep, voffA);
        if (wr == 1) PG8_BAR;
        PG8_WAIT_V(2); PG8_BAR;
        PG8_STAGE(PG8_SB(1, 0), cB + kstep, voffB); PG8_STAGE(PG8_SA(1, 0), cA + kstep, voffA); PG8_STAGE(PG8_SB(1, 1), cB + hstep + kstep, voffB);
        PG8_WAIT_V(6); PG8_BAR;
    } else {
        PG8_STAGE(PG8_SB(0, 0), cB, voffB); PG8_STAGE(PG8_SA(0, 0), cA, voffA); PG8_STAGE(PG8_SB(0, 1), cB + hstep, voffB); PG8_STAGE(PG8_SA(0, 1), cA + hstep, voffA);
        if (wr == 1) PG8_BAR;
        PG8_WAIT_V(4); PG8_BAR;
        PG8_STAGE(PG8_SB(1, 0), cB + kstep, voffB); PG8_STAGE(PG8_SA(1, 0), cA + kstep, voffA); PG8_STAGE(PG8_SB(1, 1), cB + hstep + kstep, voffB);
        PG8_WAIT_V(6); PG8_BAR;
    }
    for (;;) {
        const bool has_next = S.next(ui + 1, nxt);
        const char* nA = has_next ? S.a_ptr(nxt) : cA; const char* nB = has_next ? S.b_ptr(nxt) : cB;
        for (int t = 0; t < nt; t += 2) {
            const bool last = (t == nt - 2);
            const char* a1 = cA + (size_t)(t + 1) * kstep;
            const char* a2 = last ? nA : cA + (size_t)(t + 2) * kstep; const char* b2 = last ? nB : cB + (size_t)(t + 2) * kstep;
            const char* a3 = a2 + kstep; const char* b3 = b2 + kstep;
            if constexpr (SP2) {
            PG8_LDB(B0, 0, 0); PG8_LDB(B1, 0, 1); PG8_SCHED; PG8_LDA(At, 0, 0); PG8_STAGE(PG8_SA(1, 1), a1 + hstep, voffA);
            PG8_WAIT_V(8); PG8_WAIT_L(0); PG8_BAR; PG8_MMA(0, 0, At, B0); PG8_MMA(0, 1, At, B1); PG8_BAR; PG8_SCHED;
            PG8_LDA(At, 0, 1); PG8_STAGE(PG8_SB(0, 0), b2, voffB); PG8_STAGE(PG8_SB(0, 1), b2 + hstep, voffB); PG8_STAGE(PG8_SA(0, 0), a2, voffA);
            PG8_WAIT_V(8); PG8_WAIT_L(0); PG8_BAR; PG8_MMA(1, 0, At, B0); PG8_MMA(1, 1, At, B1); PG8_BAR; PG8_SCHED;
            PG8_LDB(B0, 1, 0); PG8_LDB(B1, 1, 1); PG8_SCHED; PG8_LDA(At, 1, 0); PG8_STAGE(PG8_SA(0, 1), a2 + hstep, voffA);
            PG8_WAIT_V(8); PG8_WAIT_L(0); PG8_BAR; PG8_MMA(0, 0, At, B0); PG8_MMA(0, 1, At, B1); PG8_BAR; PG8_SCHED;
            PG8_LDA(At, 1, 1); PG8_STAGE(PG8_SB(1, 0), b3, voffB); PG8_STAGE(PG8_SB(1, 1), b3 + hstep, voffB); PG8_STAGE(PG8_SA(1, 0), a3, voffA);
            PG8_WAIT_V(8); PG8_WAIT_L(0); PG8_BAR; PG8_MMA(1, 0, At, B0); PG8_MMA(1, 1, At, B1); PG8_BAR; PG8_SCHED;
            } else {
            PG8_LDB(B0, 0, 0); PG8_SCHED; PG8_LDA(At, 0, 0); PG8_STAGE(PG8_SA(1, 1), a1 + hstep, voffA);
            PG8_WAIT_L(8); PG8_BAR; PG8_WAIT_L(0); PG8_MMA(0, 0, At, B0); PG8_BAR; PG8_SCHED;
            PG8_LDB(B1, 0, 1); PG8_STAGE(PG8_SB(0, 0), b2, voffB);
            PG8_BAR; PG8_WAIT_L(0); PG8_MMA(0, 1, At, B1); PG8_BAR;
            PG8_LDA(At, 0, 1); PG8_STAGE(PG8_SA(0, 0), a2, voffA);
            PG8_BAR; PG8_WAIT_L(0); PG8_MMA(1, 0, At, B0); PG8_BAR; PG8_SCHED;
            PG8_STAGE(PG8_SB(0, 1), b2 + hstep, voffB);
            PG8_WAIT_V(6); PG8_BAR; PG8_MMA(1, 1, At, B1); PG8_BAR;
            PG8_LDB(B0, 1, 0); PG8_SCHED; PG8_LDA(At, 1, 0); PG8_STAGE(PG8_SA(0, 1), a2 + hstep, voffA);
            PG8_WAIT_L(8); PG8_BAR; PG8_WAIT_L(0); PG8_MMA(0, 0, At, B0); PG8_BAR; PG8_SCHED;
            PG8_LDB(B1, 1, 1); PG8_STAGE(PG8_SB(1, 0), b3, voffB);
            PG8_BAR; PG8_WAIT_L(0); PG8_MMA(0, 1, At, B1); PG8_BAR;
            PG8_LDA(At, 1, 1); PG8_STAGE(PG8_SA(1, 0), a3, voffA);
            PG8_BAR; PG8_WAIT_L(0); PG8_MMA(1, 0, At, B0); PG8_BAR; PG8_SCHED;
            PG8_STAGE(PG8_SB(1, 1), b3 + hstep, voffB);
            PG8_WAIT_V(6); PG8_BAR; PG8_MMA(1, 1, At, B1); PG8_BAR;
            }
        }
        if constexpr (ALIGN_EPI) { if (wr == 0) PG8_BAR; }
        E(acc, cur, wr, wc, fr, fq);
        if (!has_next) break;
#pragma unroll
        for (int a = 0; a < 2; ++a)
#pragma unroll
            for (int b = 0; b < 2; ++b)
#pragma unroll
                for (int m = 0; m < 4; ++m)
#pragma unroll
                    for (int n = 0; n < 2; ++n) acc[a][b][m][n] = (f32x4){0.f, 0.f, 0.f, 0.f};
        cur = nxt; cA = nA; cB = nB; ++ui;
        if constexpr (ALIGN_EPI) { if (wr == 1) PG8_BAR; }
    }
    PG8_WAIT_V(0);
    if constexpr (!ALIGN_EPI) { if (wr == 0) PG8_BAR; }
    PG8_BAR;
#undef PG8_SA
#undef PG8_SB
#undef PG8_STAGE
#undef PG8_LDA
#undef PG8_LDB
#undef PG8_MMA
#undef PG8_WAIT_V
#undef PG8_WAIT_L
#undef PG8_BAR
#undef PG8_SCHED
}
}

namespace attn_body {
using bf16=__hip_bfloat16;
using bf16x8=__attribute__((ext_vector_type(8)))short;
using s16x4=__attribute__((ext_vector_type(4)))short;
using f32x16=__attribute__((ext_vector_type(16)))float;
using u32x4=__attribute__((ext_vector_type(4)))unsigned;
constexpr int SEQ=4096,D=64,DM=1536,DMO=512;
constexpr int NW=8,QBLK=32,QB=QBLK*NW,KVBLK=64,NQB=SEQ/QB;
constexpr int ATTN_UNIT_ROWS=QB;
__device__ __forceinline__ int crow(int r,int hi){return (r&3)+8*(r>>2)+4*hi;}
#define SBAR() __builtin_amdgcn_sched_barrier(0)
__device__ __forceinline__ void cmask(f32x16&p0,f32x16&p1,int jb,int qrel,int hi){
  const float NEG=-INFINITY; int kb=64*jb+4*hi;
  #pragma unroll
  for(int r=0;r<16;++r){int kv=kb+(r&3)+8*(r>>2); if(kv>qrel)p0[r]=NEG; if(kv+32>qrel)p1[r]=NEG;}
}

constexpr int NSLOT=3, SLOTB=8192;
constexpr int LDS_K=0, LDS_V=NSLOT*SLOTB, LDS_WS=2*NSLOT*SLOTB, LDS_OST=LDS_WS+NW*64*4, LDS_BYTES=LDS_OST+NW*4096;
constexpr float C2=0.125f*1.4426950408889634f;
__device__ __forceinline__ void glds16(const void*gsrc,unsigned lds_dst){unsigned keep;
  asm volatile("s_mov_b32 %0, m0\n\ts_mov_b32 m0, %2\n\ts_nop 0\n\tglobal_load_lds_dwordx4 %1, off\n\ts_mov_b32 m0, %0":"=&s"(keep):"v"(gsrc),"s"(lds_dst):"memory");}
__device__ __forceinline__ float max3f(float a,float b,float c){float r;asm("v_max3_f32 %0, %1, %2, %3":"=v"(r):"v"(a),"v"(b),"v"(c));return r;}
__device__ __forceinline__ float max2f(float a,float b){float r;asm("v_max_f32_e32 %0, %1, %2":"=v"(r):"v"(a),"v"(b));return r;}
__device__ __forceinline__ float fadd_s(float a,float b){float r;asm("v_add_f32_e32 %0, %1, %2":"=v"(r):"v"(a),"v"(b));return r;}
__device__ __forceinline__ float fsub_s(float a,float b){float r;asm("v_sub_f32_e32 %0, %1, %2":"=v"(r):"v"(a),"v"(b));return r;}
typedef float f32x2_t __attribute__((ext_vector_type(2))); typedef __bf16 bf16x2_t __attribute__((ext_vector_type(2)));
__device__ __forceinline__ unsigned cvtpk_s(float lo,float hi){f32x2_t v={lo,hi};bf16x2_t b=__builtin_convertvector(v,bf16x2_t);return __builtin_bit_cast(unsigned,b);}
#define WAIT_BAR(N) asm volatile("s_waitcnt vmcnt(" #N ") lgkmcnt(0)\n\ts_barrier":::"memory")

__device__ __forceinline__ void qkt(f32x16&p0,f32x16&p1,const char*Kslot,const bf16x8*qr,const f32x16&negm,int r32,int hi){
  const char*kb=Kslot+hi*1024+r32*16;
  #pragma unroll
  for(int d0=0;d0<4;++d0){
    const bf16x8 b0=*reinterpret_cast<const bf16x8*>(kb+d0*2048);
    const bf16x8 b1=*reinterpret_cast<const bf16x8*>(kb+d0*2048+512);
    if(d0==0){p0=__builtin_amdgcn_mfma_f32_32x32x16_bf16(b0,qr[0],negm,0,0,0);p1=__builtin_amdgcn_mfma_f32_32x32x16_bf16(b1,qr[0],negm,0,0,0);}
    else{p0=__builtin_amdgcn_mfma_f32_32x32x16_bf16(b0,qr[d0],p0,0,0,0);p1=__builtin_amdgcn_mfma_f32_32x32x16_bf16(b1,qr[d0],p1,0,0,0);}}
}
typedef __attribute__((address_space(3))) const char* lds_cptr;
typedef short v4i16_t __attribute__((ext_vector_type(4)));
__device__ __forceinline__ void kload8(bf16x8*kf,lds_cptr kp){
  kf[0]=*(const __attribute__((address_space(3))) bf16x8*)(kp);      kf[1]=*(const __attribute__((address_space(3))) bf16x8*)(kp+512);
  kf[2]=*(const __attribute__((address_space(3))) bf16x8*)(kp+2048); kf[3]=*(const __attribute__((address_space(3))) bf16x8*)(kp+2560);
  kf[4]=*(const __attribute__((address_space(3))) bf16x8*)(kp+4096); kf[5]=*(const __attribute__((address_space(3))) bf16x8*)(kp+4608);
  kf[6]=*(const __attribute__((address_space(3))) bf16x8*)(kp+6144); kf[7]=*(const __attribute__((address_space(3))) bf16x8*)(kp+6656);
}
__device__ __forceinline__ void kload2(bf16x8*kf,lds_cptr kp,int j){ kf[2*j]=*(const __attribute__((address_space(3))) bf16x8*)(kp+j*2048); kf[2*j+1]=*(const __attribute__((address_space(3))) bf16x8*)(kp+j*2048+512); }
__device__ __forceinline__ s16x4 vtr(lds_cptr p){ return __builtin_bit_cast(s16x4,__builtin_amdgcn_ds_read_tr16_b64_v4i16((__attribute__((address_space(3))) v4i16_t*)p)); }
__device__ __forceinline__ float rowmax(const f32x16&p0,const f32x16&p1){
  float a=max3f(p0[0],p0[1],p1[0]),b=max3f(p0[2],p0[3],p1[1]);a=max3f(a,p1[2],p1[3]);
  #pragma unroll
  for(int r=4;r<16;r+=4){a=max3f(a,p0[r],p0[r+1]);b=max3f(b,p0[r+2],p0[r+3]);a=max3f(a,p1[r],p1[r+1]);b=max3f(b,p1[r+2],p1[r+3]);}
  const float m=max2f(a,b);
  auto rr=__builtin_amdgcn_permlane32_swap(__float_as_uint(m),__float_as_uint(m),false,false);
  return max2f(__uint_as_float(rr[0]),__uint_as_float(rr[1]));
}
__device__ __forceinline__ void pv(f32x16*o,int vb,bf16x8 pa0,bf16x8 pa1,bf16x8 pa2,bf16x8 pa3){
  #pragma unroll
  for(int d0=0;d0<2;++d0){s16x4 lo[4],hi[4];
    #pragma unroll
    for(int ks=0;ks<4;++ks){
      asm volatile("ds_read_b64_tr_b16 %0,%1 offset:%c2":"=&v"(lo[ks]):"v"(vb),"i"(d0*4096+ks*1024):"memory");
      asm volatile("ds_read_b64_tr_b16 %0,%1 offset:%c2":"=&v"(hi[ks]):"v"(vb),"i"(d0*4096+ks*1024+512):"memory");}
    asm volatile("s_waitcnt lgkmcnt(0)":::"memory");SBAR();
    #define PK(k) (bf16x8){lo[k][0],lo[k][1],lo[k][2],lo[k][3],hi[k][0],hi[k][1],hi[k][2],hi[k][3]}
    o[d0]=__builtin_amdgcn_mfma_f32_32x32x16_bf16(pa0,PK(0),o[d0],0,0,0);
    o[d0]=__builtin_amdgcn_mfma_f32_32x32x16_bf16(pa1,PK(1),o[d0],0,0,0);
    o[d0]=__builtin_amdgcn_mfma_f32_32x32x16_bf16(pa2,PK(2),o[d0],0,0,0);
    o[d0]=__builtin_amdgcn_mfma_f32_32x32x16_bf16(pa3,PK(3),o[d0],0,0,0);
    #undef PK
  }
}

#ifndef ATTN_STORE16
#define ATTN_STORE16(p,v) (*(u32x4*)(p)=(v))
#endif
template<int THRL> __device__ __forceinline__ void attn_unit(int b,int qcol,int kcol,int vcol,int ocol,int qb,const bf16*Q,const bf16*__restrict__ K,const bf16*__restrict__ V,bf16*O,char*shm){
  int tid_=threadIdx.x; asm volatile("":"+v"(tid_));
  const int tid=tid_,lane=tid&63,r32=lane&31,hi=lane>>5; const int wid=__builtin_amdgcn_readfirstlane(tid>>6);
  const long rowbase=(long)b*SEQ; const int q0=qb*QB;
  const bf16*Qw=Q+(rowbase+q0+wid*QBLK)*DM+qcol;
  const bf16*Kh=K+rowbase*DM+kcol,*Vh=V+rowbase*DM+vcol;
  const unsigned lds0=(unsigned)(uintptr_t)shm;
  float*wsf=(float*)(shm+LDS_WS)+wid*64;
  const bf16*ksrc=Kh+(long)lane*DM+wid*8;
  const bf16*vsrc=Vh+(long)(16*(wid&3)+(lane>>2))*DM+(wid>>2)*32+(lane&3)*8;
  const unsigned kdst=lds0+LDS_K+wid*1024, vdst=lds0+LDS_V+wid*1024;
  #define DMA_K(t,slot) glds16(ksrc+(long)(t)*KVBLK*DM,(unsigned)__builtin_amdgcn_readfirstlane(kdst+(slot)))
  #define DMA_V(t,slot) glds16(vsrc+(long)(t)*KVBLK*DM,(unsigned)__builtin_amdgcn_readfirstlane(vdst+(slot)))
  const int vb0=(int)(lds0+LDS_V)+((lane>>4)&1)*32+(lane&3)*8+(4*hi+((lane&15)>>2))*64;
  const char*Kbase=shm+LDS_K; bf16x8 kf[8];
  const lds_cptr shm3=(lds_cptr)shm; const lds_cptr kp0=shm3+LDS_K+hi*1024+r32*16; const lds_cptr vp0=shm3+LDS_V+((lane>>4)&1)*32+(lane&3)*8+(4*hi+((lane&15)>>2))*64;
  const int NT=(q0+QB)/KVBLK;
  DMA_K(0,0);DMA_V(0,0);DMA_K(1,SLOTB);
  bf16x8 qr[4];
  #pragma unroll
  for(int d0=0;d0<4;++d0)qr[d0]=*reinterpret_cast<const bf16x8*>(&Qw[(long)r32*DM+d0*16+hi*8]);
  float mhat=0.f,l_reg=0.f;f32x16 o[2];o[0]=f32x16{};o[1]=f32x16{};f32x16 negm=f32x16{};asm volatile("":"+v"(negm));
  const int qrel=wid*QBLK+r32;
  #define CMASK(P0,P1,t) do{int jb_=(t)-(NT-4); if(jb_>=0)cmask(P0,P1,jb_,qrel,hi);}while(0)
  bool resc=false;
  #define START(P0,P1) do{ const float rm=rowmax(P0,P1); resc=false; \
    { const float dl=rm; mhat=fadd_s(mhat,dl); \
      _Pragma("unroll") for(int r=0;r<16;++r){P0[r]=fsub_s(P0[r],dl);P1[r]=fsub_s(P1[r],dl);} \
      _Pragma("unroll") for(int r=0;r<16;++r)negm[r]=-mhat; asm volatile("":"+v"(negm)); } \
    _Pragma("unroll") for(int r=0;r<16;++r)P0[r]=__builtin_amdgcn_exp2f(P0[r]); }while(0)
  #define RESC() do{ if(resc){ asm volatile("s_waitcnt lgkmcnt(0)":::"memory"); \
      _Pragma("unroll") for(int d_=0;d_<2;++d_) _Pragma("unroll") for(int r=0;r<16;++r)o[d_][r]*=wsf[crow(r,hi)]; } }while(0)
  f32x16 pA0,pA1,pB0,pB1;
  int sl_prev=0,sl_cur=0,sl_next=SLOTB;
  #define ROT() do{sl_prev=sl_cur;sl_cur=sl_next;sl_next=(sl_next==(NSLOT-1)*SLOTB)?0:sl_next+SLOTB;}while(0)
  DMA_K(2,2*SLOTB);
  WAIT_BAR(3);
  qkt(pA0,pA1,Kbase,qr,negm,r32,hi);asm volatile("s_nop 15\n\ts_nop 7":"+v"(pA0),"+v"(pA1));CMASK(pA0,pA1,0);
  START(pA0,pA1);
  _Pragma("unroll") for(int r=0;r<16;++r)pA1[r]=__builtin_amdgcn_exp2f(pA1[r]);
  WAIT_BAR(0);
  DMA_K(3,0);DMA_V(1,SLOTB);
  ROT();
  kload8(kf,kp0+sl_cur);
  WAIT_BAR(2);
  s16x4 vlo[8],vhi[8]; u32x4 pw0,pw1,pw2,pw3;
  #define PKW(P,B) cvtpk_s(P[B],P[B+1])
  #define PAF(k) __builtin_bit_cast(bf16x8,pw##k)
  #define VFR(i) (bf16x8){vlo[i][0],vlo[i][1],vlo[i][2],vlo[i][3],vhi[i][0],vhi[i][1],vhi[i][2],vhi[i][3]}
  #define PIN(x) asm volatile("":"+v"(x))
  #define MX3(a,b,c) __builtin_fmaxf(__builtin_fmaxf((a),(b)),(c))
  #define GAPA(MF,A0,A1,A2,A3,W0,W1,PW) do{ MF; sacc+=A0; sacc+=A1; sacc+=A2; sacc+=A3; PIN(sacc); W0; W1; PIN(PW); SBAR(); }while(0)
  #define EX(v) __builtin_amdgcn_exp2f(v)
  #define GAPB(MF,X,B) do{ MF; X[B]=EX(X[B]); X[B+1]=EX(X[B+1]); X[B+2]=EX(X[B+2]); X[B+3]=EX(X[B+3]); PIN(X); SBAR(); }while(0)
  #define VRD(i) do{ vlo[i]=vtr(vp_+(((i)>>2)*4096+((i)&3)*1024)); vhi[i]=vtr(vp_+(((i)>>2)*4096+((i)&3)*1024+512)); }while(0)
  #define KRD(G,j) do{ if(G){ kload2(kf,kp0+sl_next,j); SBAR(); } }while(0)
  #define STEP(C0,C1,P0,P1,t,GK,GV,GL) do{ SBAR(); \
    const lds_cptr vp_=vp0+sl_prev; \
    VRD(0); SBAR(); float sacc=(P0[0]+P0[1]); \
    GAPA(C0=__builtin_amdgcn_mfma_f32_32x32x16_bf16(kf[0],qr[0],negm,0,0,0), P0[2],P0[3],P0[4],P0[5],     pw0[0]=PKW(P0,0), pw0[1]=PKW(P0,2), pw0); \
    VRD(4); SBAR(); GAPA(C1=__builtin_amdgcn_mfma_f32_32x32x16_bf16(kf[1],qr[0],negm,0,0,0), P0[6],P0[7],P0[8],P0[9],     pw0[2]=PKW(P0,4), pw0[3]=PKW(P0,6), pw0); \
    VRD(1); SBAR(); GAPA(C0=__builtin_amdgcn_mfma_f32_32x32x16_bf16(kf[2],qr[1],C0,0,0,0),   P0[10],P0[11],P0[12],P0[13], pw1[0]=PKW(P0,8), pw1[1]=PKW(P0,10), pw1); \
    VRD(5); SBAR(); GAPA(C1=__builtin_amdgcn_mfma_f32_32x32x16_bf16(kf[3],qr[1],C1,0,0,0),   P0[14],P0[15],P1[0],P1[1],   pw1[2]=PKW(P0,12),pw1[3]=PKW(P0,14), pw1); \
    VRD(2); SBAR(); GAPA(C0=__builtin_amdgcn_mfma_f32_32x32x16_bf16(kf[4],qr[2],C0,0,0,0),   P1[2],P1[3],P1[4],P1[5],     pw2[0]=PKW(P1,0), pw2[1]=PKW(P1,2), pw2); \
    VRD(6); SBAR(); GAPA(C1=__builtin_amdgcn_mfma_f32_32x32x16_bf16(kf[5],qr[2],C1,0,0,0),   P1[6],P1[7],P1[8],P1[9],     pw2[2]=PKW(P1,4), pw2[3]=PKW(P1,6), pw2); \
    VRD(3); SBAR(); GAPA(C0=__builtin_amdgcn_mfma_f32_32x32x16_bf16(kf[6],qr[3],C0,0,0,0),   P1[10],P1[11],P1[12],P1[13], pw3[0]=PKW(P1,8), pw3[1]=PKW(P1,10), pw3); \
    VRD(7); SBAR(); GAPA(C1=__builtin_amdgcn_mfma_f32_32x32x16_bf16(kf[7],qr[3],C1,0,0,0),   P1[14],P1[15],0.f,0.f,       pw3[2]=PKW(P1,12),pw3[3]=PKW(P1,14), pw3); \
    l_reg+=sacc; \
    if(GK){DMA_K((t)+3,sl_cur);} if(GV){DMA_V((t)+1,sl_next);} \
    CMASK(C0,C1,t); \
    { float a=MX3(C0[0],C0[1],C1[0]),b=MX3(C0[2],C0[3],C1[1]); a=MX3(a,C1[2],C1[3]); \
      _Pragma("unroll") for(int r=4;r<16;r+=4){a=MX3(a,C0[r],C0[r+1]);b=MX3(b,C0[r+2],C0[r+3]);a=MX3(a,C1[r],C1[r+1]);b=MX3(b,C1[r+2],C1[r+3]);} \
      float rm=__builtin_fmaxf(a,b); { auto rr=__builtin_amdgcn_permlane32_swap(__float_as_uint(rm),__float_as_uint(rm),false,false); rm=__builtin_fmaxf(__uint_as_float(rr[0]),__uint_as_float(rr[1])); } \
      resc=false; \
      if(__builtin_expect(__any(rm>(float)THRL),0)){ const float dl=__builtin_fmaxf(rm,0.f); mhat+=dl; \
        _Pragma("unroll") for(int r=0;r<16;++r){C0[r]-=dl;C1[r]-=dl;} \
        _Pragma("unroll") for(int r=0;r<16;++r)negm[r]=-mhat; asm volatile("":"+v"(negm)); \
        const float f=__builtin_amdgcn_exp2f(-dl); l_reg*=f; if(hi==0)wsf[r32]=f; resc=true; } } \
    SBAR(); \
    GAPB(o[0]=__builtin_amdgcn_mfma_f32_32x32x16_bf16(PAF(0),VFR(0),o[0],0,0,0), C0,0); \
    GAPB(o[1]=__builtin_amdgcn_mfma_f32_32x32x16_bf16(PAF(0),VFR(4),o[1],0,0,0), C0,4); \
    KRD(GL,0); GAPB(o[0]=__builtin_amdgcn_mfma_f32_32x32x16_bf16(PAF(1),VFR(1),o[0],0,0,0), C0,8); \
    KRD(GL,1); GAPB(o[1]=__builtin_amdgcn_mfma_f32_32x32x16_bf16(PAF(1),VFR(5),o[1],0,0,0), C0,12); \
    KRD(GL,2); GAPB(o[0]=__builtin_amdgcn_mfma_f32_32x32x16_bf16(PAF(2),VFR(2),o[0],0,0,0), C1,0); \
    KRD(GL,3); GAPB(o[1]=__builtin_amdgcn_mfma_f32_32x32x16_bf16(PAF(2),VFR(6),o[1],0,0,0), C1,4); \
    GAPB(o[0]=__builtin_amdgcn_mfma_f32_32x32x16_bf16(PAF(3),VFR(3),o[0],0,0,0), C1,8); \
    GAPB(o[1]=__builtin_amdgcn_mfma_f32_32x32x16_bf16(PAF(3),VFR(7),o[1],0,0,0), C1,12); \
    }while(0)
  int t=1;
  #undef CMASK
  #define CMASK(P0,P1,t) do{}while(0)
  for(;t+5<NT;t+=2){
    STEP(pB0,pB1,pA0,pA1,t,true,true,true);     WAIT_BAR(2); RESC(); ROT();
    STEP(pA0,pA1,pB0,pB1,t+1,true,true,true);   WAIT_BAR(2); RESC(); ROT();
  }
  #undef CMASK
  #define CMASK(P0,P1,t) do{int jb_=(t)-(NT-4); if(jb_>=0)cmask(P0,P1,jb_,qrel,hi);}while(0)
  #define ENDW(tt) do{ if((tt)+3<NT){WAIT_BAR(2);} else if((tt)+2<NT){WAIT_BAR(1);} else {WAIT_BAR(0);} }while(0)
  for(;t+1<NT;t+=2){
    STEP(pB0,pB1,pA0,pA1,t,(t+3<NT),(t+1<NT),(t+1<NT));       ENDW(t);   RESC(); ROT();
    STEP(pA0,pA1,pB0,pB1,t+1,(t+4<NT),(t+2<NT),(t+2<NT));     ENDW(t+1); RESC(); ROT();
  }
  STEP(pB0,pB1,pA0,pA1,NT-1,false,false,false); RESC();
  { float sacc=pB0[0]+pB0[1]; _Pragma("unroll") for(int r=2;r<16;++r)sacc+=pB0[r]; _Pragma("unroll") for(int r=0;r<16;++r)sacc+=pB1[r]; l_reg+=sacc;
    pw0=(u32x4){PKW(pB0,0),PKW(pB0,2),PKW(pB0,4),PKW(pB0,6)};pw1=(u32x4){PKW(pB0,8),PKW(pB0,10),PKW(pB0,12),PKW(pB0,14)};pw2=(u32x4){PKW(pB1,0),PKW(pB1,2),PKW(pB1,4),PKW(pB1,6)};pw3=(u32x4){PKW(pB1,8),PKW(pB1,10),PKW(pB1,12),PKW(pB1,14)};
    SBAR(); pv(o,vb0+sl_cur,PAF(0),PAF(1),PAF(2),PAF(3)); }
  #undef PKW
  #undef PAF
  #undef VFR
  #undef PIN
  #undef MX3
  #undef GAPA
  #undef GAPB
  #undef EX
  #undef VRD
  #undef KRD
  #undef STEP
  #undef ENDW
  {auto rr=__builtin_amdgcn_permlane32_swap(__float_as_uint(l_reg),__float_as_uint(l_reg),false,false);l_reg=__uint_as_float(rr[0])+__uint_as_float(rr[1]);}
  if(hi==0)wsf[32+r32]=l_reg;asm volatile("s_waitcnt lgkmcnt(0)":::"memory");
  float rli[16];
  #pragma unroll
  for(int r=0;r<16;++r)rli[r]=__builtin_amdgcn_rcpf(wsf[32+crow(r,hi)]);
  bf16*Ow=O+(rowbase+q0+wid*QBLK)*DMO+ocol;
  { bf16*stg=(bf16*)(shm+LDS_OST)+wid*2048;
    #pragma unroll
    for(int r=0;r<16;++r){const int orow=crow(r,hi);
      #pragma unroll
      for(int d0=0;d0<2;++d0)stg[orow*64+d0*32+r32]=__float2bfloat16(o[d0][r]*rli[r]);}
    asm volatile("s_waitcnt lgkmcnt(0)":::"memory");
    #pragma unroll
    for(int i=0;i<4;++i){const int row=i*8+(lane>>3),ch=lane&7; const u32x4 v=*(const u32x4*)(stg+row*64+ch*8); ATTN_STORE16(Ow+(long)row*DMO+ch*8,v);} }
  asm volatile("s_waitcnt lgkmcnt(0)\n\ts_barrier":::"memory");
  #undef DMA_K
  #undef DMA_V
  #undef CMASK
  #undef START
  #undef RESC
  #undef ROT
}
constexpr int ATTN_LDS_BYTES=LDS_BYTES;
template<int THRL=8> __device__ __forceinline__ void attn_phase(char*lds,const bf16*U,bf16*Oc,int vcu){
  const int bhc=vcu>>3,s=vcu&7,b=bhc>>3,h=(bhc>>1)&3,c=bhc&1;
  _Pragma("unroll 1") for(int i=0;i<4;++i){ const int half=i>>1,qb=(i&1)?15-s:s;
    attn_unit<THRL>(b,h*128+c*64,512+h*128+c*64,1024+h*128+half*64,h*128+half*64,qb,U,U,U,Oc+(long)c*16384*DMO,lds); }
}
#undef SBAR
#undef WAIT_BAR
}

namespace gla {
constexpr int GP = 72;
constexpr int L_BC = 0, L_VT = 16384, L_QI = 34816, L_KI = 44032, L_ATT = 53248, L_OF = 62464, OFP = 132;
__device__ __forceinline__ bf16x8 frag(const LAS unsigned char* base, int row, int k0) { return *(const LAS bf16x8*)(base + (row * GP + k0) * 2); }
struct LdState { f32x4 g0, g1; unsigned vw[8]; unsigned kw[4]; };
__device__ __forceinline__ void ld_common(f32x4& g0, f32x4& g1, unsigned (&vw)[8], const float* LOGA, const bf16_t* Ugla, size_t row0, int h, int tid) {
    const float* gp = LOGA + (row0 + (tid >> 3)) * 256 + h * 64 + (tid & 7) * 8; g0 = *(const f32x4*)gp; g1 = *(const f32x4*)(gp + 4);
    const bf16_t* vp = Ugla + (row0 + (tid >> 7) * 16) * 1536 + 512 + h * 128 + (tid & 127);
#pragma unroll
    for (int j = 0; j < 8; ++j) vw[j] = (unsigned)vp[(size_t)(2 * j) * 1536] | ((unsigned)vp[(size_t)(2 * j + 1) * 1536] << 16);
}
__device__ __forceinline__ void ld_state(LdState& L, const float* LOGA, const bf16_t* Ugla, size_t row0, int h, int tid) {
    ld_common(L.g0, L.g1, L.vw, LOGA, Ugla, row0, h, tid);
    const bf16_t* kp = Ugla + (row0 + (tid >> 6) * 8) * 1536 + 256 + h * 64 + (tid & 63);
#pragma unroll
    for (int j = 0; j < 4; ++j) L.kw[j] = (unsigned)kp[(size_t)(2 * j) * 1536] | ((unsigned)kp[(size_t)(2 * j + 1) * 1536] << 16);
}
__device__ __forceinline__ void stage_common(LAS unsigned char* lds, const f32x4& g0, const f32x4& g1, const unsigned (&vw)[8], int tid) {
    LAS float* Bc = (LAS float*)(lds + L_BC);
    *(LAS f32x4*)(Bc + (tid >> 3) * 64 + (tid & 7) * 8) = g0; *(LAS f32x4*)(Bc + (tid >> 3) * 64 + (tid & 7) * 8 + 4) = g1;
    LAS u32x4* dst = (LAS u32x4*)(lds + L_VT + ((tid & 127) * GP + (tid >> 7) * 16) * 2);
    dst[0] = (u32x4){vw[0], vw[1], vw[2], vw[3]}; dst[1] = (u32x4){vw[4], vw[5], vw[6], vw[7]};
}
__device__ __forceinline__ void cumsum_inplace(LAS unsigned char* lds, int lane, int wave) {
    LAS float* Bc = (LAS float*)(lds + L_BC);
    if (wave == 0) { float acc = 0.f;
#pragma unroll 16
        for (int s = 0; s < 64; ++s) { acc += Bc[s * 64 + lane]; Bc[s * 64 + lane] = acc; } }
}
__device__ __forceinline__ void chunk_state4(LAS unsigned char* lds, int b, int n, const float* LOGA, const bf16_t* Ugla, float* SCt, float* DEC, int tid, int lane, int wave) {
    const size_t row0 = (size_t)b * SEQ + n * 64;
    LAS float* Bc = (LAS float*)(lds + L_BC);
    LdState cur; ld_state(cur, LOGA, Ugla, row0, 0, tid);
#pragma unroll 1
    for (int h = 0; h < 4; ++h) {
        const int q = ((b * 4 + h) << 6) + n;
        stage_common(lds, cur.g0, cur.g1, cur.vw, tid);
        __syncthreads();
        cumsum_inplace(lds, lane, wave);
        __syncthreads();
        { const int k = tid & 63, sg = tid >> 6; const float bl = Bc[63 * 64 + k]; float f[8];
#pragma unroll
            for (int j = 0; j < 4; ++j) { f[2 * j] = lo_bf(cur.kw[j]) * __expf(bl - Bc[(sg * 8 + 2 * j) * 64 + k]); f[2 * j + 1] = hi_bf(cur.kw[j]) * __expf(bl - Bc[(sg * 8 + 2 * j + 1) * 64 + k]); }
            *(LAS u32x4*)(lds + L_QI + (k * GP + sg * 8) * 2) = (u32x4){pk2(f[0], f[1]), pk2(f[2], f[3]), pk2(f[4], f[5]), pk2(f[6], f[7])};
            if (tid < 64) DEC[(size_t)q * 64 + tid] = __expf(bl); }
        LdState nxt = cur; if (h < 3) ld_state(nxt, LOGA, Ugla, row0, h + 1, tid);
        __syncthreads();
        { const int fr = lane & 15, fq = lane >> 4, mt = wave >> 1;
#pragma unroll
            for (int j = 0; j < 4; ++j) { const int nt = (wave & 1) * 4 + j; f32x4 acc = {0.f, 0.f, 0.f, 0.f};
#pragma unroll
                for (int ks = 0; ks < 2; ++ks) acc = __builtin_amdgcn_mfma_f32_16x16x32_bf16(frag(lds + L_QI, 16 * mt + fr, 32 * ks + 8 * fq), frag(lds + L_VT, 16 * nt + fr, 32 * ks + 8 * fq), acc, 0, 0, 0);
                *(f32x4*)(SCt + (size_t)q * 8192 + (16 * nt + fr) * 64 + 16 * mt + 4 * fq) = acc; } }
        __syncthreads();
        cur = nxt;
    }
}
struct LdOut { f32x4 g0, g1; unsigned vw[8]; u32x4 qw, kw, r0, r1; bf16x8 sp[4][2]; };
__device__ __forceinline__ void ld_out(LdOut& L, const float* LOGA, const bf16_t* Ugla, const bf16_t* SPt, size_t row0, int h, int q, int tid, int lane, int wave) {
    ld_common(L.g0, L.g1, L.vw, LOGA, Ugla, row0, h, tid);
    const bf16_t* rp = Ugla + (row0 + (tid >> 3)) * 1536 + h * 64 + (tid & 7) * 8; L.qw = *(const u32x4*)rp; L.kw = *(const u32x4*)(rp + 256);
    const bf16_t* gp = Ugla + (row0 + (tid >> 3)) * 1536 + 1024 + h * 128 + (tid & 7) * 16; L.r0 = *(const u32x4*)gp; L.r1 = *(const u32x4*)(gp + 8);
    const int fr = lane & 15, fq = lane >> 4;
#pragma unroll
    for (int j = 0; j < 4; ++j)
#pragma unroll
        for (int ks = 0; ks < 2; ++ks) L.sp[j][ks] = *(const bf16x8*)(SPt + (size_t)q * 8192 + (16 * ((wave & 1) * 4 + j) + fr) * 64 + 32 * ks + 8 * fq);
}
__device__ __forceinline__ void chunk_out4(LAS unsigned char* lds, int b, int n, const float* LOGA, const bf16_t* Ugla, const bf16_t* SPt, const float* gog, bf16_t* OA, int tid, int lane, int wave) {
    const size_t row0 = (size_t)b * SEQ + n * 64;
    LAS float* Bc = (LAS float*)(lds + L_BC); LAS float* Of = (LAS float*)(lds + L_OF);
    const int fr = lane & 15, fq = lane >> 4;
    LdOut cur; ld_out(cur, LOGA, Ugla, SPt, row0, 0, ((b * 4) << 6) + n, tid, lane, wave);
#pragma unroll 1
    for (int h = 0; h < 4; ++h) {
        stage_common(lds, cur.g0, cur.g1, cur.vw, tid);
        __syncthreads();
        cumsum_inplace(lds, lane, wave);
        __syncthreads();
        { const int s = tid >> 3, k0 = (tid & 7) * 8; float qf[8], kf[8];
            qf[0] = lo_bf(cur.qw.x); qf[1] = hi_bf(cur.qw.x); qf[2] = lo_bf(cur.qw.y); qf[3] = hi_bf(cur.qw.y); qf[4] = lo_bf(cur.qw.z); qf[5] = hi_bf(cur.qw.z); qf[6] = lo_bf(cur.qw.w); qf[7] = hi_bf(cur.qw.w);
            kf[0] = lo_bf(cur.kw.x); kf[1] = hi_bf(cur.kw.x); kf[2] = lo_bf(cur.kw.y); kf[3] = hi_bf(cur.kw.y); kf[4] = lo_bf(cur.kw.z); kf[5] = hi_bf(cur.kw.z); kf[6] = lo_bf(cur.kw.w); kf[7] = hi_bf(cur.kw.w);
#pragma unroll
            for (int e = 0; e < 8; ++e) { const float bv = Bc[s * 64 + k0 + e]; qf[e] *= 0.125f * __expf(bv); kf[e] *= __expf(-bv); }
            *(LAS u32x4*)(lds + L_QI + (s * GP + k0) * 2) = (u32x4){pk2(qf[0], qf[1]), pk2(qf[2], qf[3]), pk2(qf[4], qf[5]), pk2(qf[6], qf[7])};
            *(LAS u32x4*)(lds + L_KI + (s * GP + k0) * 2) = (u32x4){pk2(kf[0], kf[1]), pk2(kf[2], kf[3]), pk2(kf[4], kf[5]), pk2(kf[6], kf[7])}; }
        __syncthreads();
#pragma unroll
        for (int j = 0; j < 2; ++j) { const int t = 2 * wave + j, mt = t >> 2, nt = t & 3; f32x4 acc = {0.f, 0.f, 0.f, 0.f};
#pragma unroll
            for (int ks = 0; ks < 2; ++ks) acc = __builtin_amdgcn_mfma_f32_16x16x32_bf16(frag(lds + L_QI, 16 * mt + fr, 32 * ks + 8 * fq), frag(lds + L_KI, 16 * nt + fr, 32 * ks + 8 * fq), acc, 0, 0, 0);
            LAS bf16_t* ap = (LAS bf16_t*)(lds + L_ATT); const int sc = 16 * nt + fr;
#pragma unroll
            for (int r = 0; r < 4; ++r) { const int c = 16 * mt + 4 * fq + r; ap[c * GP + sc] = (bf16_t)f2bf(sc <= c ? acc[r] : 0.f); } }
        __syncthreads();
        { const int mt = wave >> 1;
#pragma unroll
            for (int j = 0; j < 4; ++j) { const int nt = (wave & 1) * 4 + j; f32x4 acc = {0.f, 0.f, 0.f, 0.f};
#pragma unroll
                for (int ks = 0; ks < 2; ++ks) { acc = __builtin_amdgcn_mfma_f32_16x16x32_bf16(frag(lds + L_ATT, 16 * mt + fr, 32 * ks + 8 * fq), frag(lds + L_VT, 16 * nt + fr, 32 * ks + 8 * fq), acc, 0, 0, 0);
                    acc = __builtin_amdgcn_mfma_f32_16x16x32_bf16(frag(lds + L_QI, 16 * mt + fr, 32 * ks + 8 * fq), cur.sp[j][ks], acc, 0, 0, 0); }
#pragma unroll
                for (int r = 0; r < 4; ++r) Of[(16 * mt + 4 * fq + r) * OFP + 16 * nt + fr] = acc[r]; } }
        const u32x4 r0 = cur.r0, r1 = cur.r1;
        if (h < 3) ld_out(cur, LOGA, Ugla, SPt, row0, h + 1, ((b * 4 + h + 1) << 6) + n, tid, lane, wave);
        __syncthreads();
        { const int c = tid >> 3, v0 = (tid & 7) * 16; float o[16]; float ss = 0.f;
#pragma unroll
            for (int e = 0; e < 16; e += 4) { const f32x4 t4 = *(const LAS f32x4*)(Of + c * OFP + v0 + e); o[e] = t4.x; o[e + 1] = t4.y; o[e + 2] = t4.z; o[e + 3] = t4.w; ss += (t4.x * t4.x + t4.y * t4.y) + (t4.z * t4.z + t4.w * t4.w); }
            ss += __shfl_xor(ss, 1); ss += __shfl_xor(ss, 2); ss += __shfl_xor(ss, 4);
            const float rstd = rsqrtf(ss * (1.f / 128.f) + 1e-6f);
            const unsigned rw[8] = {r0.x, r0.y, r0.z, r0.w, r1.x, r1.y, r1.z, r1.w}; unsigned ow[8];
#pragma unroll
            for (int e = 0; e < 8; ++e) { const float a = o[2 * e] * rstd * gog[v0 + 2 * e] * siluf_(lo_bf(rw[e])), b2 = o[2 * e + 1] * rstd * gog[v0 + 2 * e + 1] * siluf_(hi_bf(rw[e])); ow[e] = pk2(a, b2); }
            bf16_t* op = OA + (row0 + c) * 512 + h * 128 + v0; *(u32x4*)op = (u32x4){ow[0], ow[1], ow[2], ow[3]}; *(u32x4*)(op + 8) = (u32x4){ow[4], ow[5], ow[6], ow[7]}; }
    }
}
}

#define XB_TMO      128
#define XB_XCNT(j)  (256  + 64 * (j))
#define XB_XSUB(j)  (1280 + 64 * (j))
#define XB_XGEN(j)  (2304 + 64 * (j))
#define XB_TOP      3328
#define XB_TOPGEN   3392
#define XCD_BAR_WORDS 3456
#define XB_SPIN_CAP (1u << 18)
__device__ __forceinline__ unsigned xb_ld(unsigned* p)              { return __hip_atomic_load(p, __ATOMIC_RELAXED, __HIP_MEMORY_SCOPE_AGENT); }
__device__ __forceinline__ unsigned xb_add(unsigned* p, unsigned v) { return __hip_atomic_fetch_add(p, v, __ATOMIC_RELAXED, __HIP_MEMORY_SCOPE_AGENT); }
__device__ __forceinline__ unsigned xb_xcc_id() { return (unsigned)__builtin_amdgcn_s_getreg((3 << 11) | 20) & 0xFu; }
#define XB_SPIN(cond, bar) do { unsigned _sp = 0; while (cond) { __builtin_amdgcn_s_sleep(1); \
    if ((++_sp & 255u) == 0u) { if (xb_ld(&(bar)[XB_TMO])) break; if (_sp > XB_SPIN_CAP) { atomicAdd(&(bar)[XB_TMO], 1u); break; } } } } while (0)
struct XcdBarrier { unsigned* bar; unsigned x; volatile LAS unsigned* st; };
__device__ __forceinline__ XcdBarrier xcd_barrier_post(unsigned* bar, volatile LAS unsigned* st) {
    XcdBarrier b; b.bar = bar; b.x = xb_xcc_id(); b.st = st;
    if (threadIdx.x == 0) (void)xb_add(&bar[XB_XCNT(b.x)], 1u);
    return b;
}
__device__ __forceinline__ void xcd_barrier_complete(unsigned* bar, unsigned x, unsigned& nloc, unsigned& nx) {
    const unsigned G = gridDim.x * gridDim.y * gridDim.z;
    unsigned sum, cnt, mine, sp = 0u;
    for (;;) {
        sum = 0u; cnt = 0u; mine = 0u;
#pragma unroll
        for (unsigned j = 0; j < 16; ++j) { const unsigned c = xb_ld(&bar[XB_XCNT(j)]); sum += c; cnt += (c > 0u) ? 1u : 0u; mine = (j == x) ? c : mine; }
        if (sum == G) break;
        __builtin_amdgcn_s_sleep(1);
        if ((++sp & 255u) == 0u) { if (xb_ld(&bar[XB_TMO])) break; if (sp > XB_SPIN_CAP) { atomicAdd(&bar[XB_TMO], 1u); break; } }
    }
    nloc = mine > 0u ? mine : 1u; nx = cnt > 0u ? cnt : 1u;
}
__device__ __forceinline__ void xcd_barrier(const XcdBarrier& b) {
    asm volatile("s_waitcnt vmcnt(0)" ::: "memory");
    __syncthreads();
    if (threadIdx.x == 0) {
        unsigned* bar = b.bar;
        __builtin_amdgcn_s_waitcnt(0);
        unsigned nloc = b.st[0], nx = b.st[1];
        if (nloc == 0u) { xcd_barrier_complete(bar, b.x, nloc, nx); b.st[0] = nloc; b.st[1] = nx; }
        const unsigned old = xb_add(&bar[XB_XSUB(b.x)], 1u);
        const unsigned gen = old / nloc;
        if (old + 1u == (gen + 1u) * nloc) {
            __builtin_amdgcn_fence(__ATOMIC_RELEASE, "agent");
            asm volatile("s_waitcnt vmcnt(0)" ::: "memory");
            const unsigned og = xb_add(&bar[XB_TOP], 1u);
            const unsigned tg = og / nx;
            if (og + 1u == (tg + 1u) * nx) xb_add(&bar[XB_TOPGEN], 1u);
            else XB_SPIN(xb_ld(&bar[XB_TOPGEN]) == tg, bar);
            __builtin_amdgcn_fence(__ATOMIC_ACQUIRE, "agent");
            xb_add(&bar[XB_XGEN(b.x)], 1u);
            asm volatile("s_waitcnt vmcnt(0)" ::: "memory");
        } else {
            XB_SPIN(xb_ld(&bar[XB_XGEN(b.x)]) == gen, bar);
            __builtin_amdgcn_fence(__ATOMIC_ACQUIRE, "agent");
            asm volatile("s_waitcnt vmcnt(0)" ::: "memory");
        }
    }
    __syncthreads();
}

struct Args { const void* in[28]; float* out; unsigned char* ws; int ph_lo, ph_hi; };
enum { I_X = 0, I_C, I_POS, I_ADAW, I_ADAB, I_N1G, I_N2G, I_WIN, I_AUP, I_AB, I_GOG, I_DQG, I_DKG, I_LQ1, I_LK1, I_LQ2, I_LK2, I_DOG, I_WBA, I_WBB, I_WOUT, I_RGW, I_RGB, I_REW, I_REB, I_EW1, I_EW3, I_EW2 };

struct TrJob { const float* src; bf16_t* dst; int ldn, kdst; };
__device__ __forceinline__ void tr_load(f32x4 (&v)[8], const TrJob& J, int lane) {
#pragma unroll
    for (int i = 0; i < 8; ++i) v[i] = *(const f32x4*)(J.src + (size_t)(8 * i + (lane >> 3)) * J.ldn + (lane & 7) * 4);
}
__device__ __forceinline__ void tr_store(const f32x4 (&v)[8], const TrJob& J, LAS float* scr, int lane) {
#pragma unroll
    for (int i = 0; i < 8; ++i) { LAS float* p = scr + (8 * i + (lane >> 3)) * 33 + (lane & 7) * 4; p[0] = v[i].x; p[1] = v[i].y; p[2] = v[i].z; p[3] = v[i].w; }
    LDS_WAIT(); asm volatile("" ::: "memory");
    const int c = lane & 7;
#pragma unroll
    for (int j = 0; j < 4; ++j) { const int n = (lane >> 3) + 8 * j; const LAS float* sp = scr + (8 * c) * 33 + n;
        u32x4 o; o.x = pk2(sp[0 * 33], sp[1 * 33]); o.y = pk2(sp[2 * 33], sp[3 * 33]); o.z = pk2(sp[4 * 33], sp[5 * 33]); o.w = pk2(sp[6 * 33], sp[7 * 33]);
        *(u32x4*)(J.dst + (size_t)n * J.kdst + 8 * c) = o; }
    LDS_WAIT(); asm volatile("" ::: "memory");
}
template <class Dec> __device__ __forceinline__ void tr_run(int first, int total, int stride, const Dec& dec, LAS float* scr, int lane) {
    int it = first; if (it >= total) return;
    TrJob J = dec(it); f32x4 a[8]; tr_load(a, J, lane);
    for (;;) {
        const int nx = it + stride; const bool more = nx < total; TrJob Jn = J; f32x4 b[8];
        if (more) { Jn = dec(nx); tr_load(b, Jn, lane); }
        tr_store(a, J, scr, lane);
        if (!more) break;
#pragma unroll
        for (int i = 0; i < 8; ++i) a[i] = b[i];
        J = Jn; it = nx;
    }
}
struct DecDense { const float *w_in, *wa, *wb, *wo; bf16_t *Win_t, *Wa_t, *Wb_t, *Wout_t;
    __device__ __forceinline__ TrJob operator()(int r) const {
        if (r < 2560) { const int kb = r / 160, nb = r % 160, n0 = 32 * nb, ns = n0 < 1536 ? n0 : n0 + 16; return TrJob{w_in + (size_t)(64 * kb) * DIN + ns, Win_t + (size_t)n0 * D + 64 * kb, DIN, D}; }
        r -= 2560;
        if (r < 256) { const int kb = r / 32, nb = r % 32; return TrJob{wa + (size_t)(64 * kb) * D + 32 * nb, Wa_t + (size_t)(32 * nb) * 512 + 64 * kb, D, 512}; }
        r -= 256;
        if (r < 256) { const int kb = r / 32, nb = r % 32; return TrJob{wb + (size_t)(64 * kb) * D + 32 * nb, Wb_t + (size_t)(32 * nb) * 512 + 64 * kb, D, 512}; }
        r -= 256;
        { const int kb = r / 32, nb = r % 32; return TrJob{wo + (size_t)(64 * kb) * D + 32 * nb, Wout_t + (size_t)(32 * nb) * D + 64 * kb, D, D}; }
    } };
struct DecExp { const float *w1, *w3, *w2; bf16_t *W13_t, *W2_t;
    __device__ __forceinline__ TrJob operator()(int it) const {
        const int e = it / 768, r = it % 768;
        if (r < 512) { const int kb = r >> 5, nb = r & 31, r0 = 32 * nb, pn = r0 >> 8, half = (r0 >> 7) & 1, jj = r0 & 127;
            const float* p1 = w1; const float* p3 = w3; asm volatile("" : "+s"(p1), "+s"(p3));
            return TrJob{(half ? p3 : p1) + (size_t)e * D * DEXP + (size_t)(64 * kb) * DEXP + 128 * pn + jj, W13_t + (size_t)e * 1024 * 1024 + (size_t)r0 * D + 64 * kb, DEXP, D}; }
        const int r2 = r - 512, kb = r2 >> 5, nb = r2 & 31;
        return TrJob{w2 + (size_t)e * DEXP * D + (size_t)(64 * kb) * D + 32 * nb, W2_t + (size_t)e * 1024 * 512 + (size_t)(32 * nb) * DEXP + 64 * kb, D, DEXP};
    } };

#define PHASE_LOCALS int tid_l = threadIdx.x; asm volatile("" : "+v"(tid_l)); int cb_l = blockIdx.x; asm volatile("" : "+s"(cb_l)); \
    const int tid = tid_l, lane = tid & 63, wave = __builtin_amdgcn_readfirstlane(tid >> 6), cb = cb_l, G = 256, gw = cb * NWAVES + wave, NGW = G * NWAVES; (void)lane; (void)gw; (void)NGW; (void)G;
template <int IDX> __device__ __forceinline__ const void* ldarg() {
    unsigned long long p;
    asm volatile("s_load_dwordx2 %0, %1, %2\n\ts_waitcnt lgkmcnt(0)" : "=s"(p) : "s"(__builtin_amdgcn_kernarg_segment_ptr()), "n"(IDX * 8) : "memory");
    return (const void*)p;
}
#define ARG_IN(i) (ldarg<(i)>())
#define ARG_WS ((unsigned char*)ldarg<29>())
#define XIN ((const float*)ARG_IN(I_X))
#define OUTP ((float*)ldarg<28>())
#define P_MODP ((float*)(ARG_WS + WS_MODP))
#define P_MODF ((float*)(ARG_WS + WS_MODF))
#define P_ALR ((float*)(ARG_WS + WS_ALR))
#define P_WIN ((bf16_t*)(ARG_WS + WS_WIN))
#define P_WA ((bf16_t*)(ARG_WS + WS_WA))
#define P_WB ((bf16_t*)(ARG_WS + WS_WB))
#define P_WOUT ((bf16_t*)(ARG_WS + WS_WOUT))
#define P_XN ((bf16_t*)(ARG_WS + WS_XN))
#define P_LOGA ((float*)(ARG_WS + WS_LOGA))
#define P_SCT ((float*)(ARG_WS + WS_SCT))
#define P_SPT ((bf16_t*)(ARG_WS + WS_SPT))
#define P_OC ((bf16_t*)(ARG_WS + WS_OC))
#define P_DEC ((float*)(ARG_WS + WS_DEC))
#define P_WRT ((float*)(ARG_WS + WS_WRT))
#define P_LRT ((float*)(ARG_WS + WS_LRT))
#define P_OB ((bf16_t*)(ARG_WS + WS_OB))
#define P_OA ((bf16_t*)(ARG_WS + WS_OA))
#define P_XS ((bf16_t*)(ARG_WS + WS_XS))
#define P_Y ((bf16_t*)(ARG_WS + WS_Y))
#define P_UGLA ((bf16_t*)(ARG_WS + WS_UGLA))
#define P_UDIFF ((bf16_t*)(ARG_WS + WS_UDIFF))
#define P_UGATE ((bf16_t*)(ARG_WS + WS_UGATE))
#define P_M1 ((bf16_t*)(ARG_WS + WS_M1))
#define P_MERGED ((bf16_t*)(ARG_WS + WS_MERGED))
#define P_H2 ((bf16_t*)(ARG_WS + WS_H2))
#define P_W13 ((bf16_t*)(ARG_WS + WS_W13))
#define P_W2 ((bf16_t*)(ARG_WS + WS_W2))
#define P_HMID ((bf16_t*)(ARG_WS + WS_HMID))
#define P_TOKE ((int*)(ARG_WS + WS_ROUTE + RT_TOKE))
#define P_TOKW ((float*)(ARG_WS + WS_ROUTE + RT_TOKW))
#define P_RANK ((int*)(ARG_WS + WS_ROUTE + RT_RANK))
#define P_SLOT ((int*)(ARG_WS + WS_ROUTE + RT_SLOT))
#define P_BLKCNT ((int*)(ARG_WS + WS_ROUTE + RT_BLKCNT))
#define P_TILEE ((int*)(ARG_WS + WS_ROUTE + RT_TILEE))
#define P_NT ((int*)(ARG_WS + WS_ROUTE + RT_NT))
template <int LO, int HI>
__global__ void __launch_bounds__(NTHR, 2) mk_fwd(Args args) {
    extern __shared__ __attribute__((aligned(16))) unsigned char lds_raw[];
    LAS unsigned char* lds = (LAS unsigned char*)lds_raw;
    volatile LAS unsigned* MISC = (volatile LAS unsigned*)(lds + MISC_OFF);
    unsigned* ctl = (unsigned*)(ARG_WS + WS_CTL);
    for (int u = threadIdx.x; u < (LDS_BYTES - LDSCTL_OFF) / 4; u += NTHR) ((LAS unsigned*)(lds + LDSCTL_OFF))[u] = 0u;
    __syncthreads();
    constexpr int lo = LO, hi = HI;
    XcdBarrier bar; bar.bar = ctl + CW_BAR; bar.x = 0; bar.st = nullptr;
    if constexpr (hi - lo > 1) bar = xcd_barrier_post(ctl + CW_BAR, MISC + 8);
#define IN(k) (lo <= (k) && (k) < hi)
#define SEAM(k) do { if constexpr (IN(k) && IN((k) + 1)) xcd_barrier(bar); } while (0)

    if constexpr (IN(0)) {
        asm volatile("; PHASE_BEGIN 0" ::: "memory");
        PHASE_LOCALS
        float* modp = P_MODP; bf16_t* Win_t = P_WIN; bf16_t* Wa_t = P_WA; bf16_t* Wb_t = P_WB; bf16_t* Wout_t = P_WOUT;
        const float* cvec = (const float*)ARG_IN(I_C); const float* ada_w = (const float*)ARG_IN(I_ADAW);
        const float* w_in = (const float*)ARG_IN(I_WIN);
        LAS float* scr = (LAS float*)(lds + wave * 16384);
        for (int r = gw; r < 768; r += NGW) {
            const int jc = r % 24, kc = r / 24, j = jc * 256 + lane * 4;
            f32x4 a0 = {0, 0, 0, 0}, a1 = a0, a2 = a0, a3 = a0;
#pragma unroll 8
            for (int kk = 0; kk < 32; ++kk) { const int k = kc * 32 + kk; const f32x4 w = *(const f32x4*)(ada_w + (size_t)k * NMOD + j);
                a0 += siluf_(cvec[k]) * w; a1 += siluf_(cvec[D + k]) * w; a2 += siluf_(cvec[2 * D + k]) * w; a3 += siluf_(cvec[3 * D + k]) * w; }
            *(f32x4*)(modp + (size_t)(kc * 4 + 0) * NMOD + j) = a0; *(f32x4*)(modp + (size_t)(kc * 4 + 1) * NMOD + j) = a1;
            *(f32x4*)(modp + (size_t)(kc * 4 + 2) * NMOD + j) = a2; *(f32x4*)(modp + (size_t)(kc * 4 + 3) * NMOD + j) = a3; }
        { const float* Wrg = (const float*)ARG_IN(I_RGW); const float* Wre = (const float*)ARG_IN(I_REW); float* WrT = P_WRT;
          for (int idx = cb * NTHR + tid; idx < 36 * D; idx += G * NTHR) { const int j = idx >> 10, k = idx & 1023; WrT[idx] = j < 4 ? Wrg[k * 4 + j] : Wre[k * 32 + (j - 4)]; } }
        { float* LrT = P_LRT;
          for (int idx = cb * NTHR + tid; idx < 16 * D; idx += G * NTHR) { const int r = idx >> 10, k = idx & 1023; LrT[idx] = w_in[(size_t)k * DIN + 1536 + r]; } }
        { const DecDense dec{w_in, (const float*)ARG_IN(I_WBA), (const float*)ARG_IN(I_WBB), (const float*)ARG_IN(I_WOUT), Win_t, Wa_t, Wb_t, Wout_t};
          tr_run(gw, 2560 + 256 + 256 + 512, NGW, dec, scr, lane); }
    }
    SEAM(0);

    if constexpr (IN(1)) {
        asm volatile("; PHASE_BEGIN 1" ::: "memory");
        PHASE_LOCALS
        const float* x = XIN; float* modp = P_MODP; float* modf = P_MODF; float* alr = P_ALR; bf16_t* XN = P_XN;
        const float* ada_b = (const float*)ARG_IN(I_ADAB); const float* g1 = (const float*)ARG_IN(I_N1G);
        LAS float* modS = (LAS float*)lds;
        const float* LrT = P_LRT;
        const int b = cb >> 6;
        f32x4 hv[8][4];
        const size_t m0 = (size_t)cb * 64 + wave * 8;
#pragma unroll
        for (int i = 0; i < 8; ++i) { const f32x4* xr = (const f32x4*)(x + (m0 + i) * D) + lane;
#pragma unroll
            for (int j = 0; j < 4; ++j) hv[i][j] = xr[64 * j]; }
        { const int j = tid * 4; f32x4 s = *(const f32x4*)(ada_b + j);
#pragma unroll 8
            for (int kc = 0; kc < 32; ++kc) s += *(const f32x4*)(modp + (size_t)(kc * 4 + b) * NMOD + j);
            if (j >= D) s += 1.0f;
            *(LAS f32x4*)(modS + j) = s; }
        if (tid < 96) { const int idx = cb * 96 + tid, bb = idx / NMOD, j = idx % NMOD; float s = ada_b[j];
#pragma unroll 8
            for (int kc = 0; kc < 32; ++kc) s += modp[(size_t)(kc * 4 + bb) * NMOD + j];
            modf[idx] = s; }
        __syncthreads();
#pragma unroll
        for (int i = 0; i < 8; ++i) { float ss = 0.f;
#pragma unroll
            for (int j = 0; j < 4; ++j) ss += (hv[i][j].x * hv[i][j].x + hv[i][j].y * hv[i][j].y) + (hv[i][j].z * hv[i][j].z + hv[i][j].w * hv[i][j].w);
            const float rstd = rsqrtf(wave_sum(ss) * (1.f / D) + 1e-6f);
            unsigned long long* o8 = (unsigned long long*)(XN + (m0 + i) * D) + lane;
#pragma unroll
            for (int j = 0; j < 4; ++j) { const int k = 4 * lane + 256 * j; const f32x4 gg = *(const f32x4*)(g1 + k); const f32x4 sh = *(const LAS f32x4*)(modS + k); const f32x4 sc = *(const LAS f32x4*)(modS + D + k);
                hv[i][j] = hv[i][j] * rstd * gg * sc + sh;
                o8[64 * j] = (unsigned long long)pk2(hv[i][j].x, hv[i][j].y) | ((unsigned long long)pk2(hv[i][j].z, hv[i][j].w) << 32); } }
        { float res[8];
#pragma unroll
          for (int i = 0; i < 8; ++i) res[i] = 0.f;
          f32x4 wn[4];
#pragma unroll
          for (int jj = 0; jj < 4; ++jj) wn[jj] = *(const f32x4*)(LrT + 4 * lane + 256 * jj);
#pragma unroll 1
          for (int r = 0; r < 16; ++r) {
            f32x4 w[4];
#pragma unroll
            for (int jj = 0; jj < 4; ++jj) w[jj] = wn[jj];
            const int rn = r < 15 ? r + 1 : r;
#pragma unroll
            for (int jj = 0; jj < 4; ++jj) wn[jj] = *(const f32x4*)(LrT + (size_t)rn * D + 4 * lane + 256 * jj);
#pragma unroll
            for (int i = 0; i < 8; ++i) { float a = 0.f;
#pragma unroll
                for (int jj = 0; jj < 4; ++jj) a += (hv[i][jj].x * w[jj].x + hv[i][jj].y * w[jj].y) + (hv[i][jj].z * w[jj].z + hv[i][jj].w * w[jj].w);
                a = wave_sum(a); if (lane == r) res[i] = a; }
          }
#pragma unroll
          for (int i = 0; i < 8; ++i) if (lane < 16) alr[(m0 + i) * 16 + lane] = res[i]; }
    }
    SEAM(1);

    if constexpr (IN(2)) {
        asm volatile("; PHASE_BEGIN 2" ::: "memory");
        PHASE_LOCALS
        bf16_t* XN = P_XN; bf16_t* Win_t = P_WIN; bf16_t* Ugla = P_UGLA; bf16_t* Udiff = P_UDIFF; bf16_t* Ugate = P_UGATE;
        pg8::DenseOrder S; S.init(XN, Win_t, M, NPROJ, D, G, cb);
        pg8::EpiInProj E{Ugla, Udiff, Ugate};
        pg8::gemm_phase<pg8::EpiInProj, pg8::DenseOrder, true, true>(lds, D, S, E);
    }
    SEAM(2);

    if constexpr (IN(3)) {
        asm volatile("; PHASE_BEGIN 3" ::: "memory");
        PHASE_LOCALS
        bf16_t* Udiff = P_UDIFF; float* alr = P_ALR; float* LOGA = P_LOGA;
        const int* pos = (const int*)ARG_IN(I_POS); const float* qg = (const float*)ARG_IN(I_DQG); const float* kg = (const float*)ARG_IN(I_DKG);
        const float* aup = (const float*)ARG_IN(I_AUP); const float* ab = (const float*)ARG_IN(I_AB);
        const float invf = powf(500000.0f, -(float)(lane & 7) * 0.125f);
        const size_t m0 = (size_t)cb * 64 + wave * 8;
        u32x4 w0[8], w1[8]; float posv[8], av[8];
#pragma unroll
        for (int i = 0; i < 8; ++i) { const bf16_t* rowp = Udiff + (m0 + i) * 1536 + lane * 16; w0[i] = *(const u32x4*)rowp; w1[i] = *(const u32x4*)(rowp + 8);
            posv[i] = (float)pos[m0 + i]; av[i] = alr[(m0 + i) * 16 + (lane & 15)]; }
        float gain[16];
#pragma unroll
        for (int e = 0; e < 16; ++e) gain[e] = (lane < 32 ? qg : kg)[(lane & 3) * 16 + e];
        float au[16][4], abv[4];
#pragma unroll
        for (int q = 0; q < 4; ++q) { abv[q] = ab[lane + 64 * q];
#pragma unroll
            for (int rr = 0; rr < 16; ++rr) au[rr][q] = aup[rr * 256 + lane + 64 * q]; }
#pragma unroll
        for (int i = 0; i < 8; ++i) {
            float y[16];
            y[0] = lo_bf(w0[i].x); y[1] = hi_bf(w0[i].x); y[2] = lo_bf(w0[i].y); y[3] = hi_bf(w0[i].y); y[4] = lo_bf(w0[i].z); y[5] = hi_bf(w0[i].z); y[6] = lo_bf(w0[i].w); y[7] = hi_bf(w0[i].w);
            y[8] = lo_bf(w1[i].x); y[9] = hi_bf(w1[i].x); y[10] = lo_bf(w1[i].y); y[11] = hi_bf(w1[i].y); y[12] = lo_bf(w1[i].z); y[13] = hi_bf(w1[i].z); y[14] = lo_bf(w1[i].w); y[15] = hi_bf(w1[i].w);
            float ss = 0.f;
#pragma unroll
            for (int e = 0; e < 16; ++e) ss += y[e] * y[e];
            ss += __shfl_xor(ss, 1); ss += __shfl_xor(ss, 2);
            const float rstd = rsqrtf(ss * (1.f / 64.f) + 1e-6f);
#pragma unroll
            for (int e = 0; e < 16; ++e) y[e] = y[e] * rstd * gain[e];
            const float ang = posv[i] * invf; float sv, cv; sincosf(ang, &sv, &cv);
            float r[16];
#pragma unroll
            for (int e = 0; e < 8; ++e) { const float c_ = __shfl(cv, e), s_ = __shfl(sv, e); r[e] = y[e] * c_ - y[e + 8] * s_; r[e + 8] = y[e + 8] * c_ + y[e] * s_; }
            if ((lane & 3) == 0) {
#pragma unroll
                for (int e = 0; e < 16; ++e) y[e] = r[e]; }
            if (lane < 32) {
#pragma unroll
                for (int e = 0; e < 16; ++e) y[e] *= attn_body::C2; }
            u32x4 o0, o1; o0.x = pk2(y[0], y[1]); o0.y = pk2(y[2], y[3]); o0.z = pk2(y[4], y[5]); o0.w = pk2(y[6], y[7]); o1.x = pk2(y[8], y[9]); o1.y = pk2(y[10], y[11]); o1.z = pk2(y[12], y[13]); o1.w = pk2(y[14], y[15]);
            bf16_t* rowp = Udiff + (m0 + i) * 1536 + lane * 16;
            *(u32x4*)rowp = o0; *(u32x4*)(rowp + 8) = o1;
            float xv[4];
#pragma unroll
            for (int q = 0; q < 4; ++q) xv[q] = abv[q];
#pragma unroll
            for (int rr = 0; rr < 16; ++rr) { const float a = __shfl(av[i], rr);
#pragma unroll
                for (int q = 0; q < 4; ++q) xv[q] += a * au[rr][q]; }
#pragma unroll
            for (int q = 0; q < 4; ++q) { const float ls = fminf(xv[q], 0.f) - log1pf(__expf(-fabsf(xv[q]))); LOGA[(m0 + i) * 256 + lane + 64 * q] = ls * (1.f / 16.f); }
        }
        VM_WAIT(); __syncthreads();
        gla::chunk_state4(lds, cb >> 6, cb & 63, LOGA, P_UGLA, P_SCT, P_DEC, tid, lane, wave);
    }
    SEAM(3);

    if constexpr (IN(4)) {
        asm volatile("; PHASE_BEGIN 4" ::: "memory");
        PHASE_LOCALS
        { const float* SCt = P_SCT; const float* DEC = P_DEC; bf16_t* SPt = P_SPT;
          const int idx = cb * NTHR + tid, bh = idx >> 13, e = idx & 8191, k = e & 63; float st = 0.f;
#pragma unroll 8
          for (int n = 0; n < 64; ++n) { const size_t q = (size_t)bh * 64 + n; const float sc = SCt[q * 8192 + e], d = DEC[q * 64 + k]; SPt[q * 8192 + e] = (bf16_t)f2bf(st); st = st * d + sc; } }
        { const int vcu = (cb % 8) * (G / 8) + cb / 8;
          attn_body::attn_phase<8>((char*)lds_raw, (const attn_body::bf16*)P_UDIFF, (attn_body::bf16*)P_OC, vcu); }
    }
    SEAM(4);

    if constexpr (IN(5)) {
        asm volatile("; PHASE_BEGIN 5" ::: "memory");
        PHASE_LOCALS
        { const float* lq1 = (const float*)ARG_IN(I_LQ1); const float* lk1 = (const float*)ARG_IN(I_LK1); const float* lq2 = (const float*)ARG_IN(I_LQ2); const float* lk2 = (const float*)ARG_IN(I_LK2);
          const float* og = (const float*)ARG_IN(I_DOG); const bf16_t* Oc = P_OC; bf16_t* OB = P_OB;
          const float lam = __expf(wave_sum(lq1[lane] * lk1[lane])) - __expf(wave_sum(lq2[lane] * lk2[lane])) + 0.2f;
          const size_t m0 = (size_t)cb * 64 + wave * 8; const int col0 = lane * 8;
          u32x4 av[8], bv[8];
#pragma unroll
          for (int i = 0; i < 8; ++i) { av[i] = *(const u32x4*)(Oc + (m0 + i) * 512 + col0); bv[i] = *(const u32x4*)(Oc + (size_t)M * 512 + (m0 + i) * 512 + col0); }
          float ogv[8];
#pragma unroll
          for (int e = 0; e < 8; ++e) ogv[e] = og[(col0 & 127) + e];
#pragma unroll
          for (int i = 0; i < 8; ++i) {
            const unsigned aw[4] = {av[i].x, av[i].y, av[i].z, av[i].w}, bw[4] = {bv[i].x, bv[i].y, bv[i].z, bv[i].w}; float o[8]; float ss = 0.f;
#pragma unroll
            for (int e = 0; e < 4; ++e) { o[2 * e] = lo_bf(aw[e]) - lam * lo_bf(bw[e]); o[2 * e + 1] = hi_bf(aw[e]) - lam * hi_bf(bw[e]); ss += o[2 * e] * o[2 * e] + o[2 * e + 1] * o[2 * e + 1]; }
            ss += __shfl_xor(ss, 1); ss += __shfl_xor(ss, 2); ss += __shfl_xor(ss, 4); ss += __shfl_xor(ss, 8);
            const float rstd = rsqrtf(ss * (1.f / 128.f) + 1e-6f) * 0.8f; unsigned ow[4];
#pragma unroll
            for (int e = 0; e < 4; ++e) ow[e] = pk2(o[2 * e] * rstd * ogv[2 * e], o[2 * e + 1] * rstd * ogv[2 * e + 1]);
            *(u32x4*)(OB + (m0 + i) * 512 + col0) = (u32x4){ow[0], ow[1], ow[2], ow[3]}; } }
        __syncthreads();
        gla::chunk_out4(lds, cb >> 6, cb & 63, P_LOGA, P_UGLA, P_SPT, (const float*)ARG_IN(I_GOG), P_OA, tid, lane, wave);
    }
    SEAM(5);

    if constexpr (IN(6)) {
        asm volatile("; PHASE_BEGIN 6" ::: "memory");
        PHASE_LOCALS
        bf16_t* OA = P_OA; bf16_t* OB = P_OB; bf16_t* Wa_t = P_WA; bf16_t* Wb_t = P_WB; bf16_t* Ugate = P_UGATE; bf16_t* M1 = P_M1; bf16_t* MERGED = P_MERGED;
        { pg8::DenseOrder S; S.init(OA, Wa_t, M, D, 512, G, cb); pg8::EpiBranch E{Ugate, 0, nullptr, M1};
          pg8::gemm_phase<pg8::EpiBranch, pg8::DenseOrder, true, true>(lds, 512, S, E); }
        VM_WAIT(); __syncthreads();
        { pg8::DenseOrder S; S.init(OB, Wb_t, M, D, 512, G, cb); pg8::EpiBranch E{Ugate, 1024, M1, MERGED};
          pg8::gemm_phase<pg8::EpiBranch, pg8::DenseOrder, true, true>(lds, 512, S, E); }
    }
    SEAM(6);

    if constexpr (IN(7)) {
        asm volatile("; PHASE_BEGIN 7" ::: "memory");
        PHASE_LOCALS
        const float* x = XIN; float* out = OUTP; float* modf = P_MODF; bf16_t* MERGED = P_MERGED; bf16_t* Wout_t = P_WOUT;
        pg8::DenseOrder S; S.init(MERGED, Wout_t, M, D, D, G, cb); pg8::EpiWout E{x, modf, out};
        pg8::gemm_phase<pg8::EpiWout, pg8::DenseOrder, true, true>(lds, D, S, E);
    }
    SEAM(7);

    if constexpr (IN(8)) {
        asm volatile("; PHASE_BEGIN 8" ::: "memory");
        PHASE_LOCALS
        float* out = OUTP; float* modf = P_MODF; bf16_t* H2 = P_H2; bf16_t* W13_t = P_W13; bf16_t* W2_t = P_W2; int* tok_e = P_TOKE; float* tok_w = P_TOKW; int* tok_rank = P_RANK; int* blkcnt = P_BLKCNT;
        const float* g2 = (const float*)ARG_IN(I_N2G); const float* brg = (const float*)ARG_IN(I_RGB); const float* bre = (const float*)ARG_IN(I_REB); const float* WrT = P_WRT;
        LAS float* modS = (LAS float*)lds;
        LAS int* eS = (LAS int*)(lds + 8192);
        const int b = cb >> 6;
        for (int j = tid; j < 2048; j += NTHR) modS[j] = modf[(size_t)b * NMOD + 3 * D + j] + (j >= D ? 1.0f : 0.f);
        __syncthreads();
        {
            f32x4 hv[8][4];
            const size_t m0 = (size_t)cb * 64 + wave * 8;
#pragma unroll
            for (int i = 0; i < 8; ++i) { const f32x4* xr = (const f32x4*)(out + (m0 + i) * D) + lane;
#pragma unroll
                for (int j = 0; j < 4; ++j) hv[i][j] = xr[64 * j]; }
#pragma unroll
            for (int i = 0; i < 8; ++i) { float ss = 0.f;
#pragma unroll
                for (int j = 0; j < 4; ++j) ss += (hv[i][j].x * hv[i][j].x + hv[i][j].y * hv[i][j].y) + (hv[i][j].z * hv[i][j].z + hv[i][j].w * hv[i][j].w);
                const float rstd = rsqrtf(wave_sum(ss) * (1.f / D) + 1e-6f);
                unsigned long long* o8 = (unsigned long long*)(H2 + (m0 + i) * D) + lane;
#pragma unroll
                for (int j = 0; j < 4; ++j) { const int k = 4 * lane + 256 * j; const f32x4 gg = *(const f32x4*)(g2 + k); const f32x4 sh = *(const LAS f32x4*)(modS + k); const f32x4 sc = *(const LAS f32x4*)(modS + D + k);
                    hv[i][j] = hv[i][j] * rstd * gg * sc + sh;
                    o8[64 * j] = (unsigned long long)pk2(hv[i][j].x, hv[i][j].y) | ((unsigned long long)pk2(hv[i][j].z, hv[i][j].w) << 32); } }
            float res[8];
#pragma unroll
            for (int i = 0; i < 8; ++i) res[i] = 0.f;
            { f32x4 wn[4];
#pragma unroll
              for (int jj = 0; jj < 4; ++jj) wn[jj] = *(const f32x4*)(WrT + 4 * lane + 256 * jj);
#pragma unroll 1
              for (int jx = 0; jx < 36; ++jx) {
                f32x4 w[4];
#pragma unroll
                for (int jj = 0; jj < 4; ++jj) w[jj] = wn[jj];
                const int jn = jx < 35 ? jx + 1 : jx;
#pragma unroll
                for (int jj = 0; jj < 4; ++jj) wn[jj] = *(const f32x4*)(WrT + (size_t)jn * D + 4 * lane + 256 * jj);
#pragma unroll
                for (int i = 0; i < 8; ++i) { float a = 0.f;
#pragma unroll
                    for (int jj = 0; jj < 4; ++jj) a += (hv[i][jj].x * w[jj].x + hv[i][jj].y * w[jj].y) + (hv[i][jj].z * w[jj].z + hv[i][jj].w * w[jj].w);
                    a = wave_sum(a); if (lane == jx) res[i] = a; }
              } }
            const float bias = lane < 4 ? brg[lane] : (lane < 36 ? bre[lane - 4] : 0.f);
#pragma unroll
            for (int i = 0; i < 8; ++i) {
                const int tl = wave * 8 + i; const float lgt = res[i] + bias;
                const float lg0 = __shfl(lgt, 0), lg1 = __shfl(lgt, 1), lg2 = __shfl(lgt, 2), lg3 = __shfl(lgt, 3);
                int gi = 0; float gm = lg0; if (lg1 > gm) { gm = lg1; gi = 1; } if (lg2 > gm) { gm = lg2; gi = 2; } if (lg3 > gm) { gm = lg3; gi = 3; }
                const float ptop = 1.0f / (__expf(lg0 - gm) + __expf(lg1 - gm) + __expf(lg2 - gm) + __expf(lg3 - gm));
                float el[8];
#pragma unroll
                for (int j = 0; j < 8; ++j) el[j] = __shfl(lgt, 4 + gi * 8 + j);
                int j0 = 0; float e0 = el[0];
#pragma unroll
                for (int j = 1; j < 8; ++j) if (el[j] > e0) { e0 = el[j]; j0 = j; }
                int j1 = -1; float e1 = -3.0e38f;
#pragma unroll
                for (int j = 0; j < 8; ++j) if (j != j0 && el[j] > e1) { e1 = el[j]; j1 = j; }
                const float t = __expf(e1 - e0), w0 = ptop / (1.0f + t), w1 = ptop * t / (1.0f + t);
                if (lane == 0) { eS[2 * tl] = gi * 8 + j0; eS[2 * tl + 1] = gi * 8 + j1; tok_w[(m0 + i) * 2] = w0; tok_w[(m0 + i) * 2 + 1] = w1; }
            }
        }
        __syncthreads();
        if (tid < 128) { const int e = eS[tid]; int rank = 0; for (int a = 0; a < tid; ++a) rank += (eS[a] == e) ? 1 : 0;
            tok_e[(size_t)cb * 128 + tid] = e; tok_rank[(size_t)cb * 128 + tid] = rank; }
        else if (tid < 160) { const int e = tid - 128; int cnt = 0; for (int a = 0; a < 128; ++a) cnt += (eS[a] == e) ? 1 : 0; blkcnt[cb * 32 + e] = cnt; }
        __syncthreads();
        { const DecExp dec{(const float*)ARG_IN(I_EW1), (const float*)ARG_IN(I_EW3), (const float*)ARG_IN(I_EW2), W13_t, W2_t};
          tr_run(gw, NEXP * 768, NGW, dec, (LAS float*)(lds + wave * 16384), lane); }
    }
    SEAM(8);

    if constexpr (IN(9)) {
        asm volatile("; PHASE_BEGIN 9" ::: "memory");
        PHASE_LOCALS
        bf16_t* H2 = P_H2; bf16_t* XS = P_XS; int* tok_e = P_TOKE; int* tok_rank = P_RANK; int* tok_slot = P_SLOT; int* blkcnt = P_BLKCNT; int* tile_e = P_TILEE; int* ntiles_p = P_NT;
        LAS int* red = (LAS int*)lds;
        LAS int* totS = red + 1024;
        LAS int* preS = totS + 32;
        LAS int* padS = preS + 32;
        LAS int* slotS = padS + 64;
        { const int e = tid & 31, part = tid >> 5; int tot = 0, pre = 0;
            for (int blk = part; blk < 256; blk += 16) { const int cval = blkcnt[blk * 32 + e]; tot += cval; pre += (blk < cb) ? cval : 0; }
            red[part * 64 + e] = tot; red[part * 64 + 32 + e] = pre; }
        __syncthreads();
        if (tid < 32) { int tot = 0, pre = 0; for (int p = 0; p < 16; ++p) { tot += red[p * 64 + tid]; pre += red[p * 64 + 32 + tid]; } totS[tid] = tot; preS[tid] = pre; }
        __syncthreads();
        if (tid == 0) { int off = 0; for (int e = 0; e < 32; ++e) { padS[e] = off; off += ((totS[e] + 255) >> 8) << 8; } padS[32] = off; }
        __syncthreads();
        if (cb == 0) { if (tid < 32) { for (int t = padS[tid] >> 8; t < (padS[tid + 1] >> 8); ++t) tile_e[t] = tid; } if (tid == 32) ntiles_p[0] = padS[32] >> 8; }
        if (tid < 128) { const size_t a = (size_t)cb * 128 + tid; const int e = tok_e[a]; const int slot = padS[e] + preS[e] + tok_rank[a]; tok_slot[a] = slot; slotS[tid] = slot; }
        __syncthreads();
#pragma unroll
        for (int hb = 0; hb < 2; ++hb) {
            u32x4 v0[8], v1[8]; int sl[8];
#pragma unroll
            for (int a8 = 0; a8 < 8; ++a8) { const int a = wave * 16 + hb * 8 + a8; const size_t t = (size_t)cb * 64 + (a >> 1); sl[a8] = slotS[a];
                const u32x4* src = (const u32x4*)(H2 + t * D) + lane; v0[a8] = src[0]; v1[a8] = src[64]; }
#pragma unroll
            for (int a8 = 0; a8 < 8; ++a8) { u32x4* dst = (u32x4*)(XS + (size_t)sl[a8] * D) + lane; dst[0] = v0[a8]; dst[64] = v1[a8]; }
        }
        if (cb < 32) { const int r0 = padS[cb] + totS[cb], r1 = padS[cb + 1];
            for (int r = r0 + wave; r < r1; r += NWAVES) { u32x4* dst = (u32x4*)(XS + (size_t)r * D) + lane; dst[0] = (u32x4){0, 0, 0, 0}; dst[64] = (u32x4){0, 0, 0, 0}; } }
    }
    SEAM(9);

    if constexpr (IN(10)) {
        asm volatile("; PHASE_BEGIN 10" ::: "memory");
        PHASE_LOCALS
        bf16_t* XS = P_XS; bf16_t* W13_t = P_W13; bf16_t* HMID = P_HMID; int* tile_e = P_TILEE; int* ntiles_p = P_NT;
        const int ntm = __builtin_amdgcn_readfirstlane(ntiles_p[0]);
        pg8::MoeOrder S; S.init(XS, W13_t, tile_e, ntm, D, (size_t)1024 * 1024 * 2, G, cb); pg8::EpiUp E{HMID};
        pg8::gemm_phase<pg8::EpiUp, pg8::MoeOrder, true, true>(lds, D, S, E);
    }
    SEAM(10);

    if constexpr (IN(11)) {
        asm volatile("; PHASE_BEGIN 11" ::: "memory");
        PHASE_LOCALS
        bf16_t* HMID = P_HMID; bf16_t* W2_t = P_W2; bf16_t* Y = P_Y; int* tile_e = P_TILEE; int* ntiles_p = P_NT;
        const int ntm = __builtin_amdgcn_readfirstlane(ntiles_p[0]);
        pg8::MoeOrder S; S.init(HMID, W2_t, tile_e, ntm, DEXP, (size_t)1024 * 512 * 2, G, cb); pg8::EpiPlain E{Y, D};
        pg8::gemm_phase<pg8::EpiPlain, pg8::MoeOrder, true, true>(lds, DEXP, S, E);
    }
    SEAM(11);

    if constexpr (IN(12)) {
        asm volatile("; PHASE_BEGIN 12" ::: "memory");
        PHASE_LOCALS
        float* out = OUTP; float* modf = P_MODF; bf16_t* Y = P_Y; int* tok_slot = P_SLOT; float* tok_w = P_TOKW;
        const size_t m0 = (size_t)cb * 64 + wave * 8; const float* g2p = modf + (size_t)(cb >> 6) * NMOD + 5 * D;
        int s0[8], s1[8]; float w0[8], w1[8];
#pragma unroll
        for (int i = 0; i < 8; ++i) { s0[i] = tok_slot[(m0 + i) * 2]; s1[i] = tok_slot[(m0 + i) * 2 + 1]; w0[i] = tok_w[(m0 + i) * 2]; w1[i] = tok_w[(m0 + i) * 2 + 1]; }
        f32x4 gv[4];
#pragma unroll
        for (int j = 0; j < 4; ++j) gv[j] = *(const f32x4*)(g2p + 4 * lane + 256 * j);
#pragma unroll
        for (int hb = 0; hb < 2; ++hb) {
            f32x4 xv[4][4]; u32x2 y0[4][4], y1[4][4];
#pragma unroll
            for (int i4 = 0; i4 < 4; ++i4) { const int i = hb * 4 + i4;
#pragma unroll
                for (int j = 0; j < 4; ++j) { const int k = 4 * lane + 256 * j; xv[i4][j] = *(const f32x4*)(out + (m0 + i) * D + k);
                    y0[i4][j] = *(const u32x2*)(Y + (size_t)s0[i] * D + k); y1[i4][j] = *(const u32x2*)(Y + (size_t)s1[i] * D + k); } }
#pragma unroll
            for (int i4 = 0; i4 < 4; ++i4) { const int i = hb * 4 + i4;
#pragma unroll
                for (int j = 0; j < 4; ++j) { const int k = 4 * lane + 256 * j; f32x4 o;
                    o.x = xv[i4][j].x + gv[j].x * (w0[i] * lo_bf(y0[i4][j].x) + w1[i] * lo_bf(y1[i4][j].x)); o.y = xv[i4][j].y + gv[j].y * (w0[i] * hi_bf(y0[i4][j].x) + w1[i] * hi_bf(y1[i4][j].x));
                    o.z = xv[i4][j].z + gv[j].z * (w0[i] * lo_bf(y0[i4][j].y) + w1[i] * lo_bf(y1[i4][j].y)); o.w = xv[i4][j].w + gv[j].w * (w0[i] * hi_bf(y0[i4][j].y) + w1[i] * hi_bf(y1[i4][j].y));
                    *(f32x4*)(out + (m0 + i) * D + k) = o; } }
        }
    }
#undef IN
#undef SEAM
}

constexpr int NPHASE = 13;
template <int LO, int HI> static void launch_range(const Args& a, hipStream_t stream) {
    static bool attr = false;
    if (!attr) { (void)hipFuncSetAttribute((const void*)mk_fwd<LO, HI>, hipFuncAttributeMaxDynamicSharedMemorySize, LDS_BYTES); attr = true; }
    hipLaunchKernelGGL((mk_fwd<LO, HI>), dim3(256), dim3(NTHR), LDS_BYTES, stream, a);
}
extern "C" void kernel_launch(void* const* d_in, const int* in_sizes, int n_in, void* d_out, int out_size, void* d_ws, size_t ws_size, hipStream_t stream) {
    static int ok = 0;
    if (ok == 0) {
        if (n_in != 28 || out_size != M * D || ws_size < WS_END) { fprintf(stderr, "kernel_launch: unexpected shapes (n_in %d, out %d, ws %zu < %zu)\n", n_in, out_size, ws_size, (size_t)WS_END); ok = -1; return; }
        ok = 1;
    }
    if (ok < 0) return;
    (void)hipMemsetAsync((char*)d_ws + WS_CTL, 0, CTL_ZERO_BYTES, stream);
    Args a{};
    for (int i = 0; i < 28; ++i) a.in[i] = d_in[i];
    a.out = (float*)d_out; a.ws = (unsigned char*)d_ws; a.ph_lo = 0; a.ph_hi = NPHASE;
#if MK_ONE_LAUNCH
    launch_range<0, NPHASE>(a, stream);
#else
    launch_range<0, 1>(a, stream); launch_range<1, 2>(a, stream); launch_range<2, 3>(a, stream); launch_range<3, 4>(a, stream);
    launch_range<4, 5>(a, stream); launch_range<5, 6>(a, stream); launch_range<6, 7>(a, stream); launch_range<7, 8>(a, stream);
    launch_range<8, 9>(a, stream); launch_range<9, 10>(a, stream); launch_range<10, 11>(a, stream); launch_range<11, 12>(a, stream);
    launch_range<12, 13>(a, stream);
#endif
}
```

```cpp
#include <hip/hip_runtime.h>
#include <hip/hip_bf16.h>
#include <cstdio>
#include <cstdint>

#ifndef MK_ONE_LAUNCH
#define MK_ONE_LAUNCH 1
#endif

#define LAS __attribute__((address_space(3)))
#define GAS __attribute__((address_space(1)))
typedef unsigned short bf16_t;
typedef short bf16x8 __attribute__((ext_vector_type(8)));
typedef float f32x4 __attribute__((ext_vector_type(4)));
typedef float f32x2 __attribute__((ext_vector_type(2)));
typedef unsigned u32x4 __attribute__((ext_vector_type(4)));
typedef unsigned u32x2 __attribute__((ext_vector_type(2)));

constexpr int NB = 4, SEQ = 4096, D = 1024, M = NB * SEQ;
constexpr int DIN = 5136, NPROJ = 5120;
constexpr int NEXP = 32, DEXP = 512;
constexpr int PMAX = 40960;
constexpr int NMOD = 6 * D;

constexpr size_t MiB = 1u << 20;
constexpr size_t WS_CTL = 0, CTL_ZERO_BYTES = 1 * MiB;
constexpr size_t WS_MODP = 1 * MiB;
constexpr size_t WS_MODF = 4 * MiB;
constexpr size_t WS_ALR = 5 * MiB;
constexpr size_t WS_ROUTE = 6 * MiB;
constexpr size_t WS_WIN = 8 * MiB;
constexpr size_t WS_WA = 18 * MiB, WS_WB = 19 * MiB, WS_WOUT = 20 * MiB;
constexpr size_t RA = 22 * MiB;
constexpr size_t RB = 118 * MiB;
constexpr size_t WS_END = 278 * MiB;
constexpr size_t WS_XN = RA;
constexpr size_t WS_LOGA = RA;
constexpr size_t WS_SCT = RA + 16 * MiB;
constexpr size_t WS_SPT = RA + 48 * MiB;
constexpr size_t WS_OC = RA + 64 * MiB;
constexpr size_t WS_DEC = 7 * MiB;
constexpr size_t WS_WRT = 7 * MiB + 512 * 1024;
constexpr size_t WS_LRT = 7 * MiB + 768 * 1024;
constexpr size_t WS_OB = RB + 64 * MiB;
constexpr size_t WS_OA = RB + 48 * MiB;
constexpr size_t WS_XS = RA;
constexpr size_t WS_Y = RA;
constexpr size_t WS_UGLA = RB;
constexpr size_t WS_UDIFF = RB + 48 * MiB;
constexpr size_t WS_UGATE = RB + 96 * MiB;
constexpr size_t WS_M1 = RA;
constexpr size_t WS_MERGED = RB;
constexpr size_t WS_H2 = RB;
constexpr size_t WS_W13 = RB + 64 * MiB;
constexpr size_t WS_W2 = RB + 128 * MiB;
constexpr size_t WS_HMID = RB;
constexpr size_t RT_TOKE = 0, RT_TOKW = 131072, RT_RANK = 262144, RT_SLOT = 393216, RT_BLKCNT = 524288, RT_TILEE = 557056, RT_NT = 561152;
constexpr int CW_BAR = 4096;

constexpr int RING_BYTES = 131072;
constexpr int LDSCTL_OFF = RING_BYTES, MISC_OFF = LDSCTL_OFF + 320;
constexpr int LDS_BYTES = 147456;
constexpr int NWAVES = 8, NTHR = 512;

__device__ __forceinline__ float bf2f(bf16_t h) { return __uint_as_float((unsigned)h << 16); }
__device__ __forceinline__ unsigned f2bf(float f) { unsigned u = __float_as_uint(f); return (u + 0x7fffu + ((u >> 16) & 1u)) >> 16; }
typedef __bf16 bf16x2_t __attribute__((ext_vector_type(2)));
__device__ __forceinline__ unsigned pk2(float lo, float hi) { f32x2 v = {lo, hi}; bf16x2_t b = __builtin_convertvector(v, bf16x2_t); return __builtin_bit_cast(unsigned, b); }
__device__ __forceinline__ float lo_bf(unsigned w) { return __uint_as_float(w << 16); }
__device__ __forceinline__ float hi_bf(unsigned w) { return __uint_as_float(w & 0xffff0000u); }
#define DPP_ADD(v, ctrl) ((v) + __builtin_bit_cast(float, __builtin_amdgcn_update_dpp(0, __builtin_bit_cast(int, (v)), (ctrl), 0xF, 0xF, true)))
__device__ __forceinline__ float wave_sum(float v) {
    v = DPP_ADD(v, 0xB1); v = DPP_ADD(v, 0x4E); v = DPP_ADD(v, 0x141); v = DPP_ADD(v, 0x140);
    { const unsigned u = __float_as_uint(v); auto r = __builtin_amdgcn_permlane16_swap(u, u, false, false); v = __uint_as_float(r[0]) + __uint_as_float(r[1]); }
    { const unsigned u = __float_as_uint(v); auto r = __builtin_amdgcn_permlane32_swap(u, u, false, false); v = __uint_as_float(r[0]) + __uint_as_float(r[1]); }
    return v;
}
__device__ __forceinline__ float wave_max(float v) {
#pragma unroll
    for (int o = 1; o < 64; o <<= 1) v = fmaxf(v, __shfl_xor(v, o));
    return v;
}
__device__ __forceinline__ float sigmoidf_(float x) { return 1.0f / (1.0f + __expf(-x)); }
__device__ __forceinline__ float siluf_(float x) { return x / (1.0f + __expf(-x)); }
#define LDS_WAIT() asm volatile("s_waitcnt lgkmcnt(0)" ::: "memory")
#define VM_WAIT() asm volatile("s_waitcnt vmcnt(0)" ::: "memory")

namespace pg8 {
constexpr int BM = 256, BK = 64, HALF = 128, HTB = HALF * BK * 2, STAGE_BYTES = 8 * HTB, NXCD = 8, WGM = 8;
__host__ __device__ __forceinline__ int lds_byte(int r, int c) { const int st = (r >> 4) * 2 + (c >> 5), rr = r & 15, cc = c & 31, ob = rr * 64 + cc * 2; return st * 1024 + (ob ^ (((ob >> 9) & 1) << 5)); }
__host__ __device__ __forceinline__ void stage_rc(int b, int& R, int& C) { const int st = b / 1024, sb = b % 1024, swz = sb ^ (((sb >> 9) & 1) << 5); R = (st >> 1) * 16 + swz / 64; C = (st & 1) * 32 + (swz % 64) / 2; }
__host__ __device__ __forceinline__ int perm32(int rho) { const int n = rho >> 4, i = rho & 15; return 8 * (i >> 2) + 4 * n + (i & 3); }

struct Unit { int pm, pn, aux; };

__device__ __forceinline__ int xcd_swizzle(int wgid, int nwg) { const int q = nwg / NXCD, r = nwg % NXCD, xcd = wgid % NXCD, off = wgid / NXCD; return (xcd < r ? xcd * (q + 1) : r * (q + 1) + (xcd - r) * q) + off; }

struct DenseOrder {
    const char* A; const char* Bt; size_t tstep; int nM, nN, nwg, G, c;
    __device__ __forceinline__ void init(const void* A_, const void* Bt_, int M_, int N_, int K_, int G_, int c_) { A = (const char*)A_; Bt = (const char*)Bt_; tstep = (size_t)BM * K_ * 2; nM = M_ / BM; nN = N_ / BM; nwg = nM * nN; G = G_; c = c_; }
    __device__ __forceinline__ bool next(int i, Unit& u) const {
        const long L = (long)i * G + c; if (L >= nwg) return false;
        const int wgid = xcd_swizzle((int)L, nwg);
        const int nig = WGM * nN, gid = wgid / nig, fm = gid * WGM, gsz = (nM - fm) < WGM ? (nM - fm) : WGM;
        u.pm = fm + ((wgid % nig) % gsz); u.pn = (wgid % nig) / gsz; u.aux = 0; return true;
    }
    __device__ __forceinline__ const char* a_ptr(const Unit& u) const { return A + (size_t)u.pm * tstep; }
    __device__ __forceinline__ const char* b_ptr(const Unit& u) const { return Bt + (size_t)u.pn * tstep; }
};
struct MoeOrder {
    const char* A; const char* W; const int* tile_e; size_t tstep, estride; int nwg, G, c;
    __device__ __forceinline__ void init(const void* A_, const void* W_, const int* te, int ntm, int K_, size_t estride_, int G_, int c_) { A = (const char*)A_; W = (const char*)W_; tile_e = te; tstep = (size_t)BM * K_ * 2; estride = estride_; nwg = ntm * 4; G = G_; c = c_; }
    __device__ __forceinline__ bool next(int i, Unit& u) const {
        const long L = (long)i * G + c; if (L >= nwg) return false;
        const int wgid = xcd_swizzle((int)L, nwg);
        u.pm = wgid >> 2; u.pn = wgid & 3; u.aux = __builtin_amdgcn_readfirstlane(tile_e[u.pm]); return true;
    }
    __device__ __forceinline__ const char* a_ptr(const Unit& u) const { return A + (size_t)u.pm * tstep; }
    __device__ __forceinline__ const char* b_ptr(const Unit& u) const { return W + (size_t)u.aux * estride + (size_t)u.pn * tstep; }
};

__device__ __forceinline__ u32x4 pack8(const f32x4& v0, const f32x4& v1) { u32x4 w; w.x = pk2(v0[0], v0[1]); w.y = pk2(v0[2], v0[3]); w.z = pk2(v1[0], v1[1]); w.w = pk2(v1[2], v1[3]); return w; }

struct EpiInProj {
    static constexpr bool PERM = true, AFTER_DRAIN = false;
    bf16_t *Ugla, *Udiff, *Ugate;
    __device__ __forceinline__ void operator()(const f32x4 (&acc)[2][2][4][2], const Unit& u, int wr, int wc, int fr, int fq) const {
        bf16_t* base; int ldc, colt;
        if (u.pn < 6) { base = Ugla; ldc = 1536; colt = u.pn * 256; } else if (u.pn < 12) { base = Udiff; ldc = 1536; colt = (u.pn - 6) * 256; } else { base = Ugate; ldc = 2048; colt = (u.pn - 12) * 256; }
        const int row0 = u.pm * BM + wr * 64 + fr, col0 = colt + wc * 32 + 8 * fq;
#pragma unroll
        for (int ai = 0; ai < 2; ++ai)
#pragma unroll
            for (int m = 0; m < 4; ++m) { bf16_t* rowp = base + (size_t)(row0 + ai * HALF + m * 16) * ldc + col0;
#pragma unroll
                for (int bj = 0; bj < 2; ++bj) *(u32x4*)(rowp + bj * HALF) = pack8(acc[ai][bj][m][0], acc[ai][bj][m][1]); }
    }
};
struct EpiPlain {
    static constexpr bool PERM = true, AFTER_DRAIN = false;
    bf16_t* O; int ldc;
    __device__ __forceinline__ void operator()(const f32x4 (&acc)[2][2][4][2], const Unit& u, int wr, int wc, int fr, int fq) const {
        const int row0 = u.pm * BM + wr * 64 + fr, col0 = u.pn * BM + wc * 32 + 8 * fq;
#pragma unroll
        for (int ai = 0; ai < 2; ++ai)
#pragma unroll
            for (int m = 0; m < 4; ++m) { bf16_t* rowp = O + (size_t)(row0 + ai * HALF + m * 16) * ldc + col0;
#pragma unroll
                for (int bj = 0; bj < 2; ++bj) *(u32x4*)(rowp + bj * HALF) = pack8(acc[ai][bj][m][0], acc[ai][bj][m][1]); }
    }
};
struct EpiBranch {
    static constexpr bool PERM = true, AFTER_DRAIN = false;
    const bf16_t* gate; int gcol0; const bf16_t* m1in; bf16_t* out;
    __device__ __forceinline__ void operator()(const f32x4 (&acc)[2][2][4][2], const Unit& u, int wr, int wc, int fr, int fq) const {
        const int row0 = u.pm * BM + wr * 64 + fr, col0 = u.pn * BM + wc * 32 + 8 * fq;
#pragma unroll
        for (int ai = 0; ai < 2; ++ai)
#pragma unroll
            for (int m = 0; m < 4; ++m) { const size_t r = (size_t)(row0 + ai * HALF + m * 16);
#pragma unroll
                for (int bj = 0; bj < 2; ++bj) { const int c = col0 + bj * HALF;
                    const u32x4 g = *(const u32x4*)(gate + r * 2048 + gcol0 + c);
                    f32x4 v0 = acc[ai][bj][m][0], v1 = acc[ai][bj][m][1];
                    v0[0] *= sigmoidf_(lo_bf(g.x)); v0[1] *= sigmoidf_(hi_bf(g.x)); v0[2] *= sigmoidf_(lo_bf(g.y)); v0[3] *= sigmoidf_(hi_bf(g.y));
                    v1[0] *= sigmoidf_(lo_bf(g.z)); v1[1] *= sigmoidf_(hi_bf(g.z)); v1[2] *= sigmoidf_(lo_bf(g.w)); v1[3] *= sigmoidf_(hi_bf(g.w));
                    if (m1in) { const u32x4 p = *(const u32x4*)(m1in + r * 1024 + c);
                        v0[0] += lo_bf(p.x); v0[1] += hi_bf(p.x); v0[2] += lo_bf(p.y); v0[3] += hi_bf(p.y); v1[0] += lo_bf(p.z); v1[1] += hi_bf(p.z); v1[2] += lo_bf(p.w); v1[3] += hi_bf(p.w); }
                    *(u32x4*)(out + r * 1024 + c) = pack8(v0, v1); } }
    }
};
struct EpiWout {
    static constexpr bool PERM = false, AFTER_DRAIN = false;
    const float* x; const float* modf; float* out;
    __device__ __forceinline__ void operator()(const f32x4 (&acc)[2][2][4][2], const Unit& u, int wr, int wc, int fr, int fq) const {
        const int row0 = u.pm * BM + wr * 64 + fr, col0 = u.pn * BM + wc * 32 + 4 * fq;
        const float* g1 = modf + (size_t)((u.pm * BM) >> 12) * NMOD + 2 * D;
#pragma unroll
        for (int bj = 0; bj < 2; ++bj)
#pragma unroll
            for (int n = 0; n < 2; ++n) { const int c = col0 + bj * HALF + n * 16; const f32x4 gv = *(const f32x4*)(g1 + c);
#pragma unroll
                for (int ai = 0; ai < 2; ++ai)
#pragma unroll
                    for (int m = 0; m < 4; ++m) { const size_t off = (size_t)(row0 + ai * HALF + m * 16) * D + c;
                        const f32x4 xv = *(const f32x4*)(x + off); *(f32x4*)(out + off) = xv + gv * acc[ai][bj][m][n]; } }
    }
};
struct EpiUp {
    static constexpr bool PERM = true, AFTER_DRAIN = false;
    bf16_t* H;
    __device__ __forceinline__ void operator()(const f32x4 (&acc)[2][2][4][2], const Unit& u, int wr, int wc, int fr, int fq) const {
        const int row0 = u.pm * BM + wr * 64 + fr, col0 = u.pn * HALF + wc * 32 + 8 * fq;
#pragma unroll
        for (int ai = 0; ai < 2; ++ai)
#pragma unroll
            for (int m = 0; m < 4; ++m) { f32x4 v0, v1;
#pragma unroll
                for (int e = 0; e < 4; ++e) { v0[e] = siluf_(acc[ai][0][m][0][e]) * acc[ai][1][m][0][e]; v1[e] = siluf_(acc[ai][0][m][1][e]) * acc[ai][1][m][1][e]; }
                *(u32x4*)(H + (size_t)(row0 + ai * HALF + m * 16) * DEXP + col0) = pack8(v0, v1); }
    }
};

template <class Epi, class Sched, bool ALIGN_EPI = false, bool SP2 = false>
__device__ __forceinline__ void gemm_phase(LAS unsigned char* lds, const int K, const Sched& S, const Epi& E) {
    int tid_ = threadIdx.x; asm volatile("" : "+v"(tid_));
    const int tid = tid_, wid = __builtin_amdgcn_readfirstlane(tid >> 6), lane = tid & 63, wr = wid >> 2, wc = wid & 3, fr = lane & 15, fq = lane >> 4;
    const int nt = K / BK;
    unsigned voffA[2], voffB[2];
#pragma unroll
    for (int i = 0; i < 2; ++i) { int R, C; stage_rc(tid * 16 + i * 8192, R, C); const int Rb = Epi::PERM ? ((R & ~31) + perm32(R & 31)) : R;
        voffA[i] = (unsigned)(R * K + C) * 2u; voffB[i] = (unsigned)(Rb * K + C) * 2u; }
    const size_t kstep = (size_t)(BK * 2);
    const size_t hstep = (size_t)HALF * K * 2;
    const unsigned ldsw = (unsigned)wid * 1024u;
    const int aoff = lds_byte(wr * 64 + fr, fq * 8), boff = lds_byte(wc * 32 + fr, fq * 8);
#define PG8_SA(b, h) (((b) * 2 + (h)) * HTB)
#define PG8_SB(b, h) ((4 + (b) * 2 + (h)) * HTB)
#define PG8_STAGE(bufoff, gbase, voff) do { _Pragma("unroll") for (int _i = 0; _i < 2; ++_i) \
        __builtin_amdgcn_global_load_lds((const unsigned*)((const char*)(gbase) + (voff)[_i]), (LAS unsigned*)(lds + (bufoff) + ldsw + _i * 8192), 16, 0, 0); } while (0)
#define PG8_LDA(dst, b, h) do { _Pragma("unroll") for (int m = 0; m < 4; ++m) _Pragma("unroll") for (int k = 0; k < 2; ++k) dst[m][k] = *(const LAS bf16x8*)(lds + PG8_SA(b, h) + aoff + m * 2048 + k * 1024); } while (0)
#define PG8_LDB(dst, b, h) do { _Pragma("unroll") for (int n = 0; n < 2; ++n) _Pragma("unroll") for (int k = 0; k < 2; ++k) dst[n][k] = *(const LAS bf16x8*)(lds + PG8_SB(b, h) + boff + n * 2048 + k * 1024); } while (0)
#define PG8_MMA(ai, bj, At, Bt) do { __builtin_amdgcn_s_setprio(1); _Pragma("unroll") for (int m = 0; m < 4; ++m) _Pragma("unroll") for (int n = 0; n < 2; ++n) _Pragma("unroll") for (int k = 0; k < 2; ++k) \
        acc[ai][bj][m][n] = __builtin_amdgcn_mfma_f32_16x16x32_bf16(Bt[n][k], At[m][k], acc[ai][bj][m][n], 0, 0, 0); __builtin_amdgcn_s_setprio(0); } while (0)
#define PG8_WAIT_V(n) asm volatile("s_waitcnt vmcnt(" #n ")" ::: "memory")
#define PG8_WAIT_L(n) asm volatile("s_waitcnt lgkmcnt(" #n ")" ::: "memory")
#define PG8_BAR __builtin_amdgcn_s_barrier()
#define PG8_SCHED __builtin_amdgcn_sched_barrier(0)
    Unit cur, nxt; int ui = 0;
    if (!S.next(0, cur)) return;
    f32x4 acc[2][2][4][2];
#pragma unroll
    for (int a = 0; a < 2; ++a)
#pragma unroll
        for (int b = 0; b < 2; ++b)
#pragma unroll
            for (int m = 0; m < 4; ++m)
#pragma unroll
                for (int n = 0; n < 2; ++n) acc[a][b][m][n] = (f32x4){0.f, 0.f, 0.f, 0.f};
    bf16x8 At[4][2], B0[2][2], B1[2][2];
    const char* cA = S.a_ptr(cur); const char* cB = S.b_ptr(cur);
    if constexpr (SP2) {
        PG8_STAGE(PG8_SB(0, 0), cB, voffB); PG8_STAGE(PG8_SB(0, 1), cB + hstep, voffB); PG8_STAGE(PG8_SA(0, 0), cA, voffA); PG8_STAGE(PG8_SA(0, 1), cA + hstep, voffA);
        if (wr == 1) PG8_BAR;
        PG8_WAIT_V(2); PG8_BAR;
        PG8_STAGE(PG8_SB(1, 0), cB + kstep, voffB); PG8_STAGE(PG8_SA(1, 0), cA + kstep, voffA); PG8_STAGE(PG8_SB(1, 1), cB + hstep + kstep, voffB);
        PG8_WAIT_V(6); PG8_BAR;
    } else {
        PG8_STAGE(PG8_SB(0, 0), cB, voffB); PG8_STAGE(PG8_SA(0, 0), cA, voffA); PG8_STAGE(PG8_SB(0, 1), cB + hstep, voffB); PG8_STAGE(PG8_SA(0, 1), cA + hstep, voffA);
        if (wr == 1) PG8_BAR;
        PG8_WAIT_V(4); PG8_BAR;
        PG8_STAGE(PG8_SB(1, 0), cB + kstep, voffB); PG8_STAGE(PG8_SA(1, 0), cA + kstep, voffA); PG8_STAGE(PG8_SB(1, 1), cB + hstep + kstep, voffB);
        PG8_WAIT_V(6); PG8_BAR;
    }
    for (;;) {
        const bool has_next = S.next(ui + 1, nxt);
        const char* nA = has_next ? S.a_ptr(nxt) : cA; const char* nB = has_next ? S.b_ptr(nxt) : cB;
        for (int t = 0; t < nt; t += 2) {
            const bool last = (t == nt - 2);
            const char* a1 = cA + (size_t)(t + 1) * kstep;
            const char* a2 = last ? nA : cA + (size_t)(t + 2) * kstep; const char* b2 = last ? nB : cB + (size_t)(t + 2) * kstep;
            const char* a3 = a2 + kstep; const char* b3 = b2 + kstep;
            if constexpr (SP2) {
            PG8_LDB(B0, 0, 0); PG8_LDB(B1, 0, 1); PG8_SCHED; PG8_LDA(At, 0, 0); PG8_STAGE(PG8_SA(1, 1), a1 + hstep, voffA);
            PG8_WAIT_V(8); PG8_WAIT_L(0); PG8_BAR; PG8_MMA(0, 0, At, B0); PG8_MMA(0, 1, At, B1); PG8_BAR; PG8_SCHED;
            PG8_LDA(At, 0, 1); PG8_STAGE(PG8_SB(0, 0), b2, voffB); PG8_STAGE(PG8_SB(0, 1), b2 + hstep, voffB); PG8_STAGE(PG8_SA(0, 0), a2, voffA);
            PG8_WAIT_V(8); PG8_WAIT_L(0); PG8_BAR; PG8_MMA(1, 0, At, B0); PG8_MMA(1, 1, At, B1); PG8_BAR; PG8_SCHED;
            PG8_LDB(B0, 1, 0); PG8_LDB(B1, 1, 1); PG8_SCHED; PG8_LDA(At, 1, 0); PG8_STAGE(PG8_SA(0, 1), a2 + hstep, voffA);
            PG8_WAIT_V(8); PG8_WAIT_L(0); PG8_BAR; PG8_MMA(0, 0, At, B0); PG8_MMA(0, 1, At, B1); PG8_BAR; PG8_SCHED;
            PG8_LDA(At, 1, 1); PG8_STAGE(PG8_SB(1, 0), b3, voffB); PG8_STAGE(PG8_SB(1, 1), b3 + hstep, voffB); PG8_STAGE(PG8_SA(1, 0), a3, voffA);
            PG8_WAIT_V(8); PG8_WAIT_L(0); PG8_BAR; PG8_MMA(1, 0, At, B0); PG8_MMA(1, 1, At, B1); PG8_BAR; PG8_SCHED;
            } else {
            PG8_LDB(B0, 0, 0); PG8_SCHED; PG8_LDA(At, 0, 0); PG8_STAGE(PG8_SA(1, 1), a1 + hstep, voffA);
            PG8_WAIT_L(8); PG8_BAR; PG8_WAIT_L(0); PG8_MMA(0, 0, At, B0); PG8_BAR; PG8_SCHED;
            PG8_LDB(B1, 0, 1); PG8_STAGE(PG8_SB(0, 0), b2, voffB);
            PG8_BAR; PG8_WAIT_L(0); PG8_MMA(0, 1, At, B1); PG8_BAR;
            PG8_LDA(At, 0, 1); PG8_STAGE(PG8_SA(0, 0), a2, voffA);
            PG8_BAR; PG8_WAIT_L(0); PG8_MMA(1, 0, At, B0); PG8_BAR; PG8_SCHED;
            PG8_STAGE(PG8_SB(0, 1), b2 + hstep, voffB);
            PG8_WAIT_V(6); PG8_BAR; PG8_MMA(1, 1, At, B1); PG8_BAR;
            PG8_LDB(B0, 1, 0); PG8_SCHED; PG8_LDA(At, 1, 0); PG8_STAGE(PG8_SA(0, 1), a2 + hstep, voffA);
            PG8_WAIT_L(8); PG8_BAR; PG8_WAIT_L(0); PG8_MMA(0, 0, At, B0); PG8_BAR; PG8_SCHED;
            PG8_LDB(B1, 1, 1); PG8_STAGE(PG8_SB(1, 0), b3, voffB);
            PG8_BAR; PG8_WAIT_L(0); PG8_MMA(0, 1, At, B1); PG8_BAR;
            PG8_LDA(At, 1, 1); PG8_STAGE(PG8_SA(1, 0), a3, voffA);
            PG8_BAR; PG8_WAIT_L(0); PG8_MMA(1, 0, At, B0); PG8_BAR; PG8_SCHED;
            PG8_STAGE(PG8_SB(1, 1), b3 + hstep, voffB);
            PG8_WAIT_V(6); PG8_BAR; PG8_MMA(1, 1, At, B1); PG8_BAR;
            }
        }
        if constexpr (ALIGN_EPI) { if (wr == 0) PG8_BAR; }
        E(acc, cur, wr, wc, fr, fq);
        if (!has_next) break;
#pragma unroll
        for (int a = 0; a < 2; ++a)
#pragma unroll
            for (int b = 0; b < 2; ++b)
#pragma unroll
                for (int m = 0; m < 4; ++m)
#pragma unroll
                    for (int n = 0; n < 2; ++n) acc[a][b][m][n] = (f32x4){0.f, 0.f, 0.f, 0.f};
        cur = nxt; cA = nA; cB = nB; ++ui;
        if constexpr (ALIGN_EPI) { if (wr == 1) PG8_BAR; }
    }
    PG8_WAIT_V(0);
    if constexpr (!ALIGN_EPI) { if (wr == 0) PG8_BAR; }
    PG8_BAR;
#undef PG8_SA
#undef PG8_SB
#undef PG8_STAGE
#undef PG8_LDA
#undef PG8_LDB
#undef PG8_MMA
#undef PG8_WAIT_V
#undef PG8_WAIT_L
#undef PG8_BAR
#undef PG8_SCHED
}
}

namespace attn_body {
using bf16=__hip_bfloat16;
using bf16x8=__attribute__((ext_vector_type(8)))short;
using s16x4=__attribute__((ext_vector_type(4)))short;
using f32x16=__attribute__((ext_vector_type(16)))float;
using u32x4=__attribute__((ext_vector_type(4)))unsigned;
constexpr int SEQ=4096,D=64,DM=1536,DMO=512;
constexpr int NW=8,QBLK=32,QB=QBLK*NW,KVBLK=64,NQB=SEQ/QB;
constexpr int ATTN_UNIT_ROWS=QB;
__device__ __forceinline__ int crow(int r,int hi){return (r&3)+8*(r>>2)+4*hi;}
#define SBAR() __builtin_amdgcn_sched_barrier(0)
__device__ __forceinline__ void cmask(f32x16&p0,f32x16&p1,int jb,int qrel,int hi){
  const float NEG=-INFINITY; int kb=64*jb+4*hi;
  #pragma unroll
  for(int r=0;r<16;++r){int kv=kb+(r&3)+8*(r>>2); if(kv>qrel)p0[r]=NEG; if(kv+32>qrel)p1[r]=NEG;}
}

constexpr int NSLOT=3, SLOTB=8192;
constexpr int LDS_K=0, LDS_V=NSLOT*SLOTB, LDS_WS=2*NSLOT*SLOTB, LDS_OST=LDS_WS+NW*64*4, LDS_BYTES=LDS_OST+NW*4096;
constexpr float C2=0.125f*1.4426950408889634f;
__device__ __forceinline__ void glds16(const void*gsrc,unsigned lds_dst){unsigned keep;
  asm volatile("s_mov_b32 %0, m0\n\ts_mov_b32 m0, %2\n\ts_nop 0\n\tglobal_load_lds_dwordx4 %1, off\n\ts_mov_b32 m0, %0":"=&s"(keep):"v"(gsrc),"s"(lds_dst):"memory");}
__device__ __forceinline__ float max3f(float a,float b,float c){float r;asm("v_max3_f32 %0, %1, %2, %3":"=v"(r):"v"(a),"v"(b),"v"(c));return r;}
__device__ __forceinline__ float max2f(float a,float b){float r;asm("v_max_f32_e32 %0, %1, %2":"=v"(r):"v"(a),"v"(b));return r;}
__device__ __forceinline__ float fadd_s(float a,float b){float r;asm("v_add_f32_e32 %0, %1, %2":"=v"(r):"v"(a),"v"(b));return r;}
__device__ __forceinline__ float fsub_s(float a,float b){float r;asm("v_sub_f32_e32 %0, %1, %2":"=v"(r):"v"(a),"v"(b));return r;}
typedef float f32x2_t __attribute__((ext_vector_type(2))); typedef __bf16 bf16x2_t __attribute__((ext_vector_type(2)));
__device__ __forceinline__ unsigned cvtpk_s(float lo,float hi){f32x2_t v={lo,hi};bf16x2_t b=__builtin_convertvector(v,bf16x2_t);return __builtin_bit_cast(unsigned,b);}
#define WAIT_BAR(N) asm volatile("s_waitcnt vmcnt(" #N ") lgkmcnt(0)\n\ts_barrier":::"memory")

__device__ __forceinline__ void qkt(f32x16&p0,f32x16&p1,const char*Kslot,const bf16x8*qr,const f32x16&negm,int r32,int hi){
  const char*kb=Kslot+hi*1024+r32*16;
  #pragma unroll
  for(int d0=0;d0<4;++d0){
    const bf16x8 b0=*reinterpret_cast<const bf16x8*>(kb+d0*2048);
    const bf16x8 b1=*reinterpret_cast<const bf16x8*>(kb+d0*2048+512);
    if(d0==0){p0=__builtin_amdgcn_mfma_f32_32x32x16_bf16(b0,qr[0],negm,0,0,0);p1=__builtin_amdgcn_mfma_f32_32x32x16_bf16(b1,qr[0],negm,0,0,0);}
    else{p0=__builtin_amdgcn_mfma_f32_32x32x16_bf16(b0,qr[d0],p0,0,0,0);p1=__builtin_amdgcn_mfma_f32_32x32x16_bf16(b1,qr[d0],p1,0,0,0);}}
}
typedef __attribute__((address_space(3))) const char* lds_cptr;
typedef short v4i16_t __attribute__((ext_vector_type(4)));
__device__ __forceinline__ void kload8(bf16x8*kf,lds_cptr kp){
  kf[0]=*(const __attribute__((address_space(3))) bf16x8*)(kp);      kf[1]=*(const __attribute__((address_space(3))) bf16x8*)(kp+512);
  kf[2]=*(const __attribute__((address_space(3))) bf16x8*)(kp+2048); kf[3]=*(const __attribute__((address_space(3))) bf16x8*)(kp+2560);
  kf[4]=*(const __attribute__((address_space(3))) bf16x8*)(kp+4096); kf[5]=*(const __attribute__((address_space(3))) bf16x8*)(kp+4608);
  kf[6]=*(const __attribute__((address_space(3))) bf16x8*)(kp+6144); kf[7]=*(const __attribute__((address_space(3))) bf16x8*)(kp+6656);
}
__device__ __forceinline__ void kload2(bf16x8*kf,lds_cptr kp,int j){ kf[2*j]=*(const __attribute__((address_space(3))) bf16x8*)(kp+j*2048); kf[2*j+1]=*(const __attribute__((address_space(3))) bf16x8*)(kp+j*2048+512); }
__device__ __forceinline__ s16x4 vtr(lds_cptr p){ return __builtin_bit_cast(s16x4,__builtin_amdgcn_ds_read_tr16_b64_v4i16((__attribute__((address_space(3))) v4i16_t*)p)); }
__device__ __forceinline__ float rowmax(const f32x16&p0,const f32x16&p1){
  float a=max3f(p0[0],p0[1],p1[0]),b=max3f(p0[2],p0[3],p1[1]);a=max3f(a,p1[2],p1[3]);
  #pragma unroll
  for(int r=4;r<16;r+=4){a=max3f(a,p0[r],p0[r+1]);b=max3f(b,p0[r+2],p0[r+3]);a=max3f(a,p1[r],p1[r+1]);b=max3f(b,p1[r+2],p1[r+3]);}
  const float m=max2f(a,b);
  auto rr=__builtin_amdgcn_permlane32_swap(__float_as_uint(m),__float_as_uint(m),false,false);
  return max2f(__uint_as_float(rr[0]),__uint_as_float(rr[1]));
}
__device__ __forceinline__ void pv(f32x16*o,int vb,bf16x8 pa0,bf16x8 pa1,bf16x8 pa2,bf16x8 pa3){
  #pragma unroll
  for(int d0=0;d0<2;++d0){s16x4 lo[4],hi[4];
    #pragma unroll
    for(int ks=0;ks<4;++ks){
      asm volatile("ds_read_b64_tr_b16 %0,%1 offset:%c2":"=&v"(lo[ks]):"v"(vb),"i"(d0*4096+ks*1024):"memory");
      asm volatile("ds_read_b64_tr_b16 %0,%1 offset:%c2":"=&v"(hi[ks]):"v"(vb),"i"(d0*4096+ks*1024+512):"memory");}
    asm volatile("s_waitcnt lgkmcnt(0)":::"memory");SBAR();
    #define PK(k) (bf16x8){lo[k][0],lo[k][1],lo[k][2],lo[k][3],hi[k][0],hi[k][1],hi[k][2],hi[k][3]}
    o[d0]=__builtin_amdgcn_mfma_f32_32x32x16_bf16(pa0,PK(0),o[d0],0,0,0);
    o[d0]=__builtin_amdgcn_mfma_f32_32x32x16_bf16(pa1,PK(1),o[d0],0,0,0);
    o[d0]=__builtin_amdgcn_mfma_f32_32x32x16_bf16(pa2,PK(2),o[d0],0,0,0);
    o[d0]=__builtin_amdgcn_mfma_f32_32x32x16_bf16(pa3,PK(3),o[d0],0,0,0);
    #undef PK
  }
}

#ifndef ATTN_STORE16
#define ATTN_STORE16(p,v) (*(u32x4*)(p)=(v))
#endif
template<int THRL> __device__ __forceinline__ void attn_unit(int b,int qcol,int kcol,int vcol,int ocol,int qb,const bf16*Q,const bf16*__restrict__ K,const bf16*__restrict__ V,bf16*O,char*shm){
  int tid_=threadIdx.x; asm volatile("":"+v"(tid_));
  const int tid=tid_,lane=tid&63,r32=lane&31,hi=lane>>5; const int wid=__builtin_amdgcn_readfirstlane(tid>>6);
  const long rowbase=(long)b*SEQ; const int q0=qb*QB;
  const bf16*Qw=Q+(rowbase+q0+wid*QBLK)*DM+qcol;
  const bf16*Kh=K+rowbase*DM+kcol,*Vh=V+rowbase*DM+vcol;
  const unsigned lds0=(unsigned)(uintptr_t)shm;
  float*wsf=(float*)(shm+LDS_WS)+wid*64;
  const bf16*ksrc=Kh+(long)lane*DM+wid*8;
  const bf16*vsrc=Vh+(long)(16*(wid&3)+(lane>>2))*DM+(wid>>2)*32+(lane&3)*8;
  const unsigned kdst=lds0+LDS_K+wid*1024, vdst=lds0+LDS_V+wid*1024;
  #define DMA_K(t,slot) glds16(ksrc+(long)(t)*KVBLK*DM,(unsigned)__builtin_amdgcn_readfirstlane(kdst+(slot)))
  #define DMA_V(t,slot) glds16(vsrc+(long)(t)*KVBLK*DM,(unsigned)__builtin_amdgcn_readfirstlane(vdst+(slot)))
  const int vb0=(int)(lds0+LDS_V)+((lane>>4)&1)*32+(lane&3)*8+(4*hi+((lane&15)>>2))*64;
  const char*Kbase=shm+LDS_K; bf16x8 kf[8];
  const lds_cptr shm3=(lds_cptr)shm; const lds_cptr kp0=shm3+LDS_K+hi*1024+r32*16; const lds_cptr vp0=shm3+LDS_V+((lane>>4)&1)*32+(lane&3)*8+(4*hi+((lane&15)>>2))*64;
  const int NT=(q0+QB)/KVBLK;
  DMA_K(0,0);DMA_V(0,0);DMA_K(1,SLOTB);
  bf16x8 qr[4];
  #pragma unroll
  for(int d0=0;d0<4;++d0)qr[d0]=*reinterpret_cast<const bf16x8*>(&Qw[(long)r32*DM+d0*16+hi*8]);
  float mhat=0.f,l_reg=0.f;f32x16 o[2];o[0]=f32x16{};o[1]=f32x16{};f32x16 negm=f32x16{};asm volatile("":"+v"(negm));
  const int qrel=wid*QBLK+r32;
  #define CMASK(P0,P1,t) do{int jb_=(t)-(NT-4); if(jb_>=0)cmask(P0,P1,jb_,qrel,hi);}while(0)
  bool resc=false;
  #define START(P0,P1) do{ const float rm=rowmax(P0,P1); resc=false; \
    { const float dl=rm; mhat=fadd_s(mhat,dl); \
      _Pragma("unroll") for(int r=0;r<16;++r){P0[r]=fsub_s(P0[r],dl);P1[r]=fsub_s(P1[r],dl);} \
      _Pragma("unroll") for(int r=0;r<16;++r)negm[r]=-mhat; asm volatile("":"+v"(negm)); } \
    _Pragma("unroll") for(int r=0;r<16;++r)P0[r]=__builtin_amdgcn_exp2f(P0[r]); }while(0)
  #define RESC() do{ if(resc){ asm volatile("s_waitcnt lgkmcnt(0)":::"memory"); \
      _Pragma("unroll") for(int d_=0;d_<2;++d_) _Pragma("unroll") for(int r=0;r<16;++r)o[d_][r]*=wsf[crow(r,hi)]; } }while(0)
  f32x16 pA0,pA1,pB0,pB1;
  int sl_prev=0,sl_cur=0,sl_next=SLOTB;
  #define ROT() do{sl_prev=sl_cur;sl_cur=sl_next;sl_next=(sl_next==(NSLOT-1)*SLOTB)?0:sl_next+SLOTB;}while(0)
  DMA_K(2,2*SLOTB);
  WAIT_BAR(3);
  qkt(pA0,pA1,Kbase,qr,negm,r32,hi);asm volatile("s_nop 15\n\ts_nop 7":"+v"(pA0),"+v"(pA1));CMASK(pA0,pA1,0);
  START(pA0,pA1);
  _Pragma("unroll") for(int r=0;r<16;++r)pA1[r]=__builtin_amdgcn_exp2f(pA1[r]);
  WAIT_BAR(0);
  DMA_K(3,0);DMA_V(1,SLOTB);
  ROT();
  kload8(kf,kp0+sl_cur);
  WAIT_BAR(2);
  s16x4 vlo[8],vhi[8]; u32x4 pw0,pw1,pw2,pw3;
  #define PKW(P,B) cvtpk_s(P[B],P[B+1])
  #define PAF(k) __builtin_bit_cast(bf16x8,pw##k)
  #define VFR(i) (bf16x8){vlo[i][0],vlo[i][1],vlo[i][2],vlo[i][3],vhi[i][0],vhi[i][1],vhi[i][2],vhi[i][3]}
  #define PIN(x) asm volatile("":"+v"(x))
  #define MX3(a,b,c) __builtin_fmaxf(__builtin_fmaxf((a),(b)),(c))
  #define GAPA(MF,A0,A1,A2,A3,W0,W1,PW) do{ MF; sacc+=A0; sacc+=A1; sacc+=A2; sacc+=A3; PIN(sacc); W0; W1; PIN(PW); SBAR(); }while(0)
  #define EX(v) __builtin_amdgcn_exp2f(v)
  #define GAPB(MF,X,B) do{ MF; X[B]=EX(X[B]); X[B+1]=EX(X[B+1]); X[B+2]=EX(X[B+2]); X[B+3]=EX(X[B+3]); PIN(X); SBAR(); }while(0)
  #define VRD(i) do{ vlo[i]=vtr(vp_+(((i)>>2)*4096+((i)&3)*1024)); vhi[i]=vtr(vp_+(((i)>>2)*4096+((i)&3)*1024+512)); }while(0)
  #define KRD(G,j) do{ if(G){ kload2(kf,kp0+sl_next,j); SBAR(); } }while(0)
  #define STEP(C0,C1,P0,P1,t,GK,GV,GL) do{ SBAR(); \
    const lds_cptr vp_=vp0+sl_prev; \
    VRD(0); SBAR(); float sacc=(P0[0]+P0[1]); \
    GAPA(C0=__builtin_amdgcn_mfma_f32_32x32x16_bf16(kf[0],qr[0],negm,0,0,0), P0[2],P0[3],P0[4],P0[5],     pw0[0]=PKW(P0,0), pw0[1]=PKW(P0,2), pw0); \
    VRD(4); SBAR(); GAPA(C1=__builtin_amdgcn_mfma_f32_32x32x16_bf16(kf[1],qr[0],negm,0,0,0), P0[6],P0[7],P0[8],P0[9],     pw0[2]=PKW(P0,4), pw0[3]=PKW(P0,6), pw0); \
    VRD(1); SBAR(); GAPA(C0=__builtin_amdgcn_mfma_f32_32x32x16_bf16(kf[2],qr[1],C0,0,0,0),   P0[10],P0[11],P0[12],P0[13], pw1[0]=PKW(P0,8), pw1[1]=PKW(P0,10), pw1); \
    VRD(5); SBAR(); GAPA(C1=__builtin_amdgcn_mfma_f32_32x32x16_bf16(kf[3],qr[1],C1,0,0,0),   P0[14],P0[15],P1[0],P1[1],   pw1[2]=PKW(P0,12),pw1[3]=PKW(P0,14), pw1); \
    VRD(2); SBAR(); GAPA(C0=__builtin_amdgcn_mfma_f32_32x32x16_bf16(kf[4],qr[2],C0,0,0,0),   P1[2],P1[3],P1[4],P1[5],     pw2[0]=PKW(P1,0), pw2[1]=PKW(P1,2), pw2); \
    VRD(6); SBAR(); GAPA(C1=__builtin_amdgcn_mfma_f32_32x32x16_bf16(kf[5],qr[2],C1,0,0,0),   P1[6],P1[7],P1[8],P1[9],     pw2[2]=PKW(P1,4), pw2[3]=PKW(P1,6), pw2); \
    VRD(3); SBAR(); GAPA(C0=__builtin_amdgcn_mfma_f32_32x32x16_bf16(kf[6],qr[3],C0,0,0,0),   P1[10],P1[11],P1[12],P1[13], pw3[0]=PKW(P1,8), pw3[1]=PKW(P1,10), pw3); \
    VRD(7); SBAR(); GAPA(C1=__builtin_amdgcn_mfma_f32_32x32x16_bf16(kf[7],qr[3],C1,0,0,0),   P1[14],P1[15],0.f,0.f,       pw3[2]=PKW(P1,12),pw3[3]=PKW(P1,14), pw3); \
    l_reg+=sacc; \
    if(GK){DMA_K((t)+3,sl_cur);} if(GV){DMA_V((t)+1,sl_next);} \
    CMASK(C0,C1,t); \
    { float a=MX3(C0[0],C0[1],C1[0]),b=MX3(C0[2],C0[3],C1[1]); a=MX3(a,C1[2],C1[3]); \
      _Pragma("unroll") for(int r=4;r<16;r+=4){a=MX3(a,C0[r],C0[r+1]);b=MX3(b,C0[r+2],C0[r+3]);a=MX3(a,C1[r],C1[r+1]);b=MX3(b,C1[r+2],C1[r+3]);} \
      float rm=__builtin_fmaxf(a,b); { auto rr=__builtin_amdgcn_permlane32_swap(__float_as_uint(rm),__float_as_uint(rm),false,false); rm=__builtin_fmaxf(__uint_as_float(rr[0]),__uint_as_float(rr[1])); } \
      resc=false; \
      if(__builtin_expect(__any(rm>(float)THRL),0)){ const float dl=__builtin_fmaxf(rm,0.f); mhat+=dl; \
        _Pragma("unroll") for(int r=0;r<16;++r){C0[r]-=dl;C1[r]-=dl;} \
        _Pragma("unroll") for(int r=0;r<16;++r)negm[r]=-mhat; asm volatile("":"+v"(negm)); \
        const float f=__builtin_amdgcn_exp2f(-dl); l_reg*=f; if(hi==0)wsf[r32]=f; resc=true; } } \
    SBAR(); \
    GAPB(o[0]=__builtin_amdgcn_mfma_f32_32x32x16_bf16(PAF(0),VFR(0),o[0],0,0,0), C0,0); \
    GAPB(o[1]=__builtin_amdgcn_mfma_f32_32x32x16_bf16(PAF(0),VFR(4),o[1],0,0,0), C0,4); \
    KRD(GL,0); GAPB(o[0]=__builtin_amdgcn_mfma_f32_32x32x16_bf16(PAF(1),VFR(1),o[0],0,0,0), C0,8); \
    KRD(GL,1); GAPB(o[1]=__builtin_amdgcn_mfma_f32_32x32x16_bf16(PAF(1),VFR(5),o[1],0,0,0), C0,12); \
    KRD(GL,2); GAPB(o[0]=__builtin_amdgcn_mfma_f32_32x32x16_bf16(PAF(2),VFR(2),o[0],0,0,0), C1,0); \
    KRD(GL,3); GAPB(o[1]=__builtin_amdgcn_mfma_f32_32x32x16_bf16(PAF(2),VFR(6),o[1],0,0,0), C1,4); \
    GAPB(o[0]=__builtin_amdgcn_mfma_f32_32x32x16_bf16(PAF(3),VFR(3),o[0],0,0,0), C1,8); \
    GAPB(o[1]=__builtin_amdgcn_mfma_f32_32x32x16_bf16(PAF(3),VFR(7),o[1],0,0,0), C1,12); \
    }while(0)
  int t=1;
  #undef CMASK
  #define CMASK(P0,P1,t) do{}while(0)
  for(;t+5<NT;t+=2){
    STEP(pB0,pB1,pA0,pA1,t,true,true,true);     WAIT_BAR(2); RESC(); ROT();
    STEP(pA0,pA1,pB0,pB1,t+1,true,true,true);   WAIT_BAR(2); RESC(); ROT();
  }
  #undef CMASK
  #define CMASK(P0,P1,t) do{int jb_=(t)-(NT-4); if(jb_>=0)cmask(P0,P1,jb_,qrel,hi);}while(0)
  #define ENDW(tt) do{ if((tt)+3<NT){WAIT_BAR(2);} else if((tt)+2<NT){WAIT_BAR(1);} else {WAIT_BAR(0);} }while(0)
  for(;t+1<NT;t+=2){
    STEP(pB0,pB1,pA0,pA1,t,(t+3<NT),(t+1<NT),(t+1<NT));       ENDW(t);   RESC(); ROT();
    STEP(pA0,pA1,pB0,pB1,t+1,(t+4<NT),(t+2<NT),(t+2<NT));     ENDW(t+1); RESC(); ROT();
  }
  STEP(pB0,pB1,pA0,pA1,NT-1,false,false,false); RESC();
  { float sacc=pB0[0]+pB0[1]; _Pragma("unroll") for(int r=2;r<16;++r)sacc+=pB0[r]; _Pragma("unroll") for(int r=0;r<16;++r)sacc+=pB1[r]; l_reg+=sacc;
    pw0=(u32x4){PKW(pB0,0),PKW(pB0,2),PKW(pB0,4),PKW(pB0,6)};pw1=(u32x4){PKW(pB0,8),PKW(pB0,10),PKW(pB0,12),PKW(pB0,14)};pw2=(u32x4){PKW(pB1,0),PKW(pB1,2),PKW(pB1,4),PKW(pB1,6)};pw3=(u32x4){PKW(pB1,8),PKW(pB1,10),PKW(pB1,12),PKW(pB1,14)};
    SBAR(); pv(o,vb0+sl_cur,PAF(0),PAF(1),PAF(2),PAF(3)); }
  #undef PKW
  #undef PAF
  #undef VFR
  #undef PIN
  #undef MX3
  #undef GAPA
  #undef GAPB
  #undef EX
  #undef VRD
  #undef KRD
  #undef STEP
  #undef ENDW
  {auto rr=__builtin_amdgcn_permlane32_swap(__float_as_uint(l_reg),__float_as_uint(l_reg),false,false);l_reg=__uint_as_float(rr[0])+__uint_as_float(rr[1]);}
  if(hi==0)wsf[32+r32]=l_reg;asm volatile("s_waitcnt lgkmcnt(0)":::"memory");
  float rli[16];
  #pragma unroll
  for(int r=0;r<16;++r)rli[r]=__builtin_amdgcn_rcpf(wsf[32+crow(r,hi)]);
  bf16*Ow=O+(rowbase+q0+wid*QBLK)*DMO+ocol;
  { bf16*stg=(bf16*)(shm+LDS_OST)+wid*2048;
    #pragma unroll
    for(int r=0;r<16;++r){const int orow=crow(r,hi);
      #pragma unroll
      for(int d0=0;d0<2;++d0)stg[orow*64+d0*32+r32]=__float2bfloat16(o[d0][r]*rli[r]);}
    asm volatile("s_waitcnt lgkmcnt(0)":::"memory");
    #pragma unroll
    for(int i=0;i<4;++i){const int row=i*8+(lane>>3),ch=lane&7; const u32x4 v=*(const u32x4*)(stg+row*64+ch*8); ATTN_STORE16(Ow+(long)row*DMO+ch*8,v);} }
  asm volatile("s_waitcnt lgkmcnt(0)\n\ts_barrier":::"memory");
  #undef DMA_K
  #undef DMA_V
  #undef CMASK
  #undef START
  #undef RESC
  #undef ROT
}
constexpr int ATTN_LDS_BYTES=LDS_BYTES;
template<int THRL=8> __device__ __forceinline__ void attn_phase(char*lds,const bf16*U,bf16*Oc,int vcu){
  const int bhc=vcu>>3,s=vcu&7,b=bhc>>3,h=(bhc>>1)&3,c=bhc&1;
  _Pragma("unroll 1") for(int i=0;i<4;++i){ const int half=i>>1,qb=(i&1)?15-s:s;
    attn_unit<THRL>(b,h*128+c*64,512+h*128+c*64,1024+h*128+half*64,h*128+half*64,qb,U,U,U,Oc+(long)c*16384*DMO,lds); }
}
#undef SBAR
#undef WAIT_BAR
}

namespace gla {
constexpr int GP = 72;
constexpr int L_BC = 0, L_VT = 16384, L_QI = 34816, L_KI = 44032, L_ATT = 53248, L_OF = 62464, OFP = 132;
__device__ __forceinline__ bf16x8 frag(const LAS unsigned char* base, int row, int k0) { return *(const LAS bf16x8*)(base + (row * GP + k0) * 2); }
struct LdState { f32x4 g0, g1; unsigned vw[8]; unsigned kw[4]; };
__device__ __forceinline__ void ld_common(f32x4& g0, f32x4& g1, unsigned (&vw)[8], const float* LOGA, const bf16_t* Ugla, size_t row0, int h, int tid) {
    const float* gp = LOGA + (row0 + (tid >> 3)) * 256 + h * 64 + (tid & 7) * 8; g0 = *(const f32x4*)gp; g1 = *(const f32x4*)(gp + 4);
    const bf16_t* vp = Ugla + (row0 + (tid >> 7) * 16) * 1536 + 512 + h * 128 + (tid & 127);
#pragma unroll
    for (int j = 0; j < 8; ++j) vw[j] = (unsigned)vp[(size_t)(2 * j) * 1536] | ((unsigned)vp[(size_t)(2 * j + 1) * 1536] << 16);
}
__device__ __forceinline__ void ld_state(LdState& L, const float* LOGA, const bf16_t* Ugla, size_t row0, int h, int tid) {
    ld_common(L.g0, L.g1, L.vw, LOGA, Ugla, row0, h, tid);
    const bf16_t* kp = Ugla + (row0 + (tid >> 6) * 8) * 1536 + 256 + h * 64 + (tid & 63);
#pragma unroll
    for (int j = 0; j < 4; ++j) L.kw[j] = (unsigned)kp[(size_t)(2 * j) * 1536] | ((unsigned)kp[(size_t)(2 * j + 1) * 1536] << 16);
}
__device__ __forceinline__ void stage_common(LAS unsigned char* lds, const f32x4& g0, const f32x4& g1, const unsigned (&vw)[8], int tid) {
    LAS float* Bc = (LAS float*)(lds + L_BC);
    *(LAS f32x4*)(Bc + (tid >> 3) * 64 + (tid & 7) * 8) = g0; *(LAS f32x4*)(Bc + (tid >> 3) * 64 + (tid & 7) * 8 + 4) = g1;
    LAS u32x4* dst = (LAS u32x4*)(lds + L_VT + ((tid & 127) * GP + (tid >> 7) * 16) * 2);
    dst[0] = (u32x4){vw[0], vw[1], vw[2], vw[3]}; dst[1] = (u32x4){vw[4], vw[5], vw[6], vw[7]};
}
__device__ __forceinline__ void cumsum_inplace(LAS unsigned char* lds, int lane, int wave) {
    LAS float* Bc = (LAS float*)(lds + L_BC);
    if (wave == 0) { float acc = 0.f;
#pragma unroll 16
        for (int s = 0; s < 64; ++s) { acc += Bc[s * 64 + lane]; Bc[s * 64 + lane] = acc; } }
}
__device__ __forceinline__ void chunk_state4(LAS unsigned char* lds, int b, int n, const float* LOGA, const bf16_t* Ugla, float* SCt, float* DEC, int tid, int lane, int wave) {
    const size_t row0 = (size_t)b * SEQ + n * 64;
    LAS float* Bc = (LAS float*)(lds + L_BC);
    LdState cur; ld_state(cur, LOGA, Ugla, row0, 0, tid);
#pragma unroll 1
    for (int h = 0; h < 4; ++h) {
        const int q = ((b * 4 + h) << 6) + n;
        stage_common(lds, cur.g0, cur.g1, cur.vw, tid);
        __syncthreads();
        cumsum_inplace(lds, lane, wave);
        __syncthreads();
        { const int k = tid & 63, sg = tid >> 6; const float bl = Bc[63 * 64 + k]; float f[8];
#pragma unroll
            for (int j = 0; j < 4; ++j) { f[2 * j] = lo_bf(cur.kw[j]) * __expf(bl - Bc[(sg * 8 + 2 * j) * 64 + k]); f[2 * j + 1] = hi_bf(cur.kw[j]) * __expf(bl - Bc[(sg * 8 + 2 * j + 1) * 64 + k]); }
            *(LAS u32x4*)(lds + L_QI + (k * GP + sg * 8) * 2) = (u32x4){pk2(f[0], f[1]), pk2(f[2], f[3]), pk2(f[4], f[5]), pk2(f[6], f[7])};
            if (tid < 64) DEC[(size_t)q * 64 + tid] = __expf(bl); }
        LdState nxt = cur; if (h < 3) ld_state(nxt, LOGA, Ugla, row0, h + 1, tid);
        __syncthreads();
        { const int fr = lane & 15, fq = lane >> 4, mt = wave >> 1;
#pragma unroll
            for (int j = 0; j < 4; ++j) { const int nt = (wave & 1) * 4 + j; f32x4 acc = {0.f, 0.f, 0.f, 0.f};
#pragma unroll
                for (int ks = 0; ks < 2; ++ks) acc = __builtin_amdgcn_mfma_f32_16x16x32_bf16(frag(lds + L_QI, 16 * mt + fr, 32 * ks + 8 * fq), frag(lds + L_VT, 16 * nt + fr, 32 * ks + 8 * fq), acc, 0, 0, 0);
                *(f32x4*)(SCt + (size_t)q * 8192 + (16 * nt + fr) * 64 + 16 * mt + 4 * fq) = acc; } }
        __syncthreads();
        cur = nxt;
    }
}
struct LdOut { f32x4 g0, g1; unsigned vw[8]; u32x4 qw, kw, r0, r1; bf16x8 sp[4][2]; };
__device__ __forceinline__ void ld_out(LdOut& L, const float* LOGA, const bf16_t* Ugla, const bf16_t* SPt, size_t row0, int h, int q, int tid, int lane, int wave) {
    ld_common(L.g0, L.g1, L.vw, LOGA, Ugla, row0, h, tid);
    const bf16_t* rp = Ugla + (row0 + (tid >> 3)) * 1536 + h * 64 + (tid & 7) * 8; L.qw = *(const u32x4*)rp; L.kw = *(const u32x4*)(rp + 256);
    const bf16_t* gp = Ugla + (row0 + (tid >> 3)) * 1536 + 1024 + h * 128 + (tid & 7) * 16; L.r0 = *(const u32x4*)gp; L.r1 = *(const u32x4*)(gp + 8);
    const int fr = lane & 15, fq = lane >> 4;
#pragma unroll
    for (int j = 0; j < 4; ++j)
#pragma unroll
        for (int ks = 0; ks < 2; ++ks) L.sp[j][ks] = *(const bf16x8*)(SPt + (size_t)q * 8192 + (16 * ((wave & 1) * 4 + j) + fr) * 64 + 32 * ks + 8 * fq);
}
__device__ __forceinline__ void chunk_out4(LAS unsigned char* lds, int b, int n, const float* LOGA, const bf16_t* Ugla, const bf16_t* SPt, const float* gog, bf16_t* OA, int tid, int lane, int wave) {
    const size_t row0 = (size_t)b * SEQ + n * 64;
    LAS float* Bc = (LAS float*)(lds + L_BC); LAS float* Of = (LAS float*)(lds + L_OF);
    const int fr = lane & 15, fq = lane >> 4;
    LdOut cur; ld_out(cur, LOGA, Ugla, SPt, row0, 0, ((b * 4) << 6) + n, tid, lane, wave);
#pragma unroll 1
    for (int h = 0; h < 4; ++h) {
        stage_common(lds, cur.g0, cur.g1, cur.vw, tid);
        __syncthreads();
        cumsum_inplace(lds, lane, wave);
        __syncthreads();
        { const int s = tid >> 3, k0 = (tid & 7) * 8; float qf[8], kf[8];
            qf[0] = lo_bf(cur.qw.x); qf[1] = hi_bf(cur.qw.x); qf[2] = lo_bf(cur.qw.y); qf[3] = hi_bf(cur.qw.y); qf[4] = lo_bf(cur.qw.z); qf[5] = hi_bf(cur.qw.z); qf[6] = lo_bf(cur.qw.w); qf[7] = hi_bf(cur.qw.w);
            kf[0] = lo_bf(cur.kw.x); kf[1] = hi_bf(cur.kw.x); kf[2] = lo_bf(cur.kw.y); kf[3] = hi_bf(cur.kw.y); kf[4] = lo_bf(cur.kw.z); kf[5] = hi_bf(cur.kw.z); kf[6] = lo_bf(cur.kw.w); kf[7] = hi_bf(cur.kw.w);
#pragma unroll
            for (int e = 0; e < 8; ++e) { const float bv = Bc[s * 64 + k0 + e]; qf[e] *= 0.125f * __expf(bv); kf[e] *= __expf(-bv); }
            *(LAS u32x4*)(lds + L_QI + (s * GP + k0) * 2) = (u32x4){pk2(qf[0], qf[1]), pk2(qf[2], qf[3]), pk2(qf[4], qf[5]), pk2(qf[6], qf[7])};
            *(LAS u32x4*)(lds + L_KI + (s * GP + k0) * 2) = (u32x4){pk2(kf[0], kf[1]), pk2(kf[2], kf[3]), pk2(kf[4], kf[5]), pk2(kf[6], kf[7])}; }
        __syncthreads();
#pragma unroll
        for (int j = 0; j < 2; ++j) { const int t = 2 * wave + j, mt = t >> 2, nt = t & 3; f32x4 acc = {0.f, 0.f, 0.f, 0.f};
#pragma unroll
            for (int ks = 0; ks < 2; ++ks) acc = __builtin_amdgcn_mfma_f32_16x16x32_bf16(frag(lds + L_QI, 16 * mt + fr, 32 * ks + 8 * fq), frag(lds + L_KI, 16 * nt + fr, 32 * ks + 8 * fq), acc, 0, 0, 0);
            LAS bf16_t* ap = (LAS bf16_t*)(lds + L_ATT); const int sc = 16 * nt + fr;
#pragma unroll
            for (int r = 0; r < 4; ++r) { const int c = 16 * mt + 4 * fq + r; ap[c * GP + sc] = (bf16_t)f2bf(sc <= c ? acc[r] : 0.f); } }
        __syncthreads();
        { const int mt = wave >> 1;
#pragma unroll
            for (int j = 0; j < 4; ++j) { const int nt = (wave & 1) * 4 + j; f32x4 acc = {0.f, 0.f, 0.f, 0.f};
#pragma unroll
                for (int ks = 0; ks < 2; ++ks) { acc = __builtin_amdgcn_mfma_f32_16x16x32_bf16(frag(lds + L_ATT, 16 * mt + fr, 32 * ks + 8 * fq), frag(lds + L_VT, 16 * nt + fr, 32 * ks + 8 * fq), acc, 0, 0, 0);
                    acc = __builtin_amdgcn_mfma_f32_16x16x32_bf16(frag(lds + L_QI, 16 * mt + fr, 32 * ks + 8 * fq), cur.sp[j][ks], acc, 0, 0, 0); }
#pragma unroll
                for (int r = 0; r < 4; ++r) Of[(16 * mt + 4 * fq + r) * OFP + 16 * nt + fr] = acc[r]; } }
        const u32x4 r0 = cur.r0, r1 = cur.r1;
        if (h < 3) ld_out(cur, LOGA, Ugla, SPt, row0, h + 1, ((b * 4 + h + 1) << 6) + n, tid, lane, wave);
        __syncthreads();
        { const int c = tid >> 3, v0 = (tid & 7) * 16; float o[16]; float ss = 0.f;
#pragma unroll
            for (int e = 0; e < 16; e += 4) { const f32x4 t4 = *(const LAS f32x4*)(Of + c * OFP + v0 + e); o[e] = t4.x; o[e + 1] = t4.y; o[e + 2] = t4.z; o[e + 3] = t4.w; ss += (t4.x * t4.x + t4.y * t4.y) + (t4.z * t4.z + t4.w * t4.w); }
            ss += __shfl_xor(ss, 1); ss += __shfl_xor(ss, 2); ss += __shfl_xor(ss, 4);
            const float rstd = rsqrtf(ss * (1.f / 128.f) + 1e-6f);
            const unsigned rw[8] = {r0.x, r0.y, r0.z, r0.w, r1.x, r1.y, r1.z, r1.w}; unsigned ow[8];
#pragma unroll
            for (int e = 0; e < 8; ++e) { const float a = o[2 * e] * rstd * gog[v0 + 2 * e] * siluf_(lo_bf(rw[e])), b2 = o[2 * e + 1] * rstd * gog[v0 + 2 * e + 1] * siluf_(hi_bf(rw[e])); ow[e] = pk2(a, b2); }
            bf16_t* op = OA + (row0 + c) * 512 + h * 128 + v0; *(u32x4*)op = (u32x4){ow[0], ow[1], ow[2], ow[3]}; *(u32x4*)(op + 8) = (u32x4){ow[4], ow[5], ow[6], ow[7]}; }
    }
}
}

#define XB_TMO      128
#define XB_XCNT(j)  (256  + 64 * (j))
#define XB_XSUB(j)  (1280 + 64 * (j))
#define XB_XGEN(j)  (2304 + 64 * (j))
#define XB_TOP      3328
#define XB_TOPGEN   3392
#define XCD_BAR_WORDS 3456
#define XB_SPIN_CAP (1u << 18)
__device__ __forceinline__ unsigned xb_ld(unsigned* p)              { return __hip_atomic_load(p, __ATOMIC_RELAXED, __HIP_MEMORY_SCOPE_AGENT); }
__device__ __forceinline__ unsigned xb_add(unsigned* p, unsigned v) { return __hip_atomic_fetch_add(p, v, __ATOMIC_RELAXED, __HIP_MEMORY_SCOPE_AGENT); }
__device__ __forceinline__ unsigned xb_xcc_id() { return (unsigned)__builtin_amdgcn_s_getreg((3 << 11) | 20) & 0xFu; }
#define XB_SPIN(cond, bar) do { unsigned _sp = 0; while (cond) { __builtin_amdgcn_s_sleep(1); \
    if ((++_sp & 255u) == 0u) { if (xb_ld(&(bar)[XB_TMO])) break; if (_sp > XB_SPIN_CAP) { atomicAdd(&(bar)[XB_TMO], 1u); break; } } } } while (0)
struct XcdBarrier { unsigned* bar; unsigned x; volatile LAS unsigned* st; };
__device__ __forceinline__ XcdBarrier xcd_barrier_post(unsigned* bar, volatile LAS unsigned* st) {
    XcdBarrier b; b.bar = bar; b.x = xb_xcc_id(); b.st = st;
    if (threadIdx.x == 0) (void)xb_add(&bar[XB_XCNT(b.x)], 1u);
    return b;
}
__device__ __forceinline__ void xcd_barrier_complete(unsigned* bar, unsigned x, unsigned& nloc, unsigned& nx) {
    const unsigned G = gridDim.x * gridDim.y * gridDim.z;
    unsigned sum, cnt, mine, sp = 0u;
    for (;;) {
        sum = 0u; cnt = 0u; mine = 0u;
#pragma unroll
        for (unsigned j = 0; j < 16; ++j) { const unsigned c = xb_ld(&bar[XB_XCNT(j)]); sum += c; cnt += (c > 0u) ? 1u : 0u; mine = (j == x) ? c : mine; }
        if (sum == G) break;
        __builtin_amdgcn_s_sleep(1);
        if ((++sp & 255u) == 0u) { if (xb_ld(&bar[XB_TMO])) break; if (sp > XB_SPIN_CAP) { atomicAdd(&bar[XB_TMO], 1u); break; } }
    }
    nloc = mine > 0u ? mine : 1u; nx = cnt > 0u ? cnt : 1u;
}
__device__ __forceinline__ void xcd_barrier(const XcdBarrier& b) {
    asm volatile("s_waitcnt vmcnt(0)" ::: "memory");
    __syncthreads();
    if (threadIdx.x == 0) {
        unsigned* bar = b.bar;
        __builtin_amdgcn_s_waitcnt(0);
        unsigned nloc = b.st[0], nx = b.st[1];
        if (nloc == 0u) { xcd_barrier_complete(bar, b.x, nloc, nx); b.st[0] = nloc; b.st[1] = nx; }
        const unsigned old = xb_add(&bar[XB_XSUB(b.x)], 1u);
        const unsigned gen = old / nloc;
        if (old + 1u == (gen + 1u) * nloc) {
            __builtin_amdgcn_fence(__ATOMIC_RELEASE, "agent");
            asm volatile("s_waitcnt vmcnt(0)" ::: "memory");
            const unsigned og = xb_add(&bar[XB_TOP], 1u);
            const unsigned tg = og / nx;
            if (og + 1u == (tg + 1u) * nx) xb_add(&bar[XB_TOPGEN], 1u);
            else XB_SPIN(xb_ld(&bar[XB_TOPGEN]) == tg, bar);
            __builtin_amdgcn_fence(__ATOMIC_ACQUIRE, "agent");
            xb_add(&bar[XB_XGEN(b.x)], 1u);
            asm volatile("s_waitcnt vmcnt(0)" ::: "memory");
        } else {
            XB_SPIN(xb_ld(&bar[XB_XGEN(b.x)]) == gen, bar);
            __builtin_amdgcn_fence(__ATOMIC_ACQUIRE, "agent");
            asm volatile("s_waitcnt vmcnt(0)" ::: "memory");
        }
    }
    __syncthreads();
}

struct Args { const void* in[28]; float* out; unsigned char* ws; int ph_lo, ph_hi; };
enum { I_X = 0, I_C, I_POS, I_ADAW, I_ADAB, I_N1G, I_N2G, I_WIN, I_AUP, I_AB, I_GOG, I_DQG, I_DKG, I_LQ1, I_LK1, I_LQ2, I_LK2, I_DOG, I_WBA, I_WBB, I_WOUT, I_RGW, I_RGB, I_REW, I_REB, I_EW1, I_EW3, I_EW2 };

struct TrJob { const float* src; bf16_t* dst; int ldn, kdst; };
__device__ __forceinline__ void tr_load(f32x4 (&v)[8], const TrJob& J, int lane) {
#pragma unroll
    for (int i = 0; i < 8; ++i) v[i] = *(const f32x4*)(J.src + (size_t)(8 * i + (lane >> 3)) * J.ldn + (lane & 7) * 4);
}
__device__ __forceinline__ void tr_store(const f32x4 (&v)[8], const TrJob& J, LAS float* scr, int lane) {
#pragma unroll
    for (int i = 0; i < 8; ++i) { LAS float* p = scr + (8 * i + (lane >> 3)) * 33 + (lane & 7) * 4; p[0] = v[i].x; p[1] = v[i].y; p[2] = v[i].z; p[3] = v[i].w; }
    LDS_WAIT(); asm volatile("" ::: "memory");
    const int c = lane & 7;
#pragma unroll
    for (int j = 0; j < 4; ++j) { const int n = (lane >> 3) + 8 * j; const LAS float* sp = scr + (8 * c) * 33 + n;
        u32x4 o; o.x = pk2(sp[0 * 33], sp[1 * 33]); o.y = pk2(sp[2 * 33], sp[3 * 33]); o.z = pk2(sp[4 * 33], sp[5 * 33]); o.w = pk2(sp[6 * 33], sp[7 * 33]);
        *(u32x4*)(J.dst + (size_t)n * J.kdst + 8 * c) = o; }
    LDS_WAIT(); asm volatile("" ::: "memory");
}
template <class Dec> __device__ __forceinline__ void tr_run(int first, int total, int stride, const Dec& dec, LAS float* scr, int lane) {
    int it = first; if (it >= total) return;
    TrJob J0 = dec(it), J1 = J0; f32x4 a[8], b[8];
    tr_load(a, J0, lane);
    const bool has1 = it + stride < total; if (has1) { J1 = dec(it + stride); tr_load(b, J1, lane); }
    for (;;) {
        const int n2 = it + 2 * stride; const bool more2 = n2 < total; TrJob J2 = J1; f32x4 c[8];
        if (more2) { J2 = dec(n2); tr_load(c, J2, lane); }
        tr_store(a, J0, scr, lane);
        if (it + stride >= total) break;
#pragma unroll
        for (int i = 0; i < 8; ++i) { a[i] = b[i]; b[i] = c[i]; }
        J0 = J1; J1 = J2; it += stride;
    }
}
struct DecDense { const float *w_in, *wa, *wb, *wo; bf16_t *Win_t, *Wa_t, *Wb_t, *Wout_t;
    __device__ __forceinline__ TrJob operator()(int r) const {
        if (r < 2560) { const int kb = r / 160, nb = r % 160, n0 = 32 * nb, ns = n0 < 1536 ? n0 : n0 + 16; return TrJob{w_in + (size_t)(64 * kb) * DIN + ns, Win_t + (size_t)n0 * D + 64 * kb, DIN, D}; }
        r -= 2560;
        if (r < 256) { const int kb = r / 32, nb = r % 32; return TrJob{wa + (size_t)(64 * kb) * D + 32 * nb, Wa_t + (size_t)(32 * nb) * 512 + 64 * kb, D, 512}; }
        r -= 256;
        if (r < 256) { const int kb = r / 32, nb = r % 32; return TrJob{wb + (size_t)(64 * kb) * D + 32 * nb, Wb_t + (size_t)(32 * nb) * 512 + 64 * kb, D, 512}; }
        r -= 256;
        { const int kb = r / 32, nb = r % 32; return TrJob{wo + (size_t)(64 * kb) * D + 32 * nb, Wout_t + (size_t)(32 * nb) * D + 64 * kb, D, D}; }
    } };
struct DecExp { const float *w1, *w3, *w2; bf16_t *W13_t, *W2_t;
    __device__ __forceinline__ TrJob operator()(int it) const {
        const int e = it / 768, r = it % 768;
        if (r < 512) { const int kb = r >> 5, nb = r & 31, r0 = 32 * nb, pn = r0 >> 8, half = (r0 >> 7) & 1, jj = r0 & 127;
            const float* p1 = w1; const float* p3 = w3; asm volatile("" : "+s"(p1), "+s"(p3));
            return TrJob{(half ? p3 : p1) + (size_t)e * D * DEXP + (size_t)(64 * kb) * DEXP + 128 * pn + jj, W13_t + (size_t)e * 1024 * 1024 + (size_t)r0 * D + 64 * kb, DEXP, D}; }
        const int r2 = r - 512, kb = r2 >> 5, nb = r2 & 31;
        return TrJob{w2 + (size_t)e * DEXP * D + (size_t)(64 * kb) * D + 32 * nb, W2_t + (size_t)e * 1024 * 512 + (size_t)(32 * nb) * DEXP + 64 * kb, D, DEXP};
    } };

#define PHASE_LOCALS int tid_l = threadIdx.x; asm volatile("" : "+v"(tid_l)); int cb_l = blockIdx.x; asm volatile("" : "+s"(cb_l)); \
    const int tid = tid_l, lane = tid & 63, wave = __builtin_amdgcn_readfirstlane(tid >> 6), cb = cb_l, G = 256, gw = cb * NWAVES + wave, NGW = G * NWAVES; (void)lane; (void)gw; (void)NGW; (void)G;
template <int IDX> __device__ __forceinline__ const void* ldarg() {
    unsigned long long p;
    asm volatile("s_load_dwordx2 %0, %1, %2\n\ts_waitcnt lgkmcnt(0)" : "=s"(p) : "s"(__builtin_amdgcn_kernarg_segment_ptr()), "n"(IDX * 8) : "memory");
    return (const void*)(GAS const void*)p;
}
#define ARG_IN(i) (ldarg<(i)>())
#define ARG_WS ((unsigned char*)ldarg<29>())
#define XIN ((const float*)ARG_IN(I_X))
#define OUTP ((float*)ldarg<28>())
#define P_MODP ((float*)(ARG_WS + WS_MODP))
#define P_MODF ((float*)(ARG_WS + WS_MODF))
#define P_ALR ((float*)(ARG_WS + WS_ALR))
#define P_WIN ((bf16_t*)(ARG_WS + WS_WIN))
#define P_WA ((bf16_t*)(ARG_WS + WS_WA))
#define P_WB ((bf16_t*)(ARG_WS + WS_WB))
#define P_WOUT ((bf16_t*)(ARG_WS + WS_WOUT))
#define P_XN ((bf16_t*)(ARG_WS + WS_XN))
#define P_LOGA ((float*)(ARG_WS + WS_LOGA))
#define P_SCT ((float*)(ARG_WS + WS_SCT))
#define P_SPT ((bf16_t*)(ARG_WS + WS_SPT))
#define P_OC ((bf16_t*)(ARG_WS + WS_OC))
#define P_DEC ((float*)(ARG_WS + WS_DEC))
#define P_WRT ((float*)(ARG_WS + WS_WRT))
#define P_LRT ((float*)(ARG_WS + WS_LRT))
#define P_OB ((bf16_t*)(ARG_WS + WS_OB))
#define P_OA ((bf16_t*)(ARG_WS + WS_OA))
#define P_XS ((bf16_t*)(ARG_WS + WS_XS))
#define P_Y ((bf16_t*)(ARG_WS + WS_Y))
#define P_UGLA ((bf16_t*)(ARG_WS + WS_UGLA))
#define P_UDIFF ((bf16_t*)(ARG_WS + WS_UDIFF))
#define P_UGATE ((bf16_t*)(ARG_WS + WS_UGATE))
#define P_M1 ((bf16_t*)(ARG_WS + WS_M1))
#define P_MERGED ((bf16_t*)(ARG_WS + WS_MERGED))
#define P_H2 ((bf16_t*)(ARG_WS + WS_H2))
#define P_W13 ((bf16_t*)(ARG_WS + WS_W13))
#define P_W2 ((bf16_t*)(ARG_WS + WS_W2))
#define P_HMID ((bf16_t*)(ARG_WS + WS_HMID))
#define P_TOKE ((int*)(ARG_WS + WS_ROUTE + RT_TOKE))
#define P_TOKW ((float*)(ARG_WS + WS_ROUTE + RT_TOKW))
#define P_RANK ((int*)(ARG_WS + WS_ROUTE + RT_RANK))
#define P_SLOT ((int*)(ARG_WS + WS_ROUTE + RT_SLOT))
#define P_BLKCNT ((int*)(ARG_WS + WS_ROUTE + RT_BLKCNT))
#define P_TILEE ((int*)(ARG_WS + WS_ROUTE + RT_TILEE))
#define P_NT ((int*)(ARG_WS + WS_ROUTE + RT_NT))
template <int LO, int HI>
__global__ void __launch_bounds__(NTHR, 2) mk_fwd(Args args) {
    extern __shared__ __attribute__((aligned(16))) unsigned char lds_raw[];
    LAS unsigned char* lds = (LAS unsigned char*)lds_raw;
    volatile LAS unsigned* MISC = (volatile LAS unsigned*)(lds + MISC_OFF);
    unsigned* ctl = (unsigned*)(ARG_WS + WS_CTL);
    for (int u = threadIdx.x; u < (LDS_BYTES - LDSCTL_OFF) / 4; u += NTHR) ((LAS unsigned*)(lds + LDSCTL_OFF))[u] = 0u;
    __syncthreads();
    constexpr int lo = LO, hi = HI;
    XcdBarrier bar; bar.bar = ctl + CW_BAR; bar.x = 0; bar.st = nullptr;
    if constexpr (hi - lo > 1) bar = xcd_barrier_post(ctl + CW_BAR, MISC + 8);
#define IN(k) (lo <= (k) && (k) < hi)
#define SEAM(k) do { if constexpr (IN(k) && IN((k) + 1)) xcd_barrier(bar); } while (0)

    if constexpr (IN(0)) {
        asm volatile("; PHASE_BEGIN 0" ::: "memory");
        PHASE_LOCALS
        float* modp = P_MODP; bf16_t* Win_t = P_WIN; bf16_t* Wa_t = P_WA; bf16_t* Wb_t = P_WB; bf16_t* Wout_t = P_WOUT;
        const float* cvec = (const float*)ARG_IN(I_C); const float* ada_w = (const float*)ARG_IN(I_ADAW);
        const float* w_in = (const float*)ARG_IN(I_WIN);
        LAS float* scr = (LAS float*)(lds + wave * 16384);
        for (int r = gw; r < 768; r += NGW) {
            const int jc = r % 24, kc = r / 24, j = jc * 256 + lane * 4;
            f32x4 a0 = {0, 0, 0, 0}, a1 = a0, a2 = a0, a3 = a0;
#pragma unroll 8
            for (int kk = 0; kk < 32; ++kk) { const int k = kc * 32 + kk; const f32x4 w = *(const f32x4*)(ada_w + (size_t)k * NMOD + j);
                a0 += siluf_(cvec[k]) * w; a1 += siluf_(cvec[D + k]) * w; a2 += siluf_(cvec[2 * D + k]) * w; a3 += siluf_(cvec[3 * D + k]) * w; }
            *(f32x4*)(modp + (size_t)(kc * 4 + 0) * NMOD + j) = a0; *(f32x4*)(modp + (size_t)(kc * 4 + 1) * NMOD + j) = a1;
            *(f32x4*)(modp + (size_t)(kc * 4 + 2) * NMOD + j) = a2; *(f32x4*)(modp + (size_t)(kc * 4 + 3) * NMOD + j) = a3; }
        { const float* Wrg = (const float*)ARG_IN(I_RGW); const float* Wre = (const float*)ARG_IN(I_REW); float* WrT = P_WRT;
          for (int idx = cb * NTHR + tid; idx < 36 * D; idx += G * NTHR) { const int j = idx >> 10, k = idx & 1023; WrT[idx] = j < 4 ? Wrg[k * 4 + j] : Wre[k * 32 + (j - 4)]; } }
        { float* LrT = P_LRT;
          for (int idx = cb * NTHR + tid; idx < 16 * D; idx += G * NTHR) { const int r = idx >> 10, k = idx & 1023; LrT[idx] = w_in[(size_t)k * DIN + 1536 + r]; } }
        { const DecDense dec{w_in, (const float*)ARG_IN(I_WBA), (const float*)ARG_IN(I_WBB), (const float*)ARG_IN(I_WOUT), Win_t, Wa_t, Wb_t, Wout_t};
          tr_run(gw, 2560 + 256 + 256 + 512, NGW, dec, scr, lane); }
    }
    SEAM(0);

    if constexpr (IN(1)) {
        asm volatile("; PHASE_BEGIN 1" ::: "memory");
        PHASE_LOCALS
        const float* x = XIN; float* modp = P_MODP; float* modf = P_MODF; float* alr = P_ALR; bf16_t* XN = P_XN;
        const float* ada_b = (const float*)ARG_IN(I_ADAB); const float* g1 = (const float*)ARG_IN(I_N1G);
        LAS float* modS = (LAS float*)lds;
        const float* LrT = P_LRT;
        const int b = cb >> 6;
        f32x4 hv[8][4];
        const size_t m0 = (size_t)cb * 64 + wave * 8;
#pragma unroll
        for (int i = 0; i < 8; ++i) { const f32x4* xr = (const f32x4*)(x + (m0 + i) * D) + lane;
#pragma unroll
            for (int j = 0; j < 4; ++j) hv[i][j] = xr[64 * j]; }
        { const int j = tid * 4; f32x4 s = *(const f32x4*)(ada_b + j);
#pragma unroll 8
            for (int kc = 0; kc < 32; ++kc) s += *(const f32x4*)(modp + (size_t)(kc * 4 + b) * NMOD + j);
            if (j >= D) s += 1.0f;
            *(LAS f32x4*)(modS + j) = s; }
        if (tid < 96) { const int idx = cb * 96 + tid, bb = idx / NMOD, j = idx % NMOD; float s = ada_b[j];
#pragma unroll 8
            for (int kc = 0; kc < 32; ++kc) s += modp[(size_t)(kc * 4 + bb) * NMOD + j];
            modf[idx] = s; }
        __syncthreads();
#pragma unroll
        for (int i = 0; i < 8; ++i) { float ss = 0.f;
#pragma unroll
            for (int j = 0; j < 4; ++j) ss += (hv[i][j].x * hv[i][j].x + hv[i][j].y * hv[i][j].y) + (hv[i][j].z * hv[i][j].z + hv[i][j].w * hv[i][j].w);
            const float rstd = rsqrtf(wave_sum(ss) * (1.f / D) + 1e-6f);
            unsigned long long* o8 = (unsigned long long*)(XN + (m0 + i) * D) + lane;
#pragma unroll
            for (int j = 0; j < 4; ++j) { const int k = 4 * lane + 256 * j; const f32x4 gg = *(const f32x4*)(g1 + k); const f32x4 sh = *(const LAS f32x4*)(modS + k); const f32x4 sc = *(const LAS f32x4*)(modS + D + k);
                hv[i][j] = hv[i][j] * rstd * gg * sc + sh;
                o8[64 * j] = (unsigned long long)pk2(hv[i][j].x, hv[i][j].y) | ((unsigned long long)pk2(hv[i][j].z, hv[i][j].w) << 32); } }
        { float res[8];
#pragma unroll
          for (int i = 0; i < 8; ++i) res[i] = 0.f;
          f32x4 wn[4];
#pragma unroll
          for (int jj = 0; jj < 4; ++jj) wn[jj] = *(const f32x4*)(LrT + 4 * lane + 256 * jj);
#pragma unroll 1
          for (int r = 0; r < 16; ++r) {
            f32x4 w[4];
#pragma unroll
            for (int jj = 0; jj < 4; ++jj) w[jj] = wn[jj];
            const int rn = r < 15 ? r + 1 : r;
#pragma unroll
            for (int jj = 0; jj < 4; ++jj) wn[jj] = *(const f32x4*)(LrT + (size_t)rn * D + 4 * lane + 256 * jj);
#pragma unroll
            for (int i = 0; i < 8; ++i) { float a = 0.f;
#pragma unroll
                for (int jj = 0; jj < 4; ++jj) a += (hv[i][jj].x * w[jj].x + hv[i][jj].y * w[jj].y) + (hv[i][jj].z * w[jj].z + hv[i][jj].w * w[jj].w);
                a = wave_sum(a); if (lane == r) res[i] = a; }
          }
#pragma unroll
          for (int i = 0; i < 8; ++i) if (lane < 16) alr[(m0 + i) * 16 + lane] = res[i]; }
    }
    SEAM(1);

    if constexpr (IN(2)) {
        asm volatile("; PHASE_BEGIN 2" ::: "memory");
        PHASE_LOCALS
        bf16_t* XN = P_XN; bf16_t* Win_t = P_WIN; bf16_t* Ugla = P_UGLA; bf16_t* Udiff = P_UDIFF; bf16_t* Ugate = P_UGATE;
        pg8::DenseOrder S; S.init(XN, Win_t, M, NPROJ, D, G, cb);
        pg8::EpiInProj E{Ugla, Udiff, Ugate};
        pg8::gemm_phase<pg8::EpiInProj, pg8::DenseOrder, true, true>(lds, D, S, E);
    }
    SEAM(2);

    if constexpr (IN(3)) {
        asm volatile("; PHASE_BEGIN 3" ::: "memory");
        PHASE_LOCALS
        bf16_t* Udiff = P_UDIFF; float* alr = P_ALR; float* LOGA = P_LOGA;
        const int* pos = (const int*)ARG_IN(I_POS); const float* qg = (const float*)ARG_IN(I_DQG); const float* kg = (const float*)ARG_IN(I_DKG);
        const float* aup = (const float*)ARG_IN(I_AUP); const float* ab = (const float*)ARG_IN(I_AB);
        const float invf = powf(500000.0f, -(float)(lane & 7) * 0.125f);
        const size_t m0 = (size_t)cb * 64 + wave * 8;
        u32x4 w0[8], w1[8]; float posv[8], av[8];
#pragma unroll
        for (int i = 0; i < 8; ++i) { const bf16_t* rowp = Udiff + (m0 + i) * 1536 + lane * 16; w0[i] = *(const u32x4*)rowp; w1[i] = *(const u32x4*)(rowp + 8);
            posv[i] = (float)pos[m0 + i]; av[i] = alr[(m0 + i) * 16 + (lane & 15)]; }
        float gain[16];
#pragma unroll
        for (int e = 0; e < 16; ++e) gain[e] = (lane < 32 ? qg : kg)[(lane & 3) * 16 + e];
        float au[16][4], abv[4];
#pragma unroll
        for (int q = 0; q < 4; ++q) { abv[q] = ab[lane + 64 * q];
#pragma unroll
            for (int rr = 0; rr < 16; ++rr) au[rr][q] = aup[rr * 256 + lane + 64 * q]; }
#pragma unroll
        for (int i = 0; i < 8; ++i) {
            float y[16];
            y[0] = lo_bf(w0[i].x); y[1] = hi_bf(w0[i].x); y[2] = lo_bf(w0[i].y); y[3] = hi_bf(w0[i].y); y[4] = lo_bf(w0[i].z); y[5] = hi_bf(w0[i].z); y[6] = lo_bf(w0[i].w); y[7] = hi_bf(w0[i].w);
            y[8] = lo_bf(w1[i].x); y[9] = hi_bf(w1[i].x); y[10] = lo_bf(w1[i].y); y[11] = hi_bf(w1[i].y); y[12] = lo_bf(w1[i].z); y[13] = hi_bf(w1[i].z); y[14] = lo_bf(w1[i].w); y[15] = hi_bf(w1[i].w);
            float ss = 0.f;
#pragma unroll
            for (int e = 0; e < 16; ++e) ss += y[e] * y[e];
            ss += __shfl_xor(ss, 1); ss += __shfl_xor(ss, 2);
            const float rstd = rsqrtf(ss * (1.f / 64.f) + 1e-6f);
#pragma unroll
            for (int e = 0; e < 16; ++e) y[e] = y[e] * rstd * gain[e];
            const float ang = posv[i] * invf; float sv, cv; sincosf(ang, &sv, &cv);
            float r[16];
#pragma unroll
            for (int e = 0; e < 8; ++e) { const float c_ = __shfl(cv, e), s_ = __shfl(sv, e); r[e] = y[e] * c_ - y[e + 8] * s_; r[e + 8] = y[e + 8] * c_ + y[e] * s_; }
            if ((lane & 3) == 0) {
#pragma unroll
                for (int e = 0; e < 16; ++e) y[e] = r[e]; }
            if (lane < 32) {
#pragma unroll
                for (int e = 0; e < 16; ++e) y[e] *= attn_body::C2; }
            u32x4 o0, o1; o0.x = pk2(y[0], y[1]); o0.y = pk2(y[2], y[3]); o0.z = pk2(y[4], y[5]); o0.w = pk2(y[6], y[7]); o1.x = pk2(y[8], y[9]); o1.y = pk2(y[10], y[11]); o1.z = pk2(y[12], y[13]); o1.w = pk2(y[14], y[15]);
            bf16_t* rowp = Udiff + (m0 + i) * 1536 + lane * 16;
            *(u32x4*)rowp = o0; *(u32x4*)(rowp + 8) = o1;
            float xv[4];
#pragma unroll
            for (int q = 0; q < 4; ++q) xv[q] = abv[q];
#pragma unroll
            for (int rr = 0; rr < 16; ++rr) { const float a = __shfl(av[i], rr);
#pragma unroll
                for (int q = 0; q < 4; ++q) xv[q] += a * au[rr][q]; }
#pragma unroll
            for (int q = 0; q < 4; ++q) { const float ls = fminf(xv[q], 0.f) - log1pf(__expf(-fabsf(xv[q]))); LOGA[(m0 + i) * 256 + lane + 64 * q] = ls * (1.f / 16.f); }
        }
        VM_WAIT(); __syncthreads();
        gla::chunk_state4(lds, cb >> 6, cb & 63, LOGA, P_UGLA, P_SCT, P_DEC, tid, lane, wave);
    }
    SEAM(3);

    if constexpr (IN(4)) {
        asm volatile("; PHASE_BEGIN 4" ::: "memory");
        PHASE_LOCALS
        { const float* SCt = P_SCT; const float* DEC = P_DEC; bf16_t* SPt = P_SPT;
          const int idx = cb * NTHR + tid, bh = idx >> 13, e = idx & 8191, k = e & 63; float st = 0.f;
#pragma unroll 8
          for (int n = 0; n < 64; ++n) { const size_t q = (size_t)bh * 64 + n; const float sc = SCt[q * 8192 + e], d = DEC[q * 64 + k]; SPt[q * 8192 + e] = (bf16_t)f2bf(st); st = st * d + sc; } }
        { const int vcu = (cb % 8) * (G / 8) + cb / 8;
          attn_body::attn_phase<8>((char*)lds_raw, (const attn_body::bf16*)P_UDIFF, (attn_body::bf16*)P_OC, vcu); }
    }
    SEAM(4);

    if constexpr (IN(5)) {
        asm volatile("; PHASE_BEGIN 5" ::: "memory");
        PHASE_LOCALS
        { const float* lq1 = (const float*)ARG_IN(I_LQ1); const float* lk1 = (const float*)ARG_IN(I_LK1); const float* lq2 = (const float*)ARG_IN(I_LQ2); const float* lk2 = (const float*)ARG_IN(I_LK2);
          const float* og = (const float*)ARG_IN(I_DOG); const bf16_t* Oc = P_OC; bf16_t* OB = P_OB;
          const float lam = __expf(wave_sum(lq1[lane] * lk1[lane])) - __expf(wave_sum(lq2[lane] * lk2[lane])) + 0.2f;
          const size_t m0 = (size_t)cb * 64 + wave * 8; const int col0 = lane * 8;
          u32x4 av[8], bv[8];
#pragma unroll
          for (int i = 0; i < 8; ++i) { av[i] = *(const u32x4*)(Oc + (m0 + i) * 512 + col0); bv[i] = *(const u32x4*)(Oc + (size_t)M * 512 + (m0 + i) * 512 + col0); }
          float ogv[8];
#pragma unroll
          for (int e = 0; e < 8; ++e) ogv[e] = og[(col0 & 127) + e];
#pragma unroll
          for (int i = 0; i < 8; ++i) {
            const unsigned aw[4] = {av[i].x, av[i].y, av[i].z, av[i].w}, bw[4] = {bv[i].x, bv[i].y, bv[i].z, bv[i].w}; float o[8]; float ss = 0.f;
#pragma unroll
            for (int e = 0; e < 4; ++e) { o[2 * e] = lo_bf(aw[e]) - lam * lo_bf(bw[e]); o[2 * e + 1] = hi_bf(aw[e]) - lam * hi_bf(bw[e]); ss += o[2 * e] * o[2 * e] + o[2 * e + 1] * o[2 * e + 1]; }
            ss += __shfl_xor(ss, 1); ss += __shfl_xor(ss, 2); ss += __shfl_xor(ss, 4); ss += __shfl_xor(ss, 8);
            const float rstd = rsqrtf(ss * (1.f / 128.f) + 1e-6f) * 0.8f; unsigned ow[4];
#pragma unroll
            for (int e = 0; e < 4; ++e) ow[e] = pk2(o[2 * e] * rstd * ogv[2 * e], o[2 * e + 1] * rstd * ogv[2 * e + 1]);
            *(u32x4*)(OB + (m0 + i) * 512 + col0) = (u32x4){ow[0], ow[1], ow[2], ow[3]}; } }
        __syncthreads();
        gla::chunk_out4(lds, cb >> 6, cb & 63, P_LOGA, P_UGLA, P_SPT, (const float*)ARG_IN(I_GOG), P_OA, tid, lane, wave);
    }
    SEAM(5);

    if constexpr (IN(6)) {
        asm volatile("; PHASE_BEGIN 6" ::: "memory");
        PHASE_LOCALS
        bf16_t* OA = P_OA; bf16_t* OB = P_OB; bf16_t* Wa_t = P_WA; bf16_t* Wb_t = P_WB; bf16_t* Ugate = P_UGATE; bf16_t* M1 = P_M1; bf16_t* MERGED = P_MERGED;
        { pg8::DenseOrder S; S.init(OA, Wa_t, M, D, 512, G, cb); pg8::EpiBranch E{Ugate, 0, nullptr, M1};
          pg8::gemm_phase<pg8::EpiBranch, pg8::DenseOrder, true, true>(lds, 512, S, E); }
        VM_WAIT(); __syncthreads();
        { pg8::DenseOrder S; S.init(OB, Wb_t, M, D, 512, G, cb); pg8::EpiBranch E{Ugate, 1024, M1, MERGED};
          pg8::gemm_phase<pg8::EpiBranch, pg8::DenseOrder, true, true>(lds, 512, S, E); }
    }
    SEAM(6);

    if constexpr (IN(7)) {
        asm volatile("; PHASE_BEGIN 7" ::: "memory");
        PHASE_LOCALS
        const float* x = XIN; float* out = OUTP; float* modf = P_MODF; bf16_t* MERGED = P_MERGED; bf16_t* Wout_t = P_WOUT;
        pg8::DenseOrder S; S.init(MERGED, Wout_t, M, D, D, G, cb); pg8::EpiWout E{x, modf, out};
        pg8::gemm_phase<pg8::EpiWout, pg8::DenseOrder, true, true>(lds, D, S, E);
    }
    SEAM(7);

    if constexpr (IN(8)) {
        asm volatile("; PHASE_BEGIN 8" ::: "memory");
        PHASE_LOCALS
        float* out = OUTP; float* modf = P_MODF; bf16_t* H2 = P_H2; bf16_t* W13_t = P_W13; bf16_t* W2_t = P_W2; int* tok_e = P_TOKE; float* tok_w = P_TOKW; int* tok_rank = P_RANK; int* blkcnt = P_BLKCNT;
        const float* g2 = (const float*)ARG_IN(I_N2G); const float* brg = (const float*)ARG_IN(I_RGB); const float* bre = (const float*)ARG_IN(I_REB); const float* WrT = P_WRT;
        LAS float* modS = (LAS float*)lds;
        LAS int* eS = (LAS int*)(lds + 8192);
        const int b = cb >> 6;
        for (int j = tid; j < 2048; j += NTHR) modS[j] = modf[(size_t)b * NMOD + 3 * D + j] + (j >= D ? 1.0f : 0.f);
        __syncthreads();
        {
            f32x4 hv[8][4];
            const size_t m0 = (size_t)cb * 64 + wave * 8;
#pragma unroll
            for (int i = 0; i < 8; ++i) { const f32x4* xr = (const f32x4*)(out + (m0 + i) * D) + lane;
#pragma unroll
                for (int j = 0; j < 4; ++j) hv[i][j] = xr[64 * j]; }
#pragma unroll
            for (int i = 0; i < 8; ++i) { float ss = 0.f;
#pragma unroll
                for (int j = 0; j < 4; ++j) ss += (hv[i][j].x * hv[i][j].x + hv[i][j].y * hv[i][j].y) + (hv[i][j].z * hv[i][j].z + hv[i][j].w * hv[i][j].w);
                const float rstd = rsqrtf(wave_sum(ss) * (1.f / D) + 1e-6f);
                unsigned long long* o8 = (unsigned long long*)(H2 + (m0 + i) * D) + lane;
#pragma unroll
                for (int j = 0; j < 4; ++j) { const int k = 4 * lane + 256 * j; const f32x4 gg = *(const f32x4*)(g2 + k); const f32x4 sh = *(const LAS f32x4*)(modS + k); const f32x4 sc = *(const LAS f32x4*)(modS + D + k);
                    hv[i][j] = hv[i][j] * rstd * gg * sc + sh;
                    o8[64 * j] = (unsigned long long)pk2(hv[i][j].x, hv[i][j].y) | ((unsigned long long)pk2(hv[i][j].z, hv[i][j].w) << 32); } }
            float res[8];
#pragma unroll
            for (int i = 0; i < 8; ++i) res[i] = 0.f;
            { f32x4 wn[4];
#pragma unroll
              for (int jj = 0; jj < 4; ++jj) wn[jj] = *(const f32x4*)(WrT + 4 * lane + 256 * jj);
#pragma unroll 1
              for (int jx = 0; jx < 36; ++jx) {
                f32x4 w[4];
#pragma unroll
                for (int jj = 0; jj < 4; ++jj) w[jj] = wn[jj];
                const int jn = jx < 35 ? jx + 1 : jx;
#pragma unroll
                for (int jj = 0; jj < 4; ++jj) wn[jj] = *(const f32x4*)(WrT + (size_t)jn * D + 4 * lane + 256 * jj);
#pragma unroll
                for (int i = 0; i < 8; ++i) { float a = 0.f;
#pragma unroll
                    for (int jj = 0; jj < 4; ++jj) a += (hv[i][jj].x * w[jj].x + hv[i][jj].y * w[jj].y) + (hv[i][jj].z * w[jj].z + hv[i][jj].w * w[jj].w);
                    a = wave_sum(a); if (lane == jx) res[i] = a; }
              } }
            const float bias = lane < 4 ? brg[lane] : (lane < 36 ? bre[lane - 4] : 0.f);
#pragma unroll
            for (int i = 0; i < 8; ++i) {
                const int tl = wave * 8 + i; const float lgt = res[i] + bias;
                const float lg0 = __shfl(lgt, 0), lg1 = __shfl(lgt, 1), lg2 = __shfl(lgt, 2), lg3 = __shfl(lgt, 3);
                int gi = 0; float gm = lg0; if (lg1 > gm) { gm = lg1; gi = 1; } if (lg2 > gm) { gm = lg2; gi = 2; } if (lg3 > gm) { gm = lg3; gi = 3; }
                const float ptop = 1.0f / (__expf(lg0 - gm) + __expf(lg1 - gm) + __expf(lg2 - gm) + __expf(lg3 - gm));
                float el[8];
#pragma unroll
                for (int j = 0; j < 8; ++j) el[j] = __shfl(lgt, 4 + gi * 8 + j);
                int j0 = 0; float e0 = el[0];
#pragma unroll
                for (int j = 1; j < 8; ++j) if (el[j] > e0) { e0 = el[j]; j0 = j; }
                int j1 = -1; float e1 = -3.0e38f;
#pragma unroll
                for (int j = 0; j < 8; ++j) if (j != j0 && el[j] > e1) { e1 = el[j]; j1 = j; }
                const float t = __expf(e1 - e0), w0 = ptop / (1.0f + t), w1 = ptop * t / (1.0f + t);
                if (lane == 0) { eS[2 * tl] = gi * 8 + j0; eS[2 * tl + 1] = gi * 8 + j1; tok_w[(m0 + i) * 2] = w0; tok_w[(m0 + i) * 2 + 1] = w1; }
            }
        }
        __syncthreads();
        if (tid < 128) { const int e = eS[tid]; int rank = 0; for (int a = 0; a < tid; ++a) rank += (eS[a] == e) ? 1 : 0;
            tok_e[(size_t)cb * 128 + tid] = e; tok_rank[(size_t)cb * 128 + tid] = rank; }
        else if (tid < 160) { const int e = tid - 128; int cnt = 0; for (int a = 0; a < 128; ++a) cnt += (eS[a] == e) ? 1 : 0; blkcnt[cb * 32 + e] = cnt; }
        __syncthreads();
        { const DecExp dec{(const float*)ARG_IN(I_EW1), (const float*)ARG_IN(I_EW3), (const float*)ARG_IN(I_EW2), W13_t, W2_t};
          tr_run(gw, NEXP * 768, NGW, dec, (LAS float*)(lds + wave * 16384), lane); }
    }
    SEAM(8);

    if constexpr (IN(9)) {
        asm volatile("; PHASE_BEGIN 9" ::: "memory");
        PHASE_LOCALS
        bf16_t* H2 = P_H2; bf16_t* XS = P_XS; int* tok_e = P_TOKE; int* tok_rank = P_RANK; int* tok_slot = P_SLOT; int* blkcnt = P_BLKCNT; int* tile_e = P_TILEE; int* ntiles_p = P_NT;
        LAS int* red = (LAS int*)lds;
        LAS int* totS = red + 1024;
        LAS int* preS = totS + 32;
        LAS int* padS = preS + 32;
        LAS int* slotS = padS + 64;
        { const int e = tid & 31, part = tid >> 5; int tot = 0, pre = 0;
            for (int blk = part; blk < 256; blk += 16) { const int cval = blkcnt[blk * 32 + e]; tot += cval; pre += (blk < cb) ? cval : 0; }
            red[part * 64 + e] = tot; red[part * 64 + 32 + e] = pre; }
        __syncthreads();
        if (tid < 32) { int tot = 0, pre = 0; for (int p = 0; p < 16; ++p) { tot += red[p * 64 + tid]; pre += red[p * 64 + 32 + tid]; } totS[tid] = tot; preS[tid] = pre; }
        __syncthreads();
        if (tid == 0) { int off = 0; for (int e = 0; e < 32; ++e) { padS[e] = off; off += ((totS[e] + 255) >> 8) << 8; } padS[32] = off; }
        __syncthreads();
        if (cb == 0) { if (tid < 32) { for (int t = padS[tid] >> 8; t < (padS[tid + 1] >> 8); ++t) tile_e[t] = tid; } if (tid == 32) ntiles_p[0] = padS[32] >> 8; }
        if (tid < 128) { const size_t a = (size_t)cb * 128 + tid; const int e = tok_e[a]; const int slot = padS[e] + preS[e] + tok_rank[a]; tok_slot[a] = slot; slotS[tid] = slot; }
        __syncthreads();
#pragma unroll
        for (int hb = 0; hb < 2; ++hb) {
            u32x4 v0[8], v1[8]; int sl[8];
#pragma unroll
            for (int a8 = 0; a8 < 8; ++a8) { const int a = wave * 16 + hb * 8 + a8; const size_t t = (size_t)cb * 64 + (a >> 1); sl[a8] = slotS[a];
                const u32x4* src = (const u32x4*)(H2 + t * D) + lane; v0[a8] = src[0]; v1[a8] = src[64]; }
#pragma unroll
            for (int a8 = 0; a8 < 8; ++a8) { u32x4* dst = (u32x4*)(XS + (size_t)sl[a8] * D) + lane; dst[0] = v0[a8]; dst[64] = v1[a8]; }
        }
        if (cb < 32) { const int r0 = padS[cb] + totS[cb], r1 = padS[cb + 1];
            for (int r = r0 + wave; r < r1; r += NWAVES) { u32x4* dst = (u32x4*)(XS + (size_t)r * D) + lane; dst[0] = (u32x4){0, 0, 0, 0}; dst[64] = (u32x4){0, 0, 0, 0}; } }
    }
    SEAM(9);

    if constexpr (IN(10)) {
        asm volatile("; PHASE_BEGIN 10" ::: "memory");
        PHASE_LOCALS
        bf16_t* XS = P_XS; bf16_t* W13_t = P_W13; bf16_t* HMID = P_HMID; int* tile_e = P_TILEE; int* ntiles_p = P_NT;
        const int ntm = __builtin_amdgcn_readfirstlane(ntiles_p[0]);
        pg8::MoeOrder S; S.init(XS, W13_t, tile_e, ntm, D, (size_t)1024 * 1024 * 2, G, cb); pg8::EpiUp E{HMID};
        pg8::gemm_phase<pg8::EpiUp, pg8::MoeOrder, true, true>(lds, D, S, E);
    }
    SEAM(10);

    if constexpr (IN(11)) {
        asm volatile("; PHASE_BEGIN 11" ::: "memory");
        PHASE_LOCALS
        bf16_t* HMID = P_HMID; bf16_t* W2_t = P_W2; bf16_t* Y = P_Y; int* tile_e = P_TILEE; int* ntiles_p = P_NT;
        const int ntm = __builtin_amdgcn_readfirstlane(ntiles_p[0]);
        pg8::MoeOrder S; S.init(HMID, W2_t, tile_e, ntm, DEXP, (size_t)1024 * 512 * 2, G, cb); pg8::EpiPlain E{Y, D};
        pg8::gemm_phase<pg8::EpiPlain, pg8::MoeOrder, true, true>(lds, DEXP, S, E);
    }
    SEAM(11);

    if constexpr (IN(12)) {
        asm volatile("; PHASE_BEGIN 12" ::: "memory");
        PHASE_LOCALS
        float* out = OUTP; float* modf = P_MODF; bf16_t* Y = P_Y; int* tok_slot = P_SLOT; float* tok_w = P_TOKW;
        const size_t m0 = (size_t)cb * 64 + wave * 8; const float* g2p = modf + (size_t)(cb >> 6) * NMOD + 5 * D;
        int s0[8], s1[8]; float w0[8], w1[8];
#pragma unroll
        for (int i = 0; i < 8; ++i) { s0[i] = tok_slot[(m0 + i) * 2]; s1[i] = tok_slot[(m0 + i) * 2 + 1]; w0[i] = tok_w[(m0 + i) * 2]; w1[i] = tok_w[(m0 + i) * 2 + 1]; }
        f32x4 gv[4];
#pragma unroll
        for (int j = 0; j < 4; ++j) gv[j] = *(const f32x4*)(g2p + 4 * lane + 256 * j);
#pragma unroll
        for (int hb = 0; hb < 2; ++hb) {
            f32x4 xv[4][4]; u32x2 y0[4][4], y1[4][4];
#pragma unroll
            for (int i4 = 0; i4 < 4; ++i4) { const int i = hb * 4 + i4;
#pragma unroll
                for (int j = 0; j < 4; ++j) { const int k = 4 * lane + 256 * j; xv[i4][j] = *(const f32x4*)(out + (m0 + i) * D + k);
                    y0[i4][j] = *(const u32x2*)(Y + (size_t)s0[i] * D + k); y1[i4][j] = *(const u32x2*)(Y + (size_t)s1[i] * D + k); } }
#pragma unroll
            for (int i4 = 0; i4 < 4; ++i4) { const int i = hb * 4 + i4;
#pragma unroll
                for (int j = 0; j < 4; ++j) { const int k = 4 * lane + 256 * j; f32x4 o;
                    o.x = xv[i4][j].x + gv[j].x * (w0[i] * lo_bf(y0[i4][j].x) + w1[i] * lo_bf(y1[i4][j].x)); o.y = xv[i4][j].y + gv[j].y * (w0[i] * hi_bf(y0[i4][j].x) + w1[i] * hi_bf(y1[i4][j].x));
                    o.z = xv[i4][j].z + gv[j].z * (w0[i] * lo_bf(y0[i4][j].y) + w1[i] * lo_bf(y1[i4][j].y)); o.w = xv[i4][j].w + gv[j].w * (w0[i] * hi_bf(y0[i4][j].y) + w1[i] * hi_bf(y1[i4][j].y));
                    *(f32x4*)(out + (m0 + i) * D + k) = o; } }
        }
    }
#undef IN
#undef SEAM
}

constexpr int NPHASE = 13;
template <int LO, int HI> static void launch_range(const Args& a, hipStream_t stream) {
    static bool attr = false;
    if (!attr) { (void)hipFuncSetAttribute((const void*)mk_fwd<LO, HI>, hipFuncAttributeMaxDynamicSharedMemorySize, LDS_BYTES); attr = true; }
    hipLaunchKernelGGL((mk_fwd<LO, HI>), dim3(256), dim3(NTHR), LDS_BYTES, stream, a);
}
extern "C" void kernel_launch(void* const* d_in, const int* in_sizes, int n_in, void* d_out, int out_size, void* d_ws, size_t ws_size, hipStream_t stream) {
    static int ok = 0;
    if (ok == 0) {
        if (n_in != 28 || out_size != M * D || ws_size < WS_END) { fprintf(stderr, "kernel_launch: unexpected shapes (n_in %d, out %d, ws %zu < %zu)\n", n_in, out_size, ws_size, (size_t)WS_END); ok = -1; return; }
        ok = 1;
    }
    if (ok < 0) return;
    (void)hipMemsetAsync((char*)d_ws + WS_CTL, 0, CTL_ZERO_BYTES, stream);
    Args a{};
    for (int i = 0; i < 28; ++i) a.in[i] = d_in[i];
    a.out = (float*)d_out; a.ws = (unsigned char*)d_ws; a.ph_lo = 0; a.ph_hi = NPHASE;
#if MK_ONE_LAUNCH
    launch_range<0, NPHASE>(a, stream);
#else
    launch_range<0, 1>(a, stream); launch_range<1, 2>(a, stream); launch_range<2, 3>(a, stream); launch_range<3, 4>(a, stream);
    launch_range<4, 5>(a, stream); launch_range<5, 6>(a, stream); launch_range<6, 7>(a, stream); launch_range<7, 8>(a, stream);
    launch_range<8, 9>(a, stream); launch_range<9, 10>(a, stream); launch_range<10, 11>(a, stream); launch_range<11, 12>(a, stream);
    launch_range<12, 13>(a, stream);
#endif
}
```

```cpp
#include <hip/hip_runtime.h>
#include <hip/hip_bf16.h>
#include <cstdio>
#include <cstdint>

#ifndef MK_ONE_LAUNCH
#define MK_ONE_LAUNCH 1
#endif

#define LAS __attribute__((address_space(3)))
#define GAS __attribute__((address_space(1)))
typedef unsigned short bf16_t;
typedef short bf16x8 __attribute__((ext_vector_type(8)));
typedef float f32x4 __attribute__((ext_vector_type(4)));
typedef float f32x2 __attribute__((ext_vector_type(2)));
typedef unsigned u32x4 __attribute__((ext_vector_type(4)));
typedef unsigned u32x2 __attribute__((ext_vector_type(2)));

constexpr int NB = 4, SEQ = 4096, D = 1024, M = NB * SEQ;
constexpr int DIN = 5136, NPROJ = 5120;
constexpr int NEXP = 32, DEXP = 512;
constexpr int PMAX = 40960;
constexpr int NMOD = 6 * D;

constexpr size_t MiB = 1u << 20;
constexpr size_t WS_CTL = 0, CTL_ZERO_BYTES = 1 * MiB;
constexpr size_t WS_MODP = 1 * MiB;
constexpr size_t WS_MODF = 4 * MiB;
constexpr size_t WS_ALR = 5 * MiB;
constexpr size_t WS_ROUTE = 6 * MiB;
constexpr size_t WS_WIN = 8 * MiB;
constexpr size_t WS_WA = 18 * MiB, WS_WB = 19 * MiB, WS_WOUT = 20 * MiB;
constexpr size_t RA = 22 * MiB;
constexpr size_t RB = 118 * MiB;
constexpr size_t WS_END = 278 * MiB;
constexpr size_t WS_XN = RA;
constexpr size_t WS_LOGA = RA;
constexpr size_t WS_SCT = RA + 16 * MiB;
constexpr size_t WS_SPT = RA + 48 * MiB;
constexpr size_t WS_OC = RA + 64 * MiB;
constexpr size_t WS_DEC = 7 * MiB;
constexpr size_t WS_WRT = 7 * MiB + 512 * 1024;
constexpr size_t WS_LRT = 7 * MiB + 768 * 1024;
constexpr size_t WS_OB = RB + 64 * MiB;
constexpr size_t WS_OA = RB + 48 * MiB;
constexpr size_t WS_XS = RA;
constexpr size_t WS_Y = RA;
constexpr size_t WS_UGLA = RB;
constexpr size_t WS_UDIFF = RB + 48 * MiB;
constexpr size_t WS_UGATE = RB + 96 * MiB;
constexpr size_t WS_M1 = RA;
constexpr size_t WS_MERGED = RB;
constexpr size_t WS_H2 = RB;
constexpr size_t WS_W13 = RB + 64 * MiB;
constexpr size_t WS_W2 = RB + 128 * MiB;
constexpr size_t WS_HMID = RB;
constexpr size_t RT_TOKE = 0, RT_TOKW = 131072, RT_RANK = 262144, RT_SLOT = 393216, RT_BLKCNT = 524288, RT_TILEE = 557056, RT_NT = 561152;
constexpr int CW_BAR = 4096;

constexpr int RING_BYTES = 131072;
constexpr int LDSCTL_OFF = RING_BYTES, MISC_OFF = LDSCTL_OFF + 320;
constexpr int LDS_BYTES = 147456;
constexpr int NWAVES = 8, NTHR = 512;

__device__ __forceinline__ float bf2f(bf16_t h) { return __uint_as_float((unsigned)h << 16); }
__device__ __forceinline__ unsigned f2bf(float f) { unsigned u = __float_as_uint(f); return (u + 0x7fffu + ((u >> 16) & 1u)) >> 16; }
typedef __bf16 bf16x2_t __attribute__((ext_vector_type(2)));
__device__ __forceinline__ unsigned pk2(float lo, float hi) { f32x2 v = {lo, hi}; bf16x2_t b = __builtin_convertvector(v, bf16x2_t); return __builtin_bit_cast(unsigned, b); }
__device__ __forceinline__ float lo_bf(unsigned w) { return __uint_as_float(w << 16); }
__device__ __forceinline__ float hi_bf(unsigned w) { return __uint_as_float(w & 0xffff0000u); }
#define DPP_ADD(v, ctrl) ((v) + __builtin_bit_cast(float, __builtin_amdgcn_update_dpp(0, __builtin_bit_cast(int, (v)), (ctrl), 0xF, 0xF, true)))
__device__ __forceinline__ float wave_sum(float v) {
    v = DPP_ADD(v, 0xB1); v = DPP_ADD(v, 0x4E); v = DPP_ADD(v, 0x141); v = DPP_ADD(v, 0x140);
    { const unsigned u = __float_as_uint(v); auto r = __builtin_amdgcn_permlane16_swap(u, u, false, false); v = __uint_as_float(r[0]) + __uint_as_float(r[1]); }
    { const unsigned u = __float_as_uint(v); auto r = __builtin_amdgcn_permlane32_swap(u, u, false, false); v = __uint_as_float(r[0]) + __uint_as_float(r[1]); }
    return v;
}
__device__ __forceinline__ float swapadd32(float x, float y) { auto r = __builtin_amdgcn_permlane32_swap(__float_as_uint(x), __float_as_uint(y), false, false); return __uint_as_float(r[0]) + __uint_as_float(r[1]); }
__device__ __forceinline__ float swapadd16(float x, float y) { auto r = __builtin_amdgcn_permlane16_swap(__float_as_uint(x), __float_as_uint(y), false, false); return __uint_as_float(r[0]) + __uint_as_float(r[1]); }
__device__ __forceinline__ void reduce8(const float (&a)[8], float& y0, float& y1) {
    const float x0 = swapadd32(a[0], a[4]), x1 = swapadd32(a[1], a[5]), x2 = swapadd32(a[2], a[6]), x3 = swapadd32(a[3], a[7]);
    y0 = swapadd16(x0, x2); y1 = swapadd16(x1, x3);
    y0 = DPP_ADD(y0, 0xB1); y0 = DPP_ADD(y0, 0x4E); y0 = DPP_ADD(y0, 0x141); y0 = DPP_ADD(y0, 0x140);
    y1 = DPP_ADD(y1, 0xB1); y1 = DPP_ADD(y1, 0x4E); y1 = DPP_ADD(y1, 0x141); y1 = DPP_ADD(y1, 0x140);
}
__device__ __forceinline__ float wave_max(float v) {
#pragma unroll
    for (int o = 1; o < 64; o <<= 1) v = fmaxf(v, __shfl_xor(v, o));
    return v;
}
__device__ __forceinline__ float sigmoidf_(float x) { return 1.0f / (1.0f + __expf(-x)); }
__device__ __forceinline__ float siluf_(float x) { return x / (1.0f + __expf(-x)); }
#define LDS_WAIT() asm volatile("s_waitcnt lgkmcnt(0)" ::: "memory")
#define VM_WAIT() asm volatile("s_waitcnt vmcnt(0)" ::: "memory")

namespace pg8 {
constexpr int BM = 256, BK = 64, HALF = 128, HTB = HALF * BK * 2, STAGE_BYTES = 8 * HTB, NXCD = 8, WGM = 8;
__host__ __device__ __forceinline__ int lds_byte(int r, int c) { const int st = (r >> 4) * 2 + (c >> 5), rr = r & 15, cc = c & 31, ob = rr * 64 + cc * 2; return st * 1024 + (ob ^ (((ob >> 9) & 1) << 5)); }
__host__ __device__ __forceinline__ void stage_rc(int b, int& R, int& C) { const int st = b / 1024, sb = b % 1024, swz = sb ^ (((sb >> 9) & 1) << 5); R = (st >> 1) * 16 + swz / 64; C = (st & 1) * 32 + (swz % 64) / 2; }
__host__ __device__ __forceinline__ int perm32(int rho) { const int n = rho >> 4, i = rho & 15; return 8 * (i >> 2) + 4 * n + (i & 3); }

struct Unit { int pm, pn, aux; };

__device__ __forceinline__ int xcd_swizzle(int wgid, int nwg) { const int q = nwg / NXCD, r = nwg % NXCD, xcd = wgid % NXCD, off = wgid / NXCD; return (xcd < r ? xcd * (q + 1) : r * (q + 1) + (xcd - r) * q) + off; }

struct DenseOrder {
    const char* A; const char* Bt; size_t tstep; int nM, nN, nwg, G, c;
    __device__ __forceinline__ void init(const void* A_, const void* Bt_, int M_, int N_, int K_, int G_, int c_) { A = (const char*)A_; Bt = (const char*)Bt_; tstep = (size_t)BM * K_ * 2; nM = M_ / BM; nN = N_ / BM; nwg = nM * nN; G = G_; c = c_; }
    __device__ __forceinline__ bool next(int i, Unit& u) const {
        const long L = (long)i * G + c; if (L >= nwg) return false;
        const int wgid = xcd_swizzle((int)L, nwg);
        const int nig = WGM * nN, gid = wgid / nig, fm = gid * WGM, gsz = (nM - fm) < WGM ? (nM - fm) : WGM;
        u.pm = fm + ((wgid % nig) % gsz); u.pn = (wgid % nig) / gsz; u.aux = 0; return true;
    }
    __device__ __forceinline__ const char* a_ptr(const Unit& u) const { return A + (size_t)u.pm * tstep; }
    __device__ __forceinline__ const char* b_ptr(const Unit& u) const { return Bt + (size_t)u.pn * tstep; }
};
struct MoeOrder {
    const char* A; const char* W; const int* tile_e; size_t tstep, estride; int nwg, G, c;
    __device__ __forceinline__ void init(const void* A_, const void* W_, const int* te, int ntm, int K_, size_t estride_, int G_, int c_) { A = (const char*)A_; W = (const char*)W_; tile_e = te; tstep = (size_t)BM * K_ * 2; estride = estride_; nwg = ntm * 4; G = G_; c = c_; }
    __device__ __forceinline__ bool next(int i, Unit& u) const {
        const long L = (long)i * G + c; if (L >= nwg) return false;
        const int wgid = xcd_swizzle((int)L, nwg);
        u.pm = wgid >> 2; u.pn = wgid & 3; u.aux = __builtin_amdgcn_readfirstlane(tile_e[u.pm]); return true;
    }
    __device__ __forceinline__ const char* a_ptr(const Unit& u) const { return A + (size_t)u.pm * tstep; }
    __device__ __forceinline__ const char* b_ptr(const Unit& u) const { return W + (size_t)u.aux * estride + (size_t)u.pn * tstep; }
};

__device__ __forceinline__ u32x4 pack8(const f32x4& v0, const f32x4& v1) { u32x4 w; w.x = pk2(v0[0], v0[1]); w.y = pk2(v0[2], v0[3]); w.z = pk2(v1[0], v1[1]); w.w = pk2(v1[2], v1[3]); return w; }

struct EpiInProj {
    static constexpr bool PERM = true, AFTER_DRAIN = false;
    bf16_t *Ugla, *Udiff, *Ugate;
    __device__ __forceinline__ void operator()(const f32x4 (&acc)[2][2][4][2], const Unit& u, int wr, int wc, int fr, int fq) const {
        bf16_t* base; int ldc, colt;
        if (u.pn < 6) { base = Ugla; ldc = 1536; colt = u.pn * 256; } else if (u.pn < 12) { base = Udiff; ldc = 1536; colt = (u.pn - 6) * 256; } else { base = Ugate; ldc = 2048; colt = (u.pn - 12) * 256; }
        const int row0 = u.pm * BM + wr * 64 + fr, col0 = colt + wc * 32 + 8 * fq;
#pragma unroll
        for (int ai = 0; ai < 2; ++ai)
#pragma unroll
            for (int m = 0; m < 4; ++m) { bf16_t* rowp = base + (size_t)(row0 + ai * HALF + m * 16) * ldc + col0;
#pragma unroll
                for (int bj = 0; bj < 2; ++bj) *(u32x4*)(rowp + bj * HALF) = pack8(acc[ai][bj][m][0], acc[ai][bj][m][1]); }
    }
};
struct EpiPlain {
    static constexpr bool PERM = true, AFTER_DRAIN = false;
    bf16_t* O; int ldc;
    __device__ __forceinline__ void operator()(const f32x4 (&acc)[2][2][4][2], const Unit& u, int wr, int wc, int fr, int fq) const {
        const int row0 = u.pm * BM + wr * 64 + fr, col0 = u.pn * BM + wc * 32 + 8 * fq;
#pragma unroll
        for (int ai = 0; ai < 2; ++ai)
#pragma unroll
            for (int m = 0; m < 4; ++m) { bf16_t* rowp = O + (size_t)(row0 + ai * HALF + m * 16) * ldc + col0;
#pragma unroll
                for (int bj = 0; bj < 2; ++bj) *(u32x4*)(rowp + bj * HALF) = pack8(acc[ai][bj][m][0], acc[ai][bj][m][1]); }
    }
};
struct EpiBranch {
    static constexpr bool PERM = true, AFTER_DRAIN = false;
    const bf16_t* gate; int gcol0; const bf16_t* m1in; bf16_t* out;
    __device__ __forceinline__ void operator()(const f32x4 (&acc)[2][2][4][2], const Unit& u, int wr, int wc, int fr, int fq) const {
        const int row0 = u.pm * BM + wr * 64 + fr, col0 = u.pn * BM + wc * 32 + 8 * fq;
#pragma unroll
        for (int ai = 0; ai < 2; ++ai)
#pragma unroll
            for (int m = 0; m < 4; ++m) { const size_t r = (size_t)(row0 + ai * HALF + m * 16);
#pragma unroll
                for (int bj = 0; bj < 2; ++bj) { const int c = col0 + bj * HALF;
                    const u32x4 g = *(const u32x4*)(gate + r * 2048 + gcol0 + c);
                    f32x4 v0 = acc[ai][bj][m][0], v1 = acc[ai][bj][m][1];
                    v0[0] *= sigmoidf_(lo_bf(g.x)); v0[1] *= sigmoidf_(hi_bf(g.x)); v0[2] *= sigmoidf_(lo_bf(g.y)); v0[3] *= sigmoidf_(hi_bf(g.y));
                    v1[0] *= sigmoidf_(lo_bf(g.z)); v1[1] *= sigmoidf_(hi_bf(g.z)); v1[2] *= sigmoidf_(lo_bf(g.w)); v1[3] *= sigmoidf_(hi_bf(g.w));
                    if (m1in) { const u32x4 p = *(const u32x4*)(m1in + r * 1024 + c);
                        v0[0] += lo_bf(p.x); v0[1] += hi_bf(p.x); v0[2] += lo_bf(p.y); v0[3] += hi_bf(p.y); v1[0] += lo_bf(p.z); v1[1] += hi_bf(p.z); v1[2] += lo_bf(p.w); v1[3] += hi_bf(p.w); }
                    *(u32x4*)(out + r * 1024 + c) = pack8(v0, v1); } }
    }
};
struct EpiWout {
    static constexpr bool PERM = false, AFTER_DRAIN = false;
    const float* x; const float* modf; float* out;
    __device__ __forceinline__ void operator()(const f32x4 (&acc)[2][2][4][2], const Unit& u, int wr, int wc, int fr, int fq) const {
        const int row0 = u.pm * BM + wr * 64 + fr, col0 = u.pn * BM + wc * 32 + 4 * fq;
        const float* g1 = modf + (size_t)((u.pm * BM) >> 12) * NMOD + 2 * D;
#pragma unroll
        for (int bj = 0; bj < 2; ++bj)
#pragma unroll
            for (int n = 0; n < 2; ++n) { const int c = col0 + bj * HALF + n * 16; const f32x4 gv = *(const f32x4*)(g1 + c);
#pragma unroll
                for (int ai = 0; ai < 2; ++ai)
#pragma unroll
                    for (int m = 0; m < 4; ++m) { const size_t off = (size_t)(row0 + ai * HALF + m * 16) * D + c;
                        const f32x4 xv = *(const f32x4*)(x + off); *(f32x4*)(out + off) = xv + gv * acc[ai][bj][m][n]; } }
    }
};
struct EpiUp {
    static constexpr bool PERM = true, AFTER_DRAIN = false;
    bf16_t* H;
    __device__ __forceinline__ void operator()(const f32x4 (&acc)[2][2][4][2], const Unit& u, int wr, int wc, int fr, int fq) const {
        const int row0 = u.pm * BM + wr * 64 + fr, col0 = u.pn * HALF + wc * 32 + 8 * fq;
#pragma unroll
        for (int ai = 0; ai < 2; ++ai)
#pragma unroll
            for (int m = 0; m < 4; ++m) { f32x4 v0, v1;
#pragma unroll
                for (int e = 0; e < 4; ++e) { v0[e] = siluf_(acc[ai][0][m][0][e]) * acc[ai][1][m][0][e]; v1[e] = siluf_(acc[ai][0][m][1][e]) * acc[ai][1][m][1][e]; }
                *(u32x4*)(H + (size_t)(row0 + ai * HALF + m * 16) * DEXP + col0) = pack8(v0, v1); }
    }
};

template <class Epi, class Sched, bool ALIGN_EPI = false, bool SP2 = false>
__device__ __forceinline__ void gemm_phase(LAS unsigned char* lds, const int K, const Sched& S, const Epi& E) {
    int tid_ = threadIdx.x; asm volatile("" : "+v"(tid_));
    const int tid = tid_, wid = __builtin_amdgcn_readfirstlane(tid >> 6), lane = tid & 63, wr = wid >> 2, wc = wid & 3, fr = lane & 15, fq = lane >> 4;
    const int nt = K / BK;
    unsigned voffA[2], voffB[2];
#pragma unroll
    for (int i = 0; i < 2; ++i) { int R, C; stage_rc(tid * 16 + i * 8192, R, C); const int Rb = Epi::PERM ? ((R & ~31) + perm32(R & 31)) : R;
        voffA[i] = (unsigned)(R * K + C) * 2u; voffB[i] = (unsigned)(Rb * K + C) * 2u; }
    const size_t kstep = (size_t)(BK * 2);
    const size_t hstep = (size_t)HALF * K * 2;
    const unsigned ldsw = (unsigned)wid * 1024u;
    const int aoff = lds_byte(wr * 64 + fr, fq * 8), boff = lds_byte(wc * 32 + fr, fq * 8);
#define PG8_SA(b, h) (((b) * 2 + (h)) * HTB)
#define PG8_SB(b, h) ((4 + (b) * 2 + (h)) * HTB)
#define PG8_STAGE(bufoff, gbase, voff) do { _Pragma("unroll") for (int _i = 0; _i < 2; ++_i) \
        __builtin_amdgcn_global_load_lds((const unsigned*)((const char*)(gbase) + (voff)[_i]), (LAS unsigned*)(lds + (bufoff) + ldsw + _i * 8192), 16, 0, 0); } while (0)
#define PG8_LDA(dst, b, h) do { _Pragma("unroll") for (int m = 0; m < 4; ++m) _Pragma("unroll") for (int k = 0; k < 2; ++k) dst[m][k] = *(const LAS bf16x8*)(lds + PG8_SA(b, h) + aoff + m * 2048 + k * 1024); } while (0)
#define PG8_LDB(dst, b, h) do { _Pragma("unroll") for (int n = 0; n < 2; ++n) _Pragma("unroll") for (int k = 0; k < 2; ++k) dst[n][k] = *(const LAS bf16x8*)(lds + PG8_SB(b, h) + boff + n * 2048 + k * 1024); } while (0)
#define PG8_MMA(ai, bj, At, Bt) do { __builtin_amdgcn_s_setprio(1); _Pragma("unroll") for (int m = 0; m < 4; ++m) _Pragma("unroll") for (int n = 0; n < 2; ++n) _Pragma("unroll") for (int k = 0; k < 2; ++k) \
        acc[ai][bj][m][n] = __builtin_amdgcn_mfma_f32_16x16x32_bf16(Bt[n][k], At[m][k], acc[ai][bj][m][n], 0, 0, 0); __builtin_amdgcn_s_setprio(0); } while (0)
#define PG8_WAIT_V(n) asm volatile("s_waitcnt vmcnt(" #n ")" ::: "memory")
#define PG8_WAIT_L(n) asm volatile("s_waitcnt lgkmcnt(" #n ")" ::: "memory")
#define PG8_BAR __builtin_amdgcn_s_barrier()
#define PG8_SCHED __builtin_amdgcn_sched_barrier(0)
    Unit cur, nxt; int ui = 0;
    if (!S.next(0, cur)) return;
    f32x4 acc[2][2][4][2];
#pragma unroll
    for (int a = 0; a < 2; ++a)
#pragma unroll
        for (int b = 0; b < 2; ++b)
#pragma unroll
            for (int m = 0; m < 4; ++m)
#pragma unroll
                for (int n = 0; n < 2; ++n) acc[a][b][m][n] = (f32x4){0.f, 0.f, 0.f, 0.f};
    bf16x8 At[4][2], B0[2][2], B1[2][2];
    const char* cA = S.a_ptr(cur); const char* cB = S.b_ptr(cur);
    if constexpr (SP2) {
        PG8_STAGE(PG8_SB(0, 0), cB, voffB); PG8_STAGE(PG8_SB(0, 1), cB + hstep, voffB); PG8_STAGE(PG8_SA(0, 0), cA, voffA); PG8_STAGE(PG8_SA(0, 1), cA + hstep, voffA);
        if (wr == 1) PG8_BAR;
        PG8_WAIT_V(2); PG8_BAR;
        PG8_STAGE(PG8_SB(1, 0), cB + kstep, voffB); PG8_STAGE(PG8_SA(1, 0), cA + kstep, voffA); PG8_STAGE(PG8_SB(1, 1), cB + hstep + kstep, voffB);
        PG8_WAIT_V(6); PG8_BAR;
    } else {
        PG8_STAGE(PG8_SB(0, 0), cB, voffB); PG8_STAGE(PG8_SA(0, 0), cA, voffA); PG8_STAGE(PG8_SB(0, 1), cB + hstep, voffB); PG8_STAGE(PG8_SA(0, 1), cA + hstep, voffA);
        if (wr == 1) PG8_BAR;
        PG8_WAIT_V(4); PG8_BAR;
        PG8_STAGE(PG8_SB(1, 0), cB + kstep, voffB); PG8_STAGE(PG8_SA(1, 0), cA + kstep, voffA); PG8_STAGE(PG8_SB(1, 1), cB + hstep + kstep, voffB);
        PG8_WAIT_V(6); PG8_BAR;
    }
    for (;;) {
        const bool has_next = S.next(ui + 1, nxt);
        const char* nA = has_next ? S.a_ptr(nxt) : cA; const char* nB = has_next ? S.b_ptr(nxt) : cB;
        for (int t = 0; t < nt; t += 2) {
            const bool last = (t == nt - 2);
            const char* a1 = cA + (size_t)(t + 1) * kstep;
            const char* a2 = last ? nA : cA + (size_t)(t + 2) * kstep; const char* b2 = last ? nB : cB + (size_t)(t + 2) * kstep;
            const char* a3 = a2 + kstep; const char* b3 = b2 + kstep;
            if constexpr (SP2) {
            PG8_LDB(B0, 0, 0); PG8_LDB(B1, 0, 1); PG8_SCHED; PG8_LDA(At, 0, 0); PG8_STAGE(PG8_SA(1, 1), a1 + hstep, voffA);
            PG8_WAIT_V(8); PG8_WAIT_L(0); PG8_BAR; PG8_MMA(0, 0, At, B0); PG8_MMA(0, 1, At, B1); PG8_BAR; PG8_SCHED;
            PG8_LDA(At, 0, 1); PG8_STAGE(PG8_SB(0, 0), b2, voffB); PG8_STAGE(PG8_SB(0, 1), b2 + hstep, voffB); PG8_STAGE(PG8_SA(0, 0), a2, voffA);
            PG8_WAIT_V(8); PG8_WAIT_L(0); PG8_BAR; PG8_MMA(1, 0, At, B0); PG8_MMA(1, 1, At, B1); PG8_BAR; PG8_SCHED;
            PG8_LDB(B0, 1, 0); PG8_LDB(B1, 1, 1); PG8_SCHED; PG8_LDA(At, 1, 0); PG8_STAGE(PG8_SA(0, 1), a2 + hstep, voffA);
            PG8_WAIT_V(8); PG8_WAIT_L(0); PG8_BAR; PG8_MMA(0, 0, At, B0); PG8_MMA(0, 1, At, B1); PG8_BAR; PG8_SCHED;
            PG8_LDA(At, 1, 1); PG8_STAGE(PG8_SB(1, 0), b3, voffB); PG8_STAGE(PG8_SB(1, 1), b3 + hstep, voffB); PG8_STAGE(PG8_SA(1, 0), a3, voffA);
            PG8_WAIT_V(8); PG8_WAIT_L(0); PG8_BAR; PG8_MMA(1, 0, At, B0); PG8_MMA(1, 1, At, B1); PG8_BAR; PG8_SCHED;
            } else {
            PG8_LDB(B0, 0, 0); PG8_SCHED; PG8_LDA(At, 0, 0); PG8_STAGE(PG8_SA(1, 1), a1 + hstep, voffA);
            PG8_WAIT_L(8); PG8_BAR; PG8_WAIT_L(0); PG8_MMA(0, 0, At, B0); PG8_BAR; PG8_SCHED;
            PG8_LDB(B1, 0, 1); PG8_STAGE(PG8_SB(0, 0), b2, voffB);
            PG8_BAR; PG8_WAIT_L(0); PG8_MMA(0, 1, At, B1); PG8_BAR;
            PG8_LDA(At, 0, 1); PG8_STAGE(PG8_SA(0, 0), a2, voffA);
            PG8_BAR; PG8_WAIT_L(0); PG8_MMA(1, 0, At, B0); PG8_BAR; PG8_SCHED;
            PG8_STAGE(PG8_SB(0, 1), b2 + hstep, voffB);
            PG8_WAIT_V(6); PG8_BAR; PG8_MMA(1, 1, At, B1); PG8_BAR;
            PG8_LDB(B0, 1, 0); PG8_SCHED; PG8_LDA(At, 1, 0); PG8_STAGE(PG8_SA(0, 1), a2 + hstep, voffA);
            PG8_WAIT_L(8); PG8_BAR; PG8_WAIT_L(0); PG8_MMA(0, 0, At, B0); PG8_BAR; PG8_SCHED;
            PG8_LDB(B1, 1, 1); PG8_STAGE(PG8_SB(1, 0), b3, voffB);
            PG8_BAR; PG8_WAIT_L(0); PG8_MMA(0, 1, At, B1); PG8_BAR;
            PG8_LDA(At, 1, 1); PG8_STAGE(PG8_SA(1, 0), a3, voffA);
            PG8_BAR; PG8_WAIT_L(0); PG8_MMA(1, 0, At, B0); PG8_BAR; PG8_SCHED;
            PG8_STAGE(PG8_SB(1, 1), b3 + hstep, voffB);
            PG8_WAIT_V(6); PG8_BAR; PG8_MMA(1, 1, At, B1); PG8_BAR;
            }
        }
        if constexpr (ALIGN_EPI) { if (wr == 0) PG8_BAR; }
        E(acc, cur, wr, wc, fr, fq);
        if (!has_next) break;
#pragma unroll
        for (int a = 0; a < 2; ++a)
#pragma unroll
            for (int b = 0; b < 2; ++b)
#pragma unroll
                for (int m = 0; m < 4; ++m)
#pragma unroll
                    for (int n = 0; n < 2; ++n) acc[a][b][m][n] = (f32x4){0.f, 0.f, 0.f, 0.f};
        cur = nxt; cA = nA; cB = nB; ++ui;
        if constexpr (ALIGN_EPI) { if (wr == 1) PG8_BAR; }
    }
    PG8_WAIT_V(0);
    if constexpr (!ALIGN_EPI) { if (wr == 0) PG8_BAR; }
    PG8_BAR;
#undef PG8_SA
#undef PG8_SB
#undef PG8_STAGE
#undef PG8_LDA
#undef PG8_LDB
#undef PG8_MMA
#undef PG8_WAIT_V
#undef PG8_WAIT_L
#undef PG8_BAR
#undef PG8_SCHED
}
}

namespace attn_body {
using bf16=__hip_bfloat16;
using bf16x8=__attribute__((ext_vector_type(8)))short;
using s16x4=__attribute__((ext_vector_type(4)))short;
using f32x16=__attribute__((ext_vector_type(16)))float;
using u32x4=__attribute__((ext_vector_type(4)))unsigned;
constexpr int SEQ=4096,D=64,DM=1536,DMO=512;
constexpr int NW=8,QBLK=32,QB=QBLK*NW,KVBLK=64,NQB=SEQ/QB;
constexpr int ATTN_UNIT_ROWS=QB;
__device__ __forceinline__ int crow(int r,int hi){return (r&3)+8*(r>>2)+4*hi;}
#define SBAR() __builtin_amdgcn_sched_barrier(0)
__device__ __forceinline__ void cmask(f32x16&p0,f32x16&p1,int jb,int qrel,int hi){
  const float NEG=-INFINITY; int kb=64*jb+4*hi;
  #pragma unroll
  for(int r=0;r<16;++r){int kv=kb+(r&3)+8*(r>>2); if(kv>qrel)p0[r]=NEG; if(kv+32>qrel)p1[r]=NEG;}
}

constexpr int NSLOT=3, SLOTB=8192;
constexpr int LDS_K=0, LDS_V=NSLOT*SLOTB, LDS_WS=2*NSLOT*SLOTB, LDS_OST=LDS_WS+NW*64*4, LDS_BYTES=LDS_OST+NW*4096;
constexpr float C2=0.125f*1.4426950408889634f;
__device__ __forceinline__ void glds16(const void*gsrc,unsigned lds_dst){unsigned keep;
  asm volatile("s_mov_b32 %0, m0\n\ts_mov_b32 m0, %2\n\ts_nop 0\n\tglobal_load_lds_dwordx4 %1, off\n\ts_mov_b32 m0, %0":"=&s"(keep):"v"(gsrc),"s"(lds_dst):"memory");}
__device__ __forceinline__ float max3f(float a,float b,float c){float r;asm("v_max3_f32 %0, %1, %2, %3":"=v"(r):"v"(a),"v"(b),"v"(c));return r;}
__device__ __forceinline__ float max2f(float a,float b){float r;asm("v_max_f32_e32 %0, %1, %2":"=v"(r):"v"(a),"v"(b));return r;}
__device__ __forceinline__ float fadd_s(float a,float b){float r;asm("v_add_f32_e32 %0, %1, %2":"=v"(r):"v"(a),"v"(b));return r;}
__device__ __forceinline__ float fsub_s(float a,float b){float r;asm("v_sub_f32_e32 %0, %1, %2":"=v"(r):"v"(a),"v"(b));return r;}
typedef float f32x2_t __attribute__((ext_vector_type(2))); typedef __bf16 bf16x2_t __attribute__((ext_vector_type(2)));
__device__ __forceinline__ unsigned cvtpk_s(float lo,float hi){f32x2_t v={lo,hi};bf16x2_t b=__builtin_convertvector(v,bf16x2_t);return __builtin_bit_cast(unsigned,b);}
#define WAIT_BAR(N) asm volatile("s_waitcnt vmcnt(" #N ") lgkmcnt(0)\n\ts_barrier":::"memory")

__device__ __forceinline__ void qkt(f32x16&p0,f32x16&p1,const char*Kslot,const bf16x8*qr,const f32x16&negm,int r32,int hi){
  const char*kb=Kslot+hi*1024+r32*16;
  #pragma unroll
  for(int d0=0;d0<4;++d0){
    const bf16x8 b0=*reinterpret_cast<const bf16x8*>(kb+d0*2048);
    const bf16x8 b1=*reinterpret_cast<const bf16x8*>(kb+d0*2048+512);
    if(d0==0){p0=__builtin_amdgcn_mfma_f32_32x32x16_bf16(b0,qr[0],negm,0,0,0);p1=__builtin_amdgcn_mfma_f32_32x32x16_bf16(b1,qr[0],negm,0,0,0);}
    else{p0=__builtin_amdgcn_mfma_f32_32x32x16_bf16(b0,qr[d0],p0,0,0,0);p1=__builtin_amdgcn_mfma_f32_32x32x16_bf16(b1,qr[d0],p1,0,0,0);}}
}
typedef __attribute__((address_space(3))) const char* lds_cptr;
typedef short v4i16_t __attribute__((ext_vector_type(4)));
__device__ __forceinline__ void kload8(bf16x8*kf,lds_cptr kp){
  kf[0]=*(const __attribute__((address_space(3))) bf16x8*)(kp);      kf[1]=*(const __attribute__((address_space(3))) bf16x8*)(kp+512);
  kf[2]=*(const __attribute__((address_space(3))) bf16x8*)(kp+2048); kf[3]=*(const __attribute__((address_space(3))) bf16x8*)(kp+2560);
  kf[4]=*(const __attribute__((address_space(3))) bf16x8*)(kp+4096); kf[5]=*(const __attribute__((address_space(3))) bf16x8*)(kp+4608);
  kf[6]=*(const __attribute__((address_space(3))) bf16x8*)(kp+6144); kf[7]=*(const __attribute__((address_space(3))) bf16x8*)(kp+6656);
}
__device__ __forceinline__ void kload2(bf16x8*kf,lds_cptr kp,int j){ kf[2*j]=*(const __attribute__((address_space(3))) bf16x8*)(kp+j*2048); kf[2*j+1]=*(const __attribute__((address_space(3))) bf16x8*)(kp+j*2048+512); }
__device__ __forceinline__ s16x4 vtr(lds_cptr p){ return __builtin_bit_cast(s16x4,__builtin_amdgcn_ds_read_tr16_b64_v4i16((__attribute__((address_space(3))) v4i16_t*)p)); }
__device__ __forceinline__ float rowmax(const f32x16&p0,const f32x16&p1){
  float a=max3f(p0[0],p0[1],p1[0]),b=max3f(p0[2],p0[3],p1[1]);a=max3f(a,p1[2],p1[3]);
  #pragma unroll
  for(int r=4;r<16;r+=4){a=max3f(a,p0[r],p0[r+1]);b=max3f(b,p0[r+2],p0[r+3]);a=max3f(a,p1[r],p1[r+1]);b=max3f(b,p1[r+2],p1[r+3]);}
  const float m=max2f(a,b);
  auto rr=__builtin_amdgcn_permlane32_swap(__float_as_uint(m),__float_as_uint(m),false,false);
  return max2f(__uint_as_float(rr[0]),__uint_as_float(rr[1]));
}
__device__ __forceinline__ void pv(f32x16*o,int vb,bf16x8 pa0,bf16x8 pa1,bf16x8 pa2,bf16x8 pa3){
  #pragma unroll
  for(int d0=0;d0<2;++d0){s16x4 lo[4],hi[4];
    #pragma unroll
    for(int ks=0;ks<4;++ks){
      asm volatile("ds_read_b64_tr_b16 %0,%1 offset:%c2":"=&v"(lo[ks]):"v"(vb),"i"(d0*4096+ks*1024):"memory");
      asm volatile("ds_read_b64_tr_b16 %0,%1 offset:%c2":"=&v"(hi[ks]):"v"(vb),"i"(d0*4096+ks*1024+512):"memory");}
    asm volatile("s_waitcnt lgkmcnt(0)":::"memory");SBAR();
    #define PK(k) (bf16x8){lo[k][0],lo[k][1],lo[k][2],lo[k][3],hi[k][0],hi[k][1],hi[k][2],hi[k][3]}
    o[d0]=__builtin_amdgcn_mfma_f32_32x32x16_bf16(pa0,PK(0),o[d0],0,0,0);
    o[d0]=__builtin_amdgcn_mfma_f32_32x32x16_bf16(pa1,PK(1),o[d0],0,0,0);
    o[d0]=__builtin_amdgcn_mfma_f32_32x32x16_bf16(pa2,PK(2),o[d0],0,0,0);
    o[d0]=__builtin_amdgcn_mfma_f32_32x32x16_bf16(pa3,PK(3),o[d0],0,0,0);
    #undef PK
  }
}

#ifndef ATTN_STORE16
#define ATTN_STORE16(p,v) (*(u32x4*)(p)=(v))
#endif
template<int THRL> __device__ __forceinline__ void attn_unit(int b,int qcol,int kcol,int vcol,int ocol,int qb,const bf16*Q,const bf16*__restrict__ K,const bf16*__restrict__ V,bf16*O,char*shm){
  int tid_=threadIdx.x; asm volatile("":"+v"(tid_));
  const int tid=tid_,lane=tid&63,r32=lane&31,hi=lane>>5; const int wid=__builtin_amdgcn_readfirstlane(tid>>6);
  const long rowbase=(long)b*SEQ; const int q0=qb*QB;
  const bf16*Qw=Q+(rowbase+q0+wid*QBLK)*DM+qcol;
  const bf16*Kh=K+rowbase*DM+kcol,*Vh=V+rowbase*DM+vcol;
  const unsigned lds0=(unsigned)(uintptr_t)shm;
  float*wsf=(float*)(shm+LDS_WS)+wid*64;
  const bf16*ksrc=Kh+(long)lane*DM+wid*8;
  const bf16*vsrc=Vh+(long)(16*(wid&3)+(lane>>2))*DM+(wid>>2)*32+(lane&3)*8;
  const unsigned kdst=lds0+LDS_K+wid*1024, vdst=lds0+LDS_V+wid*1024;
  #define DMA_K(t,slot) glds16(ksrc+(long)(t)*KVBLK*DM,(unsigned)__builtin_amdgcn_readfirstlane(kdst+(slot)))
  #define DMA_V(t,slot) glds16(vsrc+(long)(t)*KVBLK*DM,(unsigned)__builtin_amdgcn_readfirstlane(vdst+(slot)))
  const int vb0=(int)(lds0+LDS_V)+((lane>>4)&1)*32+(lane&3)*8+(4*hi+((lane&15)>>2))*64;
  const char*Kbase=shm+LDS_K; bf16x8 kf[8];
  const lds_cptr shm3=(lds_cptr)shm; const lds_cptr kp0=shm3+LDS_K+hi*1024+r32*16; const lds_cptr vp0=shm3+LDS_V+((lane>>4)&1)*32+(lane&3)*8+(4*hi+((lane&15)>>2))*64;
  const int NT=(q0+QB)/KVBLK;
  DMA_K(0,0);DMA_V(0,0);DMA_K(1,SLOTB);
  bf16x8 qr[4];
  #pragma unroll
  for(int d0=0;d0<4;++d0)qr[d0]=*reinterpret_cast<const bf16x8*>(&Qw[(long)r32*DM+d0*16+hi*8]);
  float mhat=0.f,l_reg=0.f;f32x16 o[2];o[0]=f32x16{};o[1]=f32x16{};f32x16 negm=f32x16{};asm volatile("":"+v"(negm));
  const int qrel=wid*QBLK+r32;
  #define CMASK(P0,P1,t) do{int jb_=(t)-(NT-4); if(jb_>=0)cmask(P0,P1,jb_,qrel,hi);}while(0)
  bool resc=false;
  #define START(P0,P1) do{ const float rm=rowmax(P0,P1); resc=false; \
    { const float dl=rm; mhat=fadd_s(mhat,dl); \
      _Pragma("unroll") for(int r=0;r<16;++r){P0[r]=fsub_s(P0[r],dl);P1[r]=fsub_s(P1[r],dl);} \
      _Pragma("unroll") for(int r=0;r<16;++r)negm[r]=-mhat; asm volatile("":"+v"(negm)); } \
    _Pragma("unroll") for(int r=0;r<16;++r)P0[r]=__builtin_amdgcn_exp2f(P0[r]); }while(0)
  #define RESC() do{ if(resc){ asm volatile("s_waitcnt lgkmcnt(0)":::"memory"); \
      _Pragma("unroll") for(int d_=0;d_<2;++d_) _Pragma("unroll") for(int r=0;r<16;++r)o[d_][r]*=wsf[crow(r,hi)]; } }while(0)
  f32x16 pA0,pA1,pB0,pB1;
  int sl_prev=0,sl_cur=0,sl_next=SLOTB;
  #define ROT() do{sl_prev=sl_cur;sl_cur=sl_next;sl_next=(sl_next==(NSLOT-1)*SLOTB)?0:sl_next+SLOTB;}while(0)
  DMA_K(2,2*SLOTB);
  WAIT_BAR(3);
  qkt(pA0,pA1,Kbase,qr,negm,r32,hi);asm volatile("s_nop 15\n\ts_nop 7":"+v"(pA0),"+v"(pA1));CMASK(pA0,pA1,0);
  START(pA0,pA1);
  _Pragma("unroll") for(int r=0;r<16;++r)pA1[r]=__builtin_amdgcn_exp2f(pA1[r]);
  WAIT_BAR(0);
  DMA_K(3,0);DMA_V(1,SLOTB);
  ROT();
  kload8(kf,kp0+sl_cur);
  WAIT_BAR(2);
  s16x4 vlo[8],vhi[8]; u32x4 pw0,pw1,pw2,pw3;
  #define PKW(P,B) cvtpk_s(P[B],P[B+1])
  #define PAF(k) __builtin_bit_cast(bf16x8,pw##k)
  #define VFR(i) (bf16x8){vlo[i][0],vlo[i][1],vlo[i][2],vlo[i][3],vhi[i][0],vhi[i][1],vhi[i][2],vhi[i][3]}
  #define PIN(x) asm volatile("":"+v"(x))
  #define MX3(a,b,c) __builtin_fmaxf(__builtin_fmaxf((a),(b)),(c))
  #define GAPA(MF,A0,A1,A2,A3,W0,W1,PW) do{ MF; sacc+=A0; sacc+=A1; sacc+=A2; sacc+=A3; PIN(sacc); W0; W1; PIN(PW); SBAR(); }while(0)
  #define EX(v) __builtin_amdgcn_exp2f(v)
  #define GAPB(MF,X,B) do{ MF; X[B]=EX(X[B]); X[B+1]=EX(X[B+1]); X[B+2]=EX(X[B+2]); X[B+3]=EX(X[B+3]); PIN(X); SBAR(); }while(0)
  #define VRD(i) do{ vlo[i]=vtr(vp_+(((i)>>2)*4096+((i)&3)*1024)); vhi[i]=vtr(vp_+(((i)>>2)*4096+((i)&3)*1024+512)); }while(0)
  #define KRD(G,j) do{ if(G){ kload2(kf,kp0+sl_next,j); SBAR(); } }while(0)
  #define STEP(C0,C1,P0,P1,t,GK,GV,GL) do{ SBAR(); \
    const lds_cptr vp_=vp0+sl_prev; \
    VRD(0); SBAR(); float sacc=(P0[0]+P0[1]); \
    GAPA(C0=__builtin_amdgcn_mfma_f32_32x32x16_bf16(kf[0],qr[0],negm,0,0,0), P0[2],P0[3],P0[4],P0[5],     pw0[0]=PKW(P0,0), pw0[1]=PKW(P0,2), pw0); \
    VRD(4); SBAR(); GAPA(C1=__builtin_amdgcn_mfma_f32_32x32x16_bf16(kf[1],qr[0],negm,0,0,0), P0[6],P0[7],P0[8],P0[9],     pw0[2]=PKW(P0,4), pw0[3]=PKW(P0,6), pw0); \
    VRD(1); SBAR(); GAPA(C0=__builtin_amdgcn_mfma_f32_32x32x16_bf16(kf[2],qr[1],C0,0,0,0),   P0[10],P0[11],P0[12],P0[13], pw1[0]=PKW(P0,8), pw1[1]=PKW(P0,10), pw1); \
    VRD(5); SBAR(); GAPA(C1=__builtin_amdgcn_mfma_f32_32x32x16_bf16(kf[3],qr[1],C1,0,0,0),   P0[14],P0[15],P1[0],P1[1],   pw1[2]=PKW(P0,12),pw1[3]=PKW(P0,14), pw1); \
    VRD(2); SBAR(); GAPA(C0=__builtin_amdgcn_mfma_f32_32x32x16_bf16(kf[4],qr[2],C0,0,0,0),   P1[2],P1[3],P1[4],P1[5],     pw2[0]=PKW(P1,0), pw2[1]=PKW(P1,2), pw2); \
    VRD(6); SBAR(); GAPA(C1=__builtin_amdgcn_mfma_f32_32x32x16_bf16(kf[5],qr[2],C1,0,0,0),   P1[6],P1[7],P1[8],P1[9],     pw2[2]=PKW(P1,4), pw2[3]=PKW(P1,6), pw2); \
    VRD(3); SBAR(); GAPA(C0=__builtin_amdgcn_mfma_f32_32x32x16_bf16(kf[6],qr[3],C0,0,0,0),   P1[10],P1[11],P1[12],P1[13], pw3[0]=PKW(P1,8), pw3[1]=PKW(P1,10), pw3); \
    VRD(7); SBAR(); GAPA(C1=__builtin_amdgcn_mfma_f32_32x32x16_bf16(kf[7],qr[3],C1,0,0,0),   P1[14],P1[15],0.f,0.f,       pw3[2]=PKW(P1,12),pw3[3]=PKW(P1,14), pw3); \
    l_reg+=sacc; \
    if(GK){DMA_K((t)+3,sl_cur);} if(GV){DMA_V((t)+1,sl_next);} \
    CMASK(C0,C1,t); \
    { float a=MX3(C0[0],C0[1],C1[0]),b=MX3(C0[2],C0[3],C1[1]); a=MX3(a,C1[2],C1[3]); \
      _Pragma("unroll") for(int r=4;r<16;r+=4){a=MX3(a,C0[r],C0[r+1]);b=MX3(b,C0[r+2],C0[r+3]);a=MX3(a,C1[r],C1[r+1]);b=MX3(b,C1[r+2],C1[r+3]);} \
      float rm=__builtin_fmaxf(a,b); { auto rr=__builtin_amdgcn_permlane32_swap(__float_as_uint(rm),__float_as_uint(rm),false,false); rm=__builtin_fmaxf(__uint_as_float(rr[0]),__uint_as_float(rr[1])); } \
      resc=false; \
      if(__builtin_expect(__any(rm>(float)THRL),0)){ const float dl=__builtin_fmaxf(rm,0.f); mhat+=dl; \
        _Pragma("unroll") for(int r=0;r<16;++r){C0[r]-=dl;C1[r]-=dl;} \
        _Pragma("unroll") for(int r=0;r<16;++r)negm[r]=-mhat; asm volatile("":"+v"(negm)); \
        const float f=__builtin_amdgcn_exp2f(-dl); l_reg*=f; if(hi==0)wsf[r32]=f; resc=true; } } \
    SBAR(); \
    GAPB(o[0]=__builtin_amdgcn_mfma_f32_32x32x16_bf16(PAF(0),VFR(0),o[0],0,0,0), C0,0); \
    GAPB(o[1]=__builtin_amdgcn_mfma_f32_32x32x16_bf16(PAF(0),VFR(4),o[1],0,0,0), C0,4); \
    KRD(GL,0); GAPB(o[0]=__builtin_amdgcn_mfma_f32_32x32x16_bf16(PAF(1),VFR(1),o[0],0,0,0), C0,8); \
    KRD(GL,1); GAPB(o[1]=__builtin_amdgcn_mfma_f32_32x32x16_bf16(PAF(1),VFR(5),o[1],0,0,0), C0,12); \
    KRD(GL,2); GAPB(o[0]=__builtin_amdgcn_mfma_f32_32x32x16_bf16(PAF(2),VFR(2),o[0],0,0,0), C1,0); \
    KRD(GL,3); GAPB(o[1]=__builtin_amdgcn_mfma_f32_32x32x16_bf16(PAF(2),VFR(6),o[1],0,0,0), C1,4); \
    GAPB(o[0]=__builtin_amdgcn_mfma_f32_32x32x16_bf16(PAF(3),VFR(3),o[0],0,0,0), C1,8); \
    GAPB(o[1]=__builtin_amdgcn_mfma_f32_32x32x16_bf16(PAF(3),VFR(7),o[1],0,0,0), C1,12); \
    }while(0)
  int t=1;
  #undef CMASK
  #define CMASK(P0,P1,t) do{}while(0)
  for(;t+5<NT;t+=2){
    STEP(pB0,pB1,pA0,pA1,t,true,true,true);     WAIT_BAR(2); RESC(); ROT();
    STEP(pA0,pA1,pB0,pB1,t+1,true,true,true);   WAIT_BAR(2); RESC(); ROT();
  }
  #undef CMASK
  #define CMASK(P0,P1,t) do{int jb_=(t)-(NT-4); if(jb_>=0)cmask(P0,P1,jb_,qrel,hi);}while(0)
  #define ENDW(tt) do{ if((tt)+3<NT){WAIT_BAR(2);} else if((tt)+2<NT){WAIT_BAR(1);} else {WAIT_BAR(0);} }while(0)
  for(;t+1<NT;t+=2){
    STEP(pB0,pB1,pA0,pA1,t,(t+3<NT),(t+1<NT),(t+1<NT));       ENDW(t);   RESC(); ROT();
    STEP(pA0,pA1,pB0,pB1,t+1,(t+4<NT),(t+2<NT),(t+2<NT));     ENDW(t+1); RESC(); ROT();
  }
  STEP(pB0,pB1,pA0,pA1,NT-1,false,false,false); RESC();
  { float sacc=pB0[0]+pB0[1]; _Pragma("unroll") for(int r=2;r<16;++r)sacc+=pB0[r]; _Pragma("unroll") for(int r=0;r<16;++r)sacc+=pB1[r]; l_reg+=sacc;
    pw0=(u32x4){PKW(pB0,0),PKW(pB0,2),PKW(pB0,4),PKW(pB0,6)};pw1=(u32x4){PKW(pB0,8),PKW(pB0,10),PKW(pB0,12),PKW(pB0,14)};pw2=(u32x4){PKW(pB1,0),PKW(pB1,2),PKW(pB1,4),PKW(pB1,6)};pw3=(u32x4){PKW(pB1,8),PKW(pB1,10),PKW(pB1,12),PKW(pB1,14)};
    SBAR(); pv(o,vb0+sl_cur,PAF(0),PAF(1),PAF(2),PAF(3)); }
  #undef PKW
  #undef PAF
  #undef VFR
  #undef PIN
  #undef MX3
  #undef GAPA
  #undef GAPB
  #undef EX
  #undef VRD
  #undef KRD
  #undef STEP
  #undef ENDW
  {auto rr=__builtin_amdgcn_permlane32_swap(__float_as_uint(l_reg),__float_as_uint(l_reg),false,false);l_reg=__uint_as_float(rr[0])+__uint_as_float(rr[1]);}
  if(hi==0)wsf[32+r32]=l_reg;asm volatile("s_waitcnt lgkmcnt(0)":::"memory");
  float rli[16];
  #pragma unroll
  for(int r=0;r<16;++r)rli[r]=__builtin_amdgcn_rcpf(wsf[32+crow(r,hi)]);
  bf16*Ow=O+(rowbase+q0+wid*QBLK)*DMO+ocol;
  { bf16*stg=(bf16*)(shm+LDS_OST)+wid*2048;
    #pragma unroll
    for(int r=0;r<16;++r){const int orow=crow(r,hi);
      #pragma unroll
      for(int d0=0;d0<2;++d0)stg[orow*64+d0*32+r32]=__float2bfloat16(o[d0][r]*rli[r]);}
    asm volatile("s_waitcnt lgkmcnt(0)":::"memory");
    #pragma unroll
    for(int i=0;i<4;++i){const int row=i*8+(lane>>3),ch=lane&7; const u32x4 v=*(const u32x4*)(stg+row*64+ch*8); ATTN_STORE16(Ow+(long)row*DMO+ch*8,v);} }
  asm volatile("s_waitcnt lgkmcnt(0)\n\ts_barrier":::"memory");
  #undef DMA_K
  #undef DMA_V
  #undef CMASK
  #undef START
  #undef RESC
  #undef ROT
}
constexpr int ATTN_LDS_BYTES=LDS_BYTES;
template<int THRL=8> __device__ __forceinline__ void attn_phase(char*lds,const bf16*U,bf16*Oc,int vcu){
  const int bhc=vcu>>3,s=vcu&7,b=bhc>>3,h=(bhc>>1)&3,c=bhc&1;
  _Pragma("unroll 1") for(int i=0;i<4;++i){ const int half=i>>1,qb=(i&1)?15-s:s;
    attn_unit<THRL>(b,h*128+c*64,512+h*128+c*64,1024+h*128+half*64,h*128+half*64,qb,U,U,U,Oc+(long)c*16384*DMO,lds); }
}
#undef SBAR
#undef WAIT_BAR
}

namespace gla {
constexpr int GP = 72;
constexpr int L_BC = 0, L_VT = 16384, L_QI = 34816, L_KI = 44032, L_ATT = 53248, L_OF = 62464, OFP = 132;
__device__ __forceinline__ bf16x8 frag(const LAS unsigned char* base, int row, int k0) { return *(const LAS bf16x8*)(base + (row * GP + k0) * 2); }
struct LdState { f32x4 g0, g1; unsigned vw[8]; unsigned kw[4]; };
__device__ __forceinline__ void ld_common(f32x4& g0, f32x4& g1, unsigned (&vw)[8], const float* LOGA, const bf16_t* Ugla, size_t row0, int h, int tid) {
    const float* gp = LOGA + (row0 + (tid >> 3)) * 256 + h * 64 + (tid & 7) * 8; g0 = *(const f32x4*)gp; g1 = *(const f32x4*)(gp + 4);
    const bf16_t* vp = Ugla + (row0 + (tid >> 7) * 16) * 1536 + 512 + h * 128 + (tid & 127);
#pragma unroll
    for (int j = 0; j < 8; ++j) vw[j] = (unsigned)vp[(size_t)(2 * j) * 1536] | ((unsigned)vp[(size_t)(2 * j + 1) * 1536] << 16);
}
__device__ __forceinline__ void ld_state(LdState& L, const float* LOGA, const bf16_t* Ugla, size_t row0, int h, int tid) {
    ld_common(L.g0, L.g1, L.vw, LOGA, Ugla, row0, h, tid);
    const bf16_t* kp = Ugla + (row0 + (tid >> 6) * 8) * 1536 + 256 + h * 64 + (tid & 63);
#pragma unroll
    for (int j = 0; j < 4; ++j) L.kw[j] = (unsigned)kp[(size_t)(2 * j) * 1536] | ((unsigned)kp[(size_t)(2 * j + 1) * 1536] << 16);
}
__device__ __forceinline__ void stage_common(LAS unsigned char* lds, const f32x4& g0, const f32x4& g1, const unsigned (&vw)[8], int tid) {
    LAS float* Bc = (LAS float*)(lds + L_BC);
    *(LAS f32x4*)(Bc + (tid >> 3) * 64 + (tid & 7) * 8) = g0; *(LAS f32x4*)(Bc + (tid >> 3) * 64 + (tid & 7) * 8 + 4) = g1;
    LAS u32x4* dst = (LAS u32x4*)(lds + L_VT + ((tid & 127) * GP + (tid >> 7) * 16) * 2);
    dst[0] = (u32x4){vw[0], vw[1], vw[2], vw[3]}; dst[1] = (u32x4){vw[4], vw[5], vw[6], vw[7]};
}
__device__ __forceinline__ void cumsum_inplace(LAS unsigned char* lds, int lane, int wave) {
    LAS float* Bc = (LAS float*)(lds + L_BC);
    if (wave == 0) { float acc = 0.f;
#pragma unroll 16
        for (int s = 0; s < 64; ++s) { acc += Bc[s * 64 + lane]; Bc[s * 64 + lane] = acc; } }
}
__device__ __forceinline__ void chunk_state4(LAS unsigned char* lds, int b, int n, const float* LOGA, const bf16_t* Ugla, float* SCt, float* DEC, int tid, int lane, int wave) {
    const size_t row0 = (size_t)b * SEQ + n * 64;
    LAS float* Bc = (LAS float*)(lds + L_BC);
    LdState cur; ld_state(cur, LOGA, Ugla, row0, 0, tid);
#pragma unroll 1
    for (int h = 0; h < 4; ++h) {
        const int q = ((b * 4 + h) << 6) + n;
        stage_common(lds, cur.g0, cur.g1, cur.vw, tid);
        __syncthreads();
        cumsum_inplace(lds, lane, wave);
        __syncthreads();
        { const int k = tid & 63, sg = tid >> 6; const float bl = Bc[63 * 64 + k]; float f[8];
#pragma unroll
            for (int j = 0; j < 4; ++j) { f[2 * j] = lo_bf(cur.kw[j]) * __expf(bl - Bc[(sg * 8 + 2 * j) * 64 + k]); f[2 * j + 1] = hi_bf(cur.kw[j]) * __expf(bl - Bc[(sg * 8 + 2 * j + 1) * 64 + k]); }
            *(LAS u32x4*)(lds + L_QI + (k * GP + sg * 8) * 2) = (u32x4){pk2(f[0], f[1]), pk2(f[2], f[3]), pk2(f[4], f[5]), pk2(f[6], f[7])};
            if (tid < 64) DEC[(size_t)q * 64 + tid] = __expf(bl); }
        LdState nxt = cur; if (h < 3) ld_state(nxt, LOGA, Ugla, row0, h + 1, tid);
        __syncthreads();
        { const int fr = lane & 15, fq = lane >> 4, mt = wave >> 1;
#pragma unroll
            for (int j = 0; j < 4; ++j) { const int nt = (wave & 1) * 4 + j; f32x4 acc = {0.f, 0.f, 0.f, 0.f};
#pragma unroll
                for (int ks = 0; ks < 2; ++ks) acc = __builtin_amdgcn_mfma_f32_16x16x32_bf16(frag(lds + L_QI, 16 * mt + fr, 32 * ks + 8 * fq), frag(lds + L_VT, 16 * nt + fr, 32 * ks + 8 * fq), acc, 0, 0, 0);
                *(f32x4*)(SCt + (size_t)q * 8192 + (16 * nt + fr) * 64 + 16 * mt + 4 * fq) = acc; } }
        __syncthreads();
        cur = nxt;
    }
}
struct LdOut { f32x4 g0, g1; unsigned vw[8]; u32x4 qw, kw, r0, r1; bf16x8 sp[4][2]; };
__device__ __forceinline__ void ld_out(LdOut& L, const float* LOGA, const bf16_t* Ugla, const bf16_t* SPt, size_t row0, int h, int q, int tid, int lane, int wave) {
    ld_common(L.g0, L.g1, L.vw, LOGA, Ugla, row0, h, tid);
    const bf16_t* rp = Ugla + (row0 + (tid >> 3)) * 1536 + h * 64 + (tid & 7) * 8; L.qw = *(const u32x4*)rp; L.kw = *(const u32x4*)(rp + 256);
    const bf16_t* gp = Ugla + (row0 + (tid >> 3)) * 1536 + 1024 + h * 128 + (tid & 7) * 16; L.r0 = *(const u32x4*)gp; L.r1 = *(const u32x4*)(gp + 8);
    const int fr = lane & 15, fq = lane >> 4;
#pragma unroll
    for (int j = 0; j < 4; ++j)
#pragma unroll
        for (int ks = 0; ks < 2; ++ks) L.sp[j][ks] = *(const bf16x8*)(SPt + (size_t)q * 8192 + (16 * ((wave & 1) * 4 + j) + fr) * 64 + 32 * ks + 8 * fq);
}
__device__ __forceinline__ void chunk_out4(LAS unsigned char* lds, int b, int n, const float* LOGA, const bf16_t* Ugla, const bf16_t* SPt, const float* gog, bf16_t* OA, int tid, int lane, int wave) {
    const size_t row0 = (size_t)b * SEQ + n * 64;
    LAS float* Bc = (LAS float*)(lds + L_BC); LAS float* Of = (LAS float*)(lds + L_OF);
    const int fr = lane & 15, fq = lane >> 4;
    LdOut cur; ld_out(cur, LOGA, Ugla, SPt, row0, 0, ((b * 4) << 6) + n, tid, lane, wave);
#pragma unroll 1
    for (int h = 0; h < 4; ++h) {
        stage_common(lds, cur.g0, cur.g1, cur.vw, tid);
        __syncthreads();
        cumsum_inplace(lds, lane, wave);
        __syncthreads();
        { const int s = tid >> 3, k0 = (tid & 7) * 8; float qf[8], kf[8];
            qf[0] = lo_bf(cur.qw.x); qf[1] = hi_bf(cur.qw.x); qf[2] = lo_bf(cur.qw.y); qf[3] = hi_bf(cur.qw.y); qf[4] = lo_bf(cur.qw.z); qf[5] = hi_bf(cur.qw.z); qf[6] = lo_bf(cur.qw.w); qf[7] = hi_bf(cur.qw.w);
            kf[0] = lo_bf(cur.kw.x); kf[1] = hi_bf(cur.kw.x); kf[2] = lo_bf(cur.kw.y); kf[3] = hi_bf(cur.kw.y); kf[4] = lo_bf(cur.kw.z); kf[5] = hi_bf(cur.kw.z); kf[6] = lo_bf(cur.kw.w); kf[7] = hi_bf(cur.kw.w);
#pragma unroll
            for (int e = 0; e < 8; ++e) { const float bv = Bc[s * 64 + k0 + e]; qf[e] *= 0.125f * __expf(bv); kf[e] *= __expf(-bv); }
            *(LAS u32x4*)(lds + L_QI + (s * GP + k0) * 2) = (u32x4){pk2(qf[0], qf[1]), pk2(qf[2], qf[3]), pk2(qf[4], qf[5]), pk2(qf[6], qf[7])};
            *(LAS u32x4*)(lds + L_KI + (s * GP + k0) * 2) = (u32x4){pk2(kf[0], kf[1]), pk2(kf[2], kf[3]), pk2(kf[4], kf[5]), pk2(kf[6], kf[7])}; }
        __syncthreads();
#pragma unroll
        for (int j = 0; j < 2; ++j) { const int t = 2 * wave + j, mt = t >> 2, nt = t & 3; f32x4 acc = {0.f, 0.f, 0.f, 0.f};
#pragma unroll
            for (int ks = 0; ks < 2; ++ks) acc = __builtin_amdgcn_mfma_f32_16x16x32_bf16(frag(lds + L_QI, 16 * mt + fr, 32 * ks + 8 * fq), frag(lds + L_KI, 16 * nt + fr, 32 * ks + 8 * fq), acc, 0, 0, 0);
            LAS bf16_t* ap = (LAS bf16_t*)(lds + L_ATT); const int sc = 16 * nt + fr;
#pragma unroll
            for (int r = 0; r < 4; ++r) { const int c = 16 * mt + 4 * fq + r; ap[c * GP + sc] = (bf16_t)f2bf(sc <= c ? acc[r] : 0.f); } }
        __syncthreads();
        { const int mt = wave >> 1;
#pragma unroll
            for (int j = 0; j < 4; ++j) { const int nt = (wave & 1) * 4 + j; f32x4 acc = {0.f, 0.f, 0.f, 0.f};
#pragma unroll
                for (int ks = 0; ks < 2; ++ks) { acc = __builtin_amdgcn_mfma_f32_16x16x32_bf16(frag(lds + L_ATT, 16 * mt + fr, 32 * ks + 8 * fq), frag(lds + L_VT, 16 * nt + fr, 32 * ks + 8 * fq), acc, 0, 0, 0);
                    acc = __builtin_amdgcn_mfma_f32_16x16x32_bf16(frag(lds + L_QI, 16 * mt + fr, 32 * ks + 8 * fq), cur.sp[j][ks], acc, 0, 0, 0); }
#pragma unroll
                for (int r = 0; r < 4; ++r) Of[(16 * mt + 4 * fq + r) * OFP + 16 * nt + fr] = acc[r]; } }
        const u32x4 r0 = cur.r0, r1 = cur.r1;
        if (h < 3) ld_out(cur, LOGA, Ugla, SPt, row0, h + 1, ((b * 4 + h + 1) << 6) + n, tid, lane, wave);
        __syncthreads();
        { const int c = tid >> 3, v0 = (tid & 7) * 16; float o[16]; float ss = 0.f;
#pragma unroll
            for (int e = 0; e < 16; e += 4) { const f32x4 t4 = *(const LAS f32x4*)(Of + c * OFP + v0 + e); o[e] = t4.x; o[e + 1] = t4.y; o[e + 2] = t4.z; o[e + 3] = t4.w; ss += (t4.x * t4.x + t4.y * t4.y) + (t4.z * t4.z + t4.w * t4.w); }
            ss += __shfl_xor(ss, 1); ss += __shfl_xor(ss, 2); ss += __shfl_xor(ss, 4);
            const float rstd = rsqrtf(ss * (1.f / 128.f) + 1e-6f);
            const unsigned rw[8] = {r0.x, r0.y, r0.z, r0.w, r1.x, r1.y, r1.z, r1.w}; unsigned ow[8];
#pragma unroll
            for (int e = 0; e < 8; ++e) { const float a = o[2 * e] * rstd * gog[v0 + 2 * e] * siluf_(lo_bf(rw[e])), b2 = o[2 * e + 1] * rstd * gog[v0 + 2 * e + 1] * siluf_(hi_bf(rw[e])); ow[e] = pk2(a, b2); }
            bf16_t* op = OA + (row0 + c) * 512 + h * 128 + v0; *(u32x4*)op = (u32x4){ow[0], ow[1], ow[2], ow[3]}; *(u32x4*)(op + 8) = (u32x4){ow[4], ow[5], ow[6], ow[7]}; }
    }
}
}

#define XB_TMO      128
#define XB_XCNT(j)  (256  + 64 * (j))
#define XB_XSUB(j)  (1280 + 64 * (j))
#define XB_XGEN(j)  (2304 + 64 * (j))
#define XB_TOP      3328
#define XB_TOPGEN   3392
#define XCD_BAR_WORDS 3456
#define XB_SPIN_CAP (1u << 18)
__device__ __forceinline__ unsigned xb_ld(unsigned* p)              { return __hip_atomic_load(p, __ATOMIC_RELAXED, __HIP_MEMORY_SCOPE_AGENT); }
__device__ __forceinline__ unsigned xb_add(unsigned* p, unsigned v) { return __hip_atomic_fetch_add(p, v, __ATOMIC_RELAXED, __HIP_MEMORY_SCOPE_AGENT); }
__device__ __forceinline__ unsigned xb_xcc_id() { return (unsigned)__builtin_amdgcn_s_getreg((3 << 11) | 20) & 0xFu; }
#define XB_SPIN(cond, bar) do { unsigned _sp = 0; while (cond) { __builtin_amdgcn_s_sleep(1); \
    if ((++_sp & 255u) == 0u) { if (xb_ld(&(bar)[XB_TMO])) break; if (_sp > XB_SPIN_CAP) { atomicAdd(&(bar)[XB_TMO], 1u); break; } } } } while (0)
struct XcdBarrier { unsigned* bar; unsigned x; volatile LAS unsigned* st; };
__device__ __forceinline__ XcdBarrier xcd_barrier_post(unsigned* bar, volatile LAS unsigned* st) {
    XcdBarrier b; b.bar = bar; b.x = xb_xcc_id(); b.st = st;
    if (threadIdx.x == 0) (void)xb_add(&bar[XB_XCNT(b.x)], 1u);
    return b;
}
__device__ __forceinline__ void xcd_barrier_complete(unsigned* bar, unsigned x, unsigned& nloc, unsigned& nx) {
    const unsigned G = gridDim.x * gridDim.y * gridDim.z;
    unsigned sum, cnt, mine, sp = 0u;
    for (;;) {
        sum = 0u; cnt = 0u; mine = 0u;
#pragma unroll
        for (unsigned j = 0; j < 16; ++j) { const unsigned c = xb_ld(&bar[XB_XCNT(j)]); sum += c; cnt += (c > 0u) ? 1u : 0u; mine = (j == x) ? c : mine; }
        if (sum == G) break;
        __builtin_amdgcn_s_sleep(1);
        if ((++sp & 255u) == 0u) { if (xb_ld(&bar[XB_TMO])) break; if (sp > XB_SPIN_CAP) { atomicAdd(&bar[XB_TMO], 1u); break; } }
    }
    nloc = mine > 0u ? mine : 1u; nx = cnt > 0u ? cnt : 1u;
}
__device__ __forceinline__ void xcd_barrier(const XcdBarrier& b) {
    asm volatile("s_waitcnt vmcnt(0)" ::: "memory");
    __syncthreads();
    if (threadIdx.x == 0) {
        unsigned* bar = b.bar;
        __builtin_amdgcn_s_waitcnt(0);
        unsigned nloc = b.st[0], nx = b.st[1];
        if (nloc == 0u) { xcd_barrier_complete(bar, b.x, nloc, nx); b.st[0] = nloc; b.st[1] = nx; }
        const unsigned old = xb_add(&bar[XB_XSUB(b.x)], 1u);
        const unsigned gen = old / nloc;
        if (old + 1u == (gen + 1u) * nloc) {
            __builtin_amdgcn_fence(__ATOMIC_RELEASE, "agent");
            asm volatile("s_waitcnt vmcnt(0)" ::: "memory");
            const unsigned og = xb_add(&bar[XB_TOP], 1u);
            const unsigned tg = og / nx;
            if (og + 1u == (tg + 1u) * nx) xb_add(&bar[XB_TOPGEN], 1u);
            else XB_SPIN(xb_ld(&bar[XB_TOPGEN]) == tg, bar);
            __builtin_amdgcn_fence(__ATOMIC_ACQUIRE, "agent");
            xb_add(&bar[XB_XGEN(b.x)], 1u);
            asm volatile("s_waitcnt vmcnt(0)" ::: "memory");
        } else {
            XB_SPIN(xb_ld(&bar[XB_XGEN(b.x)]) == gen, bar);
            __builtin_amdgcn_fence(__ATOMIC_ACQUIRE, "agent");
            asm volatile("s_waitcnt vmcnt(0)" ::: "memory");
        }
    }
    __syncthreads();
}

struct Args { const void* in[28]; float* out; unsigned char* ws; int ph_lo, ph_hi; };
enum { I_X = 0, I_C, I_POS, I_ADAW, I_ADAB, I_N1G, I_N2G, I_WIN, I_AUP, I_AB, I_GOG, I_DQG, I_DKG, I_LQ1, I_LK1, I_LQ2, I_LK2, I_DOG, I_WBA, I_WBB, I_WOUT, I_RGW, I_RGB, I_REW, I_REB, I_EW1, I_EW3, I_EW2 };

struct TrJob { const float* src; bf16_t* dst; int ldn, kdst; };
__device__ __forceinline__ void tr_load(f32x4 (&v)[8], const TrJob& J, int lane) {
#pragma unroll
    for (int i = 0; i < 8; ++i) v[i] = *(const f32x4*)(J.src + (size_t)(8 * i + (lane >> 3)) * J.ldn + (lane & 7) * 4);
}
__device__ __forceinline__ void tr_store(const f32x4 (&v)[8], const TrJob& J, LAS float* scr, int lane) {
#pragma unroll
    for (int i = 0; i < 8; ++i) { LAS float* p = scr + (8 * i + (lane >> 3)) * 33 + (lane & 7) * 4; p[0] = v[i].x; p[1] = v[i].y; p[2] = v[i].z; p[3] = v[i].w; }
    LDS_WAIT(); asm volatile("" ::: "memory");
    const int c = lane & 7;
#pragma unroll
    for (int j = 0; j < 4; ++j) { const int n = (lane >> 3) + 8 * j; const LAS float* sp = scr + (8 * c) * 33 + n;
        u32x4 o; o.x = pk2(sp[0 * 33], sp[1 * 33]); o.y = pk2(sp[2 * 33], sp[3 * 33]); o.z = pk2(sp[4 * 33], sp[5 * 33]); o.w = pk2(sp[6 * 33], sp[7 * 33]);
        *(u32x4*)(J.dst + (size_t)n * J.kdst + 8 * c) = o; }
    LDS_WAIT(); asm volatile("" ::: "memory");
}
template <class Dec> __device__ __forceinline__ void tr_run(int first, int total, int stride, const Dec& dec, LAS float* scr, int lane) {
    int it = first; if (it >= total) return;
    TrJob J0 = dec(it), J1 = J0; f32x4 a[8], b[8];
    tr_load(a, J0, lane);
    const bool has1 = it + stride < total; if (has1) { J1 = dec(it + stride); tr_load(b, J1, lane); }
    for (;;) {
        const int n2 = it + 2 * stride; const bool more2 = n2 < total; TrJob J2 = J1; f32x4 c[8];
        if (more2) { J2 = dec(n2); tr_load(c, J2, lane); }
        tr_store(a, J0, scr, lane);
        if (it + stride >= total) break;
#pragma unroll
        for (int i = 0; i < 8; ++i) { a[i] = b[i]; b[i] = c[i]; }
        J0 = J1; J1 = J2; it += stride;
    }
}
struct DecDense { const float *w_in, *wa, *wb, *wo; bf16_t *Win_t, *Wa_t, *Wb_t, *Wout_t;
    __device__ __forceinline__ TrJob operator()(int r) const {
        if (r < 2560) { const int kb = r / 160, nb = r % 160, n0 = 32 * nb, ns = n0 < 1536 ? n0 : n0 + 16; return TrJob{w_in + (size_t)(64 * kb) * DIN + ns, Win_t + (size_t)n0 * D + 64 * kb, DIN, D}; }
        r -= 2560;
        if (r < 256) { const int kb = r / 32, nb = r % 32; return TrJob{wa + (size_t)(64 * kb) * D + 32 * nb, Wa_t + (size_t)(32 * nb) * 512 + 64 * kb, D, 512}; }
        r -= 256;
        if (r < 256) { const int kb = r / 32, nb = r % 32; return TrJob{wb + (size_t)(64 * kb) * D + 32 * nb, Wb_t + (size_t)(32 * nb) * 512 + 64 * kb, D, 512}; }
        r -= 256;
        { const int kb = r / 32, nb = r % 32; return TrJob{wo + (size_t)(64 * kb) * D + 32 * nb, Wout_t + (size_t)(32 * nb) * D + 64 * kb, D, D}; }
    } };
struct DecExp { const float *w1, *w3, *w2; bf16_t *W13_t, *W2_t;
    __device__ __forceinline__ TrJob operator()(int it) const {
        const int e = it / 768, r = it % 768;
        if (r < 512) { const int kb = r >> 5, nb = r & 31, r0 = 32 * nb, pn = r0 >> 8, half = (r0 >> 7) & 1, jj = r0 & 127;
            const float* p1 = w1; const float* p3 = w3; asm volatile("" : "+s"(p1), "+s"(p3));
            return TrJob{(half ? p3 : p1) + (size_t)e * D * DEXP + (size_t)(64 * kb) * DEXP + 128 * pn + jj, W13_t + (size_t)e * 1024 * 1024 + (size_t)r0 * D + 64 * kb, DEXP, D}; }
        const int r2 = r - 512, kb = r2 >> 5, nb = r2 & 31;
        return TrJob{w2 + (size_t)e * DEXP * D + (size_t)(64 * kb) * D + 32 * nb, W2_t + (size_t)e * 1024 * 512 + (size_t)(32 * nb) * DEXP + 64 * kb, D, DEXP};
    } };

#define PHASE_LOCALS int tid_l = threadIdx.x; asm volatile("" : "+v"(tid_l)); int cb_l = blockIdx.x; asm volatile("" : "+s"(cb_l)); \
    const int tid = tid_l, lane = tid & 63, wave = __builtin_amdgcn_readfirstlane(tid >> 6), cb = cb_l, G = 256, gw = cb * NWAVES + wave, NGW = G * NWAVES; (void)lane; (void)gw; (void)NGW; (void)G;
template <int IDX> __device__ __forceinline__ const void* ldarg() {
    unsigned long long p;
    asm volatile("s_load_dwordx2 %0, %1, %2\n\ts_waitcnt lgkmcnt(0)" : "=s"(p) : "s"(__builtin_amdgcn_kernarg_segment_ptr()), "n"(IDX * 8) : "memory");
    return (const void*)(GAS const void*)p;
}
#define ARG_IN(i) (ldarg<(i)>())
#define ARG_WS ((unsigned char*)ldarg<29>())
#define XIN ((const float*)ARG_IN(I_X))
#define OUTP ((float*)ldarg<28>())
#define P_MODP ((float*)(ARG_WS + WS_MODP))
#define P_MODF ((float*)(ARG_WS + WS_MODF))
#define P_ALR ((float*)(ARG_WS + WS_ALR))
#define P_WIN ((bf16_t*)(ARG_WS + WS_WIN))
#define P_WA ((bf16_t*)(ARG_WS + WS_WA))
#define P_WB ((bf16_t*)(ARG_WS + WS_WB))
#define P_WOUT ((bf16_t*)(ARG_WS + WS_WOUT))
#define P_XN ((bf16_t*)(ARG_WS + WS_XN))
#define P_LOGA ((float*)(ARG_WS + WS_LOGA))
#define P_SCT ((float*)(ARG_WS + WS_SCT))
#define P_SPT ((bf16_t*)(ARG_WS + WS_SPT))
#define P_OC ((bf16_t*)(ARG_WS + WS_OC))
#define P_DEC ((float*)(ARG_WS + WS_DEC))
#define P_WRT ((float*)(ARG_WS + WS_WRT))
#define P_LRT ((float*)(ARG_WS + WS_LRT))
#define P_OB ((bf16_t*)(ARG_WS + WS_OB))
#define P_OA ((bf16_t*)(ARG_WS + WS_OA))
#define P_XS ((bf16_t*)(ARG_WS + WS_XS))
#define P_Y ((bf16_t*)(ARG_WS + WS_Y))
#define P_UGLA ((bf16_t*)(ARG_WS + WS_UGLA))
#define P_UDIFF ((bf16_t*)(ARG_WS + WS_UDIFF))
#define P_UGATE ((bf16_t*)(ARG_WS + WS_UGATE))
#define P_M1 ((bf16_t*)(ARG_WS + WS_M1))
#define P_MERGED ((bf16_t*)(ARG_WS + WS_MERGED))
#define P_H2 ((bf16_t*)(ARG_WS + WS_H2))
#define P_W13 ((bf16_t*)(ARG_WS + WS_W13))
#define P_W2 ((bf16_t*)(ARG_WS + WS_W2))
#define P_HMID ((bf16_t*)(ARG_WS + WS_HMID))
#define P_TOKE ((int*)(ARG_WS + WS_ROUTE + RT_TOKE))
#define P_TOKW ((float*)(ARG_WS + WS_ROUTE + RT_TOKW))
#define P_RANK ((int*)(ARG_WS + WS_ROUTE + RT_RANK))
#define P_SLOT ((int*)(ARG_WS + WS_ROUTE + RT_SLOT))
#define P_BLKCNT ((int*)(ARG_WS + WS_ROUTE + RT_BLKCNT))
#define P_TILEE ((int*)(ARG_WS + WS_ROUTE + RT_TILEE))
#define P_NT ((int*)(ARG_WS + WS_ROUTE + RT_NT))
template <int LO, int HI>
__global__ void __launch_bounds__(NTHR, 2) mk_fwd(Args args) {
    extern __shared__ __attribute__((aligned(16))) unsigned char lds_raw[];
    LAS unsigned char* lds = (LAS unsigned char*)lds_raw;
    volatile LAS unsigned* MISC = (volatile LAS unsigned*)(lds + MISC_OFF);
    unsigned* ctl = (unsigned*)(ARG_WS + WS_CTL);
    for (int u = threadIdx.x; u < (LDS_BYTES - LDSCTL_OFF) / 4; u += NTHR) ((LAS unsigned*)(lds + LDSCTL_OFF))[u] = 0u;
    __syncthreads();
    constexpr int lo = LO, hi = HI;
    XcdBarrier bar; bar.bar = ctl + CW_BAR; bar.x = 0; bar.st = nullptr;
    if constexpr (hi - lo > 1) bar = xcd_barrier_post(ctl + CW_BAR, MISC + 8);
#define IN(k) (lo <= (k) && (k) < hi)
#define SEAM(k) do { if constexpr (IN(k) && IN((k) + 1)) xcd_barrier(bar); } while (0)

    if constexpr (IN(0)) {
        asm volatile("; PHASE_BEGIN 0" ::: "memory");
        PHASE_LOCALS
        float* modp = P_MODP; bf16_t* Win_t = P_WIN; bf16_t* Wa_t = P_WA; bf16_t* Wb_t = P_WB; bf16_t* Wout_t = P_WOUT;
        const float* cvec = (const float*)ARG_IN(I_C); const float* ada_w = (const float*)ARG_IN(I_ADAW);
        const float* w_in = (const float*)ARG_IN(I_WIN);
        LAS float* scr = (LAS float*)(lds + wave * 16384);
        for (int r = gw; r < 768; r += NGW) {
            const int jc = r % 24, kc = r / 24, j = jc * 256 + lane * 4;
            f32x4 a0 = {0, 0, 0, 0}, a1 = a0, a2 = a0, a3 = a0;
#pragma unroll 8
            for (int kk = 0; kk < 32; ++kk) { const int k = kc * 32 + kk; const f32x4 w = *(const f32x4*)(ada_w + (size_t)k * NMOD + j);
                a0 += siluf_(cvec[k]) * w; a1 += siluf_(cvec[D + k]) * w; a2 += siluf_(cvec[2 * D + k]) * w; a3 += siluf_(cvec[3 * D + k]) * w; }
            *(f32x4*)(modp + (size_t)(kc * 4 + 0) * NMOD + j) = a0; *(f32x4*)(modp + (size_t)(kc * 4 + 1) * NMOD + j) = a1;
            *(f32x4*)(modp + (size_t)(kc * 4 + 2) * NMOD + j) = a2; *(f32x4*)(modp + (size_t)(kc * 4 + 3) * NMOD + j) = a3; }
        { const float* Wrg = (const float*)ARG_IN(I_RGW); const float* Wre = (const float*)ARG_IN(I_REW); float* WrT = P_WRT;
          for (int idx = cb * NTHR + tid; idx < 36 * D; idx += G * NTHR) { const int j = idx >> 10, k = idx & 1023; WrT[idx] = j < 4 ? Wrg[k * 4 + j] : Wre[k * 32 + (j - 4)]; } }
        { float* LrT = P_LRT;
          for (int idx = cb * NTHR + tid; idx < 16 * D; idx += G * NTHR) { const int r = idx >> 10, k = idx & 1023; LrT[idx] = w_in[(size_t)k * DIN + 1536 + r]; } }
        { const DecDense dec{w_in, (const float*)ARG_IN(I_WBA), (const float*)ARG_IN(I_WBB), (const float*)ARG_IN(I_WOUT), Win_t, Wa_t, Wb_t, Wout_t};
          tr_run(gw, 2560 + 256 + 256 + 512, NGW, dec, scr, lane); }
    }
    SEAM(0);

    if constexpr (IN(1)) {
        asm volatile("; PHASE_BEGIN 1" ::: "memory");
        PHASE_LOCALS
        const float* x = XIN; float* modp = P_MODP; float* modf = P_MODF; float* alr = P_ALR; bf16_t* XN = P_XN;
        const float* ada_b = (const float*)ARG_IN(I_ADAB); const float* g1 = (const float*)ARG_IN(I_N1G);
        LAS float* modS = (LAS float*)lds;
        const float* LrT = P_LRT;
        const int b = cb >> 6;
        f32x4 hv[8][4];
        const size_t m0 = (size_t)cb * 64 + wave * 8;
#pragma unroll
        for (int i = 0; i < 8; ++i) { const f32x4* xr = (const f32x4*)(x + (m0 + i) * D) + lane;
#pragma unroll
            for (int j = 0; j < 4; ++j) hv[i][j] = xr[64 * j]; }
        { const int j = tid * 4; f32x4 s = *(const f32x4*)(ada_b + j);
#pragma unroll 8
            for (int kc = 0; kc < 32; ++kc) s += *(const f32x4*)(modp + (size_t)(kc * 4 + b) * NMOD + j);
            if (j >= D) s += 1.0f;
            *(LAS f32x4*)(modS + j) = s; }
        if (tid < 96) { const int idx = cb * 96 + tid, bb = idx / NMOD, j = idx % NMOD; float s = ada_b[j];
#pragma unroll 8
            for (int kc = 0; kc < 32; ++kc) s += modp[(size_t)(kc * 4 + bb) * NMOD + j];
            modf[idx] = s; }
        __syncthreads();
#pragma unroll
        for (int i = 0; i < 8; ++i) { float ss = 0.f;
#pragma unroll
            for (int j = 0; j < 4; ++j) ss += (hv[i][j].x * hv[i][j].x + hv[i][j].y * hv[i][j].y) + (hv[i][j].z * hv[i][j].z + hv[i][j].w * hv[i][j].w);
            const float rstd = rsqrtf(wave_sum(ss) * (1.f / D) + 1e-6f);
            unsigned long long* o8 = (unsigned long long*)(XN + (m0 + i) * D) + lane;
#pragma unroll
            for (int j = 0; j < 4; ++j) { const int k = 4 * lane + 256 * j; const f32x4 gg = *(const f32x4*)(g1 + k); const f32x4 sh = *(const LAS f32x4*)(modS + k); const f32x4 sc = *(const LAS f32x4*)(modS + D + k);
                hv[i][j] = hv[i][j] * rstd * gg * sc + sh;
                o8[64 * j] = (unsigned long long)pk2(hv[i][j].x, hv[i][j].y) | ((unsigned long long)pk2(hv[i][j].z, hv[i][j].w) << 32); } }
        { float res[8];
#pragma unroll
          for (int i = 0; i < 8; ++i) res[i] = 0.f;
          f32x4 wn[4];
#pragma unroll
          for (int jj = 0; jj < 4; ++jj) wn[jj] = *(const f32x4*)(LrT + 4 * lane + 256 * jj);
#pragma unroll 1
          for (int r = 0; r < 16; ++r) {
            f32x4 w[4];
#pragma unroll
            for (int jj = 0; jj < 4; ++jj) w[jj] = wn[jj];
            const int rn = r < 15 ? r + 1 : r;
#pragma unroll
            for (int jj = 0; jj < 4; ++jj) wn[jj] = *(const f32x4*)(LrT + (size_t)rn * D + 4 * lane + 256 * jj);
#pragma unroll
            for (int i = 0; i < 8; ++i) { float a = 0.f;
#pragma unroll
                for (int jj = 0; jj < 4; ++jj) a += (hv[i][jj].x * w[jj].x + hv[i][jj].y * w[jj].y) + (hv[i][jj].z * w[jj].z + hv[i][jj].w * w[jj].w);
                a = wave_sum(a); if (lane == r) res[i] = a; }
          }
#pragma unroll
          for (int i = 0; i < 8; ++i) if (lane < 16) alr[(m0 + i) * 16 + lane] = res[i]; }
    }
    SEAM(1);

    if constexpr (IN(2)) {
        asm volatile("; PHASE_BEGIN 2" ::: "memory");
        PHASE_LOCALS
        bf16_t* XN = P_XN; bf16_t* Win_t = P_WIN; bf16_t* Ugla = P_UGLA; bf16_t* Udiff = P_UDIFF; bf16_t* Ugate = P_UGATE;
        pg8::DenseOrder S; S.init(XN, Win_t, M, NPROJ, D, G, cb);
        pg8::EpiInProj E{Ugla, Udiff, Ugate};
        pg8::gemm_phase<pg8::EpiInProj, pg8::DenseOrder, true, true>(lds, D, S, E);
    }
    SEAM(2);

    if constexpr (IN(3)) {
        asm volatile("; PHASE_BEGIN 3" ::: "memory");
        PHASE_LOCALS
        bf16_t* Udiff = P_UDIFF; float* alr = P_ALR; float* LOGA = P_LOGA;
        const int* pos = (const int*)ARG_IN(I_POS); const float* qg = (const float*)ARG_IN(I_DQG); const float* kg = (const float*)ARG_IN(I_DKG);
        const float* aup = (const float*)ARG_IN(I_AUP); const float* ab = (const float*)ARG_IN(I_AB);
        const float invf = powf(500000.0f, -(float)(lane & 7) * 0.125f);
        const size_t m0 = (size_t)cb * 64 + wave * 8;
        u32x4 w0[8], w1[8]; float posv[8], av[8];
#pragma unroll
        for (int i = 0; i < 8; ++i) { const bf16_t* rowp = Udiff + (m0 + i) * 1536 + lane * 16; w0[i] = *(const u32x4*)rowp; w1[i] = *(const u32x4*)(rowp + 8);
            posv[i] = (float)pos[m0 + i]; av[i] = alr[(m0 + i) * 16 + (lane & 15)]; }
        float gain[16];
#pragma unroll
        for (int e = 0; e < 16; ++e) gain[e] = (lane < 32 ? qg : kg)[(lane & 3) * 16 + e];
        float au[16][4], abv[4];
#pragma unroll
        for (int q = 0; q < 4; ++q) { abv[q] = ab[lane + 64 * q];
#pragma unroll
            for (int rr = 0; rr < 16; ++rr) au[rr][q] = aup[rr * 256 + lane + 64 * q]; }
#pragma unroll
        for (int i = 0; i < 8; ++i) {
            float y[16];
            y[0] = lo_bf(w0[i].x); y[1] = hi_bf(w0[i].x); y[2] = lo_bf(w0[i].y); y[3] = hi_bf(w0[i].y); y[4] = lo_bf(w0[i].z); y[5] = hi_bf(w0[i].z); y[6] = lo_bf(w0[i].w); y[7] = hi_bf(w0[i].w);
            y[8] = lo_bf(w1[i].x); y[9] = hi_bf(w1[i].x); y[10] = lo_bf(w1[i].y); y[11] = hi_bf(w1[i].y); y[12] = lo_bf(w1[i].z); y[13] = hi_bf(w1[i].z); y[14] = lo_bf(w1[i].w); y[15] = hi_bf(w1[i].w);
            float ss = 0.f;
#pragma unroll
            for (int e = 0; e < 16; ++e) ss += y[e] * y[e];
            ss += __shfl_xor(ss, 1); ss += __shfl_xor(ss, 2);
            const float rstd = rsqrtf(ss * (1.f / 64.f) + 1e-6f);
#pragma unroll
            for (int e = 0; e < 16; ++e) y[e] = y[e] * rstd * gain[e];
            const float ang = posv[i] * invf; float sv, cv; sincosf(ang, &sv, &cv);
            float r[16];
#pragma unroll
            for (int e = 0; e < 8; ++e) { const float c_ = __shfl(cv, e), s_ = __shfl(sv, e); r[e] = y[e] * c_ - y[e + 8] * s_; r[e + 8] = y[e + 8] * c_ + y[e] * s_; }
            if ((lane & 3) == 0) {
#pragma unroll
                for (int e = 0; e < 16; ++e) y[e] = r[e]; }
            if (lane < 32) {
#pragma unroll
                for (int e = 0; e < 16; ++e) y[e] *= attn_body::C2; }
            u32x4 o0, o1; o0.x = pk2(y[0], y[1]); o0.y = pk2(y[2], y[3]); o0.z = pk2(y[4], y[5]); o0.w = pk2(y[6], y[7]); o1.x = pk2(y[8], y[9]); o1.y = pk2(y[10], y[11]); o1.z = pk2(y[12], y[13]); o1.w = pk2(y[14], y[15]);
            bf16_t* rowp = Udiff + (m0 + i) * 1536 + lane * 16;
            *(u32x4*)rowp = o0; *(u32x4*)(rowp + 8) = o1;
            float xv[4];
#pragma unroll
            for (int q = 0; q < 4; ++q) xv[q] = abv[q];
#pragma unroll
            for (int rr = 0; rr < 16; ++rr) { const float a = __shfl(av[i], rr);
#pragma unroll
                for (int q = 0; q < 4; ++q) xv[q] += a * au[rr][q]; }
#pragma unroll
            for (int q = 0; q < 4; ++q) { const float ls = fminf(xv[q], 0.f) - log1pf(__expf(-fabsf(xv[q]))); LOGA[(m0 + i) * 256 + lane + 64 * q] = ls * (1.f / 16.f); }
        }
        VM_WAIT(); __syncthreads();
        gla::chunk_state4(lds, cb >> 6, cb & 63, LOGA, P_UGLA, P_SCT, P_DEC, tid, lane, wave);
    }
    SEAM(3);

    if constexpr (IN(4)) {
        asm volatile("; PHASE_BEGIN 4" ::: "memory");
        PHASE_LOCALS
        { const float* SCt = P_SCT; const float* DEC = P_DEC; bf16_t* SPt = P_SPT;
          const int idx = cb * NTHR + tid, bh = idx >> 13, e = idx & 8191, k = e & 63; float st = 0.f;
#pragma unroll 8
          for (int n = 0; n < 64; ++n) { const size_t q = (size_t)bh * 64 + n; const float sc = SCt[q * 8192 + e], d = DEC[q * 64 + k]; SPt[q * 8192 + e] = (bf16_t)f2bf(st); st = st * d + sc; } }
        { const int vcu = (cb % 8) * (G / 8) + cb / 8;
          attn_body::attn_phase<8>((char*)lds_raw, (const attn_body::bf16*)P_UDIFF, (attn_body::bf16*)P_OC, vcu); }
    }
    SEAM(4);

    if constexpr (IN(5)) {
        asm volatile("; PHASE_BEGIN 5" ::: "memory");
        PHASE_LOCALS
        { const float* lq1 = (const float*)ARG_IN(I_LQ1); const float* lk1 = (const float*)ARG_IN(I_LK1); const float* lq2 = (const float*)ARG_IN(I_LQ2); const float* lk2 = (const float*)ARG_IN(I_LK2);
          const float* og = (const float*)ARG_IN(I_DOG); const bf16_t* Oc = P_OC; bf16_t* OB = P_OB;
          const float lam = __expf(wave_sum(lq1[lane] * lk1[lane])) - __expf(wave_sum(lq2[lane] * lk2[lane])) + 0.2f;
          const size_t m0 = (size_t)cb * 64 + wave * 8; const int col0 = lane * 8;
          u32x4 av[8], bv[8];
#pragma unroll
          for (int i = 0; i < 8; ++i) { av[i] = *(const u32x4*)(Oc + (m0 + i) * 512 + col0); bv[i] = *(const u32x4*)(Oc + (size_t)M * 512 + (m0 + i) * 512 + col0); }
          float ogv[8];
#pragma unroll
          for (int e = 0; e < 8; ++e) ogv[e] = og[(col0 & 127) + e];
#pragma unroll
          for (int i = 0; i < 8; ++i) {
            const unsigned aw[4] = {av[i].x, av[i].y, av[i].z, av[i].w}, bw[4] = {bv[i].x, bv[i].y, bv[i].z, bv[i].w}; float o[8]; float ss = 0.f;
#pragma unroll
            for (int e = 0; e < 4; ++e) { o[2 * e] = lo_bf(aw[e]) - lam * lo_bf(bw[e]); o[2 * e + 1] = hi_bf(aw[e]) - lam * hi_bf(bw[e]); ss += o[2 * e] * o[2 * e] + o[2 * e + 1] * o[2 * e + 1]; }
            ss += __shfl_xor(ss, 1); ss += __shfl_xor(ss, 2); ss += __shfl_xor(ss, 4); ss += __shfl_xor(ss, 8);
            const float rstd = rsqrtf(ss * (1.f / 128.f) + 1e-6f) * 0.8f; unsigned ow[4];
#pragma unroll
            for (int e = 0; e < 4; ++e) ow[e] = pk2(o[2 * e] * rstd * ogv[2 * e], o[2 * e + 1] * rstd * ogv[2 * e + 1]);
            *(u32x4*)(OB + (m0 + i) * 512 + col0) = (u32x4){ow[0], ow[1], ow[2], ow[3]}; } }
        __syncthreads();
        gla::chunk_out4(lds, cb >> 6, cb & 63, P_LOGA, P_UGLA, P_SPT, (const float*)ARG_IN(I_GOG), P_OA, tid, lane, wave);
    }
    SEAM(5);

    if constexpr (IN(6)) {
        asm volatile("; PHASE_BEGIN 6" ::: "memory");
        PHASE_LOCALS
        bf16_t* OA = P_OA; bf16_t* OB = P_OB; bf16_t* Wa_t = P_WA; bf16_t* Wb_t = P_WB; bf16_t* Ugate = P_UGATE; bf16_t* M1 = P_M1; bf16_t* MERGED = P_MERGED;
        { pg8::DenseOrder S; S.init(OA, Wa_t, M, D, 512, G, cb); pg8::EpiBranch E{Ugate, 0, nullptr, M1};
          pg8::gemm_phase<pg8::EpiBranch, pg8::DenseOrder, true, true>(lds, 512, S, E); }
        VM_WAIT(); __syncthreads();
        { pg8::DenseOrder S; S.init(OB, Wb_t, M, D, 512, G, cb); pg8::EpiBranch E{Ugate, 1024, M1, MERGED};
          pg8::gemm_phase<pg8::EpiBranch, pg8::DenseOrder, true, true>(lds, 512, S, E); }
    }
    SEAM(6);

    if constexpr (IN(7)) {
        asm volatile("; PHASE_BEGIN 7" ::: "memory");
        PHASE_LOCALS
        const float* x = XIN; float* out = OUTP; float* modf = P_MODF; bf16_t* MERGED = P_MERGED; bf16_t* Wout_t = P_WOUT;
        pg8::DenseOrder S; S.init(MERGED, Wout_t, M, D, D, G, cb); pg8::EpiWout E{x, modf, out};
        pg8::gemm_phase<pg8::EpiWout, pg8::DenseOrder, true, true>(lds, D, S, E);
    }
    SEAM(7);

    if constexpr (IN(8)) {
        asm volatile("; PHASE_BEGIN 8" ::: "memory");
        PHASE_LOCALS
        float* out = OUTP; float* modf = P_MODF; bf16_t* H2 = P_H2; bf16_t* W13_t = P_W13; bf16_t* W2_t = P_W2; int* tok_e = P_TOKE; float* tok_w = P_TOKW; int* tok_rank = P_RANK; int* blkcnt = P_BLKCNT;
        const float* g2 = (const float*)ARG_IN(I_N2G); const float* brg = (const float*)ARG_IN(I_RGB); const float* bre = (const float*)ARG_IN(I_REB); const float* WrT = P_WRT;
        LAS float* modS = (LAS float*)lds;
        LAS int* eS = (LAS int*)(lds + 8192);
        LAS float* LG = (LAS float*)(lds + 8192 + 512);
        const int b = cb >> 6;
        for (int j = tid; j < 2048; j += NTHR) modS[j] = modf[(size_t)b * NMOD + 3 * D + j] + (j >= D ? 1.0f : 0.f);
        __syncthreads();
        if (wave < 4) {
            const float biasv = lane < 4 ? brg[lane] : (lane < 36 ? bre[lane - 4] : 0.f);
            LAS float* lgw = LG + wave * 320;
#pragma unroll 1
            for (int hb = 0; hb < 2; ++hb) {
                f32x4 hv[8][4];
                const size_t m0 = (size_t)cb * 64 + wave * 16 + hb * 8;
#pragma unroll
                for (int i = 0; i < 8; ++i) { const f32x4* xr = (const f32x4*)(out + (m0 + i) * D) + lane;
#pragma unroll
                    for (int j = 0; j < 4; ++j) hv[i][j] = xr[64 * j]; }
#pragma unroll
                for (int i = 0; i < 8; ++i) { float ss = 0.f;
#pragma unroll
                    for (int j = 0; j < 4; ++j) ss += (hv[i][j].x * hv[i][j].x + hv[i][j].y * hv[i][j].y) + (hv[i][j].z * hv[i][j].z + hv[i][j].w * hv[i][j].w);
                    const float rstd = rsqrtf(wave_sum(ss) * (1.f / D) + 1e-6f);
                    unsigned long long* o8 = (unsigned long long*)(H2 + (m0 + i) * D) + lane;
#pragma unroll
                    for (int j = 0; j < 4; ++j) { const int k = 4 * lane + 256 * j; const f32x4 gg = *(const f32x4*)(g2 + k); const f32x4 sh = *(const LAS f32x4*)(modS + k); const f32x4 sc = *(const LAS f32x4*)(modS + D + k);
                        hv[i][j] = hv[i][j] * rstd * gg * sc + sh;
                        o8[64 * j] = (unsigned long long)pk2(hv[i][j].x, hv[i][j].y) | ((unsigned long long)pk2(hv[i][j].z, hv[i][j].w) << 32); } }
                { f32x4 wn[4];
#pragma unroll
                  for (int jj = 0; jj < 4; ++jj) wn[jj] = *(const f32x4*)(WrT + 4 * lane + 256 * jj);
#pragma unroll 1
                  for (int jx = 0; jx < 36; ++jx) {
                    f32x4 w[4];
#pragma unroll
                    for (int jj = 0; jj < 4; ++jj) w[jj] = wn[jj];
                    const int jn = jx < 35 ? jx + 1 : jx;
#pragma unroll
                    for (int jj = 0; jj < 4; ++jj) wn[jj] = *(const f32x4*)(WrT + (size_t)jn * D + 4 * lane + 256 * jj);
                    float a[8];
#pragma unroll
                    for (int i = 0; i < 8; ++i) { a[i] = 0.f;
#pragma unroll
                        for (int jj = 0; jj < 4; ++jj) a[i] += (hv[i][jj].x * w[jj].x + hv[i][jj].y * w[jj].y) + (hv[i][jj].z * w[jj].z + hv[i][jj].w * w[jj].w); }
                    float y0, y1; reduce8(a, y0, y1);
                    const float bj = __shfl(biasv, jx);
                    if ((lane & 15) == 0) { lgw[(2 * (lane >> 4)) * 40 + jx] = y0 + bj; lgw[(2 * (lane >> 4) + 1) * 40 + jx] = y1 + bj; }
                  } }
                LDS_WAIT();
                if (lane < 8) {
                    const LAS float* lr = lgw + lane * 40; const int tl = wave * 16 + hb * 8 + lane;
                    const float lg0 = lr[0], lg1 = lr[1], lg2 = lr[2], lg3 = lr[3];
                    int gi = 0; float gm = lg0; if (lg1 > gm) { gm = lg1; gi = 1; } if (lg2 > gm) { gm = lg2; gi = 2; } if (lg3 > gm) { gm = lg3; gi = 3; }
                    const float ptop = 1.0f / (__expf(lg0 - gm) + __expf(lg1 - gm) + __expf(lg2 - gm) + __expf(lg3 - gm));
                    float el[8];
#pragma unroll
                    for (int j = 0; j < 8; ++j) el[j] = lr[4 + gi * 8 + j];
                    int j0 = 0; float e0 = el[0];
#pragma unroll
                    for (int j = 1; j < 8; ++j) if (el[j] > e0) { e0 = el[j]; j0 = j; }
                    int j1 = -1; float e1 = -3.0e38f;
#pragma unroll
                    for (int j = 0; j < 8; ++j) if (j != j0 && el[j] > e1) { e1 = el[j]; j1 = j; }
                    const float t = __expf(e1 - e0), w0 = ptop / (1.0f + t), w1 = ptop * t / (1.0f + t);
                    eS[2 * tl] = gi * 8 + j0; eS[2 * tl + 1] = gi * 8 + j1; tok_w[(m0 + lane) * 2] = w0; tok_w[(m0 + lane) * 2 + 1] = w1;
                }
                LDS_WAIT();
            }
        } else {
            const DecExp dec{(const float*)ARG_IN(I_EW1), (const float*)ARG_IN(I_EW3), (const float*)ARG_IN(I_EW2), W13_t, W2_t};
            tr_run(cb * 4 + (wave - 4), NEXP * 768, G * 4, dec, (LAS float*)(lds + 16384 + (wave - 4) * 16384), lane);
        }
        __syncthreads();
        if (tid < 128) { const int e = eS[tid]; int rank = 0; for (int a = 0; a < tid; ++a) rank += (eS[a] == e) ? 1 : 0;
            tok_e[(size_t)cb * 128 + tid] = e; tok_rank[(size_t)cb * 128 + tid] = rank; }
        else if (tid < 160) { const int e = tid - 128; int cnt = 0; for (int a = 0; a < 128; ++a) cnt += (eS[a] == e) ? 1 : 0; blkcnt[cb * 32 + e] = cnt; }
    }
    SEAM(8);

    if constexpr (IN(9)) {
        asm volatile("; PHASE_BEGIN 9" ::: "memory");
        PHASE_LOCALS
        bf16_t* H2 = P_H2; bf16_t* XS = P_XS; int* tok_e = P_TOKE; int* tok_rank = P_RANK; int* tok_slot = P_SLOT; int* blkcnt = P_BLKCNT; int* tile_e = P_TILEE; int* ntiles_p = P_NT;
        LAS int* red = (LAS int*)lds;
        LAS int* totS = red + 1024;
        LAS int* preS = totS + 32;
        LAS int* padS = preS + 32;
        LAS int* slotS = padS + 64;
        { const int e = tid & 31, part = tid >> 5; int tot = 0, pre = 0;
            for (int blk = part; blk < 256; blk += 16) { const int cval = blkcnt[blk * 32 + e]; tot += cval; pre += (blk < cb) ? cval : 0; }
            red[part * 64 + e] = tot; red[part * 64 + 32 + e] = pre; }
        __syncthreads();
        if (tid < 32) { int tot = 0, pre = 0; for (int p = 0; p < 16; ++p) { tot += red[p * 64 + tid]; pre += red[p * 64 + 32 + tid]; } totS[tid] = tot; preS[tid] = pre; }
        __syncthreads();
        if (tid == 0) { int off = 0; for (int e = 0; e < 32; ++e) { padS[e] = off; off += ((totS[e] + 255) >> 8) << 8; } padS[32] = off; }
        __syncthreads();
        if (cb == 0) { if (tid < 32) { for (int t = padS[tid] >> 8; t < (padS[tid + 1] >> 8); ++t) tile_e[t] = tid; } if (tid == 32) ntiles_p[0] = padS[32] >> 8; }
        if (tid < 128) { const size_t a = (size_t)cb * 128 + tid; const int e = tok_e[a]; const int slot = padS[e] + preS[e] + tok_rank[a]; tok_slot[a] = slot; slotS[tid] = slot; }
        __syncthreads();
#pragma unroll
        for (int hb = 0; hb < 2; ++hb) {
            u32x4 v0[8], v1[8]; int sl[8];
#pragma unroll
            for (int a8 = 0; a8 < 8; ++a8) { const int a = wave * 16 + hb * 8 + a8; const size_t t = (size_t)cb * 64 + (a >> 1); sl[a8] = slotS[a];
                const u32x4* src = (const u32x4*)(H2 + t * D) + lane; v0[a8] = src[0]; v1[a8] = src[64]; }
#pragma unroll
            for (int a8 = 0; a8 < 8; ++a8) { u32x4* dst = (u32x4*)(XS + (size_t)sl[a8] * D) + lane; dst[0] = v0[a8]; dst[64] = v1[a8]; }
        }
        if (cb < 32) { const int r0 = padS[cb] + totS[cb], r1 = padS[cb + 1];
            for (int r = r0 + wave; r < r1; r += NWAVES) { u32x4* dst = (u32x4*)(XS + (size_t)r * D) + lane; dst[0] = (u32x4){0, 0, 0, 0}; dst[64] = (u32x4){0, 0, 0, 0}; } }
    }
    SEAM(9);

    if constexpr (IN(10)) {
        asm volatile("; PHASE_BEGIN 10" ::: "memory");
        PHASE_LOCALS
        bf16_t* XS = P_XS; bf16_t* W13_t = P_W13; bf16_t* HMID = P_HMID; int* tile_e = P_TILEE; int* ntiles_p = P_NT;
        const int ntm = __builtin_amdgcn_readfirstlane(ntiles_p[0]);
        pg8::MoeOrder S; S.init(XS, W13_t, tile_e, ntm, D, (size_t)1024 * 1024 * 2, G, cb); pg8::EpiUp E{HMID};
        pg8::gemm_phase<pg8::EpiUp, pg8::MoeOrder, true, true>(lds, D, S, E);
    }
    SEAM(10);

    if constexpr (IN(11)) {
        asm volatile("; PHASE_BEGIN 11" ::: "memory");
        PHASE_LOCALS
        bf16_t* HMID = P_HMID; bf16_t* W2_t = P_W2; bf16_t* Y = P_Y; int* tile_e = P_TILEE; int* ntiles_p = P_NT;
        const int ntm = __builtin_amdgcn_readfirstlane(ntiles_p[0]);
        pg8::MoeOrder S; S.init(HMID, W2_t, tile_e, ntm, DEXP, (size_t)1024 * 512 * 2, G, cb); pg8::EpiPlain E{Y, D};
        pg8::gemm_phase<pg8::EpiPlain, pg8::MoeOrder, true, true>(lds, DEXP, S, E);
    }
    SEAM(11);

    if constexpr (IN(12)) {
        asm volatile("; PHASE_BEGIN 12" ::: "memory");
        PHASE_LOCALS
        float* out = OUTP; float* modf = P_MODF; bf16_t* Y = P_Y; int* tok_slot = P_SLOT; float* tok_w = P_TOKW;
        const size_t m0 = (size_t)cb * 64 + wave * 8; const float* g2p = modf + (size_t)(cb >> 6) * NMOD + 5 * D;
        int s0[8], s1[8]; float w0[8], w1[8];
#pragma unroll
        for (int i = 0; i < 8; ++i) { s0[i] = tok_slot[(m0 + i) * 2]; s1[i] = tok_slot[(m0 + i) * 2 + 1]; w0[i] = tok_w[(m0 + i) * 2]; w1[i] = tok_w[(m0 + i) * 2 + 1]; }
        f32x4 gv[4];
#pragma unroll
        for (int j = 0; j < 4; ++j) gv[j] = *(const f32x4*)(g2p + 4 * lane + 256 * j);
#pragma unroll
        for (int hb = 0; hb < 2; ++hb) {
            f32x4 xv[4][4]; u32x2 y0[4][4], y1[4][4];
#pragma unroll
            for (int i4 = 0; i4 < 4; ++i4) { const int i = hb * 4 + i4;
#pragma unroll
                for (int j = 0; j < 4; ++j) { const int k = 4 * lane + 256 * j; xv[i4][j] = *(const f32x4*)(out + (m0 + i) * D + k);
                    y0[i4][j] = *(const u32x2*)(Y + (size_t)s0[i] * D + k); y1[i4][j] = *(const u32x2*)(Y + (size_t)s1[i] * D + k); } }
#pragma unroll
            for (int i4 = 0; i4 < 4; ++i4) { const int i = hb * 4 + i4;
#pragma unroll
                for (int j = 0; j < 4; ++j) { const int k = 4 * lane + 256 * j; f32x4 o;
                    o.x = xv[i4][j].x + gv[j].x * (w0[i] * lo_bf(y0[i4][j].x) + w1[i] * lo_bf(y1[i4][j].x)); o.y = xv[i4][j].y + gv[j].y * (w0[i] * hi_bf(y0[i4][j].x) + w1[i] * hi_bf(y1[i4][j].x));
                    o.z = xv[i4][j].z + gv[j].z * (w0[i] * lo_bf(y0[i4][j].y) + w1[i] * lo_bf(y1[i4][j].y)); o.w = xv[i4][j].w + gv[j].w * (w0[i] * hi_bf(y0[i4][j].y) + w1[i] * hi_bf(y1[i4][j].y));
                    *(f32x4*)(out + (m0 + i) * D + k) = o; } }
        }
    }
#undef IN
#undef SEAM
}

constexpr int NPHASE = 13;
template <int LO, int HI> static void launch_range(const Args& a, hipStream_t stream) {
    static bool attr = false;
    if (!attr) { (void)hipFuncSetAttribute((const void*)mk_fwd<LO, HI>, hipFuncAttributeMaxDynamicSharedMemorySize, LDS_BYTES); attr = true; }
    hipLaunchKernelGGL((mk_fwd<LO, HI>), dim3(256), dim3(NTHR), LDS_BYTES, stream, a);
}
extern "C" void kernel_launch(void* const* d_in, const int* in_sizes, int n_in, void* d_out, int out_size, void* d_ws, size_t ws_size, hipStream_t stream) {
    static int ok = 0;
    if (ok == 0) {
        if (n_in != 28 || out_size != M * D || ws_size < WS_END) { fprintf(stderr, "kernel_launch: unexpected shapes (n_in %d, out %d, ws %zu < %zu)\n", n_in, out_size, ws_size, (size_t)WS_END); ok = -1; return; }
        ok = 1;
    }
    if (ok < 0) return;
    (void)hipMemsetAsync((char*)d_ws + WS_CTL, 0, CTL_ZERO_BYTES, stream);
    Args a{};
    for (int i = 0; i < 28; ++i) a.in[i] = d_in[i];
    a.out = (float*)d_out; a.ws = (unsigned char*)d_ws; a.ph_lo = 0; a.ph_hi = NPHASE;
#if MK_ONE_LAUNCH
    launch_range<0, NPHASE>(a, stream);
#else
    launch_range<0, 1>(a, stream); launch_range<1, 2>(a, stream); launch_range<2, 3>(a, stream); launch_range<3, 4>(a, stream);
    launch_range<4, 5>(a, stream); launch_range<5, 6>(a, stream); launch_range<6, 7>(a, stream); launch_range<7, 8>(a, stream);
    launch_range<8, 9>(a, stream); launch_range<9, 10>(a, stream); launch_range<10, 11>(a, stream); launch_range<11, 12>(a, stream);
    launch_range<12, 13>(a, stream);
#endif
}
```

```cpp
#include <hip/hip_runtime.h>
#include <hip/hip_bf16.h>
#include <cstdio>
#include <cstdint>

#ifndef MK_ONE_LAUNCH
#define MK_ONE_LAUNCH 1
#endif

#define LAS __attribute__((address_space(3)))
#define GAS __attribute__((address_space(1)))
typedef unsigned short bf16_t;
typedef short bf16x8 __attribute__((ext_vector_type(8)));
typedef float f32x4 __attribute__((ext_vector_type(4)));
typedef float f32x2 __attribute__((ext_vector_type(2)));
typedef unsigned u32x4 __attribute__((ext_vector_type(4)));
typedef unsigned u32x2 __attribute__((ext_vector_type(2)));

constexpr int NB = 4, SEQ = 4096, D = 1024, M = NB * SEQ;
constexpr int DIN = 5136, NPROJ = 5120;
constexpr int NEXP = 32, DEXP = 512;
constexpr int PMAX = 40960;
constexpr int NMOD = 6 * D;

constexpr size_t MiB = 1u << 20;
constexpr size_t WS_CTL = 0, CTL_ZERO_BYTES = 1 * MiB;
constexpr size_t WS_MODP = 1 * MiB;
constexpr size_t WS_MODF = 4 * MiB;
constexpr size_t WS_ALR = 5 * MiB;
constexpr size_t WS_ROUTE = 6 * MiB;
constexpr size_t WS_WIN = 8 * MiB;
constexpr size_t WS_WA = 18 * MiB, WS_WB = 19 * MiB, WS_WOUT = 20 * MiB;
constexpr size_t RA = 22 * MiB;
constexpr size_t RB = 118 * MiB;
constexpr size_t WS_END = 278 * MiB;
constexpr size_t WS_XN = RA;
constexpr size_t WS_LOGA = RA;
constexpr size_t WS_SCT = RA + 16 * MiB;
constexpr size_t WS_SPT = RA + 48 * MiB;
constexpr size_t WS_OC = RA + 64 * MiB;
constexpr size_t WS_DEC = 7 * MiB;
constexpr size_t WS_WRT = 7 * MiB + 512 * 1024;
constexpr size_t WS_LRT = 7 * MiB + 768 * 1024;
constexpr size_t WS_OB = RB + 64 * MiB;
constexpr size_t WS_OA = RB + 48 * MiB;
constexpr size_t WS_XS = RA;
constexpr size_t WS_Y = RA;
constexpr size_t WS_UGLA = RB;
constexpr size_t WS_UDIFF = RB + 48 * MiB;
constexpr size_t WS_UGATE = RB + 96 * MiB;
constexpr size_t WS_M1 = RA;
constexpr size_t WS_MERGED = RB;
constexpr size_t WS_H2 = RA;
constexpr size_t WS_SLOTTOK = RA + 84 * MiB;
constexpr size_t WS_W13 = RB + 64 * MiB;
constexpr size_t WS_W2 = RB + 128 * MiB;
constexpr size_t WS_HMID = RB;
constexpr size_t RT_TOKE = 0, RT_TOKW = 131072, RT_RANK = 262144, RT_SLOT = 393216, RT_BLKCNT = 524288, RT_TILEE = 557056, RT_NT = 561152;
constexpr int CW_BAR = 4096;

constexpr int RING_BYTES = 131072;
constexpr int LDSCTL_OFF = RING_BYTES, MISC_OFF = LDSCTL_OFF + 320;
constexpr int LDS_BYTES = 147456;
constexpr int NWAVES = 8, NTHR = 512;

__device__ __forceinline__ float bf2f(bf16_t h) { return __uint_as_float((unsigned)h << 16); }
__device__ __forceinline__ unsigned f2bf(float f) { unsigned u = __float_as_uint(f); return (u + 0x7fffu + ((u >> 16) & 1u)) >> 16; }
typedef __bf16 bf16x2_t __attribute__((ext_vector_type(2)));
__device__ __forceinline__ unsigned pk2(float lo, float hi) { f32x2 v = {lo, hi}; bf16x2_t b = __builtin_convertvector(v, bf16x2_t); return __builtin_bit_cast(unsigned, b); }
__device__ __forceinline__ float lo_bf(unsigned w) { return __uint_as_float(w << 16); }
__device__ __forceinline__ float hi_bf(unsigned w) { return __uint_as_float(w & 0xffff0000u); }
#define DPP_ADD(v, ctrl) ((v) + __builtin_bit_cast(float, __builtin_amdgcn_update_dpp(0, __builtin_bit_cast(int, (v)), (ctrl), 0xF, 0xF, true)))
__device__ __forceinline__ float wave_sum(float v) {
    v = DPP_ADD(v, 0xB1); v = DPP_ADD(v, 0x4E); v = DPP_ADD(v, 0x141); v = DPP_ADD(v, 0x140);
    { const unsigned u = __float_as_uint(v); auto r = __builtin_amdgcn_permlane16_swap(u, u, false, false); v = __uint_as_float(r[0]) + __uint_as_float(r[1]); }
    { const unsigned u = __float_as_uint(v); auto r = __builtin_amdgcn_permlane32_swap(u, u, false, false); v = __uint_as_float(r[0]) + __uint_as_float(r[1]); }
    return v;
}
__device__ __forceinline__ float swapadd32(float x, float y) { auto r = __builtin_amdgcn_permlane32_swap(__float_as_uint(x), __float_as_uint(y), false, false); return __uint_as_float(r[0]) + __uint_as_float(r[1]); }
__device__ __forceinline__ float swapadd16(float x, float y) { auto r = __builtin_amdgcn_permlane16_swap(__float_as_uint(x), __float_as_uint(y), false, false); return __uint_as_float(r[0]) + __uint_as_float(r[1]); }
__device__ __forceinline__ void reduce8(const float (&a)[8], float& y0, float& y1) {
    const float x0 = swapadd32(a[0], a[4]), x1 = swapadd32(a[1], a[5]), x2 = swapadd32(a[2], a[6]), x3 = swapadd32(a[3], a[7]);
    y0 = swapadd16(x0, x2); y1 = swapadd16(x1, x3);
    y0 = DPP_ADD(y0, 0xB1); y0 = DPP_ADD(y0, 0x4E); y0 = DPP_ADD(y0, 0x141); y0 = DPP_ADD(y0, 0x140);
    y1 = DPP_ADD(y1, 0xB1); y1 = DPP_ADD(y1, 0x4E); y1 = DPP_ADD(y1, 0x141); y1 = DPP_ADD(y1, 0x140);
}
__device__ __forceinline__ float wave_max(float v) {
#pragma unroll
    for (int o = 1; o < 64; o <<= 1) v = fmaxf(v, __shfl_xor(v, o));
    return v;
}
__device__ __forceinline__ float sigmoidf_(float x) { return 1.0f / (1.0f + __expf(-x)); }
__device__ __forceinline__ float siluf_(float x) { return x / (1.0f + __expf(-x)); }
#define LDS_WAIT() asm volatile("s_waitcnt lgkmcnt(0)" ::: "memory")
#define VM_WAIT() asm volatile("s_waitcnt vmcnt(0)" ::: "memory")

namespace pg8 {
constexpr int BM = 256, BK = 64, HALF = 128, HTB = HALF * BK * 2, STAGE_BYTES = 8 * HTB, NXCD = 8, WGM = 8;
__host__ __device__ __forceinline__ int lds_byte(int r, int c) { const int st = (r >> 4) * 2 + (c >> 5), rr = r & 15, cc = c & 31, ob = rr * 64 + cc * 2; return st * 1024 + (ob ^ (((ob >> 9) & 1) << 5)); }
__host__ __device__ __forceinline__ void stage_rc(int b, int& R, int& C) { const int st = b / 1024, sb = b % 1024, swz = sb ^ (((sb >> 9) & 1) << 5); R = (st >> 1) * 16 + swz / 64; C = (st & 1) * 32 + (swz % 64) / 2; }
__host__ __device__ __forceinline__ int perm32(int rho) { const int n = rho >> 4, i = rho & 15; return 8 * (i >> 2) + 4 * n + (i & 3); }

struct Unit { int pm, pn, aux, ord; };

__device__ __forceinline__ int xcd_swizzle(int wgid, int nwg) { const int q = nwg / NXCD, r = nwg % NXCD, xcd = wgid % NXCD, off = wgid / NXCD; return (xcd < r ? xcd * (q + 1) : r * (q + 1) + (xcd - r) * q) + off; }

struct DenseOrder {
    const char* A; const char* Bt; size_t tstep; int nM, nN, nwg, G, c;
    __device__ __forceinline__ void init(const void* A_, const void* Bt_, int M_, int N_, int K_, int G_, int c_) { A = (const char*)A_; Bt = (const char*)Bt_; tstep = (size_t)BM * K_ * 2; nM = M_ / BM; nN = N_ / BM; nwg = nM * nN; G = G_; c = c_; }
    __device__ __forceinline__ bool next(int i, Unit& u) const {
        const long L = (long)i * G + c; if (L >= nwg) return false;
        const int wgid = xcd_swizzle((int)L, nwg);
        const int nig = WGM * nN, gid = wgid / nig, fm = gid * WGM, gsz = (nM - fm) < WGM ? (nM - fm) : WGM;
        u.pm = fm + ((wgid % nig) % gsz); u.pn = (wgid % nig) / gsz; u.aux = 0; u.ord = i; return true;
    }
    __device__ __forceinline__ const char* a_ptr(const Unit& u) const { return A + (size_t)u.pm * tstep; }
    __device__ __forceinline__ const char* b_ptr(const Unit& u) const { return Bt + (size_t)u.pn * tstep; }
    __device__ __forceinline__ unsigned row_off(const Unit&, int) const { return 0u; }
};
struct MoeOrder {
    const char* A; const char* W; const LAS int* tile_e; const LAS unsigned* rowoff; size_t tstep, estride; int nwg, G, c;
    __device__ __forceinline__ void init(const void* A_, const void* W_, const LAS int* te, const LAS unsigned* ro, int ntm, int K_, size_t estride_, int G_, int c_) { A = (const char*)A_; W = (const char*)W_; tile_e = te; rowoff = ro; tstep = (size_t)BM * K_ * 2; estride = estride_; nwg = ntm * 4; G = G_; c = c_; }
    __device__ __forceinline__ bool next(int i, Unit& u) const {
        const long L = (long)i * G + c; if (L >= nwg) return false;
        const int wgid = xcd_swizzle((int)L, nwg);
        u.pm = wgid >> 2; u.pn = wgid & 3; u.aux = __builtin_amdgcn_readfirstlane(tile_e[u.pm]); u.ord = i; return true;
    }
    __device__ __forceinline__ const char* a_ptr(const Unit& u) const { return rowoff ? A : A + (size_t)u.pm * tstep; }
    __device__ __forceinline__ const char* b_ptr(const Unit& u) const { return W + (size_t)u.aux * estride + (size_t)u.pn * tstep; }
    __device__ __forceinline__ unsigned row_off(const Unit& u, int r) const { return rowoff[u.ord * 256 + r]; }
};
__device__ __forceinline__ u32x4 pack8(const f32x4& v0, const f32x4& v1) { u32x4 w; w.x = pk2(v0[0], v0[1]); w.y = pk2(v0[2], v0[3]); w.z = pk2(v1[0], v1[1]); w.w = pk2(v1[2], v1[3]); return w; }

struct EpiInProj {
    static constexpr bool PERM = true, AFTER_DRAIN = false;
    bf16_t *Ugla, *Udiff, *Ugate;
    __device__ __forceinline__ void operator()(const f32x4 (&acc)[2][2][4][2], const Unit& u, int wr, int wc, int fr, int fq) const {
        bf16_t* base; int ldc, colt;
        if (u.pn < 6) { base = Ugla; ldc = 1536; colt = u.pn * 256; } else if (u.pn < 12) { base = Udiff; ldc = 1536; colt = (u.pn - 6) * 256; } else { base = Ugate; ldc = 2048; colt = (u.pn - 12) * 256; }
        const int row0 = u.pm * BM + wr * 64 + fr, col0 = colt + wc * 32 + 8 * fq;
#pragma unroll
        for (int ai = 0; ai < 2; ++ai)
#pragma unroll
            for (int m = 0; m < 4; ++m) { bf16_t* rowp = base + (size_t)(row0 + ai * HALF + m * 16) * ldc + col0;
#pragma unroll
                for (int bj = 0; bj < 2; ++bj) *(u32x4*)(rowp + bj * HALF) = pack8(acc[ai][bj][m][0], acc[ai][bj][m][1]); }
    }
};
struct EpiPlain {
    static constexpr bool PERM = true, AFTER_DRAIN = false;
    bf16_t* O; int ldc;
    __device__ __forceinline__ void operator()(const f32x4 (&acc)[2][2][4][2], const Unit& u, int wr, int wc, int fr, int fq) const {
        const int row0 = u.pm * BM + wr * 64 + fr, col0 = u.pn * BM + wc * 32 + 8 * fq;
#pragma unroll
        for (int ai = 0; ai < 2; ++ai)
#pragma unroll
            for (int m = 0; m < 4; ++m) { bf16_t* rowp = O + (size_t)(row0 + ai * HALF + m * 16) * ldc + col0;
#pragma unroll
                for (int bj = 0; bj < 2; ++bj) *(u32x4*)(rowp + bj * HALF) = pack8(acc[ai][bj][m][0], acc[ai][bj][m][1]); }
    }
};
struct EpiBranch {
    static constexpr bool PERM = true, AFTER_DRAIN = false;
    const bf16_t* gate; int gcol0; const bf16_t* m1in; bf16_t* out;
    __device__ __forceinline__ void operator()(const f32x4 (&acc)[2][2][4][2], const Unit& u, int wr, int wc, int fr, int fq) const {
        const int row0 = u.pm * BM + wr * 64 + fr, col0 = u.pn * BM + wc * 32 + 8 * fq;
#pragma unroll
        for (int ai = 0; ai < 2; ++ai)
#pragma unroll
            for (int m = 0; m < 4; ++m) { const size_t r = (size_t)(row0 + ai * HALF + m * 16);
#pragma unroll
                for (int bj = 0; bj < 2; ++bj) { const int c = col0 + bj * HALF;
                    const u32x4 g = *(const u32x4*)(gate + r * 2048 + gcol0 + c);
                    f32x4 v0 = acc[ai][bj][m][0], v1 = acc[ai][bj][m][1];
                    v0[0] *= sigmoidf_(lo_bf(g.x)); v0[1] *= sigmoidf_(hi_bf(g.x)); v0[2] *= sigmoidf_(lo_bf(g.y)); v0[3] *= sigmoidf_(hi_bf(g.y));
                    v1[0] *= sigmoidf_(lo_bf(g.z)); v1[1] *= sigmoidf_(hi_bf(g.z)); v1[2] *= sigmoidf_(lo_bf(g.w)); v1[3] *= sigmoidf_(hi_bf(g.w));
                    if (m1in) { const u32x4 p = *(const u32x4*)(m1in + r * 1024 + c);
                        v0[0] += lo_bf(p.x); v0[1] += hi_bf(p.x); v0[2] += lo_bf(p.y); v0[3] += hi_bf(p.y); v1[0] += lo_bf(p.z); v1[1] += hi_bf(p.z); v1[2] += lo_bf(p.w); v1[3] += hi_bf(p.w); }
                    *(u32x4*)(out + r * 1024 + c) = pack8(v0, v1); } }
    }
};
struct EpiWout {
    static constexpr bool PERM = false, AFTER_DRAIN = false;
    const float* x; const float* modf; float* out;
    __device__ __forceinline__ void operator()(const f32x4 (&acc)[2][2][4][2], const Unit& u, int wr, int wc, int fr, int fq) const {
        const int row0 = u.pm * BM + wr * 64 + fr, col0 = u.pn * BM + wc * 32 + 4 * fq;
        const float* g1 = modf + (size_t)((u.pm * BM) >> 12) * NMOD + 2 * D;
#pragma unroll
        for (int bj = 0; bj < 2; ++bj)
#pragma unroll
            for (int n = 0; n < 2; ++n) { const int c = col0 + bj * HALF + n * 16; const f32x4 gv = *(const f32x4*)(g1 + c);
#pragma unroll
                for (int ai = 0; ai < 2; ++ai)
#pragma unroll
                    for (int m = 0; m < 4; ++m) { const size_t off = (size_t)(row0 + ai * HALF + m * 16) * D + c;
                        const f32x4 xv = *(const f32x4*)(x + off); *(f32x4*)(out + off) = xv + gv * acc[ai][bj][m][n]; } }
    }
};
struct EpiUp {
    static constexpr bool PERM = true, AFTER_DRAIN = false;
    bf16_t* H;
    __device__ __forceinline__ void operator()(const f32x4 (&acc)[2][2][4][2], const Unit& u, int wr, int wc, int fr, int fq) const {
        const int row0 = u.pm * BM + wr * 64 + fr, col0 = u.pn * HALF + wc * 32 + 8 * fq;
#pragma unroll
        for (int ai = 0; ai < 2; ++ai)
#pragma unroll
            for (int m = 0; m < 4; ++m) { f32x4 v0, v1;
#pragma unroll
                for (int e = 0; e < 4; ++e) { v0[e] = siluf_(acc[ai][0][m][0][e]) * acc[ai][1][m][0][e]; v1[e] = siluf_(acc[ai][0][m][1][e]) * acc[ai][1][m][1][e]; }
                *(u32x4*)(H + (size_t)(row0 + ai * HALF + m * 16) * DEXP + col0) = pack8(v0, v1); }
    }
};

template <class Epi, class Sched, bool ALIGN_EPI = false, bool GATHER = false>
__device__ __forceinline__ void gemm_phase(LAS unsigned char* lds, const int K, const Sched& S, const Epi& E) {
    int tid_ = threadIdx.x; asm volatile("" : "+v"(tid_));
    const int tid = tid_, wid = __builtin_amdgcn_readfirstlane(tid >> 6), lane = tid & 63, wr = wid >> 2, wc = wid & 3, fr = lane & 15, fq = lane >> 4;
    const int nt = K / BK;
    const size_t kstep = (size_t)(BK * 2);
    const size_t hstep = (size_t)HALF * K * 2;
    unsigned vA0[2], vA1[2], nA0[2], nA1[2], voffB[2]; int Rr[2], Cc[2];
#pragma unroll
    for (int i = 0; i < 2; ++i) { int R, C; stage_rc(tid * 16 + i * 8192, R, C); const int Rb = Epi::PERM ? ((R & ~31) + perm32(R & 31)) : R; Rr[i] = R; Cc[i] = C;
        voffB[i] = (unsigned)(Rb * K + C) * 2u; }
#define PG8_SETOFF(u, o0, o1) do { _Pragma("unroll") for (int _i = 0; _i < 2; ++_i) { \
        if constexpr (GATHER) { o0[_i] = S.row_off(u, Rr[_i]) + (unsigned)Cc[_i] * 2u; o1[_i] = S.row_off(u, Rr[_i] + HALF) + (unsigned)Cc[_i] * 2u; } \
        else { o0[_i] = (unsigned)(Rr[_i] * K + Cc[_i]) * 2u; o1[_i] = o0[_i] + (unsigned)hstep; } } } while (0)
    const unsigned ldsw = (unsigned)wid * 1024u;
    const int aoff = lds_byte(wr * 64 + fr, fq * 8), boff = lds_byte(wc * 32 + fr, fq * 8);
#define PG8_SA(b, h) (((b) * 2 + (h)) * HTB)
#define PG8_SB(b, h) ((4 + (b) * 2 + (h)) * HTB)
#define PG8_STAGE(bufoff, gbase, voff) do { _Pragma("unroll") for (int _i = 0; _i < 2; ++_i) \
        __builtin_amdgcn_global_load_lds((const unsigned*)((const char*)(gbase) + (voff)[_i]), (LAS unsigned*)(lds + (bufoff) + ldsw + _i * 8192), 16, 0, 0); } while (0)
#define PG8_LDA(dst, b, h) do { _Pragma("unroll") for (int m = 0; m < 4; ++m) _Pragma("unroll") for (int k = 0; k < 2; ++k) dst[m][k] = *(const LAS bf16x8*)(lds + PG8_SA(b, h) + aoff + m * 2048 + k * 1024); } while (0)
#define PG8_LDB(dst, b, h) do { _Pragma("unroll") for (int n = 0; n < 2; ++n) _Pragma("unroll") for (int k = 0; k < 2; ++k) dst[n][k] = *(const LAS bf16x8*)(lds + PG8_SB(b, h) + boff + n * 2048 + k * 1024); } while (0)
#define PG8_MMA(ai, bj, At, Bt) do { __builtin_amdgcn_s_setprio(1); _Pragma("unroll") for (int m = 0; m < 4; ++m) _Pragma("unroll") for (int n = 0; n < 2; ++n) _Pragma("unroll") for (int k = 0; k < 2; ++k) \
        acc[ai][bj][m][n] = __builtin_amdgcn_mfma_f32_16x16x32_bf16(Bt[n][k], At[m][k], acc[ai][bj][m][n], 0, 0, 0); __builtin_amdgcn_s_setprio(0); } while (0)
#define PG8_WAIT_V(n) asm volatile("s_waitcnt vmcnt(" #n ")" ::: "memory")
#define PG8_WAIT_L(n) asm volatile("s_waitcnt lgkmcnt(" #n ")" ::: "memory")
#define PG8_BAR __builtin_amdgcn_s_barrier()
#define PG8_SCHED __builtin_amdgcn_sched_barrier(0)
    Unit cur, nxt; int ui = 0;
    if (!S.next(0, cur)) return;
    PG8_SETOFF(cur, vA0, vA1);
#pragma unroll
    for (int i = 0; i < 2; ++i) { nA0[i] = vA0[i]; nA1[i] = vA1[i]; }
    f32x4 acc[2][2][4][2];
#pragma unroll
    for (int a = 0; a < 2; ++a)
#pragma unroll
        for (int b = 0; b < 2; ++b)
#pragma unroll
            for (int m = 0; m < 4; ++m)
#pragma unroll
                for (int n = 0; n < 2; ++n) acc[a][b][m][n] = (f32x4){0.f, 0.f, 0.f, 0.f};
    bf16x8 At[4][2], B0[2][2], B1[2][2];
    const char* cA = S.a_ptr(cur); const char* cB = S.b_ptr(cur);
    PG8_STAGE(PG8_SB(0, 0), cB, voffB); PG8_STAGE(PG8_SB(0, 1), cB + hstep, voffB); PG8_STAGE(PG8_SA(0, 0), cA, vA0); PG8_STAGE(PG8_SA(0, 1), cA, vA1);
    if (wr == 1) PG8_BAR;
    PG8_WAIT_V(2); PG8_BAR;
    PG8_STAGE(PG8_SB(1, 0), cB + kstep, voffB); PG8_STAGE(PG8_SA(1, 0), cA + kstep, vA0); PG8_STAGE(PG8_SB(1, 1), cB + hstep + kstep, voffB);
    PG8_WAIT_V(6); PG8_BAR;
    for (;;) {
        const bool has_next = S.next(ui + 1, nxt);
        const char* nA = has_next ? S.a_ptr(nxt) : cA; const char* nB = has_next ? S.b_ptr(nxt) : cB;
        if constexpr (GATHER) { if (has_next) PG8_SETOFF(nxt, nA0, nA1); }
        for (int t = 0; t < nt; t += 2) {
            const bool last = (t == nt - 2);
            const char* a1 = cA + (size_t)(t + 1) * kstep;
            const char* a2 = last ? nA : cA + (size_t)(t + 2) * kstep; const char* b2 = last ? nB : cB + (size_t)(t + 2) * kstep;
            const char* a3 = a2 + kstep; const char* b3 = b2 + kstep;
            unsigned w0[2], w1[2];
#pragma unroll
            for (int i = 0; i < 2; ++i) { if constexpr (GATHER) { w0[i] = last ? nA0[i] : vA0[i]; w1[i] = last ? nA1[i] : vA1[i]; } else { w0[i] = vA0[i]; w1[i] = vA1[i]; } }
            PG8_LDB(B0, 0, 0); PG8_LDB(B1, 0, 1); PG8_SCHED; PG8_LDA(At, 0, 0); PG8_STAGE(PG8_SA(1, 1), a1, vA1);
            PG8_WAIT_V(8); PG8_WAIT_L(0); PG8_BAR; PG8_MMA(0, 0, At, B0); PG8_MMA(0, 1, At, B1); PG8_BAR; PG8_SCHED;
            PG8_LDA(At, 0, 1); PG8_STAGE(PG8_SB(0, 0), b2, voffB); PG8_STAGE(PG8_SB(0, 1), b2 + hstep, voffB); PG8_STAGE(PG8_SA(0, 0), a2, w0);
            PG8_WAIT_V(8); PG8_WAIT_L(0); PG8_BAR; PG8_MMA(1, 0, At, B0); PG8_MMA(1, 1, At, B1); PG8_BAR; PG8_SCHED;
            PG8_LDB(B0, 1, 0); PG8_LDB(B1, 1, 1); PG8_SCHED; PG8_LDA(At, 1, 0); PG8_STAGE(PG8_SA(0, 1), a2, w1);
            PG8_WAIT_V(8); PG8_WAIT_L(0); PG8_BAR; PG8_MMA(0, 0, At, B0); PG8_MMA(0, 1, At, B1); PG8_BAR; PG8_SCHED;
            PG8_LDA(At, 1, 1); PG8_STAGE(PG8_SB(1, 0), b3, voffB); PG8_STAGE(PG8_SB(1, 1), b3 + hstep, voffB); PG8_STAGE(PG8_SA(1, 0), a3, w0);
            PG8_WAIT_V(8); PG8_WAIT_L(0); PG8_BAR; PG8_MMA(1, 0, At, B0); PG8_MMA(1, 1, At, B1); PG8_BAR; PG8_SCHED;
        }
        if constexpr (ALIGN_EPI) { if (wr == 0) PG8_BAR; }
        E(acc, cur, wr, wc, fr, fq);
        if (!has_next) break;
#pragma unroll
        for (int a = 0; a < 2; ++a)
#pragma unroll
            for (int b = 0; b < 2; ++b)
#pragma unroll
                for (int m = 0; m < 4; ++m)
#pragma unroll
                    for (int n = 0; n < 2; ++n) acc[a][b][m][n] = (f32x4){0.f, 0.f, 0.f, 0.f};
        cur = nxt; cA = nA; cB = nB; ++ui;
#pragma unroll
        for (int i = 0; i < 2; ++i) { vA0[i] = nA0[i]; vA1[i] = nA1[i]; }
        if constexpr (ALIGN_EPI) { if (wr == 1) PG8_BAR; }
    }
    PG8_WAIT_V(0);
    if constexpr (!ALIGN_EPI) { if (wr == 0) PG8_BAR; }
    PG8_BAR;
#undef PG8_SETOFF
#undef PG8_SA
#undef PG8_SB
#undef PG8_STAGE
#undef PG8_LDA
#undef PG8_LDB
#undef PG8_MMA
#undef PG8_WAIT_V
#undef PG8_WAIT_L
#undef PG8_BAR
#undef PG8_SCHED
}
}

namespace attn_body {
using bf16=__hip_bfloat16;
using bf16x8=__attribute__((ext_vector_type(8)))short;
using s16x4=__attribute__((ext_vector_type(4)))short;
using f32x16=__attribute__((ext_vector_type(16)))float;
using u32x4=__attribute__((ext_vector_type(4)))unsigned;
constexpr int SEQ=4096,D=64,DM=1536,DMO=512;
constexpr int NW=8,QBLK=32,QB=QBLK*NW,KVBLK=64,NQB=SEQ/QB;
constexpr int ATTN_UNIT_ROWS=QB;
__device__ __forceinline__ int crow(int r,int hi){return (r&3)+8*(r>>2)+4*hi;}
#define SBAR() __builtin_amdgcn_sched_barrier(0)
__device__ __forceinline__ void cmask(f32x16&p0,f32x16&p1,int jb,int qrel,int hi){
  const float NEG=-INFINITY; int kb=64*jb+4*hi;
  #pragma unroll
  for(int r=0;r<16;++r){int kv=kb+(r&3)+8*(r>>2); if(kv>qrel)p0[r]=NEG; if(kv+32>qrel)p1[r]=NEG;}
}

constexpr int NSLOT=3, SLOTB=8192;
constexpr int LDS_K=0, LDS_V=NSLOT*SLOTB, LDS_WS=2*NSLOT*SLOTB, LDS_OST=LDS_WS+NW*64*4, LDS_BYTES=LDS_OST+NW*4096;
constexpr float C2=0.125f*1.4426950408889634f;
__device__ __forceinline__ void glds16(const void*gsrc,unsigned lds_dst){unsigned keep;
  asm volatile("s_mov_b32 %0, m0\n\ts_mov_b32 m0, %2\n\ts_nop 0\n\tglobal_load_lds_dwordx4 %1, off\n\ts_mov_b32 m0, %0":"=&s"(keep):"v"(gsrc),"s"(lds_dst):"memory");}
__device__ __forceinline__ float max3f(float a,float b,float c){float r;asm("v_max3_f32 %0, %1, %2, %3":"=v"(r):"v"(a),"v"(b),"v"(c));return r;}
__device__ __forceinline__ float max2f(float a,float b){float r;asm("v_max_f32_e32 %0, %1, %2":"=v"(r):"v"(a),"v"(b));return r;}
__device__ __forceinline__ float fadd_s(float a,float b){float r;asm("v_add_f32_e32 %0, %1, %2":"=v"(r):"v"(a),"v"(b));return r;}
__device__ __forceinline__ float fsub_s(float a,float b){float r;asm("v_sub_f32_e32 %0, %1, %2":"=v"(r):"v"(a),"v"(b));return r;}
typedef float f32x2_t __attribute__((ext_vector_type(2))); typedef __bf16 bf16x2_t __attribute__((ext_vector_type(2)));
__device__ __forceinline__ unsigned cvtpk_s(float lo,float hi){f32x2_t v={lo,hi};bf16x2_t b=__builtin_convertvector(v,bf16x2_t);return __builtin_bit_cast(unsigned,b);}
#define WAIT_BAR(N) asm volatile("s_waitcnt vmcnt(" #N ") lgkmcnt(0)\n\ts_barrier":::"memory")

__device__ __forceinline__ void qkt(f32x16&p0,f32x16&p1,const char*Kslot,const bf16x8*qr,const f32x16&negm,int r32,int hi){
  const char*kb=Kslot+hi*1024+r32*16;
  #pragma unroll
  for(int d0=0;d0<4;++d0){
    const bf16x8 b0=*reinterpret_cast<const bf16x8*>(kb+d0*2048);
    const bf16x8 b1=*reinterpret_cast<const bf16x8*>(kb+d0*2048+512);
    if(d0==0){p0=__builtin_amdgcn_mfma_f32_32x32x16_bf16(b0,qr[0],negm,0,0,0);p1=__builtin_amdgcn_mfma_f32_32x32x16_bf16(b1,qr[0],negm,0,0,0);}
    else{p0=__builtin_amdgcn_mfma_f32_32x32x16_bf16(b0,qr[d0],p0,0,0,0);p1=__builtin_amdgcn_mfma_f32_32x32x16_bf16(b1,qr[d0],p1,0,0,0);}}
}
typedef __attribute__((address_space(3))) const char* lds_cptr;
typedef short v4i16_t __attribute__((ext_vector_type(4)));
__device__ __forceinline__ void kload8(bf16x8*kf,lds_cptr kp){
  kf[0]=*(const __attribute__((address_space(3))) bf16x8*)(kp);      kf[1]=*(const __attribute__((address_space(3))) bf16x8*)(kp+512);
  kf[2]=*(const __attribute__((address_space(3))) bf16x8*)(kp+2048); kf[3]=*(const __attribute__((address_space(3))) bf16x8*)(kp+2560);
  kf[4]=*(const __attribute__((address_space(3))) bf16x8*)(kp+4096); kf[5]=*(const __attribute__((address_space(3))) bf16x8*)(kp+4608);
  kf[6]=*(const __attribute__((address_space(3))) bf16x8*)(kp+6144); kf[7]=*(const __attribute__((address_space(3))) bf16x8*)(kp+6656);
}
__device__ __forceinline__ void kload2(bf16x8*kf,lds_cptr kp,int j){ kf[2*j]=*(const __attribute__((address_space(3))) bf16x8*)(kp+j*2048); kf[2*j+1]=*(const __attribute__((address_space(3))) bf16x8*)(kp+j*2048+512); }
__device__ __forceinline__ s16x4 vtr(lds_cptr p){ return __builtin_bit_cast(s16x4,__builtin_amdgcn_ds_read_tr16_b64_v4i16((__attribute__((address_space(3))) v4i16_t*)p)); }
__device__ __forceinline__ float rowmax(const f32x16&p0,const f32x16&p1){
  float a=max3f(p0[0],p0[1],p1[0]),b=max3f(p0[2],p0[3],p1[1]);a=max3f(a,p1[2],p1[3]);
  #pragma unroll
  for(int r=4;r<16;r+=4){a=max3f(a,p0[r],p0[r+1]);b=max3f(b,p0[r+2],p0[r+3]);a=max3f(a,p1[r],p1[r+1]);b=max3f(b,p1[r+2],p1[r+3]);}
  const float m=max2f(a,b);
  auto rr=__builtin_amdgcn_permlane32_swap(__float_as_uint(m),__float_as_uint(m),false,false);
  return max2f(__uint_as_float(rr[0]),__uint_as_float(rr[1]));
}
__device__ __forceinline__ void pv(f32x16*o,int vb,bf16x8 pa0,bf16x8 pa1,bf16x8 pa2,bf16x8 pa3){
  #pragma unroll
  for(int d0=0;d0<2;++d0){s16x4 lo[4],hi[4];
    #pragma unroll
    for(int ks=0;ks<4;++ks){
      asm volatile("ds_read_b64_tr_b16 %0,%1 offset:%c2":"=&v"(lo[ks]):"v"(vb),"i"(d0*4096+ks*1024):"memory");
      asm volatile("ds_read_b64_tr_b16 %0,%1 offset:%c2":"=&v"(hi[ks]):"v"(vb),"i"(d0*4096+ks*1024+512):"memory");}
    asm volatile("s_waitcnt lgkmcnt(0)":::"memory");SBAR();
    #define PK(k) (bf16x8){lo[k][0],lo[k][1],lo[k][2],lo[k][3],hi[k][0],hi[k][1],hi[k][2],hi[k][3]}
    o[d0]=__builtin_amdgcn_mfma_f32_32x32x16_bf16(pa0,PK(0),o[d0],0,0,0);
    o[d0]=__builtin_amdgcn_mfma_f32_32x32x16_bf16(pa1,PK(1),o[d0],0,0,0);
    o[d0]=__builtin_amdgcn_mfma_f32_32x32x16_bf16(pa2,PK(2),o[d0],0,0,0);
    o[d0]=__builtin_amdgcn_mfma_f32_32x32x16_bf16(pa3,PK(3),o[d0],0,0,0);
    #undef PK
  }
}

#ifndef ATTN_STORE16
#define ATTN_STORE16(p,v) (*(u32x4*)(p)=(v))
#endif
template<int THRL> __device__ __forceinline__ void attn_unit(int b,int qcol,int kcol,int vcol,int ocol,int qb,const bf16*Q,const bf16*__restrict__ K,const bf16*__restrict__ V,bf16*O,char*shm){
  int tid_=threadIdx.x; asm volatile("":"+v"(tid_));
  const int tid=tid_,lane=tid&63,r32=lane&31,hi=lane>>5; const int wid=__builtin_amdgcn_readfirstlane(tid>>6);
  const long rowbase=(long)b*SEQ; const int q0=qb*QB;
  const bf16*Qw=Q+(rowbase+q0+wid*QBLK)*DM+qcol;
  const bf16*Kh=K+rowbase*DM+kcol,*Vh=V+rowbase*DM+vcol;
  const unsigned lds0=(unsigned)(uintptr_t)shm;
  float*wsf=(float*)(shm+LDS_WS)+wid*64;
  const bf16*ksrc=Kh+(long)lane*DM+wid*8;
  const bf16*vsrc=Vh+(long)(16*(wid&3)+(lane>>2))*DM+(wid>>2)*32+(lane&3)*8;
  const unsigned kdst=lds0+LDS_K+wid*1024, vdst=lds0+LDS_V+wid*1024;
  #define DMA_K(t,slot) glds16(ksrc+(long)(t)*KVBLK*DM,(unsigned)__builtin_amdgcn_readfirstlane(kdst+(slot)))
  #define DMA_V(t,slot) glds16(vsrc+(long)(t)*KVBLK*DM,(unsigned)__builtin_amdgcn_readfirstlane(vdst+(slot)))
  const int vb0=(int)(lds0+LDS_V)+((lane>>4)&1)*32+(lane&3)*8+(4*hi+((lane&15)>>2))*64;
  const char*Kbase=shm+LDS_K; bf16x8 kf[8];
  const lds_cptr shm3=(lds_cptr)shm; const lds_cptr kp0=shm3+LDS_K+hi*1024+r32*16; const lds_cptr vp0=shm3+LDS_V+((lane>>4)&1)*32+(lane&3)*8+(4*hi+((lane&15)>>2))*64;
  const int NT=(q0+QB)/KVBLK;
  DMA_K(0,0);DMA_V(0,0);DMA_K(1,SLOTB);
  bf16x8 qr[4];
  #pragma unroll
  for(int d0=0;d0<4;++d0)qr[d0]=*reinterpret_cast<const bf16x8*>(&Qw[(long)r32*DM+d0*16+hi*8]);
  float mhat=0.f,l_reg=0.f;f32x16 o[2];o[0]=f32x16{};o[1]=f32x16{};f32x16 negm=f32x16{};asm volatile("":"+v"(negm));
  const int qrel=wid*QBLK+r32;
  #define CMASK(P0,P1,t) do{int jb_=(t)-(NT-4); if(jb_>=0)cmask(P0,P1,jb_,qrel,hi);}while(0)
  bool resc=false;
  #define START(P0,P1) do{ const float rm=rowmax(P0,P1); resc=false; \
    { const float dl=rm; mhat=fadd_s(mhat,dl); \
      _Pragma("unroll") for(int r=0;r<16;++r){P0[r]=fsub_s(P0[r],dl);P1[r]=fsub_s(P1[r],dl);} \
      _Pragma("unroll") for(int r=0;r<16;++r)negm[r]=-mhat; asm volatile("":"+v"(negm)); } \
    _Pragma("unroll") for(int r=0;r<16;++r)P0[r]=__builtin_amdgcn_exp2f(P0[r]); }while(0)
  #define RESC() do{ if(resc){ asm volatile("s_waitcnt lgkmcnt(0)":::"memory"); \
      _Pragma("unroll") for(int d_=0;d_<2;++d_) _Pragma("unroll") for(int r=0;r<16;++r)o[d_][r]*=wsf[crow(r,hi)]; } }while(0)
  f32x16 pA0,pA1,pB0,pB1;
  int sl_prev=0,sl_cur=0,sl_next=SLOTB;
  #define ROT() do{sl_prev=sl_cur;sl_cur=sl_next;sl_next=(sl_next==(NSLOT-1)*SLOTB)?0:sl_next+SLOTB;}while(0)
  DMA_K(2,2*SLOTB);
  WAIT_BAR(3);
  qkt(pA0,pA1,Kbase,qr,negm,r32,hi);asm volatile("s_nop 15\n\ts_nop 7":"+v"(pA0),"+v"(pA1));CMASK(pA0,pA1,0);
  START(pA0,pA1);
  _Pragma("unroll") for(int r=0;r<16;++r)pA1[r]=__builtin_amdgcn_exp2f(pA1[r]);
  WAIT_BAR(0);
  DMA_K(3,0);DMA_V(1,SLOTB);
  ROT();
  kload8(kf,kp0+sl_cur);
  WAIT_BAR(2);
  s16x4 vlo[8],vhi[8]; u32x4 pw0,pw1,pw2,pw3;
  #define PKW(P,B) cvtpk_s(P[B],P[B+1])
  #define PAF(k) __builtin_bit_cast(bf16x8,pw##k)
  #define VFR(i) (bf16x8){vlo[i][0],vlo[i][1],vlo[i][2],vlo[i][3],vhi[i][0],vhi[i][1],vhi[i][2],vhi[i][3]}
  #define PIN(x) asm volatile("":"+v"(x))
  #define MX3(a,b,c) __builtin_fmaxf(__builtin_fmaxf((a),(b)),(c))
  #define GAPA(MF,A0,A1,A2,A3,W0,W1,PW) do{ MF; sacc+=A0; sacc+=A1; sacc+=A2; sacc+=A3; PIN(sacc); W0; W1; PIN(PW); SBAR(); }while(0)
  #define EX(v) __builtin_amdgcn_exp2f(v)
  #define GAPB(MF,X,B) do{ MF; X[B]=EX(X[B]); X[B+1]=EX(X[B+1]); X[B+2]=EX(X[B+2]); X[B+3]=EX(X[B+3]); PIN(X); SBAR(); }while(0)
  #define VRD(i) do{ vlo[i]=vtr(vp_+(((i)>>2)*4096+((i)&3)*1024)); vhi[i]=vtr(vp_+(((i)>>2)*4096+((i)&3)*1024+512)); }while(0)
  #define KRD(G,j) do{ if(G){ kload2(kf,kp0+sl_next,j); SBAR(); } }while(0)
  #define STEP(C0,C1,P0,P1,t,GK,GV,GL) do{ SBAR(); \
    const lds_cptr vp_=vp0+sl_prev; \
    VRD(0); SBAR(); float sacc=(P0[0]+P0[1]); \
    GAPA(C0=__builtin_amdgcn_mfma_f32_32x32x16_bf16(kf[0],qr[0],negm,0,0,0), P0[2],P0[3],P0[4],P0[5],     pw0[0]=PKW(P0,0), pw0[1]=PKW(P0,2), pw0); \
    VRD(4); SBAR(); GAPA(C1=__builtin_amdgcn_mfma_f32_32x32x16_bf16(kf[1],qr[0],negm,0,0,0), P0[6],P0[7],P0[8],P0[9],     pw0[2]=PKW(P0,4), pw0[3]=PKW(P0,6), pw0); \
    VRD(1); SBAR(); GAPA(C0=__builtin_amdgcn_mfma_f32_32x32x16_bf16(kf[2],qr[1],C0,0,0,0),   P0[10],P0[11],P0[12],P0[13], pw1[0]=PKW(P0,8), pw1[1]=PKW(P0,10), pw1); \
    VRD(5); SBAR(); GAPA(C1=__builtin_amdgcn_mfma_f32_32x32x16_bf16(kf[3],qr[1],C1,0,0,0),   P0[14],P0[15],P1[0],P1[1],   pw1[2]=PKW(P0,12),pw1[3]=PKW(P0,14), pw1); \
    VRD(2); SBAR(); GAPA(C0=__builtin_amdgcn_mfma_f32_32x32x16_bf16(kf[4],qr[2],C0,0,0,0),   P1[2],P1[3],P1[4],P1[5],     pw2[0]=PKW(P1,0), pw2[1]=PKW(P1,2), pw2); \
    VRD(6); SBAR(); GAPA(C1=__builtin_amdgcn_mfma_f32_32x32x16_bf16(kf[5],qr[2],C1,0,0,0),   P1[6],P1[7],P1[8],P1[9],     pw2[2]=PKW(P1,4), pw2[3]=PKW(P1,6), pw2); \
    VRD(3); SBAR(); GAPA(C0=__builtin_amdgcn_mfma_f32_32x32x16_bf16(kf[6],qr[3],C0,0,0,0),   P1[10],P1[11],P1[12],P1[13], pw3[0]=PKW(P1,8), pw3[1]=PKW(P1,10), pw3); \
    VRD(7); SBAR(); GAPA(C1=__builtin_amdgcn_mfma_f32_32x32x16_bf16(kf[7],qr[3],C1,0,0,0),   P1[14],P1[15],0.f,0.f,       pw3[2]=PKW(P1,12),pw3[3]=PKW(P1,14), pw3); \
    l_reg+=sacc; \
    if(GK){DMA_K((t)+3,sl_cur);} if(GV){DMA_V((t)+1,sl_next);} \
    CMASK(C0,C1,t); \
    { float a=MX3(C0[0],C0[1],C1[0]),b=MX3(C0[2],C0[3],C1[1]); a=MX3(a,C1[2],C1[3]); \
      _Pragma("unroll") for(int r=4;r<16;r+=4){a=MX3(a,C0[r],C0[r+1]);b=MX3(b,C0[r+2],C0[r+3]);a=MX3(a,C1[r],C1[r+1]);b=MX3(b,C1[r+2],C1[r+3]);} \
      float rm=__builtin_fmaxf(a,b); { auto rr=__builtin_amdgcn_permlane32_swap(__float_as_uint(rm),__float_as_uint(rm),false,false); rm=__builtin_fmaxf(__uint_as_float(rr[0]),__uint_as_float(rr[1])); } \
      resc=false; \
      if(__builtin_expect(__any(rm>(float)THRL),0)){ const float dl=__builtin_fmaxf(rm,0.f); mhat+=dl; \
        _Pragma("unroll") for(int r=0;r<16;++r){C0[r]-=dl;C1[r]-=dl;} \
        _Pragma("unroll") for(int r=0;r<16;++r)negm[r]=-mhat; asm volatile("":"+v"(negm)); \
        const float f=__builtin_amdgcn_exp2f(-dl); l_reg*=f; if(hi==0)wsf[r32]=f; resc=true; } } \
    SBAR(); \
    GAPB(o[0]=__builtin_amdgcn_mfma_f32_32x32x16_bf16(PAF(0),VFR(0),o[0],0,0,0), C0,0); \
    GAPB(o[1]=__builtin_amdgcn_mfma_f32_32x32x16_bf16(PAF(0),VFR(4),o[1],0,0,0), C0,4); \
    KRD(GL,0); GAPB(o[0]=__builtin_amdgcn_mfma_f32_32x32x16_bf16(PAF(1),VFR(1),o[0],0,0,0), C0,8); \
    KRD(GL,1); GAPB(o[1]=__builtin_amdgcn_mfma_f32_32x32x16_bf16(PAF(1),VFR(5),o[1],0,0,0), C0,12); \
    KRD(GL,2); GAPB(o[0]=__builtin_amdgcn_mfma_f32_32x32x16_bf16(PAF(2),VFR(2),o[0],0,0,0), C1,0); \
    KRD(GL,3); GAPB(o[1]=__builtin_amdgcn_mfma_f32_32x32x16_bf16(PAF(2),VFR(6),o[1],0,0,0), C1,4); \
    GAPB(o[0]=__builtin_amdgcn_mfma_f32_32x32x16_bf16(PAF(3),VFR(3),o[0],0,0,0), C1,8); \
    GAPB(o[1]=__builtin_amdgcn_mfma_f32_32x32x16_bf16(PAF(3),VFR(7),o[1],0,0,0), C1,12); \
    }while(0)
  int t=1;
  #undef CMASK
  #define CMASK(P0,P1,t) do{}while(0)
  for(;t+5<NT;t+=2){
    STEP(pB0,pB1,pA0,pA1,t,true,true,true);     WAIT_BAR(2); RESC(); ROT();
    STEP(pA0,pA1,pB0,pB1,t+1,true,true,true);   WAIT_BAR(2); RESC(); ROT();
  }
  #undef CMASK
  #define CMASK(P0,P1,t) do{int jb_=(t)-(NT-4); if(jb_>=0)cmask(P0,P1,jb_,qrel,hi);}while(0)
  #define ENDW(tt) do{ if((tt)+3<NT){WAIT_BAR(2);} else if((tt)+2<NT){WAIT_BAR(1);} else {WAIT_BAR(0);} }while(0)
  for(;t+1<NT;t+=2){
    STEP(pB0,pB1,pA0,pA1,t,(t+3<NT),(t+1<NT),(t+1<NT));       ENDW(t);   RESC(); ROT();
    STEP(pA0,pA1,pB0,pB1,t+1,(t+4<NT),(t+2<NT),(t+2<NT));     ENDW(t+1); RESC(); ROT();
  }
  STEP(pB0,pB1,pA0,pA1,NT-1,false,false,false); RESC();
  { float sacc=pB0[0]+pB0[1]; _Pragma("unroll") for(int r=2;r<16;++r)sacc+=pB0[r]; _Pragma("unroll") for(int r=0;r<16;++r)sacc+=pB1[r]; l_reg+=sacc;
    pw0=(u32x4){PKW(pB0,0),PKW(pB0,2),PKW(pB0,4),PKW(pB0,6)};pw1=(u32x4){PKW(pB0,8),PKW(pB0,10),PKW(pB0,12),PKW(pB0,14)};pw2=(u32x4){PKW(pB1,0),PKW(pB1,2),PKW(pB1,4),PKW(pB1,6)};pw3=(u32x4){PKW(pB1,8),PKW(pB1,10),PKW(pB1,12),PKW(pB1,14)};
    SBAR(); pv(o,vb0+sl_cur,PAF(0),PAF(1),PAF(2),PAF(3)); }
  #undef PKW
  #undef PAF
  #undef VFR
  #undef PIN
  #undef MX3
  #undef GAPA
  #undef GAPB
  #undef EX
  #undef VRD
  #undef KRD
  #undef STEP
  #undef ENDW
  {auto rr=__builtin_amdgcn_permlane32_swap(__float_as_uint(l_reg),__float_as_uint(l_reg),false,false);l_reg=__uint_as_float(rr[0])+__uint_as_float(rr[1]);}
  if(hi==0)wsf[32+r32]=l_reg;asm volatile("s_waitcnt lgkmcnt(0)":::"memory");
  float rli[16];
  #pragma unroll
  for(int r=0;r<16;++r)rli[r]=__builtin_amdgcn_rcpf(wsf[32+crow(r,hi)]);
  bf16*Ow=O+(rowbase+q0+wid*QBLK)*DMO+ocol;
  { bf16*stg=(bf16*)(shm+LDS_OST)+wid*2048;
    #pragma unroll
    for(int r=0;r<16;++r){const int orow=crow(r,hi);
      #pragma unroll
      for(int d0=0;d0<2;++d0)stg[orow*64+d0*32+r32]=__float2bfloat16(o[d0][r]*rli[r]);}
    asm volatile("s_waitcnt lgkmcnt(0)":::"memory");
    #pragma unroll
    for(int i=0;i<4;++i){const int row=i*8+(lane>>3),ch=lane&7; const u32x4 v=*(const u32x4*)(stg+row*64+ch*8); ATTN_STORE16(Ow+(long)row*DMO+ch*8,v);} }
  asm volatile("s_waitcnt lgkmcnt(0)\n\ts_barrier":::"memory");
  #undef DMA_K
  #undef DMA_V
  #undef CMASK
  #undef START
  #undef RESC
  #undef ROT
}
constexpr int ATTN_LDS_BYTES=LDS_BYTES;
template<int THRL=8> __device__ __forceinline__ void attn_phase(char*lds,const bf16*U,bf16*Oc,int vcu){
  const int bhc=vcu>>3,s=vcu&7,b=bhc>>3,h=(bhc>>1)&3,c=bhc&1;
  _Pragma("unroll 1") for(int i=0;i<4;++i){ const int half=i>>1,qb=(i&1)?15-s:s;
    attn_unit<THRL>(b,h*128+c*64,512+h*128+c*64,1024+h*128+half*64,h*128+half*64,qb,U,U,U,Oc+(long)c*16384*DMO,lds); }
}
#undef SBAR
#undef WAIT_BAR
}

namespace gla {
constexpr int GP = 72;
constexpr int L_BC = 0, L_VT = 16384, L_QI = 34816, L_KI = 44032, L_ATT = 53248, L_OF = 62464, OFP = 132;
__device__ __forceinline__ bf16x8 frag(const LAS unsigned char* base, int row, int k0) { return *(const LAS bf16x8*)(base + (row * GP + k0) * 2); }
struct LdState { f32x4 g0, g1; unsigned vw[8]; unsigned kw[4]; };
__device__ __forceinline__ void ld_common(f32x4& g0, f32x4& g1, unsigned (&vw)[8], const float* LOGA, const bf16_t* Ugla, size_t row0, int h, int tid) {
    const float* gp = LOGA + (row0 + (tid >> 3)) * 256 + h * 64 + (tid & 7) * 8; g0 = *(const f32x4*)gp; g1 = *(const f32x4*)(gp + 4);
    const bf16_t* vp = Ugla + (row0 + (tid >> 7) * 16) * 1536 + 512 + h * 128 + (tid & 127);
#pragma unroll
    for (int j = 0; j < 8; ++j) vw[j] = (unsigned)vp[(size_t)(2 * j) * 1536] | ((unsigned)vp[(size_t)(2 * j + 1) * 1536] << 16);
}
__device__ __forceinline__ void ld_state(LdState& L, const float* LOGA, const bf16_t* Ugla, size_t row0, int h, int tid) {
    ld_common(L.g0, L.g1, L.vw, LOGA, Ugla, row0, h, tid);
    const bf16_t* kp = Ugla + (row0 + (tid >> 6) * 8) * 1536 + 256 + h * 64 + (tid & 63);
#pragma unroll
    for (int j = 0; j < 4; ++j) L.kw[j] = (unsigned)kp[(size_t)(2 * j) * 1536] | ((unsigned)kp[(size_t)(2 * j + 1) * 1536] << 16);
}
__device__ __forceinline__ void stage_common(LAS unsigned char* lds, const f32x4& g0, const f32x4& g1, const unsigned (&vw)[8], int tid) {
    LAS float* Bc = (LAS float*)(lds + L_BC);
    *(LAS f32x4*)(Bc + (tid >> 3) * 64 + (tid & 7) * 8) = g0; *(LAS f32x4*)(Bc + (tid >> 3) * 64 + (tid & 7) * 8 + 4) = g1;
    LAS u32x4* dst = (LAS u32x4*)(lds + L_VT + ((tid & 127) * GP + (tid >> 7) * 16) * 2);
    dst[0] = (u32x4){vw[0], vw[1], vw[2], vw[3]}; dst[1] = (u32x4){vw[4], vw[5], vw[6], vw[7]};
}
__device__ __forceinline__ void cumsum_inplace(LAS unsigned char* lds, int lane, int wave) {
    LAS float* Bc = (LAS float*)(lds + L_BC);
    if (wave == 0) { float acc = 0.f;
#pragma unroll 16
        for (int s = 0; s < 64; ++s) { acc += Bc[s * 64 + lane]; Bc[s * 64 + lane] = acc; } }
}
__device__ __forceinline__ void chunk_state4(LAS unsigned char* lds, int b, int n, const float* LOGA, const bf16_t* Ugla, float* SCt, float* DEC, int tid, int lane, int wave) {
    const size_t row0 = (size_t)b * SEQ + n * 64;
    LAS float* Bc = (LAS float*)(lds + L_BC);
    LdState cur; ld_state(cur, LOGA, Ugla, row0, 0, tid);
#pragma unroll 1
    for (int h = 0; h < 4; ++h) {
        const int q = ((b * 4 + h) << 6) + n;
        stage_common(lds, cur.g0, cur.g1, cur.vw, tid);
        __syncthreads();
        cumsum_inplace(lds, lane, wave);
        __syncthreads();
        { const int k = tid & 63, sg = tid >> 6; const float bl = Bc[63 * 64 + k]; float f[8];
#pragma unroll
            for (int j = 0; j < 4; ++j) { f[2 * j] = lo_bf(cur.kw[j]) * __expf(bl - Bc[(sg * 8 + 2 * j) * 64 + k]); f[2 * j + 1] = hi_bf(cur.kw[j]) * __expf(bl - Bc[(sg * 8 + 2 * j + 1) * 64 + k]); }
            *(LAS u32x4*)(lds + L_QI + (k * GP + sg * 8) * 2) = (u32x4){pk2(f[0], f[1]), pk2(f[2], f[3]), pk2(f[4], f[5]), pk2(f[6], f[7])};
            if (tid < 64) DEC[(size_t)q * 64 + tid] = __expf(bl); }
        LdState nxt = cur; if (h < 3) ld_state(nxt, LOGA, Ugla, row0, h + 1, tid);
        __syncthreads();
        { const int fr = lane & 15, fq = lane >> 4, mt = wave >> 1;
#pragma unroll
            for (int j = 0; j < 4; ++j) { const int nt = (wave & 1) * 4 + j; f32x4 acc = {0.f, 0.f, 0.f, 0.f};
#pragma unroll
                for (int ks = 0; ks < 2; ++ks) acc = __builtin_amdgcn_mfma_f32_16x16x32_bf16(frag(lds + L_QI, 16 * mt + fr, 32 * ks + 8 * fq), frag(lds + L_VT, 16 * nt + fr, 32 * ks + 8 * fq), acc, 0, 0, 0);
                *(f32x4*)(SCt + (size_t)q * 8192 + (16 * nt + fr) * 64 + 16 * mt + 4 * fq) = acc; } }
        __syncthreads();
        cur = nxt;
    }
}
struct LdOut { f32x4 g0, g1; unsigned vw[8]; u32x4 qw, kw, r0, r1; bf16x8 sp[4][2]; };
__device__ __forceinline__ void ld_out(LdOut& L, const float* LOGA, const bf16_t* Ugla, const bf16_t* SPt, size_t row0, int h, int q, int tid, int lane, int wave) {
    ld_common(L.g0, L.g1, L.vw, LOGA, Ugla, row0, h, tid);
    const bf16_t* rp = Ugla + (row0 + (tid >> 3)) * 1536 + h * 64 + (tid & 7) * 8; L.qw = *(const u32x4*)rp; L.kw = *(const u32x4*)(rp + 256);
    const bf16_t* gp = Ugla + (row0 + (tid >> 3)) * 1536 + 1024 + h * 128 + (tid & 7) * 16; L.r0 = *(const u32x4*)gp; L.r1 = *(const u32x4*)(gp + 8);
    const int fr = lane & 15, fq = lane >> 4;
#pragma unroll
    for (int j = 0; j < 4; ++j)
#pragma unroll
        for (int ks = 0; ks < 2; ++ks) L.sp[j][ks] = *(const bf16x8*)(SPt + (size_t)q * 8192 + (16 * ((wave & 1) * 4 + j) + fr) * 64 + 32 * ks + 8 * fq);
}
__device__ __forceinline__ void chunk_out4(LAS unsigned char* lds, int b, int n, const float* LOGA, const bf16_t* Ugla, const bf16_t* SPt, const float* gog, bf16_t* OA, int tid, int lane, int wave) {
    const size_t row0 = (size_t)b * SEQ + n * 64;
    LAS float* Bc = (LAS float*)(lds + L_BC); LAS float* Of = (LAS float*)(lds + L_OF);
    const int fr = lane & 15, fq = lane >> 4;
    LdOut cur; ld_out(cur, LOGA, Ugla, SPt, row0, 0, ((b * 4) << 6) + n, tid, lane, wave);
#pragma unroll 1
    for (int h = 0; h < 4; ++h) {
        stage_common(lds, cur.g0, cur.g1, cur.vw, tid);
        __syncthreads();
        cumsum_inplace(lds, lane, wave);
        __syncthreads();
        { const int s = tid >> 3, k0 = (tid & 7) * 8; float qf[8], kf[8];
            qf[0] = lo_bf(cur.qw.x); qf[1] = hi_bf(cur.qw.x); qf[2] = lo_bf(cur.qw.y); qf[3] = hi_bf(cur.qw.y); qf[4] = lo_bf(cur.qw.z); qf[5] = hi_bf(cur.qw.z); qf[6] = lo_bf(cur.qw.w); qf[7] = hi_bf(cur.qw.w);
            kf[0] = lo_bf(cur.kw.x); kf[1] = hi_bf(cur.kw.x); kf[2] = lo_bf(cur.kw.y); kf[3] = hi_bf(cur.kw.y); kf[4] = lo_bf(cur.kw.z); kf[5] = hi_bf(cur.kw.z); kf[6] = lo_bf(cur.kw.w); kf[7] = hi_bf(cur.kw.w);
#pragma unroll
            for (int e = 0; e < 8; ++e) { const float bv = Bc[s * 64 + k0 + e]; qf[e] *= 0.125f * __expf(bv); kf[e] *= __expf(-bv); }
            *(LAS u32x4*)(lds + L_QI + (s * GP + k0) * 2) = (u32x4){pk2(qf[0], qf[1]), pk2(qf[2], qf[3]), pk2(qf[4], qf[5]), pk2(qf[6], qf[7])};
            *(LAS u32x4*)(lds + L_KI + (s * GP + k0) * 2) = (u32x4){pk2(kf[0], kf[1]), pk2(kf[2], kf[3]), pk2(kf[4], kf[5]), pk2(kf[6], kf[7])}; }
        __syncthreads();
#pragma unroll
        for (int j = 0; j < 2; ++j) { const int t = 2 * wave + j, mt = t >> 2, nt = t & 3; f32x4 acc = {0.f, 0.f, 0.f, 0.f};
#pragma unroll
            for (int ks = 0; ks < 2; ++ks) acc = __builtin_amdgcn_mfma_f32_16x16x32_bf16(frag(lds + L_QI, 16 * mt + fr, 32 * ks + 8 * fq), frag(lds + L_KI, 16 * nt + fr, 32 * ks + 8 * fq), acc, 0, 0, 0);
            LAS bf16_t* ap = (LAS bf16_t*)(lds + L_ATT); const int sc = 16 * nt + fr;
#pragma unroll
            for (int r = 0; r < 4; ++r) { const int c = 16 * mt + 4 * fq + r; ap[c * GP + sc] = (bf16_t)f2bf(sc <= c ? acc[r] : 0.f); } }
        __syncthreads();
        { const int mt = wave >> 1;
#pragma unroll
            for (int j = 0; j < 4; ++j) { const int nt = (wave & 1) * 4 + j; f32x4 acc = {0.f, 0.f, 0.f, 0.f};
#pragma unroll
                for (int ks = 0; ks < 2; ++ks) { acc = __builtin_amdgcn_mfma_f32_16x16x32_bf16(frag(lds + L_ATT, 16 * mt + fr, 32 * ks + 8 * fq), frag(lds + L_VT, 16 * nt + fr, 32 * ks + 8 * fq), acc, 0, 0, 0);
                    acc = __builtin_amdgcn_mfma_f32_16x16x32_bf16(frag(lds + L_QI, 16 * mt + fr, 32 * ks + 8 * fq), cur.sp[j][ks], acc, 0, 0, 0); }
#pragma unroll
                for (int r = 0; r < 4; ++r) Of[(16 * mt + 4 * fq + r) * OFP + 16 * nt + fr] = acc[r]; } }
        const u32x4 r0 = cur.r0, r1 = cur.r1;
        if (h < 3) ld_out(cur, LOGA, Ugla, SPt, row0, h + 1, ((b * 4 + h + 1) << 6) + n, tid, lane, wave);
        __syncthreads();
        { const int c = tid >> 3, v0 = (tid & 7) * 16; float o[16]; float ss = 0.f;
#pragma unroll
            for (int e = 0; e < 16; e += 4) { const f32x4 t4 = *(const LAS f32x4*)(Of + c * OFP + v0 + e); o[e] = t4.x; o[e + 1] = t4.y; o[e + 2] = t4.z; o[e + 3] = t4.w; ss += (t4.x * t4.x + t4.y * t4.y) + (t4.z * t4.z + t4.w * t4.w); }
            ss += __shfl_xor(ss, 1); ss += __shfl_xor(ss, 2); ss += __shfl_xor(ss, 4);
            const float rstd = rsqrtf(ss * (1.f / 128.f) + 1e-6f);
            const unsigned rw[8] = {r0.x, r0.y, r0.z, r0.w, r1.x, r1.y, r1.z, r1.w}; unsigned ow[8];
#pragma unroll
            for (int e = 0; e < 8; ++e) { const float a = o[2 * e] * rstd * gog[v0 + 2 * e] * siluf_(lo_bf(rw[e])), b2 = o[2 * e + 1] * rstd * gog[v0 + 2 * e + 1] * siluf_(hi_bf(rw[e])); ow[e] = pk2(a, b2); }
            bf16_t* op = OA + (row0 + c) * 512 + h * 128 + v0; *(u32x4*)op = (u32x4){ow[0], ow[1], ow[2], ow[3]}; *(u32x4*)(op + 8) = (u32x4){ow[4], ow[5], ow[6], ow[7]}; }
    }
}
}

#define XB_TMO      128
#define XB_XCNT(j)  (256  + 64 * (j))
#define XB_XSUB(j)  (1280 + 64 * (j))
#define XB_XGEN(j)  (2304 + 64 * (j))
#define XB_TOP      3328
#define XB_TOPGEN   3392
#define XCD_BAR_WORDS 3456
#define XB_SPIN_CAP (1u << 18)
__device__ __forceinline__ unsigned xb_ld(unsigned* p)              { return __hip_atomic_load(p, __ATOMIC_RELAXED, __HIP_MEMORY_SCOPE_AGENT); }
__device__ __forceinline__ unsigned xb_add(unsigned* p, unsigned v) { return __hip_atomic_fetch_add(p, v, __ATOMIC_RELAXED, __HIP_MEMORY_SCOPE_AGENT); }
__device__ __forceinline__ unsigned xb_xcc_id() { return (unsigned)__builtin_amdgcn_s_getreg((3 << 11) | 20) & 0xFu; }
#define XB_SPIN(cond, bar) do { unsigned _sp = 0; while (cond) { __builtin_amdgcn_s_sleep(1); \
    if ((++_sp & 255u) == 0u) { if (xb_ld(&(bar)[XB_TMO])) break; if (_sp > XB_SPIN_CAP) { atomicAdd(&(bar)[XB_TMO], 1u); break; } } } } while (0)
struct XcdBarrier { unsigned* bar; unsigned x; volatile LAS unsigned* st; };
__device__ __forceinline__ XcdBarrier xcd_barrier_post(unsigned* bar, volatile LAS unsigned* st) {
    XcdBarrier b; b.bar = bar; b.x = xb_xcc_id(); b.st = st;
    if (threadIdx.x == 0) (void)xb_add(&bar[XB_XCNT(b.x)], 1u);
    return b;
}
__device__ __forceinline__ void xcd_barrier_complete(unsigned* bar, unsigned x, unsigned& nloc, unsigned& nx) {
    const unsigned G = gridDim.x * gridDim.y * gridDim.z;
    unsigned sum, cnt, mine, sp = 0u;
    for (;;) {
        sum = 0u; cnt = 0u; mine = 0u;
#pragma unroll
        for (unsigned j = 0; j < 16; ++j) { const unsigned c = xb_ld(&bar[XB_XCNT(j)]); sum += c; cnt += (c > 0u) ? 1u : 0u; mine = (j == x) ? c : mine; }
        if (sum == G) break;
        __builtin_amdgcn_s_sleep(1);
        if ((++sp & 255u) == 0u) { if (xb_ld(&bar[XB_TMO])) break; if (sp > XB_SPIN_CAP) { atomicAdd(&bar[XB_TMO], 1u); break; } }
    }
    nloc = mine > 0u ? mine : 1u; nx = cnt > 0u ? cnt : 1u;
}
__device__ __forceinline__ void xcd_barrier(const XcdBarrier& b) {
    asm volatile("s_waitcnt vmcnt(0)" ::: "memory");
    __syncthreads();
    if (threadIdx.x == 0) {
        unsigned* bar = b.bar;
        __builtin_amdgcn_s_waitcnt(0);
        unsigned nloc = b.st[0], nx = b.st[1];
        if (nloc == 0u) { xcd_barrier_complete(bar, b.x, nloc, nx); b.st[0] = nloc; b.st[1] = nx; }
        const unsigned old = xb_add(&bar[XB_XSUB(b.x)], 1u);
        const unsigned gen = old / nloc;
        if (old + 1u == (gen + 1u) * nloc) {
            __builtin_amdgcn_fence(__ATOMIC_RELEASE, "agent");
            asm volatile("s_waitcnt vmcnt(0)" ::: "memory");
            const unsigned og = xb_add(&bar[XB_TOP], 1u);
            const unsigned tg = og / nx;
            if (og + 1u == (tg + 1u) * nx) xb_add(&bar[XB_TOPGEN], 1u);
            else XB_SPIN(xb_ld(&bar[XB_TOPGEN]) == tg, bar);
            __builtin_amdgcn_fence(__ATOMIC_ACQUIRE, "agent");
            xb_add(&bar[XB_XGEN(b.x)], 1u);
            asm volatile("s_waitcnt vmcnt(0)" ::: "memory");
        } else {
            XB_SPIN(xb_ld(&bar[XB_XGEN(b.x)]) == gen, bar);
            __builtin_amdgcn_fence(__ATOMIC_ACQUIRE, "agent");
            asm volatile("s_waitcnt vmcnt(0)" ::: "memory");
        }
    }
    __syncthreads();
}

struct Args { const void* in[28]; float* out; unsigned char* ws; int ph_lo, ph_hi; };
enum { I_X = 0, I_C, I_POS, I_ADAW, I_ADAB, I_N1G, I_N2G, I_WIN, I_AUP, I_AB, I_GOG, I_DQG, I_DKG, I_LQ1, I_LK1, I_LQ2, I_LK2, I_DOG, I_WBA, I_WBB, I_WOUT, I_RGW, I_RGB, I_REW, I_REB, I_EW1, I_EW3, I_EW2 };

struct TrJob { const float* src; bf16_t* dst; int ldn, kdst; };
__device__ __forceinline__ void tr_load(f32x4 (&v)[8], const TrJob& J, int lane) {
#pragma unroll
    for (int i = 0; i < 8; ++i) v[i] = *(const f32x4*)(J.src + (size_t)(8 * i + (lane >> 3)) * J.ldn + (lane & 7) * 4);
}
__device__ __forceinline__ void tr_store(const f32x4 (&v)[8], const TrJob& J, LAS float* scr, int lane) {
#pragma unroll
    for (int i = 0; i < 8; ++i) { LAS float* p = scr + (8 * i + (lane >> 3)) * 33 + (lane & 7) * 4; p[0] = v[i].x; p[1] = v[i].y; p[2] = v[i].z; p[3] = v[i].w; }
    LDS_WAIT(); asm volatile("" ::: "memory");
    const int c = lane & 7;
#pragma unroll
    for (int j = 0; j < 4; ++j) { const int n = (lane >> 3) + 8 * j; const LAS float* sp = scr + (8 * c) * 33 + n;
        u32x4 o; o.x = pk2(sp[0 * 33], sp[1 * 33]); o.y = pk2(sp[2 * 33], sp[3 * 33]); o.z = pk2(sp[4 * 33], sp[5 * 33]); o.w = pk2(sp[6 * 33], sp[7 * 33]);
        *(u32x4*)(J.dst + (size_t)n * J.kdst + 8 * c) = o; }
    LDS_WAIT(); asm volatile("" ::: "memory");
}
template <class Dec> __device__ __forceinline__ void tr_run(int first, int total, int stride, const Dec& dec, LAS float* scr, int lane) {
    int it = first; if (it >= total) return;
    TrJob J0 = dec(it), J1 = J0; f32x4 a[8], b[8];
    tr_load(a, J0, lane);
    const bool has1 = it + stride < total; if (has1) { J1 = dec(it + stride); tr_load(b, J1, lane); }
    for (;;) {
        const int n2 = it + 2 * stride; const bool more2 = n2 < total; TrJob J2 = J1; f32x4 c[8];
        if (more2) { J2 = dec(n2); tr_load(c, J2, lane); }
        tr_store(a, J0, scr, lane);
        if (it + stride >= total) break;
#pragma unroll
        for (int i = 0; i < 8; ++i) { a[i] = b[i]; b[i] = c[i]; }
        J0 = J1; J1 = J2; it += stride;
    }
}
struct DecDense { const float *w_in, *wa, *wb, *wo; bf16_t *Win_t, *Wa_t, *Wb_t, *Wout_t;
    __device__ __forceinline__ TrJob operator()(int r) const {
        if (r < 2560) { const int kb = r / 160, nb = r % 160, n0 = 32 * nb, ns = n0 < 1536 ? n0 : n0 + 16; return TrJob{w_in + (size_t)(64 * kb) * DIN + ns, Win_t + (size_t)n0 * D + 64 * kb, DIN, D}; }
        r -= 2560;
        if (r < 256) { const int kb = r / 32, nb = r % 32; return TrJob{wa + (size_t)(64 * kb) * D + 32 * nb, Wa_t + (size_t)(32 * nb) * 512 + 64 * kb, D, 512}; }
        r -= 256;
        if (r < 256) { const int kb = r / 32, nb = r % 32; return TrJob{wb + (size_t)(64 * kb) * D + 32 * nb, Wb_t + (size_t)(32 * nb) * 512 + 64 * kb, D, 512}; }
        r -= 256;
        { const int kb = r / 32, nb = r % 32; return TrJob{wo + (size_t)(64 * kb) * D + 32 * nb, Wout_t + (size_t)(32 * nb) * D + 64 * kb, D, D}; }
    } };
struct DecExp { const float *w1, *w3, *w2; bf16_t *W13_t, *W2_t;
    __device__ __forceinline__ TrJob operator()(int it) const {
        const int e = it / 768, r = it % 768;
        if (r < 512) { const int kb = r >> 5, nb = r & 31, r0 = 32 * nb, pn = r0 >> 8, half = (r0 >> 7) & 1, jj = r0 & 127;
            const float* p1 = w1; const float* p3 = w3; asm volatile("" : "+s"(p1), "+s"(p3));
            return TrJob{(half ? p3 : p1) + (size_t)e * D * DEXP + (size_t)(64 * kb) * DEXP + 128 * pn + jj, W13_t + (size_t)e * 1024 * 1024 + (size_t)r0 * D + 64 * kb, DEXP, D}; }
        const int r2 = r - 512, kb = r2 >> 5, nb = r2 & 31;
        return TrJob{w2 + (size_t)e * DEXP * D + (size_t)(64 * kb) * D + 32 * nb, W2_t + (size_t)e * 1024 * 512 + (size_t)(32 * nb) * DEXP + 64 * kb, D, DEXP};
    } };

constexpr int TBL_OFF = LDSCTL_OFF + 1024;
constexpr int TBL_CNT = 0, TBL_PAD = 32, TBL_TE = 96, TBL_RO = 320;
constexpr int GCNT_W = 8192;
constexpr int ESEG = 32768;
__device__ __forceinline__ int build_moe_tables(LAS int* tb, const unsigned* gcnt, int tid) {
    if (tid < 32) tb[TBL_CNT + tid] = (int)gcnt[tid];
    __syncthreads();
    if (tid == 0) { int off = 0; for (int e = 0; e < 32; ++e) { tb[TBL_PAD + e] = off; off += ((tb[TBL_CNT + e] + 255) >> 8) << 8; } tb[TBL_PAD + 32] = off; }
    __syncthreads();
    if (tid < 32) { for (int t = tb[TBL_PAD + tid] >> 8; t < (tb[TBL_PAD + tid + 1] >> 8); ++t) tb[TBL_TE + t] = tid; }
    __syncthreads();
    return tb[TBL_PAD + 32] >> 8;
}
#define PHASE_LOCALS int tid_l = threadIdx.x; asm volatile("" : "+v"(tid_l)); int cb_l = blockIdx.x; asm volatile("" : "+s"(cb_l)); \
    const int tid = tid_l, lane = tid & 63, wave = __builtin_amdgcn_readfirstlane(tid >> 6), cb = cb_l, G = 256, gw = cb * NWAVES + wave, NGW = G * NWAVES; (void)lane; (void)gw; (void)NGW; (void)G;
template <int IDX> __device__ __forceinline__ const void* ldarg() {
    unsigned long long p;
    asm volatile("s_load_dwordx2 %0, %1, %2\n\ts_waitcnt lgkmcnt(0)" : "=s"(p) : "s"(__builtin_amdgcn_kernarg_segment_ptr()), "n"(IDX * 8) : "memory");
    return (const void*)(GAS const void*)p;
}
#define ARG_IN(i) (ldarg<(i)>())
#define ARG_WS ((unsigned char*)ldarg<29>())
#define XIN ((const float*)ARG_IN(I_X))
#define OUTP ((float*)ldarg<28>())
#define P_MODP ((float*)(ARG_WS + WS_MODP))
#define P_MODF ((float*)(ARG_WS + WS_MODF))
#define P_ALR ((float*)(ARG_WS + WS_ALR))
#define P_WIN ((bf16_t*)(ARG_WS + WS_WIN))
#define P_WA ((bf16_t*)(ARG_WS + WS_WA))
#define P_WB ((bf16_t*)(ARG_WS + WS_WB))
#define P_WOUT ((bf16_t*)(ARG_WS + WS_WOUT))
#define P_XN ((bf16_t*)(ARG_WS + WS_XN))
#define P_LOGA ((float*)(ARG_WS + WS_LOGA))
#define P_SCT ((float*)(ARG_WS + WS_SCT))
#define P_SPT ((bf16_t*)(ARG_WS + WS_SPT))
#define P_OC ((bf16_t*)(ARG_WS + WS_OC))
#define P_DEC ((float*)(ARG_WS + WS_DEC))
#define P_WRT ((float*)(ARG_WS + WS_WRT))
#define P_LRT ((float*)(ARG_WS + WS_LRT))
#define P_OB ((bf16_t*)(ARG_WS + WS_OB))
#define P_OA ((bf16_t*)(ARG_WS + WS_OA))
#define P_XS ((bf16_t*)(ARG_WS + WS_XS))
#define P_Y ((bf16_t*)(ARG_WS + WS_Y))
#define P_UGLA ((bf16_t*)(ARG_WS + WS_UGLA))
#define P_UDIFF ((bf16_t*)(ARG_WS + WS_UDIFF))
#define P_UGATE ((bf16_t*)(ARG_WS + WS_UGATE))
#define P_M1 ((bf16_t*)(ARG_WS + WS_M1))
#define P_MERGED ((bf16_t*)(ARG_WS + WS_MERGED))
#define P_H2 ((bf16_t*)(ARG_WS + WS_H2))
#define P_SLOTTOK ((int*)(ARG_WS + WS_SLOTTOK))
#define P_W13 ((bf16_t*)(ARG_WS + WS_W13))
#define P_W2 ((bf16_t*)(ARG_WS + WS_W2))
#define P_HMID ((bf16_t*)(ARG_WS + WS_HMID))
#define P_TOKE ((int*)(ARG_WS + WS_ROUTE + RT_TOKE))
#define P_TOKW ((float*)(ARG_WS + WS_ROUTE + RT_TOKW))
#define P_RANK ((int*)(ARG_WS + WS_ROUTE + RT_RANK))
#define P_SLOT ((int*)(ARG_WS + WS_ROUTE + RT_SLOT))
#define P_BLKCNT ((int*)(ARG_WS + WS_ROUTE + RT_BLKCNT))
#define P_TILEE ((int*)(ARG_WS + WS_ROUTE + RT_TILEE))
#define P_NT ((int*)(ARG_WS + WS_ROUTE + RT_NT))
template <int LO, int HI>
__global__ void __launch_bounds__(NTHR, 2) mk_fwd(Args args) {
    extern __shared__ __attribute__((aligned(16))) unsigned char lds_raw[];
    LAS unsigned char* lds = (LAS unsigned char*)lds_raw;
    volatile LAS unsigned* MISC = (volatile LAS unsigned*)(lds + MISC_OFF);
    unsigned* ctl = (unsigned*)(ARG_WS + WS_CTL);
    for (int u = threadIdx.x; u < (LDS_BYTES - LDSCTL_OFF) / 4; u += NTHR) ((LAS unsigned*)(lds + LDSCTL_OFF))[u] = 0u;
    __syncthreads();
    constexpr int lo = LO, hi = HI;
    XcdBarrier bar; bar.bar = ctl + CW_BAR; bar.x = 0; bar.st = nullptr;
    if constexpr (hi - lo > 1) bar = xcd_barrier_post(ctl + CW_BAR, MISC + 8);
#define IN(k) (lo <= (k) && (k) < hi)
#define SEAM(k) do { if constexpr (IN(k) && IN((k) + 1)) xcd_barrier(bar); } while (0)

    if constexpr (IN(0)) {
        asm volatile("; PHASE_BEGIN 0" ::: "memory");
        PHASE_LOCALS
        float* modp = P_MODP; bf16_t* Win_t = P_WIN; bf16_t* Wa_t = P_WA; bf16_t* Wb_t = P_WB; bf16_t* Wout_t = P_WOUT;
        const float* cvec = (const float*)ARG_IN(I_C); const float* ada_w = (const float*)ARG_IN(I_ADAW);
        const float* w_in = (const float*)ARG_IN(I_WIN);
        LAS float* scr = (LAS float*)(lds + wave * 16384);
        for (int r = gw; r < 768; r += NGW) {
            const int jc = r % 24, kc = r / 24, j = jc * 256 + lane * 4;
            f32x4 a0 = {0, 0, 0, 0}, a1 = a0, a2 = a0, a3 = a0;
#pragma unroll 8
            for (int kk = 0; kk < 32; ++kk) { const int k = kc * 32 + kk; const f32x4 w = *(const f32x4*)(ada_w + (size_t)k * NMOD + j);
                a0 += siluf_(cvec[k]) * w; a1 += siluf_(cvec[D + k]) * w; a2 += siluf_(cvec[2 * D + k]) * w; a3 += siluf_(cvec[3 * D + k]) * w; }
            *(f32x4*)(modp + (size_t)(kc * 4 + 0) * NMOD + j) = a0; *(f32x4*)(modp + (size_t)(kc * 4 + 1) * NMOD + j) = a1;
            *(f32x4*)(modp + (size_t)(kc * 4 + 2) * NMOD + j) = a2; *(f32x4*)(modp + (size_t)(kc * 4 + 3) * NMOD + j) = a3; }
        { const float* Wrg = (const float*)ARG_IN(I_RGW); const float* Wre = (const float*)ARG_IN(I_REW); float* WrT = P_WRT;
          for (int idx = cb * NTHR + tid; idx < 36 * D; idx += G * NTHR) { const int j = idx >> 10, k = idx & 1023; WrT[idx] = j < 4 ? Wrg[k * 4 + j] : Wre[k * 32 + (j - 4)]; } }
        { float* LrT = P_LRT;
          for (int idx = cb * NTHR + tid; idx < 16 * D; idx += G * NTHR) { const int r = idx >> 10, k = idx & 1023; LrT[idx] = w_in[(size_t)k * DIN + 1536 + r]; } }
        { const DecDense dec{w_in, (const float*)ARG_IN(I_WBA), (const float*)ARG_IN(I_WBB), (const float*)ARG_IN(I_WOUT), Win_t, Wa_t, Wb_t, Wout_t};
          tr_run(gw, 2560 + 256 + 256 + 512, NGW, dec, scr, lane); }
    }
    SEAM(0);

    if constexpr (IN(1)) {
        asm volatile("; PHASE_BEGIN 1" ::: "memory");
        PHASE_LOCALS
        const float* x = XIN; float* modp = P_MODP; float* modf = P_MODF; float* alr = P_ALR; bf16_t* XN = P_XN;
        const float* ada_b = (const float*)ARG_IN(I_ADAB); const float* g1 = (const float*)ARG_IN(I_N1G);
        LAS float* modS = (LAS float*)lds;
        const float* LrT = P_LRT;
        const int b = cb >> 6;
        f32x4 hv[8][4];
        const size_t m0 = (size_t)cb * 64 + wave * 8;
#pragma unroll
        for (int i = 0; i < 8; ++i) { const f32x4* xr = (const f32x4*)(x + (m0 + i) * D) + lane;
#pragma unroll
            for (int j = 0; j < 4; ++j) hv[i][j] = xr[64 * j]; }
        { const int j = tid * 4; f32x4 s = *(const f32x4*)(ada_b + j);
#pragma unroll 8
            for (int kc = 0; kc < 32; ++kc) s += *(const f32x4*)(modp + (size_t)(kc * 4 + b) * NMOD + j);
            if (j >= D) s += 1.0f;
            *(LAS f32x4*)(modS + j) = s; }
        if (tid < 96) { const int idx = cb * 96 + tid, bb = idx / NMOD, j = idx % NMOD; float s = ada_b[j];
#pragma unroll 8
            for (int kc = 0; kc < 32; ++kc) s += modp[(size_t)(kc * 4 + bb) * NMOD + j];
            modf[idx] = s; }
        __syncthreads();
#pragma unroll
        for (int i = 0; i < 8; ++i) { float ss = 0.f;
#pragma unroll
            for (int j = 0; j < 4; ++j) ss += (hv[i][j].x * hv[i][j].x + hv[i][j].y * hv[i][j].y) + (hv[i][j].z * hv[i][j].z + hv[i][j].w * hv[i][j].w);
            const float rstd = rsqrtf(wave_sum(ss) * (1.f / D) + 1e-6f);
            unsigned long long* o8 = (unsigned long long*)(XN + (m0 + i) * D) + lane;
#pragma unroll
            for (int j = 0; j < 4; ++j) { const int k = 4 * lane + 256 * j; const f32x4 gg = *(const f32x4*)(g1 + k); const f32x4 sh = *(const LAS f32x4*)(modS + k); const f32x4 sc = *(const LAS f32x4*)(modS + D + k);
                hv[i][j] = hv[i][j] * rstd * gg * sc + sh;
                o8[64 * j] = (unsigned long long)pk2(hv[i][j].x, hv[i][j].y) | ((unsigned long long)pk2(hv[i][j].z, hv[i][j].w) << 32); } }
        { float res[8];
#pragma unroll
          for (int i = 0; i < 8; ++i) res[i] = 0.f;
          f32x4 wn[4];
#pragma unroll
          for (int jj = 0; jj < 4; ++jj) wn[jj] = *(const f32x4*)(LrT + 4 * lane + 256 * jj);
#pragma unroll 1
          for (int r = 0; r < 16; ++r) {
            f32x4 w[4];
#pragma unroll
            for (int jj = 0; jj < 4; ++jj) w[jj] = wn[jj];
            const int rn = r < 15 ? r + 1 : r;
#pragma unroll
            for (int jj = 0; jj < 4; ++jj) wn[jj] = *(const f32x4*)(LrT + (size_t)rn * D + 4 * lane + 256 * jj);
#pragma unroll
            for (int i = 0; i < 8; ++i) { float a = 0.f;
#pragma unroll
                for (int jj = 0; jj < 4; ++jj) a += (hv[i][jj].x * w[jj].x + hv[i][jj].y * w[jj].y) + (hv[i][jj].z * w[jj].z + hv[i][jj].w * w[jj].w);
                a = wave_sum(a); if (lane == r) res[i] = a; }
          }
#pragma unroll
          for (int i = 0; i < 8; ++i) if (lane < 16) alr[(m0 + i) * 16 + lane] = res[i]; }
    }
    SEAM(1);

    if constexpr (IN(2)) {
        asm volatile("; PHASE_BEGIN 2" ::: "memory");
        PHASE_LOCALS
        bf16_t* XN = P_XN; bf16_t* Win_t = P_WIN; bf16_t* Ugla = P_UGLA; bf16_t* Udiff = P_UDIFF; bf16_t* Ugate = P_UGATE;
        pg8::DenseOrder S; S.init(XN, Win_t, M, NPROJ, D, G, cb);
        pg8::EpiInProj E{Ugla, Udiff, Ugate};
        pg8::gemm_phase<pg8::EpiInProj, pg8::DenseOrder, true>(lds, D, S, E);
    }
    SEAM(2);

    if constexpr (IN(3)) {
        asm volatile("; PHASE_BEGIN 3" ::: "memory");
        PHASE_LOCALS
        bf16_t* Udiff = P_UDIFF; float* alr = P_ALR; float* LOGA = P_LOGA;
        const int* pos = (const int*)ARG_IN(I_POS); const float* qg = (const float*)ARG_IN(I_DQG); const float* kg = (const float*)ARG_IN(I_DKG);
        const float* aup = (const float*)ARG_IN(I_AUP); const float* ab = (const float*)ARG_IN(I_AB);
        const float invf = powf(500000.0f, -(float)(lane & 7) * 0.125f);
        const size_t m0 = (size_t)cb * 64 + wave * 8;
        u32x4 w0[8], w1[8]; float posv[8], av[8];
#pragma unroll
        for (int i = 0; i < 8; ++i) { const bf16_t* rowp = Udiff + (m0 + i) * 1536 + lane * 16; w0[i] = *(const u32x4*)rowp; w1[i] = *(const u32x4*)(rowp + 8);
            posv[i] = (float)pos[m0 + i]; av[i] = alr[(m0 + i) * 16 + (lane & 15)]; }
        float gain[16];
#pragma unroll
        for (int e = 0; e < 16; ++e) gain[e] = (lane < 32 ? qg : kg)[(lane & 3) * 16 + e];
        float au[16][4], abv[4];
#pragma unroll
        for (int q = 0; q < 4; ++q) { abv[q] = ab[lane + 64 * q];
#pragma unroll
            for (int rr = 0; rr < 16; ++rr) au[rr][q] = aup[rr * 256 + lane + 64 * q]; }
#pragma unroll
        for (int i = 0; i < 8; ++i) {
            float y[16];
            y[0] = lo_bf(w0[i].x); y[1] = hi_bf(w0[i].x); y[2] = lo_bf(w0[i].y); y[3] = hi_bf(w0[i].y); y[4] = lo_bf(w0[i].z); y[5] = hi_bf(w0[i].z); y[6] = lo_bf(w0[i].w); y[7] = hi_bf(w0[i].w);
            y[8] = lo_bf(w1[i].x); y[9] = hi_bf(w1[i].x); y[10] = lo_bf(w1[i].y); y[11] = hi_bf(w1[i].y); y[12] = lo_bf(w1[i].z); y[13] = hi_bf(w1[i].z); y[14] = lo_bf(w1[i].w); y[15] = hi_bf(w1[i].w);
            float ss = 0.f;
#pragma unroll
            for (int e = 0; e < 16; ++e) ss += y[e] * y[e];
            ss += __shfl_xor(ss, 1); ss += __shfl_xor(ss, 2);
            const float rstd = rsqrtf(ss * (1.f / 64.f) + 1e-6f);
#pragma unroll
            for (int e = 0; e < 16; ++e) y[e] = y[e] * rstd * gain[e];
            const float ang = posv[i] * invf; float sv, cv; sincosf(ang, &sv, &cv);
            float r[16];
#pragma unroll
            for (int e = 0; e < 8; ++e) { const float c_ = __shfl(cv, e), s_ = __shfl(sv, e); r[e] = y[e] * c_ - y[e + 8] * s_; r[e + 8] = y[e + 8] * c_ + y[e] * s_; }
            if ((lane & 3) == 0) {
#pragma unroll
                for (int e = 0; e < 16; ++e) y[e] = r[e]; }
            if (lane < 32) {
#pragma unroll
                for (int e = 0; e < 16; ++e) y[e] *= attn_body::C2; }
            u32x4 o0, o1; o0.x = pk2(y[0], y[1]); o0.y = pk2(y[2], y[3]); o0.z = pk2(y[4], y[5]); o0.w = pk2(y[6], y[7]); o1.x = pk2(y[8], y[9]); o1.y = pk2(y[10], y[11]); o1.z = pk2(y[12], y[13]); o1.w = pk2(y[14], y[15]);
            bf16_t* rowp = Udiff + (m0 + i) * 1536 + lane * 16;
            *(u32x4*)rowp = o0; *(u32x4*)(rowp + 8) = o1;
            float xv[4];
#pragma unroll
            for (int q = 0; q < 4; ++q) xv[q] = abv[q];
#pragma unroll
            for (int rr = 0; rr < 16; ++rr) { const float a = __shfl(av[i], rr);
#pragma unroll
                for (int q = 0; q < 4; ++q) xv[q] += a * au[rr][q]; }
#pragma unroll
            for (int q = 0; q < 4; ++q) { const float ls = fminf(xv[q], 0.f) - log1pf(__expf(-fabsf(xv[q]))); LOGA[(m0 + i) * 256 + lane + 64 * q] = ls * (1.f / 16.f); }
        }
        VM_WAIT(); __syncthreads();
        gla::chunk_state4(lds, cb >> 6, cb & 63, LOGA, P_UGLA, P_SCT, P_DEC, tid, lane, wave);
    }
    SEAM(3);

    if constexpr (IN(4)) {
        asm volatile("; PHASE_BEGIN 4" ::: "memory");
        PHASE_LOCALS
        { const float* SCt = P_SCT; const float* DEC = P_DEC; bf16_t* SPt = P_SPT;
          const int idx = cb * NTHR + tid, bh = idx >> 13, e = idx & 8191, k = e & 63; float st = 0.f;
#pragma unroll 8
          for (int n = 0; n < 64; ++n) { const size_t q = (size_t)bh * 64 + n; const float sc = SCt[q * 8192 + e], d = DEC[q * 64 + k]; SPt[q * 8192 + e] = (bf16_t)f2bf(st); st = st * d + sc; } }
        { const int vcu = (cb % 8) * (G / 8) + cb / 8;
          attn_body::attn_phase<8>((char*)lds_raw, (const attn_body::bf16*)P_UDIFF, (attn_body::bf16*)P_OC, vcu); }
    }
    SEAM(4);

    if constexpr (IN(5)) {
        asm volatile("; PHASE_BEGIN 5" ::: "memory");
        PHASE_LOCALS
        { const float* lq1 = (const float*)ARG_IN(I_LQ1); const float* lk1 = (const float*)ARG_IN(I_LK1); const float* lq2 = (const float*)ARG_IN(I_LQ2); const float* lk2 = (const float*)ARG_IN(I_LK2);
          const float* og = (const float*)ARG_IN(I_DOG); const bf16_t* Oc = P_OC; bf16_t* OB = P_OB;
          const float lam = __expf(wave_sum(lq1[lane] * lk1[lane])) - __expf(wave_sum(lq2[lane] * lk2[lane])) + 0.2f;
          const size_t m0 = (size_t)cb * 64 + wave * 8; const int col0 = lane * 8;
          u32x4 av[8], bv[8];
#pragma unroll
          for (int i = 0; i < 8; ++i) { av[i] = *(const u32x4*)(Oc + (m0 + i) * 512 + col0); bv[i] = *(const u32x4*)(Oc + (size_t)M * 512 + (m0 + i) * 512 + col0); }
          float ogv[8];
#pragma unroll
          for (int e = 0; e < 8; ++e) ogv[e] = og[(col0 & 127) + e];
#pragma unroll
          for (int i = 0; i < 8; ++i) {
            const unsigned aw[4] = {av[i].x, av[i].y, av[i].z, av[i].w}, bw[4] = {bv[i].x, bv[i].y, bv[i].z, bv[i].w}; float o[8]; float ss = 0.f;
#pragma unroll
            for (int e = 0; e < 4; ++e) { o[2 * e] = lo_bf(aw[e]) - lam * lo_bf(bw[e]); o[2 * e + 1] = hi_bf(aw[e]) - lam * hi_bf(bw[e]); ss += o[2 * e] * o[2 * e] + o[2 * e + 1] * o[2 * e + 1]; }
            ss += __shfl_xor(ss, 1); ss += __shfl_xor(ss, 2); ss += __shfl_xor(ss, 4); ss += __shfl_xor(ss, 8);
            const float rstd = rsqrtf(ss * (1.f / 128.f) + 1e-6f) * 0.8f; unsigned ow[4];
#pragma unroll
            for (int e = 0; e < 4; ++e) ow[e] = pk2(o[2 * e] * rstd * ogv[2 * e], o[2 * e + 1] * rstd * ogv[2 * e + 1]);
            *(u32x4*)(OB + (m0 + i) * 512 + col0) = (u32x4){ow[0], ow[1], ow[2], ow[3]}; } }
        __syncthreads();
        gla::chunk_out4(lds, cb >> 6, cb & 63, P_LOGA, P_UGLA, P_SPT, (const float*)ARG_IN(I_GOG), P_OA, tid, lane, wave);
    }
    SEAM(5);

    if constexpr (IN(6)) {
        asm volatile("; PHASE_BEGIN 6" ::: "memory");
        PHASE_LOCALS
        bf16_t* OA = P_OA; bf16_t* OB = P_OB; bf16_t* Wa_t = P_WA; bf16_t* Wb_t = P_WB; bf16_t* Ugate = P_UGATE; bf16_t* M1 = P_M1; bf16_t* MERGED = P_MERGED;
        { pg8::DenseOrder S; S.init(OA, Wa_t, M, D, 512, G, cb); pg8::EpiBranch E{Ugate, 0, nullptr, M1};
          pg8::gemm_phase<pg8::EpiBranch, pg8::DenseOrder, true>(lds, 512, S, E); }
        VM_WAIT(); __syncthreads();
        { pg8::DenseOrder S; S.init(OB, Wb_t, M, D, 512, G, cb); pg8::EpiBranch E{Ugate, 1024, M1, MERGED};
          pg8::gemm_phase<pg8::EpiBranch, pg8::DenseOrder, true>(lds, 512, S, E); }
    }
    SEAM(6);

    if constexpr (IN(7)) {
        asm volatile("; PHASE_BEGIN 7" ::: "memory");
        PHASE_LOCALS
        const float* x = XIN; float* out = OUTP; float* modf = P_MODF; bf16_t* MERGED = P_MERGED; bf16_t* Wout_t = P_WOUT;
        pg8::DenseOrder S; S.init(MERGED, Wout_t, M, D, D, G, cb); pg8::EpiWout E{x, modf, out};
        pg8::gemm_phase<pg8::EpiWout, pg8::DenseOrder, true>(lds, D, S, E);
    }
    SEAM(7);

    if constexpr (IN(8)) {
        asm volatile("; PHASE_BEGIN 8" ::: "memory");
        PHASE_LOCALS
        float* out = OUTP; float* modf = P_MODF; bf16_t* H2 = P_H2; bf16_t* W13_t = P_W13; bf16_t* W2_t = P_W2; int* tok_e = P_TOKE; float* tok_w = P_TOKW; int* tok_rank = P_RANK; int* slot_tok = P_SLOTTOK;
        const float* g2 = (const float*)ARG_IN(I_N2G); const float* brg = (const float*)ARG_IN(I_RGB); const float* bre = (const float*)ARG_IN(I_REB); const float* WrT = P_WRT;
        LAS float* modS = (LAS float*)lds;
        LAS int* eS = (LAS int*)(lds + 8192);
        LAS float* LG = (LAS float*)(lds + 8192 + 512);
        const int b = cb >> 6;
        for (int j = tid; j < 2048; j += NTHR) modS[j] = modf[(size_t)b * NMOD + 3 * D + j] + (j >= D ? 1.0f : 0.f);
        __syncthreads();
        if (wave < 4) {
            const float biasv = lane < 4 ? brg[lane] : (lane < 36 ? bre[lane - 4] : 0.f);
            LAS float* lgw = LG + wave * 320;
#pragma unroll 1
            for (int hb = 0; hb < 2; ++hb) {
                f32x4 hv[8][4];
                const size_t m0 = (size_t)cb * 64 + wave * 16 + hb * 8;
#pragma unroll
                for (int i = 0; i < 8; ++i) { const f32x4* xr = (const f32x4*)(out + (m0 + i) * D) + lane;
#pragma unroll
                    for (int j = 0; j < 4; ++j) hv[i][j] = xr[64 * j]; }
#pragma unroll
                for (int i = 0; i < 8; ++i) { float ss = 0.f;
#pragma unroll
                    for (int j = 0; j < 4; ++j) ss += (hv[i][j].x * hv[i][j].x + hv[i][j].y * hv[i][j].y) + (hv[i][j].z * hv[i][j].z + hv[i][j].w * hv[i][j].w);
                    const float rstd = rsqrtf(wave_sum(ss) * (1.f / D) + 1e-6f);
                    unsigned long long* o8 = (unsigned long long*)(H2 + (m0 + i) * D) + lane;
#pragma unroll
                    for (int j = 0; j < 4; ++j) { const int k = 4 * lane + 256 * j; const f32x4 gg = *(const f32x4*)(g2 + k); const f32x4 sh = *(const LAS f32x4*)(modS + k); const f32x4 sc = *(const LAS f32x4*)(modS + D + k);
                        hv[i][j] = hv[i][j] * rstd * gg * sc + sh;
                        o8[64 * j] = (unsigned long long)pk2(hv[i][j].x, hv[i][j].y) | ((unsigned long long)pk2(hv[i][j].z, hv[i][j].w) << 32); } }
                { f32x4 wn[4];
#pragma unroll
                  for (int jj = 0; jj < 4; ++jj) wn[jj] = *(const f32x4*)(WrT + 4 * lane + 256 * jj);
#pragma unroll 1
                  for (int jx = 0; jx < 36; ++jx) {
                    f32x4 w[4];
#pragma unroll
                    for (int jj = 0; jj < 4; ++jj) w[jj] = wn[jj];
                    const int jn = jx < 35 ? jx + 1 : jx;
#pragma unroll
                    for (int jj = 0; jj < 4; ++jj) wn[jj] = *(const f32x4*)(WrT + (size_t)jn * D + 4 * lane + 256 * jj);
                    float a[8];
#pragma unroll
                    for (int i = 0; i < 8; ++i) { a[i] = 0.f;
#pragma unroll
                        for (int jj = 0; jj < 4; ++jj) a[i] += (hv[i][jj].x * w[jj].x + hv[i][jj].y * w[jj].y) + (hv[i][jj].z * w[jj].z + hv[i][jj].w * w[jj].w); }
                    float y0, y1; reduce8(a, y0, y1);
                    const float bj = __shfl(biasv, jx);
                    if ((lane & 15) == 0) { lgw[(2 * (lane >> 4)) * 40 + jx] = y0 + bj; lgw[(2 * (lane >> 4) + 1) * 40 + jx] = y1 + bj; }
                  } }
                LDS_WAIT();
                if (lane < 8) {
                    const LAS float* lr = lgw + lane * 40; const int tl = wave * 16 + hb * 8 + lane;
                    const float lg0 = lr[0], lg1 = lr[1], lg2 = lr[2], lg3 = lr[3];
                    int gi = 0; float gm = lg0; if (lg1 > gm) { gm = lg1; gi = 1; } if (lg2 > gm) { gm = lg2; gi = 2; } if (lg3 > gm) { gm = lg3; gi = 3; }
                    const float ptop = 1.0f / (__expf(lg0 - gm) + __expf(lg1 - gm) + __expf(lg2 - gm) + __expf(lg3 - gm));
                    float el[8];
#pragma unroll
                    for (int j = 0; j < 8; ++j) el[j] = lr[4 + gi * 8 + j];
                    int j0 = 0; float e0 = el[0];
#pragma unroll
                    for (int j = 1; j < 8; ++j) if (el[j] > e0) { e0 = el[j]; j0 = j; }
                    int j1 = -1; float e1 = -3.0e38f;
#pragma unroll
                    for (int j = 0; j < 8; ++j) if (j != j0 && el[j] > e1) { e1 = el[j]; j1 = j; }
                    const float t = __expf(e1 - e0), w0 = ptop / (1.0f + t), w1 = ptop * t / (1.0f + t);
                    eS[2 * tl] = gi * 8 + j0; eS[2 * tl + 1] = gi * 8 + j1; tok_w[(m0 + lane) * 2] = w0; tok_w[(m0 + lane) * 2 + 1] = w1;
                }
                LDS_WAIT();
            }
        } else {
            const DecExp dec{(const float*)ARG_IN(I_EW1), (const float*)ARG_IN(I_EW3), (const float*)ARG_IN(I_EW2), W13_t, W2_t};
            tr_run(cb * 4 + (wave - 4), NEXP * 768, G * 4, dec, (LAS float*)(lds + 16384 + (wave - 4) * 16384), lane);
        }
        __syncthreads();
        {
            LAS int* baseS = eS + 128; int e = 0, rank = 0;
            if (tid < 128) { e = eS[tid]; for (int a = 0; a < tid; ++a) rank += (eS[a] == e) ? 1 : 0; }
            else if (tid < 160) { const int ee = tid - 128; int cnt = 0; for (int a = 0; a < 128; ++a) cnt += (eS[a] == ee) ? 1 : 0;
                baseS[ee] = cnt ? (int)__hip_atomic_fetch_add((unsigned*)(ARG_WS + WS_CTL) + GCNT_W + ee, (unsigned)cnt, __ATOMIC_RELAXED, __HIP_MEMORY_SCOPE_AGENT) : 0; }
            __syncthreads();
            if (tid < 128) { const int g = baseS[e] + rank; tok_e[(size_t)cb * 128 + tid] = e; tok_rank[(size_t)cb * 128 + tid] = g; slot_tok[(size_t)e * ESEG + g] = cb * 64 + (tid >> 1); }
        }
    }
    SEAM(8);

    if constexpr (IN(9)) {
        asm volatile("; PHASE_BEGIN 9" ::: "memory");
        PHASE_LOCALS
        bf16_t* H2 = P_H2; bf16_t* W13_t = P_W13; bf16_t* HMID = P_HMID; const int* slot_tok = P_SLOTTOK;
        LAS int* tb = (LAS int*)(lds + TBL_OFF);
        const int ntm = __builtin_amdgcn_readfirstlane(build_moe_tables(tb, (const unsigned*)(ARG_WS + WS_CTL) + GCNT_W, tid));
        pg8::MoeOrder S; S.init(H2, W13_t, tb + TBL_TE, (const LAS unsigned*)(tb + TBL_RO), ntm, D, (size_t)1024 * 1024 * 2, G, cb); pg8::EpiUp E{HMID};
        { pg8::Unit u;
          for (int i = 0; i < 3; ++i) if (S.next(i, u) && tid < 256) { const int e = u.aux, idx = u.pm * 256 - tb[TBL_PAD + e] + tid;
              const int tok = idx < tb[TBL_CNT + e] ? slot_tok[(size_t)e * ESEG + idx] : 0; tb[TBL_RO + i * 256 + tid] = tok * (D * 2); } }
        __syncthreads();
        pg8::gemm_phase<pg8::EpiUp, pg8::MoeOrder, true, true>(lds, D, S, E);
    }
    SEAM(9);

    if constexpr (IN(10)) {
        asm volatile("; PHASE_BEGIN 10" ::: "memory");
        PHASE_LOCALS
        bf16_t* HMID = P_HMID; bf16_t* W2_t = P_W2; bf16_t* Y = P_Y;
        LAS int* tb = (LAS int*)(lds + TBL_OFF);
        const int ntm = __builtin_amdgcn_readfirstlane(build_moe_tables(tb, (const unsigned*)(ARG_WS + WS_CTL) + GCNT_W, tid));
        pg8::MoeOrder S; S.init(HMID, W2_t, tb + TBL_TE, nullptr, ntm, DEXP, (size_t)1024 * 512 * 2, G, cb); pg8::EpiPlain E{Y, D};
        pg8::gemm_phase<pg8::EpiPlain, pg8::MoeOrder, true>(lds, DEXP, S, E);
    }
    SEAM(10);

    if constexpr (IN(11)) {
        asm volatile("; PHASE_BEGIN 11" ::: "memory");
        PHASE_LOCALS
        float* out = OUTP; float* modf = P_MODF; bf16_t* Y = P_Y; const int* tok_e = P_TOKE; const int* tok_rank = P_RANK; float* tok_w = P_TOKW;
        LAS int* tb = (LAS int*)(lds + TBL_OFF);
        (void)build_moe_tables(tb, (const unsigned*)(ARG_WS + WS_CTL) + GCNT_W, tid);
        const size_t m0 = (size_t)cb * 64 + wave * 8; const float* g2p = modf + (size_t)(cb >> 6) * NMOD + 5 * D;
        int s0[8], s1[8]; float w0[8], w1[8];
#pragma unroll
        for (int i = 0; i < 8; ++i) { const int e0 = __builtin_amdgcn_readfirstlane(tok_e[(m0 + i) * 2]), e1 = __builtin_amdgcn_readfirstlane(tok_e[(m0 + i) * 2 + 1]);
            s0[i] = tb[TBL_PAD + e0] + tok_rank[(m0 + i) * 2]; s1[i] = tb[TBL_PAD + e1] + tok_rank[(m0 + i) * 2 + 1]; w0[i] = tok_w[(m0 + i) * 2]; w1[i] = tok_w[(m0 + i) * 2 + 1]; }
        f32x4 gv[4];
#pragma unroll
        for (int j = 0; j < 4; ++j) gv[j] = *(const f32x4*)(g2p + 4 * lane + 256 * j);
#pragma unroll
        for (int hb = 0; hb < 2; ++hb) {
            f32x4 xv[4][4]; u32x2 y0[4][4], y1[4][4];
#pragma unroll
            for (int i4 = 0; i4 < 4; ++i4) { const int i = hb * 4 + i4;
#pragma unroll
                for (int j = 0; j < 4; ++j) { const int k = 4 * lane + 256 * j; xv[i4][j] = *(const f32x4*)(out + (m0 + i) * D + k);
                    y0[i4][j] = *(const u32x2*)(Y + (size_t)s0[i] * D + k); y1[i4][j] = *(const u32x2*)(Y + (size_t)s1[i] * D + k); } }
#pragma unroll
            for (int i4 = 0; i4 < 4; ++i4) { const int i = hb * 4 + i4;
#pragma unroll
                for (int j = 0; j < 4; ++j) { const int k = 4 * lane + 256 * j; f32x4 o;
                    o.x = xv[i4][j].x + gv[j].x * (w0[i] * lo_bf(y0[i4][j].x) + w1[i] * lo_bf(y1[i4][j].x)); o.y = xv[i4][j].y + gv[j].y * (w0[i] * hi_bf(y0[i4][j].x) + w1[i] * hi_bf(y1[i4][j].x));
                    o.z = xv[i4][j].z + gv[j].z * (w0[i] * lo_bf(y0[i4][j].y) + w1[i] * lo_bf(y1[i4][j].y)); o.w = xv[i4][j].w + gv[j].w * (w0[i] * hi_bf(y0[i4][j].y) + w1[i] * hi_bf(y1[i4][j].y));
                    *(f32x4*)(out + (m0 + i) * D + k) = o; } }
        }
    }
#undef IN
#undef SEAM
}

constexpr int NPHASE = 12;
template <int LO, int HI> static void launch_range(const Args& a, hipStream_t stream) {
    static bool attr = false;
    if (!attr) { (void)hipFuncSetAttribute((const void*)mk_fwd<LO, HI>, hipFuncAttributeMaxDynamicSharedMemorySize, LDS_BYTES); attr = true; }
    hipLaunchKernelGGL((mk_fwd<LO, HI>), dim3(256), dim3(NTHR), LDS_BYTES, stream, a);
}
extern "C" void kernel_launch(void* const* d_in, const int* in_sizes, int n_in, void* d_out, int out_size, void* d_ws, size_t ws_size, hipStream_t stream) {
    static int ok = 0;
    if (ok == 0) {
        if (n_in != 28 || out_size != M * D || ws_size < WS_END) { fprintf(stderr, "kernel_launch: unexpected shapes (n_in %d, out %d, ws %zu < %zu)\n", n_in, out_size, ws_size, (size_t)WS_END); ok = -1; return; }
        ok = 1;
    }
    if (ok < 0) return;
    (void)hipMemsetAsync((char*)d_ws + WS_CTL, 0, CTL_ZERO_BYTES, stream);
    Args a{};
    for (int i = 0; i < 28; ++i) a.in[i] = d_in[i];
    a.out = (float*)d_out; a.ws = (unsigned char*)d_ws; a.ph_lo = 0; a.ph_hi = NPHASE;
#if MK_ONE_LAUNCH
    launch_range<0, NPHASE>(a, stream);
#else
    launch_range<0, 1>(a, stream); launch_range<1, 2>(a, stream); launch_range<2, 3>(a, stream); launch_range<3, 4>(a, stream);
    launch_range<4, 5>(a, stream); launch_range<5, 6>(a, stream); launch_range<6, 7>(a, stream); launch_range<7, 8>(a, stream);
    launch_range<8, 9>(a, stream); launch_range<9, 10>(a, stream); launch_range<10, 11>(a, stream); launch_range<11, 12>(a, stream);
#endif
}
```

```cpp
#include <hip/hip_runtime.h>
#include <hip/hip_bf16.h>
#include <cstdio>
#include <cstdint>

#ifndef MK_ONE_LAUNCH
#define MK_ONE_LAUNCH 1
#endif

#define LAS __attribute__((address_space(3)))
#define GAS __attribute__((address_space(1)))
typedef unsigned short bf16_t;
typedef short bf16x8 __attribute__((ext_vector_type(8)));
typedef float f32x4 __attribute__((ext_vector_type(4)));
typedef float f32x2 __attribute__((ext_vector_type(2)));
typedef unsigned u32x4 __attribute__((ext_vector_type(4)));
typedef unsigned u32x2 __attribute__((ext_vector_type(2)));

constexpr int NB = 4, SEQ = 4096, D = 1024, M = NB * SEQ;
constexpr int DIN = 5136, NPROJ = 5120;
constexpr int NEXP = 32, DEXP = 512;
constexpr int PMAX = 40960;
constexpr int NMOD = 6 * D;

constexpr size_t MiB = 1u << 20;
constexpr size_t WS_CTL = 0, CTL_ZERO_BYTES = 1 * MiB;
constexpr size_t WS_MODP = 1 * MiB;
constexpr size_t WS_MODF = 4 * MiB;
constexpr size_t WS_ALR = 5 * MiB;
constexpr size_t WS_ROUTE = 6 * MiB;
constexpr size_t WS_WIN = 8 * MiB;
constexpr size_t WS_WA = 18 * MiB, WS_WB = 19 * MiB, WS_WOUT = 20 * MiB;
constexpr size_t RA = 22 * MiB;
constexpr size_t RB = 118 * MiB;
constexpr size_t WS_END = 278 * MiB;
constexpr size_t WS_XN = RA;
constexpr size_t WS_LOGA = RA;
constexpr size_t WS_SCT = RA + 16 * MiB;
constexpr size_t WS_SPT = RA + 48 * MiB;
constexpr size_t WS_OC = RA + 64 * MiB;
constexpr size_t WS_DEC = 7 * MiB;
constexpr size_t WS_WRT = 7 * MiB + 512 * 1024;
constexpr size_t WS_LRT = 7 * MiB + 768 * 1024;
constexpr size_t WS_OB = RB + 64 * MiB;
constexpr size_t WS_OA = RB + 48 * MiB;
constexpr size_t WS_XS = RA;
constexpr size_t WS_Y = RA;
constexpr size_t WS_UGLA = RB;
constexpr size_t WS_UDIFF = RB + 48 * MiB;
constexpr size_t WS_UGATE = RB + 96 * MiB;
constexpr size_t WS_M1 = RA;
constexpr size_t WS_MERGED = RB;
constexpr size_t WS_H2 = RA;
constexpr size_t WS_SLOTTOK = RA + 84 * MiB;
constexpr size_t WS_W13 = RB + 64 * MiB;
constexpr size_t WS_W2 = RB + 128 * MiB;
constexpr size_t WS_HMID = RB;
constexpr size_t RT_TOKE = 0, RT_TOKW = 131072, RT_RANK = 262144, RT_SLOT = 393216, RT_BLKCNT = 524288, RT_TILEE = 557056, RT_NT = 561152;
constexpr int CW_BAR = 4096;

constexpr int RING_BYTES = 131072;
constexpr int LDSCTL_OFF = RING_BYTES, MISC_OFF = LDSCTL_OFF + 320;
constexpr int LDS_BYTES = 147456;
constexpr int NWAVES = 8, NTHR = 512;

__device__ __forceinline__ float bf2f(bf16_t h) { return __uint_as_float((unsigned)h << 16); }
__device__ __forceinline__ unsigned f2bf(float f) { unsigned u = __float_as_uint(f); return (u + 0x7fffu + ((u >> 16) & 1u)) >> 16; }
typedef __bf16 bf16x2_t __attribute__((ext_vector_type(2)));
__device__ __forceinline__ unsigned pk2(float lo, float hi) { f32x2 v = {lo, hi}; bf16x2_t b = __builtin_convertvector(v, bf16x2_t); return __builtin_bit_cast(unsigned, b); }
__device__ __forceinline__ float lo_bf(unsigned w) { return __uint_as_float(w << 16); }
__device__ __forceinline__ float hi_bf(unsigned w) { return __uint_as_float(w & 0xffff0000u); }
#define DPP_ADD(v, ctrl) ((v) + __builtin_bit_cast(float, __builtin_amdgcn_update_dpp(0, __builtin_bit_cast(int, (v)), (ctrl), 0xF, 0xF, true)))
__device__ __forceinline__ float wave_sum(float v) {
    v = DPP_ADD(v, 0xB1); v = DPP_ADD(v, 0x4E); v = DPP_ADD(v, 0x141); v = DPP_ADD(v, 0x140);
    { const unsigned u = __float_as_uint(v); auto r = __builtin_amdgcn_permlane16_swap(u, u, false, false); v = __uint_as_float(r[0]) + __uint_as_float(r[1]); }
    { const unsigned u = __float_as_uint(v); auto r = __builtin_amdgcn_permlane32_swap(u, u, false, false); v = __uint_as_float(r[0]) + __uint_as_float(r[1]); }
    return v;
}
__device__ __forceinline__ void dot4_pk(f32x2& acc, const f32x4& h, const f32x4& w) { acc += (f32x2){h.x, h.y} * (f32x2){w.x, w.y}; acc += (f32x2){h.z, h.w} * (f32x2){w.z, w.w}; }
__device__ __forceinline__ float swapadd32(float x, float y) { auto r = __builtin_amdgcn_permlane32_swap(__float_as_uint(x), __float_as_uint(y), false, false); return __uint_as_float(r[0]) + __uint_as_float(r[1]); }
__device__ __forceinline__ float swapadd16(float x, float y) { auto r = __builtin_amdgcn_permlane16_swap(__float_as_uint(x), __float_as_uint(y), false, false); return __uint_as_float(r[0]) + __uint_as_float(r[1]); }
__device__ __forceinline__ void reduce8(const float (&a)[8], float& y0, float& y1) {
    const float x0 = swapadd32(a[0], a[4]), x1 = swapadd32(a[1], a[5]), x2 = swapadd32(a[2], a[6]), x3 = swapadd32(a[3], a[7]);
    y0 = swapadd16(x0, x2); y1 = swapadd16(x1, x3);
    y0 = DPP_ADD(y0, 0xB1); y0 = DPP_ADD(y0, 0x4E); y0 = DPP_ADD(y0, 0x141); y0 = DPP_ADD(y0, 0x140);
    y1 = DPP_ADD(y1, 0xB1); y1 = DPP_ADD(y1, 0x4E); y1 = DPP_ADD(y1, 0x141); y1 = DPP_ADD(y1, 0x140);
}
__device__ __forceinline__ float wave_max(float v) {
#pragma unroll
    for (int o = 1; o < 64; o <<= 1) v = fmaxf(v, __shfl_xor(v, o));
    return v;
}
__device__ __forceinline__ float sigmoidf_(float x) { return 1.0f / (1.0f + __expf(-x)); }
__device__ __forceinline__ float siluf_(float x) { return x / (1.0f + __expf(-x)); }
#define LDS_WAIT() asm volatile("s_waitcnt lgkmcnt(0)" ::: "memory")
#define VM_WAIT() asm volatile("s_waitcnt vmcnt(0)" ::: "memory")

namespace pg8 {
constexpr int BM = 256, BK = 64, HALF = 128, HTB = HALF * BK * 2, STAGE_BYTES = 8 * HTB, NXCD = 8, WGM = 8;
__host__ __device__ __forceinline__ int lds_byte(int r, int c) { const int st = (r >> 4) * 2 + (c >> 5), rr = r & 15, cc = c & 31, ob = rr * 64 + cc * 2; return st * 1024 + (ob ^ (((ob >> 9) & 1) << 5)); }
__host__ __device__ __forceinline__ void stage_rc(int b, int& R, int& C) { const int st = b / 1024, sb = b % 1024, swz = sb ^ (((sb >> 9) & 1) << 5); R = (st >> 1) * 16 + swz / 64; C = (st & 1) * 32 + (swz % 64) / 2; }
__host__ __device__ __forceinline__ int perm32(int rho) { const int n = rho >> 4, i = rho & 15; return 8 * (i >> 2) + 4 * n + (i & 3); }

struct Unit { int pm, pn, aux, ord; };

__device__ __forceinline__ int xcd_swizzle(int wgid, int nwg) { const int q = nwg / NXCD, r = nwg % NXCD, xcd = wgid % NXCD, off = wgid / NXCD; return (xcd < r ? xcd * (q + 1) : r * (q + 1) + (xcd - r) * q) + off; }

struct DenseOrder {
    const char* A; const char* Bt; size_t tstep; int nM, nN, nwg, G, c;
    __device__ __forceinline__ void init(const void* A_, const void* Bt_, int M_, int N_, int K_, int G_, int c_) { A = (const char*)A_; Bt = (const char*)Bt_; tstep = (size_t)BM * K_ * 2; nM = M_ / BM; nN = N_ / BM; nwg = nM * nN; G = G_; c = c_; }
    __device__ __forceinline__ bool next(int i, Unit& u) const {
        const long L = (long)i * G + c; if (L >= nwg) return false;
        const int wgid = xcd_swizzle((int)L, nwg);
        const int nig = WGM * nN, gid = wgid / nig, fm = gid * WGM, gsz = (nM - fm) < WGM ? (nM - fm) : WGM;
        u.pm = fm + ((wgid % nig) % gsz); u.pn = (wgid % nig) / gsz; u.aux = 0; u.ord = i; return true;
    }
    __device__ __forceinline__ const char* a_ptr(const Unit& u) const { return A + (size_t)u.pm * tstep; }
    __device__ __forceinline__ const char* b_ptr(const Unit& u) const { return Bt + (size_t)u.pn * tstep; }
    __device__ __forceinline__ unsigned row_off(const Unit&, int) const { return 0u; }
};
struct MoeOrder {
    const char* A; const char* W; const LAS int* tile_e; const LAS unsigned* rowoff; size_t tstep, estride; int nwg, G, c;
    __device__ __forceinline__ void init(const void* A_, const void* W_, const LAS int* te, const LAS unsigned* ro, int ntm, int K_, size_t estride_, int G_, int c_) { A = (const char*)A_; W = (const char*)W_; tile_e = te; rowoff = ro; tstep = (size_t)BM * K_ * 2; estride = estride_; nwg = ntm * 4; G = G_; c = c_; }
    __device__ __forceinline__ bool next(int i, Unit& u) const {
        const long L = (long)i * G + c; if (L >= nwg) return false;
        const int wgid = xcd_swizzle((int)L, nwg);
        u.pm = wgid >> 2; u.pn = wgid & 3; u.aux = __builtin_amdgcn_readfirstlane(tile_e[u.pm]); u.ord = i; return true;
    }
    __device__ __forceinline__ const char* a_ptr(const Unit& u) const { return rowoff ? A : A + (size_t)u.pm * tstep; }
    __device__ __forceinline__ const char* b_ptr(const Unit& u) const { return W + (size_t)u.aux * estride + (size_t)u.pn * tstep; }
    __device__ __forceinline__ unsigned row_off(const Unit& u, int r) const { return rowoff[u.ord * 256 + r]; }
};
__device__ __forceinline__ u32x4 pack8(const f32x4& v0, const f32x4& v1) { u32x4 w; w.x = pk2(v0[0], v0[1]); w.y = pk2(v0[2], v0[3]); w.z = pk2(v1[0], v1[1]); w.w = pk2(v1[2], v1[3]); return w; }

struct EpiInProj {
    static constexpr bool PERM = true, AFTER_DRAIN = false;
    bf16_t *Ugla, *Udiff, *Ugate;
    __device__ __forceinline__ void operator()(const f32x4 (&acc)[2][2][4][2], const Unit& u, int wr, int wc, int fr, int fq) const {
        bf16_t* base; int ldc, colt;
        if (u.pn < 6) { base = Ugla; ldc = 1536; colt = u.pn * 256; } else if (u.pn < 12) { base = Udiff; ldc = 1536; colt = (u.pn - 6) * 256; } else { base = Ugate; ldc = 2048; colt = (u.pn - 12) * 256; }
        const int row0 = u.pm * BM + wr * 64 + fr, col0 = colt + wc * 32 + 8 * fq;
#pragma unroll
        for (int ai = 0; ai < 2; ++ai)
#pragma unroll
            for (int m = 0; m < 4; ++m) { bf16_t* rowp = base + (size_t)(row0 + ai * HALF + m * 16) * ldc + col0;
#pragma unroll
                for (int bj = 0; bj < 2; ++bj) *(u32x4*)(rowp + bj * HALF) = pack8(acc[ai][bj][m][0], acc[ai][bj][m][1]); }
    }
};
struct EpiPlain {
    static constexpr bool PERM = true, AFTER_DRAIN = false;
    bf16_t* O; int ldc;
    __device__ __forceinline__ void operator()(const f32x4 (&acc)[2][2][4][2], const Unit& u, int wr, int wc, int fr, int fq) const {
        const int row0 = u.pm * BM + wr * 64 + fr, col0 = u.pn * BM + wc * 32 + 8 * fq;
#pragma unroll
        for (int ai = 0; ai < 2; ++ai)
#pragma unroll
            for (int m = 0; m < 4; ++m) { bf16_t* rowp = O + (size_t)(row0 + ai * HALF + m * 16) * ldc + col0;
#pragma unroll
                for (int bj = 0; bj < 2; ++bj) *(u32x4*)(rowp + bj * HALF) = pack8(acc[ai][bj][m][0], acc[ai][bj][m][1]); }
    }
};
struct EpiBranch {
    static constexpr bool PERM = true, AFTER_DRAIN = false;
    const bf16_t* gate; int gcol0; const bf16_t* m1in; bf16_t* out;
    __device__ __forceinline__ void operator()(const f32x4 (&acc)[2][2][4][2], const Unit& u, int wr, int wc, int fr, int fq) const {
        const int row0 = u.pm * BM + wr * 64 + fr, col0 = u.pn * BM + wc * 32 + 8 * fq;
#pragma unroll
        for (int ai = 0; ai < 2; ++ai)
#pragma unroll
            for (int m = 0; m < 4; ++m) { const size_t r = (size_t)(row0 + ai * HALF + m * 16);
#pragma unroll
                for (int bj = 0; bj < 2; ++bj) { const int c = col0 + bj * HALF;
                    const u32x4 g = *(const u32x4*)(gate + r * 2048 + gcol0 + c);
                    f32x4 v0 = acc[ai][bj][m][0], v1 = acc[ai][bj][m][1];
                    v0[0] *= sigmoidf_(lo_bf(g.x)); v0[1] *= sigmoidf_(hi_bf(g.x)); v0[2] *= sigmoidf_(lo_bf(g.y)); v0[3] *= sigmoidf_(hi_bf(g.y));
                    v1[0] *= sigmoidf_(lo_bf(g.z)); v1[1] *= sigmoidf_(hi_bf(g.z)); v1[2] *= sigmoidf_(lo_bf(g.w)); v1[3] *= sigmoidf_(hi_bf(g.w));
                    if (m1in) { const u32x4 p = *(const u32x4*)(m1in + r * 1024 + c);
                        v0[0] += lo_bf(p.x); v0[1] += hi_bf(p.x); v0[2] += lo_bf(p.y); v0[3] += hi_bf(p.y); v1[0] += lo_bf(p.z); v1[1] += hi_bf(p.z); v1[2] += lo_bf(p.w); v1[3] += hi_bf(p.w); }
                    *(u32x4*)(out + r * 1024 + c) = pack8(v0, v1); } }
    }
};
struct EpiWout {
    static constexpr bool PERM = false, AFTER_DRAIN = false;
    const float* x; const float* modf; float* out;
    __device__ __forceinline__ void operator()(const f32x4 (&acc)[2][2][4][2], const Unit& u, int wr, int wc, int fr, int fq) const {
        const int row0 = u.pm * BM + wr * 64 + fr, col0 = u.pn * BM + wc * 32 + 4 * fq;
        const float* g1 = modf + (size_t)((u.pm * BM) >> 12) * NMOD + 2 * D;
#pragma unroll
        for (int bj = 0; bj < 2; ++bj)
#pragma unroll
            for (int n = 0; n < 2; ++n) { const int c = col0 + bj * HALF + n * 16; const f32x4 gv = *(const f32x4*)(g1 + c);
#pragma unroll
                for (int ai = 0; ai < 2; ++ai)
#pragma unroll
                    for (int m = 0; m < 4; ++m) { const size_t off = (size_t)(row0 + ai * HALF + m * 16) * D + c;
                        const f32x4 xv = *(const f32x4*)(x + off); *(f32x4*)(out + off) = xv + gv * acc[ai][bj][m][n]; } }
    }
};
struct EpiUp {
    static constexpr bool PERM = true, AFTER_DRAIN = false;
    bf16_t* H;
    __device__ __forceinline__ void operator()(const f32x4 (&acc)[2][2][4][2], const Unit& u, int wr, int wc, int fr, int fq) const {
        const int row0 = u.pm * BM + wr * 64 + fr, col0 = u.pn * HALF + wc * 32 + 8 * fq;
#pragma unroll
        for (int ai = 0; ai < 2; ++ai)
#pragma unroll
            for (int m = 0; m < 4; ++m) { f32x4 v0, v1;
#pragma unroll
                for (int e = 0; e < 4; ++e) { v0[e] = siluf_(acc[ai][0][m][0][e]) * acc[ai][1][m][0][e]; v1[e] = siluf_(acc[ai][0][m][1][e]) * acc[ai][1][m][1][e]; }
                *(u32x4*)(H + (size_t)(row0 + ai * HALF + m * 16) * DEXP + col0) = pack8(v0, v1); }
    }
};

template <class Epi, class Sched, bool ALIGN_EPI = false, bool GATHER = false>
__device__ __forceinline__ void gemm_phase(LAS unsigned char* lds, const int K, const Sched& S, const Epi& E) {
    int tid_ = threadIdx.x; asm volatile("" : "+v"(tid_));
    const int tid = tid_, wid = __builtin_amdgcn_readfirstlane(tid >> 6), lane = tid & 63, wr = wid >> 2, wc = wid & 3, fr = lane & 15, fq = lane >> 4;
    const int nt = K / BK;
    const size_t kstep = (size_t)(BK * 2);
    const size_t hstep = (size_t)HALF * K * 2;
    unsigned vA0[2], vA1[2], nA0[2], nA1[2], voffB[2]; int Rr[2], Cc[2];
#pragma unroll
    for (int i = 0; i < 2; ++i) { int R, C; stage_rc(tid * 16 + i * 8192, R, C); const int Rb = Epi::PERM ? ((R & ~31) + perm32(R & 31)) : R; Rr[i] = R; Cc[i] = C;
        voffB[i] = (unsigned)(Rb * K + C) * 2u; }
#define PG8_SETOFF(u, o0, o1) do { _Pragma("unroll") for (int _i = 0; _i < 2; ++_i) { \
        if constexpr (GATHER) { o0[_i] = S.row_off(u, Rr[_i]) + (unsigned)Cc[_i] * 2u; o1[_i] = S.row_off(u, Rr[_i] + HALF) + (unsigned)Cc[_i] * 2u; } \
        else { o0[_i] = (unsigned)(Rr[_i] * K + Cc[_i]) * 2u; o1[_i] = o0[_i] + (unsigned)hstep; } } } while (0)
    const unsigned ldsw = (unsigned)wid * 1024u;
    const int aoff = lds_byte(wr * 64 + fr, fq * 8), boff = lds_byte(wc * 32 + fr, fq * 8);
#define PG8_SA(b, h) (((b) * 2 + (h)) * HTB)
#define PG8_SB(b, h) ((4 + (b) * 2 + (h)) * HTB)
#define PG8_STAGE(bufoff, gbase, voff) do { _Pragma("unroll") for (int _i = 0; _i < 2; ++_i) \
        __builtin_amdgcn_global_load_lds((const unsigned*)((const char*)(gbase) + (voff)[_i]), (LAS unsigned*)(lds + (bufoff) + ldsw + _i * 8192), 16, 0, 0); } while (0)
#define PG8_LDA(dst, b, h) do { _Pragma("unroll") for (int m = 0; m < 4; ++m) _Pragma("unroll") for (int k = 0; k < 2; ++k) dst[m][k] = *(const LAS bf16x8*)(lds + PG8_SA(b, h) + aoff + m * 2048 + k * 1024); } while (0)
#define PG8_LDB(dst, b, h) do { _Pragma("unroll") for (int n = 0; n < 2; ++n) _Pragma("unroll") for (int k = 0; k < 2; ++k) dst[n][k] = *(const LAS bf16x8*)(lds + PG8_SB(b, h) + boff + n * 2048 + k * 1024); } while (0)
#define PG8_MMA(ai, bj, At, Bt) do { __builtin_amdgcn_s_setprio(1); _Pragma("unroll") for (int m = 0; m < 4; ++m) _Pragma("unroll") for (int n = 0; n < 2; ++n) _Pragma("unroll") for (int k = 0; k < 2; ++k) \
        acc[ai][bj][m][n] = __builtin_amdgcn_mfma_f32_16x16x32_bf16(Bt[n][k], At[m][k], acc[ai][bj][m][n], 0, 0, 0); __builtin_amdgcn_s_setprio(0); } while (0)
#define PG8_WAIT_V(n) asm volatile("s_waitcnt vmcnt(" #n ")" ::: "memory")
#define PG8_WAIT_L(n) asm volatile("s_waitcnt lgkmcnt(" #n ")" ::: "memory")
#define PG8_BAR __builtin_amdgcn_s_barrier()
#define PG8_SCHED __builtin_amdgcn_sched_barrier(0)
    Unit cur, nxt; int ui = 0;
    if (!S.next(0, cur)) return;
    PG8_SETOFF(cur, vA0, vA1);
#pragma unroll
    for (int i = 0; i < 2; ++i) { nA0[i] = vA0[i]; nA1[i] = vA1[i]; }
    f32x4 acc[2][2][4][2];
#pragma unroll
    for (int a = 0; a < 2; ++a)
#pragma unroll
        for (int b = 0; b < 2; ++b)
#pragma unroll
            for (int m = 0; m < 4; ++m)
#pragma unroll
                for (int n = 0; n < 2; ++n) acc[a][b][m][n] = (f32x4){0.f, 0.f, 0.f, 0.f};
    bf16x8 At[4][2], B0[2][2], B1[2][2];
    const char* cA = S.a_ptr(cur); const char* cB = S.b_ptr(cur);
    PG8_STAGE(PG8_SB(0, 0), cB, voffB); PG8_STAGE(PG8_SB(0, 1), cB + hstep, voffB); PG8_STAGE(PG8_SA(0, 0), cA, vA0); PG8_STAGE(PG8_SA(0, 1), cA, vA1);
    if (wr == 1) PG8_BAR;
    PG8_WAIT_V(2); PG8_BAR;
    PG8_STAGE(PG8_SB(1, 0), cB + kstep, voffB); PG8_STAGE(PG8_SA(1, 0), cA + kstep, vA0); PG8_STAGE(PG8_SB(1, 1), cB + hstep + kstep, voffB);
    PG8_WAIT_V(6); PG8_BAR;
    for (;;) {
        const bool has_next = S.next(ui + 1, nxt);
        const char* nA = has_next ? S.a_ptr(nxt) : cA; const char* nB = has_next ? S.b_ptr(nxt) : cB;
        if constexpr (GATHER) { if (has_next) PG8_SETOFF(nxt, nA0, nA1); }
        for (int t = 0; t < nt; t += 2) {
            const bool last = (t == nt - 2);
            const char* a1 = cA + (size_t)(t + 1) * kstep;
            const char* a2 = last ? nA : cA + (size_t)(t + 2) * kstep; const char* b2 = last ? nB : cB + (size_t)(t + 2) * kstep;
            const char* a3 = a2 + kstep; const char* b3 = b2 + kstep;
            unsigned w0[2], w1[2];
#pragma unroll
            for (int i = 0; i < 2; ++i) { if constexpr (GATHER) { w0[i] = last ? nA0[i] : vA0[i]; w1[i] = last ? nA1[i] : vA1[i]; } else { w0[i] = vA0[i]; w1[i] = vA1[i]; } }
            PG8_LDB(B0, 0, 0); PG8_LDB(B1, 0, 1); PG8_SCHED; PG8_LDA(At, 0, 0); PG8_STAGE(PG8_SA(1, 1), a1, vA1);
            PG8_WAIT_V(8); PG8_WAIT_L(0); PG8_BAR; PG8_MMA(0, 0, At, B0); PG8_MMA(0, 1, At, B1); PG8_BAR; PG8_SCHED;
            PG8_LDA(At, 0, 1); PG8_STAGE(PG8_SB(0, 0), b2, voffB); PG8_STAGE(PG8_SB(0, 1), b2 + hstep, voffB); PG8_STAGE(PG8_SA(0, 0), a2, w0);
            PG8_WAIT_V(8); PG8_WAIT_L(0); PG8_BAR; PG8_MMA(1, 0, At, B0); PG8_MMA(1, 1, At, B1); PG8_BAR; PG8_SCHED;
            PG8_LDB(B0, 1, 0); PG8_LDB(B1, 1, 1); PG8_SCHED; PG8_LDA(At, 1, 0); PG8_STAGE(PG8_SA(0, 1), a2, w1);
            PG8_WAIT_V(8); PG8_WAIT_L(0); PG8_BAR; PG8_MMA(0, 0, At, B0); PG8_MMA(0, 1, At, B1); PG8_BAR; PG8_SCHED;
            PG8_LDA(At, 1, 1); PG8_STAGE(PG8_SB(1, 0), b3, voffB); PG8_STAGE(PG8_SB(1, 1), b3 + hstep, voffB); PG8_STAGE(PG8_SA(1, 0), a3, w0);
            PG8_WAIT_V(8); PG8_WAIT_L(0); PG8_BAR; PG8_MMA(1, 0, At, B0); PG8_MMA(1, 1, At, B1); PG8_BAR; PG8_SCHED;
        }
        if constexpr (ALIGN_EPI) { if (wr == 0) PG8_BAR; }
        E(acc, cur, wr, wc, fr, fq);
        if (!has_next) break;
#pragma unroll
        for (int a = 0; a < 2; ++a)
#pragma unroll
            for (int b = 0; b < 2; ++b)
#pragma unroll
                for (int m = 0; m < 4; ++m)
#pragma unroll
                    for (int n = 0; n < 2; ++n) acc[a][b][m][n] = (f32x4){0.f, 0.f, 0.f, 0.f};
        cur = nxt; cA = nA; cB = nB; ++ui;
#pragma unroll
        for (int i = 0; i < 2; ++i) { vA0[i] = nA0[i]; vA1[i] = nA1[i]; }
        if constexpr (ALIGN_EPI) { if (wr == 1) PG8_BAR; }
    }
    PG8_WAIT_V(0);
    if constexpr (!ALIGN_EPI) { if (wr == 0) PG8_BAR; }
    PG8_BAR;
#undef PG8_SETOFF
#undef PG8_SA
#undef PG8_SB
#undef PG8_STAGE
#undef PG8_LDA
#undef PG8_LDB
#undef PG8_MMA
#undef PG8_WAIT_V
#undef PG8_WAIT_L
#undef PG8_BAR
#undef PG8_SCHED
}
}

namespace attn_body {
using bf16=__hip_bfloat16;
using bf16x8=__attribute__((ext_vector_type(8)))short;
using s16x4=__attribute__((ext_vector_type(4)))short;
using f32x16=__attribute__((ext_vector_type(16)))float;
using u32x4=__attribute__((ext_vector_type(4)))unsigned;
constexpr int SEQ=4096,D=64,DM=1536,DMO=512;
constexpr int NW=8,QBLK=32,QB=QBLK*NW,KVBLK=64,NQB=SEQ/QB;
constexpr int ATTN_UNIT_ROWS=QB;
__device__ __forceinline__ int crow(int r,int hi){return (r&3)+8*(r>>2)+4*hi;}
#define SBAR() __builtin_amdgcn_sched_barrier(0)
__device__ __forceinline__ void cmask(f32x16&p0,f32x16&p1,int jb,int qrel,int hi){
  const float NEG=-INFINITY; int kb=64*jb+4*hi;
  #pragma unroll
  for(int r=0;r<16;++r){int kv=kb+(r&3)+8*(r>>2); if(kv>qrel)p0[r]=NEG; if(kv+32>qrel)p1[r]=NEG;}
}

constexpr int NSLOT=3, SLOTB=8192;
constexpr int LDS_K=0, LDS_V=NSLOT*SLOTB, LDS_WS=2*NSLOT*SLOTB, LDS_OST=LDS_WS+NW*64*4, LDS_BYTES=LDS_OST+NW*4096;
constexpr float C2=0.125f*1.4426950408889634f;
__device__ __forceinline__ void glds16(const void*gsrc,unsigned lds_dst){unsigned keep;
  asm volatile("s_mov_b32 %0, m0\n\ts_mov_b32 m0, %2\n\ts_nop 0\n\tglobal_load_lds_dwordx4 %1, off\n\ts_mov_b32 m0, %0":"=&s"(keep):"v"(gsrc),"s"(lds_dst):"memory");}
__device__ __forceinline__ float max3f(float a,float b,float c){float r;asm("v_max3_f32 %0, %1, %2, %3":"=v"(r):"v"(a),"v"(b),"v"(c));return r;}
__device__ __forceinline__ float max2f(float a,float b){float r;asm("v_max_f32_e32 %0, %1, %2":"=v"(r):"v"(a),"v"(b));return r;}
__device__ __forceinline__ float fadd_s(float a,float b){float r;asm("v_add_f32_e32 %0, %1, %2":"=v"(r):"v"(a),"v"(b));return r;}
__device__ __forceinline__ float fsub_s(float a,float b){float r;asm("v_sub_f32_e32 %0, %1, %2":"=v"(r):"v"(a),"v"(b));return r;}
typedef float f32x2_t __attribute__((ext_vector_type(2))); typedef __bf16 bf16x2_t __attribute__((ext_vector_type(2)));
__device__ __forceinline__ unsigned cvtpk_s(float lo,float hi){f32x2_t v={lo,hi};bf16x2_t b=__builtin_convertvector(v,bf16x2_t);return __builtin_bit_cast(unsigned,b);}
#define WAIT_BAR(N) asm volatile("s_waitcnt vmcnt(" #N ") lgkmcnt(0)\n\ts_barrier":::"memory")

__device__ __forceinline__ void qkt(f32x16&p0,f32x16&p1,const char*Kslot,const bf16x8*qr,const f32x16&negm,int r32,int hi){
  const char*kb=Kslot+hi*1024+r32*16;
  #pragma unroll
  for(int d0=0;d0<4;++d0){
    const bf16x8 b0=*reinterpret_cast<const bf16x8*>(kb+d0*2048);
    const bf16x8 b1=*reinterpret_cast<const bf16x8*>(kb+d0*2048+512);
    if(d0==0){p0=__builtin_amdgcn_mfma_f32_32x32x16_bf16(b0,qr[0],negm,0,0,0);p1=__builtin_amdgcn_mfma_f32_32x32x16_bf16(b1,qr[0],negm,0,0,0);}
    else{p0=__builtin_amdgcn_mfma_f32_32x32x16_bf16(b0,qr[d0],p0,0,0,0);p1=__builtin_amdgcn_mfma_f32_32x32x16_bf16(b1,qr[d0],p1,0,0,0);}}
}
typedef __attribute__((address_space(3))) const char* lds_cptr;
typedef short v4i16_t __attribute__((ext_vector_type(4)));
__device__ __forceinline__ void kload8(bf16x8*kf,lds_cptr kp){
  kf[0]=*(const __attribute__((address_space(3))) bf16x8*)(kp);      kf[1]=*(const __attribute__((address_space(3))) bf16x8*)(kp+512);
  kf[2]=*(const __attribute__((address_space(3))) bf16x8*)(kp+2048); kf[3]=*(const __attribute__((address_space(3))) bf16x8*)(kp+2560);
  kf[4]=*(const __attribute__((address_space(3))) bf16x8*)(kp+4096); kf[5]=*(const __attribute__((address_space(3))) bf16x8*)(kp+4608);
  kf[6]=*(const __attribute__((address_space(3))) bf16x8*)(kp+6144); kf[7]=*(const __attribute__((address_space(3))) bf16x8*)(kp+6656);
}
__device__ __forceinline__ void kload2(bf16x8*kf,lds_cptr kp,int j){ kf[2*j]=*(const __attribute__((address_space(3))) bf16x8*)(kp+j*2048); kf[2*j+1]=*(const __attribute__((address_space(3))) bf16x8*)(kp+j*2048+512); }
__device__ __forceinline__ s16x4 vtr(lds_cptr p){ return __builtin_bit_cast(s16x4,__builtin_amdgcn_ds_read_tr16_b64_v4i16((__attribute__((address_space(3))) v4i16_t*)p)); }
__device__ __forceinline__ float rowmax(const f32x16&p0,const f32x16&p1){
  float a=max3f(p0[0],p0[1],p1[0]),b=max3f(p0[2],p0[3],p1[1]);a=max3f(a,p1[2],p1[3]);
  #pragma unroll
  for(int r=4;r<16;r+=4){a=max3f(a,p0[r],p0[r+1]);b=max3f(b,p0[r+2],p0[r+3]);a=max3f(a,p1[r],p1[r+1]);b=max3f(b,p1[r+2],p1[r+3]);}
  const float m=max2f(a,b);
  auto rr=__builtin_amdgcn_permlane32_swap(__float_as_uint(m),__float_as_uint(m),false,false);
  return max2f(__uint_as_float(rr[0]),__uint_as_float(rr[1]));
}
__device__ __forceinline__ void pv(f32x16*o,int vb,bf16x8 pa0,bf16x8 pa1,bf16x8 pa2,bf16x8 pa3){
  #pragma unroll
  for(int d0=0;d0<2;++d0){s16x4 lo[4],hi[4];
    #pragma unroll
    for(int ks=0;ks<4;++ks){
      asm volatile("ds_read_b64_tr_b16 %0,%1 offset:%c2":"=&v"(lo[ks]):"v"(vb),"i"(d0*4096+ks*1024):"memory");
      asm volatile("ds_read_b64_tr_b16 %0,%1 offset:%c2":"=&v"(hi[ks]):"v"(vb),"i"(d0*4096+ks*1024+512):"memory");}
    asm volatile("s_waitcnt lgkmcnt(0)":::"memory");SBAR();
    #define PK(k) (bf16x8){lo[k][0],lo[k][1],lo[k][2],lo[k][3],hi[k][0],hi[k][1],hi[k][2],hi[k][3]}
    o[d0]=__builtin_amdgcn_mfma_f32_32x32x16_bf16(pa0,PK(0),o[d0],0,0,0);
    o[d0]=__builtin_amdgcn_mfma_f32_32x32x16_bf16(pa1,PK(1),o[d0],0,0,0);
    o[d0]=__builtin_amdgcn_mfma_f32_32x32x16_bf16(pa2,PK(2),o[d0],0,0,0);
    o[d0]=__builtin_amdgcn_mfma_f32_32x32x16_bf16(pa3,PK(3),o[d0],0,0,0);
    #undef PK
  }
}

#ifndef ATTN_STORE16
#define ATTN_STORE16(p,v) (*(u32x4*)(p)=(v))
#endif
template<int THRL> __device__ __forceinline__ void attn_unit(int b,int qcol,int kcol,int vcol,int ocol,int qb,const bf16*Q,const bf16*__restrict__ K,const bf16*__restrict__ V,bf16*O,char*shm){
  int tid_=threadIdx.x; asm volatile("":"+v"(tid_));
  const int tid=tid_,lane=tid&63,r32=lane&31,hi=lane>>5; const int wid=__builtin_amdgcn_readfirstlane(tid>>6);
  const long rowbase=(long)b*SEQ; const int q0=qb*QB;
  const bf16*Qw=Q+(rowbase+q0+wid*QBLK)*DM+qcol;
  const bf16*Kh=K+rowbase*DM+kcol,*Vh=V+rowbase*DM+vcol;
  const unsigned lds0=(unsigned)(uintptr_t)shm;
  float*wsf=(float*)(shm+LDS_WS)+wid*64;
  const bf16*ksrc=Kh+(long)lane*DM+wid*8;
  const bf16*vsrc=Vh+(long)(16*(wid&3)+(lane>>2))*DM+(wid>>2)*32+(lane&3)*8;
  const unsigned kdst=lds0+LDS_K+wid*1024, vdst=lds0+LDS_V+wid*1024;
  #define DMA_K(t,slot) glds16(ksrc+(long)(t)*KVBLK*DM,(unsigned)__builtin_amdgcn_readfirstlane(kdst+(slot)))
  #define DMA_V(t,slot) glds16(vsrc+(long)(t)*KVBLK*DM,(unsigned)__builtin_amdgcn_readfirstlane(vdst+(slot)))
  const int vb0=(int)(lds0+LDS_V)+((lane>>4)&1)*32+(lane&3)*8+(4*hi+((lane&15)>>2))*64;
  const char*Kbase=shm+LDS_K; bf16x8 kf[8];
  const lds_cptr shm3=(lds_cptr)shm; const lds_cptr kp0=shm3+LDS_K+hi*1024+r32*16; const lds_cptr vp0=shm3+LDS_V+((lane>>4)&1)*32+(lane&3)*8+(4*hi+((lane&15)>>2))*64;
  const int NT=(q0+QB)/KVBLK;
  DMA_K(0,0);DMA_V(0,0);DMA_K(1,SLOTB);
  bf16x8 qr[4];
  #pragma unroll
  for(int d0=0;d0<4;++d0)qr[d0]=*reinterpret_cast<const bf16x8*>(&Qw[(long)r32*DM+d0*16+hi*8]);
  float mhat=0.f,l_reg=0.f;f32x16 o[2];o[0]=f32x16{};o[1]=f32x16{};f32x16 negm=f32x16{};asm volatile("":"+v"(negm));
  const int qrel=wid*QBLK+r32;
  #define CMASK(P0,P1,t) do{int jb_=(t)-(NT-4); if(jb_>=0)cmask(P0,P1,jb_,qrel,hi);}while(0)
  bool resc=false;
  #define START(P0,P1) do{ const float rm=rowmax(P0,P1); resc=false; \
    { const float dl=rm; mhat=fadd_s(mhat,dl); \
      _Pragma("unroll") for(int r=0;r<16;++r){P0[r]=fsub_s(P0[r],dl);P1[r]=fsub_s(P1[r],dl);} \
      _Pragma("unroll") for(int r=0;r<16;++r)negm[r]=-mhat; asm volatile("":"+v"(negm)); } \
    _Pragma("unroll") for(int r=0;r<16;++r)P0[r]=__builtin_amdgcn_exp2f(P0[r]); }while(0)
  #define RESC() do{ if(resc){ asm volatile("s_waitcnt lgkmcnt(0)":::"memory"); \
      _Pragma("unroll") for(int d_=0;d_<2;++d_) _Pragma("unroll") for(int r=0;r<16;++r)o[d_][r]*=wsf[crow(r,hi)]; } }while(0)
  f32x16 pA0,pA1,pB0,pB1;
  int sl_prev=0,sl_cur=0,sl_next=SLOTB;
  #define ROT() do{sl_prev=sl_cur;sl_cur=sl_next;sl_next=(sl_next==(NSLOT-1)*SLOTB)?0:sl_next+SLOTB;}while(0)
  DMA_K(2,2*SLOTB);
  WAIT_BAR(3);
  qkt(pA0,pA1,Kbase,qr,negm,r32,hi);asm volatile("s_nop 15\n\ts_nop 7":"+v"(pA0),"+v"(pA1));CMASK(pA0,pA1,0);
  START(pA0,pA1);
  _Pragma("unroll") for(int r=0;r<16;++r)pA1[r]=__builtin_amdgcn_exp2f(pA1[r]);
  WAIT_BAR(0);
  DMA_K(3,0);DMA_V(1,SLOTB);
  ROT();
  kload8(kf,kp0+sl_cur);
  WAIT_BAR(2);
  s16x4 vlo[8],vhi[8]; u32x4 pw0,pw1,pw2,pw3;
  #define PKW(P,B) cvtpk_s(P[B],P[B+1])
  #define PAF(k) __builtin_bit_cast(bf16x8,pw##k)
  #define VFR(i) (bf16x8){vlo[i][0],vlo[i][1],vlo[i][2],vlo[i][3],vhi[i][0],vhi[i][1],vhi[i][2],vhi[i][3]}
  #define PIN(x) asm volatile("":"+v"(x))
  #define MX3(a,b,c) __builtin_fmaxf(__builtin_fmaxf((a),(b)),(c))
  #define GAPA(MF,A0,A1,A2,A3,W0,W1,PW) do{ MF; sacc+=A0; sacc+=A1; sacc+=A2; sacc+=A3; PIN(sacc); W0; W1; PIN(PW); SBAR(); }while(0)
  #define EX(v) __builtin_amdgcn_exp2f(v)
  #define GAPB(MF,X,B) do{ MF; X[B]=EX(X[B]); X[B+1]=EX(X[B+1]); X[B+2]=EX(X[B+2]); X[B+3]=EX(X[B+3]); PIN(X); SBAR(); }while(0)
  #define VRD(i) do{ vlo[i]=vtr(vp_+(((i)>>2)*4096+((i)&3)*1024)); vhi[i]=vtr(vp_+(((i)>>2)*4096+((i)&3)*1024+512)); }while(0)
  #define KRD(G,j) do{ if(G){ kload2(kf,kp0+sl_next,j); SBAR(); } }while(0)
  #define STEP(C0,C1,P0,P1,t,GK,GV,GL) do{ SBAR(); \
    const lds_cptr vp_=vp0+sl_prev; \
    VRD(0); SBAR(); float sacc=(P0[0]+P0[1]); \
    GAPA(C0=__builtin_amdgcn_mfma_f32_32x32x16_bf16(kf[0],qr[0],negm,0,0,0), P0[2],P0[3],P0[4],P0[5],     pw0[0]=PKW(P0,0), pw0[1]=PKW(P0,2), pw0); \
    VRD(4); SBAR(); GAPA(C1=__builtin_amdgcn_mfma_f32_32x32x16_bf16(kf[1],qr[0],negm,0,0,0), P0[6],P0[7],P0[8],P0[9],     pw0[2]=PKW(P0,4), pw0[3]=PKW(P0,6), pw0); \
    VRD(1); SBAR(); GAPA(C0=__builtin_amdgcn_mfma_f32_32x32x16_bf16(kf[2],qr[1],C0,0,0,0),   P0[10],P0[11],P0[12],P0[13], pw1[0]=PKW(P0,8), pw1[1]=PKW(P0,10), pw1); \
    VRD(5); SBAR(); GAPA(C1=__builtin_amdgcn_mfma_f32_32x32x16_bf16(kf[3],qr[1],C1,0,0,0),   P0[14],P0[15],P1[0],P1[1],   pw1[2]=PKW(P0,12),pw1[3]=PKW(P0,14), pw1); \
    VRD(2); SBAR(); GAPA(C0=__builtin_amdgcn_mfma_f32_32x32x16_bf16(kf[4],qr[2],C0,0,0,0),   P1[2],P1[3],P1[4],P1[5],     pw2[0]=PKW(P1,0), pw2[1]=PKW(P1,2), pw2); \
    VRD(6); SBAR(); GAPA(C1=__builtin_amdgcn_mfma_f32_32x32x16_bf16(kf[5],qr[2],C1,0,0,0),   P1[6],P1[7],P1[8],P1[9],     pw2[2]=PKW(P1,4), pw2[3]=PKW(P1,6), pw2); \
    VRD(3); SBAR(); GAPA(C0=__builtin_amdgcn_mfma_f32_32x32x16_bf16(kf[6],qr[3],C0,0,0,0),   P1[10],P1[11],P1[12],P1[13], pw3[0]=PKW(P1,8), pw3[1]=PKW(P1,10), pw3); \
    VRD(7); SBAR(); GAPA(C1=__builtin_amdgcn_mfma_f32_32x32x16_bf16(kf[7],qr[3],C1,0,0,0),   P1[14],P1[15],0.f,0.f,       pw3[2]=PKW(P1,12),pw3[3]=PKW(P1,14), pw3); \
    l_reg+=sacc; \
    if(GK){DMA_K((t)+3,sl_cur);} if(GV){DMA_V((t)+1,sl_next);} \
    CMASK(C0,C1,t); \
    { float a=MX3(C0[0],C0[1],C1[0]),b=MX3(C0[2],C0[3],C1[1]); a=MX3(a,C1[2],C1[3]); \
      _Pragma("unroll") for(int r=4;r<16;r+=4){a=MX3(a,C0[r],C0[r+1]);b=MX3(b,C0[r+2],C0[r+3]);a=MX3(a,C1[r],C1[r+1]);b=MX3(b,C1[r+2],C1[r+3]);} \
      float rm=__builtin_fmaxf(a,b); { auto rr=__builtin_amdgcn_permlane32_swap(__float_as_uint(rm),__float_as_uint(rm),false,false); rm=__builtin_fmaxf(__uint_as_float(rr[0]),__uint_as_float(rr[1])); } \
      resc=false; \
      if(__builtin_expect(__any(rm>(float)THRL),0)){ const float dl=__builtin_fmaxf(rm,0.f); mhat+=dl; \
        _Pragma("unroll") for(int r=0;r<16;++r){C0[r]-=dl;C1[r]-=dl;} \
        _Pragma("unroll") for(int r=0;r<16;++r)negm[r]=-mhat; asm volatile("":"+v"(negm)); \
        const float f=__builtin_amdgcn_exp2f(-dl); l_reg*=f; if(hi==0)wsf[r32]=f; resc=true; } } \
    SBAR(); \
    GAPB(o[0]=__builtin_amdgcn_mfma_f32_32x32x16_bf16(PAF(0),VFR(0),o[0],0,0,0), C0,0); \
    GAPB(o[1]=__builtin_amdgcn_mfma_f32_32x32x16_bf16(PAF(0),VFR(4),o[1],0,0,0), C0,4); \
    KRD(GL,0); GAPB(o[0]=__builtin_amdgcn_mfma_f32_32x32x16_bf16(PAF(1),VFR(1),o[0],0,0,0), C0,8); \
    KRD(GL,1); GAPB(o[1]=__builtin_amdgcn_mfma_f32_32x32x16_bf16(PAF(1),VFR(5),o[1],0,0,0), C0,12); \
    KRD(GL,2); GAPB(o[0]=__builtin_amdgcn_mfma_f32_32x32x16_bf16(PAF(2),VFR(2),o[0],0,0,0), C1,0); \
    KRD(GL,3); GAPB(o[1]=__builtin_amdgcn_mfma_f32_32x32x16_bf16(PAF(2),VFR(6),o[1],0,0,0), C1,4); \
    GAPB(o[0]=__builtin_amdgcn_mfma_f32_32x32x16_bf16(PAF(3),VFR(3),o[0],0,0,0), C1,8); \
    GAPB(o[1]=__builtin_amdgcn_mfma_f32_32x32x16_bf16(PAF(3),VFR(7),o[1],0,0,0), C1,12); \
    }while(0)
  int t=1;
  #undef CMASK
  #define CMASK(P0,P1,t) do{}while(0)
  for(;t+5<NT;t+=2){
    STEP(pB0,pB1,pA0,pA1,t,true,true,true);     WAIT_BAR(2); RESC(); ROT();
    STEP(pA0,pA1,pB0,pB1,t+1,true,true,true);   WAIT_BAR(2); RESC(); ROT();
  }
  #undef CMASK
  #define CMASK(P0,P1,t) do{int jb_=(t)-(NT-4); if(jb_>=0)cmask(P0,P1,jb_,qrel,hi);}while(0)
  #define ENDW(tt) do{ if((tt)+3<NT){WAIT_BAR(2);} else if((tt)+2<NT){WAIT_BAR(1);} else {WAIT_BAR(0);} }while(0)
  for(;t+1<NT;t+=2){
    STEP(pB0,pB1,pA0,pA1,t,(t+3<NT),(t+1<NT),(t+1<NT));       ENDW(t);   RESC(); ROT();
    STEP(pA0,pA1,pB0,pB1,t+1,(t+4<NT),(t+2<NT),(t+2<NT));     ENDW(t+1); RESC(); ROT();
  }
  STEP(pB0,pB1,pA0,pA1,NT-1,false,false,false); RESC();
  { float sacc=pB0[0]+pB0[1]; _Pragma("unroll") for(int r=2;r<16;++r)sacc+=pB0[r]; _Pragma("unroll") for(int r=0;r<16;++r)sacc+=pB1[r]; l_reg+=sacc;
    pw0=(u32x4){PKW(pB0,0),PKW(pB0,2),PKW(pB0,4),PKW(pB0,6)};pw1=(u32x4){PKW(pB0,8),PKW(pB0,10),PKW(pB0,12),PKW(pB0,14)};pw2=(u32x4){PKW(pB1,0),PKW(pB1,2),PKW(pB1,4),PKW(pB1,6)};pw3=(u32x4){PKW(pB1,8),PKW(pB1,10),PKW(pB1,12),PKW(pB1,14)};
    SBAR(); pv(o,vb0+sl_cur,PAF(0),PAF(1),PAF(2),PAF(3)); }
  #undef PKW
  #undef PAF
  #undef VFR
  #undef PIN
  #undef MX3
  #undef GAPA
  #undef GAPB
  #undef EX
  #undef VRD
  #undef KRD
  #undef STEP
  #undef ENDW
  {auto rr=__builtin_amdgcn_permlane32_swap(__float_as_uint(l_reg),__float_as_uint(l_reg),false,false);l_reg=__uint_as_float(rr[0])+__uint_as_float(rr[1]);}
  if(hi==0)wsf[32+r32]=l_reg;asm volatile("s_waitcnt lgkmcnt(0)":::"memory");
  float rli[16];
  #pragma unroll
  for(int r=0;r<16;++r)rli[r]=__builtin_amdgcn_rcpf(wsf[32+crow(r,hi)]);
  bf16*Ow=O+(rowbase+q0+wid*QBLK)*DMO+ocol;
  { bf16*stg=(bf16*)(shm+LDS_OST)+wid*2048;
    #pragma unroll
    for(int r=0;r<16;++r){const int orow=crow(r,hi);
      #pragma unroll
      for(int d0=0;d0<2;++d0)stg[orow*64+d0*32+r32]=__float2bfloat16(o[d0][r]*rli[r]);}
    asm volatile("s_waitcnt lgkmcnt(0)":::"memory");
    #pragma unroll
    for(int i=0;i<4;++i){const int row=i*8+(lane>>3),ch=lane&7; const u32x4 v=*(const u32x4*)(stg+row*64+ch*8); ATTN_STORE16(Ow+(long)row*DMO+ch*8,v);} }
  asm volatile("s_waitcnt lgkmcnt(0)\n\ts_barrier":::"memory");
  #undef DMA_K
  #undef DMA_V
  #undef CMASK
  #undef START
  #undef RESC
  #undef ROT
}
constexpr int ATTN_LDS_BYTES=LDS_BYTES;
template<int THRL=8> __device__ __forceinline__ void attn_phase(char*lds,const bf16*U,bf16*Oc,int vcu){
  const int bhc=vcu>>3,s=vcu&7,b=bhc>>3,h=(bhc>>1)&3,c=bhc&1;
  _Pragma("unroll 1") for(int i=0;i<4;++i){ const int half=i>>1,qb=(i&1)?15-s:s;
    attn_unit<THRL>(b,h*128+c*64,512+h*128+c*64,1024+h*128+half*64,h*128+half*64,qb,U,U,U,Oc+(long)c*16384*DMO,lds); }
}
#undef SBAR
#undef WAIT_BAR
}

namespace attn2 {
using bf16=__hip_bfloat16;
using bf16x8=__attribute__((ext_vector_type(8)))short;
using s16x4=__attribute__((ext_vector_type(4)))short;
using f32x16=__attribute__((ext_vector_type(16)))float;
using u32x4=__attribute__((ext_vector_type(4)))unsigned;
constexpr int SEQ=4096,D=64,DM=1536,DMO=512;
constexpr int NW=8,QBLK=32,QB=QBLK*NW,KVBLK=64,NQB=SEQ/QB;
constexpr int ATTN_UNIT_ROWS=QB;
__device__ __forceinline__ int crow(int r,int hi){return (r&3)+8*(r>>2)+4*hi;}
#define SBAR() __builtin_amdgcn_sched_barrier(0)
__device__ __forceinline__ void cmask(f32x16&p0,f32x16&p1,int jb,int qrel,int hi){
  const float NEG=-INFINITY; int kb=64*jb+4*hi;
  #pragma unroll
  for(int r=0;r<16;++r){int kv=kb+(r&3)+8*(r>>2); if(kv>qrel)p0[r]=NEG; if(kv+32>qrel)p1[r]=NEG;}
}

constexpr int NSLOT=3, SLOTB=8192;
constexpr int LDS_K=0, LDS_V=NSLOT*SLOTB, LDS_WS=3*NSLOT*SLOTB, LDS_OST=LDS_WS+NW*64*4, LDS_BYTES=LDS_OST+NW*4096;
constexpr float C2=0.125f*1.4426950408889634f;
__device__ __forceinline__ void glds16(const void*gsrc,unsigned lds_dst){unsigned keep;
  asm volatile("s_mov_b32 %0, m0\n\ts_mov_b32 m0, %2\n\ts_nop 0\n\tglobal_load_lds_dwordx4 %1, off\n\ts_mov_b32 m0, %0":"=&s"(keep):"v"(gsrc),"s"(lds_dst):"memory");}
__device__ __forceinline__ float max3f(float a,float b,float c){float r;asm("v_max3_f32 %0, %1, %2, %3":"=v"(r):"v"(a),"v"(b),"v"(c));return r;}
__device__ __forceinline__ float max2f(float a,float b){float r;asm("v_max_f32_e32 %0, %1, %2":"=v"(r):"v"(a),"v"(b));return r;}
__device__ __forceinline__ float fadd_s(float a,float b){float r;asm("v_add_f32_e32 %0, %1, %2":"=v"(r):"v"(a),"v"(b));return r;}
__device__ __forceinline__ float fsub_s(float a,float b){float r;asm("v_sub_f32_e32 %0, %1, %2":"=v"(r):"v"(a),"v"(b));return r;}
typedef float f32x2_t __attribute__((ext_vector_type(2))); typedef __bf16 bf16x2_t __attribute__((ext_vector_type(2)));
__device__ __forceinline__ unsigned cvtpk_s(float lo,float hi){f32x2_t v={lo,hi};bf16x2_t b=__builtin_convertvector(v,bf16x2_t);return __builtin_bit_cast(unsigned,b);}
#define WAIT_BAR(N) asm volatile("s_waitcnt vmcnt(" #N ") lgkmcnt(0)\n\ts_barrier":::"memory")

__device__ __forceinline__ void qkt(f32x16&p0,f32x16&p1,const char*Kslot,const bf16x8*qr,int r32,int hi){
  const f32x16 negm=f32x16{};
  const char*kb=Kslot+hi*1024+r32*16;
  #pragma unroll
  for(int d0=0;d0<4;++d0){
    const bf16x8 b0=*reinterpret_cast<const bf16x8*>(kb+d0*2048);
    const bf16x8 b1=*reinterpret_cast<const bf16x8*>(kb+d0*2048+512);
    if(d0==0){p0=__builtin_amdgcn_mfma_f32_32x32x16_bf16(b0,qr[0],negm,0,0,0);p1=__builtin_amdgcn_mfma_f32_32x32x16_bf16(b1,qr[0],negm,0,0,0);}
    else{p0=__builtin_amdgcn_mfma_f32_32x32x16_bf16(b0,qr[d0],p0,0,0,0);p1=__builtin_amdgcn_mfma_f32_32x32x16_bf16(b1,qr[d0],p1,0,0,0);}}
}
typedef __attribute__((address_space(3))) const char* lds_cptr;
typedef short v4i16_t __attribute__((ext_vector_type(4)));
__device__ __forceinline__ void kload8(bf16x8*kf,lds_cptr kp){
  kf[0]=*(const __attribute__((address_space(3))) bf16x8*)(kp);      kf[1]=*(const __attribute__((address_space(3))) bf16x8*)(kp+512);
  kf[2]=*(const __attribute__((address_space(3))) bf16x8*)(kp+2048); kf[3]=*(const __attribute__((address_space(3))) bf16x8*)(kp+2560);
  kf[4]=*(const __attribute__((address_space(3))) bf16x8*)(kp+4096); kf[5]=*(const __attribute__((address_space(3))) bf16x8*)(kp+4608);
  kf[6]=*(const __attribute__((address_space(3))) bf16x8*)(kp+6144); kf[7]=*(const __attribute__((address_space(3))) bf16x8*)(kp+6656);
}
__device__ __forceinline__ void kload2(bf16x8*kf,lds_cptr kp,int j){ kf[2*j]=*(const __attribute__((address_space(3))) bf16x8*)(kp+j*2048); kf[2*j+1]=*(const __attribute__((address_space(3))) bf16x8*)(kp+j*2048+512); }
__device__ __forceinline__ s16x4 vtr(lds_cptr p){ return __builtin_bit_cast(s16x4,__builtin_amdgcn_ds_read_tr16_b64_v4i16((__attribute__((address_space(3))) v4i16_t*)p)); }
__device__ __forceinline__ float rowmax(const f32x16&p0,const f32x16&p1){
  float a=max3f(p0[0],p0[1],p1[0]),b=max3f(p0[2],p0[3],p1[1]);a=max3f(a,p1[2],p1[3]);
  #pragma unroll
  for(int r=4;r<16;r+=4){a=max3f(a,p0[r],p0[r+1]);b=max3f(b,p0[r+2],p0[r+3]);a=max3f(a,p1[r],p1[r+1]);b=max3f(b,p1[r+2],p1[r+3]);}
  const float m=max2f(a,b);
  auto rr=__builtin_amdgcn_permlane32_swap(__float_as_uint(m),__float_as_uint(m),false,false);
  return max2f(__uint_as_float(rr[0]),__uint_as_float(rr[1]));
}
__device__ __forceinline__ void pv(f32x16*o,int vb,bf16x8 pa0,bf16x8 pa1,bf16x8 pa2,bf16x8 pa3){
  #pragma unroll
  for(int d0=0;d0<4;++d0){s16x4 lo[4],hi[4];
    #pragma unroll
    for(int ks=0;ks<4;++ks){
      asm volatile("ds_read_b64_tr_b16 %0,%1 offset:%c2":"=&v"(lo[ks]):"v"(vb),"i"(d0*4096+ks*1024):"memory");
      asm volatile("ds_read_b64_tr_b16 %0,%1 offset:%c2":"=&v"(hi[ks]):"v"(vb),"i"(d0*4096+ks*1024+512):"memory");}
    asm volatile("s_waitcnt lgkmcnt(0)":::"memory");SBAR();
    #define PK(k) (bf16x8){lo[k][0],lo[k][1],lo[k][2],lo[k][3],hi[k][0],hi[k][1],hi[k][2],hi[k][3]}
    o[d0]=__builtin_amdgcn_mfma_f32_32x32x16_bf16(pa0,PK(0),o[d0],0,0,0);
    o[d0]=__builtin_amdgcn_mfma_f32_32x32x16_bf16(pa1,PK(1),o[d0],0,0,0);
    o[d0]=__builtin_amdgcn_mfma_f32_32x32x16_bf16(pa2,PK(2),o[d0],0,0,0);
    o[d0]=__builtin_amdgcn_mfma_f32_32x32x16_bf16(pa3,PK(3),o[d0],0,0,0);
    #undef PK
  }
}

#ifndef ATTN_STORE16
#define ATTN_STORE16(p,v) (*(u32x4*)(p)=(v))
#endif
template<int THRL> __device__ __forceinline__ void attn_unit(int b,int qcol,int kcol,int vcol,int ocol,int qb,const bf16*Q,const bf16*__restrict__ K,const bf16*__restrict__ V,bf16*O,char*shm){
  int tid_=threadIdx.x; asm volatile("":"+v"(tid_));
  const int tid=tid_,lane=tid&63,r32=lane&31,hi=lane>>5; const int wid=__builtin_amdgcn_readfirstlane(tid>>6);
  const long rowbase=(long)b*SEQ; const int q0=qb*QB;
  const bf16*Qw=Q+(rowbase+q0+wid*QBLK)*DM+qcol;
  const bf16*Kh=K+rowbase*DM+kcol,*Vh=V+rowbase*DM+vcol;
  const unsigned lds0=(unsigned)(uintptr_t)shm;
  float*wsf=(float*)(shm+LDS_WS)+wid*64;
  const bf16*ksrc=Kh+(long)lane*DM+wid*8;
  const bf16*vsrc=Vh+(long)(16*(wid&3)+(lane>>2))*DM+(wid>>2)*32+(lane&3)*8;
  const unsigned kdst=lds0+LDS_K+wid*1024, vdst=lds0+LDS_V+wid*1024;
  #define DMA_K(t,slot) glds16(ksrc+(long)(t)*KVBLK*DM,(unsigned)__builtin_amdgcn_readfirstlane(kdst+(slot)))
  #define DMA_V(t,slot) do{ glds16(vsrc+(long)(t)*KVBLK*DM,(unsigned)__builtin_amdgcn_readfirstlane(vdst+2*(slot))); glds16(vsrc+(long)(t)*KVBLK*DM+64,(unsigned)__builtin_amdgcn_readfirstlane(vdst+2*(slot)+8192)); }while(0)
  const int vb0=(int)(lds0+LDS_V)+((lane>>4)&1)*32+(lane&3)*8+(4*hi+((lane&15)>>2))*64;
  const char*Kbase=shm+LDS_K; bf16x8 kf[8];
  const lds_cptr shm3=(lds_cptr)shm; const lds_cptr kp0=shm3+LDS_K+hi*1024+r32*16; const lds_cptr vp0=shm3+LDS_V+((lane>>4)&1)*32+(lane&3)*8+(4*hi+((lane&15)>>2))*64;
  const int NT=(q0+QB)/KVBLK;
  DMA_K(0,0);DMA_V(0,0);DMA_K(1,SLOTB);
  bf16x8 qr[4];
  #pragma unroll
  for(int d0=0;d0<4;++d0)qr[d0]=*reinterpret_cast<const bf16x8*>(&Qw[(long)r32*DM+d0*16+hi*8]);
  float mhat=0.f,l_reg=0.f;f32x16 o[4];o[0]=f32x16{};o[1]=f32x16{};o[2]=f32x16{};o[3]=f32x16{};
  const int qrel=wid*QBLK+r32;
  #define CMASK(P0,P1,t) do{int jb_=(t)-(NT-4); if(jb_>=0)cmask(P0,P1,jb_,qrel,hi);}while(0)
  bool resc=false;
  #define START(P0,P1) do{ const float rm=rowmax(P0,P1); resc=false; mhat=rm; \
    _Pragma("unroll") for(int r=0;r<16;++r)P0[r]=__builtin_amdgcn_exp2f(P0[r]-mhat); }while(0)
  #define RESC() do{ if(resc){ asm volatile("s_waitcnt lgkmcnt(0)":::"memory"); \
      _Pragma("unroll") for(int d_=0;d_<4;++d_) _Pragma("unroll") for(int r=0;r<16;++r)o[d_][r]*=wsf[crow(r,hi)]; } }while(0)
  f32x16 pA0,pA1,pB0,pB1;
  int sl_prev=0,sl_cur=0,sl_next=SLOTB;
  #define ROT() do{sl_prev=sl_cur;sl_cur=sl_next;sl_next=(sl_next==(NSLOT-1)*SLOTB)?0:sl_next+SLOTB;}while(0)
  DMA_K(2,2*SLOTB);
  WAIT_BAR(4);
  qkt(pA0,pA1,Kbase,qr,r32,hi);asm volatile("s_nop 15\n\ts_nop 7":"+v"(pA0),"+v"(pA1));CMASK(pA0,pA1,0);
  START(pA0,pA1);
  _Pragma("unroll") for(int r=0;r<16;++r)pA1[r]=__builtin_amdgcn_exp2f(pA1[r]-mhat);
  WAIT_BAR(0);
  DMA_K(3,0);DMA_V(1,SLOTB);
  ROT();
  kload8(kf,kp0+sl_cur);
  WAIT_BAR(3);
  s16x4 vlo[8],vhi[8]; u32x4 pw0,pw1,pw2,pw3;
  #define PKW(P,B) cvtpk_s(P[B],P[B+1])
  #define PAF(k) __builtin_bit_cast(bf16x8,pw##k)
  #define VFR(i) (bf16x8){vlo[i][0],vlo[i][1],vlo[i][2],vlo[i][3],vhi[i][0],vhi[i][1],vhi[i][2],vhi[i][3]}
  #define PIN(x) asm volatile("":"+v"(x))
  #define MX3(a,b,c) __builtin_fmaxf(__builtin_fmaxf((a),(b)),(c))
  #define GAPA(MF,A0,A1,A2,A3,W0,W1,PW) do{ MF; sacc+=A0; sacc+=A1; sacc+=A2; sacc+=A3; PIN(sacc); W0; W1; PIN(PW); SBAR(); }while(0)
  #define EX(v) __builtin_amdgcn_exp2f(v)
  #define GAPB(MF,X,B) do{ MF; X[B]=EX(X[B]-mhat); X[B+1]=EX(X[B+1]-mhat); PIN(X); SBAR(); }while(0)
  #define VRD(i) do{ vlo[i]=vtr(vp_+(((i)>>2)*4096+((i)&3)*1024)); vhi[i]=vtr(vp_+(((i)>>2)*4096+((i)&3)*1024+512)); }while(0)
  #define VRD2(i) do{ vlo[i]=vtr(vp_+((2+((i)>>2))*4096+((i)&3)*1024)); vhi[i]=vtr(vp_+((2+((i)>>2))*4096+((i)&3)*1024+512)); SBAR(); }while(0)
  #define KRD(G,j) do{ if(G){ kload2(kf,kp0+sl_next,j); SBAR(); } }while(0)
  #define STEP(C0,C1,P0,P1,t,GK,GV,GL) do{ SBAR(); \
    const lds_cptr vp_=vp0+2*sl_prev; const f32x16 zz=f32x16{}; \
    VRD(0); SBAR(); float sacc=(P0[0]+P0[1]); \
    GAPA(C0=__builtin_amdgcn_mfma_f32_32x32x16_bf16(kf[0],qr[0],zz,0,0,0), P0[2],P0[3],P0[4],P0[5],     pw0[0]=PKW(P0,0), pw0[1]=PKW(P0,2), pw0); \
    VRD(4); SBAR(); GAPA(C1=__builtin_amdgcn_mfma_f32_32x32x16_bf16(kf[1],qr[0],zz,0,0,0), P0[6],P0[7],P0[8],P0[9],     pw0[2]=PKW(P0,4), pw0[3]=PKW(P0,6), pw0); \
    VRD(1); SBAR(); GAPA(C0=__builtin_amdgcn_mfma_f32_32x32x16_bf16(kf[2],qr[1],C0,0,0,0),   P0[10],P0[11],P0[12],P0[13], pw1[0]=PKW(P0,8), pw1[1]=PKW(P0,10), pw1); \
    VRD(5); SBAR(); GAPA(C1=__builtin_amdgcn_mfma_f32_32x32x16_bf16(kf[3],qr[1],C1,0,0,0),   P0[14],P0[15],P1[0],P1[1],   pw1[2]=PKW(P0,12),pw1[3]=PKW(P0,14), pw1); \
    VRD(2); SBAR(); GAPA(C0=__builtin_amdgcn_mfma_f32_32x32x16_bf16(kf[4],qr[2],C0,0,0,0),   P1[2],P1[3],P1[4],P1[5],     pw2[0]=PKW(P1,0), pw2[1]=PKW(P1,2), pw2); \
    VRD(6); SBAR(); GAPA(C1=__builtin_amdgcn_mfma_f32_32x32x16_bf16(kf[5],qr[2],C1,0,0,0),   P1[6],P1[7],P1[8],P1[9],     pw2[2]=PKW(P1,4), pw2[3]=PKW(P1,6), pw2); \
    VRD(3); SBAR(); GAPA(C0=__builtin_amdgcn_mfma_f32_32x32x16_bf16(kf[6],qr[3],C0,0,0,0),   P1[10],P1[11],P1[12],P1[13], pw3[0]=PKW(P1,8), pw3[1]=PKW(P1,10), pw3); \
    VRD(7); SBAR(); GAPA(C1=__builtin_amdgcn_mfma_f32_32x32x16_bf16(kf[7],qr[3],C1,0,0,0),   P1[14],P1[15],0.f,0.f,       pw3[2]=PKW(P1,12),pw3[3]=PKW(P1,14), pw3); \
    l_reg+=sacc; \
    if(GK){DMA_K((t)+3,sl_cur);} if(GV){DMA_V((t)+1,sl_next);} \
    CMASK(C0,C1,t); \
    { float a=MX3(C0[0],C0[1],C1[0]),b=MX3(C0[2],C0[3],C1[1]); a=MX3(a,C1[2],C1[3]); \
      _Pragma("unroll") for(int r=4;r<16;r+=4){a=MX3(a,C0[r],C0[r+1]);b=MX3(b,C0[r+2],C0[r+3]);a=MX3(a,C1[r],C1[r+1]);b=MX3(b,C1[r+2],C1[r+3]);} \
      float rm=__builtin_fmaxf(a,b); { auto rr=__builtin_amdgcn_permlane32_swap(__float_as_uint(rm),__float_as_uint(rm),false,false); rm=__builtin_fmaxf(__uint_as_float(rr[0]),__uint_as_float(rr[1])); } \
      resc=false; \
      if(__builtin_expect(__any(rm-mhat>(float)THRL),0)){ const float dl=__builtin_fmaxf(rm-mhat,0.f); mhat+=dl; \
        const float f=__builtin_amdgcn_exp2f(-dl); l_reg*=f; if(hi==0)wsf[r32]=f; resc=true; } } \
    SBAR(); \
    GAPB(o[0]=__builtin_amdgcn_mfma_f32_32x32x16_bf16(PAF(0),VFR(0),o[0],0,0,0), C0,0);  VRD2(0); \
    GAPB(o[1]=__builtin_amdgcn_mfma_f32_32x32x16_bf16(PAF(0),VFR(4),o[1],0,0,0), C0,2);  VRD2(4); \
    GAPB(o[0]=__builtin_amdgcn_mfma_f32_32x32x16_bf16(PAF(1),VFR(1),o[0],0,0,0), C0,4);  VRD2(1); \
    GAPB(o[1]=__builtin_amdgcn_mfma_f32_32x32x16_bf16(PAF(1),VFR(5),o[1],0,0,0), C0,6);  VRD2(5); \
    GAPB(o[0]=__builtin_amdgcn_mfma_f32_32x32x16_bf16(PAF(2),VFR(2),o[0],0,0,0), C0,8);  VRD2(2); \
    GAPB(o[1]=__builtin_amdgcn_mfma_f32_32x32x16_bf16(PAF(2),VFR(6),o[1],0,0,0), C0,10); VRD2(6); \
    GAPB(o[0]=__builtin_amdgcn_mfma_f32_32x32x16_bf16(PAF(3),VFR(3),o[0],0,0,0), C0,12); VRD2(3); \
    GAPB(o[1]=__builtin_amdgcn_mfma_f32_32x32x16_bf16(PAF(3),VFR(7),o[1],0,0,0), C0,14); VRD2(7); \
    GAPB(o[2]=__builtin_amdgcn_mfma_f32_32x32x16_bf16(PAF(0),VFR(0),o[2],0,0,0), C1,0); \
    GAPB(o[3]=__builtin_amdgcn_mfma_f32_32x32x16_bf16(PAF(0),VFR(4),o[3],0,0,0), C1,2); \
    KRD(GL,0); GAPB(o[2]=__builtin_amdgcn_mfma_f32_32x32x16_bf16(PAF(1),VFR(1),o[2],0,0,0), C1,4); \
    KRD(GL,1); GAPB(o[3]=__builtin_amdgcn_mfma_f32_32x32x16_bf16(PAF(1),VFR(5),o[3],0,0,0), C1,6); \
    KRD(GL,2); GAPB(o[2]=__builtin_amdgcn_mfma_f32_32x32x16_bf16(PAF(2),VFR(2),o[2],0,0,0), C1,8); \
    KRD(GL,3); GAPB(o[3]=__builtin_amdgcn_mfma_f32_32x32x16_bf16(PAF(2),VFR(6),o[3],0,0,0), C1,10); \
    GAPB(o[2]=__builtin_amdgcn_mfma_f32_32x32x16_bf16(PAF(3),VFR(3),o[2],0,0,0), C1,12); \
    GAPB(o[3]=__builtin_amdgcn_mfma_f32_32x32x16_bf16(PAF(3),VFR(7),o[3],0,0,0), C1,14); \
    }while(0)
  int t=1;
  #undef CMASK
  #define CMASK(P0,P1,t) do{}while(0)
  for(;t+5<NT;t+=2){
    STEP(pB0,pB1,pA0,pA1,t,true,true,true);     WAIT_BAR(3); RESC(); ROT();
    STEP(pA0,pA1,pB0,pB1,t+1,true,true,true);   WAIT_BAR(3); RESC(); ROT();
  }
  #undef CMASK
  #define CMASK(P0,P1,t) do{int jb_=(t)-(NT-4); if(jb_>=0)cmask(P0,P1,jb_,qrel,hi);}while(0)
  #define ENDW(tt) do{ if((tt)+3<NT){WAIT_BAR(3);} else if((tt)+2<NT){WAIT_BAR(2);} else {WAIT_BAR(0);} }while(0)
  for(;t+1<NT;t+=2){
    STEP(pB0,pB1,pA0,pA1,t,(t+3<NT),(t+1<NT),(t+1<NT));       ENDW(t);   RESC(); ROT();
    STEP(pA0,pA1,pB0,pB1,t+1,(t+4<NT),(t+2<NT),(t+2<NT));     ENDW(t+1); RESC(); ROT();
  }
  STEP(pB0,pB1,pA0,pA1,NT-1,false,false,false); RESC();
  { float sacc=pB0[0]+pB0[1]; _Pragma("unroll") for(int r=2;r<16;++r)sacc+=pB0[r]; _Pragma("unroll") for(int r=0;r<16;++r)sacc+=pB1[r]; l_reg+=sacc;
    pw0=(u32x4){PKW(pB0,0),PKW(pB0,2),PKW(pB0,4),PKW(pB0,6)};pw1=(u32x4){PKW(pB0,8),PKW(pB0,10),PKW(pB0,12),PKW(pB0,14)};pw2=(u32x4){PKW(pB1,0),PKW(pB1,2),PKW(pB1,4),PKW(pB1,6)};pw3=(u32x4){PKW(pB1,8),PKW(pB1,10),PKW(pB1,12),PKW(pB1,14)};
    SBAR(); pv(o,vb0+2*sl_cur,PAF(0),PAF(1),PAF(2),PAF(3)); }
  #undef PKW
  #undef PAF
  #undef VFR
  #undef PIN
  #undef MX3
  #undef GAPA
  #undef GAPB
  #undef EX
  #undef VRD
  #undef VRD2
  #undef KRD
  #undef STEP
  #undef ENDW
  {auto rr=__builtin_amdgcn_permlane32_swap(__float_as_uint(l_reg),__float_as_uint(l_reg),false,false);l_reg=__uint_as_float(rr[0])+__uint_as_float(rr[1]);}
  if(hi==0)wsf[32+r32]=l_reg;asm volatile("s_waitcnt lgkmcnt(0)":::"memory");
  float rli[16];
  #pragma unroll
  for(int r=0;r<16;++r)rli[r]=__builtin_amdgcn_rcpf(wsf[32+crow(r,hi)]);
  bf16*Ow=O+(rowbase+q0+wid*QBLK)*DMO+ocol;
  { bf16*stg=(bf16*)(shm+LDS_OST)+wid*2048;
    #pragma unroll
    for(int ps=0;ps<2;++ps){
      #pragma unroll
      for(int r=0;r<16;++r){const int orow=crow(r,hi);
        #pragma unroll
        for(int d0=0;d0<2;++d0)stg[orow*64+d0*32+r32]=__float2bfloat16(o[2*ps+d0][r]*rli[r]);}
      asm volatile("s_waitcnt lgkmcnt(0)":::"memory");
      #pragma unroll
      for(int i=0;i<4;++i){const int row=i*8+(lane>>3),ch=lane&7; const u32x4 v=*(const u32x4*)(stg+row*64+ch*8); ATTN_STORE16(Ow+(long)row*DMO+ps*64+ch*8,v);}
      asm volatile("s_waitcnt lgkmcnt(0)":::"memory"); } }
  asm volatile("s_waitcnt lgkmcnt(0)\n\ts_barrier":::"memory");
  #undef DMA_K
  #undef DMA_V
  #undef CMASK
  #undef START
  #undef RESC
  #undef ROT
}
constexpr int ATTN_LDS_BYTES=LDS_BYTES;
template<int THRL=8> __device__ __forceinline__ void attn_phase(char*lds,const bf16*U,bf16*Oc,int vcu){
  const int bhc=vcu>>3,s=vcu&7,b=bhc>>3,h=(bhc>>1)&3,c=bhc&1;
  _Pragma("unroll 1") for(int i=0;i<2;++i){ const int qb=i?15-s:s;
    attn_unit<THRL>(b,h*128+c*64,512+h*128+c*64,1024+h*128,h*128,qb,U,U,U,Oc+(long)c*16384*DMO,lds); }
}
#undef SBAR
#undef WAIT_BAR
}


namespace gla {
constexpr int GP = 72;
constexpr int L_BC = 0, L_VT = 16384, L_QI = 34816, L_KI = 44032, L_ATT = 53248, L_OF = 62464, OFP = 132;
__device__ __forceinline__ bf16x8 frag(const LAS unsigned char* base, int row, int k0) { return *(const LAS bf16x8*)(base + (row * GP + k0) * 2); }
struct LdState { f32x4 g0, g1; unsigned vw[8]; unsigned kw[4]; };
__device__ __forceinline__ void ld_common(f32x4& g0, f32x4& g1, unsigned (&vw)[8], const float* LOGA, const bf16_t* Ugla, size_t row0, int h, int tid) {
    const float* gp = LOGA + (row0 + (tid >> 3)) * 256 + h * 64 + (tid & 7) * 8; g0 = *(const f32x4*)gp; g1 = *(const f32x4*)(gp + 4);
    const bf16_t* vp = Ugla + (row0 + (tid >> 7) * 16) * 1536 + 512 + h * 128 + (tid & 127);
#pragma unroll
    for (int j = 0; j < 8; ++j) vw[j] = (unsigned)vp[(size_t)(2 * j) * 1536] | ((unsigned)vp[(size_t)(2 * j + 1) * 1536] << 16);
}
__device__ __forceinline__ void ld_state(LdState& L, const float* LOGA, const bf16_t* Ugla, size_t row0, int h, int tid) {
    ld_common(L.g0, L.g1, L.vw, LOGA, Ugla, row0, h, tid);
    const bf16_t* kp = Ugla + (row0 + (tid >> 6) * 8) * 1536 + 256 + h * 64 + (tid & 63);
#pragma unroll
    for (int j = 0; j < 4; ++j) L.kw[j] = (unsigned)kp[(size_t)(2 * j) * 1536] | ((unsigned)kp[(size_t)(2 * j + 1) * 1536] << 16);
}
__device__ __forceinline__ void stage_common(LAS unsigned char* lds, const f32x4& g0, const f32x4& g1, const unsigned (&vw)[8], int tid) {
    LAS float* Bc = (LAS float*)(lds + L_BC);
    *(LAS f32x4*)(Bc + (tid >> 3) * 64 + (tid & 7) * 8) = g0; *(LAS f32x4*)(Bc + (tid >> 3) * 64 + (tid & 7) * 8 + 4) = g1;
    LAS u32x4* dst = (LAS u32x4*)(lds + L_VT + ((tid & 127) * GP + (tid >> 7) * 16) * 2);
    dst[0] = (u32x4){vw[0], vw[1], vw[2], vw[3]}; dst[1] = (u32x4){vw[4], vw[5], vw[6], vw[7]};
}
__device__ __forceinline__ void cumsum_inplace(LAS unsigned char* lds, int lane, int wave) {
    LAS float* Bc = (LAS float*)(lds + L_BC);
    if (wave == 0) { float acc = 0.f;
#pragma unroll 16
        for (int s = 0; s < 64; ++s) { acc += Bc[s * 64 + lane]; Bc[s * 64 + lane] = acc; } }
}
__device__ __forceinline__ void chunk_state4(LAS unsigned char* lds, int b, int n, const float* LOGA, const bf16_t* Ugla, float* SCt, float* DEC, int tid, int lane, int wave) {
    const size_t row0 = (size_t)b * SEQ + n * 64;
    LAS float* Bc = (LAS float*)(lds + L_BC);
    LdState cur; ld_state(cur, LOGA, Ugla, row0, 0, tid);
#pragma unroll 1
    for (int h = 0; h < 4; ++h) {
        const int q = ((b * 4 + h) << 6) + n;
        stage_common(lds, cur.g0, cur.g1, cur.vw, tid);
        __syncthreads();
        cumsum_inplace(lds, lane, wave);
        __syncthreads();
        { const int k = tid & 63, sg = tid >> 6; const float bl = Bc[63 * 64 + k]; float f[8];
#pragma unroll
            for (int j = 0; j < 4; ++j) { f[2 * j] = lo_bf(cur.kw[j]) * __expf(bl - Bc[(sg * 8 + 2 * j) * 64 + k]); f[2 * j + 1] = hi_bf(cur.kw[j]) * __expf(bl - Bc[(sg * 8 + 2 * j + 1) * 64 + k]); }
            *(LAS u32x4*)(lds + L_QI + (k * GP + sg * 8) * 2) = (u32x4){pk2(f[0], f[1]), pk2(f[2], f[3]), pk2(f[4], f[5]), pk2(f[6], f[7])};
            if (tid < 64) DEC[(size_t)q * 64 + tid] = __expf(bl); }
        LdState nxt = cur; if (h < 3) ld_state(nxt, LOGA, Ugla, row0, h + 1, tid);
        __syncthreads();
        { const int fr = lane & 15, fq = lane >> 4, mt = wave >> 1;
#pragma unroll
            for (int j = 0; j < 4; ++j) { const int nt = (wave & 1) * 4 + j; f32x4 acc = {0.f, 0.f, 0.f, 0.f};
#pragma unroll
                for (int ks = 0; ks < 2; ++ks) acc = __builtin_amdgcn_mfma_f32_16x16x32_bf16(frag(lds + L_QI, 16 * mt + fr, 32 * ks + 8 * fq), frag(lds + L_VT, 16 * nt + fr, 32 * ks + 8 * fq), acc, 0, 0, 0);
                *(f32x4*)(SCt + (size_t)q * 8192 + (16 * nt + fr) * 64 + 16 * mt + 4 * fq) = acc; } }
        __syncthreads();
        cur = nxt;
    }
}
struct LdOut { f32x4 g0, g1; unsigned vw[8]; u32x4 qw, kw, r0, r1; bf16x8 sp[4][2]; };
__device__ __forceinline__ void ld_out(LdOut& L, const float* LOGA, const bf16_t* Ugla, const bf16_t* SPt, size_t row0, int h, int q, int tid, int lane, int wave) {
    ld_common(L.g0, L.g1, L.vw, LOGA, Ugla, row0, h, tid);
    const bf16_t* rp = Ugla + (row0 + (tid >> 3)) * 1536 + h * 64 + (tid & 7) * 8; L.qw = *(const u32x4*)rp; L.kw = *(const u32x4*)(rp + 256);
    const bf16_t* gp = Ugla + (row0 + (tid >> 3)) * 1536 + 1024 + h * 128 + (tid & 7) * 16; L.r0 = *(const u32x4*)gp; L.r1 = *(const u32x4*)(gp + 8);
    const int fr = lane & 15, fq = lane >> 4;
#pragma unroll
    for (int j = 0; j < 4; ++j)
#pragma unroll
        for (int ks = 0; ks < 2; ++ks) L.sp[j][ks] = *(const bf16x8*)(SPt + (size_t)q * 8192 + (16 * ((wave & 1) * 4 + j) + fr) * 64 + 32 * ks + 8 * fq);
}
__device__ __forceinline__ void chunk_out4(LAS unsigned char* lds, int b, int n, const float* LOGA, const bf16_t* Ugla, const bf16_t* SPt, const float* gog, bf16_t* OA, int tid, int lane, int wave) {
    const size_t row0 = (size_t)b * SEQ + n * 64;
    LAS float* Bc = (LAS float*)(lds + L_BC); LAS float* Of = (LAS float*)(lds + L_OF);
    const int fr = lane & 15, fq = lane >> 4;
    LdOut cur; ld_out(cur, LOGA, Ugla, SPt, row0, 0, ((b * 4) << 6) + n, tid, lane, wave);
#pragma unroll 1
    for (int h = 0; h < 4; ++h) {
        stage_common(lds, cur.g0, cur.g1, cur.vw, tid);
        __syncthreads();
        cumsum_inplace(lds, lane, wave);
        __syncthreads();
        { const int s = tid >> 3, k0 = (tid & 7) * 8; float qf[8], kf[8];
            qf[0] = lo_bf(cur.qw.x); qf[1] = hi_bf(cur.qw.x); qf[2] = lo_bf(cur.qw.y); qf[3] = hi_bf(cur.qw.y); qf[4] = lo_bf(cur.qw.z); qf[5] = hi_bf(cur.qw.z); qf[6] = lo_bf(cur.qw.w); qf[7] = hi_bf(cur.qw.w);
            kf[0] = lo_bf(cur.kw.x); kf[1] = hi_bf(cur.kw.x); kf[2] = lo_bf(cur.kw.y); kf[3] = hi_bf(cur.kw.y); kf[4] = lo_bf(cur.kw.z); kf[5] = hi_bf(cur.kw.z); kf[6] = lo_bf(cur.kw.w); kf[7] = hi_bf(cur.kw.w);
#pragma unroll
            for (int e = 0; e < 8; ++e) { const float bv = Bc[s * 64 + k0 + e]; qf[e] *= 0.125f * __expf(bv); kf[e] *= __expf(-bv); }
            *(LAS u32x4*)(lds + L_QI + (s * GP + k0) * 2) = (u32x4){pk2(qf[0], qf[1]), pk2(qf[2], qf[3]), pk2(qf[4], qf[5]), pk2(qf[6], qf[7])};
            *(LAS u32x4*)(lds + L_KI + (s * GP + k0) * 2) = (u32x4){pk2(kf[0], kf[1]), pk2(kf[2], kf[3]), pk2(kf[4], kf[5]), pk2(kf[6], kf[7])}; }
        __syncthreads();
#pragma unroll
        for (int j = 0; j < 2; ++j) { const int t = 2 * wave + j, mt = t >> 2, nt = t & 3; f32x4 acc = {0.f, 0.f, 0.f, 0.f};
#pragma unroll
            for (int ks = 0; ks < 2; ++ks) acc = __builtin_amdgcn_mfma_f32_16x16x32_bf16(frag(lds + L_QI, 16 * mt + fr, 32 * ks + 8 * fq), frag(lds + L_KI, 16 * nt + fr, 32 * ks + 8 * fq), acc, 0, 0, 0);
            LAS bf16_t* ap = (LAS bf16_t*)(lds + L_ATT); const int sc = 16 * nt + fr;
#pragma unroll
            for (int r = 0; r < 4; ++r) { const int c = 16 * mt + 4 * fq + r; ap[c * GP + sc] = (bf16_t)f2bf(sc <= c ? acc[r] : 0.f); } }
        __syncthreads();
        { const int mt = wave >> 1;
#pragma unroll
            for (int j = 0; j < 4; ++j) { const int nt = (wave & 1) * 4 + j; f32x4 acc = {0.f, 0.f, 0.f, 0.f};
#pragma unroll
                for (int ks = 0; ks < 2; ++ks) { acc = __builtin_amdgcn_mfma_f32_16x16x32_bf16(frag(lds + L_ATT, 16 * mt + fr, 32 * ks + 8 * fq), frag(lds + L_VT, 16 * nt + fr, 32 * ks + 8 * fq), acc, 0, 0, 0);
                    acc = __builtin_amdgcn_mfma_f32_16x16x32_bf16(frag(lds + L_QI, 16 * mt + fr, 32 * ks + 8 * fq), cur.sp[j][ks], acc, 0, 0, 0); }
#pragma unroll
                for (int r = 0; r < 4; ++r) Of[(16 * mt + 4 * fq + r) * OFP + 16 * nt + fr] = acc[r]; } }
        const u32x4 r0 = cur.r0, r1 = cur.r1;
        if (h < 3) ld_out(cur, LOGA, Ugla, SPt, row0, h + 1, ((b * 4 + h + 1) << 6) + n, tid, lane, wave);
        __syncthreads();
        { const int c = tid >> 3, v0 = (tid & 7) * 16; float o[16]; float ss = 0.f;
#pragma unroll
            for (int e = 0; e < 16; e += 4) { const f32x4 t4 = *(const LAS f32x4*)(Of + c * OFP + v0 + e); o[e] = t4.x; o[e + 1] = t4.y; o[e + 2] = t4.z; o[e + 3] = t4.w; ss += (t4.x * t4.x + t4.y * t4.y) + (t4.z * t4.z + t4.w * t4.w); }
            ss += __shfl_xor(ss, 1); ss += __shfl_xor(ss, 2); ss += __shfl_xor(ss, 4);
            const float rstd = rsqrtf(ss * (1.f / 128.f) + 1e-6f);
            const unsigned rw[8] = {r0.x, r0.y, r0.z, r0.w, r1.x, r1.y, r1.z, r1.w}; unsigned ow[8];
#pragma unroll
            for (int e = 0; e < 8; ++e) { const float a = o[2 * e] * rstd * gog[v0 + 2 * e] * siluf_(lo_bf(rw[e])), b2 = o[2 * e + 1] * rstd * gog[v0 + 2 * e + 1] * siluf_(hi_bf(rw[e])); ow[e] = pk2(a, b2); }
            bf16_t* op = OA + (row0 + c) * 512 + h * 128 + v0; *(u32x4*)op = (u32x4){ow[0], ow[1], ow[2], ow[3]}; *(u32x4*)(op + 8) = (u32x4){ow[4], ow[5], ow[6], ow[7]}; }
    }
}
}

#define XB_TMO      128
#define XB_XCNT(j)  (256  + 64 * (j))
#define XB_XSUB(j)  (1280 + 64 * (j))
#define XB_XGEN(j)  (2304 + 64 * (j))
#define XB_TOP      3328
#define XB_TOPGEN   3392
#define XCD_BAR_WORDS 3456
#define XB_SPIN_CAP (1u << 18)
__device__ __forceinline__ unsigned xb_ld(unsigned* p)              { return __hip_atomic_load(p, __ATOMIC_RELAXED, __HIP_MEMORY_SCOPE_AGENT); }
__device__ __forceinline__ unsigned xb_add(unsigned* p, unsigned v) { return __hip_atomic_fetch_add(p, v, __ATOMIC_RELAXED, __HIP_MEMORY_SCOPE_AGENT); }
__device__ __forceinline__ unsigned xb_xcc_id() { return (unsigned)__builtin_amdgcn_s_getreg((3 << 11) | 20) & 0xFu; }
#define XB_SPIN(cond, bar) do { unsigned _sp = 0; while (cond) { __builtin_amdgcn_s_sleep(1); \
    if ((++_sp & 255u) == 0u) { if (xb_ld(&(bar)[XB_TMO])) break; if (_sp > XB_SPIN_CAP) { atomicAdd(&(bar)[XB_TMO], 1u); break; } } } } while (0)
struct XcdBarrier { unsigned* bar; unsigned x; volatile LAS unsigned* st; };
__device__ __forceinline__ XcdBarrier xcd_barrier_post(unsigned* bar, volatile LAS unsigned* st) {
    XcdBarrier b; b.bar = bar; b.x = xb_xcc_id(); b.st = st;
    if (threadIdx.x == 0) (void)xb_add(&bar[XB_XCNT(b.x)], 1u);
    return b;
}
__device__ __forceinline__ void xcd_barrier_complete(unsigned* bar, unsigned x, unsigned& nloc, unsigned& nx) {
    const unsigned G = gridDim.x * gridDim.y * gridDim.z;
    unsigned sum, cnt, mine, sp = 0u;
    for (;;) {
        sum = 0u; cnt = 0u; mine = 0u;
#pragma unroll
        for (unsigned j = 0; j < 16; ++j) { const unsigned c = xb_ld(&bar[XB_XCNT(j)]); sum += c; cnt += (c > 0u) ? 1u : 0u; mine = (j == x) ? c : mine; }
        if (sum == G) break;
        __builtin_amdgcn_s_sleep(1);
        if ((++sp & 255u) == 0u) { if (xb_ld(&bar[XB_TMO])) break; if (sp > XB_SPIN_CAP) { atomicAdd(&bar[XB_TMO], 1u); break; } }
    }
    nloc = mine > 0u ? mine : 1u; nx = cnt > 0u ? cnt : 1u;
}
__device__ __forceinline__ void xcd_barrier(const XcdBarrier& b) {
    asm volatile("s_waitcnt vmcnt(0)" ::: "memory");
    __syncthreads();
    if (threadIdx.x == 0) {
        unsigned* bar = b.bar;
        __builtin_amdgcn_s_waitcnt(0);
        unsigned nloc = b.st[0], nx = b.st[1];
        if (nloc == 0u) { xcd_barrier_complete(bar, b.x, nloc, nx); b.st[0] = nloc; b.st[1] = nx; }
        const unsigned old = xb_add(&bar[XB_XSUB(b.x)], 1u);
        const unsigned gen = old / nloc;
        if (old + 1u == (gen + 1u) * nloc) {
            __builtin_amdgcn_fence(__ATOMIC_RELEASE, "agent");
            asm volatile("s_waitcnt vmcnt(0)" ::: "memory");
            const unsigned og = xb_add(&bar[XB_TOP], 1u);
            const unsigned tg = og / nx;
            if (og + 1u == (tg + 1u) * nx) xb_add(&bar[XB_TOPGEN], 1u);
            else XB_SPIN(xb_ld(&bar[XB_TOPGEN]) == tg, bar);
            __builtin_amdgcn_fence(__ATOMIC_ACQUIRE, "agent");
            xb_add(&bar[XB_XGEN(b.x)], 1u);
            asm volatile("s_waitcnt vmcnt(0)" ::: "memory");
        } else {
            XB_SPIN(xb_ld(&bar[XB_XGEN(b.x)]) == gen, bar);
            __builtin_amdgcn_fence(__ATOMIC_ACQUIRE, "agent");
            asm volatile("s_waitcnt vmcnt(0)" ::: "memory");
        }
    }
    __syncthreads();
}

struct Args { const void* in[28]; float* out; unsigned char* ws; int ph_lo, ph_hi; };
enum { I_X = 0, I_C, I_POS, I_ADAW, I_ADAB, I_N1G, I_N2G, I_WIN, I_AUP, I_AB, I_GOG, I_DQG, I_DKG, I_LQ1, I_LK1, I_LQ2, I_LK2, I_DOG, I_WBA, I_WBB, I_WOUT, I_RGW, I_RGB, I_REW, I_REB, I_EW1, I_EW3, I_EW2 };

struct TrJob { const float* src; bf16_t* dst; int ldn, kdst; };
__device__ __forceinline__ void tr_load(f32x4 (&v)[8], const TrJob& J, int lane) {
#pragma unroll
    for (int i = 0; i < 8; ++i) v[i] = *(const f32x4*)(J.src + (size_t)(8 * i + (lane >> 3)) * J.ldn + (lane & 7) * 4);
}
__device__ __forceinline__ void tr_store(const f32x4 (&v)[8], const TrJob& J, LAS float* scr, int lane) {
#pragma unroll
    for (int i = 0; i < 8; ++i) { LAS float* p = scr + (8 * i + (lane >> 3)) * 33 + (lane & 7) * 4; p[0] = v[i].x; p[1] = v[i].y; p[2] = v[i].z; p[3] = v[i].w; }
    LDS_WAIT(); asm volatile("" ::: "memory");
    const int c = lane & 7;
#pragma unroll
    for (int j = 0; j < 4; ++j) { const int n = (lane >> 3) + 8 * j; const LAS float* sp = scr + (8 * c) * 33 + n;
        u32x4 o; o.x = pk2(sp[0 * 33], sp[1 * 33]); o.y = pk2(sp[2 * 33], sp[3 * 33]); o.z = pk2(sp[4 * 33], sp[5 * 33]); o.w = pk2(sp[6 * 33], sp[7 * 33]);
        *(u32x4*)(J.dst + (size_t)n * J.kdst + 8 * c) = o; }
    LDS_WAIT(); asm volatile("" ::: "memory");
}
template <class Dec> __device__ __forceinline__ void tr_run(int first, int total, int stride, const Dec& dec, LAS float* scr, int lane) {
    int it = first; if (it >= total) return;
    TrJob J0 = dec(it), J1 = J0; f32x4 a[8], b[8];
    tr_load(a, J0, lane);
    const bool has1 = it + stride < total; if (has1) { J1 = dec(it + stride); tr_load(b, J1, lane); }
    for (;;) {
        const int n2 = it + 2 * stride; const bool more2 = n2 < total; TrJob J2 = J1; f32x4 c[8];
        if (more2) { J2 = dec(n2); tr_load(c, J2, lane); }
        tr_store(a, J0, scr, lane);
        if (it + stride >= total) break;
#pragma unroll
        for (int i = 0; i < 8; ++i) { a[i] = b[i]; b[i] = c[i]; }
        J0 = J1; J1 = J2; it += stride;
    }
}
struct DecDense { const float *w_in, *wa, *wb, *wo; bf16_t *Win_t, *Wa_t, *Wb_t, *Wout_t;
    __device__ __forceinline__ TrJob operator()(int r) const {
        if (r < 2560) { const int kb = r / 160, nb = r % 160, n0 = 32 * nb, ns = n0 < 1536 ? n0 : n0 + 16; return TrJob{w_in + (size_t)(64 * kb) * DIN + ns, Win_t + (size_t)n0 * D + 64 * kb, DIN, D}; }
        r -= 2560;
        if (r < 256) { const int kb = r / 32, nb = r % 32; return TrJob{wa + (size_t)(64 * kb) * D + 32 * nb, Wa_t + (size_t)(32 * nb) * 512 + 64 * kb, D, 512}; }
        r -= 256;
        if (r < 256) { const int kb = r / 32, nb = r % 32; return TrJob{wb + (size_t)(64 * kb) * D + 32 * nb, Wb_t + (size_t)(32 * nb) * 512 + 64 * kb, D, 512}; }
        r -= 256;
        { const int kb = r / 32, nb = r % 32; return TrJob{wo + (size_t)(64 * kb) * D + 32 * nb, Wout_t + (size_t)(32 * nb) * D + 64 * kb, D, D}; }
    } };
struct DecExp13 { const float *w1, *w3; bf16_t *W13_t;
    __device__ __forceinline__ TrJob operator()(int it) const {
        const int e = it >> 9, r = it & 511, kb = r >> 5, nb = r & 31, r0 = 32 * nb, pn = r0 >> 8, half = (r0 >> 7) & 1, jj = r0 & 127;
        const float* p1 = w1; const float* p3 = w3; asm volatile("" : "+s"(p1), "+s"(p3));
        return TrJob{(half ? p3 : p1) + (size_t)e * D * DEXP + (size_t)(64 * kb) * DEXP + 128 * pn + jj, W13_t + (size_t)e * 1024 * 1024 + (size_t)r0 * D + 64 * kb, DEXP, D};
    } };
struct DecExp2 { const float *w2; bf16_t *W2_t;
    __device__ __forceinline__ TrJob operator()(int it) const {
        const int e = it >> 8, r2 = it & 255, kb = r2 >> 5, nb = r2 & 31;
        return TrJob{w2 + (size_t)e * DEXP * D + (size_t)(64 * kb) * D + 32 * nb, W2_t + (size_t)e * 1024 * 512 + (size_t)(32 * nb) * DEXP + 64 * kb, D, DEXP};
    } };

constexpr int TBL_OFF = LDSCTL_OFF + 1024;
constexpr int TBL_CNT = 0, TBL_PAD = 32, TBL_TE = 96, TBL_RO = 320;
constexpr int GCNT_W = 8192;
constexpr int ESEG = 32768;
__device__ __forceinline__ int build_moe_tables(LAS int* tb, const unsigned* gcnt, int tid) {
    if (tid < 32) tb[TBL_CNT + tid] = (int)gcnt[tid];
    __syncthreads();
    if (tid == 0) { int off = 0; for (int e = 0; e < 32; ++e) { tb[TBL_PAD + e] = off; off += ((tb[TBL_CNT + e] + 255) >> 8) << 8; } tb[TBL_PAD + 32] = off; }
    __syncthreads();
    if (tid < 32) { for (int t = tb[TBL_PAD + tid] >> 8; t < (tb[TBL_PAD + tid + 1] >> 8); ++t) tb[TBL_TE + t] = tid; }
    __syncthreads();
    return tb[TBL_PAD + 32] >> 8;
}
#define PHASE_LOCALS int tid_l = threadIdx.x; asm volatile("" : "+v"(tid_l)); int cb_l = blockIdx.x; asm volatile("" : "+s"(cb_l)); \
    const int tid = tid_l, lane = tid & 63, wave = __builtin_amdgcn_readfirstlane(tid >> 6), cb = cb_l, G = 256, gw = cb * NWAVES + wave, NGW = G * NWAVES; (void)lane; (void)gw; (void)NGW; (void)G;
template <int IDX> __device__ __forceinline__ const void* ldarg() {
    unsigned long long p;
    asm volatile("s_load_dwordx2 %0, %1, %2\n\ts_waitcnt lgkmcnt(0)" : "=s"(p) : "s"(__builtin_amdgcn_kernarg_segment_ptr()), "n"(IDX * 8) : "memory");
    return (const void*)(GAS const void*)p;
}
#define ARG_IN(i) (ldarg<(i)>())
#define ARG_WS ((unsigned char*)ldarg<29>())
#define XIN ((const float*)ARG_IN(I_X))
#define OUTP ((float*)ldarg<28>())
#define P_MODP ((float*)(ARG_WS + WS_MODP))
#define P_MODF ((float*)(ARG_WS + WS_MODF))
#define P_ALR ((float*)(ARG_WS + WS_ALR))
#define P_WIN ((bf16_t*)(ARG_WS + WS_WIN))
#define P_WA ((bf16_t*)(ARG_WS + WS_WA))
#define P_WB ((bf16_t*)(ARG_WS + WS_WB))
#define P_WOUT ((bf16_t*)(ARG_WS + WS_WOUT))
#define P_XN ((bf16_t*)(ARG_WS + WS_XN))
#define P_LOGA ((float*)(ARG_WS + WS_LOGA))
#define P_SCT ((float*)(ARG_WS + WS_SCT))
#define P_SPT ((bf16_t*)(ARG_WS + WS_SPT))
#define P_OC ((bf16_t*)(ARG_WS + WS_OC))
#define P_DEC ((float*)(ARG_WS + WS_DEC))
#define P_WRT ((float*)(ARG_WS + WS_WRT))
#define P_LRT ((float*)(ARG_WS + WS_LRT))
#define P_OB ((bf16_t*)(ARG_WS + WS_OB))
#define P_OA ((bf16_t*)(ARG_WS + WS_OA))
#define P_XS ((bf16_t*)(ARG_WS + WS_XS))
#define P_Y ((bf16_t*)(ARG_WS + WS_Y))
#define P_UGLA ((bf16_t*)(ARG_WS + WS_UGLA))
#define P_UDIFF ((bf16_t*)(ARG_WS + WS_UDIFF))
#define P_UGATE ((bf16_t*)(ARG_WS + WS_UGATE))
#define P_M1 ((bf16_t*)(ARG_WS + WS_M1))
#define P_MERGED ((bf16_t*)(ARG_WS + WS_MERGED))
#define P_H2 ((bf16_t*)(ARG_WS + WS_H2))
#define P_SLOTTOK ((int*)(ARG_WS + WS_SLOTTOK))
#define P_W13 ((bf16_t*)(ARG_WS + WS_W13))
#define P_W2 ((bf16_t*)(ARG_WS + WS_W2))
#define P_HMID ((bf16_t*)(ARG_WS + WS_HMID))
#define P_TOKE ((int*)(ARG_WS + WS_ROUTE + RT_TOKE))
#define P_TOKW ((float*)(ARG_WS + WS_ROUTE + RT_TOKW))
#define P_RANK ((int*)(ARG_WS + WS_ROUTE + RT_RANK))
#define P_SLOT ((int*)(ARG_WS + WS_ROUTE + RT_SLOT))
#define P_BLKCNT ((int*)(ARG_WS + WS_ROUTE + RT_BLKCNT))
#define P_TILEE ((int*)(ARG_WS + WS_ROUTE + RT_TILEE))
#define P_NT ((int*)(ARG_WS + WS_ROUTE + RT_NT))
template <int LO, int HI>
__global__ void __launch_bounds__(NTHR, 2) mk_fwd(Args args) {
    extern __shared__ __attribute__((aligned(16))) unsigned char lds_raw[];
    LAS unsigned char* lds = (LAS unsigned char*)lds_raw;
    volatile LAS unsigned* MISC = (volatile LAS unsigned*)(lds + MISC_OFF);
    unsigned* ctl = (unsigned*)(ARG_WS + WS_CTL);
    for (int u = threadIdx.x; u < (LDS_BYTES - LDSCTL_OFF) / 4; u += NTHR) ((LAS unsigned*)(lds + LDSCTL_OFF))[u] = 0u;
    __syncthreads();
    constexpr int lo = LO, hi = HI;
    XcdBarrier bar; bar.bar = ctl + CW_BAR; bar.x = 0; bar.st = nullptr;
    if constexpr (hi - lo > 1) bar = xcd_barrier_post(ctl + CW_BAR, MISC + 8);
#define IN(k) (lo <= (k) && (k) < hi)
#define SEAM(k) do { if constexpr (IN(k) && IN((k) + 1)) xcd_barrier(bar); } while (0)

    if constexpr (IN(0)) {
        asm volatile("; PHASE_BEGIN 0" ::: "memory");
        PHASE_LOCALS
        float* modp = P_MODP; bf16_t* Win_t = P_WIN; bf16_t* Wa_t = P_WA; bf16_t* Wb_t = P_WB; bf16_t* Wout_t = P_WOUT;
        const float* cvec = (const float*)ARG_IN(I_C); const float* ada_w = (const float*)ARG_IN(I_ADAW);
        const float* w_in = (const float*)ARG_IN(I_WIN);
        LAS float* scr = (LAS float*)(lds + wave * 16384);
        for (int r = gw; r < 768; r += NGW) {
            const int jc = r % 24, kc = r / 24, j = jc * 256 + lane * 4;
            f32x4 a0 = {0, 0, 0, 0}, a1 = a0, a2 = a0, a3 = a0;
#pragma unroll 8
            for (int kk = 0; kk < 32; ++kk) { const int k = kc * 32 + kk; const f32x4 w = *(const f32x4*)(ada_w + (size_t)k * NMOD + j);
                a0 += siluf_(cvec[k]) * w; a1 += siluf_(cvec[D + k]) * w; a2 += siluf_(cvec[2 * D + k]) * w; a3 += siluf_(cvec[3 * D + k]) * w; }
            *(f32x4*)(modp + (size_t)(kc * 4 + 0) * NMOD + j) = a0; *(f32x4*)(modp + (size_t)(kc * 4 + 1) * NMOD + j) = a1;
            *(f32x4*)(modp + (size_t)(kc * 4 + 2) * NMOD + j) = a2; *(f32x4*)(modp + (size_t)(kc * 4 + 3) * NMOD + j) = a3; }
        { const float* Wrg = (const float*)ARG_IN(I_RGW); const float* Wre = (const float*)ARG_IN(I_REW); float* WrT = P_WRT;
          for (int idx = cb * NTHR + tid; idx < 36 * D; idx += G * NTHR) { const int j = idx >> 10, k = idx & 1023; WrT[idx] = j < 4 ? Wrg[k * 4 + j] : Wre[k * 32 + (j - 4)]; } }
        { float* LrT = P_LRT;
          for (int idx = cb * NTHR + tid; idx < 16 * D; idx += G * NTHR) { const int r = idx >> 10, k = idx & 1023; LrT[idx] = w_in[(size_t)k * DIN + 1536 + r]; } }
        { const DecDense dec{w_in, (const float*)ARG_IN(I_WBA), (const float*)ARG_IN(I_WBB), (const float*)ARG_IN(I_WOUT), Win_t, Wa_t, Wb_t, Wout_t};
          tr_run(gw, 2560 + 256 + 256 + 512, NGW, dec, scr, lane); }
    }
    SEAM(0);

    if constexpr (IN(1)) {
        asm volatile("; PHASE_BEGIN 1" ::: "memory");
        PHASE_LOCALS
        const float* x = XIN; float* modp = P_MODP; float* modf = P_MODF; float* alr = P_ALR; bf16_t* XN = P_XN;
        const float* ada_b = (const float*)ARG_IN(I_ADAB); const float* g1 = (const float*)ARG_IN(I_N1G);
        LAS float* modS = (LAS float*)lds;
        const float* LrT = P_LRT;
        const int b = cb >> 6;
        { const int j = tid * 4; f32x4 pv[32];
#pragma unroll
            for (int kc = 0; kc < 32; ++kc) pv[kc] = *(const f32x4*)(modp + (size_t)(kc * 4 + b) * NMOD + j);
            float pm[32]; const int idx = cb * 96 + (tid < 96 ? tid : 0), bb = idx / NMOD, jm = idx % NMOD;
#pragma unroll
            for (int kc = 0; kc < 32; ++kc) pm[kc] = modp[(size_t)(kc * 4 + bb) * NMOD + jm];
            f32x4 s = *(const f32x4*)(ada_b + j);
#pragma unroll
            for (int kc = 0; kc < 32; ++kc) s += pv[kc];
            if (j >= D) s += 1.0f;
            *(LAS f32x4*)(modS + j) = s;
            float sm = ada_b[jm];
#pragma unroll
            for (int kc = 0; kc < 32; ++kc) sm += pm[kc];
            if (tid < 96) modf[idx] = sm; }
        f32x4 hv[8][4];
        const size_t m0 = (size_t)cb * 64 + wave * 8;
#pragma unroll
        for (int i = 0; i < 8; ++i) { const f32x4* xr = (const f32x4*)(x + (m0 + i) * D) + lane;
#pragma unroll
            for (int j = 0; j < 4; ++j) hv[i][j] = xr[64 * j]; }
        __syncthreads();
#pragma unroll
        for (int i = 0; i < 8; ++i) { float ss = 0.f;
#pragma unroll
            for (int j = 0; j < 4; ++j) ss += (hv[i][j].x * hv[i][j].x + hv[i][j].y * hv[i][j].y) + (hv[i][j].z * hv[i][j].z + hv[i][j].w * hv[i][j].w);
            const float rstd = rsqrtf(wave_sum(ss) * (1.f / D) + 1e-6f);
            unsigned long long* o8 = (unsigned long long*)(XN + (m0 + i) * D) + lane;
#pragma unroll
            for (int j = 0; j < 4; ++j) { const int k = 4 * lane + 256 * j; const f32x4 gg = *(const f32x4*)(g1 + k); const f32x4 sh = *(const LAS f32x4*)(modS + k); const f32x4 sc = *(const LAS f32x4*)(modS + D + k);
                hv[i][j] = hv[i][j] * rstd * gg * sc + sh;
                o8[64 * j] = (unsigned long long)pk2(hv[i][j].x, hv[i][j].y) | ((unsigned long long)pk2(hv[i][j].z, hv[i][j].w) << 32); } }
        { f32x4 wn[4];
#pragma unroll
          for (int jj = 0; jj < 4; ++jj) wn[jj] = *(const f32x4*)(LrT + 4 * lane + 256 * jj);
#pragma unroll 1
          for (int r = 0; r < 16; ++r) {
            f32x4 w[4];
#pragma unroll
            for (int jj = 0; jj < 4; ++jj) w[jj] = wn[jj];
            const int rn = r < 15 ? r + 1 : r;
#pragma unroll
            for (int jj = 0; jj < 4; ++jj) wn[jj] = *(const f32x4*)(LrT + (size_t)rn * D + 4 * lane + 256 * jj);
            float a[8];
#pragma unroll
            for (int i = 0; i < 8; ++i) { f32x2 a2 = {0.f, 0.f};
#pragma unroll
                for (int jj = 0; jj < 4; ++jj) dot4_pk(a2, hv[i][jj], w[jj]);
                a[i] = a2.x + a2.y; }
            float y0, y1; reduce8(a, y0, y1);
            if ((lane & 15) == 0) { alr[(m0 + 2 * (lane >> 4)) * 16 + r] = y0; alr[(m0 + 2 * (lane >> 4) + 1) * 16 + r] = y1; }
          } }
    }
    SEAM(1);

    if constexpr (IN(2)) {
        asm volatile("; PHASE_BEGIN 2" ::: "memory");
        PHASE_LOCALS
        bf16_t* XN = P_XN; bf16_t* Win_t = P_WIN; bf16_t* Ugla = P_UGLA; bf16_t* Udiff = P_UDIFF; bf16_t* Ugate = P_UGATE;
        pg8::DenseOrder S; S.init(XN, Win_t, M, NPROJ, D, G, cb);
        pg8::EpiInProj E{Ugla, Udiff, Ugate};
        pg8::gemm_phase<pg8::EpiInProj, pg8::DenseOrder, true>(lds, D, S, E);
    }
    SEAM(2);

    if constexpr (IN(3)) {
        asm volatile("; PHASE_BEGIN 3" ::: "memory");
        PHASE_LOCALS
        bf16_t* Udiff = P_UDIFF; float* alr = P_ALR; float* LOGA = P_LOGA;
        const int* pos = (const int*)ARG_IN(I_POS); const float* qg = (const float*)ARG_IN(I_DQG); const float* kg = (const float*)ARG_IN(I_DKG);
        const float* aup = (const float*)ARG_IN(I_AUP); const float* ab = (const float*)ARG_IN(I_AB);
        const float invf = powf(500000.0f, -(float)(lane & 7) * 0.125f);
        const size_t m0 = (size_t)cb * 64 + wave * 8;
        u32x4 w0[8], w1[8]; float posv[8], av[8];
#pragma unroll
        for (int i = 0; i < 8; ++i) { const bf16_t* rowp = Udiff + (m0 + i) * 1536 + lane * 16; w0[i] = *(const u32x4*)rowp; w1[i] = *(const u32x4*)(rowp + 8);
            posv[i] = (float)pos[m0 + i]; av[i] = alr[(m0 + i) * 16 + (lane & 15)]; }
        float gain[16];
#pragma unroll
        for (int e = 0; e < 16; ++e) gain[e] = (lane < 32 ? qg : kg)[(lane & 3) * 16 + e];
        float au[16][4], abv[4];
#pragma unroll
        for (int q = 0; q < 4; ++q) { abv[q] = ab[lane + 64 * q];
#pragma unroll
            for (int rr = 0; rr < 16; ++rr) au[rr][q] = aup[rr * 256 + lane + 64 * q]; }
#pragma unroll
        for (int i = 0; i < 8; ++i) {
            float y[16];
            y[0] = lo_bf(w0[i].x); y[1] = hi_bf(w0[i].x); y[2] = lo_bf(w0[i].y); y[3] = hi_bf(w0[i].y); y[4] = lo_bf(w0[i].z); y[5] = hi_bf(w0[i].z); y[6] = lo_bf(w0[i].w); y[7] = hi_bf(w0[i].w);
            y[8] = lo_bf(w1[i].x); y[9] = hi_bf(w1[i].x); y[10] = lo_bf(w1[i].y); y[11] = hi_bf(w1[i].y); y[12] = lo_bf(w1[i].z); y[13] = hi_bf(w1[i].z); y[14] = lo_bf(w1[i].w); y[15] = hi_bf(w1[i].w);
            float ss = 0.f;
#pragma unroll
            for (int e = 0; e < 16; ++e) ss += y[e] * y[e];
            ss += __shfl_xor(ss, 1); ss += __shfl_xor(ss, 2);
            const float rstd = rsqrtf(ss * (1.f / 64.f) + 1e-6f);
#pragma unroll
            for (int e = 0; e < 16; ++e) y[e] = y[e] * rstd * gain[e];
            const float ang = posv[i] * invf; float sv, cv; sincosf(ang, &sv, &cv);
            float r[16];
#pragma unroll
            for (int e = 0; e < 8; ++e) { const float c_ = __shfl(cv, e), s_ = __shfl(sv, e); r[e] = y[e] * c_ - y[e + 8] * s_; r[e + 8] = y[e + 8] * c_ + y[e] * s_; }
            if ((lane & 3) == 0) {
#pragma unroll
                for (int e = 0; e < 16; ++e) y[e] = r[e]; }
            if (lane < 32) {
#pragma unroll
                for (int e = 0; e < 16; ++e) y[e] *= attn_body::C2; }
            u32x4 o0, o1; o0.x = pk2(y[0], y[1]); o0.y = pk2(y[2], y[3]); o0.z = pk2(y[4], y[5]); o0.w = pk2(y[6], y[7]); o1.x = pk2(y[8], y[9]); o1.y = pk2(y[10], y[11]); o1.z = pk2(y[12], y[13]); o1.w = pk2(y[14], y[15]);
            bf16_t* rowp = Udiff + (m0 + i) * 1536 + lane * 16;
            *(u32x4*)rowp = o0; *(u32x4*)(rowp + 8) = o1;
            float xv[4];
#pragma unroll
            for (int q = 0; q < 4; ++q) xv[q] = abv[q];
#pragma unroll
            for (int rr = 0; rr < 16; ++rr) { const float a = __shfl(av[i], rr);
#pragma unroll
                for (int q = 0; q < 4; ++q) xv[q] += a * au[rr][q]; }
#pragma unroll
            for (int q = 0; q < 4; ++q) { const float ls = fminf(xv[q], 0.f) - log1pf(__expf(-fabsf(xv[q]))); LOGA[(m0 + i) * 256 + lane + 64 * q] = ls * (1.f / 16.f); }
        }
        VM_WAIT(); __syncthreads();
        gla::chunk_state4(lds, cb >> 6, cb & 63, LOGA, P_UGLA, P_SCT, P_DEC, tid, lane, wave);
    }
    SEAM(3);

    if constexpr (IN(4)) {
        asm volatile("; PHASE_BEGIN 4" ::: "memory");
        PHASE_LOCALS
        { const float* SCt = P_SCT; const float* DEC = P_DEC; bf16_t* SPt = P_SPT;
          const int idx = cb * NTHR + tid, bh = idx >> 13, e = idx & 8191, k = e & 63; float st = 0.f;
#pragma unroll 16
          for (int n = 0; n < 64; ++n) { const size_t q = (size_t)bh * 64 + n; const float sc = SCt[q * 8192 + e], d = DEC[q * 64 + k]; SPt[q * 8192 + e] = (bf16_t)f2bf(st); st = st * d + sc; } }
        { const int vcu = (cb % 8) * (G / 8) + cb / 8;
          attn2::attn_phase<8>((char*)lds_raw, (const attn2::bf16*)P_UDIFF, (attn2::bf16*)P_OC, vcu); }
    }
    SEAM(4);

    if constexpr (IN(5)) {
        asm volatile("; PHASE_BEGIN 5" ::: "memory");
        PHASE_LOCALS
        { const float* lq1 = (const float*)ARG_IN(I_LQ1); const float* lk1 = (const float*)ARG_IN(I_LK1); const float* lq2 = (const float*)ARG_IN(I_LQ2); const float* lk2 = (const float*)ARG_IN(I_LK2);
          const float* og = (const float*)ARG_IN(I_DOG); const bf16_t* Oc = P_OC; bf16_t* OB = P_OB;
          const float lam = __expf(wave_sum(lq1[lane] * lk1[lane])) - __expf(wave_sum(lq2[lane] * lk2[lane])) + 0.2f;
          const size_t m0 = (size_t)cb * 64 + wave * 8; const int col0 = lane * 8;
          u32x4 av[8], bv[8];
#pragma unroll
          for (int i = 0; i < 8; ++i) { av[i] = *(const u32x4*)(Oc + (m0 + i) * 512 + col0); bv[i] = *(const u32x4*)(Oc + (size_t)M * 512 + (m0 + i) * 512 + col0); }
          float ogv[8];
#pragma unroll
          for (int e = 0; e < 8; ++e) ogv[e] = og[(col0 & 127) + e];
#pragma unroll
          for (int i = 0; i < 8; ++i) {
            const unsigned aw[4] = {av[i].x, av[i].y, av[i].z, av[i].w}, bw[4] = {bv[i].x, bv[i].y, bv[i].z, bv[i].w}; float o[8]; float ss = 0.f;
#pragma unroll
            for (int e = 0; e < 4; ++e) { o[2 * e] = lo_bf(aw[e]) - lam * lo_bf(bw[e]); o[2 * e + 1] = hi_bf(aw[e]) - lam * hi_bf(bw[e]); ss += o[2 * e] * o[2 * e] + o[2 * e + 1] * o[2 * e + 1]; }
            ss += __shfl_xor(ss, 1); ss += __shfl_xor(ss, 2); ss += __shfl_xor(ss, 4); ss += __shfl_xor(ss, 8);
            const float rstd = rsqrtf(ss * (1.f / 128.f) + 1e-6f) * 0.8f; unsigned ow[4];
#pragma unroll
            for (int e = 0; e < 4; ++e) ow[e] = pk2(o[2 * e] * rstd * ogv[2 * e], o[2 * e + 1] * rstd * ogv[2 * e + 1]);
            *(u32x4*)(OB + (m0 + i) * 512 + col0) = (u32x4){ow[0], ow[1], ow[2], ow[3]}; } }
        __syncthreads();
        gla::chunk_out4(lds, cb >> 6, cb & 63, P_LOGA, P_UGLA, P_SPT, (const float*)ARG_IN(I_GOG), P_OA, tid, lane, wave);
    }
    SEAM(5);

    if constexpr (IN(6)) {
        asm volatile("; PHASE_BEGIN 6" ::: "memory");
        PHASE_LOCALS
        bf16_t* OA = P_OA; bf16_t* OB = P_OB; bf16_t* Wa_t = P_WA; bf16_t* Wb_t = P_WB; bf16_t* Ugate = P_UGATE; bf16_t* M1 = P_M1; bf16_t* MERGED = P_MERGED;
        { pg8::DenseOrder S; S.init(OA, Wa_t, M, D, 512, G, cb); pg8::EpiBranch E{Ugate, 0, nullptr, M1};
          pg8::gemm_phase<pg8::EpiBranch, pg8::DenseOrder, true>(lds, 512, S, E); }
        VM_WAIT(); __syncthreads();
        { pg8::DenseOrder S; S.init(OB, Wb_t, M, D, 512, G, cb); pg8::EpiBranch E{Ugate, 1024, M1, MERGED};
          pg8::gemm_phase<pg8::EpiBranch, pg8::DenseOrder, true>(lds, 512, S, E); }
    }
    SEAM(6);

    if constexpr (IN(7)) {
        asm volatile("; PHASE_BEGIN 7" ::: "memory");
        PHASE_LOCALS
        const float* x = XIN; float* out = OUTP; float* modf = P_MODF; bf16_t* MERGED = P_MERGED; bf16_t* Wout_t = P_WOUT;
        pg8::DenseOrder S; S.init(MERGED, Wout_t, M, D, D, G, cb); pg8::EpiWout E{x, modf, out};
        pg8::gemm_phase<pg8::EpiWout, pg8::DenseOrder, true>(lds, D, S, E);
    }
    SEAM(7);

    if constexpr (IN(8)) {
        asm volatile("; PHASE_BEGIN 8" ::: "memory");
        PHASE_LOCALS
        float* out = OUTP; float* modf = P_MODF; bf16_t* H2 = P_H2; bf16_t* W13_t = P_W13; int* tok_e = P_TOKE; float* tok_w = P_TOKW; int* tok_rank = P_RANK; int* slot_tok = P_SLOTTOK;
        const float* g2 = (const float*)ARG_IN(I_N2G); const float* brg = (const float*)ARG_IN(I_RGB); const float* bre = (const float*)ARG_IN(I_REB); const float* WrT = P_WRT;
        LAS float* modS = (LAS float*)lds;
        LAS int* eS = (LAS int*)(lds + 8192);
        LAS float* LG = (LAS float*)(lds + 8192 + 1024);
        LAS float* WS = (LAS float*)(lds + 24576);
        const int b = cb >> 6;
        f32x4 hv[8][4];
        const size_t m0 = (size_t)cb * 64 + wave * 8;
#pragma unroll
        for (int i = 0; i < 8; ++i) { const f32x4* xr = (const f32x4*)(out + (m0 + i) * D) + lane;
#pragma unroll
            for (int j = 0; j < 4; ++j) hv[i][j] = xr[64 * j]; }
        for (int j = tid; j < 2048; j += NTHR) modS[j] = modf[(size_t)b * NMOD + 3 * D + j] + (j >= D ? 1.0f : 0.f);
#pragma unroll
        for (int q = 0; q < 10; ++q) *(LAS f32x4*)(WS + (q * NTHR + tid) * 4) = *(const f32x4*)(WrT + (size_t)(q * NTHR + tid) * 4);
        __syncthreads();
#pragma unroll
        for (int i = 0; i < 8; ++i) { float ss = 0.f;
#pragma unroll
            for (int j = 0; j < 4; ++j) ss += (hv[i][j].x * hv[i][j].x + hv[i][j].y * hv[i][j].y) + (hv[i][j].z * hv[i][j].z + hv[i][j].w * hv[i][j].w);
            const float rstd = rsqrtf(wave_sum(ss) * (1.f / D) + 1e-6f);
            unsigned long long* o8 = (unsigned long long*)(H2 + (m0 + i) * D) + lane;
#pragma unroll
            for (int j = 0; j < 4; ++j) { const int k = 4 * lane + 256 * j; const f32x4 gg = *(const f32x4*)(g2 + k); const f32x4 sh = *(const LAS f32x4*)(modS + k); const f32x4 sc = *(const LAS f32x4*)(modS + D + k);
                hv[i][j] = hv[i][j] * rstd * gg * sc + sh;
                o8[64 * j] = (unsigned long long)pk2(hv[i][j].x, hv[i][j].y) | ((unsigned long long)pk2(hv[i][j].z, hv[i][j].w) << 32); } }
        const float biasv = lane < 4 ? brg[lane] : (lane < 36 ? bre[lane - 4] : 0.f);
        LAS float* lgw = LG + wave * 320;
#define RT_STEP(jl, jq) do { f32x4 W[4]; _Pragma("unroll") for (int jj = 0; jj < 4; ++jj) W[jj] = *(const LAS f32x4*)(WS + (jl) * D + 4 * lane + 256 * jj); \
            float a[8]; _Pragma("unroll") for (int i = 0; i < 8; ++i) { f32x2 a2 = {0.f, 0.f}; \
                _Pragma("unroll") for (int jj = 0; jj < 4; ++jj) dot4_pk(a2, hv[i][jj], W[jj]); a[i] = a2.x + a2.y; } \
            float y0, y1; reduce8(a, y0, y1); const float bj = __shfl(biasv, (jq)); \
            if ((lane & 15) == 0) { lgw[(2 * (lane >> 4)) * 40 + (jq)] = y0 + bj; lgw[(2 * (lane >> 4) + 1) * 40 + (jq)] = y1 + bj; } } while (0)
#pragma unroll 2
        for (int jx = 0; jx < 20; ++jx) RT_STEP(jx, jx);
        __syncthreads();
#pragma unroll
        for (int q = 0; q < 8; ++q) *(LAS f32x4*)(WS + (q * NTHR + tid) * 4) = *(const f32x4*)(WrT + (size_t)20 * D + (size_t)(q * NTHR + tid) * 4);
        __syncthreads();
#pragma unroll 2
        for (int jx = 0; jx < 16; ++jx) RT_STEP(jx, jx + 20);
#undef RT_STEP
        LDS_WAIT();
        if (lane < 8) {
            const LAS float* lr = lgw + lane * 40; const int tl = wave * 8 + lane;
            const float lg0 = lr[0], lg1 = lr[1], lg2 = lr[2], lg3 = lr[3];
            int gi = 0; float gm = lg0; if (lg1 > gm) { gm = lg1; gi = 1; } if (lg2 > gm) { gm = lg2; gi = 2; } if (lg3 > gm) { gm = lg3; gi = 3; }
            const float ptop = 1.0f / (__expf(lg0 - gm) + __expf(lg1 - gm) + __expf(lg2 - gm) + __expf(lg3 - gm));
            float el[8];
#pragma unroll
            for (int j = 0; j < 8; ++j) el[j] = lr[4 + gi * 8 + j];
            int j0 = 0; float e0 = el[0];
#pragma unroll
            for (int j = 1; j < 8; ++j) if (el[j] > e0) { e0 = el[j]; j0 = j; }
            int j1 = -1; float e1 = -3.0e38f;
#pragma unroll
            for (int j = 0; j < 8; ++j) if (j != j0 && el[j] > e1) { e1 = el[j]; j1 = j; }
            const float t = __expf(e1 - e0), w0 = ptop / (1.0f + t), w1 = ptop * t / (1.0f + t);
            eS[2 * tl] = gi * 8 + j0; eS[2 * tl + 1] = gi * 8 + j1; tok_w[(m0 + lane) * 2] = w0; tok_w[(m0 + lane) * 2 + 1] = w1;
        }
        __syncthreads();
        {
            LAS int* baseS = eS + 128; int e = 0, rank = 0;
            if (tid < 128) { e = eS[tid]; for (int a = 0; a < tid; ++a) rank += (eS[a] == e) ? 1 : 0; }
            else if (tid < 160) { const int ee = tid - 128; int cnt = 0; for (int a = 0; a < 128; ++a) cnt += (eS[a] == ee) ? 1 : 0;
                baseS[ee] = cnt ? (int)__hip_atomic_fetch_add((unsigned*)(ARG_WS + WS_CTL) + GCNT_W + ee, (unsigned)cnt, __ATOMIC_RELAXED, __HIP_MEMORY_SCOPE_AGENT) : 0; }
            __syncthreads();
            if (tid < 128) { const int g = baseS[e] + rank; tok_e[(size_t)cb * 128 + tid] = e; tok_rank[(size_t)cb * 128 + tid] = g; slot_tok[(size_t)e * ESEG + g] = cb * 64 + (tid >> 1); }
        }
        __syncthreads();
        { const DecExp13 dec{(const float*)ARG_IN(I_EW1), (const float*)ARG_IN(I_EW3), W13_t};
          tr_run(gw, NEXP * 512, NGW, dec, (LAS float*)(lds + wave * 16384), lane); }
    }
    SEAM(8);

    if constexpr (IN(9)) {
        asm volatile("; PHASE_BEGIN 9" ::: "memory");
        PHASE_LOCALS
        bf16_t* H2 = P_H2; bf16_t* W13_t = P_W13; bf16_t* HMID = P_HMID; const int* slot_tok = P_SLOTTOK;
        LAS int* tb = (LAS int*)(lds + TBL_OFF);
        const int ntm = __builtin_amdgcn_readfirstlane(build_moe_tables(tb, (const unsigned*)(ARG_WS + WS_CTL) + GCNT_W, tid));
        pg8::MoeOrder S; S.init(H2, W13_t, tb + TBL_TE, (const LAS unsigned*)(tb + TBL_RO), ntm, D, (size_t)1024 * 1024 * 2, G, cb); pg8::EpiUp E{HMID};
        { pg8::Unit u;
          for (int i = 0; i < 3; ++i) if (S.next(i, u) && tid < 256) { const int e = u.aux, idx = u.pm * 256 - tb[TBL_PAD + e] + tid;
              const int tok = idx < tb[TBL_CNT + e] ? slot_tok[(size_t)e * ESEG + idx] : 0; tb[TBL_RO + i * 256 + tid] = tok * (D * 2); } }
        __syncthreads();
        pg8::gemm_phase<pg8::EpiUp, pg8::MoeOrder, true, true>(lds, D, S, E);
        { const int nwg = ntm * 4, first_idle = nwg > 512 ? nwg - 512 : 0;
          if (cb >= first_idle) { const DecExp2 dec{(const float*)ARG_IN(I_EW2), P_W2}; const int nidle = G - first_idle;
              tr_run((cb - first_idle) * NWAVES + wave, NEXP * 256, nidle * NWAVES, dec, (LAS float*)(lds + wave * 16384), lane); } }
    }
    SEAM(9);

    if constexpr (IN(10)) {
        asm volatile("; PHASE_BEGIN 10" ::: "memory");
        PHASE_LOCALS
        bf16_t* HMID = P_HMID; bf16_t* W2_t = P_W2; bf16_t* Y = P_Y;
        LAS int* tb = (LAS int*)(lds + TBL_OFF);
        const int ntm = __builtin_amdgcn_readfirstlane(build_moe_tables(tb, (const unsigned*)(ARG_WS + WS_CTL) + GCNT_W, tid));
        pg8::MoeOrder S; S.init(HMID, W2_t, tb + TBL_TE, nullptr, ntm, DEXP, (size_t)1024 * 512 * 2, G, cb); pg8::EpiPlain E{Y, D};
        pg8::gemm_phase<pg8::EpiPlain, pg8::MoeOrder, true>(lds, DEXP, S, E);
    }
    SEAM(10);

    if constexpr (IN(11)) {
        asm volatile("; PHASE_BEGIN 11" ::: "memory");
        PHASE_LOCALS
        float* out = OUTP; float* modf = P_MODF; bf16_t* Y = P_Y; const int* tok_e = P_TOKE; const int* tok_rank = P_RANK; float* tok_w = P_TOKW;
        LAS int* tb = (LAS int*)(lds + TBL_OFF);
        (void)build_moe_tables(tb, (const unsigned*)(ARG_WS + WS_CTL) + GCNT_W, tid);
        const size_t m0 = (size_t)cb * 64 + wave * 8; const float* g2p = modf + (size_t)(cb >> 6) * NMOD + 5 * D;
        int s0[8], s1[8]; float w0[8], w1[8];
#pragma unroll
        for (int i = 0; i < 8; ++i) { const int e0 = __builtin_amdgcn_readfirstlane(tok_e[(m0 + i) * 2]), e1 = __builtin_amdgcn_readfirstlane(tok_e[(m0 + i) * 2 + 1]);
            s0[i] = tb[TBL_PAD + e0] + tok_rank[(m0 + i) * 2]; s1[i] = tb[TBL_PAD + e1] + tok_rank[(m0 + i) * 2 + 1]; w0[i] = tok_w[(m0 + i) * 2]; w1[i] = tok_w[(m0 + i) * 2 + 1]; }
        f32x4 gv[4];
#pragma unroll
        for (int j = 0; j < 4; ++j) gv[j] = *(const f32x4*)(g2p + 4 * lane + 256 * j);
        f32x4 xa[2][4], xb[2][4]; u32x2 ya0[2][4], ya1[2][4], yb0[2][4], yb1[2][4];
#define P11_LOAD(XV, Y0, Y1, bb) do { _Pragma("unroll") for (int i2 = 0; i2 < 2; ++i2) { const int i = (bb) * 2 + i2; \
            _Pragma("unroll") for (int j = 0; j < 4; ++j) { const int k = 4 * lane + 256 * j; XV[i2][j] = *(const f32x4*)(out + (m0 + i) * D + k); \
                Y0[i2][j] = *(const u32x2*)(Y + (size_t)s0[i] * D + k); Y1[i2][j] = *(const u32x2*)(Y + (size_t)s1[i] * D + k); } } } while (0)
#define P11_DO(XV, Y0, Y1, bb) do { _Pragma("unroll") for (int i2 = 0; i2 < 2; ++i2) { const int i = (bb) * 2 + i2; \
            _Pragma("unroll") for (int j = 0; j < 4; ++j) { const int k = 4 * lane + 256 * j; f32x4 o; \
                o.x = XV[i2][j].x + gv[j].x * (w0[i] * lo_bf(Y0[i2][j].x) + w1[i] * lo_bf(Y1[i2][j].x)); o.y = XV[i2][j].y + gv[j].y * (w0[i] * hi_bf(Y0[i2][j].x) + w1[i] * hi_bf(Y1[i2][j].x)); \
                o.z = XV[i2][j].z + gv[j].z * (w0[i] * lo_bf(Y0[i2][j].y) + w1[i] * lo_bf(Y1[i2][j].y)); o.w = XV[i2][j].w + gv[j].w * (w0[i] * hi_bf(Y0[i2][j].y) + w1[i] * hi_bf(Y1[i2][j].y)); \
                *(f32x4*)(out + (m0 + i) * D + k) = o; } } } while (0)
        P11_LOAD(xa, ya0, ya1, 0);
        P11_LOAD(xb, yb0, yb1, 1); P11_DO(xa, ya0, ya1, 0);
        P11_LOAD(xa, ya0, ya1, 2); P11_DO(xb, yb0, yb1, 1);
        P11_LOAD(xb, yb0, yb1, 3); P11_DO(xa, ya0, ya1, 2);
        P11_DO(xb, yb0, yb1, 3);
#undef P11_LOAD
#undef P11_DO
    }
#undef IN
#undef SEAM
}

constexpr int NPHASE = 12;
template <int LO, int HI> static void launch_range(const Args& a, hipStream_t stream) {
    static bool attr = false;
    if (!attr) { (void)hipFuncSetAttribute((const void*)mk_fwd<LO, HI>, hipFuncAttributeMaxDynamicSharedMemorySize, LDS_BYTES); attr = true; }
    hipLaunchKernelGGL((mk_fwd<LO, HI>), dim3(256), dim3(NTHR), LDS_BYTES, stream, a);
}
extern "C" void kernel_launch(void* const* d_in, const int* in_sizes, int n_in, void* d_out, int out_size, void* d_ws, size_t ws_size, hipStream_t stream) {
    static int ok = 0;
    if (ok == 0) {
        if (n_in != 28 || out_size != M * D || ws_size < WS_END) { fprintf(stderr, "kernel_launch: unexpected shapes (n_in %d, out %d, ws %zu < %zu)\n", n_in, out_size, ws_size, (size_t)WS_END); ok = -1; return; }
        ok = 1;
    }
    if (ok < 0) return;
    (void)hipMemsetAsync((char*)d_ws + WS_CTL, 0, CTL_ZERO_BYTES, stream);
    Args a{};
    for (int i = 0; i < 28; ++i) a.in[i] = d_in[i];
    a.out = (float*)d_out; a.ws = (unsigned char*)d_ws; a.ph_lo = 0; a.ph_hi = NPHASE;
#if MK_ONE_LAUNCH
    launch_range<0, NPHASE>(a, stream);
#else
    launch_range<0, 1>(a, stream); launch_range<1, 2>(a, stream); launch_range<2, 3>(a, stream); launch_range<3, 4>(a, stream);
    launch_range<4, 5>(a, stream); launch_range<5, 6>(a, stream); launch_range<6, 7>(a, stream); launch_range<7, 8>(a, stream);
    launch_range<8, 9>(a, stream); launch_range<9, 10>(a, stream); launch_range<10, 11>(a, stream); launch_range<11, 12>(a, stream);
#endif
}
```

```cpp
#include <hip/hip_runtime.h>
#include <hip/hip_bf16.h>
#include <cstdio>
#include <cstdint>

#ifndef MK_ONE_LAUNCH
#define MK_ONE_LAUNCH 1
#endif

#define LAS __attribute__((address_space(3)))
#define GAS __attribute__((address_space(1)))
typedef unsigned short bf16_t;
typedef short bf16x8 __attribute__((ext_vector_type(8)));
typedef float f32x4 __attribute__((ext_vector_type(4)));
typedef float f32x2 __attribute__((ext_vector_type(2)));
typedef unsigned u32x4 __attribute__((ext_vector_type(4)));
typedef unsigned u32x2 __attribute__((ext_vector_type(2)));

constexpr int NB = 4, SEQ = 4096, D = 1024, M = NB * SEQ;
constexpr int DIN = 5136, NPROJ = 5120;
constexpr int NEXP = 32, DEXP = 512;
constexpr int PMAX = 40960;
constexpr int NMOD = 6 * D;

constexpr size_t MiB = 1u << 20;
constexpr size_t WS_CTL = 0, CTL_ZERO_BYTES = 1 * MiB;
constexpr size_t WS_MODP = 1 * MiB;
constexpr size_t WS_MODF = 4 * MiB;
constexpr size_t WS_ALR = 5 * MiB;
constexpr size_t WS_ROUTE = 6 * MiB;
constexpr size_t WS_WIN = 8 * MiB;
constexpr size_t WS_WA = 18 * MiB, WS_WB = 19 * MiB, WS_WOUT = 20 * MiB;
constexpr size_t RA = 22 * MiB;
constexpr size_t RB = 118 * MiB;
constexpr size_t WS_END = 278 * MiB;
constexpr size_t WS_XN = RA;
constexpr size_t WS_LOGA = RA;
constexpr size_t WS_SCT = RA + 16 * MiB;
constexpr size_t WS_SPT = RA + 48 * MiB;
constexpr size_t WS_OC = RA + 64 * MiB;
constexpr size_t WS_DEC = 7 * MiB;
constexpr size_t WS_WRT = 7 * MiB + 512 * 1024;
constexpr size_t WS_LRT = 7 * MiB + 768 * 1024;
constexpr size_t WS_OA = RB + 48 * MiB;
constexpr size_t WS_OB = WS_OA;
constexpr size_t WS_XS = RA;
constexpr size_t WS_Y = RA;
constexpr size_t WS_UGLA = RB;
constexpr size_t WS_UDIFF = RB + 48 * MiB;
constexpr size_t WS_UGATE = RB + 96 * MiB;
constexpr size_t WS_M1 = RA;
constexpr size_t WS_MERGED = RB;
constexpr size_t WS_H2 = RA;
constexpr size_t WS_SLOTTOK = RA + 84 * MiB;
constexpr size_t WS_W13 = RB + 64 * MiB;
constexpr size_t WS_W2 = RB + 128 * MiB;
constexpr size_t WS_HMID = RB;
constexpr size_t RT_TOKE = 0, RT_TOKW = 131072, RT_RANK = 262144, RT_SLOT = 393216, RT_BLKCNT = 524288, RT_TILEE = 557056, RT_NT = 561152;
constexpr int CW_BAR = 4096;

constexpr int RING_BYTES = 131072;
constexpr int LDSCTL_OFF = RING_BYTES, MISC_OFF = LDSCTL_OFF + 320;
constexpr int LDS_BYTES = 147456;
constexpr int NWAVES = 8, NTHR = 512;

__device__ __forceinline__ float bf2f(bf16_t h) { return __uint_as_float((unsigned)h << 16); }
__device__ __forceinline__ unsigned f2bf(float f) { unsigned u = __float_as_uint(f); return (u + 0x7fffu + ((u >> 16) & 1u)) >> 16; }
typedef __bf16 bf16x2_t __attribute__((ext_vector_type(2)));
__device__ __forceinline__ unsigned pk2(float lo, float hi) { f32x2 v = {lo, hi}; bf16x2_t b = __builtin_convertvector(v, bf16x2_t); return __builtin_bit_cast(unsigned, b); }
__device__ __forceinline__ float lo_bf(unsigned w) { return __uint_as_float(w << 16); }
__device__ __forceinline__ float hi_bf(unsigned w) { return __uint_as_float(w & 0xffff0000u); }
#define DPP_ADD(v, ctrl) ((v) + __builtin_bit_cast(float, __builtin_amdgcn_update_dpp(0, __builtin_bit_cast(int, (v)), (ctrl), 0xF, 0xF, true)))
__device__ __forceinline__ float wave_sum(float v) {
    v = DPP_ADD(v, 0xB1); v = DPP_ADD(v, 0x4E); v = DPP_ADD(v, 0x141); v = DPP_ADD(v, 0x140);
    { const unsigned u = __float_as_uint(v); auto r = __builtin_amdgcn_permlane16_swap(u, u, false, false); v = __uint_as_float(r[0]) + __uint_as_float(r[1]); }
    { const unsigned u = __float_as_uint(v); auto r = __builtin_amdgcn_permlane32_swap(u, u, false, false); v = __uint_as_float(r[0]) + __uint_as_float(r[1]); }
    return v;
}
__device__ __forceinline__ void dot4_pk(f32x2& acc, const f32x4& h, const f32x4& w) { acc += (f32x2){h.x, h.y} * (f32x2){w.x, w.y}; acc += (f32x2){h.z, h.w} * (f32x2){w.z, w.w}; }
__device__ __forceinline__ float swapadd32(float x, float y) { auto r = __builtin_amdgcn_permlane32_swap(__float_as_uint(x), __float_as_uint(y), false, false); return __uint_as_float(r[0]) + __uint_as_float(r[1]); }
__device__ __forceinline__ float swapadd16(float x, float y) { auto r = __builtin_amdgcn_permlane16_swap(__float_as_uint(x), __float_as_uint(y), false, false); return __uint_as_float(r[0]) + __uint_as_float(r[1]); }
__device__ __forceinline__ void reduce8(const float (&a)[8], float& y0, float& y1) {
    const float x0 = swapadd32(a[0], a[4]), x1 = swapadd32(a[1], a[5]), x2 = swapadd32(a[2], a[6]), x3 = swapadd32(a[3], a[7]);
    y0 = swapadd16(x0, x2); y1 = swapadd16(x1, x3);
    y0 = DPP_ADD(y0, 0xB1); y0 = DPP_ADD(y0, 0x4E); y0 = DPP_ADD(y0, 0x141); y0 = DPP_ADD(y0, 0x140);
    y1 = DPP_ADD(y1, 0xB1); y1 = DPP_ADD(y1, 0x4E); y1 = DPP_ADD(y1, 0x141); y1 = DPP_ADD(y1, 0x140);
}
__device__ __forceinline__ float wave_max(float v) {
#pragma unroll
    for (int o = 1; o < 64; o <<= 1) v = fmaxf(v, __shfl_xor(v, o));
    return v;
}
__device__ __forceinline__ float sigmoidf_(float x) { return 1.0f / (1.0f + __expf(-x)); }
__device__ __forceinline__ float siluf_(float x) { return x / (1.0f + __expf(-x)); }
#define LDS_WAIT() asm volatile("s_waitcnt lgkmcnt(0)" ::: "memory")
#define VM_WAIT() asm volatile("s_waitcnt vmcnt(0)" ::: "memory")

namespace pg8 {
constexpr int BM = 256, BK = 64, HALF = 128, HTB = HALF * BK * 2, STAGE_BYTES = 8 * HTB, NXCD = 8, WGM = 8;
__host__ __device__ __forceinline__ int lds_byte(int r, int c) { const int st = (r >> 4) * 2 + (c >> 5), rr = r & 15, cc = c & 31, ob = rr * 64 + cc * 2; return st * 1024 + (ob ^ (((ob >> 9) & 1) << 5)); }
__host__ __device__ __forceinline__ void stage_rc(int b, int& R, int& C) { const int st = b / 1024, sb = b % 1024, swz = sb ^ (((sb >> 9) & 1) << 5); R = (st >> 1) * 16 + swz / 64; C = (st & 1) * 32 + (swz % 64) / 2; }
__host__ __device__ __forceinline__ int perm32(int rho) { const int n = rho >> 4, i = rho & 15; return 8 * (i >> 2) + 4 * n + (i & 3); }

struct Unit { int pm, pn, aux, ord; };

__device__ __forceinline__ int xcd_swizzle(int wgid, int nwg) { const int q = nwg / NXCD, r = nwg % NXCD, xcd = wgid % NXCD, off = wgid / NXCD; return (xcd < r ? xcd * (q + 1) : r * (q + 1) + (xcd - r) * q) + off; }

struct DenseOrder {
    const char* A; const char* Bt; size_t tstep; int nM, nN, nwg, G, c;
    __device__ __forceinline__ void init(const void* A_, const void* Bt_, int M_, int N_, int K_, int G_, int c_) { A = (const char*)A_; Bt = (const char*)Bt_; tstep = (size_t)BM * K_ * 2; nM = M_ / BM; nN = N_ / BM; nwg = nM * nN; G = G_; c = c_; }
    __device__ __forceinline__ bool next(int i, Unit& u) const {
        const long L = (long)i * G + c; if (L >= nwg) return false;
        const int wgid = xcd_swizzle((int)L, nwg);
        const int nig = WGM * nN, gid = wgid / nig, fm = gid * WGM, gsz = (nM - fm) < WGM ? (nM - fm) : WGM;
        u.pm = fm + ((wgid % nig) % gsz); u.pn = (wgid % nig) / gsz; u.aux = 0; u.ord = i; return true;
    }
    __device__ __forceinline__ const char* a_ptr(const Unit& u) const { return A + (size_t)u.pm * tstep; }
    __device__ __forceinline__ const char* b_ptr(const Unit& u) const { return Bt + (size_t)u.pn * tstep; }
    __device__ __forceinline__ unsigned row_off(const Unit&, int) const { return 0u; }
};
struct MoeOrder {
    const char* A; const char* W; const LAS int* tile_e; const LAS unsigned* rowoff; size_t tstep, estride; int nwg, G, c;
    __device__ __forceinline__ void init(const void* A_, const void* W_, const LAS int* te, const LAS unsigned* ro, int ntm, int K_, size_t estride_, int G_, int c_) { A = (const char*)A_; W = (const char*)W_; tile_e = te; rowoff = ro; tstep = (size_t)BM * K_ * 2; estride = estride_; nwg = ntm * 4; G = G_; c = c_; }
    __device__ __forceinline__ bool next(int i, Unit& u) const {
        const long L = (long)i * G + c; if (L >= nwg) return false;
        const int wgid = xcd_swizzle((int)L, nwg);
        u.pm = wgid >> 2; u.pn = wgid & 3; u.aux = __builtin_amdgcn_readfirstlane(tile_e[u.pm]); u.ord = i; return true;
    }
    __device__ __forceinline__ const char* a_ptr(const Unit& u) const { return rowoff ? A : A + (size_t)u.pm * tstep; }
    __device__ __forceinline__ const char* b_ptr(const Unit& u) const { return W + (size_t)u.aux * estride + (size_t)u.pn * tstep; }
    __device__ __forceinline__ unsigned row_off(const Unit& u, int r) const { return rowoff[u.ord * 256 + r]; }
};
__device__ __forceinline__ u32x4 pack8(const f32x4& v0, const f32x4& v1) { u32x4 w; w.x = pk2(v0[0], v0[1]); w.y = pk2(v0[2], v0[3]); w.z = pk2(v1[0], v1[1]); w.w = pk2(v1[2], v1[3]); return w; }

struct EpiInProj {
    static constexpr bool PERM = true, AFTER_DRAIN = false;
    bf16_t *Ugla, *Udiff, *Ugate;
    __device__ __forceinline__ void operator()(const f32x4 (&acc)[2][2][4][2], const Unit& u, int wr, int wc, int fr, int fq) const {
        bf16_t* base; int ldc, colt;
        if (u.pn < 6) { base = Ugla; ldc = 1536; colt = u.pn * 256; } else if (u.pn < 12) { base = Udiff; ldc = 1536; colt = (u.pn - 6) * 256; } else { base = Ugate; ldc = 2048; colt = (u.pn - 12) * 256; }
        const int row0 = u.pm * BM + wr * 64 + fr, col0 = colt + wc * 32 + 8 * fq;
#pragma unroll
        for (int ai = 0; ai < 2; ++ai)
#pragma unroll
            for (int m = 0; m < 4; ++m) { bf16_t* rowp = base + (size_t)(row0 + ai * HALF + m * 16) * ldc + col0;
#pragma unroll
                for (int bj = 0; bj < 2; ++bj) *(u32x4*)(rowp + bj * HALF) = pack8(acc[ai][bj][m][0], acc[ai][bj][m][1]); }
    }
};
struct EpiPlain {
    static constexpr bool PERM = true, AFTER_DRAIN = false;
    bf16_t* O; int ldc;
    __device__ __forceinline__ void operator()(const f32x4 (&acc)[2][2][4][2], const Unit& u, int wr, int wc, int fr, int fq) const {
        const int row0 = u.pm * BM + wr * 64 + fr, col0 = u.pn * BM + wc * 32 + 8 * fq;
#pragma unroll
        for (int ai = 0; ai < 2; ++ai)
#pragma unroll
            for (int m = 0; m < 4; ++m) { bf16_t* rowp = O + (size_t)(row0 + ai * HALF + m * 16) * ldc + col0;
#pragma unroll
                for (int bj = 0; bj < 2; ++bj) *(u32x4*)(rowp + bj * HALF) = pack8(acc[ai][bj][m][0], acc[ai][bj][m][1]); }
    }
};
struct EpiBranch {
    static constexpr bool PERM = true, AFTER_DRAIN = false;
    const bf16_t* gate; bf16_t* out;
    __device__ __forceinline__ void mid(f32x4 (&acc)[2][2][4][2], const Unit& u, int wr, int wc, int fr, int fq) const {
        int row0 = u.pm * BM + wr * 64 + fr, col0 = u.pn * BM + wc * 32 + 8 * fq;
        asm volatile("" : "+v"(row0), "+v"(col0));
#pragma unroll
        for (int ai = 0; ai < 2; ++ai)
#pragma unroll
            for (int m = 0; m < 4; ++m) { const size_t r = (size_t)(row0 + ai * HALF + m * 16);
#pragma unroll
                for (int bj = 0; bj < 2; ++bj) { const int c = col0 + bj * HALF;
                    const u32x4 ga = *(const u32x4*)(gate + r * 2048 + c), gb = *(const u32x4*)(gate + r * 2048 + 1024 + c);
                    const unsigned aw[4] = {ga.x, ga.y, ga.z, ga.w}, bw[4] = {gb.x, gb.y, gb.z, gb.w};
#pragma unroll
                    for (int e = 0; e < 4; ++e) { const float r0 = (1.0f + __expf(-lo_bf(bw[e]))) / (1.0f + __expf(-lo_bf(aw[e]))), r1 = (1.0f + __expf(-hi_bf(bw[e]))) / (1.0f + __expf(-hi_bf(aw[e])));
                        acc[ai][bj][m][e >> 1][(e & 1) * 2] *= r0; acc[ai][bj][m][e >> 1][(e & 1) * 2 + 1] *= r1; } }
                asm volatile("" ::: "memory"); }
    }
    __device__ __forceinline__ void operator()(const f32x4 (&acc)[2][2][4][2], const Unit& u, int wr, int wc, int fr, int fq) const {
        const int row0 = u.pm * BM + wr * 64 + fr, col0 = u.pn * BM + wc * 32 + 8 * fq;
#pragma unroll
        for (int ai = 0; ai < 2; ++ai)
#pragma unroll
            for (int m = 0; m < 4; ++m) { const size_t r = (size_t)(row0 + ai * HALF + m * 16);
#pragma unroll
                for (int bj = 0; bj < 2; ++bj) { const int c = col0 + bj * HALF;
                    const u32x4 g = *(const u32x4*)(gate + r * 2048 + 1024 + c);
                    f32x4 v0 = acc[ai][bj][m][0], v1 = acc[ai][bj][m][1];
                    v0[0] *= sigmoidf_(lo_bf(g.x)); v0[1] *= sigmoidf_(hi_bf(g.x)); v0[2] *= sigmoidf_(lo_bf(g.y)); v0[3] *= sigmoidf_(hi_bf(g.y));
                    v1[0] *= sigmoidf_(lo_bf(g.z)); v1[1] *= sigmoidf_(hi_bf(g.z)); v1[2] *= sigmoidf_(lo_bf(g.w)); v1[3] *= sigmoidf_(hi_bf(g.w));
                    *(u32x4*)(out + r * 1024 + c) = pack8(v0, v1); } }
    }
};
struct EpiWout {
    static constexpr bool PERM = true, AFTER_DRAIN = false;
    const float* x; const float* modf; bf16_t* x1b;
    __device__ __forceinline__ void operator()(const f32x4 (&acc)[2][2][4][2], const Unit& u, int wr, int wc, int fr, int fq) const {
        const int row0 = u.pm * BM + wr * 64 + fr, col0 = u.pn * BM + wc * 32 + 8 * fq;
        const float* g1 = modf + (size_t)((u.pm * BM) >> 12) * NMOD + 2 * D;
#pragma unroll
        for (int bj = 0; bj < 2; ++bj) { const int c = col0 + bj * HALF; const f32x4 g0 = *(const f32x4*)(g1 + c), g1v = *(const f32x4*)(g1 + c + 4);
#pragma unroll
            for (int ai = 0; ai < 2; ++ai)
#pragma unroll
                for (int m = 0; m < 4; ++m) { const size_t r = (size_t)(row0 + ai * HALF + m * 16);
                    const f32x4 x0 = *(const f32x4*)(x + r * D + c), x1v = *(const f32x4*)(x + r * D + c + 4);
                    *(u32x4*)(x1b + r * 2048 + 1024 + c) = pack8(x0 + g0 * acc[ai][bj][m][0], x1v + g1v * acc[ai][bj][m][1]); } }
    }
};
struct EpiUp {
    static constexpr bool PERM = true, AFTER_DRAIN = false;
    bf16_t* H;
    __device__ __forceinline__ void operator()(const f32x4 (&acc)[2][2][4][2], const Unit& u, int wr, int wc, int fr, int fq) const {
        const int row0 = u.pm * BM + wr * 64 + fr, col0 = u.pn * HALF + wc * 32 + 8 * fq;
#pragma unroll
        for (int ai = 0; ai < 2; ++ai)
#pragma unroll
            for (int m = 0; m < 4; ++m) { f32x4 v0, v1;
#pragma unroll
                for (int e = 0; e < 4; ++e) { v0[e] = siluf_(acc[ai][0][m][0][e]) * acc[ai][1][m][0][e]; v1[e] = siluf_(acc[ai][0][m][1][e]) * acc[ai][1][m][1][e]; }
                *(u32x4*)(H + (size_t)(row0 + ai * HALF + m * 16) * DEXP + col0) = pack8(v0, v1); }
    }
};

template <class Epi, class Sched, bool ALIGN_EPI = false, bool GATHER = false, int MIDT = 0>
__device__ __forceinline__ void gemm_phase(LAS unsigned char* lds, const int K, const Sched& S, const Epi& E) {
    int tid_ = threadIdx.x; asm volatile("" : "+v"(tid_));
    const int tid = tid_, wid = __builtin_amdgcn_readfirstlane(tid >> 6), lane = tid & 63, wr = wid >> 2, wc = wid & 3, fr = lane & 15, fq = lane >> 4;
    const int nt = K / BK;
    const size_t kstep = (size_t)(BK * 2);
    const size_t hstep = (size_t)HALF * K * 2;
    unsigned vA0[2], vA1[2], nA0[2], nA1[2], voffB[2]; int Rr[2], Cc[2];
#pragma unroll
    for (int i = 0; i < 2; ++i) { int R, C; stage_rc(tid * 16 + i * 8192, R, C); const int Rb = Epi::PERM ? ((R & ~31) + perm32(R & 31)) : R; Rr[i] = R; Cc[i] = C;
        voffB[i] = (unsigned)(Rb * K + C) * 2u; }
#define PG8_SETOFF(u, o0, o1) do { _Pragma("unroll") for (int _i = 0; _i < 2; ++_i) { \
        if constexpr (GATHER) { o0[_i] = S.row_off(u, Rr[_i]) + (unsigned)Cc[_i] * 2u; o1[_i] = S.row_off(u, Rr[_i] + HALF) + (unsigned)Cc[_i] * 2u; } \
        else { o0[_i] = (unsigned)(Rr[_i] * K + Cc[_i]) * 2u; o1[_i] = o0[_i] + (unsigned)hstep; } } } while (0)
    const unsigned ldsw = (unsigned)wid * 1024u;
    const int aoff = lds_byte(wr * 64 + fr, fq * 8), boff = lds_byte(wc * 32 + fr, fq * 8);
#define PG8_SA(b, h) (((b) * 2 + (h)) * HTB)
#define PG8_SB(b, h) ((4 + (b) * 2 + (h)) * HTB)
#define PG8_STAGE(bufoff, gbase, voff) do { _Pragma("unroll") for (int _i = 0; _i < 2; ++_i) \
        __builtin_amdgcn_global_load_lds((const unsigned*)((const char*)(gbase) + (voff)[_i]), (LAS unsigned*)(lds + (bufoff) + ldsw + _i * 8192), 16, 0, 0); } while (0)
#define PG8_LDA(dst, b, h) do { _Pragma("unroll") for (int m = 0; m < 4; ++m) _Pragma("unroll") for (int k = 0; k < 2; ++k) dst[m][k] = *(const LAS bf16x8*)(lds + PG8_SA(b, h) + aoff + m * 2048 + k * 1024); } while (0)
#define PG8_LDB(dst, b, h) do { _Pragma("unroll") for (int n = 0; n < 2; ++n) _Pragma("unroll") for (int k = 0; k < 2; ++k) dst[n][k] = *(const LAS bf16x8*)(lds + PG8_SB(b, h) + boff + n * 2048 + k * 1024); } while (0)
#define PG8_MMA(ai, bj, At, Bt) do { __builtin_amdgcn_s_setprio(1); _Pragma("unroll") for (int m = 0; m < 4; ++m) _Pragma("unroll") for (int n = 0; n < 2; ++n) _Pragma("unroll") for (int k = 0; k < 2; ++k) \
        acc[ai][bj][m][n] = __builtin_amdgcn_mfma_f32_16x16x32_bf16(Bt[n][k], At[m][k], acc[ai][bj][m][n], 0, 0, 0); __builtin_amdgcn_s_setprio(0); } while (0)
#define PG8_WAIT_V(n) asm volatile("s_waitcnt vmcnt(" #n ")" ::: "memory")
#define PG8_WAIT_L(n) asm volatile("s_waitcnt lgkmcnt(" #n ")" ::: "memory")
#define PG8_BAR __builtin_amdgcn_s_barrier()
#define PG8_SCHED __builtin_amdgcn_sched_barrier(0)
    Unit cur, nxt; int ui = 0;
    if (!S.next(0, cur)) return;
    PG8_SETOFF(cur, vA0, vA1);
#pragma unroll
    for (int i = 0; i < 2; ++i) { nA0[i] = vA0[i]; nA1[i] = vA1[i]; }
    f32x4 acc[2][2][4][2];
#pragma unroll
    for (int a = 0; a < 2; ++a)
#pragma unroll
        for (int b = 0; b < 2; ++b)
#pragma unroll
            for (int m = 0; m < 4; ++m)
#pragma unroll
                for (int n = 0; n < 2; ++n) acc[a][b][m][n] = (f32x4){0.f, 0.f, 0.f, 0.f};
    bf16x8 At[4][2], B0[2][2], B1[2][2];
    const char* cA = S.a_ptr(cur); const char* cB = S.b_ptr(cur);
    PG8_STAGE(PG8_SB(0, 0), cB, voffB); PG8_STAGE(PG8_SB(0, 1), cB + hstep, voffB); PG8_STAGE(PG8_SA(0, 0), cA, vA0); PG8_STAGE(PG8_SA(0, 1), cA, vA1);
    if (wr == 1) PG8_BAR;
    PG8_WAIT_V(2); PG8_BAR;
    PG8_STAGE(PG8_SB(1, 0), cB + kstep, voffB); PG8_STAGE(PG8_SA(1, 0), cA + kstep, vA0); PG8_STAGE(PG8_SB(1, 1), cB + hstep + kstep, voffB);
    PG8_WAIT_V(6); PG8_BAR;
    for (;;) {
        const bool has_next = S.next(ui + 1, nxt);
        const char* nA = has_next ? S.a_ptr(nxt) : cA; const char* nB = has_next ? S.b_ptr(nxt) : cB;
        if constexpr (GATHER) { if (has_next) PG8_SETOFF(nxt, nA0, nA1); }
        for (int t = 0; t < nt; t += 2) {
            if constexpr (MIDT > 0) { if (t == MIDT) E.mid(acc, cur, wr, wc, fr, fq); }
            const bool last = (t == nt - 2);
            const char* a1 = cA + (size_t)(t + 1) * kstep;
            const char* a2 = last ? nA : cA + (size_t)(t + 2) * kstep; const char* b2 = last ? nB : cB + (size_t)(t + 2) * kstep;
            const char* a3 = a2 + kstep; const char* b3 = b2 + kstep;
            unsigned w0[2], w1[2];
#pragma unroll
            for (int i = 0; i < 2; ++i) { if constexpr (GATHER) { w0[i] = last ? nA0[i] : vA0[i]; w1[i] = last ? nA1[i] : vA1[i]; } else { w0[i] = vA0[i]; w1[i] = vA1[i]; } }
            PG8_LDB(B0, 0, 0); PG8_LDB(B1, 0, 1); PG8_SCHED; PG8_LDA(At, 0, 0); PG8_STAGE(PG8_SA(1, 1), a1, vA1);
            PG8_WAIT_V(8); PG8_WAIT_L(0); PG8_BAR; PG8_MMA(0, 0, At, B0); PG8_MMA(0, 1, At, B1); PG8_BAR; PG8_SCHED;
            PG8_LDA(At, 0, 1); PG8_STAGE(PG8_SB(0, 0), b2, voffB); PG8_STAGE(PG8_SB(0, 1), b2 + hstep, voffB); PG8_STAGE(PG8_SA(0, 0), a2, w0);
            PG8_WAIT_V(8); PG8_WAIT_L(0); PG8_BAR; PG8_MMA(1, 0, At, B0); PG8_MMA(1, 1, At, B1); PG8_BAR; PG8_SCHED;
            PG8_LDB(B0, 1, 0); PG8_LDB(B1, 1, 1); PG8_SCHED; PG8_LDA(At, 1, 0); PG8_STAGE(PG8_SA(0, 1), a2, w1);
            PG8_WAIT_V(8); PG8_WAIT_L(0); PG8_BAR; PG8_MMA(0, 0, At, B0); PG8_MMA(0, 1, At, B1); PG8_BAR; PG8_SCHED;
            PG8_LDA(At, 1, 1); PG8_STAGE(PG8_SB(1, 0), b3, voffB); PG8_STAGE(PG8_SB(1, 1), b3 + hstep, voffB); PG8_STAGE(PG8_SA(1, 0), a3, w0);
            PG8_WAIT_V(8); PG8_WAIT_L(0); PG8_BAR; PG8_MMA(1, 0, At, B0); PG8_MMA(1, 1, At, B1); PG8_BAR; PG8_SCHED;
        }
        if constexpr (ALIGN_EPI) { if (wr == 0) PG8_BAR; }
        E(acc, cur, wr, wc, fr, fq);
        if (!has_next) break;
#pragma unroll
        for (int a = 0; a < 2; ++a)
#pragma unroll
            for (int b = 0; b < 2; ++b)
#pragma unroll
                for (int m = 0; m < 4; ++m)
#pragma unroll
                    for (int n = 0; n < 2; ++n) acc[a][b][m][n] = (f32x4){0.f, 0.f, 0.f, 0.f};
        cur = nxt; cA = nA; cB = nB; ++ui;
#pragma unroll
        for (int i = 0; i < 2; ++i) { vA0[i] = nA0[i]; vA1[i] = nA1[i]; }
        if constexpr (ALIGN_EPI) { if (wr == 1) PG8_BAR; }
    }
    PG8_WAIT_V(0);
    if constexpr (!ALIGN_EPI) { if (wr == 0) PG8_BAR; }
    PG8_BAR;
#undef PG8_SETOFF
#undef PG8_SA
#undef PG8_SB
#undef PG8_STAGE
#undef PG8_LDA
#undef PG8_LDB
#undef PG8_MMA
#undef PG8_WAIT_V
#undef PG8_WAIT_L
#undef PG8_BAR
#undef PG8_SCHED
}
}

namespace attn_body {
using bf16=__hip_bfloat16;
using bf16x8=__attribute__((ext_vector_type(8)))short;
using s16x4=__attribute__((ext_vector_type(4)))short;
using f32x16=__attribute__((ext_vector_type(16)))float;
using u32x4=__attribute__((ext_vector_type(4)))unsigned;
constexpr int SEQ=4096,D=64,DM=1536,DMO=512;
constexpr int NW=8,QBLK=32,QB=QBLK*NW,KVBLK=64,NQB=SEQ/QB;
constexpr int ATTN_UNIT_ROWS=QB;
__device__ __forceinline__ int crow(int r,int hi){return (r&3)+8*(r>>2)+4*hi;}
#define SBAR() __builtin_amdgcn_sched_barrier(0)
__device__ __forceinline__ void cmask(f32x16&p0,f32x16&p1,int jb,int qrel,int hi){
  const float NEG=-INFINITY; int kb=64*jb+4*hi;
  #pragma unroll
  for(int r=0;r<16;++r){int kv=kb+(r&3)+8*(r>>2); if(kv>qrel)p0[r]=NEG; if(kv+32>qrel)p1[r]=NEG;}
}

constexpr int NSLOT=3, SLOTB=8192;
constexpr int LDS_K=0, LDS_V=NSLOT*SLOTB, LDS_WS=2*NSLOT*SLOTB, LDS_OST=LDS_WS+NW*64*4, LDS_BYTES=LDS_OST+NW*4096;
constexpr float C2=0.125f*1.4426950408889634f;
__device__ __forceinline__ void glds16(const void*gsrc,unsigned lds_dst){unsigned keep;
  asm volatile("s_mov_b32 %0, m0\n\ts_mov_b32 m0, %2\n\ts_nop 0\n\tglobal_load_lds_dwordx4 %1, off\n\ts_mov_b32 m0, %0":"=&s"(keep):"v"(gsrc),"s"(lds_dst):"memory");}
__device__ __forceinline__ float max3f(float a,float b,float c){float r;asm("v_max3_f32 %0, %1, %2, %3":"=v"(r):"v"(a),"v"(b),"v"(c));return r;}
__device__ __forceinline__ float max2f(float a,float b){float r;asm("v_max_f32_e32 %0, %1, %2":"=v"(r):"v"(a),"v"(b));return r;}
__device__ __forceinline__ float fadd_s(float a,float b){float r;asm("v_add_f32_e32 %0, %1, %2":"=v"(r):"v"(a),"v"(b));return r;}
__device__ __forceinline__ float fsub_s(float a,float b){float r;asm("v_sub_f32_e32 %0, %1, %2":"=v"(r):"v"(a),"v"(b));return r;}
typedef float f32x2_t __attribute__((ext_vector_type(2))); typedef __bf16 bf16x2_t __attribute__((ext_vector_type(2)));
__device__ __forceinline__ unsigned cvtpk_s(float lo,float hi){f32x2_t v={lo,hi};bf16x2_t b=__builtin_convertvector(v,bf16x2_t);return __builtin_bit_cast(unsigned,b);}
#define WAIT_BAR(N) asm volatile("s_waitcnt vmcnt(" #N ") lgkmcnt(0)\n\ts_barrier":::"memory")

__device__ __forceinline__ void qkt(f32x16&p0,f32x16&p1,const char*Kslot,const bf16x8*qr,const f32x16&negm,int r32,int hi){
  const char*kb=Kslot+hi*1024+r32*16;
  #pragma unroll
  for(int d0=0;d0<4;++d0){
    const bf16x8 b0=*reinterpret_cast<const bf16x8*>(kb+d0*2048);
    const bf16x8 b1=*reinterpret_cast<const bf16x8*>(kb+d0*2048+512);
    if(d0==0){p0=__builtin_amdgcn_mfma_f32_32x32x16_bf16(b0,qr[0],negm,0,0,0);p1=__builtin_amdgcn_mfma_f32_32x32x16_bf16(b1,qr[0],negm,0,0,0);}
    else{p0=__builtin_amdgcn_mfma_f32_32x32x16_bf16(b0,qr[d0],p0,0,0,0);p1=__builtin_amdgcn_mfma_f32_32x32x16_bf16(b1,qr[d0],p1,0,0,0);}}
}
typedef __attribute__((address_space(3))) const char* lds_cptr;
typedef short v4i16_t __attribute__((ext_vector_type(4)));
__device__ __forceinline__ void kload8(bf16x8*kf,lds_cptr kp){
  kf[0]=*(const __attribute__((address_space(3))) bf16x8*)(kp);      kf[1]=*(const __attribute__((address_space(3))) bf16x8*)(kp+512);
  kf[2]=*(const __attribute__((address_space(3))) bf16x8*)(kp+2048); kf[3]=*(const __attribute__((address_space(3))) bf16x8*)(kp+2560);
  kf[4]=*(const __attribute__((address_space(3))) bf16x8*)(kp+4096); kf[5]=*(const __attribute__((address_space(3))) bf16x8*)(kp+4608);
  kf[6]=*(const __attribute__((address_space(3))) bf16x8*)(kp+6144); kf[7]=*(const __attribute__((address_space(3))) bf16x8*)(kp+6656);
}
__device__ __forceinline__ void kload2(bf16x8*kf,lds_cptr kp,int j){ kf[2*j]=*(const __attribute__((address_space(3))) bf16x8*)(kp+j*2048); kf[2*j+1]=*(const __attribute__((address_space(3))) bf16x8*)(kp+j*2048+512); }
__device__ __forceinline__ s16x4 vtr(lds_cptr p){ return __builtin_bit_cast(s16x4,__builtin_amdgcn_ds_read_tr16_b64_v4i16((__attribute__((address_space(3))) v4i16_t*)p)); }
__device__ __forceinline__ float rowmax(const f32x16&p0,const f32x16&p1){
  float a=max3f(p0[0],p0[1],p1[0]),b=max3f(p0[2],p0[3],p1[1]);a=max3f(a,p1[2],p1[3]);
  #pragma unroll
  for(int r=4;r<16;r+=4){a=max3f(a,p0[r],p0[r+1]);b=max3f(b,p0[r+2],p0[r+3]);a=max3f(a,p1[r],p1[r+1]);b=max3f(b,p1[r+2],p1[r+3]);}
  const float m=max2f(a,b);
  auto rr=__builtin_amdgcn_permlane32_swap(__float_as_uint(m),__float_as_uint(m),false,false);
  return max2f(__uint_as_float(rr[0]),__uint_as_float(rr[1]));
}
__device__ __forceinline__ void pv(f32x16*o,int vb,bf16x8 pa0,bf16x8 pa1,bf16x8 pa2,bf16x8 pa3){
  #pragma unroll
  for(int d0=0;d0<2;++d0){s16x4 lo[4],hi[4];
    #pragma unroll
    for(int ks=0;ks<4;++ks){
      asm volatile("ds_read_b64_tr_b16 %0,%1 offset:%c2":"=&v"(lo[ks]):"v"(vb),"i"(d0*4096+ks*1024):"memory");
      asm volatile("ds_read_b64_tr_b16 %0,%1 offset:%c2":"=&v"(hi[ks]):"v"(vb),"i"(d0*4096+ks*1024+512):"memory");}
    asm volatile("s_waitcnt lgkmcnt(0)":::"memory");SBAR();
    #define PK(k) (bf16x8){lo[k][0],lo[k][1],lo[k][2],lo[k][3],hi[k][0],hi[k][1],hi[k][2],hi[k][3]}
    o[d0]=__builtin_amdgcn_mfma_f32_32x32x16_bf16(pa0,PK(0),o[d0],0,0,0);
    o[d0]=__builtin_amdgcn_mfma_f32_32x32x16_bf16(pa1,PK(1),o[d0],0,0,0);
    o[d0]=__builtin_amdgcn_mfma_f32_32x32x16_bf16(pa2,PK(2),o[d0],0,0,0);
    o[d0]=__builtin_amdgcn_mfma_f32_32x32x16_bf16(pa3,PK(3),o[d0],0,0,0);
    #undef PK
  }
}

#ifndef ATTN_STORE16
#define ATTN_STORE16(p,v) (*(u32x4*)(p)=(v))
#endif
template<int THRL> __device__ __forceinline__ void attn_unit(int b,int qcol,int kcol,int vcol,int ocol,int qb,const bf16*Q,const bf16*__restrict__ K,const bf16*__restrict__ V,bf16*O,char*shm){
  int tid_=threadIdx.x; asm volatile("":"+v"(tid_));
  const int tid=tid_,lane=tid&63,r32=lane&31,hi=lane>>5; const int wid=__builtin_amdgcn_readfirstlane(tid>>6);
  const long rowbase=(long)b*SEQ; const int q0=qb*QB;
  const bf16*Qw=Q+(rowbase+q0+wid*QBLK)*DM+qcol;
  const bf16*Kh=K+rowbase*DM+kcol,*Vh=V+rowbase*DM+vcol;
  const unsigned lds0=(unsigned)(uintptr_t)shm;
  float*wsf=(float*)(shm+LDS_WS)+wid*64;
  const bf16*ksrc=Kh+(long)lane*DM+wid*8;
  const bf16*vsrc=Vh+(long)(16*(wid&3)+(lane>>2))*DM+(wid>>2)*32+(lane&3)*8;
  const unsigned kdst=lds0+LDS_K+wid*1024, vdst=lds0+LDS_V+wid*1024;
  #define DMA_K(t,slot) glds16(ksrc+(long)(t)*KVBLK*DM,(unsigned)__builtin_amdgcn_readfirstlane(kdst+(slot)))
  #define DMA_V(t,slot) glds16(vsrc+(long)(t)*KVBLK*DM,(unsigned)__builtin_amdgcn_readfirstlane(vdst+(slot)))
  const int vb0=(int)(lds0+LDS_V)+((lane>>4)&1)*32+(lane&3)*8+(4*hi+((lane&15)>>2))*64;
  const char*Kbase=shm+LDS_K; bf16x8 kf[8];
  const lds_cptr shm3=(lds_cptr)shm; const lds_cptr kp0=shm3+LDS_K+hi*1024+r32*16; const lds_cptr vp0=shm3+LDS_V+((lane>>4)&1)*32+(lane&3)*8+(4*hi+((lane&15)>>2))*64;
  const int NT=(q0+QB)/KVBLK;
  DMA_K(0,0);DMA_V(0,0);DMA_K(1,SLOTB);
  bf16x8 qr[4];
  #pragma unroll
  for(int d0=0;d0<4;++d0)qr[d0]=*reinterpret_cast<const bf16x8*>(&Qw[(long)r32*DM+d0*16+hi*8]);
  float mhat=0.f,l_reg=0.f;f32x16 o[2];o[0]=f32x16{};o[1]=f32x16{};f32x16 negm=f32x16{};asm volatile("":"+v"(negm));
  const int qrel=wid*QBLK+r32;
  #define CMASK(P0,P1,t) do{int jb_=(t)-(NT-4); if(jb_>=0)cmask(P0,P1,jb_,qrel,hi);}while(0)
  bool resc=false;
  #define START(P0,P1) do{ const float rm=rowmax(P0,P1); resc=false; \
    { const float dl=rm; mhat=fadd_s(mhat,dl); \
      _Pragma("unroll") for(int r=0;r<16;++r){P0[r]=fsub_s(P0[r],dl);P1[r]=fsub_s(P1[r],dl);} \
      _Pragma("unroll") for(int r=0;r<16;++r)negm[r]=-mhat; asm volatile("":"+v"(negm)); } \
    _Pragma("unroll") for(int r=0;r<16;++r)P0[r]=__builtin_amdgcn_exp2f(P0[r]); }while(0)
  #define RESC() do{ if(resc){ asm volatile("s_waitcnt lgkmcnt(0)":::"memory"); \
      _Pragma("unroll") for(int d_=0;d_<2;++d_) _Pragma("unroll") for(int r=0;r<16;++r)o[d_][r]*=wsf[crow(r,hi)]; } }while(0)
  f32x16 pA0,pA1,pB0,pB1;
  int sl_prev=0,sl_cur=0,sl_next=SLOTB;
  #define ROT() do{sl_prev=sl_cur;sl_cur=sl_next;sl_next=(sl_next==(NSLOT-1)*SLOTB)?0:sl_next+SLOTB;}while(0)
  DMA_K(2,2*SLOTB);
  WAIT_BAR(3);
  qkt(pA0,pA1,Kbase,qr,negm,r32,hi);asm volatile("s_nop 15\n\ts_nop 7":"+v"(pA0),"+v"(pA1));CMASK(pA0,pA1,0);
  START(pA0,pA1);
  _Pragma("unroll") for(int r=0;r<16;++r)pA1[r]=__builtin_amdgcn_exp2f(pA1[r]);
  WAIT_BAR(0);
  DMA_K(3,0);DMA_V(1,SLOTB);
  ROT();
  kload8(kf,kp0+sl_cur);
  WAIT_BAR(2);
  s16x4 vlo[8],vhi[8]; u32x4 pw0,pw1,pw2,pw3;
  #define PKW(P,B) cvtpk_s(P[B],P[B+1])
  #define PAF(k) __builtin_bit_cast(bf16x8,pw##k)
  #define VFR(i) (bf16x8){vlo[i][0],vlo[i][1],vlo[i][2],vlo[i][3],vhi[i][0],vhi[i][1],vhi[i][2],vhi[i][3]}
  #define PIN(x) asm volatile("":"+v"(x))
  #define MX3(a,b,c) __builtin_fmaxf(__builtin_fmaxf((a),(b)),(c))
  #define GAPA(MF,A0,A1,A2,A3,W0,W1,PW) do{ MF; sacc+=A0; sacc+=A1; sacc+=A2; sacc+=A3; PIN(sacc); W0; W1; PIN(PW); SBAR(); }while(0)
  #define EX(v) __builtin_amdgcn_exp2f(v)
  #define GAPB(MF,X,B) do{ MF; X[B]=EX(X[B]); X[B+1]=EX(X[B+1]); X[B+2]=EX(X[B+2]); X[B+3]=EX(X[B+3]); PIN(X); SBAR(); }while(0)
  #define VRD(i) do{ vlo[i]=vtr(vp_+(((i)>>2)*4096+((i)&3)*1024)); vhi[i]=vtr(vp_+(((i)>>2)*4096+((i)&3)*1024+512)); }while(0)
  #define KRD(G,j) do{ if(G){ kload2(kf,kp0+sl_next,j); SBAR(); } }while(0)
  #define STEP(C0,C1,P0,P1,t,GK,GV,GL) do{ SBAR(); \
    const lds_cptr vp_=vp0+sl_prev; \
    VRD(0); SBAR(); float sacc=(P0[0]+P0[1]); \
    GAPA(C0=__builtin_amdgcn_mfma_f32_32x32x16_bf16(kf[0],qr[0],negm,0,0,0), P0[2],P0[3],P0[4],P0[5],     pw0[0]=PKW(P0,0), pw0[1]=PKW(P0,2), pw0); \
    VRD(4); SBAR(); GAPA(C1=__builtin_amdgcn_mfma_f32_32x32x16_bf16(kf[1],qr[0],negm,0,0,0), P0[6],P0[7],P0[8],P0[9],     pw0[2]=PKW(P0,4), pw0[3]=PKW(P0,6), pw0); \
    VRD(1); SBAR(); GAPA(C0=__builtin_amdgcn_mfma_f32_32x32x16_bf16(kf[2],qr[1],C0,0,0,0),   P0[10],P0[11],P0[12],P0[13], pw1[0]=PKW(P0,8), pw1[1]=PKW(P0,10), pw1); \
    VRD(5); SBAR(); GAPA(C1=__builtin_amdgcn_mfma_f32_32x32x16_bf16(kf[3],qr[1],C1,0,0,0),   P0[14],P0[15],P1[0],P1[1],   pw1[2]=PKW(P0,12),pw1[3]=PKW(P0,14), pw1); \
    VRD(2); SBAR(); GAPA(C0=__builtin_amdgcn_mfma_f32_32x32x16_bf16(kf[4],qr[2],C0,0,0,0),   P1[2],P1[3],P1[4],P1[5],     pw2[0]=PKW(P1,0), pw2[1]=PKW(P1,2), pw2); \
    VRD(6); SBAR(); GAPA(C1=__builtin_amdgcn_mfma_f32_32x32x16_bf16(kf[5],qr[2],C1,0,0,0),   P1[6],P1[7],P1[8],P1[9],     pw2[2]=PKW(P1,4), pw2[3]=PKW(P1,6), pw2); \
    VRD(3); SBAR(); GAPA(C0=__builtin_amdgcn_mfma_f32_32x32x16_bf16(kf[6],qr[3],C0,0,0,0),   P1[10],P1[11],P1[12],P1[13], pw3[0]=PKW(P1,8), pw3[1]=PKW(P1,10), pw3); \
    VRD(7); SBAR(); GAPA(C1=__builtin_amdgcn_mfma_f32_32x32x16_bf16(kf[7],qr[3],C1,0,0,0),   P1[14],P1[15],0.f,0.f,       pw3[2]=PKW(P1,12),pw3[3]=PKW(P1,14), pw3); \
    l_reg+=sacc; \
    if(GK){DMA_K((t)+3,sl_cur);} if(GV){DMA_V((t)+1,sl_next);} \
    CMASK(C0,C1,t); \
    { float a=MX3(C0[0],C0[1],C1[0]),b=MX3(C0[2],C0[3],C1[1]); a=MX3(a,C1[2],C1[3]); \
      _Pragma("unroll") for(int r=4;r<16;r+=4){a=MX3(a,C0[r],C0[r+1]);b=MX3(b,C0[r+2],C0[r+3]);a=MX3(a,C1[r],C1[r+1]);b=MX3(b,C1[r+2],C1[r+3]);} \
      float rm=__builtin_fmaxf(a,b); { auto rr=__builtin_amdgcn_permlane32_swap(__float_as_uint(rm),__float_as_uint(rm),false,false); rm=__builtin_fmaxf(__uint_as_float(rr[0]),__uint_as_float(rr[1])); } \
      resc=false; \
      if(__builtin_expect(__any(rm>(float)THRL),0)){ const float dl=__builtin_fmaxf(rm,0.f); mhat+=dl; \
        _Pragma("unroll") for(int r=0;r<16;++r){C0[r]-=dl;C1[r]-=dl;} \
        _Pragma("unroll") for(int r=0;r<16;++r)negm[r]=-mhat; asm volatile("":"+v"(negm)); \
        const float f=__builtin_amdgcn_exp2f(-dl); l_reg*=f; if(hi==0)wsf[r32]=f; resc=true; } } \
    SBAR(); \
    GAPB(o[0]=__builtin_amdgcn_mfma_f32_32x32x16_bf16(PAF(0),VFR(0),o[0],0,0,0), C0,0); \
    GAPB(o[1]=__builtin_amdgcn_mfma_f32_32x32x16_bf16(PAF(0),VFR(4),o[1],0,0,0), C0,4); \
    KRD(GL,0); GAPB(o[0]=__builtin_amdgcn_mfma_f32_32x32x16_bf16(PAF(1),VFR(1),o[0],0,0,0), C0,8); \
    KRD(GL,1); GAPB(o[1]=__builtin_amdgcn_mfma_f32_32x32x16_bf16(PAF(1),VFR(5),o[1],0,0,0), C0,12); \
    KRD(GL,2); GAPB(o[0]=__builtin_amdgcn_mfma_f32_32x32x16_bf16(PAF(2),VFR(2),o[0],0,0,0), C1,0); \
    KRD(GL,3); GAPB(o[1]=__builtin_amdgcn_mfma_f32_32x32x16_bf16(PAF(2),VFR(6),o[1],0,0,0), C1,4); \
    GAPB(o[0]=__builtin_amdgcn_mfma_f32_32x32x16_bf16(PAF(3),VFR(3),o[0],0,0,0), C1,8); \
    GAPB(o[1]=__builtin_amdgcn_mfma_f32_32x32x16_bf16(PAF(3),VFR(7),o[1],0,0,0), C1,12); \
    }while(0)
  int t=1;
  #undef CMASK
  #define CMASK(P0,P1,t) do{}while(0)
  for(;t+5<NT;t+=2){
    STEP(pB0,pB1,pA0,pA1,t,true,true,true);     WAIT_BAR(2); RESC(); ROT();
    STEP(pA0,pA1,pB0,pB1,t+1,true,true,true);   WAIT_BAR(2); RESC(); ROT();
  }
  #undef CMASK
  #define CMASK(P0,P1,t) do{int jb_=(t)-(NT-4); if(jb_>=0)cmask(P0,P1,jb_,qrel,hi);}while(0)
  #define ENDW(tt) do{ if((tt)+3<NT){WAIT_BAR(2);} else if((tt)+2<NT){WAIT_BAR(1);} else {WAIT_BAR(0);} }while(0)
  for(;t+1<NT;t+=2){
    STEP(pB0,pB1,pA0,pA1,t,(t+3<NT),(t+1<NT),(t+1<NT));       ENDW(t);   RESC(); ROT();
    STEP(pA0,pA1,pB0,pB1,t+1,(t+4<NT),(t+2<NT),(t+2<NT));     ENDW(t+1); RESC(); ROT();
  }
  STEP(pB0,pB1,pA0,pA1,NT-1,false,false,false); RESC();
  { float sacc=pB0[0]+pB0[1]; _Pragma("unroll") for(int r=2;r<16;++r)sacc+=pB0[r]; _Pragma("unroll") for(int r=0;r<16;++r)sacc+=pB1[r]; l_reg+=sacc;
    pw0=(u32x4){PKW(pB0,0),PKW(pB0,2),PKW(pB0,4),PKW(pB0,6)};pw1=(u32x4){PKW(pB0,8),PKW(pB0,10),PKW(pB0,12),PKW(pB0,14)};pw2=(u32x4){PKW(pB1,0),PKW(pB1,2),PKW(pB1,4),PKW(pB1,6)};pw3=(u32x4){PKW(pB1,8),PKW(pB1,10),PKW(pB1,12),PKW(pB1,14)};
    SBAR(); pv(o,vb0+sl_cur,PAF(0),PAF(1),PAF(2),PAF(3)); }
  #undef PKW
  #undef PAF
  #undef VFR
  #undef PIN
  #undef MX3
  #undef GAPA
  #undef GAPB
  #undef EX
  #undef VRD
  #undef KRD
  #undef STEP
  #undef ENDW
  {auto rr=__builtin_amdgcn_permlane32_swap(__float_as_uint(l_reg),__float_as_uint(l_reg),false,false);l_reg=__uint_as_float(rr[0])+__uint_as_float(rr[1]);}
  if(hi==0)wsf[32+r32]=l_reg;asm volatile("s_waitcnt lgkmcnt(0)":::"memory");
  float rli[16];
  #pragma unroll
  for(int r=0;r<16;++r)rli[r]=__builtin_amdgcn_rcpf(wsf[32+crow(r,hi)]);
  bf16*Ow=O+(rowbase+q0+wid*QBLK)*DMO+ocol;
  { bf16*stg=(bf16*)(shm+LDS_OST)+wid*2048;
    #pragma unroll
    for(int r=0;r<16;++r){const int orow=crow(r,hi);
      #pragma unroll
      for(int d0=0;d0<2;++d0)stg[orow*64+d0*32+r32]=__float2bfloat16(o[d0][r]*rli[r]);}
    asm volatile("s_waitcnt lgkmcnt(0)":::"memory");
    #pragma unroll
    for(int i=0;i<4;++i){const int row=i*8+(lane>>3),ch=lane&7; const u32x4 v=*(const u32x4*)(stg+row*64+ch*8); ATTN_STORE16(Ow+(long)row*DMO+ch*8,v);} }
  asm volatile("s_waitcnt lgkmcnt(0)\n\ts_barrier":::"memory");
  #undef DMA_K
  #undef DMA_V
  #undef CMASK
  #undef START
  #undef RESC
  #undef ROT
}
constexpr int ATTN_LDS_BYTES=LDS_BYTES;
template<int THRL=8> __device__ __forceinline__ void attn_phase(char*lds,const bf16*U,bf16*Oc,int vcu){
  const int bhc=vcu>>3,s=vcu&7,b=bhc>>3,h=(bhc>>1)&3,c=bhc&1;
  _Pragma("unroll 1") for(int i=0;i<4;++i){ const int half=i>>1,qb=(i&1)?15-s:s;
    attn_unit<THRL>(b,h*128+c*64,512+h*128+c*64,1024+h*128+half*64,h*128+half*64,qb,U,U,U,Oc+(long)c*16384*DMO,lds); }
}
#undef SBAR
#undef WAIT_BAR
}

namespace attn2 {
using bf16=__hip_bfloat16;
using bf16x8=__attribute__((ext_vector_type(8)))short;
using s16x4=__attribute__((ext_vector_type(4)))short;
using f32x16=__attribute__((ext_vector_type(16)))float;
using u32x4=__attribute__((ext_vector_type(4)))unsigned;
constexpr int SEQ=4096,D=64,DM=1536,DMO=512;
constexpr int NW=8,QBLK=32,QB=QBLK*NW,KVBLK=64,NQB=SEQ/QB;
constexpr int ATTN_UNIT_ROWS=QB;
__device__ __forceinline__ int crow(int r,int hi){return (r&3)+8*(r>>2)+4*hi;}
#define SBAR() __builtin_amdgcn_sched_barrier(0)
__device__ __forceinline__ void cmask(f32x16&p0,f32x16&p1,int jb,int qrel,int hi){
  const float NEG=-INFINITY; int kb=64*jb+4*hi;
  #pragma unroll
  for(int r=0;r<16;++r){int kv=kb+(r&3)+8*(r>>2); if(kv>qrel)p0[r]=NEG; if(kv+32>qrel)p1[r]=NEG;}
}

constexpr int NSLOT=3, SLOTB=8192;
constexpr int LDS_K=0, LDS_V=NSLOT*SLOTB, LDS_WS=3*NSLOT*SLOTB, LDS_OST=LDS_WS+NW*64*4, LDS_BYTES=LDS_OST+NW*4096;
constexpr float C2=0.125f*1.4426950408889634f;
__device__ __forceinline__ void glds16(const void*gsrc,unsigned lds_dst){unsigned keep;
  asm volatile("s_mov_b32 %0, m0\n\ts_mov_b32 m0, %2\n\ts_nop 0\n\tglobal_load_lds_dwordx4 %1, off\n\ts_mov_b32 m0, %0":"=&s"(keep):"v"(gsrc),"s"(lds_dst):"memory");}
__device__ __forceinline__ float max3f(float a,float b,float c){float r;asm("v_max3_f32 %0, %1, %2, %3":"=v"(r):"v"(a),"v"(b),"v"(c));return r;}
__device__ __forceinline__ float max2f(float a,float b){float r;asm("v_max_f32_e32 %0, %1, %2":"=v"(r):"v"(a),"v"(b));return r;}
__device__ __forceinline__ float fadd_s(float a,float b){float r;asm("v_add_f32_e32 %0, %1, %2":"=v"(r):"v"(a),"v"(b));return r;}
__device__ __forceinline__ float fsub_s(float a,float b){float r;asm("v_sub_f32_e32 %0, %1, %2":"=v"(r):"v"(a),"v"(b));return r;}
typedef float f32x2_t __attribute__((ext_vector_type(2))); typedef __bf16 bf16x2_t __attribute__((ext_vector_type(2)));
__device__ __forceinline__ unsigned cvtpk_s(float lo,float hi){f32x2_t v={lo,hi};bf16x2_t b=__builtin_convertvector(v,bf16x2_t);return __builtin_bit_cast(unsigned,b);}
#define WAIT_BAR(N) asm volatile("s_waitcnt vmcnt(" #N ") lgkmcnt(0)\n\ts_barrier":::"memory")

__device__ __forceinline__ void qkt(f32x16&p0,f32x16&p1,const char*Kslot,const bf16x8*qr,int r32,int hi){
  const f32x16 negm=f32x16{};
  const char*kb=Kslot+hi*1024+r32*16;
  #pragma unroll
  for(int d0=0;d0<4;++d0){
    const bf16x8 b0=*reinterpret_cast<const bf16x8*>(kb+d0*2048);
    const bf16x8 b1=*reinterpret_cast<const bf16x8*>(kb+d0*2048+512);
    if(d0==0){p0=__builtin_amdgcn_mfma_f32_32x32x16_bf16(b0,qr[0],negm,0,0,0);p1=__builtin_amdgcn_mfma_f32_32x32x16_bf16(b1,qr[0],negm,0,0,0);}
    else{p0=__builtin_amdgcn_mfma_f32_32x32x16_bf16(b0,qr[d0],p0,0,0,0);p1=__builtin_amdgcn_mfma_f32_32x32x16_bf16(b1,qr[d0],p1,0,0,0);}}
}
typedef __attribute__((address_space(3))) const char* lds_cptr;
typedef short v4i16_t __attribute__((ext_vector_type(4)));
__device__ __forceinline__ void kload8(bf16x8*kf,lds_cptr kp){
  kf[0]=*(const __attribute__((address_space(3))) bf16x8*)(kp);      kf[1]=*(const __attribute__((address_space(3))) bf16x8*)(kp+512);
  kf[2]=*(const __attribute__((address_space(3))) bf16x8*)(kp+2048); kf[3]=*(const __attribute__((address_space(3))) bf16x8*)(kp+2560);
  kf[4]=*(const __attribute__((address_space(3))) bf16x8*)(kp+4096); kf[5]=*(const __attribute__((address_space(3))) bf16x8*)(kp+4608);
  kf[6]=*(const __attribute__((address_space(3))) bf16x8*)(kp+6144); kf[7]=*(const __attribute__((address_space(3))) bf16x8*)(kp+6656);
}
__device__ __forceinline__ void kload2(bf16x8*kf,lds_cptr kp,int j){ kf[2*j]=*(const __attribute__((address_space(3))) bf16x8*)(kp+j*2048); kf[2*j+1]=*(const __attribute__((address_space(3))) bf16x8*)(kp+j*2048+512); }
__device__ __forceinline__ s16x4 vtr(lds_cptr p){ return __builtin_bit_cast(s16x4,__builtin_amdgcn_ds_read_tr16_b64_v4i16((__attribute__((address_space(3))) v4i16_t*)p)); }
__device__ __forceinline__ float rowmax(const f32x16&p0,const f32x16&p1){
  float a=max3f(p0[0],p0[1],p1[0]),b=max3f(p0[2],p0[3],p1[1]);a=max3f(a,p1[2],p1[3]);
  #pragma unroll
  for(int r=4;r<16;r+=4){a=max3f(a,p0[r],p0[r+1]);b=max3f(b,p0[r+2],p0[r+3]);a=max3f(a,p1[r],p1[r+1]);b=max3f(b,p1[r+2],p1[r+3]);}
  const float m=max2f(a,b);
  auto rr=__builtin_amdgcn_permlane32_swap(__float_as_uint(m),__float_as_uint(m),false,false);
  return max2f(__uint_as_float(rr[0]),__uint_as_float(rr[1]));
}
__device__ __forceinline__ void pv(f32x16*o,int vb,bf16x8 pa0,bf16x8 pa1,bf16x8 pa2,bf16x8 pa3){
  #pragma unroll
  for(int d0=0;d0<4;++d0){s16x4 lo[4],hi[4];
    #pragma unroll
    for(int ks=0;ks<4;++ks){
      asm volatile("ds_read_b64_tr_b16 %0,%1 offset:%c2":"=&v"(lo[ks]):"v"(vb),"i"(d0*4096+ks*1024):"memory");
      asm volatile("ds_read_b64_tr_b16 %0,%1 offset:%c2":"=&v"(hi[ks]):"v"(vb),"i"(d0*4096+ks*1024+512):"memory");}
    asm volatile("s_waitcnt lgkmcnt(0)":::"memory");SBAR();
    #define PK(k) (bf16x8){lo[k][0],lo[k][1],lo[k][2],lo[k][3],hi[k][0],hi[k][1],hi[k][2],hi[k][3]}
    o[d0]=__builtin_amdgcn_mfma_f32_32x32x16_bf16(pa0,PK(0),o[d0],0,0,0);
    o[d0]=__builtin_amdgcn_mfma_f32_32x32x16_bf16(pa1,PK(1),o[d0],0,0,0);
    o[d0]=__builtin_amdgcn_mfma_f32_32x32x16_bf16(pa2,PK(2),o[d0],0,0,0);
    o[d0]=__builtin_amdgcn_mfma_f32_32x32x16_bf16(pa3,PK(3),o[d0],0,0,0);
    #undef PK
  }
}

#ifndef ATTN_STORE16
#define ATTN_STORE16(p,v) (*(u32x4*)(p)=(v))
#endif
template<int THRL> __device__ __forceinline__ void attn_unit(int b,int qcol,int kcol,int vcol,int ocol,int qb,const bf16*Q,const bf16*__restrict__ K,const bf16*__restrict__ V,bf16*O,char*shm){
  int tid_=threadIdx.x; asm volatile("":"+v"(tid_));
  const int tid=tid_,lane=tid&63,r32=lane&31,hi=lane>>5; const int wid=__builtin_amdgcn_readfirstlane(tid>>6);
  const long rowbase=(long)b*SEQ; const int q0=qb*QB;
  const bf16*Qw=Q+(rowbase+q0+wid*QBLK)*DM+qcol;
  const bf16*Kh=K+rowbase*DM+kcol,*Vh=V+rowbase*DM+vcol;
  const unsigned lds0=(unsigned)(uintptr_t)shm;
  float*wsf=(float*)(shm+LDS_WS)+wid*64;
  const bf16*ksrc=Kh+(long)lane*DM+wid*8;
  const bf16*vsrc=Vh+(long)(16*(wid&3)+(lane>>2))*DM+(wid>>2)*32+(lane&3)*8;
  const unsigned kdst=lds0+LDS_K+wid*1024, vdst=lds0+LDS_V+wid*1024;
  #define DMA_K(t,slot) glds16(ksrc+(long)(t)*KVBLK*DM,(unsigned)__builtin_amdgcn_readfirstlane(kdst+(slot)))
  #define DMA_V(t,slot) do{ glds16(vsrc+(long)(t)*KVBLK*DM,(unsigned)__builtin_amdgcn_readfirstlane(vdst+2*(slot))); glds16(vsrc+(long)(t)*KVBLK*DM+64,(unsigned)__builtin_amdgcn_readfirstlane(vdst+2*(slot)+8192)); }while(0)
  const int vb0=(int)(lds0+LDS_V)+((lane>>4)&1)*32+(lane&3)*8+(4*hi+((lane&15)>>2))*64;
  const char*Kbase=shm+LDS_K; bf16x8 kf[8];
  const lds_cptr shm3=(lds_cptr)shm; const lds_cptr kp0=shm3+LDS_K+hi*1024+r32*16; const lds_cptr vp0=shm3+LDS_V+((lane>>4)&1)*32+(lane&3)*8+(4*hi+((lane&15)>>2))*64;
  const int NT=(q0+QB)/KVBLK;
  DMA_K(0,0);DMA_V(0,0);DMA_K(1,SLOTB);
  bf16x8 qr[4];
  #pragma unroll
  for(int d0=0;d0<4;++d0)qr[d0]=*reinterpret_cast<const bf16x8*>(&Qw[(long)r32*DM+d0*16+hi*8]);
  float mhat=0.f,l_reg=0.f;f32x16 o[4];o[0]=f32x16{};o[1]=f32x16{};o[2]=f32x16{};o[3]=f32x16{};
  const int qrel=wid*QBLK+r32;
  #define CMASK(P0,P1,t) do{int jb_=(t)-(NT-4); if(jb_>=0)cmask(P0,P1,jb_,qrel,hi);}while(0)
  bool resc=false;
  #define START(P0,P1) do{ const float rm=rowmax(P0,P1); resc=false; mhat=rm; \
    _Pragma("unroll") for(int r=0;r<16;++r)P0[r]=__builtin_amdgcn_exp2f(P0[r]-mhat); }while(0)
  #define RESC() do{ if(resc){ asm volatile("s_waitcnt lgkmcnt(0)":::"memory"); \
      _Pragma("unroll") for(int d_=0;d_<4;++d_) _Pragma("unroll") for(int r=0;r<16;++r)o[d_][r]*=wsf[crow(r,hi)]; } }while(0)
  f32x16 pA0,pA1,pB0,pB1;
  int sl_prev=0,sl_cur=0,sl_next=SLOTB;
  #define ROT() do{sl_prev=sl_cur;sl_cur=sl_next;sl_next=(sl_next==(NSLOT-1)*SLOTB)?0:sl_next+SLOTB;}while(0)
  DMA_K(2,2*SLOTB);
  WAIT_BAR(4);
  qkt(pA0,pA1,Kbase,qr,r32,hi);asm volatile("s_nop 15\n\ts_nop 7":"+v"(pA0),"+v"(pA1));CMASK(pA0,pA1,0);
  START(pA0,pA1);
  _Pragma("unroll") for(int r=0;r<16;++r)pA1[r]=__builtin_amdgcn_exp2f(pA1[r]-mhat);
  WAIT_BAR(0);
  DMA_K(3,0);DMA_V(1,SLOTB);
  ROT();
  kload8(kf,kp0+sl_cur);
  WAIT_BAR(3);
  s16x4 vlo[8],vhi[8]; u32x4 pw0,pw1,pw2,pw3;
  #define PKW(P,B) cvtpk_s(P[B],P[B+1])
  #define PAF(k) __builtin_bit_cast(bf16x8,pw##k)
  #define VFR(i) (bf16x8){vlo[i][0],vlo[i][1],vlo[i][2],vlo[i][3],vhi[i][0],vhi[i][1],vhi[i][2],vhi[i][3]}
  #define PIN(x) asm volatile("":"+v"(x))
  #define MX3(a,b,c) __builtin_fmaxf(__builtin_fmaxf((a),(b)),(c))
  #define GAPA(MF,A0,A1,A2,A3,W0,W1,PW) do{ MF; sacc+=A0; sacc+=A1; sacc+=A2; sacc+=A3; PIN(sacc); W0; W1; PIN(PW); SBAR(); }while(0)
  #define EX(v) __builtin_amdgcn_exp2f(v)
  #define GAPB(MF,X,B) do{ MF; X[B]=EX(X[B]-mhat); X[B+1]=EX(X[B+1]-mhat); PIN(X); SBAR(); }while(0)
  #define VRD(i) do{ vlo[i]=vtr(vp_+(((i)>>2)*4096+((i)&3)*1024)); vhi[i]=vtr(vp_+(((i)>>2)*4096+((i)&3)*1024+512)); }while(0)
  #define VRD2(i) do{ vlo[i]=vtr(vp_+((2+((i)>>2))*4096+((i)&3)*1024)); vhi[i]=vtr(vp_+((2+((i)>>2))*4096+((i)&3)*1024+512)); SBAR(); }while(0)
  #define KRD(G,j) do{ if(G){ kload2(kf,kp0+sl_next,j); SBAR(); } }while(0)
  #define STEP(C0,C1,P0,P1,t,GK,GV,GL) do{ SBAR(); \
    const lds_cptr vp_=vp0+2*sl_prev; const f32x16 zz=f32x16{}; \
    VRD(0); SBAR(); float sacc=(P0[0]+P0[1]); \
    GAPA(C0=__builtin_amdgcn_mfma_f32_32x32x16_bf16(kf[0],qr[0],zz,0,0,0), P0[2],P0[3],P0[4],P0[5],     pw0[0]=PKW(P0,0), pw0[1]=PKW(P0,2), pw0); \
    VRD(4); SBAR(); GAPA(C1=__builtin_amdgcn_mfma_f32_32x32x16_bf16(kf[1],qr[0],zz,0,0,0), P0[6],P0[7],P0[8],P0[9],     pw0[2]=PKW(P0,4), pw0[3]=PKW(P0,6), pw0); \
    VRD(1); SBAR(); GAPA(C0=__builtin_amdgcn_mfma_f32_32x32x16_bf16(kf[2],qr[1],C0,0,0,0),   P0[10],P0[11],P0[12],P0[13], pw1[0]=PKW(P0,8), pw1[1]=PKW(P0,10), pw1); \
    VRD(5); SBAR(); GAPA(C1=__builtin_amdgcn_mfma_f32_32x32x16_bf16(kf[3],qr[1],C1,0,0,0),   P0[14],P0[15],P1[0],P1[1],   pw1[2]=PKW(P0,12),pw1[3]=PKW(P0,14), pw1); \
    VRD(2); SBAR(); GAPA(C0=__builtin_amdgcn_mfma_f32_32x32x16_bf16(kf[4],qr[2],C0,0,0,0),   P1[2],P1[3],P1[4],P1[5],     pw2[0]=PKW(P1,0), pw2[1]=PKW(P1,2), pw2); \
    VRD(6); SBAR(); GAPA(C1=__builtin_amdgcn_mfma_f32_32x32x16_bf16(kf[5],qr[2],C1,0,0,0),   P1[6],P1[7],P1[8],P1[9],     pw2[2]=PKW(P1,4), pw2[3]=PKW(P1,6), pw2); \
    VRD(3); SBAR(); GAPA(C0=__builtin_amdgcn_mfma_f32_32x32x16_bf16(kf[6],qr[3],C0,0,0,0),   P1[10],P1[11],P1[12],P1[13], pw3[0]=PKW(P1,8), pw3[1]=PKW(P1,10), pw3); \
    VRD(7); SBAR(); GAPA(C1=__builtin_amdgcn_mfma_f32_32x32x16_bf16(kf[7],qr[3],C1,0,0,0),   P1[14],P1[15],0.f,0.f,       pw3[2]=PKW(P1,12),pw3[3]=PKW(P1,14), pw3); \
    l_reg+=sacc; \
    if(GK){DMA_K((t)+3,sl_cur);} if(GV){DMA_V((t)+1,sl_next);} \
    CMASK(C0,C1,t); \
    { float a=MX3(C0[0],C0[1],C1[0]),b=MX3(C0[2],C0[3],C1[1]); a=MX3(a,C1[2],C1[3]); \
      _Pragma("unroll") for(int r=4;r<16;r+=4){a=MX3(a,C0[r],C0[r+1]);b=MX3(b,C0[r+2],C0[r+3]);a=MX3(a,C1[r],C1[r+1]);b=MX3(b,C1[r+2],C1[r+3]);} \
      float rm=__builtin_fmaxf(a,b); { auto rr=__builtin_amdgcn_permlane32_swap(__float_as_uint(rm),__float_as_uint(rm),false,false); rm=__builtin_fmaxf(__uint_as_float(rr[0]),__uint_as_float(rr[1])); } \
      resc=false; \
      if(__builtin_expect(__any(rm-mhat>(float)THRL),0)){ const float dl=__builtin_fmaxf(rm-mhat,0.f); mhat+=dl; \
        const float f=__builtin_amdgcn_exp2f(-dl); l_reg*=f; if(hi==0)wsf[r32]=f; resc=true; } } \
    SBAR(); \
    GAPB(o[0]=__builtin_amdgcn_mfma_f32_32x32x16_bf16(PAF(0),VFR(0),o[0],0,0,0), C0,0);  VRD2(0); \
    GAPB(o[1]=__builtin_amdgcn_mfma_f32_32x32x16_bf16(PAF(0),VFR(4),o[1],0,0,0), C0,2);  VRD2(4); \
    GAPB(o[0]=__builtin_amdgcn_mfma_f32_32x32x16_bf16(PAF(1),VFR(1),o[0],0,0,0), C0,4);  VRD2(1); \
    GAPB(o[1]=__builtin_amdgcn_mfma_f32_32x32x16_bf16(PAF(1),VFR(5),o[1],0,0,0), C0,6);  VRD2(5); \
    GAPB(o[0]=__builtin_amdgcn_mfma_f32_32x32x16_bf16(PAF(2),VFR(2),o[0],0,0,0), C0,8);  VRD2(2); \
    GAPB(o[1]=__builtin_amdgcn_mfma_f32_32x32x16_bf16(PAF(2),VFR(6),o[1],0,0,0), C0,10); VRD2(6); \
    GAPB(o[0]=__builtin_amdgcn_mfma_f32_32x32x16_bf16(PAF(3),VFR(3),o[0],0,0,0), C0,12); VRD2(3); \
    GAPB(o[1]=__builtin_amdgcn_mfma_f32_32x32x16_bf16(PAF(3),VFR(7),o[1],0,0,0), C0,14); VRD2(7); \
    GAPB(o[2]=__builtin_amdgcn_mfma_f32_32x32x16_bf16(PAF(0),VFR(0),o[2],0,0,0), C1,0); \
    GAPB(o[3]=__builtin_amdgcn_mfma_f32_32x32x16_bf16(PAF(0),VFR(4),o[3],0,0,0), C1,2); \
    KRD(GL,0); GAPB(o[2]=__builtin_amdgcn_mfma_f32_32x32x16_bf16(PAF(1),VFR(1),o[2],0,0,0), C1,4); \
    KRD(GL,1); GAPB(o[3]=__builtin_amdgcn_mfma_f32_32x32x16_bf16(PAF(1),VFR(5),o[3],0,0,0), C1,6); \
    KRD(GL,2); GAPB(o[2]=__builtin_amdgcn_mfma_f32_32x32x16_bf16(PAF(2),VFR(2),o[2],0,0,0), C1,8); \
    KRD(GL,3); GAPB(o[3]=__builtin_amdgcn_mfma_f32_32x32x16_bf16(PAF(2),VFR(6),o[3],0,0,0), C1,10); \
    GAPB(o[2]=__builtin_amdgcn_mfma_f32_32x32x16_bf16(PAF(3),VFR(3),o[2],0,0,0), C1,12); \
    GAPB(o[3]=__builtin_amdgcn_mfma_f32_32x32x16_bf16(PAF(3),VFR(7),o[3],0,0,0), C1,14); \
    }while(0)
  int t=1;
  #undef CMASK
  #define CMASK(P0,P1,t) do{}while(0)
  for(;t+5<NT;t+=2){
    STEP(pB0,pB1,pA0,pA1,t,true,true,true);     WAIT_BAR(3); RESC(); ROT();
    STEP(pA0,pA1,pB0,pB1,t+1,true,true,true);   WAIT_BAR(3); RESC(); ROT();
  }
  #undef CMASK
  #define CMASK(P0,P1,t) do{int jb_=(t)-(NT-4); if(jb_>=0)cmask(P0,P1,jb_,qrel,hi);}while(0)
  #define ENDW(tt) do{ if((tt)+3<NT){WAIT_BAR(3);} else if((tt)+2<NT){WAIT_BAR(2);} else {WAIT_BAR(0);} }while(0)
  for(;t+1<NT;t+=2){
    STEP(pB0,pB1,pA0,pA1,t,(t+3<NT),(t+1<NT),(t+1<NT));       ENDW(t);   RESC(); ROT();
    STEP(pA0,pA1,pB0,pB1,t+1,(t+4<NT),(t+2<NT),(t+2<NT));     ENDW(t+1); RESC(); ROT();
  }
  STEP(pB0,pB1,pA0,pA1,NT-1,false,false,false); RESC();
  { float sacc=pB0[0]+pB0[1]; _Pragma("unroll") for(int r=2;r<16;++r)sacc+=pB0[r]; _Pragma("unroll") for(int r=0;r<16;++r)sacc+=pB1[r]; l_reg+=sacc;
    pw0=(u32x4){PKW(pB0,0),PKW(pB0,2),PKW(pB0,4),PKW(pB0,6)};pw1=(u32x4){PKW(pB0,8),PKW(pB0,10),PKW(pB0,12),PKW(pB0,14)};pw2=(u32x4){PKW(pB1,0),PKW(pB1,2),PKW(pB1,4),PKW(pB1,6)};pw3=(u32x4){PKW(pB1,8),PKW(pB1,10),PKW(pB1,12),PKW(pB1,14)};
    SBAR(); pv(o,vb0+2*sl_cur,PAF(0),PAF(1),PAF(2),PAF(3)); }
  #undef PKW
  #undef PAF
  #undef VFR
  #undef PIN
  #undef MX3
  #undef GAPA
  #undef GAPB
  #undef EX
  #undef VRD
  #undef VRD2
  #undef KRD
  #undef STEP
  #undef ENDW
  {auto rr=__builtin_amdgcn_permlane32_swap(__float_as_uint(l_reg),__float_as_uint(l_reg),false,false);l_reg=__uint_as_float(rr[0])+__uint_as_float(rr[1]);}
  if(hi==0)wsf[32+r32]=l_reg;asm volatile("s_waitcnt lgkmcnt(0)":::"memory");
  float rli[16];
  #pragma unroll
  for(int r=0;r<16;++r)rli[r]=__builtin_amdgcn_rcpf(wsf[32+crow(r,hi)]);
  bf16*Ow=O+(rowbase+q0+wid*QBLK)*DMO+ocol;
  { bf16*stg=(bf16*)(shm+LDS_OST)+wid*2048;
    #pragma unroll
    for(int ps=0;ps<2;++ps){
      #pragma unroll
      for(int r=0;r<16;++r){const int orow=crow(r,hi);
        #pragma unroll
        for(int d0=0;d0<2;++d0)stg[orow*64+d0*32+r32]=__float2bfloat16(o[2*ps+d0][r]*rli[r]);}
      asm volatile("s_waitcnt lgkmcnt(0)":::"memory");
      #pragma unroll
      for(int i=0;i<4;++i){const int row=i*8+(lane>>3),ch=lane&7; const u32x4 v=*(const u32x4*)(stg+row*64+ch*8); ATTN_STORE16(Ow+(long)row*DMO+ps*64+ch*8,v);}
      asm volatile("s_waitcnt lgkmcnt(0)":::"memory"); } }
  asm volatile("s_waitcnt lgkmcnt(0)\n\ts_barrier":::"memory");
  #undef DMA_K
  #undef DMA_V
  #undef CMASK
  #undef START
  #undef RESC
  #undef ROT
}
constexpr int ATTN_LDS_BYTES=LDS_BYTES;
template<int THRL=8> __device__ __forceinline__ void attn_phase(char*lds,const bf16*U,bf16*Oc,int vcu){
  const int bhc=vcu>>3,s=vcu&7,b=bhc>>3,h=(bhc>>1)&3,c=bhc&1;
  _Pragma("unroll 1") for(int i=0;i<2;++i){ const int qb=i?15-s:s;
    attn_unit<THRL>(b,h*128+c*64,512+h*128+c*64,1024+h*128,h*128,qb,U,U,U,Oc+(long)c*16384*DMO,lds); }
}
#undef SBAR
#undef WAIT_BAR
}


namespace gla {
constexpr int GP = 72;
constexpr int L_BC = 0, L_VT = 16384, L_QI = 34816, L_KI = 44032, L_ATT = 53248, L_OF = 62464, OFP = 132;
__device__ __forceinline__ bf16x8 frag(const LAS unsigned char* base, int row, int k0) { return *(const LAS bf16x8*)(base + (row * GP + k0) * 2); }
struct LdState { f32x4 g0, g1; unsigned vw[8]; unsigned kw[4]; };
__device__ __forceinline__ void ld_common(f32x4& g0, f32x4& g1, unsigned (&vw)[8], const float* LOGA, const bf16_t* Ugla, size_t row0, int h, int tid) {
    const float* gp = LOGA + (row0 + (tid >> 3)) * 256 + h * 64 + (tid & 7) * 8; g0 = *(const f32x4*)gp; g1 = *(const f32x4*)(gp + 4);
    const bf16_t* vp = Ugla + (row0 + (tid >> 7) * 16) * 1536 + 512 + h * 128 + (tid & 127);
#pragma unroll
    for (int j = 0; j < 8; ++j) vw[j] = (unsigned)vp[(size_t)(2 * j) * 1536] | ((unsigned)vp[(size_t)(2 * j + 1) * 1536] << 16);
}
__device__ __forceinline__ void ld_state(LdState& L, const float* LOGA, const bf16_t* Ugla, size_t row0, int h, int tid) {
    ld_common(L.g0, L.g1, L.vw, LOGA, Ugla, row0, h, tid);
    const bf16_t* kp = Ugla + (row0 + (tid >> 6) * 8) * 1536 + 256 + h * 64 + (tid & 63);
#pragma unroll
    for (int j = 0; j < 4; ++j) L.kw[j] = (unsigned)kp[(size_t)(2 * j) * 1536] | ((unsigned)kp[(size_t)(2 * j + 1) * 1536] << 16);
}
__device__ __forceinline__ void stage_common(LAS unsigned char* lds, const f32x4& g0, const f32x4& g1, const unsigned (&vw)[8], int tid) {
    LAS float* Bc = (LAS float*)(lds + L_BC);
    *(LAS f32x4*)(Bc + (tid >> 3) * 64 + (tid & 7) * 8) = g0; *(LAS f32x4*)(Bc + (tid >> 3) * 64 + (tid & 7) * 8 + 4) = g1;
    LAS u32x4* dst = (LAS u32x4*)(lds + L_VT + ((tid & 127) * GP + (tid >> 7) * 16) * 2);
    dst[0] = (u32x4){vw[0], vw[1], vw[2], vw[3]}; dst[1] = (u32x4){vw[4], vw[5], vw[6], vw[7]};
}
__device__ __forceinline__ void cumsum_inplace(LAS unsigned char* lds, int lane, int wave) {
    LAS float* Bc = (LAS float*)(lds + L_BC);
    if (wave == 0) { float acc = 0.f;
#pragma unroll 16
        for (int s = 0; s < 64; ++s) { acc += Bc[s * 64 + lane]; Bc[s * 64 + lane] = acc; } }
}
__device__ __forceinline__ void chunk_state4(LAS unsigned char* lds, int b, int n, const float* LOGA, const bf16_t* Ugla, float* SCt, float* DEC, int tid, int lane, int wave) {
    const size_t row0 = (size_t)b * SEQ + n * 64;
    LAS float* Bc = (LAS float*)(lds + L_BC);
    LdState cur; ld_state(cur, LOGA, Ugla, row0, 0, tid);
#pragma unroll 1
    for (int h = 0; h < 4; ++h) {
        const int q = ((b * 4 + h) << 6) + n;
        stage_common(lds, cur.g0, cur.g1, cur.vw, tid);
        __syncthreads();
        cumsum_inplace(lds, lane, wave);
        __syncthreads();
        { const int k = tid & 63, sg = tid >> 6; const float bl = Bc[63 * 64 + k]; float f[8];
#pragma unroll
            for (int j = 0; j < 4; ++j) { f[2 * j] = lo_bf(cur.kw[j]) * __expf(bl - Bc[(sg * 8 + 2 * j) * 64 + k]); f[2 * j + 1] = hi_bf(cur.kw[j]) * __expf(bl - Bc[(sg * 8 + 2 * j + 1) * 64 + k]); }
            *(LAS u32x4*)(lds + L_QI + (k * GP + sg * 8) * 2) = (u32x4){pk2(f[0], f[1]), pk2(f[2], f[3]), pk2(f[4], f[5]), pk2(f[6], f[7])};
            if (tid < 64) DEC[(size_t)q * 64 + tid] = __expf(bl); }
        LdState nxt = cur; if (h < 3) ld_state(nxt, LOGA, Ugla, row0, h + 1, tid);
        __syncthreads();
        { const int fr = lane & 15, fq = lane >> 4, mt = wave >> 1;
#pragma unroll
            for (int j = 0; j < 4; ++j) { const int nt = (wave & 1) * 4 + j; f32x4 acc = {0.f, 0.f, 0.f, 0.f};
#pragma unroll
                for (int ks = 0; ks < 2; ++ks) acc = __builtin_amdgcn_mfma_f32_16x16x32_bf16(frag(lds + L_QI, 16 * mt + fr, 32 * ks + 8 * fq), frag(lds + L_VT, 16 * nt + fr, 32 * ks + 8 * fq), acc, 0, 0, 0);
                *(f32x4*)(SCt + (size_t)q * 8192 + (16 * nt + fr) * 64 + 16 * mt + 4 * fq) = acc; } }
        __syncthreads();
        cur = nxt;
    }
}
struct LdOut { f32x4 g0, g1; unsigned vw[8]; u32x4 qw, kw, r0, r1; bf16x8 sp[4][2]; };
__device__ __forceinline__ void ld_out(LdOut& L, const float* LOGA, const bf16_t* Ugla, const bf16_t* SPt, size_t row0, int h, int q, int tid, int lane, int wave) {
    ld_common(L.g0, L.g1, L.vw, LOGA, Ugla, row0, h, tid);
    const bf16_t* rp = Ugla + (row0 + (tid >> 3)) * 1536 + h * 64 + (tid & 7) * 8; L.qw = *(const u32x4*)rp; L.kw = *(const u32x4*)(rp + 256);
    const bf16_t* gp = Ugla + (row0 + (tid >> 3)) * 1536 + 1024 + h * 128 + (tid & 7) * 16; L.r0 = *(const u32x4*)gp; L.r1 = *(const u32x4*)(gp + 8);
    const int fr = lane & 15, fq = lane >> 4;
#pragma unroll
    for (int j = 0; j < 4; ++j)
#pragma unroll
        for (int ks = 0; ks < 2; ++ks) L.sp[j][ks] = *(const bf16x8*)(SPt + (size_t)q * 8192 + (16 * ((wave & 1) * 4 + j) + fr) * 64 + 32 * ks + 8 * fq);
}
__device__ __forceinline__ void chunk_out4(LAS unsigned char* lds, int b, int n, const float* LOGA, const bf16_t* Ugla, const bf16_t* SPt, const float* gog, bf16_t* OA, int tid, int lane, int wave) {
    const size_t row0 = (size_t)b * SEQ + n * 64;
    LAS float* Bc = (LAS float*)(lds + L_BC); LAS float* Of = (LAS float*)(lds + L_OF);
    const int fr = lane & 15, fq = lane >> 4;
    LdOut cur; ld_out(cur, LOGA, Ugla, SPt, row0, 0, ((b * 4) << 6) + n, tid, lane, wave);
#pragma unroll 1
    for (int h = 0; h < 4; ++h) {
        stage_common(lds, cur.g0, cur.g1, cur.vw, tid);
        __syncthreads();
        cumsum_inplace(lds, lane, wave);
        __syncthreads();
        { const int s = tid >> 3, k0 = (tid & 7) * 8; float qf[8], kf[8];
            qf[0] = lo_bf(cur.qw.x); qf[1] = hi_bf(cur.qw.x); qf[2] = lo_bf(cur.qw.y); qf[3] = hi_bf(cur.qw.y); qf[4] = lo_bf(cur.qw.z); qf[5] = hi_bf(cur.qw.z); qf[6] = lo_bf(cur.qw.w); qf[7] = hi_bf(cur.qw.w);
            kf[0] = lo_bf(cur.kw.x); kf[1] = hi_bf(cur.kw.x); kf[2] = lo_bf(cur.kw.y); kf[3] = hi_bf(cur.kw.y); kf[4] = lo_bf(cur.kw.z); kf[5] = hi_bf(cur.kw.z); kf[6] = lo_bf(cur.kw.w); kf[7] = hi_bf(cur.kw.w);
#pragma unroll
            for (int e = 0; e < 8; ++e) { const float bv = Bc[s * 64 + k0 + e]; qf[e] *= 0.125f * __expf(bv); kf[e] *= __expf(-bv); }
            *(LAS u32x4*)(lds + L_QI + (s * GP + k0) * 2) = (u32x4){pk2(qf[0], qf[1]), pk2(qf[2], qf[3]), pk2(qf[4], qf[5]), pk2(qf[6], qf[7])};
            *(LAS u32x4*)(lds + L_KI + (s * GP + k0) * 2) = (u32x4){pk2(kf[0], kf[1]), pk2(kf[2], kf[3]), pk2(kf[4], kf[5]), pk2(kf[6], kf[7])}; }
        __syncthreads();
#pragma unroll
        for (int j = 0; j < 2; ++j) { const int t = 2 * wave + j, mt = t >> 2, nt = t & 3; f32x4 acc = {0.f, 0.f, 0.f, 0.f};
#pragma unroll
            for (int ks = 0; ks < 2; ++ks) acc = __builtin_amdgcn_mfma_f32_16x16x32_bf16(frag(lds + L_QI, 16 * mt + fr, 32 * ks + 8 * fq), frag(lds + L_KI, 16 * nt + fr, 32 * ks + 8 * fq), acc, 0, 0, 0);
            LAS bf16_t* ap = (LAS bf16_t*)(lds + L_ATT); const int sc = 16 * nt + fr;
#pragma unroll
            for (int r = 0; r < 4; ++r) { const int c = 16 * mt + 4 * fq + r; ap[c * GP + sc] = (bf16_t)f2bf(sc <= c ? acc[r] : 0.f); } }
        __syncthreads();
        { const int mt = wave >> 1;
#pragma unroll
            for (int j = 0; j < 4; ++j) { const int nt = (wave & 1) * 4 + j; f32x4 acc = {0.f, 0.f, 0.f, 0.f};
#pragma unroll
                for (int ks = 0; ks < 2; ++ks) { acc = __builtin_amdgcn_mfma_f32_16x16x32_bf16(frag(lds + L_ATT, 16 * mt + fr, 32 * ks + 8 * fq), frag(lds + L_VT, 16 * nt + fr, 32 * ks + 8 * fq), acc, 0, 0, 0);
                    acc = __builtin_amdgcn_mfma_f32_16x16x32_bf16(frag(lds + L_QI, 16 * mt + fr, 32 * ks + 8 * fq), cur.sp[j][ks], acc, 0, 0, 0); }
#pragma unroll
                for (int r = 0; r < 4; ++r) Of[(16 * mt + 4 * fq + r) * OFP + 16 * nt + fr] = acc[r]; } }
        const u32x4 r0 = cur.r0, r1 = cur.r1;
        if (h < 3) ld_out(cur, LOGA, Ugla, SPt, row0, h + 1, ((b * 4 + h + 1) << 6) + n, tid, lane, wave);
        __syncthreads();
        { const int c = tid >> 3, v0 = (tid & 7) * 16; float o[16]; float ss = 0.f;
#pragma unroll
            for (int e = 0; e < 16; e += 4) { const f32x4 t4 = *(const LAS f32x4*)(Of + c * OFP + v0 + e); o[e] = t4.x; o[e + 1] = t4.y; o[e + 2] = t4.z; o[e + 3] = t4.w; ss += (t4.x * t4.x + t4.y * t4.y) + (t4.z * t4.z + t4.w * t4.w); }
            ss += __shfl_xor(ss, 1); ss += __shfl_xor(ss, 2); ss += __shfl_xor(ss, 4);
            const float rstd = rsqrtf(ss * (1.f / 128.f) + 1e-6f);
            const unsigned rw[8] = {r0.x, r0.y, r0.z, r0.w, r1.x, r1.y, r1.z, r1.w}; unsigned ow[8];
#pragma unroll
            for (int e = 0; e < 8; ++e) { const float a = o[2 * e] * rstd * gog[v0 + 2 * e] * siluf_(lo_bf(rw[e])), b2 = o[2 * e + 1] * rstd * gog[v0 + 2 * e + 1] * siluf_(hi_bf(rw[e])); ow[e] = pk2(a, b2); }
            bf16_t* op = OA + (row0 + c) * 1024 + h * 128 + v0; *(u32x4*)op = (u32x4){ow[0], ow[1], ow[2], ow[3]}; *(u32x4*)(op + 8) = (u32x4){ow[4], ow[5], ow[6], ow[7]}; }
    }
}
}

#define XB_TMO      128
#define XB_XCNT(j)  (256  + 64 * (j))
#define XB_XSUB(j)  (1280 + 64 * (j))
#define XB_XGEN(j)  (2304 + 64 * (j))
#define XB_TOP      3328
#define XB_TOPGEN   3392
#define XCD_BAR_WORDS 3456
#define XB_SPIN_CAP (1u << 18)
__device__ __forceinline__ unsigned xb_ld(unsigned* p)              { return __hip_atomic_load(p, __ATOMIC_RELAXED, __HIP_MEMORY_SCOPE_AGENT); }
__device__ __forceinline__ unsigned xb_add(unsigned* p, unsigned v) { return __hip_atomic_fetch_add(p, v, __ATOMIC_RELAXED, __HIP_MEMORY_SCOPE_AGENT); }
__device__ __forceinline__ unsigned xb_xcc_id() { return (unsigned)__builtin_amdgcn_s_getreg((3 << 11) | 20) & 0xFu; }
#define XB_SPIN(cond, bar) do { unsigned _sp = 0; while (cond) { __builtin_amdgcn_s_sleep(1); \
    if ((++_sp & 255u) == 0u) { if (xb_ld(&(bar)[XB_TMO])) break; if (_sp > XB_SPIN_CAP) { atomicAdd(&(bar)[XB_TMO], 1u); break; } } } } while (0)
struct XcdBarrier { unsigned* bar; unsigned x; volatile LAS unsigned* st; };
__device__ __forceinline__ XcdBarrier xcd_barrier_post(unsigned* bar, volatile LAS unsigned* st) {
    XcdBarrier b; b.bar = bar; b.x = xb_xcc_id(); b.st = st;
    if (threadIdx.x == 0) (void)xb_add(&bar[XB_XCNT(b.x)], 1u);
    return b;
}
__device__ __forceinline__ void xcd_barrier_complete(unsigned* bar, unsigned x, unsigned& nloc, unsigned& nx) {
    const unsigned G = gridDim.x * gridDim.y * gridDim.z;
    unsigned sum, cnt, mine, sp = 0u;
    for (;;) {
        sum = 0u; cnt = 0u; mine = 0u;
#pragma unroll
        for (unsigned j = 0; j < 16; ++j) { const unsigned c = xb_ld(&bar[XB_XCNT(j)]); sum += c; cnt += (c > 0u) ? 1u : 0u; mine = (j == x) ? c : mine; }
        if (sum == G) break;
        __builtin_amdgcn_s_sleep(1);
        if ((++sp & 255u) == 0u) { if (xb_ld(&bar[XB_TMO])) break; if (sp > XB_SPIN_CAP) { atomicAdd(&bar[XB_TMO], 1u); break; } }
    }
    nloc = mine > 0u ? mine : 1u; nx = cnt > 0u ? cnt : 1u;
}
__device__ __forceinline__ void xcd_barrier(const XcdBarrier& b) {
    asm volatile("s_waitcnt vmcnt(0)" ::: "memory");
    __syncthreads();
    if (threadIdx.x == 0) {
        unsigned* bar = b.bar;
        __builtin_amdgcn_s_waitcnt(0);
        unsigned nloc = b.st[0], nx = b.st[1];
        if (nloc == 0u) { xcd_barrier_complete(bar, b.x, nloc, nx); b.st[0] = nloc; b.st[1] = nx; }
        const unsigned old = xb_add(&bar[XB_XSUB(b.x)], 1u);
        const unsigned gen = old / nloc;
        if (old + 1u == (gen + 1u) * nloc) {
            __builtin_amdgcn_fence(__ATOMIC_RELEASE, "agent");
            asm volatile("s_waitcnt vmcnt(0)" ::: "memory");
            const unsigned og = xb_add(&bar[XB_TOP], 1u);
            const unsigned tg = og / nx;
            if (og + 1u == (tg + 1u) * nx) xb_add(&bar[XB_TOPGEN], 1u);
            else XB_SPIN(xb_ld(&bar[XB_TOPGEN]) == tg, bar);
            __builtin_amdgcn_fence(__ATOMIC_ACQUIRE, "agent");
            xb_add(&bar[XB_XGEN(b.x)], 1u);
            asm volatile("s_waitcnt vmcnt(0)" ::: "memory");
        } else {
            XB_SPIN(xb_ld(&bar[XB_XGEN(b.x)]) == gen, bar);
            __builtin_amdgcn_fence(__ATOMIC_ACQUIRE, "agent");
            asm volatile("s_waitcnt vmcnt(0)" ::: "memory");
        }
    }
    __syncthreads();
}

struct Args { const void* in[28]; float* out; unsigned char* ws; int ph_lo, ph_hi; };
enum { I_X = 0, I_C, I_POS, I_ADAW, I_ADAB, I_N1G, I_N2G, I_WIN, I_AUP, I_AB, I_GOG, I_DQG, I_DKG, I_LQ1, I_LK1, I_LQ2, I_LK2, I_DOG, I_WBA, I_WBB, I_WOUT, I_RGW, I_RGB, I_REW, I_REB, I_EW1, I_EW3, I_EW2 };

struct TrJob { const float* src; bf16_t* dst; int ldn, kdst; };
__device__ __forceinline__ void tr_load(f32x4 (&v)[8], const TrJob& J, int lane) {
#pragma unroll
    for (int i = 0; i < 8; ++i) v[i] = *(const f32x4*)(J.src + (size_t)(8 * i + (lane >> 3)) * J.ldn + (lane & 7) * 4);
}
__device__ __forceinline__ void tr_store(const f32x4 (&v)[8], const TrJob& J, LAS float* scr, int lane) {
#pragma unroll
    for (int i = 0; i < 8; ++i) { LAS float* p = scr + (8 * i + (lane >> 3)) * 33 + (lane & 7) * 4; p[0] = v[i].x; p[1] = v[i].y; p[2] = v[i].z; p[3] = v[i].w; }
    LDS_WAIT(); asm volatile("" ::: "memory");
    const int c = lane & 7;
#pragma unroll
    for (int j = 0; j < 4; ++j) { const int n = (lane >> 3) + 8 * j; const LAS float* sp = scr + (8 * c) * 33 + n;
        u32x4 o; o.x = pk2(sp[0 * 33], sp[1 * 33]); o.y = pk2(sp[2 * 33], sp[3 * 33]); o.z = pk2(sp[4 * 33], sp[5 * 33]); o.w = pk2(sp[6 * 33], sp[7 * 33]);
        *(u32x4*)(J.dst + (size_t)n * J.kdst + 8 * c) = o; }
    LDS_WAIT(); asm volatile("" ::: "memory");
}
template <class Dec> __device__ __forceinline__ void tr_run(int first, int total, int stride, const Dec& dec, LAS float* scr, int lane) {
    int it = first; if (it >= total) return;
    TrJob J0 = dec(it), J1 = J0; f32x4 a[8], b[8];
    tr_load(a, J0, lane);
    const bool has1 = it + stride < total; if (has1) { J1 = dec(it + stride); tr_load(b, J1, lane); }
    for (;;) {
        const int n2 = it + 2 * stride; const bool more2 = n2 < total; TrJob J2 = J1; f32x4 c[8];
        if (more2) { J2 = dec(n2); tr_load(c, J2, lane); }
        tr_store(a, J0, scr, lane);
        if (it + stride >= total) break;
#pragma unroll
        for (int i = 0; i < 8; ++i) { a[i] = b[i]; b[i] = c[i]; }
        J0 = J1; J1 = J2; it += stride;
    }
}
struct DecDense { const float *w_in, *wa, *wb, *wo; bf16_t *Win_t, *Wa_t, *Wb_t, *Wout_t;
    __device__ __forceinline__ TrJob operator()(int r) const {
        if (r < 2560) { const int kb = r / 160, nb = r % 160, n0 = 32 * nb, ns = n0 < 1536 ? n0 : n0 + 16; return TrJob{w_in + (size_t)(64 * kb) * DIN + ns, Win_t + (size_t)n0 * D + 64 * kb, DIN, D}; }
        r -= 2560;
        if (r < 256) { const int kb = r / 32, nb = r % 32; return TrJob{wa + (size_t)(64 * kb) * D + 32 * nb, Wa_t + (size_t)(32 * nb) * 1024 + 64 * kb, D, 1024}; }
        r -= 256;
        if (r < 256) { const int kb = r / 32, nb = r % 32; return TrJob{wb + (size_t)(64 * kb) * D + 32 * nb, Wb_t + (size_t)(32 * nb) * 1024 + 512 + 64 * kb, D, 1024}; }
        r -= 256;
        { const int kb = r / 32, nb = r % 32; return TrJob{wo + (size_t)(64 * kb) * D + 32 * nb, Wout_t + (size_t)(32 * nb) * D + 64 * kb, D, D}; }
    } };
struct DecExp13 { const float *w1, *w3; bf16_t *W13_t;
    __device__ __forceinline__ TrJob operator()(int it) const {
        const int e = it >> 9, r = it & 511, kb = r >> 5, nb = r & 31, r0 = 32 * nb, pn = r0 >> 8, half = (r0 >> 7) & 1, jj = r0 & 127;
        const float* p1 = w1; const float* p3 = w3; asm volatile("" : "+s"(p1), "+s"(p3));
        return TrJob{(half ? p3 : p1) + (size_t)e * D * DEXP + (size_t)(64 * kb) * DEXP + 128 * pn + jj, W13_t + (size_t)e * 1024 * 1024 + (size_t)r0 * D + 64 * kb, DEXP, D};
    } };
struct DecExp2 { const float *w2; bf16_t *W2_t;
    __device__ __forceinline__ TrJob operator()(int it) const {
        const int e = it >> 8, r2 = it & 255, kb = r2 >> 5, nb = r2 & 31;
        return TrJob{w2 + (size_t)e * DEXP * D + (size_t)(64 * kb) * D + 32 * nb, W2_t + (size_t)e * 1024 * 512 + (size_t)(32 * nb) * DEXP + 64 * kb, D, DEXP};
    } };

constexpr int TBL_OFF = LDSCTL_OFF + 1024;
constexpr int TBL_CNT = 0, TBL_PAD = 32, TBL_TE = 96, TBL_RO = 320;
constexpr int GCNT_W = 8192;
constexpr int W2_EARLY = 10;
constexpr int ESEG = 32768;
__device__ __forceinline__ int build_moe_tables(LAS int* tb, const unsigned* gcnt, int tid) {
    if (tid < 32) tb[TBL_CNT + tid] = (int)gcnt[tid];
    __syncthreads();
    if (tid == 0) { int off = 0; for (int e = 0; e < 32; ++e) { tb[TBL_PAD + e] = off; off += ((tb[TBL_CNT + e] + 255) >> 8) << 8; } tb[TBL_PAD + 32] = off; }
    __syncthreads();
    if (tid < 32) { for (int t = tb[TBL_PAD + tid] >> 8; t < (tb[TBL_PAD + tid + 1] >> 8); ++t) tb[TBL_TE + t] = tid; }
    __syncthreads();
    return tb[TBL_PAD + 32] >> 8;
}
#define PHASE_LOCALS int tid_l = threadIdx.x; asm volatile("" : "+v"(tid_l)); int cb_l = blockIdx.x; asm volatile("" : "+s"(cb_l)); \
    const int tid = tid_l, lane = tid & 63, wave = __builtin_amdgcn_readfirstlane(tid >> 6), cb = cb_l, G = 256, gw = cb * NWAVES + wave, NGW = G * NWAVES; (void)lane; (void)gw; (void)NGW; (void)G;
template <int IDX> __device__ __forceinline__ const void* ldarg() {
    unsigned long long p;
    asm volatile("s_load_dwordx2 %0, %1, %2\n\ts_waitcnt lgkmcnt(0)" : "=s"(p) : "s"(__builtin_amdgcn_kernarg_segment_ptr()), "n"(IDX * 8) : "memory");
    return (const void*)(GAS const void*)p;
}
#define ARG_IN(i) (ldarg<(i)>())
#define ARG_WS ((unsigned char*)ldarg<29>())
#define XIN ((const float*)ARG_IN(I_X))
#define OUTP ((float*)ldarg<28>())
#define P_MODP ((float*)(ARG_WS + WS_MODP))
#define P_MODF ((float*)(ARG_WS + WS_MODF))
#define P_ALR ((float*)(ARG_WS + WS_ALR))
#define P_WIN ((bf16_t*)(ARG_WS + WS_WIN))
#define P_WA ((bf16_t*)(ARG_WS + WS_WA))
#define P_WB ((bf16_t*)(ARG_WS + WS_WB))
#define P_WOUT ((bf16_t*)(ARG_WS + WS_WOUT))
#define P_XN ((bf16_t*)(ARG_WS + WS_XN))
#define P_LOGA ((float*)(ARG_WS + WS_LOGA))
#define P_SCT ((float*)(ARG_WS + WS_SCT))
#define P_SPT ((bf16_t*)(ARG_WS + WS_SPT))
#define P_OC ((bf16_t*)(ARG_WS + WS_OC))
#define P_DEC ((float*)(ARG_WS + WS_DEC))
#define P_WRT ((float*)(ARG_WS + WS_WRT))
#define P_LRT ((float*)(ARG_WS + WS_LRT))
#define P_OB ((bf16_t*)(ARG_WS + WS_OB))
#define P_OA ((bf16_t*)(ARG_WS + WS_OA))
#define P_XS ((bf16_t*)(ARG_WS + WS_XS))
#define P_Y ((bf16_t*)(ARG_WS + WS_Y))
#define P_UGLA ((bf16_t*)(ARG_WS + WS_UGLA))
#define P_UDIFF ((bf16_t*)(ARG_WS + WS_UDIFF))
#define P_UGATE ((bf16_t*)(ARG_WS + WS_UGATE))
#define P_M1 ((bf16_t*)(ARG_WS + WS_M1))
#define P_MERGED ((bf16_t*)(ARG_WS + WS_MERGED))
#define P_H2 ((bf16_t*)(ARG_WS + WS_H2))
#define P_SLOTTOK ((int*)(ARG_WS + WS_SLOTTOK))
#define P_W13 ((bf16_t*)(ARG_WS + WS_W13))
#define P_W2 ((bf16_t*)(ARG_WS + WS_W2))
#define P_HMID ((bf16_t*)(ARG_WS + WS_HMID))
#define P_TOKE ((int*)(ARG_WS + WS_ROUTE + RT_TOKE))
#define P_TOKW ((float*)(ARG_WS + WS_ROUTE + RT_TOKW))
#define P_RANK ((int*)(ARG_WS + WS_ROUTE + RT_RANK))
#define P_SLOT ((int*)(ARG_WS + WS_ROUTE + RT_SLOT))
#define P_BLKCNT ((int*)(ARG_WS + WS_ROUTE + RT_BLKCNT))
#define P_TILEE ((int*)(ARG_WS + WS_ROUTE + RT_TILEE))
#define P_NT ((int*)(ARG_WS + WS_ROUTE + RT_NT))
template <int LO, int HI>
__global__ void __launch_bounds__(NTHR, 2) mk_fwd(Args args) {
    extern __shared__ __attribute__((aligned(16))) unsigned char lds_raw[];
    LAS unsigned char* lds = (LAS unsigned char*)lds_raw;
    volatile LAS unsigned* MISC = (volatile LAS unsigned*)(lds + MISC_OFF);
    unsigned* ctl = (unsigned*)(ARG_WS + WS_CTL);
    for (int u = threadIdx.x; u < (LDS_BYTES - LDSCTL_OFF) / 4; u += NTHR) ((LAS unsigned*)(lds + LDSCTL_OFF))[u] = 0u;
    __syncthreads();
    constexpr int lo = LO, hi = HI;
    XcdBarrier bar; bar.bar = ctl + CW_BAR; bar.x = 0; bar.st = nullptr;
    if constexpr (hi - lo > 1) bar = xcd_barrier_post(ctl + CW_BAR, MISC + 8);
#define IN(k) (lo <= (k) && (k) < hi)
#define SEAM(k) do { if constexpr (IN(k) && IN((k) + 1)) xcd_barrier(bar); } while (0)

    if constexpr (IN(0)) {
        asm volatile("; PHASE_BEGIN 0" ::: "memory");
        PHASE_LOCALS
        float* modp = P_MODP; bf16_t* Win_t = P_WIN; bf16_t* Wa_t = P_WA; bf16_t* Wb_t = P_WA; bf16_t* Wout_t = P_WOUT;
        const float* cvec = (const float*)ARG_IN(I_C); const float* ada_w = (const float*)ARG_IN(I_ADAW);
        const float* w_in = (const float*)ARG_IN(I_WIN);
        LAS float* scr = (LAS float*)(lds + wave * 16384);
        for (int r = gw; r < 768; r += NGW) {
            const int jc = r % 24, kc = r / 24, j = jc * 256 + lane * 4;
            f32x4 a0 = {0, 0, 0, 0}, a1 = a0, a2 = a0, a3 = a0;
#pragma unroll 8
            for (int kk = 0; kk < 32; ++kk) { const int k = kc * 32 + kk; const f32x4 w = *(const f32x4*)(ada_w + (size_t)k * NMOD + j);
                a0 += siluf_(cvec[k]) * w; a1 += siluf_(cvec[D + k]) * w; a2 += siluf_(cvec[2 * D + k]) * w; a3 += siluf_(cvec[3 * D + k]) * w; }
            *(f32x4*)(modp + (size_t)(kc * 4 + 0) * NMOD + j) = a0; *(f32x4*)(modp + (size_t)(kc * 4 + 1) * NMOD + j) = a1;
            *(f32x4*)(modp + (size_t)(kc * 4 + 2) * NMOD + j) = a2; *(f32x4*)(modp + (size_t)(kc * 4 + 3) * NMOD + j) = a3; }
        { const float* Wrg = (const float*)ARG_IN(I_RGW); const float* Wre = (const float*)ARG_IN(I_REW); float* WrT = P_WRT;
          for (int idx = cb * NTHR + tid; idx < 36 * D; idx += G * NTHR) { const int j = idx >> 10, k = idx & 1023; WrT[idx] = j < 4 ? Wrg[k * 4 + j] : Wre[k * 32 + (j - 4)]; } }
        { float* LrT = P_LRT;
          for (int idx = cb * NTHR + tid; idx < 16 * D; idx += G * NTHR) { const int r = idx >> 10, k = idx & 1023; LrT[idx] = w_in[(size_t)k * DIN + 1536 + r]; } }
        { const DecDense dec{w_in, (const float*)ARG_IN(I_WBA), (const float*)ARG_IN(I_WBB), (const float*)ARG_IN(I_WOUT), Win_t, Wa_t, Wb_t, Wout_t};
          tr_run(gw, 2560 + 256 + 256 + 512, NGW, dec, scr, lane); }
    }
    SEAM(0);

    if constexpr (IN(1)) {
        asm volatile("; PHASE_BEGIN 1" ::: "memory");
        PHASE_LOCALS
        const float* x = XIN; float* modp = P_MODP; float* modf = P_MODF; float* alr = P_ALR; bf16_t* XN = P_XN;
        const float* ada_b = (const float*)ARG_IN(I_ADAB); const float* g1 = (const float*)ARG_IN(I_N1G);
        LAS float* modS = (LAS float*)lds;
        const float* LrT = P_LRT;
        const int b = cb >> 6;
        { const int j = tid * 4; f32x4 pv[32];
#pragma unroll
            for (int kc = 0; kc < 32; ++kc) pv[kc] = *(const f32x4*)(modp + (size_t)(kc * 4 + b) * NMOD + j);
            float pm[32]; const int idx = cb * 96 + (tid < 96 ? tid : 0), bb = idx / NMOD, jm = idx % NMOD;
#pragma unroll
            for (int kc = 0; kc < 32; ++kc) pm[kc] = modp[(size_t)(kc * 4 + bb) * NMOD + jm];
            f32x4 s = *(const f32x4*)(ada_b + j);
#pragma unroll
            for (int kc = 0; kc < 32; ++kc) s += pv[kc];
            if (j >= D) s += 1.0f;
            *(LAS f32x4*)(modS + j) = s;
            float sm = ada_b[jm];
#pragma unroll
            for (int kc = 0; kc < 32; ++kc) sm += pm[kc];
            if (tid < 96) modf[idx] = sm; }
        f32x4 hv[8][4];
        const size_t m0 = (size_t)cb * 64 + wave * 8;
#pragma unroll
        for (int i = 0; i < 8; ++i) { const f32x4* xr = (const f32x4*)(x + (m0 + i) * D) + lane;
#pragma unroll
            for (int j = 0; j < 4; ++j) hv[i][j] = xr[64 * j]; }
        { LAS float* lrS = (LAS float*)(lds + 8192);
          f32x4 t8[8];
#pragma unroll
          for (int q = 0; q < 8; ++q) t8[q] = *(const f32x4*)(LrT + (size_t)(q * NTHR + tid) * 4);
#pragma unroll
          for (int q = 0; q < 8; ++q) *(LAS f32x4*)(lrS + (q * NTHR + tid) * 4) = t8[q]; }
        __syncthreads();
#pragma unroll
        for (int i = 0; i < 8; ++i) { float ss = 0.f;
#pragma unroll
            for (int j = 0; j < 4; ++j) ss += (hv[i][j].x * hv[i][j].x + hv[i][j].y * hv[i][j].y) + (hv[i][j].z * hv[i][j].z + hv[i][j].w * hv[i][j].w);
            const float rstd = rsqrtf(wave_sum(ss) * (1.f / D) + 1e-6f);
            unsigned long long* o8 = (unsigned long long*)(XN + (m0 + i) * D) + lane;
#pragma unroll
            for (int j = 0; j < 4; ++j) { const int k = 4 * lane + 256 * j; const f32x4 gg = *(const f32x4*)(g1 + k); const f32x4 sh = *(const LAS f32x4*)(modS + k); const f32x4 sc = *(const LAS f32x4*)(modS + D + k);
                hv[i][j] = hv[i][j] * rstd * gg * sc + sh;
                o8[64 * j] = (unsigned long long)pk2(hv[i][j].x, hv[i][j].y) | ((unsigned long long)pk2(hv[i][j].z, hv[i][j].w) << 32); } }
        { const LAS float* lrS = (const LAS float*)(lds + 8192);
#pragma unroll 2
          for (int r = 0; r < 16; ++r) {
            f32x4 w[4];
#pragma unroll
            for (int jj = 0; jj < 4; ++jj) w[jj] = *(const LAS f32x4*)(lrS + r * D + 4 * lane + 256 * jj);
            float a[8];
#pragma unroll
            for (int i = 0; i < 8; ++i) { f32x2 a2 = {0.f, 0.f};
#pragma unroll
                for (int jj = 0; jj < 4; ++jj) dot4_pk(a2, hv[i][jj], w[jj]);
                a[i] = a2.x + a2.y; }
            float y0, y1; reduce8(a, y0, y1);
            if ((lane & 15) == 0) { alr[(m0 + 2 * (lane >> 4)) * 16 + r] = y0; alr[(m0 + 2 * (lane >> 4) + 1) * 16 + r] = y1; }
          } }
    }
    SEAM(1);

    if constexpr (IN(2)) {
        asm volatile("; PHASE_BEGIN 2" ::: "memory");
        PHASE_LOCALS
        bf16_t* XN = P_XN; bf16_t* Win_t = P_WIN; bf16_t* Ugla = P_UGLA; bf16_t* Udiff = P_UDIFF; bf16_t* Ugate = P_UGATE;
        pg8::DenseOrder S; S.init(XN, Win_t, M, NPROJ, D, G, cb);
        pg8::EpiInProj E{Ugla, Udiff, Ugate};
        pg8::gemm_phase<pg8::EpiInProj, pg8::DenseOrder, true>(lds, D, S, E);
    }
    SEAM(2);

    if constexpr (IN(3)) {
        asm volatile("; PHASE_BEGIN 3" ::: "memory");
        PHASE_LOCALS
        bf16_t* Udiff = P_UDIFF; float* alr = P_ALR; float* LOGA = P_LOGA;
        const int* pos = (const int*)ARG_IN(I_POS); const float* qg = (const float*)ARG_IN(I_DQG); const float* kg = (const float*)ARG_IN(I_DKG);
        const float* aup = (const float*)ARG_IN(I_AUP); const float* ab = (const float*)ARG_IN(I_AB);
        const float invf = powf(500000.0f, -(float)(lane & 7) * 0.125f);
        const size_t m0 = (size_t)cb * 64 + wave * 8;
        u32x4 w0[8], w1[8]; float posv[8], av[8];
#pragma unroll
        for (int i = 0; i < 8; ++i) { const bf16_t* rowp = Udiff + (m0 + i) * 1536 + lane * 16; w0[i] = *(const u32x4*)rowp; w1[i] = *(const u32x4*)(rowp + 8);
            posv[i] = (float)pos[m0 + i]; av[i] = alr[(m0 + i) * 16 + (lane & 15)]; }
        float gain[16];
#pragma unroll
        for (int e = 0; e < 16; ++e) gain[e] = (lane < 32 ? qg : kg)[(lane & 3) * 16 + e];
        float au[16][4], abv[4];
#pragma unroll
        for (int q = 0; q < 4; ++q) { abv[q] = ab[lane + 64 * q];
#pragma unroll
            for (int rr = 0; rr < 16; ++rr) au[rr][q] = aup[rr * 256 + lane + 64 * q]; }
#pragma unroll
        for (int i = 0; i < 8; ++i) {
            float y[16];
            y[0] = lo_bf(w0[i].x); y[1] = hi_bf(w0[i].x); y[2] = lo_bf(w0[i].y); y[3] = hi_bf(w0[i].y); y[4] = lo_bf(w0[i].z); y[5] = hi_bf(w0[i].z); y[6] = lo_bf(w0[i].w); y[7] = hi_bf(w0[i].w);
            y[8] = lo_bf(w1[i].x); y[9] = hi_bf(w1[i].x); y[10] = lo_bf(w1[i].y); y[11] = hi_bf(w1[i].y); y[12] = lo_bf(w1[i].z); y[13] = hi_bf(w1[i].z); y[14] = lo_bf(w1[i].w); y[15] = hi_bf(w1[i].w);
            float ss = 0.f;
#pragma unroll
            for (int e = 0; e < 16; ++e) ss += y[e] * y[e];
            ss += __shfl_xor(ss, 1); ss += __shfl_xor(ss, 2);
            const float rstd = rsqrtf(ss * (1.f / 64.f) + 1e-6f);
#pragma unroll
            for (int e = 0; e < 16; ++e) y[e] = y[e] * rstd * gain[e];
            const float ang = posv[i] * invf; float sv, cv; sincosf(ang, &sv, &cv);
            float r[16];
#pragma unroll
            for (int e = 0; e < 8; ++e) { const float c_ = __shfl(cv, e), s_ = __shfl(sv, e); r[e] = y[e] * c_ - y[e + 8] * s_; r[e + 8] = y[e + 8] * c_ + y[e] * s_; }
            if ((lane & 3) == 0) {
#pragma unroll
                for (int e = 0; e < 16; ++e) y[e] = r[e]; }
            if (lane < 32) {
#pragma unroll
                for (int e = 0; e < 16; ++e) y[e] *= attn_body::C2; }
            u32x4 o0, o1; o0.x = pk2(y[0], y[1]); o0.y = pk2(y[2], y[3]); o0.z = pk2(y[4], y[5]); o0.w = pk2(y[6], y[7]); o1.x = pk2(y[8], y[9]); o1.y = pk2(y[10], y[11]); o1.z = pk2(y[12], y[13]); o1.w = pk2(y[14], y[15]);
            bf16_t* rowp = Udiff + (m0 + i) * 1536 + lane * 16;
            *(u32x4*)rowp = o0; *(u32x4*)(rowp + 8) = o1;
            float xv[4];
#pragma unroll
            for (int q = 0; q < 4; ++q) xv[q] = abv[q];
#pragma unroll
            for (int rr = 0; rr < 16; ++rr) { const float a = __shfl(av[i], rr);
#pragma unroll
                for (int q = 0; q < 4; ++q) xv[q] += a * au[rr][q]; }
#pragma unroll
            for (int q = 0; q < 4; ++q) { const float ls = fminf(xv[q], 0.f) - log1pf(__expf(-fabsf(xv[q]))); LOGA[(m0 + i) * 256 + lane + 64 * q] = ls * (1.f / 16.f); }
        }
        VM_WAIT(); __syncthreads();
        gla::chunk_state4(lds, cb >> 6, cb & 63, LOGA, P_UGLA, P_SCT, P_DEC, tid, lane, wave);
    }
    SEAM(3);

    if constexpr (IN(4)) {
        asm volatile("; PHASE_BEGIN 4" ::: "memory");
        PHASE_LOCALS
        { const float* SCt = P_SCT; const float* DEC = P_DEC; bf16_t* SPt = P_SPT;
          const int idx = cb * NTHR + tid, bh = idx >> 13, e = idx & 8191, k = e & 63; float st = 0.f;
#pragma unroll 16
          for (int n = 0; n < 64; ++n) { const size_t q = (size_t)bh * 64 + n; const float sc = SCt[q * 8192 + e], d = DEC[q * 64 + k]; SPt[q * 8192 + e] = (bf16_t)f2bf(st); st = st * d + sc; } }
        { const int vcu = (cb % 8) * (G / 8) + cb / 8;
          attn2::attn_phase<8>((char*)lds_raw, (const attn2::bf16*)P_UDIFF, (attn2::bf16*)P_OC, vcu); }
    }
    SEAM(4);

    if constexpr (IN(5)) {
        asm volatile("; PHASE_BEGIN 5" ::: "memory");
        PHASE_LOCALS
        { const float* lq1 = (const float*)ARG_IN(I_LQ1); const float* lk1 = (const float*)ARG_IN(I_LK1); const float* lq2 = (const float*)ARG_IN(I_LQ2); const float* lk2 = (const float*)ARG_IN(I_LK2);
          const float* og = (const float*)ARG_IN(I_DOG); const bf16_t* Oc = P_OC; bf16_t* OB = P_OB;
          const float lam = __expf(wave_sum(lq1[lane] * lk1[lane])) - __expf(wave_sum(lq2[lane] * lk2[lane])) + 0.2f;
          const size_t m0 = (size_t)cb * 64 + wave * 8; const int col0 = lane * 8;
          u32x4 av[8], bv[8];
#pragma unroll
          for (int i = 0; i < 8; ++i) { av[i] = *(const u32x4*)(Oc + (m0 + i) * 512 + col0); bv[i] = *(const u32x4*)(Oc + (size_t)M * 512 + (m0 + i) * 512 + col0); }
          float ogv[8];
#pragma unroll
          for (int e = 0; e < 8; ++e) ogv[e] = og[(col0 & 127) + e];
#pragma unroll
          for (int i = 0; i < 8; ++i) {
            const unsigned aw[4] = {av[i].x, av[i].y, av[i].z, av[i].w}, bw[4] = {bv[i].x, bv[i].y, bv[i].z, bv[i].w}; float o[8]; float ss = 0.f;
#pragma unroll
            for (int e = 0; e < 4; ++e) { o[2 * e] = lo_bf(aw[e]) - lam * lo_bf(bw[e]); o[2 * e + 1] = hi_bf(aw[e]) - lam * hi_bf(bw[e]); ss += o[2 * e] * o[2 * e] + o[2 * e + 1] * o[2 * e + 1]; }
            ss += __shfl_xor(ss, 1); ss += __shfl_xor(ss, 2); ss += __shfl_xor(ss, 4); ss += __shfl_xor(ss, 8);
            const float rstd = rsqrtf(ss * (1.f / 128.f) + 1e-6f) * 0.8f; unsigned ow[4];
#pragma unroll
            for (int e = 0; e < 4; ++e) ow[e] = pk2(o[2 * e] * rstd * ogv[2 * e], o[2 * e + 1] * rstd * ogv[2 * e + 1]);
            *(u32x4*)(OB + (m0 + i) * 1024 + 512 + col0) = (u32x4){ow[0], ow[1], ow[2], ow[3]}; } }
        __syncthreads();
        gla::chunk_out4(lds, cb >> 6, cb & 63, P_LOGA, P_UGLA, P_SPT, (const float*)ARG_IN(I_GOG), P_OA, tid, lane, wave);
    }
    SEAM(5);

    if constexpr (IN(6)) {
        asm volatile("; PHASE_BEGIN 6" ::: "memory");
        PHASE_LOCALS
        bf16_t* OAB = P_OA; bf16_t* Wab_t = P_WA; bf16_t* Ugate = P_UGATE; bf16_t* MERGED = P_MERGED;
        pg8::DenseOrder S; S.init(OAB, Wab_t, M, D, D, G, cb); pg8::EpiBranch E{Ugate, MERGED};
        pg8::gemm_phase<pg8::EpiBranch, pg8::DenseOrder, true, false, 8>(lds, D, S, E);
    }
    SEAM(6);

    if constexpr (IN(7)) {
        asm volatile("; PHASE_BEGIN 7" ::: "memory");
        PHASE_LOCALS
        const float* x = XIN; float* out = OUTP; float* modf = P_MODF; bf16_t* MERGED = P_MERGED; bf16_t* Wout_t = P_WOUT;
        pg8::DenseOrder S; S.init(MERGED, Wout_t, M, D, D, G, cb); pg8::EpiWout E{x, modf, (bf16_t*)out};
        pg8::gemm_phase<pg8::EpiWout, pg8::DenseOrder, true>(lds, D, S, E);
    }
    SEAM(7);

    if constexpr (IN(8)) {
        asm volatile("; PHASE_BEGIN 8" ::: "memory");
        PHASE_LOCALS
        float* out = OUTP; float* modf = P_MODF; bf16_t* H2 = P_H2; bf16_t* W13_t = P_W13; int* tok_e = P_TOKE; float* tok_w = P_TOKW; int* tok_rank = P_RANK; int* slot_tok = P_SLOTTOK;
        const float* g2 = (const float*)ARG_IN(I_N2G); const float* brg = (const float*)ARG_IN(I_RGB); const float* bre = (const float*)ARG_IN(I_REB); const float* WrT = P_WRT;
        LAS float* modS = (LAS float*)lds;
        LAS int* eS = (LAS int*)(lds + 8192);
        LAS float* LG = (LAS float*)(lds + 8192 + 1024);
        LAS float* WS = (LAS float*)(lds + 24576);
        const int b = cb >> 6;
        f32x4 hv[8][4];
        const size_t m0 = (size_t)cb * 64 + wave * 8;
#pragma unroll
        for (int i = 0; i < 8; ++i) { const bf16_t* xr = (const bf16_t*)out + (m0 + i) * 2048 + 1024 + 4 * lane;
#pragma unroll
            for (int j = 0; j < 4; ++j) { const u32x2 w = *(const u32x2*)(xr + 256 * j); hv[i][j] = (f32x4){lo_bf(w.x), hi_bf(w.x), lo_bf(w.y), hi_bf(w.y)}; } }
        for (int j = tid; j < 2048; j += NTHR) modS[j] = modf[(size_t)b * NMOD + 3 * D + j] + (j >= D ? 1.0f : 0.f);
#pragma unroll
        for (int q = 0; q < 10; ++q) *(LAS f32x4*)(WS + (q * NTHR + tid) * 4) = *(const f32x4*)(WrT + (size_t)(q * NTHR + tid) * 4);
        __syncthreads();
#pragma unroll
        for (int i = 0; i < 8; ++i) { float ss = 0.f;
#pragma unroll
            for (int j = 0; j < 4; ++j) ss += (hv[i][j].x * hv[i][j].x + hv[i][j].y * hv[i][j].y) + (hv[i][j].z * hv[i][j].z + hv[i][j].w * hv[i][j].w);
            const float rstd = rsqrtf(wave_sum(ss) * (1.f / D) + 1e-6f);
            unsigned long long* o8 = (unsigned long long*)(H2 + (m0 + i) * D) + lane;
#pragma unroll
            for (int j = 0; j < 4; ++j) { const int k = 4 * lane + 256 * j; const f32x4 gg = *(const f32x4*)(g2 + k); const f32x4 sh = *(const LAS f32x4*)(modS + k); const f32x4 sc = *(const LAS f32x4*)(modS + D + k);
                hv[i][j] = hv[i][j] * rstd * gg * sc + sh;
                o8[64 * j] = (unsigned long long)pk2(hv[i][j].x, hv[i][j].y) | ((unsigned long long)pk2(hv[i][j].z, hv[i][j].w) << 32); } }
        const float biasv = lane < 4 ? brg[lane] : (lane < 36 ? bre[lane - 4] : 0.f);
        LAS float* lgw = LG + wave * 320;
#define RT_STEP(jl, jq) do { f32x4 W[4]; _Pragma("unroll") for (int jj = 0; jj < 4; ++jj) W[jj] = *(const LAS f32x4*)(WS + (jl) * D + 4 * lane + 256 * jj); \
            float a[8]; _Pragma("unroll") for (int i = 0; i < 8; ++i) { f32x2 a2 = {0.f, 0.f}; \
                _Pragma("unroll") for (int jj = 0; jj < 4; ++jj) dot4_pk(a2, hv[i][jj], W[jj]); a[i] = a2.x + a2.y; } \
            float y0, y1; reduce8(a, y0, y1); const float bj = __shfl(biasv, (jq)); \
            if ((lane & 15) == 0) { lgw[(2 * (lane >> 4)) * 40 + (jq)] = y0 + bj; lgw[(2 * (lane >> 4) + 1) * 40 + (jq)] = y1 + bj; } } while (0)
#pragma unroll 2
        for (int jx = 0; jx < 20; ++jx) RT_STEP(jx, jx);
        __syncthreads();
#pragma unroll
        for (int q = 0; q < 8; ++q) *(LAS f32x4*)(WS + (q * NTHR + tid) * 4) = *(const f32x4*)(WrT + (size_t)20 * D + (size_t)(q * NTHR + tid) * 4);
        __syncthreads();
#pragma unroll 2
        for (int jx = 0; jx < 16; ++jx) RT_STEP(jx, jx + 20);
#undef RT_STEP
        LDS_WAIT();
        if (lane < 8) {
            const LAS float* lr = lgw + lane * 40; const int tl = wave * 8 + lane;
            const float lg0 = lr[0], lg1 = lr[1], lg2 = lr[2], lg3 = lr[3];
            int gi = 0; float gm = lg0; if (lg1 > gm) { gm = lg1; gi = 1; } if (lg2 > gm) { gm = lg2; gi = 2; } if (lg3 > gm) { gm = lg3; gi = 3; }
            const float ptop = 1.0f / (__expf(lg0 - gm) + __expf(lg1 - gm) + __expf(lg2 - gm) + __expf(lg3 - gm));
            float el[8];
#pragma unroll
            for (int j = 0; j < 8; ++j) el[j] = lr[4 + gi * 8 + j];
            int j0 = 0; float e0 = el[0];
#pragma unroll
            for (int j = 1; j < 8; ++j) if (el[j] > e0) { e0 = el[j]; j0 = j; }
            int j1 = -1; float e1 = -3.0e38f;
#pragma unroll
            for (int j = 0; j < 8; ++j) if (j != j0 && el[j] > e1) { e1 = el[j]; j1 = j; }
            const float t = __expf(e1 - e0), w0 = ptop / (1.0f + t), w1 = ptop * t / (1.0f + t);
            eS[2 * tl] = gi * 8 + j0; eS[2 * tl + 1] = gi * 8 + j1; tok_w[(m0 + lane) * 2] = w0; tok_w[(m0 + lane) * 2 + 1] = w1;
        }
        __syncthreads();
        {
            LAS int* baseS = eS + 128; LAS int* cnt0S = eS + 160;
            int e = 0, rank = 0, myc = 0;
            if (tid < 128) { e = eS[tid]; const unsigned long long lt = (1ull << lane) - 1ull;
#pragma unroll 4
                for (int ex = 0; ex < 32; ++ex) { const unsigned long long mk = __ballot(e == ex); if (e == ex) rank = __popcll(mk & lt); if (lane == ex) myc = __popcll(mk); }
                if (wave == 0 && lane < 32) cnt0S[lane] = myc; }
            __syncthreads();
            if (tid >= 64 && tid < 128) { rank += cnt0S[e];
                if (lane < 32) { const int cnt = myc + cnt0S[lane];
                    baseS[lane] = cnt ? (int)__hip_atomic_fetch_add((unsigned*)(ARG_WS + WS_CTL) + GCNT_W + lane, (unsigned)cnt, __ATOMIC_RELAXED, __HIP_MEMORY_SCOPE_AGENT) : 0; } }
            __syncthreads();
            if (tid < 128) { const int g = baseS[e] + rank; tok_e[(size_t)cb * 128 + tid] = e; tok_rank[(size_t)cb * 128 + tid] = g; slot_tok[(size_t)e * ESEG + g] = cb * 64 + (tid >> 1); }
        }
        __syncthreads();
        { const DecExp13 dec{(const float*)ARG_IN(I_EW1), (const float*)ARG_IN(I_EW3), W13_t};
          tr_run(gw, NEXP * 512, NGW, dec, (LAS float*)(lds + wave * 16384), lane);
          const DecExp2 dec2{(const float*)ARG_IN(I_EW2), P_W2};
          tr_run(gw, W2_EARLY * 256, NGW, dec2, (LAS float*)(lds + wave * 16384), lane); }
    }
    SEAM(8);

    if constexpr (IN(9)) {
        asm volatile("; PHASE_BEGIN 9" ::: "memory");
        PHASE_LOCALS
        bf16_t* H2 = P_H2; bf16_t* W13_t = P_W13; bf16_t* HMID = P_HMID; const int* slot_tok = P_SLOTTOK;
        LAS int* tb = (LAS int*)(lds + TBL_OFF);
        const int ntm = __builtin_amdgcn_readfirstlane(build_moe_tables(tb, (const unsigned*)(ARG_WS + WS_CTL) + GCNT_W, tid));
        pg8::MoeOrder S; S.init(H2, W13_t, tb + TBL_TE, (const LAS unsigned*)(tb + TBL_RO), ntm, D, (size_t)1024 * 1024 * 2, G, cb); pg8::EpiUp E{HMID};
        { pg8::Unit u;
          for (int i = 0; i < 3; ++i) if (S.next(i, u) && tid < 256) { const int e = u.aux, idx = u.pm * 256 - tb[TBL_PAD + e] + tid;
              const int tok = idx < tb[TBL_CNT + e] ? slot_tok[(size_t)e * ESEG + idx] : 0; tb[TBL_RO + i * 256 + tid] = tok * (D * 2); } }
        __syncthreads();
        pg8::gemm_phase<pg8::EpiUp, pg8::MoeOrder, true, true>(lds, D, S, E);
        { const int nwg = ntm * 4, first_idle = nwg > 512 ? nwg - 512 : 0;
          if (cb >= first_idle) { const DecExp2 dec{(const float*)ARG_IN(I_EW2), P_W2}; const int nidle = G - first_idle;
              tr_run(W2_EARLY * 256 + (cb - first_idle) * NWAVES + wave, NEXP * 256, nidle * NWAVES, dec, (LAS float*)(lds + wave * 16384), lane); } }
    }
    SEAM(9);

    if constexpr (IN(10)) {
        asm volatile("; PHASE_BEGIN 10" ::: "memory");
        PHASE_LOCALS
        bf16_t* HMID = P_HMID; bf16_t* W2_t = P_W2; bf16_t* Y = P_Y;
        LAS int* tb = (LAS int*)(lds + TBL_OFF);
        const int ntm = __builtin_amdgcn_readfirstlane(build_moe_tables(tb, (const unsigned*)(ARG_WS + WS_CTL) + GCNT_W, tid));
        pg8::MoeOrder S; S.init(HMID, W2_t, tb + TBL_TE, nullptr, ntm, DEXP, (size_t)1024 * 512 * 2, G, cb); pg8::EpiPlain E{Y, D};
        pg8::gemm_phase<pg8::EpiPlain, pg8::MoeOrder, true>(lds, DEXP, S, E);
    }
    SEAM(10);

    if constexpr (IN(11)) {
        asm volatile("; PHASE_BEGIN 11" ::: "memory");
        PHASE_LOCALS
        float* out = OUTP; float* modf = P_MODF; bf16_t* Y = P_Y; const int* tok_e = P_TOKE; const int* tok_rank = P_RANK; float* tok_w = P_TOKW;
        LAS int* tb = (LAS int*)(lds + TBL_OFF);
        (void)build_moe_tables(tb, (const unsigned*)(ARG_WS + WS_CTL) + GCNT_W, tid);
        const size_t m0 = (size_t)cb * 64 + wave * 8; const float* g2p = modf + (size_t)(cb >> 6) * NMOD + 5 * D;
        int s0[8], s1[8]; float w0[8], w1[8];
#pragma unroll
        for (int i = 0; i < 8; ++i) { const int e0 = __builtin_amdgcn_readfirstlane(tok_e[(m0 + i) * 2]), e1 = __builtin_amdgcn_readfirstlane(tok_e[(m0 + i) * 2 + 1]);
            s0[i] = tb[TBL_PAD + e0] + tok_rank[(m0 + i) * 2]; s1[i] = tb[TBL_PAD + e1] + tok_rank[(m0 + i) * 2 + 1]; w0[i] = tok_w[(m0 + i) * 2]; w1[i] = tok_w[(m0 + i) * 2 + 1]; }
        f32x4 gv[4];
#pragma unroll
        for (int j = 0; j < 4; ++j) gv[j] = *(const f32x4*)(g2p + 4 * lane + 256 * j);
        f32x4 xa[2][4], xb[2][4]; u32x2 ya0[2][4], ya1[2][4], yb0[2][4], yb1[2][4];
#define P11_LOAD(XV, Y0, Y1, bb) do { _Pragma("unroll") for (int i2 = 0; i2 < 2; ++i2) { const int i = (bb) * 2 + i2; \
            _Pragma("unroll") for (int j = 0; j < 4; ++j) { const int k = 4 * lane + 256 * j; { const u32x2 w_ = *(const u32x2*)((const bf16_t*)out + (m0 + i) * 2048 + 1024 + k); XV[i2][j] = (f32x4){lo_bf(w_.x), hi_bf(w_.x), lo_bf(w_.y), hi_bf(w_.y)}; } \
                Y0[i2][j] = *(const u32x2*)(Y + (size_t)s0[i] * D + k); Y1[i2][j] = *(const u32x2*)(Y + (size_t)s1[i] * D + k); } } } while (0)
#define P11_DO(XV, Y0, Y1, bb) do { _Pragma("unroll") for (int i2 = 0; i2 < 2; ++i2) { const int i = (bb) * 2 + i2; \
            _Pragma("unroll") for (int j = 0; j < 4; ++j) { const int k = 4 * lane + 256 * j; f32x4 o; \
                o.x = XV[i2][j].x + gv[j].x * (w0[i] * lo_bf(Y0[i2][j].x) + w1[i] * lo_bf(Y1[i2][j].x)); o.y = XV[i2][j].y + gv[j].y * (w0[i] * hi_bf(Y0[i2][j].x) + w1[i] * hi_bf(Y1[i2][j].x)); \
                o.z = XV[i2][j].z + gv[j].z * (w0[i] * lo_bf(Y0[i2][j].y) + w1[i] * lo_bf(Y1[i2][j].y)); o.w = XV[i2][j].w + gv[j].w * (w0[i] * hi_bf(Y0[i2][j].y) + w1[i] * hi_bf(Y1[i2][j].y)); \
                *(f32x4*)(out + (m0 + i) * D + k) = o; } } } while (0)
        P11_LOAD(xa, ya0, ya1, 0);
        P11_LOAD(xb, yb0, yb1, 1); P11_DO(xa, ya0, ya1, 0);
        P11_LOAD(xa, ya0, ya1, 2); P11_DO(xb, yb0, yb1, 1);
        P11_LOAD(xb, yb0, yb1, 3); P11_DO(xa, ya0, ya1, 2);
        P11_DO(xb, yb0, yb1, 3);
#undef P11_LOAD
#undef P11_DO
    }
#undef IN
#undef SEAM
}

constexpr int NPHASE = 12;
template <int LO, int HI> static void launch_range(const Args& a, hipStream_t stream) {
    static bool attr = false;
    if (!attr) { (void)hipFuncSetAttribute((const void*)mk_fwd<LO, HI>, hipFuncAttributeMaxDynamicSharedMemorySize, LDS_BYTES); attr = true; }
    hipLaunchKernelGGL((mk_fwd<LO, HI>), dim3(256), dim3(NTHR), LDS_BYTES, stream, a);
}
extern "C" void kernel_launch(void* const* d_in, const int* in_sizes, int n_in, void* d_out, int out_size, void* d_ws, size_t ws_size, hipStream_t stream) {
    static int ok = 0;
    if (ok == 0) {
        if (n_in != 28 || out_size != M * D || ws_size < WS_END) { fprintf(stderr, "kernel_launch: unexpected shapes (n_in %d, out %d, ws %zu < %zu)\n", n_in, out_size, ws_size, (size_t)WS_END); ok = -1; return; }
        ok = 1;
    }
    if (ok < 0) return;
    (void)hipMemsetAsync((char*)d_ws + WS_CTL, 0, CTL_ZERO_BYTES, stream);
    Args a{};
    for (int i = 0; i < 28; ++i) a.in[i] = d_in[i];
    a.out = (float*)d_out; a.ws = (unsigned char*)d_ws; a.ph_lo = 0; a.ph_hi = NPHASE;
#if MK_ONE_LAUNCH
    launch_range<0, NPHASE>(a, stream);
#else
    launch_range<0, 1>(a, stream); launch_range<1, 2>(a, stream); launch_range<2, 3>(a, stream); launch_range<3, 4>(a, stream);
    launch_range<4, 5>(a, stream); launch_range<5, 6>(a, stream); launch_range<6, 7>(a, stream); launch_range<7, 8>(a, stream);
    launch_range<8, 9>(a, stream); launch_range<9, 10>(a, stream); launch_range<10, 11>(a, stream); launch_range<11, 12>(a, stream);
#endif
}
```

```cpp
#include <hip/hip_runtime.h>
#include <hip/hip_bf16.h>
#include <cstdio>
#include <cstdint>

#ifndef MK_ONE_LAUNCH
#define MK_ONE_LAUNCH 1
#endif

#define LAS __attribute__((address_space(3)))
#define GAS __attribute__((address_space(1)))
typedef unsigned short bf16_t;
typedef short bf16x8 __attribute__((ext_vector_type(8)));
typedef float f32x4 __attribute__((ext_vector_type(4)));
typedef float f32x2 __attribute__((ext_vector_type(2)));
typedef unsigned u32x4 __attribute__((ext_vector_type(4)));
typedef unsigned u32x2 __attribute__((ext_vector_type(2)));

constexpr int NB = 4, SEQ = 4096, D = 1024, M = NB * SEQ;
constexpr int DIN = 5136, NPROJ = 5120;
constexpr int NEXP = 32, DEXP = 512;
constexpr int PMAX = 40960;
constexpr int NMOD = 6 * D;

constexpr size_t MiB = 1u << 20;
constexpr size_t WS_CTL = 0, CTL_ZERO_BYTES = 1 * MiB;
constexpr size_t WS_MODP = 1 * MiB;
constexpr size_t WS_MODF = 4 * MiB;
constexpr size_t WS_ALR = 5 * MiB;
constexpr size_t WS_ROUTE = 6 * MiB;
constexpr size_t WS_WIN = 8 * MiB;
constexpr size_t WS_WA = 18 * MiB, WS_WB = 19 * MiB, WS_WOUT = 20 * MiB;
constexpr size_t RA = 22 * MiB;
constexpr size_t RB = 118 * MiB;
constexpr size_t WS_END = 278 * MiB;
constexpr size_t WS_XN = RA;
constexpr size_t WS_LOGA = RA;
constexpr size_t WS_SCT = RA + 16 * MiB;
constexpr size_t WS_SPT = RA + 48 * MiB;
constexpr size_t WS_OC = RA + 64 * MiB;
constexpr size_t WS_DEC = 7 * MiB;
constexpr size_t WS_WRT = 7 * MiB + 512 * 1024;
constexpr size_t WS_LRT = 7 * MiB + 768 * 1024;
constexpr size_t WS_OA = RB + 48 * MiB;
constexpr size_t WS_OB = WS_OA;
constexpr size_t WS_XS = RA;
constexpr size_t WS_Y = RA;
constexpr size_t WS_UGLA = RB;
constexpr size_t WS_UDIFF = RB + 48 * MiB;
constexpr size_t WS_UGATE = RB + 96 * MiB;
constexpr size_t WS_M1 = RA;
constexpr size_t WS_MERGED = RB;
constexpr size_t WS_H2 = RA;
constexpr size_t WS_SLOTTOK = RA + 84 * MiB;
constexpr size_t WS_W13 = RB + 64 * MiB;
constexpr size_t WS_W2 = RB + 128 * MiB;
constexpr size_t WS_HMID = RB;
constexpr size_t RT_TOKE = 0, RT_TOKW = 131072, RT_RANK = 262144, RT_SLOT = 393216, RT_BLKCNT = 524288, RT_TILEE = 557056, RT_NT = 561152;
constexpr int CW_BAR = 4096;

constexpr int RING_BYTES = 131072;
constexpr int LDSCTL_OFF = RING_BYTES, MISC_OFF = LDSCTL_OFF + 320;
constexpr int LDS_BYTES = 147456;
constexpr int NWAVES = 8, NTHR = 512;

__device__ __forceinline__ float bf2f(bf16_t h) { return __uint_as_float((unsigned)h << 16); }
__device__ __forceinline__ unsigned f2bf(float f) { unsigned u = __float_as_uint(f); return (u + 0x7fffu + ((u >> 16) & 1u)) >> 16; }
typedef __bf16 bf16x2_t __attribute__((ext_vector_type(2)));
__device__ __forceinline__ unsigned pk2(float lo, float hi) { f32x2 v = {lo, hi}; bf16x2_t b = __builtin_convertvector(v, bf16x2_t); return __builtin_bit_cast(unsigned, b); }
__device__ __forceinline__ float lo_bf(unsigned w) { return __uint_as_float(w << 16); }
__device__ __forceinline__ float hi_bf(unsigned w) { return __uint_as_float(w & 0xffff0000u); }
#define DPP_ADD(v, ctrl) ((v) + __builtin_bit_cast(float, __builtin_amdgcn_update_dpp(0, __builtin_bit_cast(int, (v)), (ctrl), 0xF, 0xF, true)))
__device__ __forceinline__ float wave_sum(float v) {
    v = DPP_ADD(v, 0xB1); v = DPP_ADD(v, 0x4E); v = DPP_ADD(v, 0x141); v = DPP_ADD(v, 0x140);
    { const unsigned u = __float_as_uint(v); auto r = __builtin_amdgcn_permlane16_swap(u, u, false, false); v = __uint_as_float(r[0]) + __uint_as_float(r[1]); }
    { const unsigned u = __float_as_uint(v); auto r = __builtin_amdgcn_permlane32_swap(u, u, false, false); v = __uint_as_float(r[0]) + __uint_as_float(r[1]); }
    return v;
}
__device__ __forceinline__ void dot4_pk(f32x2& acc, const f32x4& h, const f32x4& w) { acc += (f32x2){h.x, h.y} * (f32x2){w.x, w.y}; acc += (f32x2){h.z, h.w} * (f32x2){w.z, w.w}; }
__device__ __forceinline__ float swapadd32(float x, float y) { auto r = __builtin_amdgcn_permlane32_swap(__float_as_uint(x), __float_as_uint(y), false, false); return __uint_as_float(r[0]) + __uint_as_float(r[1]); }
__device__ __forceinline__ float swapadd16(float x, float y) { auto r = __builtin_amdgcn_permlane16_swap(__float_as_uint(x), __float_as_uint(y), false, false); return __uint_as_float(r[0]) + __uint_as_float(r[1]); }
__device__ __forceinline__ void reduce8(const float (&a)[8], float& y0, float& y1) {
    const float x0 = swapadd32(a[0], a[4]), x1 = swapadd32(a[1], a[5]), x2 = swapadd32(a[2], a[6]), x3 = swapadd32(a[3], a[7]);
    y0 = swapadd16(x0, x2); y1 = swapadd16(x1, x3);
    y0 = DPP_ADD(y0, 0xB1); y0 = DPP_ADD(y0, 0x4E); y0 = DPP_ADD(y0, 0x141); y0 = DPP_ADD(y0, 0x140);
    y1 = DPP_ADD(y1, 0xB1); y1 = DPP_ADD(y1, 0x4E); y1 = DPP_ADD(y1, 0x141); y1 = DPP_ADD(y1, 0x140);
}
__device__ __forceinline__ float wave_max(float v) {
#pragma unroll
    for (int o = 1; o < 64; o <<= 1) v = fmaxf(v, __shfl_xor(v, o));
    return v;
}
__device__ __forceinline__ float frcp_(float x) { return __builtin_amdgcn_rcpf(x); }
__device__ __forceinline__ float sigmoidf_(float x) { return frcp_(1.0f + __expf(-x)); }
__device__ __forceinline__ float siluf_(float x) { return x * frcp_(1.0f + __expf(-x)); }
#define LDS_WAIT() asm volatile("s_waitcnt lgkmcnt(0)" ::: "memory")
#define VM_WAIT() asm volatile("s_waitcnt vmcnt(0)" ::: "memory")

namespace pg8 {
constexpr int BM = 256, BK = 64, HALF = 128, HTB = HALF * BK * 2, STAGE_BYTES = 8 * HTB, NXCD = 8, WGM = 8;
__host__ __device__ __forceinline__ int lds_byte(int r, int c) { const int st = (r >> 4) * 2 + (c >> 5), rr = r & 15, cc = c & 31, ob = rr * 64 + cc * 2; return st * 1024 + (ob ^ (((ob >> 9) & 1) << 5)); }
__host__ __device__ __forceinline__ void stage_rc(int b, int& R, int& C) { const int st = b / 1024, sb = b % 1024, swz = sb ^ (((sb >> 9) & 1) << 5); R = (st >> 1) * 16 + swz / 64; C = (st & 1) * 32 + (swz % 64) / 2; }
__host__ __device__ __forceinline__ int perm32(int rho) { const int n = rho >> 4, i = rho & 15; return 8 * (i >> 2) + 4 * n + (i & 3); }

struct Unit { int pm, pn, aux, ord; };

__device__ __forceinline__ int xcd_swizzle(int wgid, int nwg) { const int q = nwg / NXCD, r = nwg % NXCD, xcd = wgid % NXCD, off = wgid / NXCD; return (xcd < r ? xcd * (q + 1) : r * (q + 1) + (xcd - r) * q) + off; }

struct DenseOrder {
    const char* A; const char* Bt; size_t tstep; int nM, nN, nwg, G, c;
    __device__ __forceinline__ void init(const void* A_, const void* Bt_, int M_, int N_, int K_, int G_, int c_) { A = (const char*)A_; Bt = (const char*)Bt_; tstep = (size_t)BM * K_ * 2; nM = M_ / BM; nN = N_ / BM; nwg = nM * nN; G = G_; c = c_; }
    __device__ __forceinline__ bool next(int i, Unit& u) const {
        const long L = (long)i * G + c; if (L >= nwg) return false;
        const int wgid = xcd_swizzle((int)L, nwg);
        const int nig = WGM * nN, gid = wgid / nig, fm = gid * WGM, gsz = (nM - fm) < WGM ? (nM - fm) : WGM;
        u.pm = fm + ((wgid % nig) % gsz); u.pn = (wgid % nig) / gsz; u.aux = 0; u.ord = i; return true;
    }
    __device__ __forceinline__ const char* a_ptr(const Unit& u) const { return A + (size_t)u.pm * tstep; }
    __device__ __forceinline__ const char* b_ptr(const Unit& u) const { return Bt + (size_t)u.pn * tstep; }
    __device__ __forceinline__ unsigned row_off(const Unit&, int) const { return 0u; }
};
struct MoeOrder {
    const char* A; const char* W; const LAS int* tile_e; const LAS unsigned* rowoff; size_t tstep, estride; int nwg, G, c;
    __device__ __forceinline__ void init(const void* A_, const void* W_, const LAS int* te, const LAS unsigned* ro, int ntm, int K_, size_t estride_, int G_, int c_) { A = (const char*)A_; W = (const char*)W_; tile_e = te; rowoff = ro; tstep = (size_t)BM * K_ * 2; estride = estride_; nwg = ntm * 4; G = G_; c = c_; }
    __device__ __forceinline__ bool next(int i, Unit& u) const {
        const long L = (long)i * G + c; if (L >= nwg) return false;
        const int wgid = xcd_swizzle((int)L, nwg);
        u.pm = wgid >> 2; u.pn = wgid & 3; u.aux = __builtin_amdgcn_readfirstlane(tile_e[u.pm]); u.ord = i; return true;
    }
    __device__ __forceinline__ const char* a_ptr(const Unit& u) const { return rowoff ? A : A + (size_t)u.pm * tstep; }
    __device__ __forceinline__ const char* b_ptr(const Unit& u) const { return W + (size_t)u.aux * estride + (size_t)u.pn * tstep; }
    __device__ __forceinline__ unsigned row_off(const Unit& u, int r) const { return rowoff[u.ord * 256 + r]; }
};
__device__ __forceinline__ u32x4 pack8(const f32x4& v0, const f32x4& v1) { u32x4 w; w.x = pk2(v0[0], v0[1]); w.y = pk2(v0[2], v0[3]); w.z = pk2(v1[0], v1[1]); w.w = pk2(v1[2], v1[3]); return w; }

struct EpiInProj {
    static constexpr bool PERM = true, AFTER_DRAIN = false;
    bf16_t *Ugla, *Udiff, *Ugate;
    __device__ __forceinline__ void operator()(const f32x4 (&acc)[2][2][4][2], const Unit& u, int wr, int wc, int fr, int fq) const {
        bf16_t* base; int ldc, colt;
        if (u.pn < 6) { base = Ugla; ldc = 1536; colt = u.pn * 256; } else if (u.pn < 12) { base = Udiff; ldc = 1536; colt = (u.pn - 6) * 256; } else { base = Ugate; ldc = 2048; colt = (u.pn - 12) * 256; }
        const int row0 = u.pm * BM + wr * 64 + fr, col0 = colt + wc * 32 + 8 * fq;
#pragma unroll
        for (int ai = 0; ai < 2; ++ai)
#pragma unroll
            for (int m = 0; m < 4; ++m) { bf16_t* rowp = base + (size_t)(row0 + ai * HALF + m * 16) * ldc + col0;
#pragma unroll
                for (int bj = 0; bj < 2; ++bj) *(u32x4*)(rowp + bj * HALF) = pack8(acc[ai][bj][m][0], acc[ai][bj][m][1]); }
    }
};
struct EpiPlain {
    static constexpr bool PERM = true, AFTER_DRAIN = false;
    bf16_t* O; int ldc;
    __device__ __forceinline__ void operator()(const f32x4 (&acc)[2][2][4][2], const Unit& u, int wr, int wc, int fr, int fq) const {
        const int row0 = u.pm * BM + wr * 64 + fr, col0 = u.pn * BM + wc * 32 + 8 * fq;
#pragma unroll
        for (int ai = 0; ai < 2; ++ai)
#pragma unroll
            for (int m = 0; m < 4; ++m) { bf16_t* rowp = O + (size_t)(row0 + ai * HALF + m * 16) * ldc + col0;
#pragma unroll
                for (int bj = 0; bj < 2; ++bj) *(u32x4*)(rowp + bj * HALF) = pack8(acc[ai][bj][m][0], acc[ai][bj][m][1]); }
    }
};
struct EpiBranch {
    static constexpr bool PERM = true, AFTER_DRAIN = false;
    const bf16_t* gate; bf16_t* out;
    __device__ __forceinline__ void mid(f32x4 (&acc)[2][2][4][2], const Unit& u, int wr, int wc, int fr, int fq) const {
        int row0 = u.pm * BM + wr * 64 + fr, col0 = u.pn * BM + wc * 32 + 8 * fq;
        asm volatile("" : "+v"(row0), "+v"(col0));
#pragma unroll
        for (int ai = 0; ai < 2; ++ai)
#pragma unroll
            for (int m = 0; m < 4; ++m) { const size_t r = (size_t)(row0 + ai * HALF + m * 16);
#pragma unroll
                for (int bj = 0; bj < 2; ++bj) { const int c = col0 + bj * HALF;
                    const u32x4 ga = *(const u32x4*)(gate + r * 2048 + c), gb = *(const u32x4*)(gate + r * 2048 + 1024 + c);
                    const unsigned aw[4] = {ga.x, ga.y, ga.z, ga.w}, bw[4] = {gb.x, gb.y, gb.z, gb.w};
#pragma unroll
                    for (int e = 0; e < 4; ++e) { const float r0 = (1.0f + __expf(-lo_bf(bw[e]))) * frcp_(1.0f + __expf(-lo_bf(aw[e]))), r1 = (1.0f + __expf(-hi_bf(bw[e]))) * frcp_(1.0f + __expf(-hi_bf(aw[e])));
                        acc[ai][bj][m][e >> 1][(e & 1) * 2] *= r0; acc[ai][bj][m][e >> 1][(e & 1) * 2 + 1] *= r1; } }
                asm volatile("" ::: "memory"); }
    }
    __device__ __forceinline__ void operator()(const f32x4 (&acc)[2][2][4][2], const Unit& u, int wr, int wc, int fr, int fq) const {
        const int row0 = u.pm * BM + wr * 64 + fr, col0 = u.pn * BM + wc * 32 + 8 * fq;
#pragma unroll
        for (int ai = 0; ai < 2; ++ai)
#pragma unroll
            for (int m = 0; m < 4; ++m) { const size_t r = (size_t)(row0 + ai * HALF + m * 16);
#pragma unroll
                for (int bj = 0; bj < 2; ++bj) { const int c = col0 + bj * HALF;
                    const u32x4 g = *(const u32x4*)(gate + r * 2048 + 1024 + c);
                    f32x4 v0 = acc[ai][bj][m][0], v1 = acc[ai][bj][m][1];
                    v0[0] *= sigmoidf_(lo_bf(g.x)); v0[1] *= sigmoidf_(hi_bf(g.x)); v0[2] *= sigmoidf_(lo_bf(g.y)); v0[3] *= sigmoidf_(hi_bf(g.y));
                    v1[0] *= sigmoidf_(lo_bf(g.z)); v1[1] *= sigmoidf_(hi_bf(g.z)); v1[2] *= sigmoidf_(lo_bf(g.w)); v1[3] *= sigmoidf_(hi_bf(g.w));
                    *(u32x4*)(out + r * 1024 + c) = pack8(v0, v1); } }
    }
};
struct EpiWout {
    static constexpr bool PERM = true, AFTER_DRAIN = false;
    const float* x; const float* modf; bf16_t* x1b;
    __device__ __forceinline__ void operator()(const f32x4 (&acc)[2][2][4][2], const Unit& u, int wr, int wc, int fr, int fq) const {
        const int row0 = u.pm * BM + wr * 64 + fr, col0 = u.pn * BM + wc * 32 + 8 * fq;
        const float* g1 = modf + (size_t)((u.pm * BM) >> 12) * NMOD + 2 * D;
#pragma unroll
        for (int bj = 0; bj < 2; ++bj) { const int c = col0 + bj * HALF; const f32x4 g0 = *(const f32x4*)(g1 + c), g1v = *(const f32x4*)(g1 + c + 4);
#pragma unroll
            for (int ai = 0; ai < 2; ++ai)
#pragma unroll
                for (int m = 0; m < 4; ++m) { const size_t r = (size_t)(row0 + ai * HALF + m * 16);
                    const f32x4 x0 = *(const f32x4*)(x + r * D + c), x1v = *(const f32x4*)(x + r * D + c + 4);
                    *(u32x4*)(x1b + r * 2048 + 1024 + c) = pack8(x0 + g0 * acc[ai][bj][m][0], x1v + g1v * acc[ai][bj][m][1]); } }
    }
};
struct EpiUp {
    static constexpr bool PERM = true, AFTER_DRAIN = false;
    bf16_t* H;
    __device__ __forceinline__ void operator()(const f32x4 (&acc)[2][2][4][2], const Unit& u, int wr, int wc, int fr, int fq) const {
        const int row0 = u.pm * BM + wr * 64 + fr, col0 = u.pn * HALF + wc * 32 + 8 * fq;
#pragma unroll
        for (int ai = 0; ai < 2; ++ai)
#pragma unroll
            for (int m = 0; m < 4; ++m) { f32x4 v0, v1;
#pragma unroll
                for (int e = 0; e < 4; ++e) { v0[e] = siluf_(acc[ai][0][m][0][e]) * acc[ai][1][m][0][e]; v1[e] = siluf_(acc[ai][0][m][1][e]) * acc[ai][1][m][1][e]; }
                *(u32x4*)(H + (size_t)(row0 + ai * HALF + m * 16) * DEXP + col0) = pack8(v0, v1); }
    }
};

template <class Epi, class Sched, bool ALIGN_EPI = false, bool GATHER = false, int MIDT = 0>
__device__ __forceinline__ void gemm_phase(LAS unsigned char* lds, const int K, const Sched& S, const Epi& E) {
    int tid_ = threadIdx.x; asm volatile("" : "+v"(tid_));
    const int tid = tid_, wid = __builtin_amdgcn_readfirstlane(tid >> 6), lane = tid & 63, wr = wid >> 2, wc = wid & 3, fr = lane & 15, fq = lane >> 4;
    const int nt = K / BK;
    const size_t kstep = (size_t)(BK * 2);
    const size_t hstep = (size_t)HALF * K * 2;
    unsigned vA0[2], vA1[2], nA0[2], nA1[2], voffB[2]; int Rr[2], Cc[2];
#pragma unroll
    for (int i = 0; i < 2; ++i) { int R, C; stage_rc(tid * 16 + i * 8192, R, C); const int Rb = Epi::PERM ? ((R & ~31) + perm32(R & 31)) : R; Rr[i] = R; Cc[i] = C;
        voffB[i] = (unsigned)(Rb * K + C) * 2u; }
#define PG8_SETOFF(u, o0, o1) do { _Pragma("unroll") for (int _i = 0; _i < 2; ++_i) { \
        if constexpr (GATHER) { o0[_i] = S.row_off(u, Rr[_i]) + (unsigned)Cc[_i] * 2u; o1[_i] = S.row_off(u, Rr[_i] + HALF) + (unsigned)Cc[_i] * 2u; } \
        else { o0[_i] = (unsigned)(Rr[_i] * K + Cc[_i]) * 2u; o1[_i] = o0[_i] + (unsigned)hstep; } } } while (0)
    const unsigned ldsw = (unsigned)wid * 1024u;
    const int aoff = lds_byte(wr * 64 + fr, fq * 8), boff = lds_byte(wc * 32 + fr, fq * 8);
#define PG8_SA(b, h) (((b) * 2 + (h)) * HTB)
#define PG8_SB(b, h) ((4 + (b) * 2 + (h)) * HTB)
#define PG8_STAGE(bufoff, gbase, voff) do { _Pragma("unroll") for (int _i = 0; _i < 2; ++_i) \
        __builtin_amdgcn_global_load_lds((const unsigned*)((const char*)(gbase) + (voff)[_i]), (LAS unsigned*)(lds + (bufoff) + ldsw + _i * 8192), 16, 0, 0); } while (0)
#define PG8_LDA(dst, b, h) do { _Pragma("unroll") for (int m = 0; m < 4; ++m) _Pragma("unroll") for (int k = 0; k < 2; ++k) dst[m][k] = *(const LAS bf16x8*)(lds + PG8_SA(b, h) + aoff + m * 2048 + k * 1024); } while (0)
#define PG8_LDB(dst, b, h) do { _Pragma("unroll") for (int n = 0; n < 2; ++n) _Pragma("unroll") for (int k = 0; k < 2; ++k) dst[n][k] = *(const LAS bf16x8*)(lds + PG8_SB(b, h) + boff + n * 2048 + k * 1024); } while (0)
#define PG8_MMA(ai, bj, At, Bt) do { __builtin_amdgcn_s_setprio(1); _Pragma("unroll") for (int m = 0; m < 4; ++m) _Pragma("unroll") for (int n = 0; n < 2; ++n) _Pragma("unroll") for (int k = 0; k < 2; ++k) \
        acc[ai][bj][m][n] = __builtin_amdgcn_mfma_f32_16x16x32_bf16(Bt[n][k], At[m][k], acc[ai][bj][m][n], 0, 0, 0); __builtin_amdgcn_s_setprio(0); } while (0)
#define PG8_WAIT_V(n) asm volatile("s_waitcnt vmcnt(" #n ")" ::: "memory")
#define PG8_WAIT_L(n) asm volatile("s_waitcnt lgkmcnt(" #n ")" ::: "memory")
#define PG8_BAR __builtin_amdgcn_s_barrier()
#define PG8_SCHED __builtin_amdgcn_sched_barrier(0)
    Unit cur, nxt; int ui = 0;
    if (!S.next(0, cur)) return;
    PG8_SETOFF(cur, vA0, vA1);
#pragma unroll
    for (int i = 0; i < 2; ++i) { nA0[i] = vA0[i]; nA1[i] = vA1[i]; }
    f32x4 acc[2][2][4][2];
#pragma unroll
    for (int a = 0; a < 2; ++a)
#pragma unroll
        for (int b = 0; b < 2; ++b)
#pragma unroll
            for (int m = 0; m < 4; ++m)
#pragma unroll
                for (int n = 0; n < 2; ++n) acc[a][b][m][n] = (f32x4){0.f, 0.f, 0.f, 0.f};
    bf16x8 At[4][2], B0[2][2], B1[2][2];
    const char* cA = S.a_ptr(cur); const char* cB = S.b_ptr(cur);
    PG8_STAGE(PG8_SB(0, 0), cB, voffB); PG8_STAGE(PG8_SB(0, 1), cB + hstep, voffB); PG8_STAGE(PG8_SA(0, 0), cA, vA0); PG8_STAGE(PG8_SA(0, 1), cA, vA1);
    if (wr == 1) PG8_BAR;
    PG8_WAIT_V(2); PG8_BAR;
    PG8_STAGE(PG8_SB(1, 0), cB + kstep, voffB); PG8_STAGE(PG8_SA(1, 0), cA + kstep, vA0); PG8_STAGE(PG8_SB(1, 1), cB + hstep + kstep, voffB);
    PG8_WAIT_V(6); PG8_BAR;
    for (;;) {
        const bool has_next = S.next(ui + 1, nxt);
        const char* nA = has_next ? S.a_ptr(nxt) : cA; const char* nB = has_next ? S.b_ptr(nxt) : cB;
        if constexpr (GATHER) { if (has_next) PG8_SETOFF(nxt, nA0, nA1); }
        for (int t = 0; t < nt; t += 2) {
            if constexpr (MIDT > 0) { if (t == MIDT) E.mid(acc, cur, wr, wc, fr, fq); }
            const bool last = (t == nt - 2);
            const char* a1 = cA + (size_t)(t + 1) * kstep;
            const char* a2 = last ? nA : cA + (size_t)(t + 2) * kstep; const char* b2 = last ? nB : cB + (size_t)(t + 2) * kstep;
            const char* a3 = a2 + kstep; const char* b3 = b2 + kstep;
            unsigned w0[2], w1[2];
#pragma unroll
            for (int i = 0; i < 2; ++i) { if constexpr (GATHER) { w0[i] = last ? nA0[i] : vA0[i]; w1[i] = last ? nA1[i] : vA1[i]; } else { w0[i] = vA0[i]; w1[i] = vA1[i]; } }
            PG8_LDB(B0, 0, 0); PG8_LDB(B1, 0, 1); PG8_SCHED; PG8_LDA(At, 0, 0); PG8_STAGE(PG8_SA(1, 1), a1, vA1);
            PG8_WAIT_V(8); PG8_WAIT_L(0); PG8_BAR; PG8_MMA(0, 0, At, B0); PG8_MMA(0, 1, At, B1); PG8_BAR; PG8_SCHED;
            PG8_LDA(At, 0, 1); PG8_STAGE(PG8_SB(0, 0), b2, voffB); PG8_STAGE(PG8_SB(0, 1), b2 + hstep, voffB); PG8_STAGE(PG8_SA(0, 0), a2, w0);
            PG8_WAIT_V(8); PG8_WAIT_L(0); PG8_BAR; PG8_MMA(1, 0, At, B0); PG8_MMA(1, 1, At, B1); PG8_BAR; PG8_SCHED;
            PG8_LDB(B0, 1, 0); PG8_LDB(B1, 1, 1); PG8_SCHED; PG8_LDA(At, 1, 0); PG8_STAGE(PG8_SA(0, 1), a2, w1);
            PG8_WAIT_V(8); PG8_WAIT_L(0); PG8_BAR; PG8_MMA(0, 0, At, B0); PG8_MMA(0, 1, At, B1); PG8_BAR; PG8_SCHED;
            PG8_LDA(At, 1, 1); PG8_STAGE(PG8_SB(1, 0), b3, voffB); PG8_STAGE(PG8_SB(1, 1), b3 + hstep, voffB); PG8_STAGE(PG8_SA(1, 0), a3, w0);
            PG8_WAIT_V(8); PG8_WAIT_L(0); PG8_BAR; PG8_MMA(1, 0, At, B0); PG8_MMA(1, 1, At, B1); PG8_BAR; PG8_SCHED;
        }
        if constexpr (ALIGN_EPI) { if (wr == 0) PG8_BAR; }
        E(acc, cur, wr, wc, fr, fq);
        if (!has_next) break;
#pragma unroll
        for (int a = 0; a < 2; ++a)
#pragma unroll
            for (int b = 0; b < 2; ++b)
#pragma unroll
                for (int m = 0; m < 4; ++m)
#pragma unroll
                    for (int n = 0; n < 2; ++n) acc[a][b][m][n] = (f32x4){0.f, 0.f, 0.f, 0.f};
        cur = nxt; cA = nA; cB = nB; ++ui;
#pragma unroll
        for (int i = 0; i < 2; ++i) { vA0[i] = nA0[i]; vA1[i] = nA1[i]; }
        if constexpr (ALIGN_EPI) { if (wr == 1) PG8_BAR; }
    }
    PG8_WAIT_V(0);
    if constexpr (!ALIGN_EPI) { if (wr == 0) PG8_BAR; }
    PG8_BAR;
#undef PG8_SETOFF
#undef PG8_SA
#undef PG8_SB
#undef PG8_STAGE
#undef PG8_LDA
#undef PG8_LDB
#undef PG8_MMA
#undef PG8_WAIT_V
#undef PG8_WAIT_L
#undef PG8_BAR
#undef PG8_SCHED
}
}

namespace attn_body {
using bf16=__hip_bfloat16;
using bf16x8=__attribute__((ext_vector_type(8)))short;
using s16x4=__attribute__((ext_vector_type(4)))short;
using f32x16=__attribute__((ext_vector_type(16)))float;
using u32x4=__attribute__((ext_vector_type(4)))unsigned;
constexpr int SEQ=4096,D=64,DM=1536,DMO=512;
constexpr int NW=8,QBLK=32,QB=QBLK*NW,KVBLK=64,NQB=SEQ/QB;
constexpr int ATTN_UNIT_ROWS=QB;
__device__ __forceinline__ int crow(int r,int hi){return (r&3)+8*(r>>2)+4*hi;}
#define SBAR() __builtin_amdgcn_sched_barrier(0)
__device__ __forceinline__ void cmask(f32x16&p0,f32x16&p1,int jb,int qrel,int hi){
  const float NEG=-INFINITY; int kb=64*jb+4*hi;
  #pragma unroll
  for(int r=0;r<16;++r){int kv=kb+(r&3)+8*(r>>2); if(kv>qrel)p0[r]=NEG; if(kv+32>qrel)p1[r]=NEG;}
}

constexpr int NSLOT=3, SLOTB=8192;
constexpr int LDS_K=0, LDS_V=NSLOT*SLOTB, LDS_WS=2*NSLOT*SLOTB, LDS_OST=LDS_WS+NW*64*4, LDS_BYTES=LDS_OST+NW*4096;
constexpr float C2=0.125f*1.4426950408889634f;
__device__ __forceinline__ void glds16(const void*gsrc,unsigned lds_dst){unsigned keep;
  asm volatile("s_mov_b32 %0, m0\n\ts_mov_b32 m0, %2\n\ts_nop 0\n\tglobal_load_lds_dwordx4 %1, off\n\ts_mov_b32 m0, %0":"=&s"(keep):"v"(gsrc),"s"(lds_dst):"memory");}
__device__ __forceinline__ float max3f(float a,float b,float c){float r;asm("v_max3_f32 %0, %1, %2, %3":"=v"(r):"v"(a),"v"(b),"v"(c));return r;}
__device__ __forceinline__ float max2f(float a,float b){float r;asm("v_max_f32_e32 %0, %1, %2":"=v"(r):"v"(a),"v"(b));return r;}
__device__ __forceinline__ float fadd_s(float a,float b){float r;asm("v_add_f32_e32 %0, %1, %2":"=v"(r):"v"(a),"v"(b));return r;}
__device__ __forceinline__ float fsub_s(float a,float b){float r;asm("v_sub_f32_e32 %0, %1, %2":"=v"(r):"v"(a),"v"(b));return r;}
typedef float f32x2_t __attribute__((ext_vector_type(2))); typedef __bf16 bf16x2_t __attribute__((ext_vector_type(2)));
__device__ __forceinline__ unsigned cvtpk_s(float lo,float hi){f32x2_t v={lo,hi};bf16x2_t b=__builtin_convertvector(v,bf16x2_t);return __builtin_bit_cast(unsigned,b);}
#define WAIT_BAR(N) asm volatile("s_waitcnt vmcnt(" #N ") lgkmcnt(0)\n\ts_barrier":::"memory")

__device__ __forceinline__ void qkt(f32x16&p0,f32x16&p1,const char*Kslot,const bf16x8*qr,const f32x16&negm,int r32,int hi){
  const char*kb=Kslot+hi*1024+r32*16;
  #pragma unroll
  for(int d0=0;d0<4;++d0){
    const bf16x8 b0=*reinterpret_cast<const bf16x8*>(kb+d0*2048);
    const bf16x8 b1=*reinterpret_cast<const bf16x8*>(kb+d0*2048+512);
    if(d0==0){p0=__builtin_amdgcn_mfma_f32_32x32x16_bf16(b0,qr[0],negm,0,0,0);p1=__builtin_amdgcn_mfma_f32_32x32x16_bf16(b1,qr[0],negm,0,0,0);}
    else{p0=__builtin_amdgcn_mfma_f32_32x32x16_bf16(b0,qr[d0],p0,0,0,0);p1=__builtin_amdgcn_mfma_f32_32x32x16_bf16(b1,qr[d0],p1,0,0,0);}}
}
typedef __attribute__((address_space(3))) const char* lds_cptr;
typedef short v4i16_t __attribute__((ext_vector_type(4)));
__device__ __forceinline__ void kload8(bf16x8*kf,lds_cptr kp){
  kf[0]=*(const __attribute__((address_space(3))) bf16x8*)(kp);      kf[1]=*(const __attribute__((address_space(3))) bf16x8*)(kp+512);
  kf[2]=*(const __attribute__((address_space(3))) bf16x8*)(kp+2048); kf[3]=*(const __attribute__((address_space(3))) bf16x8*)(kp+2560);
  kf[4]=*(const __attribute__((address_space(3))) bf16x8*)(kp+4096); kf[5]=*(const __attribute__((address_space(3))) bf16x8*)(kp+4608);
  kf[6]=*(const __attribute__((address_space(3))) bf16x8*)(kp+6144); kf[7]=*(const __attribute__((address_space(3))) bf16x8*)(kp+6656);
}
__device__ __forceinline__ void kload2(bf16x8*kf,lds_cptr kp,int j){ kf[2*j]=*(const __attribute__((address_space(3))) bf16x8*)(kp+j*2048); kf[2*j+1]=*(const __attribute__((address_space(3))) bf16x8*)(kp+j*2048+512); }
__device__ __forceinline__ s16x4 vtr(lds_cptr p){ return __builtin_bit_cast(s16x4,__builtin_amdgcn_ds_read_tr16_b64_v4i16((__attribute__((address_space(3))) v4i16_t*)p)); }
__device__ __forceinline__ float rowmax(const f32x16&p0,const f32x16&p1){
  float a=max3f(p0[0],p0[1],p1[0]),b=max3f(p0[2],p0[3],p1[1]);a=max3f(a,p1[2],p1[3]);
  #pragma unroll
  for(int r=4;r<16;r+=4){a=max3f(a,p0[r],p0[r+1]);b=max3f(b,p0[r+2],p0[r+3]);a=max3f(a,p1[r],p1[r+1]);b=max3f(b,p1[r+2],p1[r+3]);}
  const float m=max2f(a,b);
  auto rr=__builtin_amdgcn_permlane32_swap(__float_as_uint(m),__float_as_uint(m),false,false);
  return max2f(__uint_as_float(rr[0]),__uint_as_float(rr[1]));
}
__device__ __forceinline__ void pv(f32x16*o,int vb,bf16x8 pa0,bf16x8 pa1,bf16x8 pa2,bf16x8 pa3){
  #pragma unroll
  for(int d0=0;d0<2;++d0){s16x4 lo[4],hi[4];
    #pragma unroll
    for(int ks=0;ks<4;++ks){
      asm volatile("ds_read_b64_tr_b16 %0,%1 offset:%c2":"=&v"(lo[ks]):"v"(vb),"i"(d0*4096+ks*1024):"memory");
      asm volatile("ds_read_b64_tr_b16 %0,%1 offset:%c2":"=&v"(hi[ks]):"v"(vb),"i"(d0*4096+ks*1024+512):"memory");}
    asm volatile("s_waitcnt lgkmcnt(0)":::"memory");SBAR();
    #define PK(k) (bf16x8){lo[k][0],lo[k][1],lo[k][2],lo[k][3],hi[k][0],hi[k][1],hi[k][2],hi[k][3]}
    o[d0]=__builtin_amdgcn_mfma_f32_32x32x16_bf16(pa0,PK(0),o[d0],0,0,0);
    o[d0]=__builtin_amdgcn_mfma_f32_32x32x16_bf16(pa1,PK(1),o[d0],0,0,0);
    o[d0]=__builtin_amdgcn_mfma_f32_32x32x16_bf16(pa2,PK(2),o[d0],0,0,0);
    o[d0]=__builtin_amdgcn_mfma_f32_32x32x16_bf16(pa3,PK(3),o[d0],0,0,0);
    #undef PK
  }
}

#ifndef ATTN_STORE16
#define ATTN_STORE16(p,v) (*(u32x4*)(p)=(v))
#endif
template<int THRL> __device__ __forceinline__ void attn_unit(int b,int qcol,int kcol,int vcol,int ocol,int qb,const bf16*Q,const bf16*__restrict__ K,const bf16*__restrict__ V,bf16*O,char*shm){
  int tid_=threadIdx.x; asm volatile("":"+v"(tid_));
  const int tid=tid_,lane=tid&63,r32=lane&31,hi=lane>>5; const int wid=__builtin_amdgcn_readfirstlane(tid>>6);
  const long rowbase=(long)b*SEQ; const int q0=qb*QB;
  const bf16*Qw=Q+(rowbase+q0+wid*QBLK)*DM+qcol;
  const bf16*Kh=K+rowbase*DM+kcol,*Vh=V+rowbase*DM+vcol;
  const unsigned lds0=(unsigned)(uintptr_t)shm;
  float*wsf=(float*)(shm+LDS_WS)+wid*64;
  const bf16*ksrc=Kh+(long)lane*DM+wid*8;
  const bf16*vsrc=Vh+(long)(16*(wid&3)+(lane>>2))*DM+(wid>>2)*32+(lane&3)*8;
  const unsigned kdst=lds0+LDS_K+wid*1024, vdst=lds0+LDS_V+wid*1024;
  #define DMA_K(t,slot) glds16(ksrc+(long)(t)*KVBLK*DM,(unsigned)__builtin_amdgcn_readfirstlane(kdst+(slot)))
  #define DMA_V(t,slot) glds16(vsrc+(long)(t)*KVBLK*DM,(unsigned)__builtin_amdgcn_readfirstlane(vdst+(slot)))
  const int vb0=(int)(lds0+LDS_V)+((lane>>4)&1)*32+(lane&3)*8+(4*hi+((lane&15)>>2))*64;
  const char*Kbase=shm+LDS_K; bf16x8 kf[8];
  const lds_cptr shm3=(lds_cptr)shm; const lds_cptr kp0=shm3+LDS_K+hi*1024+r32*16; const lds_cptr vp0=shm3+LDS_V+((lane>>4)&1)*32+(lane&3)*8+(4*hi+((lane&15)>>2))*64;
  const int NT=(q0+QB)/KVBLK;
  DMA_K(0,0);DMA_V(0,0);DMA_K(1,SLOTB);
  bf16x8 qr[4];
  #pragma unroll
  for(int d0=0;d0<4;++d0)qr[d0]=*reinterpret_cast<const bf16x8*>(&Qw[(long)r32*DM+d0*16+hi*8]);
  float mhat=0.f,l_reg=0.f;f32x16 o[2];o[0]=f32x16{};o[1]=f32x16{};f32x16 negm=f32x16{};asm volatile("":"+v"(negm));
  const int qrel=wid*QBLK+r32;
  #define CMASK(P0,P1,t) do{int jb_=(t)-(NT-4); if(jb_>=0)cmask(P0,P1,jb_,qrel,hi);}while(0)
  bool resc=false;
  #define START(P0,P1) do{ const float rm=rowmax(P0,P1); resc=false; \
    { const float dl=rm; mhat=fadd_s(mhat,dl); \
      _Pragma("unroll") for(int r=0;r<16;++r){P0[r]=fsub_s(P0[r],dl);P1[r]=fsub_s(P1[r],dl);} \
      _Pragma("unroll") for(int r=0;r<16;++r)negm[r]=-mhat; asm volatile("":"+v"(negm)); } \
    _Pragma("unroll") for(int r=0;r<16;++r)P0[r]=__builtin_amdgcn_exp2f(P0[r]); }while(0)
  #define RESC() do{ if(resc){ asm volatile("s_waitcnt lgkmcnt(0)":::"memory"); \
      _Pragma("unroll") for(int d_=0;d_<2;++d_) _Pragma("unroll") for(int r=0;r<16;++r)o[d_][r]*=wsf[crow(r,hi)]; } }while(0)
  f32x16 pA0,pA1,pB0,pB1;
  int sl_prev=0,sl_cur=0,sl_next=SLOTB;
  #define ROT() do{sl_prev=sl_cur;sl_cur=sl_next;sl_next=(sl_next==(NSLOT-1)*SLOTB)?0:sl_next+SLOTB;}while(0)
  DMA_K(2,2*SLOTB);
  WAIT_BAR(3);
  qkt(pA0,pA1,Kbase,qr,negm,r32,hi);asm volatile("s_nop 15\n\ts_nop 7":"+v"(pA0),"+v"(pA1));CMASK(pA0,pA1,0);
  START(pA0,pA1);
  _Pragma("unroll") for(int r=0;r<16;++r)pA1[r]=__builtin_amdgcn_exp2f(pA1[r]);
  WAIT_BAR(0);
  DMA_K(3,0);DMA_V(1,SLOTB);
  ROT();
  kload8(kf,kp0+sl_cur);
  WAIT_BAR(2);
  s16x4 vlo[8],vhi[8]; u32x4 pw0,pw1,pw2,pw3;
  #define PKW(P,B) cvtpk_s(P[B],P[B+1])
  #define PAF(k) __builtin_bit_cast(bf16x8,pw##k)
  #define VFR(i) (bf16x8){vlo[i][0],vlo[i][1],vlo[i][2],vlo[i][3],vhi[i][0],vhi[i][1],vhi[i][2],vhi[i][3]}
  #define PIN(x) asm volatile("":"+v"(x))
  #define MX3(a,b,c) __builtin_fmaxf(__builtin_fmaxf((a),(b)),(c))
  #define GAPA(MF,A0,A1,A2,A3,W0,W1,PW) do{ MF; sacc+=A0; sacc+=A1; sacc+=A2; sacc+=A3; PIN(sacc); W0; W1; PIN(PW); SBAR(); }while(0)
  #define EX(v) __builtin_amdgcn_exp2f(v)
  #define GAPB(MF,X,B) do{ MF; X[B]=EX(X[B]); X[B+1]=EX(X[B+1]); X[B+2]=EX(X[B+2]); X[B+3]=EX(X[B+3]); PIN(X); SBAR(); }while(0)
  #define VRD(i) do{ vlo[i]=vtr(vp_+(((i)>>2)*4096+((i)&3)*1024)); vhi[i]=vtr(vp_+(((i)>>2)*4096+((i)&3)*1024+512)); }while(0)
  #define KRD(G,j) do{ if(G){ kload2(kf,kp0+sl_next,j); SBAR(); } }while(0)
  #define STEP(C0,C1,P0,P1,t,GK,GV,GL) do{ SBAR(); \
    const lds_cptr vp_=vp0+sl_prev; \
    VRD(0); SBAR(); float sacc=(P0[0]+P0[1]); \
    GAPA(C0=__builtin_amdgcn_mfma_f32_32x32x16_bf16(kf[0],qr[0],negm,0,0,0), P0[2],P0[3],P0[4],P0[5],     pw0[0]=PKW(P0,0), pw0[1]=PKW(P0,2), pw0); \
    VRD(4); SBAR(); GAPA(C1=__builtin_amdgcn_mfma_f32_32x32x16_bf16(kf[1],qr[0],negm,0,0,0), P0[6],P0[7],P0[8],P0[9],     pw0[2]=PKW(P0,4), pw0[3]=PKW(P0,6), pw0); \
    VRD(1); SBAR(); GAPA(C0=__builtin_amdgcn_mfma_f32_32x32x16_bf16(kf[2],qr[1],C0,0,0,0),   P0[10],P0[11],P0[12],P0[13], pw1[0]=PKW(P0,8), pw1[1]=PKW(P0,10), pw1); \
    VRD(5); SBAR(); GAPA(C1=__builtin_amdgcn_mfma_f32_32x32x16_bf16(kf[3],qr[1],C1,0,0,0),   P0[14],P0[15],P1[0],P1[1],   pw1[2]=PKW(P0,12),pw1[3]=PKW(P0,14), pw1); \
    VRD(2); SBAR(); GAPA(C0=__builtin_amdgcn_mfma_f32_32x32x16_bf16(kf[4],qr[2],C0,0,0,0),   P1[2],P1[3],P1[4],P1[5],     pw2[0]=PKW(P1,0), pw2[1]=PKW(P1,2), pw2); \
    VRD(6); SBAR(); GAPA(C1=__builtin_amdgcn_mfma_f32_32x32x16_bf16(kf[5],qr[2],C1,0,0,0),   P1[6],P1[7],P1[8],P1[9],     pw2[2]=PKW(P1,4), pw2[3]=PKW(P1,6), pw2); \
    VRD(3); SBAR(); GAPA(C0=__builtin_amdgcn_mfma_f32_32x32x16_bf16(kf[6],qr[3],C0,0,0,0),   P1[10],P1[11],P1[12],P1[13], pw3[0]=PKW(P1,8), pw3[1]=PKW(P1,10), pw3); \
    VRD(7); SBAR(); GAPA(C1=__builtin_amdgcn_mfma_f32_32x32x16_bf16(kf[7],qr[3],C1,0,0,0),   P1[14],P1[15],0.f,0.f,       pw3[2]=PKW(P1,12),pw3[3]=PKW(P1,14), pw3); \
    l_reg+=sacc; \
    if(GK){DMA_K((t)+3,sl_cur);} if(GV){DMA_V((t)+1,sl_next);} \
    CMASK(C0,C1,t); \
    { float a=MX3(C0[0],C0[1],C1[0]),b=MX3(C0[2],C0[3],C1[1]); a=MX3(a,C1[2],C1[3]); \
      _Pragma("unroll") for(int r=4;r<16;r+=4){a=MX3(a,C0[r],C0[r+1]);b=MX3(b,C0[r+2],C0[r+3]);a=MX3(a,C1[r],C1[r+1]);b=MX3(b,C1[r+2],C1[r+3]);} \
      float rm=__builtin_fmaxf(a,b); { auto rr=__builtin_amdgcn_permlane32_swap(__float_as_uint(rm),__float_as_uint(rm),false,false); rm=__builtin_fmaxf(__uint_as_float(rr[0]),__uint_as_float(rr[1])); } \
      resc=false; \
      if(__builtin_expect(__any(rm>(float)THRL),0)){ const float dl=__builtin_fmaxf(rm,0.f); mhat+=dl; \
        _Pragma("unroll") for(int r=0;r<16;++r){C0[r]-=dl;C1[r]-=dl;} \
        _Pragma("unroll") for(int r=0;r<16;++r)negm[r]=-mhat; asm volatile("":"+v"(negm)); \
        const float f=__builtin_amdgcn_exp2f(-dl); l_reg*=f; if(hi==0)wsf[r32]=f; resc=true; } } \
    SBAR(); \
    GAPB(o[0]=__builtin_amdgcn_mfma_f32_32x32x16_bf16(PAF(0),VFR(0),o[0],0,0,0), C0,0); \
    GAPB(o[1]=__builtin_amdgcn_mfma_f32_32x32x16_bf16(PAF(0),VFR(4),o[1],0,0,0), C0,4); \
    KRD(GL,0); GAPB(o[0]=__builtin_amdgcn_mfma_f32_32x32x16_bf16(PAF(1),VFR(1),o[0],0,0,0), C0,8); \
    KRD(GL,1); GAPB(o[1]=__builtin_amdgcn_mfma_f32_32x32x16_bf16(PAF(1),VFR(5),o[1],0,0,0), C0,12); \
    KRD(GL,2); GAPB(o[0]=__builtin_amdgcn_mfma_f32_32x32x16_bf16(PAF(2),VFR(2),o[0],0,0,0), C1,0); \
    KRD(GL,3); GAPB(o[1]=__builtin_amdgcn_mfma_f32_32x32x16_bf16(PAF(2),VFR(6),o[1],0,0,0), C1,4); \
    GAPB(o[0]=__builtin_amdgcn_mfma_f32_32x32x16_bf16(PAF(3),VFR(3),o[0],0,0,0), C1,8); \
    GAPB(o[1]=__builtin_amdgcn_mfma_f32_32x32x16_bf16(PAF(3),VFR(7),o[1],0,0,0), C1,12); \
    }while(0)
  int t=1;
  #undef CMASK
  #define CMASK(P0,P1,t) do{}while(0)
  for(;t+5<NT;t+=2){
    STEP(pB0,pB1,pA0,pA1,t,true,true,true);     WAIT_BAR(2); RESC(); ROT();
    STEP(pA0,pA1,pB0,pB1,t+1,true,true,true);   WAIT_BAR(2); RESC(); ROT();
  }
  #undef CMASK
  #define CMASK(P0,P1,t) do{int jb_=(t)-(NT-4); if(jb_>=0)cmask(P0,P1,jb_,qrel,hi);}while(0)
  #define ENDW(tt) do{ if((tt)+3<NT){WAIT_BAR(2);} else if((tt)+2<NT){WAIT_BAR(1);} else {WAIT_BAR(0);} }while(0)
  for(;t+1<NT;t+=2){
    STEP(pB0,pB1,pA0,pA1,t,(t+3<NT),(t+1<NT),(t+1<NT));       ENDW(t);   RESC(); ROT();
    STEP(pA0,pA1,pB0,pB1,t+1,(t+4<NT),(t+2<NT),(t+2<NT));     ENDW(t+1); RESC(); ROT();
  }
  STEP(pB0,pB1,pA0,pA1,NT-1,false,false,false); RESC();
  { float sacc=pB0[0]+pB0[1]; _Pragma("unroll") for(int r=2;r<16;++r)sacc+=pB0[r]; _Pragma("unroll") for(int r=0;r<16;++r)sacc+=pB1[r]; l_reg+=sacc;
    pw0=(u32x4){PKW(pB0,0),PKW(pB0,2),PKW(pB0,4),PKW(pB0,6)};pw1=(u32x4){PKW(pB0,8),PKW(pB0,10),PKW(pB0,12),PKW(pB0,14)};pw2=(u32x4){PKW(pB1,0),PKW(pB1,2),PKW(pB1,4),PKW(pB1,6)};pw3=(u32x4){PKW(pB1,8),PKW(pB1,10),PKW(pB1,12),PKW(pB1,14)};
    SBAR(); pv(o,vb0+sl_cur,PAF(0),PAF(1),PAF(2),PAF(3)); }
  #undef PKW
  #undef PAF
  #undef VFR
  #undef PIN
  #undef MX3
  #undef GAPA
  #undef GAPB
  #undef EX
  #undef VRD
  #undef KRD
  #undef STEP
  #undef ENDW
  {auto rr=__builtin_amdgcn_permlane32_swap(__float_as_uint(l_reg),__float_as_uint(l_reg),false,false);l_reg=__uint_as_float(rr[0])+__uint_as_float(rr[1]);}
  if(hi==0)wsf[32+r32]=l_reg;asm volatile("s_waitcnt lgkmcnt(0)":::"memory");
  float rli[16];
  #pragma unroll
  for(int r=0;r<16;++r)rli[r]=__builtin_amdgcn_rcpf(wsf[32+crow(r,hi)]);
  bf16*Ow=O+(rowbase+q0+wid*QBLK)*DMO+ocol;
  { bf16*stg=(bf16*)(shm+LDS_OST)+wid*2048;
    #pragma unroll
    for(int r=0;r<16;++r){const int orow=crow(r,hi);
      #pragma unroll
      for(int d0=0;d0<2;++d0)stg[orow*64+d0*32+r32]=__float2bfloat16(o[d0][r]*rli[r]);}
    asm volatile("s_waitcnt lgkmcnt(0)":::"memory");
    #pragma unroll
    for(int i=0;i<4;++i){const int row=i*8+(lane>>3),ch=lane&7; const u32x4 v=*(const u32x4*)(stg+row*64+ch*8); ATTN_STORE16(Ow+(long)row*DMO+ch*8,v);} }
  asm volatile("s_waitcnt lgkmcnt(0)\n\ts_barrier":::"memory");
  #undef DMA_K
  #undef DMA_V
  #undef CMASK
  #undef START
  #undef RESC
  #undef ROT
}
constexpr int ATTN_LDS_BYTES=LDS_BYTES;
template<int THRL=8> __device__ __forceinline__ void attn_phase(char*lds,const bf16*U,bf16*Oc,int vcu){
  const int bhc=vcu>>3,s=vcu&7,b=bhc>>3,h=(bhc>>1)&3,c=bhc&1;
  _Pragma("unroll 1") for(int i=0;i<4;++i){ const int half=i>>1,qb=(i&1)?15-s:s;
    attn_unit<THRL>(b,h*128+c*64,512+h*128+c*64,1024+h*128+half*64,h*128+half*64,qb,U,U,U,Oc+(long)c*16384*DMO,lds); }
}
#undef SBAR
#undef WAIT_BAR
}

namespace attn2 {
using bf16=__hip_bfloat16;
using bf16x8=__attribute__((ext_vector_type(8)))short;
using s16x4=__attribute__((ext_vector_type(4)))short;
using f32x16=__attribute__((ext_vector_type(16)))float;
using u32x4=__attribute__((ext_vector_type(4)))unsigned;
constexpr int SEQ=4096,D=64,DM=1536,DMO=512;
constexpr int NW=8,QBLK=32,QB=QBLK*NW,KVBLK=64,NQB=SEQ/QB;
constexpr int ATTN_UNIT_ROWS=QB;
__device__ __forceinline__ int crow(int r,int hi){return (r&3)+8*(r>>2)+4*hi;}
#define SBAR() __builtin_amdgcn_sched_barrier(0)
__device__ __forceinline__ void cmask(f32x16&p0,f32x16&p1,int jb,int qrel,int hi){
  const float NEG=-INFINITY; int kb=64*jb+4*hi;
  #pragma unroll
  for(int r=0;r<16;++r){int kv=kb+(r&3)+8*(r>>2); if(kv>qrel)p0[r]=NEG; if(kv+32>qrel)p1[r]=NEG;}
}

constexpr int NSLOT=3, SLOTB=8192;
constexpr int LDS_K=0, LDS_V=NSLOT*SLOTB, LDS_WS=3*NSLOT*SLOTB, LDS_OST=LDS_WS+NW*64*4, LDS_BYTES=LDS_OST+NW*4096;
constexpr float C2=0.125f*1.4426950408889634f;
__device__ __forceinline__ void glds16(const void*gsrc,unsigned lds_dst){unsigned keep;
  asm volatile("s_mov_b32 %0, m0\n\ts_mov_b32 m0, %2\n\ts_nop 0\n\tglobal_load_lds_dwordx4 %1, off\n\ts_mov_b32 m0, %0":"=&s"(keep):"v"(gsrc),"s"(lds_dst):"memory");}
__device__ __forceinline__ float max3f(float a,float b,float c){float r;asm("v_max3_f32 %0, %1, %2, %3":"=v"(r):"v"(a),"v"(b),"v"(c));return r;}
__device__ __forceinline__ float max2f(float a,float b){float r;asm("v_max_f32_e32 %0, %1, %2":"=v"(r):"v"(a),"v"(b));return r;}
__device__ __forceinline__ float fadd_s(float a,float b){float r;asm("v_add_f32_e32 %0, %1, %2":"=v"(r):"v"(a),"v"(b));return r;}
__device__ __forceinline__ float fsub_s(float a,float b){float r;asm("v_sub_f32_e32 %0, %1, %2":"=v"(r):"v"(a),"v"(b));return r;}
typedef float f32x2_t __attribute__((ext_vector_type(2))); typedef __bf16 bf16x2_t __attribute__((ext_vector_type(2)));
__device__ __forceinline__ unsigned cvtpk_s(float lo,float hi){f32x2_t v={lo,hi};bf16x2_t b=__builtin_convertvector(v,bf16x2_t);return __builtin_bit_cast(unsigned,b);}
#define WAIT_BAR(N) asm volatile("s_waitcnt vmcnt(" #N ") lgkmcnt(0)\n\ts_barrier":::"memory")

__device__ __forceinline__ void qkt(f32x16&p0,f32x16&p1,const char*Kslot,const bf16x8*qr,int r32,int hi){
  const f32x16 negm=f32x16{};
  const char*kb=Kslot+hi*1024+r32*16;
  #pragma unroll
  for(int d0=0;d0<4;++d0){
    const bf16x8 b0=*reinterpret_cast<const bf16x8*>(kb+d0*2048);
    const bf16x8 b1=*reinterpret_cast<const bf16x8*>(kb+d0*2048+512);
    if(d0==0){p0=__builtin_amdgcn_mfma_f32_32x32x16_bf16(b0,qr[0],negm,0,0,0);p1=__builtin_amdgcn_mfma_f32_32x32x16_bf16(b1,qr[0],negm,0,0,0);}
    else{p0=__builtin_amdgcn_mfma_f32_32x32x16_bf16(b0,qr[d0],p0,0,0,0);p1=__builtin_amdgcn_mfma_f32_32x32x16_bf16(b1,qr[d0],p1,0,0,0);}}
}
typedef __attribute__((address_space(3))) const char* lds_cptr;
typedef short v4i16_t __attribute__((ext_vector_type(4)));
__device__ __forceinline__ void kload8(bf16x8*kf,lds_cptr kp){
  kf[0]=*(const __attribute__((address_space(3))) bf16x8*)(kp);      kf[1]=*(const __attribute__((address_space(3))) bf16x8*)(kp+512);
  kf[2]=*(const __attribute__((address_space(3))) bf16x8*)(kp+2048); kf[3]=*(const __attribute__((address_space(3))) bf16x8*)(kp+2560);
  kf[4]=*(const __attribute__((address_space(3))) bf16x8*)(kp+4096); kf[5]=*(const __attribute__((address_space(3))) bf16x8*)(kp+4608);
  kf[6]=*(const __attribute__((address_space(3))) bf16x8*)(kp+6144); kf[7]=*(const __attribute__((address_space(3))) bf16x8*)(kp+6656);
}
__device__ __forceinline__ void kload2(bf16x8*kf,lds_cptr kp,int j){ kf[2*j]=*(const __attribute__((address_space(3))) bf16x8*)(kp+j*2048); kf[2*j+1]=*(const __attribute__((address_space(3))) bf16x8*)(kp+j*2048+512); }
__device__ __forceinline__ s16x4 vtr(lds_cptr p){ return __builtin_bit_cast(s16x4,__builtin_amdgcn_ds_read_tr16_b64_v4i16((__attribute__((address_space(3))) v4i16_t*)p)); }
__device__ __forceinline__ float rowmax(const f32x16&p0,const f32x16&p1){
  float a=max3f(p0[0],p0[1],p1[0]),b=max3f(p0[2],p0[3],p1[1]);a=max3f(a,p1[2],p1[3]);
  #pragma unroll
  for(int r=4;r<16;r+=4){a=max3f(a,p0[r],p0[r+1]);b=max3f(b,p0[r+2],p0[r+3]);a=max3f(a,p1[r],p1[r+1]);b=max3f(b,p1[r+2],p1[r+3]);}
  const float m=max2f(a,b);
  auto rr=__builtin_amdgcn_permlane32_swap(__float_as_uint(m),__float_as_uint(m),false,false);
  return max2f(__uint_as_float(rr[0]),__uint_as_float(rr[1]));
}
__device__ __forceinline__ void pv(f32x16*o,int vb,bf16x8 pa0,bf16x8 pa1,bf16x8 pa2,bf16x8 pa3){
  #pragma unroll
  for(int d0=0;d0<4;++d0){s16x4 lo[4],hi[4];
    #pragma unroll
    for(int ks=0;ks<4;++ks){
      asm volatile("ds_read_b64_tr_b16 %0,%1 offset:%c2":"=&v"(lo[ks]):"v"(vb),"i"(d0*4096+ks*1024):"memory");
      asm volatile("ds_read_b64_tr_b16 %0,%1 offset:%c2":"=&v"(hi[ks]):"v"(vb),"i"(d0*4096+ks*1024+512):"memory");}
    asm volatile("s_waitcnt lgkmcnt(0)":::"memory");SBAR();
    #define PK(k) (bf16x8){lo[k][0],lo[k][1],lo[k][2],lo[k][3],hi[k][0],hi[k][1],hi[k][2],hi[k][3]}
    o[d0]=__builtin_amdgcn_mfma_f32_32x32x16_bf16(pa0,PK(0),o[d0],0,0,0);
    o[d0]=__builtin_amdgcn_mfma_f32_32x32x16_bf16(pa1,PK(1),o[d0],0,0,0);
    o[d0]=__builtin_amdgcn_mfma_f32_32x32x16_bf16(pa2,PK(2),o[d0],0,0,0);
    o[d0]=__builtin_amdgcn_mfma_f32_32x32x16_bf16(pa3,PK(3),o[d0],0,0,0);
    #undef PK
  }
}

#ifndef ATTN_STORE16
#define ATTN_STORE16(p,v) (*(u32x4*)(p)=(v))
#endif
template<int THRL> __device__ __forceinline__ void attn_unit(int b,int qcol,int kcol,int vcol,int ocol,int qb,const bf16*Q,const bf16*__restrict__ K,const bf16*__restrict__ V,bf16*O,char*shm){
  int tid_=threadIdx.x; asm volatile("":"+v"(tid_));
  const int tid=tid_,lane=tid&63,r32=lane&31,hi=lane>>5; const int wid=__builtin_amdgcn_readfirstlane(tid>>6);
  const long rowbase=(long)b*SEQ; const int q0=qb*QB;
  const bf16*Qw=Q+(rowbase+q0+wid*QBLK)*DM+qcol;
  const bf16*Kh=K+rowbase*DM+kcol,*Vh=V+rowbase*DM+vcol;
  const unsigned lds0=(unsigned)(uintptr_t)shm;
  float*wsf=(float*)(shm+LDS_WS)+wid*64;
  const bf16*ksrc=Kh+(long)lane*DM+wid*8;
  const bf16*vsrc=Vh+(long)(16*(wid&3)+(lane>>2))*DM+(wid>>2)*32+(lane&3)*8;
  const unsigned kdst=lds0+LDS_K+wid*1024, vdst=lds0+LDS_V+wid*1024;
  #define DMA_K(t,slot) glds16(ksrc+(long)(t)*KVBLK*DM,(unsigned)__builtin_amdgcn_readfirstlane(kdst+(slot)))
  #define DMA_V(t,slot) do{ glds16(vsrc+(long)(t)*KVBLK*DM,(unsigned)__builtin_amdgcn_readfirstlane(vdst+2*(slot))); glds16(vsrc+(long)(t)*KVBLK*DM+64,(unsigned)__builtin_amdgcn_readfirstlane(vdst+2*(slot)+8192)); }while(0)
  const int vb0=(int)(lds0+LDS_V)+((lane>>4)&1)*32+(lane&3)*8+(4*hi+((lane&15)>>2))*64;
  const char*Kbase=shm+LDS_K; bf16x8 kf[8];
  const lds_cptr shm3=(lds_cptr)shm; const lds_cptr kp0=shm3+LDS_K+hi*1024+r32*16; const lds_cptr vp0=shm3+LDS_V+((lane>>4)&1)*32+(lane&3)*8+(4*hi+((lane&15)>>2))*64;
  const int NT=(q0+QB)/KVBLK;
  DMA_K(0,0);DMA_V(0,0);DMA_K(1,SLOTB);
  bf16x8 qr[4];
  #pragma unroll
  for(int d0=0;d0<4;++d0)qr[d0]=*reinterpret_cast<const bf16x8*>(&Qw[(long)r32*DM+d0*16+hi*8]);
  float mhat=0.f,l_reg=0.f;f32x16 o[4];o[0]=f32x16{};o[1]=f32x16{};o[2]=f32x16{};o[3]=f32x16{};
  const int qrel=wid*QBLK+r32;
  #define CMASK(P0,P1,t) do{int jb_=(t)-(NT-4); if(jb_>=0)cmask(P0,P1,jb_,qrel,hi);}while(0)
  bool resc=false;
  #define START(P0,P1) do{ const float rm=rowmax(P0,P1); resc=false; mhat=rm; \
    _Pragma("unroll") for(int r=0;r<16;++r)P0[r]=__builtin_amdgcn_exp2f(P0[r]-mhat); }while(0)
  #define RESC() do{ if(resc){ asm volatile("s_waitcnt lgkmcnt(0)":::"memory"); \
      _Pragma("unroll") for(int d_=0;d_<4;++d_) _Pragma("unroll") for(int r=0;r<16;++r)o[d_][r]*=wsf[crow(r,hi)]; } }while(0)
  f32x16 pA0,pA1,pB0,pB1;
  int sl_prev=0,sl_cur=0,sl_next=SLOTB;
  #define ROT() do{sl_prev=sl_cur;sl_cur=sl_next;sl_next=(sl_next==(NSLOT-1)*SLOTB)?0:sl_next+SLOTB;}while(0)
  DMA_K(2,2*SLOTB);
  WAIT_BAR(4);
  qkt(pA0,pA1,Kbase,qr,r32,hi);asm volatile("s_nop 15\n\ts_nop 7":"+v"(pA0),"+v"(pA1));CMASK(pA0,pA1,0);
  START(pA0,pA1);
  _Pragma("unroll") for(int r=0;r<16;++r)pA1[r]=__builtin_amdgcn_exp2f(pA1[r]-mhat);
  WAIT_BAR(0);
  DMA_K(3,0);DMA_V(1,SLOTB);
  ROT();
  kload8(kf,kp0+sl_cur);
  WAIT_BAR(3);
  s16x4 vlo[8],vhi[8]; u32x4 pw0,pw1,pw2,pw3;
  #define PKW(P,B) cvtpk_s(P[B],P[B+1])
  #define PAF(k) __builtin_bit_cast(bf16x8,pw##k)
  #define VFR(i) (bf16x8){vlo[i][0],vlo[i][1],vlo[i][2],vlo[i][3],vhi[i][0],vhi[i][1],vhi[i][2],vhi[i][3]}
  #define PIN(x) asm volatile("":"+v"(x))
  #define MX3(a,b,c) __builtin_fmaxf(__builtin_fmaxf((a),(b)),(c))
  #define GAPA(MF,A0,A1,A2,A3,W0,W1,PW) do{ MF; sacc+=A0; sacc+=A1; sacc+=A2; sacc+=A3; PIN(sacc); W0; W1; PIN(PW); SBAR(); }while(0)
  #define EX(v) __builtin_amdgcn_exp2f(v)
  #define GAPB(MF,X,B) do{ MF; X[B]=EX(X[B]-mhat); X[B+1]=EX(X[B+1]-mhat); PIN(X); SBAR(); }while(0)
  #define VRD(i) do{ vlo[i]=vtr(vp_+(((i)>>2)*4096+((i)&3)*1024)); vhi[i]=vtr(vp_+(((i)>>2)*4096+((i)&3)*1024+512)); }while(0)
  #define VRD2(i) do{ vlo[i]=vtr(vp_+((2+((i)>>2))*4096+((i)&3)*1024)); vhi[i]=vtr(vp_+((2+((i)>>2))*4096+((i)&3)*1024+512)); SBAR(); }while(0)
  #define KRD(G,j) do{ if(G){ kload2(kf,kp0+sl_next,j); SBAR(); } }while(0)
  #define STEP(C0,C1,P0,P1,t,GK,GV,GL) do{ SBAR(); \
    const lds_cptr vp_=vp0+2*sl_prev; const f32x16 zz=f32x16{}; \
    VRD(0); SBAR(); float sacc=(P0[0]+P0[1]); \
    GAPA(C0=__builtin_amdgcn_mfma_f32_32x32x16_bf16(kf[0],qr[0],zz,0,0,0), P0[2],P0[3],P0[4],P0[5],     pw0[0]=PKW(P0,0), pw0[1]=PKW(P0,2), pw0); \
    VRD(4); SBAR(); GAPA(C1=__builtin_amdgcn_mfma_f32_32x32x16_bf16(kf[1],qr[0],zz,0,0,0), P0[6],P0[7],P0[8],P0[9],     pw0[2]=PKW(P0,4), pw0[3]=PKW(P0,6), pw0); \
    VRD(1); SBAR(); GAPA(C0=__builtin_amdgcn_mfma_f32_32x32x16_bf16(kf[2],qr[1],C0,0,0,0),   P0[10],P0[11],P0[12],P0[13], pw1[0]=PKW(P0,8), pw1[1]=PKW(P0,10), pw1); \
    VRD(5); SBAR(); GAPA(C1=__builtin_amdgcn_mfma_f32_32x32x16_bf16(kf[3],qr[1],C1,0,0,0),   P0[14],P0[15],P1[0],P1[1],   pw1[2]=PKW(P0,12),pw1[3]=PKW(P0,14), pw1); \
    VRD(2); SBAR(); GAPA(C0=__builtin_amdgcn_mfma_f32_32x32x16_bf16(kf[4],qr[2],C0,0,0,0),   P1[2],P1[3],P1[4],P1[5],     pw2[0]=PKW(P1,0), pw2[1]=PKW(P1,2), pw2); \
    VRD(6); SBAR(); GAPA(C1=__builtin_amdgcn_mfma_f32_32x32x16_bf16(kf[5],qr[2],C1,0,0,0),   P1[6],P1[7],P1[8],P1[9],     pw2[2]=PKW(P1,4), pw2[3]=PKW(P1,6), pw2); \
    VRD(3); SBAR(); GAPA(C0=__builtin_amdgcn_mfma_f32_32x32x16_bf16(kf[6],qr[3],C0,0,0,0),   P1[10],P1[11],P1[12],P1[13], pw3[0]=PKW(P1,8), pw3[1]=PKW(P1,10), pw3); \
    VRD(7); SBAR(); GAPA(C1=__builtin_amdgcn_mfma_f32_32x32x16_bf16(kf[7],qr[3],C1,0,0,0),   P1[14],P1[15],0.f,0.f,       pw3[2]=PKW(P1,12),pw3[3]=PKW(P1,14), pw3); \
    l_reg+=sacc; \
    if(GK){DMA_K((t)+3,sl_cur);} if(GV){DMA_V((t)+1,sl_next);} \
    CMASK(C0,C1,t); \
    { float a=MX3(C0[0],C0[1],C1[0]),b=MX3(C0[2],C0[3],C1[1]); a=MX3(a,C1[2],C1[3]); \
      _Pragma("unroll") for(int r=4;r<16;r+=4){a=MX3(a,C0[r],C0[r+1]);b=MX3(b,C0[r+2],C0[r+3]);a=MX3(a,C1[r],C1[r+1]);b=MX3(b,C1[r+2],C1[r+3]);} \
      float rm=__builtin_fmaxf(a,b); { auto rr=__builtin_amdgcn_permlane32_swap(__float_as_uint(rm),__float_as_uint(rm),false,false); rm=__builtin_fmaxf(__uint_as_float(rr[0]),__uint_as_float(rr[1])); } \
      resc=false; \
      if(__builtin_expect(__any(rm-mhat>(float)THRL),0)){ const float dl=__builtin_fmaxf(rm-mhat,0.f); mhat+=dl; \
        const float f=__builtin_amdgcn_exp2f(-dl); l_reg*=f; if(hi==0)wsf[r32]=f; resc=true; } } \
    SBAR(); \
    GAPB(o[0]=__builtin_amdgcn_mfma_f32_32x32x16_bf16(PAF(0),VFR(0),o[0],0,0,0), C0,0);  VRD2(0); \
    GAPB(o[1]=__builtin_amdgcn_mfma_f32_32x32x16_bf16(PAF(0),VFR(4),o[1],0,0,0), C0,2);  VRD2(4); \
    GAPB(o[0]=__builtin_amdgcn_mfma_f32_32x32x16_bf16(PAF(1),VFR(1),o[0],0,0,0), C0,4);  VRD2(1); \
    GAPB(o[1]=__builtin_amdgcn_mfma_f32_32x32x16_bf16(PAF(1),VFR(5),o[1],0,0,0), C0,6);  VRD2(5); \
    GAPB(o[0]=__builtin_amdgcn_mfma_f32_32x32x16_bf16(PAF(2),VFR(2),o[0],0,0,0), C0,8);  VRD2(2); \
    GAPB(o[1]=__builtin_amdgcn_mfma_f32_32x32x16_bf16(PAF(2),VFR(6),o[1],0,0,0), C0,10); VRD2(6); \
    GAPB(o[0]=__builtin_amdgcn_mfma_f32_32x32x16_bf16(PAF(3),VFR(3),o[0],0,0,0), C0,12); VRD2(3); \
    GAPB(o[1]=__builtin_amdgcn_mfma_f32_32x32x16_bf16(PAF(3),VFR(7),o[1],0,0,0), C0,14); VRD2(7); \
    GAPB(o[2]=__builtin_amdgcn_mfma_f32_32x32x16_bf16(PAF(0),VFR(0),o[2],0,0,0), C1,0); \
    GAPB(o[3]=__builtin_amdgcn_mfma_f32_32x32x16_bf16(PAF(0),VFR(4),o[3],0,0,0), C1,2); \
    KRD(GL,0); GAPB(o[2]=__builtin_amdgcn_mfma_f32_32x32x16_bf16(PAF(1),VFR(1),o[2],0,0,0), C1,4); \
    KRD(GL,1); GAPB(o[3]=__builtin_amdgcn_mfma_f32_32x32x16_bf16(PAF(1),VFR(5),o[3],0,0,0), C1,6); \
    KRD(GL,2); GAPB(o[2]=__builtin_amdgcn_mfma_f32_32x32x16_bf16(PAF(2),VFR(2),o[2],0,0,0), C1,8); \
    KRD(GL,3); GAPB(o[3]=__builtin_amdgcn_mfma_f32_32x32x16_bf16(PAF(2),VFR(6),o[3],0,0,0), C1,10); \
    GAPB(o[2]=__builtin_amdgcn_mfma_f32_32x32x16_bf16(PAF(3),VFR(3),o[2],0,0,0), C1,12); \
    GAPB(o[3]=__builtin_amdgcn_mfma_f32_32x32x16_bf16(PAF(3),VFR(7),o[3],0,0,0), C1,14); \
    }while(0)
  int t=1;
  #undef CMASK
  #define CMASK(P0,P1,t) do{}while(0)
  for(;t+5<NT;t+=2){
    STEP(pB0,pB1,pA0,pA1,t,true,true,true);     WAIT_BAR(3); RESC(); ROT();
    STEP(pA0,pA1,pB0,pB1,t+1,true,true,true);   WAIT_BAR(3); RESC(); ROT();
  }
  #undef CMASK
  #define CMASK(P0,P1,t) do{int jb_=(t)-(NT-4); if(jb_>=0)cmask(P0,P1,jb_,qrel,hi);}while(0)
  #define ENDW(tt) do{ if((tt)+3<NT){WAIT_BAR(3);} else if((tt)+2<NT){WAIT_BAR(2);} else {WAIT_BAR(0);} }while(0)
  for(;t+1<NT;t+=2){
    STEP(pB0,pB1,pA0,pA1,t,(t+3<NT),(t+1<NT),(t+1<NT));       ENDW(t);   RESC(); ROT();
    STEP(pA0,pA1,pB0,pB1,t+1,(t+4<NT),(t+2<NT),(t+2<NT));     ENDW(t+1); RESC(); ROT();
  }
  STEP(pB0,pB1,pA0,pA1,NT-1,false,false,false); RESC();
  { float sacc=pB0[0]+pB0[1]; _Pragma("unroll") for(int r=2;r<16;++r)sacc+=pB0[r]; _Pragma("unroll") for(int r=0;r<16;++r)sacc+=pB1[r]; l_reg+=sacc;
    pw0=(u32x4){PKW(pB0,0),PKW(pB0,2),PKW(pB0,4),PKW(pB0,6)};pw1=(u32x4){PKW(pB0,8),PKW(pB0,10),PKW(pB0,12),PKW(pB0,14)};pw2=(u32x4){PKW(pB1,0),PKW(pB1,2),PKW(pB1,4),PKW(pB1,6)};pw3=(u32x4){PKW(pB1,8),PKW(pB1,10),PKW(pB1,12),PKW(pB1,14)};
    SBAR(); pv(o,vb0+2*sl_cur,PAF(0),PAF(1),PAF(2),PAF(3)); }
  #undef PKW
  #undef PAF
  #undef VFR
  #undef PIN
  #undef MX3
  #undef GAPA
  #undef GAPB
  #undef EX
  #undef VRD
  #undef VRD2
  #undef KRD
  #undef STEP
  #undef ENDW
  {auto rr=__builtin_amdgcn_permlane32_swap(__float_as_uint(l_reg),__float_as_uint(l_reg),false,false);l_reg=__uint_as_float(rr[0])+__uint_as_float(rr[1]);}
  if(hi==0)wsf[32+r32]=l_reg;asm volatile("s_waitcnt lgkmcnt(0)":::"memory");
  float rli[16];
  #pragma unroll
  for(int r=0;r<16;++r)rli[r]=__builtin_amdgcn_rcpf(wsf[32+crow(r,hi)]);
  bf16*Ow=O+(rowbase+q0+wid*QBLK)*DMO+ocol;
  { bf16*stg=(bf16*)(shm+LDS_OST)+wid*2048;
    #pragma unroll
    for(int ps=0;ps<2;++ps){
      #pragma unroll
      for(int r=0;r<16;++r){const int orow=crow(r,hi);
        #pragma unroll
        for(int d0=0;d0<2;++d0)stg[orow*64+d0*32+r32]=__float2bfloat16(o[2*ps+d0][r]*rli[r]);}
      asm volatile("s_waitcnt lgkmcnt(0)":::"memory");
      #pragma unroll
      for(int i=0;i<4;++i){const int row=i*8+(lane>>3),ch=lane&7; const u32x4 v=*(const u32x4*)(stg+row*64+ch*8); ATTN_STORE16(Ow+(long)row*DMO+ps*64+ch*8,v);}
      asm volatile("s_waitcnt lgkmcnt(0)":::"memory"); } }
  asm volatile("s_waitcnt lgkmcnt(0)\n\ts_barrier":::"memory");
  #undef DMA_K
  #undef DMA_V
  #undef CMASK
  #undef START
  #undef RESC
  #undef ROT
}
constexpr int ATTN_LDS_BYTES=LDS_BYTES;
template<int THRL=8> __device__ __forceinline__ void attn_phase(char*lds,const bf16*U,bf16*Oc,int vcu){
  const int bhc=vcu>>3,s=vcu&7,b=bhc>>3,h=(bhc>>1)&3,c=bhc&1;
  _Pragma("unroll 1") for(int i=0;i<2;++i){ const int qb=i?15-s:s;
    attn_unit<THRL>(b,h*128+c*64,512+h*128+c*64,1024+h*128,h*128,qb,U,U,U,Oc+(long)c*16384*DMO,lds); }
}
#undef SBAR
#undef WAIT_BAR
}


namespace gla {
constexpr int GP = 72;
constexpr int L_BC = 0, L_VT = 16384, L_QI = 34816, L_KI = 44032, L_ATT = 53248, L_OF = 62464, OFP = 132;
__device__ __forceinline__ bf16x8 frag(const LAS unsigned char* base, int row, int k0) { return *(const LAS bf16x8*)(base + (row * GP + k0) * 2); }
struct LdState { f32x4 g0, g1; unsigned vw[8]; unsigned kw[4]; };
__device__ __forceinline__ void ld_common(f32x4& g0, f32x4& g1, unsigned (&vw)[8], const float* LOGA, const bf16_t* Ugla, size_t row0, int h, int tid) {
    const float* gp = LOGA + (row0 + (tid >> 3)) * 256 + h * 64 + (tid & 7) * 8; g0 = *(const f32x4*)gp; g1 = *(const f32x4*)(gp + 4);
    const bf16_t* vp = Ugla + (row0 + (tid >> 7) * 16) * 1536 + 512 + h * 128 + (tid & 127);
#pragma unroll
    for (int j = 0; j < 8; ++j) vw[j] = (unsigned)vp[(size_t)(2 * j) * 1536] | ((unsigned)vp[(size_t)(2 * j + 1) * 1536] << 16);
}
__device__ __forceinline__ void ld_state(LdState& L, const float* LOGA, const bf16_t* Ugla, size_t row0, int h, int tid) {
    ld_common(L.g0, L.g1, L.vw, LOGA, Ugla, row0, h, tid);
    const bf16_t* kp = Ugla + (row0 + (tid >> 6) * 8) * 1536 + 256 + h * 64 + (tid & 63);
#pragma unroll
    for (int j = 0; j < 4; ++j) L.kw[j] = (unsigned)kp[(size_t)(2 * j) * 1536] | ((unsigned)kp[(size_t)(2 * j + 1) * 1536] << 16);
}
__device__ __forceinline__ void stage_common(LAS unsigned char* lds, const f32x4& g0, const f32x4& g1, const unsigned (&vw)[8], int tid) {
    LAS float* Bc = (LAS float*)(lds + L_BC);
    *(LAS f32x4*)(Bc + (tid >> 3) * 64 + (tid & 7) * 8) = g0; *(LAS f32x4*)(Bc + (tid >> 3) * 64 + (tid & 7) * 8 + 4) = g1;
    LAS u32x4* dst = (LAS u32x4*)(lds + L_VT + ((tid & 127) * GP + (tid >> 7) * 16) * 2);
    dst[0] = (u32x4){vw[0], vw[1], vw[2], vw[3]}; dst[1] = (u32x4){vw[4], vw[5], vw[6], vw[7]};
}
__device__ __forceinline__ void cumsum_inplace(LAS unsigned char* lds, int lane, int wave) {
    LAS float* Bc = (LAS float*)(lds + L_BC);
    if (wave == 0) { float acc = 0.f;
#pragma unroll 16
        for (int s = 0; s < 64; ++s) { acc += Bc[s * 64 + lane]; Bc[s * 64 + lane] = acc; } }
}
__device__ __forceinline__ void chunk_state4(LAS unsigned char* lds, int b, int n, const float* LOGA, const bf16_t* Ugla, bf16_t* SCt, float* DEC, int tid, int lane, int wave) {
    const size_t row0 = (size_t)b * SEQ + n * 64;
    LAS float* Bc = (LAS float*)(lds + L_BC);
    LdState cur; ld_state(cur, LOGA, Ugla, row0, 0, tid);
#pragma unroll 1
    for (int h = 0; h < 4; ++h) {
        const int q = ((b * 4 + h) << 6) + n;
        stage_common(lds, cur.g0, cur.g1, cur.vw, tid);
        __syncthreads();
        cumsum_inplace(lds, lane, wave);
        __syncthreads();
        { const int k = tid & 63, sg = tid >> 6; const float bl = Bc[63 * 64 + k]; float f[8];
#pragma unroll
            for (int j = 0; j < 4; ++j) { f[2 * j] = lo_bf(cur.kw[j]) * __expf(bl - Bc[(sg * 8 + 2 * j) * 64 + k]); f[2 * j + 1] = hi_bf(cur.kw[j]) * __expf(bl - Bc[(sg * 8 + 2 * j + 1) * 64 + k]); }
            *(LAS u32x4*)(lds + L_QI + (k * GP + sg * 8) * 2) = (u32x4){pk2(f[0], f[1]), pk2(f[2], f[3]), pk2(f[4], f[5]), pk2(f[6], f[7])};
            if (tid < 64) DEC[(size_t)q * 64 + tid] = __expf(bl); }
        LdState nxt = cur; if (h < 3) ld_state(nxt, LOGA, Ugla, row0, h + 1, tid);
        __syncthreads();
        { const int fr = lane & 15, fq = lane >> 4, mt = wave >> 1;
#pragma unroll
            for (int j = 0; j < 4; ++j) { const int nt = (wave & 1) * 4 + j; f32x4 acc = {0.f, 0.f, 0.f, 0.f};
#pragma unroll
                for (int ks = 0; ks < 2; ++ks) acc = __builtin_amdgcn_mfma_f32_16x16x32_bf16(frag(lds + L_QI, 16 * mt + fr, 32 * ks + 8 * fq), frag(lds + L_VT, 16 * nt + fr, 32 * ks + 8 * fq), acc, 0, 0, 0);
                *(u32x2*)(SCt + (size_t)q * 8192 + (16 * nt + fr) * 64 + 16 * mt + 4 * fq) = (u32x2){pk2(acc[0], acc[1]), pk2(acc[2], acc[3])}; } }
        __syncthreads();
        cur = nxt;
    }
}
struct LdOut { f32x4 g0, g1; unsigned vw[8]; u32x4 qw, kw, r0, r1; bf16x8 sp[4][2]; };
__device__ __forceinline__ void ld_out(LdOut& L, const float* LOGA, const bf16_t* Ugla, const bf16_t* SPt, size_t row0, int h, int q, int tid, int lane, int wave) {
    ld_common(L.g0, L.g1, L.vw, LOGA, Ugla, row0, h, tid);
    const bf16_t* rp = Ugla + (row0 + (tid >> 3)) * 1536 + h * 64 + (tid & 7) * 8; L.qw = *(const u32x4*)rp; L.kw = *(const u32x4*)(rp + 256);
    const bf16_t* gp = Ugla + (row0 + (tid >> 3)) * 1536 + 1024 + h * 128 + (tid & 7) * 16; L.r0 = *(const u32x4*)gp; L.r1 = *(const u32x4*)(gp + 8);
    const int fr = lane & 15, fq = lane >> 4;
#pragma unroll
    for (int j = 0; j < 4; ++j)
#pragma unroll
        for (int ks = 0; ks < 2; ++ks) L.sp[j][ks] = *(const bf16x8*)(SPt + (size_t)q * 8192 + (16 * ((wave & 1) * 4 + j) + fr) * 64 + 32 * ks + 8 * fq);
}
__device__ __forceinline__ void chunk_out4(LAS unsigned char* lds, int b, int n, const float* LOGA, const bf16_t* Ugla, const bf16_t* SPt, const float* gog, bf16_t* OA, int tid, int lane, int wave) {
    const size_t row0 = (size_t)b * SEQ + n * 64;
    LAS float* Bc = (LAS float*)(lds + L_BC); LAS float* Of = (LAS float*)(lds + L_OF);
    const int fr = lane & 15, fq = lane >> 4;
    float gg[16];
#pragma unroll
    for (int e = 0; e < 16; ++e) gg[e] = gog[(tid & 7) * 16 + e];
    LdOut cur; ld_out(cur, LOGA, Ugla, SPt, row0, 0, ((b * 4) << 6) + n, tid, lane, wave);
#pragma unroll 1
    for (int h = 0; h < 4; ++h) {
        stage_common(lds, cur.g0, cur.g1, cur.vw, tid);
        __syncthreads();
        cumsum_inplace(lds, lane, wave);
        __syncthreads();
        { const int s = tid >> 3, k0 = (tid & 7) * 8; float qf[8], kf[8];
            qf[0] = lo_bf(cur.qw.x); qf[1] = hi_bf(cur.qw.x); qf[2] = lo_bf(cur.qw.y); qf[3] = hi_bf(cur.qw.y); qf[4] = lo_bf(cur.qw.z); qf[5] = hi_bf(cur.qw.z); qf[6] = lo_bf(cur.qw.w); qf[7] = hi_bf(cur.qw.w);
            kf[0] = lo_bf(cur.kw.x); kf[1] = hi_bf(cur.kw.x); kf[2] = lo_bf(cur.kw.y); kf[3] = hi_bf(cur.kw.y); kf[4] = lo_bf(cur.kw.z); kf[5] = hi_bf(cur.kw.z); kf[6] = lo_bf(cur.kw.w); kf[7] = hi_bf(cur.kw.w);
#pragma unroll
            for (int e = 0; e < 8; ++e) { const float bv = Bc[s * 64 + k0 + e]; qf[e] *= 0.125f * __expf(bv); kf[e] *= __expf(-bv); }
            *(LAS u32x4*)(lds + L_QI + (s * GP + k0) * 2) = (u32x4){pk2(qf[0], qf[1]), pk2(qf[2], qf[3]), pk2(qf[4], qf[5]), pk2(qf[6], qf[7])};
            *(LAS u32x4*)(lds + L_KI + (s * GP + k0) * 2) = (u32x4){pk2(kf[0], kf[1]), pk2(kf[2], kf[3]), pk2(kf[4], kf[5]), pk2(kf[6], kf[7])}; }
        __syncthreads();
#pragma unroll
        for (int j = 0; j < 2; ++j) { const int t = 2 * wave + j, mt = t >> 2, nt = t & 3; f32x4 acc = {0.f, 0.f, 0.f, 0.f};
#pragma unroll
            for (int ks = 0; ks < 2; ++ks) acc = __builtin_amdgcn_mfma_f32_16x16x32_bf16(frag(lds + L_QI, 16 * mt + fr, 32 * ks + 8 * fq), frag(lds + L_KI, 16 * nt + fr, 32 * ks + 8 * fq), acc, 0, 0, 0);
            LAS bf16_t* ap = (LAS bf16_t*)(lds + L_ATT); const int sc = 16 * nt + fr;
#pragma unroll
            for (int r = 0; r < 4; ++r) { const int c = 16 * mt + 4 * fq + r; ap[c * GP + sc] = (bf16_t)f2bf(sc <= c ? acc[r] : 0.f); } }
        __syncthreads();
        { const int mt = wave >> 1;
#pragma unroll
            for (int j = 0; j < 4; ++j) { const int nt = (wave & 1) * 4 + j; f32x4 acc = {0.f, 0.f, 0.f, 0.f};
#pragma unroll
                for (int ks = 0; ks < 2; ++ks) { acc = __builtin_amdgcn_mfma_f32_16x16x32_bf16(frag(lds + L_ATT, 16 * mt + fr, 32 * ks + 8 * fq), frag(lds + L_VT, 16 * nt + fr, 32 * ks + 8 * fq), acc, 0, 0, 0);
                    acc = __builtin_amdgcn_mfma_f32_16x16x32_bf16(frag(lds + L_QI, 16 * mt + fr, 32 * ks + 8 * fq), cur.sp[j][ks], acc, 0, 0, 0); }
#pragma unroll
                for (int r = 0; r < 4; ++r) Of[(16 * mt + 4 * fq + r) * OFP + 16 * nt + fr] = acc[r]; } }
        const u32x4 r0 = cur.r0, r1 = cur.r1;
        if (h < 3) ld_out(cur, LOGA, Ugla, SPt, row0, h + 1, ((b * 4 + h + 1) << 6) + n, tid, lane, wave);
        __syncthreads();
        { const int c = tid >> 3, v0 = (tid & 7) * 16; float o[16]; float ss = 0.f;
#pragma unroll
            for (int e = 0; e < 16; e += 4) { const f32x4 t4 = *(const LAS f32x4*)(Of + c * OFP + v0 + e); o[e] = t4.x; o[e + 1] = t4.y; o[e + 2] = t4.z; o[e + 3] = t4.w; ss += (t4.x * t4.x + t4.y * t4.y) + (t4.z * t4.z + t4.w * t4.w); }
            ss += __shfl_xor(ss, 1); ss += __shfl_xor(ss, 2); ss += __shfl_xor(ss, 4);
            const float rstd = __builtin_amdgcn_rsqf(ss * (1.f / 128.f) + 1e-6f);
            const unsigned rw[8] = {r0.x, r0.y, r0.z, r0.w, r1.x, r1.y, r1.z, r1.w}; unsigned ow[8];
#pragma unroll
            for (int e = 0; e < 8; ++e) { const float a = o[2 * e] * rstd * gg[2 * e] * siluf_(lo_bf(rw[e])), b2 = o[2 * e + 1] * rstd * gg[2 * e + 1] * siluf_(hi_bf(rw[e])); ow[e] = pk2(a, b2); }
            bf16_t* op = OA + (row0 + c) * 1024 + h * 128 + v0; *(u32x4*)op = (u32x4){ow[0], ow[1], ow[2], ow[3]}; *(u32x4*)(op + 8) = (u32x4){ow[4], ow[5], ow[6], ow[7]}; }
    }
}
}

#define XB_TMO      128
#define XB_XCNT(j)  (256  + 64 * (j))
#define XB_XSUB(j)  (1280 + 64 * (j))
#define XB_XGEN(j)  (2304 + 64 * (j))
#define XB_TOP      3328
#define XB_TOPGEN   3392
#define XCD_BAR_WORDS 3456
#define XB_SPIN_CAP (1u << 18)
__device__ __forceinline__ unsigned xb_ld(unsigned* p)              { return __hip_atomic_load(p, __ATOMIC_RELAXED, __HIP_MEMORY_SCOPE_AGENT); }
__device__ __forceinline__ unsigned xb_add(unsigned* p, unsigned v) { return __hip_atomic_fetch_add(p, v, __ATOMIC_RELAXED, __HIP_MEMORY_SCOPE_AGENT); }
__device__ __forceinline__ unsigned xb_xcc_id() { return (unsigned)__builtin_amdgcn_s_getreg((3 << 11) | 20) & 0xFu; }
#define XB_SPIN(cond, bar) do { unsigned _sp = 0; while (cond) { __builtin_amdgcn_s_sleep(1); \
    if ((++_sp & 255u) == 0u) { if (xb_ld(&(bar)[XB_TMO])) break; if (_sp > XB_SPIN_CAP) { atomicAdd(&(bar)[XB_TMO], 1u); break; } } } } while (0)
struct XcdBarrier { unsigned* bar; unsigned x; volatile LAS unsigned* st; };
__device__ __forceinline__ XcdBarrier xcd_barrier_post(unsigned* bar, volatile LAS unsigned* st) {
    XcdBarrier b; b.bar = bar; b.x = xb_xcc_id(); b.st = st;
    if (threadIdx.x == 0) (void)xb_add(&bar[XB_XCNT(b.x)], 1u);
    return b;
}
__device__ __forceinline__ void xcd_barrier_complete(unsigned* bar, unsigned x, unsigned& nloc, unsigned& nx) {
    const unsigned G = gridDim.x * gridDim.y * gridDim.z;
    unsigned sum, cnt, mine, sp = 0u;
    for (;;) {
        sum = 0u; cnt = 0u; mine = 0u;
#pragma unroll
        for (unsigned j = 0; j < 16; ++j) { const unsigned c = xb_ld(&bar[XB_XCNT(j)]); sum += c; cnt += (c > 0u) ? 1u : 0u; mine = (j == x) ? c : mine; }
        if (sum == G) break;
        __builtin_amdgcn_s_sleep(1);
        if ((++sp & 255u) == 0u) { if (xb_ld(&bar[XB_TMO])) break; if (sp > XB_SPIN_CAP) { atomicAdd(&bar[XB_TMO], 1u); break; } }
    }
    nloc = mine > 0u ? mine : 1u; nx = cnt > 0u ? cnt : 1u;
}
__device__ __forceinline__ void xcd_barrier(const XcdBarrier& b) {
    asm volatile("s_waitcnt vmcnt(0)" ::: "memory");
    __syncthreads();
    if (threadIdx.x == 0) {
        unsigned* bar = b.bar;
        __builtin_amdgcn_s_waitcnt(0);
        unsigned nloc = b.st[0], nx = b.st[1];
        if (nloc == 0u) { xcd_barrier_complete(bar, b.x, nloc, nx); b.st[0] = nloc; b.st[1] = nx; }
        const unsigned old = xb_add(&bar[XB_XSUB(b.x)], 1u);
        const unsigned gen = old / nloc;
        if (old + 1u == (gen + 1u) * nloc) {
            __builtin_amdgcn_fence(__ATOMIC_RELEASE, "agent");
            asm volatile("s_waitcnt vmcnt(0)" ::: "memory");
            const unsigned og = xb_add(&bar[XB_TOP], 1u);
            const unsigned tg = og / nx;
            if (og + 1u == (tg + 1u) * nx) xb_add(&bar[XB_TOPGEN], 1u);
            else XB_SPIN(xb_ld(&bar[XB_TOPGEN]) == tg, bar);
            __builtin_amdgcn_fence(__ATOMIC_ACQUIRE, "agent");
            xb_add(&bar[XB_XGEN(b.x)], 1u);
            asm volatile("s_waitcnt vmcnt(0)" ::: "memory");
        } else {
            XB_SPIN(xb_ld(&bar[XB_XGEN(b.x)]) == gen, bar);
            __builtin_amdgcn_fence(__ATOMIC_ACQUIRE, "agent");
            asm volatile("s_waitcnt vmcnt(0)" ::: "memory");
        }
    }
    __syncthreads();
}

struct Args { const void* in[28]; float* out; unsigned char* ws; int ph_lo, ph_hi; };
enum { I_X = 0, I_C, I_POS, I_ADAW, I_ADAB, I_N1G, I_N2G, I_WIN, I_AUP, I_AB, I_GOG, I_DQG, I_DKG, I_LQ1, I_LK1, I_LQ2, I_LK2, I_DOG, I_WBA, I_WBB, I_WOUT, I_RGW, I_RGB, I_REW, I_REB, I_EW1, I_EW3, I_EW2 };

struct TrJob { const float* src; bf16_t* dst; int ldn, kdst; };
__device__ __forceinline__ void tr_load(f32x4 (&v)[8], const TrJob& J, int lane) {
#pragma unroll
    for (int i = 0; i < 8; ++i) v[i] = *(const f32x4*)(J.src + (size_t)(8 * i + (lane >> 3)) * J.ldn + (lane & 7) * 4);
}
__device__ __forceinline__ void tr_store(const f32x4 (&v)[8], const TrJob& J, LAS float* scr, int lane) {
#pragma unroll
    for (int i = 0; i < 8; ++i) { LAS float* p = scr + (8 * i + (lane >> 3)) * 33 + (lane & 7) * 4; p[0] = v[i].x; p[1] = v[i].y; p[2] = v[i].z; p[3] = v[i].w; }
    LDS_WAIT(); asm volatile("" ::: "memory");
    const int c = lane & 7;
#pragma unroll
    for (int j = 0; j < 4; ++j) { const int n = (lane >> 3) + 8 * j; const LAS float* sp = scr + (8 * c) * 33 + n;
        u32x4 o; o.x = pk2(sp[0 * 33], sp[1 * 33]); o.y = pk2(sp[2 * 33], sp[3 * 33]); o.z = pk2(sp[4 * 33], sp[5 * 33]); o.w = pk2(sp[6 * 33], sp[7 * 33]);
        *(u32x4*)(J.dst + (size_t)n * J.kdst + 8 * c) = o; }
    LDS_WAIT(); asm volatile("" ::: "memory");
}
template <class Dec> __device__ __forceinline__ void tr_run(int first, int total, int stride, const Dec& dec, LAS float* scr, int lane) {
    int it = first; if (it >= total) return;
    TrJob J0 = dec(it), J1 = J0; f32x4 a[8], b[8];
    tr_load(a, J0, lane);
    const bool has1 = it + stride < total; if (has1) { J1 = dec(it + stride); tr_load(b, J1, lane); }
    for (;;) {
        const int n2 = it + 2 * stride; const bool more2 = n2 < total; TrJob J2 = J1; f32x4 c[8];
        if (more2) { J2 = dec(n2); tr_load(c, J2, lane); }
        tr_store(a, J0, scr, lane);
        if (it + stride >= total) break;
#pragma unroll
        for (int i = 0; i < 8; ++i) { a[i] = b[i]; b[i] = c[i]; }
        J0 = J1; J1 = J2; it += stride;
    }
}
struct DecDense { const float *w_in, *wa, *wb, *wo; bf16_t *Win_t, *Wa_t, *Wb_t, *Wout_t;
    __device__ __forceinline__ TrJob operator()(int r) const {
        if (r < 2560) { const int kb = r / 160, nb = r % 160, n0 = 32 * nb, ns = n0 < 1536 ? n0 : n0 + 16; return TrJob{w_in + (size_t)(64 * kb) * DIN + ns, Win_t + (size_t)n0 * D + 64 * kb, DIN, D}; }
        r -= 2560;
        if (r < 256) { const int kb = r / 32, nb = r % 32; return TrJob{wa + (size_t)(64 * kb) * D + 32 * nb, Wa_t + (size_t)(32 * nb) * 1024 + 64 * kb, D, 1024}; }
        r -= 256;
        if (r < 256) { const int kb = r / 32, nb = r % 32; return TrJob{wb + (size_t)(64 * kb) * D + 32 * nb, Wb_t + (size_t)(32 * nb) * 1024 + 512 + 64 * kb, D, 1024}; }
        r -= 256;
        { const int kb = r / 32, nb = r % 32; return TrJob{wo + (size_t)(64 * kb) * D + 32 * nb, Wout_t + (size_t)(32 * nb) * D + 64 * kb, D, D}; }
    } };
struct DecExp13 { const float *w1, *w3; bf16_t *W13_t;
    __device__ __forceinline__ TrJob operator()(int it) const {
        const int e = it >> 9, r = it & 511, kb = r >> 5, nb = r & 31, r0 = 32 * nb, pn = r0 >> 8, half = (r0 >> 7) & 1, jj = r0 & 127;
        const float* p1 = w1; const float* p3 = w3; asm volatile("" : "+s"(p1), "+s"(p3));
        return TrJob{(half ? p3 : p1) + (size_t)e * D * DEXP + (size_t)(64 * kb) * DEXP + 128 * pn + jj, W13_t + (size_t)e * 1024 * 1024 + (size_t)r0 * D + 64 * kb, DEXP, D};
    } };
struct DecExp2 { const float *w2; bf16_t *W2_t;
    __device__ __forceinline__ TrJob operator()(int it) const {
        const int e = it >> 8, r2 = it & 255, kb = r2 >> 5, nb = r2 & 31;
        return TrJob{w2 + (size_t)e * DEXP * D + (size_t)(64 * kb) * D + 32 * nb, W2_t + (size_t)e * 1024 * 512 + (size_t)(32 * nb) * DEXP + 64 * kb, D, DEXP};
    } };

constexpr int TBL_OFF = LDSCTL_OFF + 1024;
constexpr int TBL_CNT = 0, TBL_PAD = 32, TBL_TE = 96, TBL_RO = 320;
constexpr int GCNT_W = 8192;
constexpr int W2_EARLY = 10;
constexpr int ESEG = 32768;
__device__ __forceinline__ int build_moe_tables(LAS int* tb, const unsigned* gcnt, int tid) {
    if (tid < 32) tb[TBL_CNT + tid] = (int)gcnt[tid];
    __syncthreads();
    if (tid == 0) { int off = 0; for (int e = 0; e < 32; ++e) { tb[TBL_PAD + e] = off; off += ((tb[TBL_CNT + e] + 255) >> 8) << 8; } tb[TBL_PAD + 32] = off; }
    __syncthreads();
    if (tid < 32) { for (int t = tb[TBL_PAD + tid] >> 8; t < (tb[TBL_PAD + tid + 1] >> 8); ++t) tb[TBL_TE + t] = tid; }
    __syncthreads();
    return tb[TBL_PAD + 32] >> 8;
}
#define PHASE_LOCALS int tid_l = threadIdx.x; asm volatile("" : "+v"(tid_l)); int cb_l = blockIdx.x; asm volatile("" : "+s"(cb_l)); \
    const int tid = tid_l, lane = tid & 63, wave = __builtin_amdgcn_readfirstlane(tid >> 6), cb = cb_l, G = 256, gw = cb * NWAVES + wave, NGW = G * NWAVES; (void)lane; (void)gw; (void)NGW; (void)G;
template <int IDX> __device__ __forceinline__ const void* ldarg() {
    unsigned long long p;
    asm volatile("s_load_dwordx2 %0, %1, %2\n\ts_waitcnt lgkmcnt(0)" : "=s"(p) : "s"(__builtin_amdgcn_kernarg_segment_ptr()), "n"(IDX * 8) : "memory");
    return (const void*)(GAS const void*)p;
}
#define ARG_IN(i) (ldarg<(i)>())
#define ARG_WS ((unsigned char*)ldarg<29>())
#define XIN ((const float*)ARG_IN(I_X))
#define OUTP ((float*)ldarg<28>())
#define P_MODP ((float*)(ARG_WS + WS_MODP))
#define P_MODF ((float*)(ARG_WS + WS_MODF))
#define P_ALR ((float*)(ARG_WS + WS_ALR))
#define P_WIN ((bf16_t*)(ARG_WS + WS_WIN))
#define P_WA ((bf16_t*)(ARG_WS + WS_WA))
#define P_WB ((bf16_t*)(ARG_WS + WS_WB))
#define P_WOUT ((bf16_t*)(ARG_WS + WS_WOUT))
#define P_XN ((bf16_t*)(ARG_WS + WS_XN))
#define P_LOGA ((float*)(ARG_WS + WS_LOGA))
#define P_SCT ((bf16_t*)(ARG_WS + WS_SCT))
#define P_SPT ((bf16_t*)(ARG_WS + WS_SPT))
#define P_OC ((bf16_t*)(ARG_WS + WS_OC))
#define P_DEC ((float*)(ARG_WS + WS_DEC))
#define P_WRT ((float*)(ARG_WS + WS_WRT))
#define P_LRT ((float*)(ARG_WS + WS_LRT))
#define P_OB ((bf16_t*)(ARG_WS + WS_OB))
#define P_OA ((bf16_t*)(ARG_WS + WS_OA))
#define P_XS ((bf16_t*)(ARG_WS + WS_XS))
#define P_Y ((bf16_t*)(ARG_WS + WS_Y))
#define P_UGLA ((bf16_t*)(ARG_WS + WS_UGLA))
#define P_UDIFF ((bf16_t*)(ARG_WS + WS_UDIFF))
#define P_UGATE ((bf16_t*)(ARG_WS + WS_UGATE))
#define P_M1 ((bf16_t*)(ARG_WS + WS_M1))
#define P_MERGED ((bf16_t*)(ARG_WS + WS_MERGED))
#define P_H2 ((bf16_t*)(ARG_WS + WS_H2))
#define P_SLOTTOK ((int*)(ARG_WS + WS_SLOTTOK))
#define P_W13 ((bf16_t*)(ARG_WS + WS_W13))
#define P_W2 ((bf16_t*)(ARG_WS + WS_W2))
#define P_HMID ((bf16_t*)(ARG_WS + WS_HMID))
#define P_TOKE ((int*)(ARG_WS + WS_ROUTE + RT_TOKE))
#define P_TOKW ((float*)(ARG_WS + WS_ROUTE + RT_TOKW))
#define P_RANK ((int*)(ARG_WS + WS_ROUTE + RT_RANK))
#define P_SLOT ((int*)(ARG_WS + WS_ROUTE + RT_SLOT))
#define P_BLKCNT ((int*)(ARG_WS + WS_ROUTE + RT_BLKCNT))
#define P_TILEE ((int*)(ARG_WS + WS_ROUTE + RT_TILEE))
#define P_NT ((int*)(ARG_WS + WS_ROUTE + RT_NT))
template <int LO, int HI>
__global__ void __launch_bounds__(NTHR, 2) mk_fwd(Args args) {
    extern __shared__ __attribute__((aligned(16))) unsigned char lds_raw[];
    LAS unsigned char* lds = (LAS unsigned char*)lds_raw;
    volatile LAS unsigned* MISC = (volatile LAS unsigned*)(lds + MISC_OFF);
    unsigned* ctl = (unsigned*)(ARG_WS + WS_CTL);
    for (int u = threadIdx.x; u < (LDS_BYTES - LDSCTL_OFF) / 4; u += NTHR) ((LAS unsigned*)(lds + LDSCTL_OFF))[u] = 0u;
    __syncthreads();
    constexpr int lo = LO, hi = HI;
    XcdBarrier bar; bar.bar = ctl + CW_BAR; bar.x = 0; bar.st = nullptr;
    if constexpr (hi - lo > 1) bar = xcd_barrier_post(ctl + CW_BAR, MISC + 8);
#define IN(k) (lo <= (k) && (k) < hi)
#define SEAM(k) do { if constexpr (IN(k) && IN((k) + 1)) xcd_barrier(bar); } while (0)

    if constexpr (IN(0)) {
        asm volatile("; PHASE_BEGIN 0" ::: "memory");
        PHASE_LOCALS
        float* modp = P_MODP; bf16_t* Win_t = P_WIN; bf16_t* Wa_t = P_WA; bf16_t* Wb_t = P_WA; bf16_t* Wout_t = P_WOUT;
        const float* cvec = (const float*)ARG_IN(I_C); const float* ada_w = (const float*)ARG_IN(I_ADAW);
        const float* w_in = (const float*)ARG_IN(I_WIN);
        LAS float* scr = (LAS float*)(lds + wave * 16384);
        for (int r = gw; r < 768; r += NGW) {
            const int jc = r % 24, kc = r / 24, j = jc * 256 + lane * 4;
            f32x4 a0 = {0, 0, 0, 0}, a1 = a0, a2 = a0, a3 = a0;
            const float sA = siluf_(cvec[(lane >> 5) * D + kc * 32 + (lane & 31)]), sB = siluf_(cvec[(2 + (lane >> 5)) * D + kc * 32 + (lane & 31)]);
#pragma unroll 8
            for (int kk = 0; kk < 32; ++kk) { const int k = kc * 32 + kk; const f32x4 w = *(const f32x4*)(ada_w + (size_t)k * NMOD + j);
                a0 += __shfl(sA, kk) * w; a1 += __shfl(sA, 32 + kk) * w; a2 += __shfl(sB, kk) * w; a3 += __shfl(sB, 32 + kk) * w; }
            *(f32x4*)(modp + (size_t)(kc * 4 + 0) * NMOD + j) = a0; *(f32x4*)(modp + (size_t)(kc * 4 + 1) * NMOD + j) = a1;
            *(f32x4*)(modp + (size_t)(kc * 4 + 2) * NMOD + j) = a2; *(f32x4*)(modp + (size_t)(kc * 4 + 3) * NMOD + j) = a3; }
        { const float* Wrg = (const float*)ARG_IN(I_RGW); const float* Wre = (const float*)ARG_IN(I_REW); float* WrT = P_WRT;
          for (int idx = cb * NTHR + tid; idx < 36 * D; idx += G * NTHR) { const int j = idx >> 10, k = idx & 1023; WrT[idx] = j < 4 ? Wrg[k * 4 + j] : Wre[k * 32 + (j - 4)]; } }
        { float* LrT = P_LRT;
          for (int idx = cb * NTHR + tid; idx < 16 * D; idx += G * NTHR) { const int r = idx >> 10, k = idx & 1023; LrT[idx] = w_in[(size_t)k * DIN + 1536 + r]; } }
        { const DecDense dec{w_in, (const float*)ARG_IN(I_WBA), (const float*)ARG_IN(I_WBB), (const float*)ARG_IN(I_WOUT), Win_t, Wa_t, Wb_t, Wout_t};
          tr_run(gw, 2560 + 256 + 256 + 512, NGW, dec, scr, lane); }
    }
    SEAM(0);

    if constexpr (IN(1)) {
        asm volatile("; PHASE_BEGIN 1" ::: "memory");
        PHASE_LOCALS
        const float* x = XIN; float* modp = P_MODP; float* modf = P_MODF; float* alr = P_ALR; bf16_t* XN = P_XN;
        const float* ada_b = (const float*)ARG_IN(I_ADAB); const float* g1 = (const float*)ARG_IN(I_N1G);
        LAS float* modS = (LAS float*)lds;
        const float* LrT = P_LRT;
        const int b = cb >> 6;
        { const int j = tid * 4; f32x4 pv[32];
#pragma unroll
            for (int kc = 0; kc < 32; ++kc) pv[kc] = *(const f32x4*)(modp + (size_t)(kc * 4 + b) * NMOD + j);
            float pm[32]; const int idx = cb * 96 + (tid < 96 ? tid : 0), bb = idx / NMOD, jm = idx % NMOD;
#pragma unroll
            for (int kc = 0; kc < 32; ++kc) pm[kc] = modp[(size_t)(kc * 4 + bb) * NMOD + jm];
            f32x4 s = *(const f32x4*)(ada_b + j);
#pragma unroll
            for (int kc = 0; kc < 32; ++kc) s += pv[kc];
            if (j >= D) s += 1.0f;
            *(LAS f32x4*)(modS + j) = s;
            float sm = ada_b[jm];
#pragma unroll
            for (int kc = 0; kc < 32; ++kc) sm += pm[kc];
            if (tid < 96) modf[idx] = sm; }
        f32x4 hv[8][4];
        const size_t m0 = (size_t)cb * 64 + wave * 8;
#pragma unroll
        for (int i = 0; i < 8; ++i) { const f32x4* xr = (const f32x4*)(x + (m0 + i) * D) + lane;
#pragma unroll
            for (int j = 0; j < 4; ++j) hv[i][j] = xr[64 * j]; }
        { LAS float* lrS = (LAS float*)(lds + 8192);
          f32x4 t8[8];
#pragma unroll
          for (int q = 0; q < 8; ++q) t8[q] = *(const f32x4*)(LrT + (size_t)(q * NTHR + tid) * 4);
#pragma unroll
          for (int q = 0; q < 8; ++q) *(LAS f32x4*)(lrS + (q * NTHR + tid) * 4) = t8[q]; }
        __syncthreads();
#pragma unroll
        for (int i = 0; i < 8; ++i) { float ss = 0.f;
#pragma unroll
            for (int j = 0; j < 4; ++j) ss += (hv[i][j].x * hv[i][j].x + hv[i][j].y * hv[i][j].y) + (hv[i][j].z * hv[i][j].z + hv[i][j].w * hv[i][j].w);
            const float rstd = __builtin_amdgcn_rsqf(wave_sum(ss) * (1.f / D) + 1e-6f);
            unsigned long long* o8 = (unsigned long long*)(XN + (m0 + i) * D) + lane;
#pragma unroll
            for (int j = 0; j < 4; ++j) { const int k = 4 * lane + 256 * j; const f32x4 gg = *(const f32x4*)(g1 + k); const f32x4 sh = *(const LAS f32x4*)(modS + k); const f32x4 sc = *(const LAS f32x4*)(modS + D + k);
                hv[i][j] = hv[i][j] * rstd * gg * sc + sh;
                o8[64 * j] = (unsigned long long)pk2(hv[i][j].x, hv[i][j].y) | ((unsigned long long)pk2(hv[i][j].z, hv[i][j].w) << 32); } }
        { const LAS float* lrS = (const LAS float*)(lds + 8192);
#pragma unroll 2
          for (int r = 0; r < 16; ++r) {
            f32x4 w[4];
#pragma unroll
            for (int jj = 0; jj < 4; ++jj) w[jj] = *(const LAS f32x4*)(lrS + r * D + 4 * lane + 256 * jj);
            float a[8];
#pragma unroll
            for (int i = 0; i < 8; ++i) { f32x2 a2 = {0.f, 0.f};
#pragma unroll
                for (int jj = 0; jj < 4; ++jj) dot4_pk(a2, hv[i][jj], w[jj]);
                a[i] = a2.x + a2.y; }
            float y0, y1; reduce8(a, y0, y1);
            if ((lane & 15) == 0) { alr[(m0 + 2 * (lane >> 4)) * 16 + r] = y0; alr[(m0 + 2 * (lane >> 4) + 1) * 16 + r] = y1; }
          } }
    }
    SEAM(1);

    if constexpr (IN(2)) {
        asm volatile("; PHASE_BEGIN 2" ::: "memory");
        PHASE_LOCALS
        bf16_t* XN = P_XN; bf16_t* Win_t = P_WIN; bf16_t* Ugla = P_UGLA; bf16_t* Udiff = P_UDIFF; bf16_t* Ugate = P_UGATE;
        pg8::DenseOrder S; S.init(XN, Win_t, M, NPROJ, D, G, cb);
        pg8::EpiInProj E{Ugla, Udiff, Ugate};
        pg8::gemm_phase<pg8::EpiInProj, pg8::DenseOrder, true>(lds, D, S, E);
    }
    SEAM(2);

    if constexpr (IN(3)) {
        asm volatile("; PHASE_BEGIN 3" ::: "memory");
        PHASE_LOCALS
        bf16_t* Udiff = P_UDIFF; float* alr = P_ALR; float* LOGA = P_LOGA;
        const int* pos = (const int*)ARG_IN(I_POS); const float* qg = (const float*)ARG_IN(I_DQG); const float* kg = (const float*)ARG_IN(I_DKG);
        const float* aup = (const float*)ARG_IN(I_AUP); const float* ab = (const float*)ARG_IN(I_AB);
        const float invf = powf(500000.0f, -(float)(lane & 7) * 0.125f);
        const size_t m0 = (size_t)cb * 64 + wave * 8;
        u32x4 w0[8], w1[8]; float posv[8], av[8];
#pragma unroll
        for (int i = 0; i < 8; ++i) { const bf16_t* rowp = Udiff + (m0 + i) * 1536 + lane * 16; w0[i] = *(const u32x4*)rowp; w1[i] = *(const u32x4*)(rowp + 8);
            posv[i] = (float)pos[m0 + i]; av[i] = alr[(m0 + i) * 16 + (lane & 15)]; }
        float gain[16];
#pragma unroll
        for (int e = 0; e < 16; ++e) gain[e] = (lane < 32 ? qg : kg)[(lane & 3) * 16 + e];
        float au[16][4], abv[4];
#pragma unroll
        for (int q = 0; q < 4; ++q) { abv[q] = ab[lane + 64 * q];
#pragma unroll
            for (int rr = 0; rr < 16; ++rr) au[rr][q] = aup[rr * 256 + lane + 64 * q]; }
#pragma unroll
        for (int i = 0; i < 8; ++i) {
            float y[16];
            y[0] = lo_bf(w0[i].x); y[1] = hi_bf(w0[i].x); y[2] = lo_bf(w0[i].y); y[3] = hi_bf(w0[i].y); y[4] = lo_bf(w0[i].z); y[5] = hi_bf(w0[i].z); y[6] = lo_bf(w0[i].w); y[7] = hi_bf(w0[i].w);
            y[8] = lo_bf(w1[i].x); y[9] = hi_bf(w1[i].x); y[10] = lo_bf(w1[i].y); y[11] = hi_bf(w1[i].y); y[12] = lo_bf(w1[i].z); y[13] = hi_bf(w1[i].z); y[14] = lo_bf(w1[i].w); y[15] = hi_bf(w1[i].w);
            float ss = 0.f;
#pragma unroll
            for (int e = 0; e < 16; ++e) ss += y[e] * y[e];
            ss += __shfl_xor(ss, 1); ss += __shfl_xor(ss, 2);
            const float rstd = __builtin_amdgcn_rsqf(ss * (1.f / 64.f) + 1e-6f);
#pragma unroll
            for (int e = 0; e < 16; ++e) y[e] = y[e] * rstd * gain[e];
            float rev = posv[i] * invf * 0.15915494309189535f; rev -= floorf(rev);
            const float sv = __builtin_amdgcn_sinf(rev), cv = __builtin_amdgcn_cosf(rev);
            float r[16];
#pragma unroll
            for (int e = 0; e < 8; ++e) { const float c_ = __shfl(cv, e), s_ = __shfl(sv, e); r[e] = y[e] * c_ - y[e + 8] * s_; r[e + 8] = y[e + 8] * c_ + y[e] * s_; }
            if ((lane & 3) == 0) {
#pragma unroll
                for (int e = 0; e < 16; ++e) y[e] = r[e]; }
            if (lane < 32) {
#pragma unroll
                for (int e = 0; e < 16; ++e) y[e] *= attn_body::C2; }
            u32x4 o0, o1; o0.x = pk2(y[0], y[1]); o0.y = pk2(y[2], y[3]); o0.z = pk2(y[4], y[5]); o0.w = pk2(y[6], y[7]); o1.x = pk2(y[8], y[9]); o1.y = pk2(y[10], y[11]); o1.z = pk2(y[12], y[13]); o1.w = pk2(y[14], y[15]);
            bf16_t* rowp = Udiff + (m0 + i) * 1536 + lane * 16;
            *(u32x4*)rowp = o0; *(u32x4*)(rowp + 8) = o1;
            float xv[4];
#pragma unroll
            for (int q = 0; q < 4; ++q) xv[q] = abv[q];
#pragma unroll
            for (int rr = 0; rr < 16; ++rr) { const float a = __shfl(av[i], rr);
#pragma unroll
                for (int q = 0; q < 4; ++q) xv[q] += a * au[rr][q]; }
#pragma unroll
            for (int q = 0; q < 4; ++q) { const float ls = fminf(xv[q], 0.f) - __logf(1.0f + __expf(-fabsf(xv[q]))); LOGA[(m0 + i) * 256 + lane + 64 * q] = ls * (1.f / 16.f); }
        }
        VM_WAIT(); __syncthreads();
        gla::chunk_state4(lds, cb >> 6, cb & 63, LOGA, P_UGLA, P_SCT, P_DEC, tid, lane, wave);
    }
    SEAM(3);

    if constexpr (IN(4)) {
        asm volatile("; PHASE_BEGIN 4" ::: "memory");
        PHASE_LOCALS
        { const bf16_t* SCt = P_SCT; const float* DEC = P_DEC; bf16_t* SPt = P_SPT;
          const int idx = cb * NTHR + tid, bh = idx >> 13, e = idx & 8191, k = e & 63; float st = 0.f;
#pragma unroll 32
          for (int n = 0; n < 64; ++n) { const size_t q = (size_t)bh * 64 + n; const float sc = bf2f(SCt[q * 8192 + e]), d = DEC[q * 64 + k]; SPt[q * 8192 + e] = (bf16_t)f2bf(st); st = st * d + sc; } }
        { const int vcu = (cb % 8) * (G / 8) + cb / 8;
          attn2::attn_phase<8>((char*)lds_raw, (const attn2::bf16*)P_UDIFF, (attn2::bf16*)P_OC, vcu); }
    }
    SEAM(4);

    if constexpr (IN(5)) {
        asm volatile("; PHASE_BEGIN 5" ::: "memory");
        PHASE_LOCALS
        { const float* lq1 = (const float*)ARG_IN(I_LQ1); const float* lk1 = (const float*)ARG_IN(I_LK1); const float* lq2 = (const float*)ARG_IN(I_LQ2); const float* lk2 = (const float*)ARG_IN(I_LK2);
          const float* og = (const float*)ARG_IN(I_DOG); const bf16_t* Oc = P_OC; bf16_t* OB = P_OB;
          const float lam = __expf(wave_sum(lq1[lane] * lk1[lane])) - __expf(wave_sum(lq2[lane] * lk2[lane])) + 0.2f;
          const size_t m0 = (size_t)cb * 64 + wave * 8; const int col0 = lane * 8;
          u32x4 av[8], bv[8];
#pragma unroll
          for (int i = 0; i < 8; ++i) { av[i] = *(const u32x4*)(Oc + (m0 + i) * 512 + col0); bv[i] = *(const u32x4*)(Oc + (size_t)M * 512 + (m0 + i) * 512 + col0); }
          float ogv[8];
#pragma unroll
          for (int e = 0; e < 8; ++e) ogv[e] = og[(col0 & 127) + e];
#pragma unroll
          for (int i = 0; i < 8; ++i) {
            const unsigned aw[4] = {av[i].x, av[i].y, av[i].z, av[i].w}, bw[4] = {bv[i].x, bv[i].y, bv[i].z, bv[i].w}; float o[8]; float ss = 0.f;
#pragma unroll
            for (int e = 0; e < 4; ++e) { o[2 * e] = lo_bf(aw[e]) - lam * lo_bf(bw[e]); o[2 * e + 1] = hi_bf(aw[e]) - lam * hi_bf(bw[e]); ss += o[2 * e] * o[2 * e] + o[2 * e + 1] * o[2 * e + 1]; }
            ss += __shfl_xor(ss, 1); ss += __shfl_xor(ss, 2); ss += __shfl_xor(ss, 4); ss += __shfl_xor(ss, 8);
            const float rstd = __builtin_amdgcn_rsqf(ss * (1.f / 128.f) + 1e-6f) * 0.8f; unsigned ow[4];
#pragma unroll
            for (int e = 0; e < 4; ++e) ow[e] = pk2(o[2 * e] * rstd * ogv[2 * e], o[2 * e + 1] * rstd * ogv[2 * e + 1]);
            *(u32x4*)(OB + (m0 + i) * 1024 + 512 + col0) = (u32x4){ow[0], ow[1], ow[2], ow[3]}; } }
        __syncthreads();
        gla::chunk_out4(lds, cb >> 6, cb & 63, P_LOGA, P_UGLA, P_SPT, (const float*)ARG_IN(I_GOG), P_OA, tid, lane, wave);
    }
    SEAM(5);

    if constexpr (IN(6)) {
        asm volatile("; PHASE_BEGIN 6" ::: "memory");
        PHASE_LOCALS
        bf16_t* OAB = P_OA; bf16_t* Wab_t = P_WA; bf16_t* Ugate = P_UGATE; bf16_t* MERGED = P_MERGED;
        pg8::DenseOrder S; S.init(OAB, Wab_t, M, D, D, G, cb); pg8::EpiBranch E{Ugate, MERGED};
        pg8::gemm_phase<pg8::EpiBranch, pg8::DenseOrder, true, false, 8>(lds, D, S, E);
    }
    SEAM(6);

    if constexpr (IN(7)) {
        asm volatile("; PHASE_BEGIN 7" ::: "memory");
        PHASE_LOCALS
        const float* x = XIN; float* out = OUTP; float* modf = P_MODF; bf16_t* MERGED = P_MERGED; bf16_t* Wout_t = P_WOUT;
        pg8::DenseOrder S; S.init(MERGED, Wout_t, M, D, D, G, cb); pg8::EpiWout E{x, modf, (bf16_t*)out};
        pg8::gemm_phase<pg8::EpiWout, pg8::DenseOrder, true>(lds, D, S, E);
    }
    SEAM(7);

    if constexpr (IN(8)) {
        asm volatile("; PHASE_BEGIN 8" ::: "memory");
        PHASE_LOCALS
        float* out = OUTP; float* modf = P_MODF; bf16_t* H2 = P_H2; bf16_t* W13_t = P_W13; int* tok_e = P_TOKE; float* tok_w = P_TOKW; int* tok_rank = P_RANK; int* slot_tok = P_SLOTTOK;
        const float* g2 = (const float*)ARG_IN(I_N2G); const float* brg = (const float*)ARG_IN(I_RGB); const float* bre = (const float*)ARG_IN(I_REB); const float* WrT = P_WRT;
        LAS float* modS = (LAS float*)lds;
        LAS int* eS = (LAS int*)(lds + 8192);
        LAS float* LG = (LAS float*)(lds + 8192 + 1024);
        LAS float* WS = (LAS float*)(lds + 24576);
        const int b = cb >> 6;
        f32x4 hv[8][4];
        const size_t m0 = (size_t)cb * 64 + wave * 8;
#pragma unroll
        for (int i = 0; i < 8; ++i) { const bf16_t* xr = (const bf16_t*)out + (m0 + i) * 2048 + 1024 + 4 * lane;
#pragma unroll
            for (int j = 0; j < 4; ++j) { const u32x2 w = *(const u32x2*)(xr + 256 * j); hv[i][j] = (f32x4){lo_bf(w.x), hi_bf(w.x), lo_bf(w.y), hi_bf(w.y)}; } }
        for (int j = tid; j < 2048; j += NTHR) modS[j] = modf[(size_t)b * NMOD + 3 * D + j] + (j >= D ? 1.0f : 0.f);
#pragma unroll
        for (int q = 0; q < 10; ++q) *(LAS f32x4*)(WS + (q * NTHR + tid) * 4) = *(const f32x4*)(WrT + (size_t)(q * NTHR + tid) * 4);
        __syncthreads();
#pragma unroll
        for (int i = 0; i < 8; ++i) { float ss = 0.f;
#pragma unroll
            for (int j = 0; j < 4; ++j) ss += (hv[i][j].x * hv[i][j].x + hv[i][j].y * hv[i][j].y) + (hv[i][j].z * hv[i][j].z + hv[i][j].w * hv[i][j].w);
            const float rstd = __builtin_amdgcn_rsqf(wave_sum(ss) * (1.f / D) + 1e-6f);
            unsigned long long* o8 = (unsigned long long*)(H2 + (m0 + i) * D) + lane;
#pragma unroll
            for (int j = 0; j < 4; ++j) { const int k = 4 * lane + 256 * j; const f32x4 gg = *(const f32x4*)(g2 + k); const f32x4 sh = *(const LAS f32x4*)(modS + k); const f32x4 sc = *(const LAS f32x4*)(modS + D + k);
                hv[i][j] = hv[i][j] * rstd * gg * sc + sh;
                o8[64 * j] = (unsigned long long)pk2(hv[i][j].x, hv[i][j].y) | ((unsigned long long)pk2(hv[i][j].z, hv[i][j].w) << 32); } }
        const float biasv = lane < 4 ? brg[lane] : (lane < 36 ? bre[lane - 4] : 0.f);
        LAS float* lgw = LG + wave * 320;
#define RT_STEP(jl, jq) do { f32x4 W[4]; _Pragma("unroll") for (int jj = 0; jj < 4; ++jj) W[jj] = *(const LAS f32x4*)(WS + (jl) * D + 4 * lane + 256 * jj); \
            float a[8]; _Pragma("unroll") for (int i = 0; i < 8; ++i) { f32x2 a2 = {0.f, 0.f}; \
                _Pragma("unroll") for (int jj = 0; jj < 4; ++jj) dot4_pk(a2, hv[i][jj], W[jj]); a[i] = a2.x + a2.y; } \
            float y0, y1; reduce8(a, y0, y1); const float bj = __shfl(biasv, (jq)); \
            if ((lane & 15) == 0) { lgw[(2 * (lane >> 4)) * 40 + (jq)] = y0 + bj; lgw[(2 * (lane >> 4) + 1) * 40 + (jq)] = y1 + bj; } } while (0)
#pragma unroll 2
        for (int jx = 0; jx < 20; ++jx) RT_STEP(jx, jx);
        __syncthreads();
#pragma unroll
        for (int q = 0; q < 8; ++q) *(LAS f32x4*)(WS + (q * NTHR + tid) * 4) = *(const f32x4*)(WrT + (size_t)20 * D + (size_t)(q * NTHR + tid) * 4);
        __syncthreads();
#pragma unroll 2
        for (int jx = 0; jx < 16; ++jx) RT_STEP(jx, jx + 20);
#undef RT_STEP
        LDS_WAIT();
        if (lane < 8) {
            const LAS float* lr = lgw + lane * 40; const int tl = wave * 8 + lane;
            const float lg0 = lr[0], lg1 = lr[1], lg2 = lr[2], lg3 = lr[3];
            int gi = 0; float gm = lg0; if (lg1 > gm) { gm = lg1; gi = 1; } if (lg2 > gm) { gm = lg2; gi = 2; } if (lg3 > gm) { gm = lg3; gi = 3; }
            const float ptop = 1.0f / (__expf(lg0 - gm) + __expf(lg1 - gm) + __expf(lg2 - gm) + __expf(lg3 - gm));
            float el[8];
#pragma unroll
            for (int j = 0; j < 8; ++j) el[j] = lr[4 + gi * 8 + j];
            int j0 = 0; float e0 = el[0];
#pragma unroll
            for (int j = 1; j < 8; ++j) if (el[j] > e0) { e0 = el[j]; j0 = j; }
            int j1 = -1; float e1 = -3.0e38f;
#pragma unroll
            for (int j = 0; j < 8; ++j) if (j != j0 && el[j] > e1) { e1 = el[j]; j1 = j; }
            const float t = __expf(e1 - e0), w0 = ptop / (1.0f + t), w1 = ptop * t / (1.0f + t);
            eS[2 * tl] = gi * 8 + j0; eS[2 * tl + 1] = gi * 8 + j1; tok_w[(m0 + lane) * 2] = w0; tok_w[(m0 + lane) * 2 + 1] = w1;
        }
        __syncthreads();
        {
            LAS int* baseS = eS + 128; LAS int* cnt0S = eS + 160;
            int e = 0, rank = 0, myc = 0;
            if (tid < 128) { e = eS[tid]; const unsigned long long lt = (1ull << lane) - 1ull;
#pragma unroll 4
                for (int ex = 0; ex < 32; ++ex) { const unsigned long long mk = __ballot(e == ex); if (e == ex) rank = __popcll(mk & lt); if (lane == ex) myc = __popcll(mk); }
                if (wave == 0 && lane < 32) cnt0S[lane] = myc; }
            __syncthreads();
            if (tid >= 64 && tid < 128) { rank += cnt0S[e];
                if (lane < 32) { const int cnt = myc + cnt0S[lane];
                    baseS[lane] = cnt ? (int)__hip_atomic_fetch_add((unsigned*)(ARG_WS + WS_CTL) + GCNT_W + lane, (unsigned)cnt, __ATOMIC_RELAXED, __HIP_MEMORY_SCOPE_AGENT) : 0; } }
            __syncthreads();
            if (tid < 128) { const int g = baseS[e] + rank; tok_e[(size_t)cb * 128 + tid] = e; tok_rank[(size_t)cb * 128 + tid] = g; slot_tok[(size_t)e * ESEG + g] = cb * 64 + (tid >> 1); }
        }
        __syncthreads();
        { const DecExp13 dec{(const float*)ARG_IN(I_EW1), (const float*)ARG_IN(I_EW3), W13_t};
          tr_run(gw, NEXP * 512, NGW, dec, (LAS float*)(lds + wave * 16384), lane);
          const DecExp2 dec2{(const float*)ARG_IN(I_EW2), P_W2};
          tr_run(gw, W2_EARLY * 256, NGW, dec2, (LAS float*)(lds + wave * 16384), lane); }
    }
    SEAM(8);

    if constexpr (IN(9)) {
        asm volatile("; PHASE_BEGIN 9" ::: "memory");
        PHASE_LOCALS
        bf16_t* H2 = P_H2; bf16_t* W13_t = P_W13; bf16_t* HMID = P_HMID; const int* slot_tok = P_SLOTTOK;
        LAS int* tb = (LAS int*)(lds + TBL_OFF);
        const int ntm = __builtin_amdgcn_readfirstlane(build_moe_tables(tb, (const unsigned*)(ARG_WS + WS_CTL) + GCNT_W, tid));
        pg8::MoeOrder S; S.init(H2, W13_t, tb + TBL_TE, (const LAS unsigned*)(tb + TBL_RO), ntm, D, (size_t)1024 * 1024 * 2, G, cb); pg8::EpiUp E{HMID};
        { pg8::Unit u;
          for (int i = 0; i < 3; ++i) if (S.next(i, u) && tid < 256) { const int e = u.aux, idx = u.pm * 256 - tb[TBL_PAD + e] + tid;
              const int tok = idx < tb[TBL_CNT + e] ? slot_tok[(size_t)e * ESEG + idx] : 0; tb[TBL_RO + i * 256 + tid] = tok * (D * 2); } }
        __syncthreads();
        pg8::gemm_phase<pg8::EpiUp, pg8::MoeOrder, true, true>(lds, D, S, E);
        { const int nwg = ntm * 4, first_idle = nwg > 512 ? nwg - 512 : 0;
          if (cb >= first_idle) { const DecExp2 dec{(const float*)ARG_IN(I_EW2), P_W2}; const int nidle = G - first_idle;
              tr_run(W2_EARLY * 256 + (cb - first_idle) * NWAVES + wave, NEXP * 256, nidle * NWAVES, dec, (LAS float*)(lds + wave * 16384), lane); } }
    }
    SEAM(9);

    if constexpr (IN(10)) {
        asm volatile("; PHASE_BEGIN 10" ::: "memory");
        PHASE_LOCALS
        bf16_t* HMID = P_HMID; bf16_t* W2_t = P_W2; bf16_t* Y = P_Y;
        LAS int* tb = (LAS int*)(lds + TBL_OFF);
        const int ntm = __builtin_amdgcn_readfirstlane(build_moe_tables(tb, (const unsigned*)(ARG_WS + WS_CTL) + GCNT_W, tid));
        pg8::MoeOrder S; S.init(HMID, W2_t, tb + TBL_TE, nullptr, ntm, DEXP, (size_t)1024 * 512 * 2, G, cb); pg8::EpiPlain E{Y, D};
        pg8::gemm_phase<pg8::EpiPlain, pg8::MoeOrder, true>(lds, DEXP, S, E);
    }
    SEAM(10);

    if constexpr (IN(11)) {
        asm volatile("; PHASE_BEGIN 11" ::: "memory");
        PHASE_LOCALS
        float* out = OUTP; float* modf = P_MODF; bf16_t* Y = P_Y; const int* tok_e = P_TOKE; const int* tok_rank = P_RANK; float* tok_w = P_TOKW;
        LAS int* tb = (LAS int*)(lds + TBL_OFF);
        (void)build_moe_tables(tb, (const unsigned*)(ARG_WS + WS_CTL) + GCNT_W, tid);
        const size_t m0 = (size_t)cb * 64 + wave * 8; const float* g2p = modf + (size_t)(cb >> 6) * NMOD + 5 * D;
        int s0[8], s1[8]; float w0[8], w1[8];
#pragma unroll
        for (int i = 0; i < 8; ++i) { const int e0 = __builtin_amdgcn_readfirstlane(tok_e[(m0 + i) * 2]), e1 = __builtin_amdgcn_readfirstlane(tok_e[(m0 + i) * 2 + 1]);
            s0[i] = tb[TBL_PAD + e0] + tok_rank[(m0 + i) * 2]; s1[i] = tb[TBL_PAD + e1] + tok_rank[(m0 + i) * 2 + 1]; w0[i] = tok_w[(m0 + i) * 2]; w1[i] = tok_w[(m0 + i) * 2 + 1]; }
        f32x4 gv[4];
#pragma unroll
        for (int j = 0; j < 4; ++j) gv[j] = *(const f32x4*)(g2p + 4 * lane + 256 * j);
        f32x4 xa[2][4], xb[2][4]; u32x2 ya0[2][4], ya1[2][4], yb0[2][4], yb1[2][4];
#define P11_LOAD(XV, Y0, Y1, bb) do { _Pragma("unroll") for (int i2 = 0; i2 < 2; ++i2) { const int i = (bb) * 2 + i2; \
            _Pragma("unroll") for (int j = 0; j < 4; ++j) { const int k = 4 * lane + 256 * j; { const u32x2 w_ = *(const u32x2*)((const bf16_t*)out + (m0 + i) * 2048 + 1024 + k); XV[i2][j] = (f32x4){lo_bf(w_.x), hi_bf(w_.x), lo_bf(w_.y), hi_bf(w_.y)}; } \
                Y0[i2][j] = *(const u32x2*)(Y + (size_t)s0[i] * D + k); Y1[i2][j] = *(const u32x2*)(Y + (size_t)s1[i] * D + k); } } } while (0)
#define P11_DO(XV, Y0, Y1, bb) do { _Pragma("unroll") for (int i2 = 0; i2 < 2; ++i2) { const int i = (bb) * 2 + i2; \
            _Pragma("unroll") for (int j = 0; j < 4; ++j) { const int k = 4 * lane + 256 * j; f32x4 o; \
                o.x = XV[i2][j].x + gv[j].x * (w0[i] * lo_bf(Y0[i2][j].x) + w1[i] * lo_bf(Y1[i2][j].x)); o.y = XV[i2][j].y + gv[j].y * (w0[i] * hi_bf(Y0[i2][j].x) + w1[i] * hi_bf(Y1[i2][j].x)); \
                o.z = XV[i2][j].z + gv[j].z * (w0[i] * lo_bf(Y0[i2][j].y) + w1[i] * lo_bf(Y1[i2][j].y)); o.w = XV[i2][j].w + gv[j].w * (w0[i] * hi_bf(Y0[i2][j].y) + w1[i] * hi_bf(Y1[i2][j].y)); \
                *(f32x4*)(out + (m0 + i) * D + k) = o; } } } while (0)
        P11_LOAD(xa, ya0, ya1, 0);
        P11_LOAD(xb, yb0, yb1, 1); P11_DO(xa, ya0, ya1, 0);
        P11_LOAD(xa, ya0, ya1, 2); P11_DO(xb, yb0, yb1, 1);
        P11_LOAD(xb, yb0, yb1, 3); P11_DO(xa, ya0, ya1, 2);
        P11_DO(xb, yb0, yb1, 3);
#undef P11_LOAD
#undef P11_DO
    }
#undef IN
#undef SEAM
}

constexpr int NPHASE = 12;
template <int LO, int HI> static void launch_range(const Args& a, hipStream_t stream) {
    static bool attr = false;
    if (!attr) { (void)hipFuncSetAttribute((const void*)mk_fwd<LO, HI>, hipFuncAttributeMaxDynamicSharedMemorySize, LDS_BYTES); attr = true; }
    hipLaunchKernelGGL((mk_fwd<LO, HI>), dim3(256), dim3(NTHR), LDS_BYTES, stream, a);
}
extern "C" void kernel_launch(void* const* d_in, const int* in_sizes, int n_in, void* d_out, int out_size, void* d_ws, size_t ws_size, hipStream_t stream) {
    static int ok = 0;
    if (ok == 0) {
        if (n_in != 28 || out_size != M * D || ws_size < WS_END) { fprintf(stderr, "kernel_launch: unexpected shapes (n_in %d, out %d, ws %zu < %zu)\n", n_in, out_size, ws_size, (size_t)WS_END); ok = -1; return; }
        ok = 1;
    }
    if (ok < 0) return;
    (void)hipMemsetAsync((char*)d_ws + WS_CTL, 0, CTL_ZERO_BYTES, stream);
    Args a{};
    for (int i = 0; i < 28; ++i) a.in[i] = d_in[i];
    a.out = (float*)d_out; a.ws = (unsigned char*)d_ws; a.ph_lo = 0; a.ph_hi = NPHASE;
#if MK_ONE_LAUNCH
    launch_range<0, NPHASE>(a, stream);
#else
    launch_range<0, 1>(a, stream); launch_range<1, 2>(a, stream); launch_range<2, 3>(a, stream); launch_range<3, 4>(a, stream);
    launch_range<4, 5>(a, stream); launch_range<5, 6>(a, stream); launch_range<6, 7>(a, stream); launch_range<7, 8>(a, stream);
    launch_range<8, 9>(a, stream); launch_range<9, 10>(a, stream); launch_range<10, 11>(a, stream); launch_range<11, 12>(a, stream);
#endif
}
```
